# Optimizing an MI355X kernel written in HIP

```python
import jax
import jax.numpy as jnp
from jax import lax
import numpy as np

D_MODEL = 1024
BATCH = 4
SEQ = 4096
DEPTH = 1

HEAD_DIM = 128
N_HEADS_DN = 4
N_HEADS_MOBA = 4
D_DN = N_HEADS_DN * HEAD_DIM
D_MOBA = N_HEADS_MOBA * HEAD_DIM
D_MIX = D_DN + D_MOBA
CONV_K = 4
DN_CHUNK = 64
MOBA_BLOCK = 256
MOBA_TOPK = 3
MOBA_Q_CHUNK = 64
ROPE_THETA = 10000.0
N_GROUPS = 4
EXPERTS_PER_GROUP = 4
N_EXPERTS = N_GROUPS * EXPERTS_PER_GROUP
TOPK_IN_GROUP = 2
D_EXPERT = 256
LN_EPS = 1e-5
RMS_EPS = 1e-6
NEG_INF = -1e30
DEEPNORM_ALPHA = (2 * DEPTH) ** 0.25
DEEPNORM_BETA = (8 * DEPTH) ** -0.25

IN_PROJ_SIZES = (D_DN, D_DN, D_DN, D_DN, N_HEADS_DN, N_HEADS_DN, D_MOBA, D_MOBA, D_MOBA)
IN_PROJ_SPLITS = tuple(sum(IN_PROJ_SIZES[:i + 1]) for i in range(len(IN_PROJ_SIZES) - 1))
D_IN_PROJ = sum(IN_PROJ_SIZES)

kernel_name = 'hybrid_deltanet_moba_hmoe_deepnorm'


def causal_depthwise_conv(u, w):
    k_width, channels = w.shape
    return lax.conv_general_dilated(
        u, w[:, None, :].astype(u.dtype), window_strides=(1,), padding=[(k_width - 1, 0)],
        dimension_numbers=('NWC', 'WIO', 'NWC'), feature_group_count=channels)


def l2_normalize(t, eps=1e-6):
    return t * lax.rsqrt(jnp.sum(t * t, axis=-1, keepdims=True) + eps)


def layer_norm(t, g, b):
    tf = t.astype(jnp.float32)
    mu = jnp.mean(tf, axis=-1, keepdims=True)
    var = jnp.mean(jnp.square(tf - mu), axis=-1, keepdims=True)
    y = (tf - mu) * lax.rsqrt(var + LN_EPS) * g.astype(jnp.float32) + b.astype(jnp.float32)
    return y.astype(t.dtype)


def apply_rope(t, positions):
    half = HEAD_DIM // 2
    inv_freq = ROPE_THETA ** (-jnp.arange(half, dtype=jnp.float32) / half)
    ang = positions.astype(jnp.float32)[:, None] * inv_freq[None, :]
    cos, sin = jnp.cos(ang), jnp.sin(ang)
    tf = t.astype(jnp.float32)
    t1, t2 = tf[..., :half], tf[..., half:]
    return jnp.concatenate([t1 * cos - t2 * sin, t2 * cos + t1 * sin], axis=-1).astype(t.dtype)


def gated_deltanet(q, k, v, z, b, a, conv_w, a_log, dt_bias, norm_w):
    bsz, seq, _ = q.shape
    dtype = q.dtype
    f32 = jnp.float32
    qkv = jax.nn.silu(causal_depthwise_conv(jnp.concatenate([q, k, v], axis=-1), conv_w))
    q, k, v = jnp.split(qkv.astype(f32), 3, axis=-1)

    def heads(t):
        return t.reshape(bsz, seq, N_HEADS_DN, HEAD_DIM).transpose(0, 2, 1, 3)

    q = l2_normalize(heads(q)) * (HEAD_DIM ** -0.5)
    k = l2_normalize(heads(k))
    v = heads(v)
    beta = jax.nn.sigmoid(b.astype(f32)).transpose(0, 2, 1)
    g = (-jnp.exp(a_log.astype(f32)) *
         jax.nn.softplus(a.astype(f32) + dt_bias.astype(f32))).transpose(0, 2, 1)

    nc = seq // DN_CHUNK

    def chunks(t):
        return t.reshape(bsz, N_HEADS_DN, nc, DN_CHUNK, *t.shape[3:])

    q, k, v, beta, g = chunks(q), chunks(k), chunks(v), chunks(beta), chunks(g)
    g = jnp.cumsum(g, axis=-1)
    idx = jnp.arange(DN_CHUNK)
    incl = idx[:, None] >= idx[None, :]
    strict = idx[:, None] > idx[None, :]
    decay = jnp.exp(jnp.where(incl, g[..., :, None] - g[..., None, :], -jnp.inf))
    k_beta = k * beta[..., None]
    v_beta = v * beta[..., None]
    a_mat = jnp.where(strict, jnp.einsum('bhncd,bhnsd->bhncs', k_beta, k) * decay, 0.0)
    lhs = a_mat + jnp.eye(DN_CHUNK, dtype=f32)
    w_c = lax.linalg.triangular_solve(lhs, k_beta * jnp.exp(g)[..., None], left_side=True,
                                      lower=True, unit_diagonal=True)
    u_c = lax.linalg.triangular_solve(lhs, v_beta, left_side=True, lower=True, unit_diagonal=True)
    qk = jnp.einsum('bhncd,bhnsd->bhncs', q, k) * decay
    q_dec = q * jnp.exp(g)[..., None]
    k_dec = k * jnp.exp(g[..., -1:] - g)[..., None]
    g_last = jnp.exp(g[..., -1])

    def step(state, inp):
        qk_c, qd_c, wc, uc, kd_c, gl_c = inp
        v_new = uc - jnp.einsum('bhck,bhkv->bhcv', wc, state)
        o_c = jnp.einsum('bhck,bhkv->bhcv', qd_c, state) + jnp.einsum('bhcs,bhsv->bhcv', qk_c, v_new)
        state = state * gl_c[..., None, None] + jnp.einsum('bhck,bhcv->bhkv', kd_c, v_new)
        return state, o_c

    s0 = jnp.zeros((bsz, N_HEADS_DN, HEAD_DIM, HEAD_DIM), f32)
    xs = tuple(jnp.moveaxis(t, 2, 0) for t in (qk, q_dec, w_c, u_c, k_dec, g_last))
    _, o = lax.scan(step, s0, xs)
    o = jnp.moveaxis(o, 0, 2).reshape(bsz, N_HEADS_DN, seq, HEAD_DIM).transpose(0, 2, 1, 3)
    o = o * lax.rsqrt(jnp.mean(o * o, axis=-1, keepdims=True) + RMS_EPS) * norm_w.astype(f32)
    o = o * jax.nn.silu(z.astype(f32).reshape(bsz, seq, N_HEADS_DN, HEAD_DIM))
    return o.reshape(bsz, seq, D_DN).astype(dtype)


def moba_attention(q, k, v):
    bsz, seq, _ = q.shape
    dtype = q.dtype

    def heads(t):
        return t.reshape(bsz, seq, N_HEADS_MOBA, HEAD_DIM).transpose(0, 2, 1, 3)

    pos = jnp.arange(seq)
    q = apply_rope(heads(q), pos) * (HEAD_DIM ** -0.5)
    k = apply_rope(heads(k), pos)
    v = heads(v)
    nb = -(-seq // MOBA_BLOCK)
    pad = nb * MOBA_BLOCK - seq
    k = jnp.pad(k, ((0, 0), (0, 0), (0, pad), (0, 0)))
    v = jnp.pad(v, ((0, 0), (0, 0), (0, pad), (0, 0)))
    kb = k.reshape(bsz, N_HEADS_MOBA, nb, MOBA_BLOCK, HEAD_DIM)
    vb = v.reshape(bsz, N_HEADS_MOBA, nb, MOBA_BLOCK, HEAD_DIM)
    kmean = jnp.mean(kb.astype(jnp.float32), axis=3)
    topk = min(MOBA_TOPK, nb)
    gather_blocks = jax.vmap(jax.vmap(lambda blk, ix: blk[ix]))
    blk_ids = jnp.arange(nb)
    n_chunks = seq // MOBA_Q_CHUNK

    def chunk(c):
        start = c * MOBA_Q_CHUNK
        qc = lax.dynamic_slice_in_dim(q, start, MOBA_Q_CHUNK, axis=2)
        qpos = start + jnp.arange(MOBA_Q_CHUNK)
        own = start // MOBA_BLOCK
        gate = jnp.einsum('bhqd,bhnd->bhqn', qc.astype(jnp.float32), kmean)
        gate = jnp.where(blk_ids < own, gate, NEG_INF)
        _, sel = lax.top_k(gate, topk)
        valid = sel < own
        k_sel = gather_blocks(kb, sel)
        v_sel = gather_blocks(vb, sel)
        s_sel = jnp.einsum('bhqd,bhqnkd->bhqnk', qc, k_sel).astype(jnp.float32)
        s_sel = jnp.where(valid[..., None], s_sel, NEG_INF)
        s_sel = s_sel.reshape(bsz, N_HEADS_MOBA, MOBA_Q_CHUNK, topk * MOBA_BLOCK)
        k_own = lax.dynamic_index_in_dim(kb, own, axis=2, keepdims=False)
        v_own = lax.dynamic_index_in_dim(vb, own, axis=2, keepdims=False)
        s_own = jnp.einsum('bhqd,bhkd->bhqk', qc, k_own).astype(jnp.float32)
        kpos = own * MOBA_BLOCK + jnp.arange(MOBA_BLOCK)
        s_own = jnp.where(kpos[None, :] <= qpos[:, None], s_own, NEG_INF)
        p = jax.nn.softmax(jnp.concatenate([s_sel, s_own], axis=-1), axis=-1).astype(dtype)
        p_sel = p[..., :topk * MOBA_BLOCK].reshape(bsz, N_HEADS_MOBA, MOBA_Q_CHUNK, topk, MOBA_BLOCK)
        p_own = p[..., topk * MOBA_BLOCK:]
        return (jnp.einsum('bhqnk,bhqnkd->bhqd', p_sel, v_sel) +
                jnp.einsum('bhqk,bhkd->bhqd', p_own, v_own))

    out = lax.map(chunk, jnp.arange(n_chunks))
    out = out.transpose(1, 0, 3, 2, 4).reshape(bsz, seq, D_MOBA)
    return out.astype(dtype)


def hierarchical_moe(h, router_w1, router_b1, router_w2, router_b2, w_gate, w_up, w_down):
    bsz, seq, d = h.shape
    xt = h.reshape(-1, d)
    f32 = jnp.float32
    p_group = jax.nn.softmax(jnp.einsum('nd,dg->ng', xt, router_w1).astype(f32)
                             + router_b1.astype(f32), axis=-1)
    pg, gsel = lax.top_k(p_group, 1)
    logits2 = jnp.einsum('nd,gde->nge', xt, router_w2).astype(f32) + router_b2.astype(f32)
    logits2 = jnp.einsum('nge,ng->ne', logits2, jax.nn.one_hot(gsel[:, 0], N_GROUPS, dtype=f32))
    pe, esel = lax.top_k(jax.nn.softmax(logits2, axis=-1), TOPK_IN_GROUP)
    weights = pg * (pe / jnp.sum(pe, axis=-1, keepdims=True))
    expert_id = gsel * EXPERTS_PER_GROUP + esel
    gates = jnp.einsum('nk,nke->ne', weights,
                       jax.nn.one_hot(expert_id, N_EXPERTS, dtype=f32)).astype(xt.dtype)
    y = jnp.zeros_like(xt)
    for e in range(N_EXPERTS):
        he = jax.nn.silu(xt @ w_gate[e]) * (xt @ w_up[e])
        y = y + gates[:, e:e + 1] * (he @ w_down[e])
    return y.reshape(bsz, seq, d)


def setup_inputs(seed: int = 0) -> dict:
    key = jax.random.key(seed)
    ks = jax.random.split(key, 20)
    f32 = jnp.float32
    x = jax.random.normal(ks[0], (BATCH, SEQ, D_MODEL), f32)
    col_scale = np.ones((D_IN_PROJ,), np.float32)
    col_scale[2 * D_DN:3 * D_DN] = DEEPNORM_BETA
    col_scale[D_IN_PROJ - D_MOBA:] = DEEPNORM_BETA
    w_in = (jax.random.normal(ks[1], (DEPTH, D_MODEL, D_IN_PROJ), f32) * D_MODEL ** -0.5
            * jnp.asarray(col_scale))
    conv_w = jax.random.normal(ks[2], (DEPTH, CONV_K, 3 * D_DN), f32) * CONV_K ** -0.5
    a_log = jnp.log(jax.random.uniform(ks[3], (DEPTH, N_HEADS_DN), f32, minval=1.0, maxval=16.0))
    dt_bias = 1.0 + 0.1 * jax.random.normal(ks[4], (DEPTH, N_HEADS_DN), f32)
    dn_norm_w = 1.0 + 0.02 * jax.random.normal(ks[5], (DEPTH, HEAD_DIM), f32)
    w_out = jax.random.normal(ks[6], (DEPTH, D_MIX, D_MODEL), f32) * D_MIX ** -0.5 * DEEPNORM_BETA
    ln1_g = 1.0 + 0.02 * jax.random.normal(ks[7], (DEPTH, D_MODEL), f32)
    ln1_b = 0.02 * jax.random.normal(ks[8], (DEPTH, D_MODEL), f32)
    router_w1 = jax.random.normal(ks[9], (DEPTH, D_MODEL, N_GROUPS), f32) * D_MODEL ** -0.5
    router_b1 = 0.01 * jax.random.normal(ks[10], (DEPTH, N_GROUPS), f32)
    router_w2 = (jax.random.normal(ks[11], (DEPTH, N_GROUPS, D_MODEL, EXPERTS_PER_GROUP), f32)
                 * D_MODEL ** -0.5)
    router_b2 = 0.01 * jax.random.normal(ks[12], (DEPTH, N_GROUPS, EXPERTS_PER_GROUP), f32)
    expert_w_gate = (jax.random.normal(ks[13], (DEPTH, N_EXPERTS, D_MODEL, D_EXPERT), f32)
                     * D_MODEL ** -0.5)
    expert_w_up = (jax.random.normal(ks[14], (DEPTH, N_EXPERTS, D_MODEL, D_EXPERT), f32)
                   * D_MODEL ** -0.5 * DEEPNORM_BETA)
    expert_w_down = (jax.random.normal(ks[15], (DEPTH, N_EXPERTS, D_EXPERT, D_MODEL), f32)
                     * D_EXPERT ** -0.5 * DEEPNORM_BETA)
    ln2_g = 1.0 + 0.02 * jax.random.normal(ks[16], (DEPTH, D_MODEL), f32)
    ln2_b = 0.02 * jax.random.normal(ks[17], (DEPTH, D_MODEL), f32)
    return {'x': x, 'w_in': w_in, 'conv_w': conv_w, 'a_log': a_log, 'dt_bias': dt_bias,
            'dn_norm_w': dn_norm_w, 'w_out': w_out, 'ln1_g': ln1_g, 'ln1_b': ln1_b,
            'router_w1': router_w1, 'router_b1': router_b1, 'router_w2': router_w2,
            'router_b2': router_b2, 'expert_w_gate': expert_w_gate, 'expert_w_up': expert_w_up,
            'expert_w_down': expert_w_down, 'ln2_g': ln2_g, 'ln2_b': ln2_b}


def reference(x, w_in, conv_w, a_log, dt_bias, dn_norm_w, w_out, ln1_g, ln1_b,
              router_w1, router_b1, router_w2, router_b2, expert_w_gate, expert_w_up,
              expert_w_down, ln2_g, ln2_b):
    for l in range(DEPTH):
        proj = jnp.einsum('btd,dc->btc', x, w_in[l])
        q_dn, k_dn, v_dn, z_dn, b_dn, a_dn, q_mb, k_mb, v_mb = jnp.split(proj, IN_PROJ_SPLITS, axis=-1)
        y_dn = gated_deltanet(q_dn, k_dn, v_dn, z_dn, b_dn, a_dn, conv_w[l], a_log[l],
                              dt_bias[l], dn_norm_w[l])
        y_mb = moba_attention(q_mb, k_mb, v_mb)
        mix = jnp.einsum('btc,cd->btd', jnp.concatenate([y_dn, y_mb], axis=-1), w_out[l])
        h = layer_norm(DEEPNORM_ALPHA * x + mix, ln1_g[l], ln1_b[l])
        ffn = hierarchical_moe(h, router_w1[l], router_b1[l], router_w2[l], router_b2[l],
                               expert_w_gate[l], expert_w_up[l], expert_w_down[l])
        x = layer_norm(DEEPNORM_ALPHA * h + ffn, ln2_g[l], ln2_b[l])
    return x
```

```cpp
#include <hip/hip_runtime.h>
#include <cstdio>
#include <cstdint>
namespace pg8 {
#define PG8_LAS __attribute__((address_space(3)))
typedef unsigned short bf16_t;
typedef short bf16x8 __attribute__((ext_vector_type(8)));
typedef float f32x4 __attribute__((ext_vector_type(4)));
typedef unsigned u32x4 __attribute__((ext_vector_type(4)));
constexpr int BM = 256, BK = 64, HALF = 128, HTB = HALF * BK * 2  , STAGE_BYTES = 8 * HTB, NXCD = 8, WGM = 8;

__host__ __device__ __forceinline__ int lds_byte(int r, int c) { const int st = (r >> 4) * 2 + (c >> 5), rr = r & 15, cc = c & 31, ob = rr * 64 + cc * 2; return st * 1024 + (ob ^ (((ob >> 9) & 1) << 5)); }
__host__ __device__ __forceinline__ void stage_rc(int b, int& R, int& C) { const int st = b / 1024, sb = b % 1024, swz = sb ^ (((sb >> 9) & 1) << 5); R = (st >> 1) * 16 + swz / 64; C = (st & 1) * 32 + (swz % 64) / 2; }
__host__ __device__ __forceinline__ int perm32(int rho) { const int n = rho >> 4, i = rho & 15; return 8 * (i >> 2) + 4 * n + (i & 3); }

struct Unit { int pm, pn; };
struct Gemm { const bf16_t* A; const bf16_t* Bt; int M, N, K; };

struct StaticOrder {
    int nM, nN, nwg, G, c;
    __host__ __device__ void init(int M, int N, int G_, int c_) { nM = M / BM; nN = N / BM; nwg = nM * nN; G = G_; c = c_; }
    __host__ __device__ bool next(int i, Unit& u) const {
        const long L = (long)i * G + c; if (L >= nwg) return false;
        int wgid = (int)L; { const int q = nwg / NXCD, r = nwg % NXCD, xcd = wgid % NXCD, off = wgid / NXCD; wgid = (xcd < r ? xcd * (q + 1) : r * (q + 1) + (xcd - r) * q) + off; }
        const int nig = WGM * nN, gid = wgid / nig, fm = gid * WGM, gsz = (nM - fm) < WGM ? (nM - fm) : WGM;
        u.pm = fm + ((wgid % nig) % gsz); u.pn = (wgid % nig) / gsz; return true;
    }
    __device__ __forceinline__ void a_ready(const Unit&) const {}
    __device__ __forceinline__ void done(const Unit&) const {}
};

__device__ __forceinline__ unsigned cvt_pk_bf16(float lo, float hi) { unsigned r; asm volatile("v_cvt_pk_bf16_f32 %0, %1, %2" : "=v"(r) : "v"(lo), "v"(hi)); return r; }
typedef float f32x2 __attribute__((ext_vector_type(2)));
__device__ __forceinline__ f32x2 gelu_pk(f32x2 v) {
    const f32x2 av = __builtin_elementwise_abs(v), d = av * 0.2316418882f + 1.0f;
    f32x2 t; t.x = __builtin_amdgcn_rcpf(d.x); t.y = __builtin_amdgcn_rcpf(d.y);
    f32x2 q = t * 0.5307027145f + (-0.7265760135f); q = q * t + 0.7107068705f; q = q * t + (-0.142248368f); q = q * t + 0.127414796f; q = q * t;
    const f32x2 s = (v * v) * (-0.72134752044f);
    f32x2 e; e.x = __builtin_amdgcn_exp2f(s.x); e.y = __builtin_amdgcn_exp2f(s.y);
    const f32x2 m = v * (q * e), r = v - m;
    f32x2 o; o.x = v.x < 0.f ? m.x : r.x; o.y = v.y < 0.f ? m.y : r.y; return o;
}

template <int ACT  > struct EpiBf16 {
    static constexpr bool PERM = true, AFTER_DRAIN = false; static_assert(ACT == 0 || ACT == 1, "EpiBf16: ACT is 0 (none) or 1 (gelu_pk)");
    bf16_t* O; int ldc; const float* bias; int split_cols; size_t split_stride; float scale0;
    __device__ __forceinline__ void operator()(const f32x4 (&acc)[2][2][4][2], const Unit& u, int wr, int wc, int fr, int fq) const {
        const int row0 = u.pm * BM + wr * 64 + fr; int colt = u.pn * BM; bf16_t* base = O;
        float sc = 1.f; if (split_cols) { const int t = colt / split_cols; base += (size_t)t * split_stride; colt -= t * split_cols; if (t == 0) sc = scale0; }
        const int col0 = colt + wc * 32 + 8 * fq, bcol0 = u.pn * BM + wc * 32 + 8 * fq;
        f32x4 bv[2][2];
#pragma unroll
        for (int bj = 0; bj < 2; ++bj)
#pragma unroll
            for (int n = 0; n < 2; ++n) bv[bj][n] = bias ? *(const f32x4*)(bias + bcol0 + bj * HALF + 4 * n) : (f32x4){0.f, 0.f, 0.f, 0.f};
#pragma unroll
        for (int ai = 0; ai < 2; ++ai)
#pragma unroll
            for (int m = 0; m < 4; ++m) { bf16_t* rowp = base + (size_t)(row0 + ai * HALF + m * 16) * ldc + col0;
#pragma unroll
                for (int bj = 0; bj < 2; ++bj) { f32x4 v0 = acc[ai][bj][m][0] + bv[bj][0], v1 = acc[ai][bj][m][1] + bv[bj][1];
                    if (ACT == 1) { f32x2 a = gelu_pk((f32x2){v0[0], v0[1]}), b = gelu_pk((f32x2){v0[2], v0[3]}), c = gelu_pk((f32x2){v1[0], v1[1]}), d = gelu_pk((f32x2){v1[2], v1[3]});
                        v0 = (f32x4){a.x, a.y, b.x, b.y}; v1 = (f32x4){c.x, c.y, d.x, d.y}; }
                    v0 = v0 * sc; v1 = v1 * sc; u32x4 w; w.x = cvt_pk_bf16(v0[0], v0[1]); w.y = cvt_pk_bf16(v0[2], v0[3]); w.z = cvt_pk_bf16(v1[0], v1[1]); w.w = cvt_pk_bf16(v1[2], v1[3]);
                    *(u32x4*)(rowp + bj * HALF) = w; } }
    }
};

struct PanelStats {
    unsigned* xbuf;
    unsigned* cnt;
    unsigned* tmo;
    int ntn; float eps;
    unsigned code;
    __device__ __forceinline__ bool run(const f32x4 (&v)[2][2][4][2], const Unit& u, int wr, int wc, int fr, int fq, PG8_LAS unsigned char* lds, int wid, int lane) const {
        typedef float f32x2v __attribute__((ext_vector_type(2)));
        PG8_LAS f32x2v* P = (PG8_LAS f32x2v*)lds;
        PG8_LAS f32x2v* S = (PG8_LAS f32x2v*)(lds + 8192);
        PG8_LAS unsigned* flag = (PG8_LAS unsigned*)(lds + 8192 + 2048);
#pragma unroll
        for (int ai = 0; ai < 2; ++ai)
#pragma unroll
            for (int m = 0; m < 4; ++m) {
                float s = 0.f;
#pragma unroll
                for (int bj = 0; bj < 2; ++bj)
#pragma unroll
                    for (int n = 0; n < 2; ++n) { const f32x4 x = v[ai][bj][m][n]; s += (x[0] + x[1]) + (x[2] + x[3]); }
                s += __shfl_xor(s, 16); s += __shfl_xor(s, 32);
                const float mw = s * (1.0f / 64.0f); float q = 0.f;
#pragma unroll
                for (int bj = 0; bj < 2; ++bj)
#pragma unroll
                    for (int n = 0; n < 2; ++n) { const f32x4 d = v[ai][bj][m][n] - mw; q += (d[0] * d[0] + d[1] * d[1]) + (d[2] * d[2] + d[3] * d[3]); }
                q += __shfl_xor(q, 16); q += __shfl_xor(q, 32);
                if (fq == 0) P[(ai * HALF + wr * 64 + m * 16 + fr) * 4 + wc] = (f32x2v){mw, q};
            }
        asm volatile("s_waitcnt lgkmcnt(0)" ::: "memory"); __builtin_amdgcn_s_barrier(); asm volatile("" ::: "memory");
#if defined(BROKEN_EXCHANGE_NO_WAIT)
#warning BROKEN CONTROL BUILD: the row-statistics exchange does not wait; results are wrong by design
        if (blockIdx.x >= 64) { const long long t0_ = clock64(); while (clock64() - t0_ < 60000) __builtin_amdgcn_s_sleep(8); }
#endif
        const int row = wid * 32 + (lane & 31);
        if (lane < 32) {
            const f32x2v a = P[row * 4 + 0], b = P[row * 4 + 1], c = P[row * 4 + 2], d = P[row * 4 + 3];
            const float mt = (a.x + b.x + c.x + d.x) * 0.25f;
            const float da = a.x - mt, db = b.x - mt, dc = c.x - mt, dd = d.x - mt;
            const float m2 = (a.y + b.y) + (c.y + d.y) + 64.0f * ((da * da + db * db) + (dc * dc + dd * dd));
            unsigned long long* slot = (unsigned long long*)xbuf + ((size_t)(u.pm * BM + row) * 4 + u.pn);
            __hip_atomic_store(slot, ((unsigned long long)__float_as_uint(m2) << 32) | __float_as_uint(mt), __ATOMIC_RELAXED, __HIP_MEMORY_SCOPE_AGENT);
        }
        asm volatile("s_waitcnt vmcnt(0)" ::: "memory");
        if (lane == 0) __hip_atomic_fetch_add(cnt + 64 * u.pm, 1u, __ATOMIC_RELAXED, __HIP_MEMORY_SCOPE_AGENT);
        if (wid == 0) {
            bool dead = false; const unsigned long long t0 = __builtin_amdgcn_s_memrealtime(); const unsigned want = 8u * (unsigned)ntn;
            for (;;) {
#if defined(BROKEN_EXCHANGE_NO_WAIT)
                break;
#endif
                if ((unsigned)__builtin_amdgcn_readfirstlane(__hip_atomic_load(cnt + 64 * u.pm, __ATOMIC_RELAXED, __HIP_MEMORY_SCOPE_AGENT)) >= want) break;
                if (__builtin_amdgcn_s_memrealtime() - t0 > 2000000ull) {
                    if (lane == 0) { unsigned expect = 0u; __hip_atomic_compare_exchange_strong(tmo + 1, &expect, code | (unsigned)(u.pm & 0xff), __ATOMIC_RELAXED, __ATOMIC_RELAXED, __HIP_MEMORY_SCOPE_AGENT);
                                     __hip_atomic_store(tmo, 1u, __ATOMIC_RELAXED, __HIP_MEMORY_SCOPE_AGENT); }
                    dead = true; break; }
                __builtin_amdgcn_s_sleep(2);
            }
            __builtin_amdgcn_fence(__ATOMIC_ACQUIRE, "agent");
            if (lane == 0) flag[0] = dead ? 1u : 0u;
        }
        asm volatile("s_waitcnt vmcnt(0) lgkmcnt(0)" ::: "memory"); __builtin_amdgcn_s_barrier(); asm volatile("" ::: "memory");
        const bool bad = flag[0] != 0u;
        if (lane < 32) {
            const unsigned long long* slot = (const unsigned long long*)xbuf + (size_t)(u.pm * BM + row) * 4; float mt[4], m2[4]; float ms = 0.f;
#pragma unroll
            for (int t = 0; t < 4; ++t) { if (t < ntn) { const unsigned long long w = __hip_atomic_load(slot + t, __ATOMIC_RELAXED, __HIP_MEMORY_SCOPE_AGENT); mt[t] = __uint_as_float((unsigned)w); m2[t] = __uint_as_float((unsigned)(w >> 32)); } else { mt[t] = 0.f; m2[t] = 0.f; } ms += mt[t]; }
            const float mean = ms / (float)ntn; float q = 0.f;
#pragma unroll
            for (int t = 0; t < 4; ++t) if (t < ntn) { const float dm = mt[t] - mean; q += m2[t] + 256.0f * dm * dm; }
            S[row] = (f32x2v){mean, 1.0f / sqrtf(q / (256.0f * (float)ntn) + eps)};
        }
        asm volatile("s_waitcnt lgkmcnt(0)" ::: "memory"); __builtin_amdgcn_s_barrier(); asm volatile("" ::: "memory");
        return bad;
    }
};
struct EpiLnRes {
    static constexpr bool PERM = false, AFTER_DRAIN = true;
    const float* base; float* out; int ldc; const float* bias; PanelStats st; unsigned poison;
    __device__ __forceinline__ void fused(f32x4 (&acc)[2][2][4][2], const Unit& u, int wr, int wc, int fr, int fq, PG8_LAS unsigned char* lds, int wid, int lane) const {
        typedef float f32x2v __attribute__((ext_vector_type(2)));
        const PG8_LAS f32x2v* S = (const PG8_LAS f32x2v*)(lds + 8192);
        const int col0 = u.pn * BM + wc * 32 + 4 * fq;
#pragma unroll
        for (int bj = 0; bj < 2; ++bj)
#pragma unroll
            for (int n = 0; n < 2; ++n) { const f32x4 bv = bias ? *(const f32x4*)(bias + col0 + bj * HALF + n * 16) : (f32x4){0.f, 0.f, 0.f, 0.f};
#pragma unroll
                for (int ai = 0; ai < 2; ++ai)
#pragma unroll
                    for (int m = 0; m < 4; ++m) acc[ai][bj][m][n] += bv; }
        f32x4 pre[4][2][2];
#pragma unroll
        for (int m = 0; m < 4; ++m) { const size_t off = (size_t)(u.pm * BM + wr * 64 + m * 16 + fr) * ldc + col0;
#pragma unroll
            for (int bj = 0; bj < 2; ++bj)
#pragma unroll
                for (int n = 0; n < 2; ++n) pre[m][bj][n] = *(const f32x4*)(base + off + bj * HALF + n * 16); }
        const bool bad = st.run(acc, u, wr, wc, fr, fq, lds, wid, lane) || poison != 0u;
        const float qnan = __builtin_nanf("");
#pragma unroll
        for (int ai = 0; ai < 2; ++ai)
#pragma unroll
            for (int m = 0; m < 4; ++m) { const int r = ai * HALF + wr * 64 + m * 16 + fr; const f32x2v sr = S[r]; const size_t off = (size_t)(u.pm * BM + r) * ldc + col0;
#pragma unroll
                for (int bj = 0; bj < 2; ++bj)
#pragma unroll
                    for (int n = 0; n < 2; ++n) { const f32x4 bs = ai == 0 ? pre[m][bj][n] : *(const f32x4*)(base + off + bj * HALF + n * 16); f32x4 o = bs + (acc[ai][bj][m][n] - sr.x) * sr.y;
                        if (bad) o = (f32x4){qnan, qnan, qnan, qnan}; *(f32x4*)(out + off + bj * HALF + n * 16) = o; }
                if (m & 1) asm volatile("" ::: "memory"); }
    }
};
struct EpiLnResLn {
    static constexpr bool PERM = false, AFTER_DRAIN = true;
    const float* base; float* out; bf16_t* xn; int ldc; const float* bias; PanelStats st1, st2; unsigned poison;
    __device__ __forceinline__ void fused(f32x4 (&acc)[2][2][4][2], const Unit& u, int wr, int wc, int fr, int fq, PG8_LAS unsigned char* lds, int wid, int lane) const {
        typedef float f32x2v __attribute__((ext_vector_type(2))); typedef unsigned u32x2v __attribute__((ext_vector_type(2)));
        const PG8_LAS f32x2v* S = (const PG8_LAS f32x2v*)(lds + 8192);
        const int col0 = u.pn * BM + wc * 32 + 4 * fq;
#pragma unroll
        for (int bj = 0; bj < 2; ++bj)
#pragma unroll
            for (int n = 0; n < 2; ++n) { const f32x4 bv = bias ? *(const f32x4*)(bias + col0 + bj * HALF + n * 16) : (f32x4){0.f, 0.f, 0.f, 0.f};
#pragma unroll
                for (int ai = 0; ai < 2; ++ai)
#pragma unroll
                    for (int m = 0; m < 4; ++m) acc[ai][bj][m][n] += bv; }
        bool bad = st1.run(acc, u, wr, wc, fr, fq, lds, wid, lane) || poison != 0u;
        const float qnan = __builtin_nanf("");
#pragma unroll
        for (int ai = 0; ai < 2; ++ai)
#pragma unroll
            for (int m = 0; m < 4; ++m) { const int r = ai * HALF + wr * 64 + m * 16 + fr; const f32x2v sr = S[r]; const size_t off = (size_t)(u.pm * BM + r) * ldc + col0;
#pragma unroll
                for (int bj = 0; bj < 2; ++bj)
#pragma unroll
                    for (int n = 0; n < 2; ++n) { const f32x4 bs = *(const f32x4*)(base + off + bj * HALF + n * 16); acc[ai][bj][m][n] = bs + (acc[ai][bj][m][n] - sr.x) * sr.y; }
                asm volatile("" : "+v"(acc[ai][0][m][0]), "+v"(acc[ai][0][m][1]), "+v"(acc[ai][1][m][0]), "+v"(acc[ai][1][m][1]));
                if (m & 1) asm volatile("" ::: "memory"); }
        const bool bad1 = bad;
        bad = st2.run(acc, u, wr, wc, fr, fq, lds, wid, lane) || bad;
#pragma unroll
        for (int ai = 0; ai < 2; ++ai)
#pragma unroll
            for (int m = 0; m < 4; ++m) { const int r = ai * HALF + wr * 64 + m * 16 + fr; const f32x2v sr = S[r]; const size_t off = (size_t)(u.pm * BM + r) * ldc + col0;
#pragma unroll
                for (int bj = 0; bj < 2; ++bj)
#pragma unroll
                    for (int n = 0; n < 2; ++n) { const f32x4 x1 = acc[ai][bj][m][n]; *(f32x4*)(out + off + bj * HALF + n * 16) = bad1 ? (f32x4){qnan, qnan, qnan, qnan} : x1;
                        const f32x4 o = (x1 - sr.x) * sr.y; u32x2v w; w.x = cvt_pk_bf16(o[0], o[1]); w.y = cvt_pk_bf16(o[2], o[3]);
                        if (bad) { w.x = 0x7fc07fc0u; w.y = 0x7fc07fc0u; } *(u32x2v*)(xn + off + bj * HALF + n * 16) = w; }
                asm volatile("" ::: "memory"); }
    }
};

template <class Epi, class Sched, bool ALIGN_EPI = false, bool SP2 = false>
__device__ __forceinline__ void gemm_phase(PG8_LAS unsigned char* lds, const Gemm g, const Sched& S, const Epi& E) {
    const int tid = threadIdx.x, wid = __builtin_amdgcn_readfirstlane(tid >> 6), lane = tid & 63, wr = wid >> 2, wc = wid & 3, fr = lane & 15, fq = lane >> 4;
    const int K = g.K, nt = K / BK;
    unsigned voffA[2], voffB[2];
#pragma unroll
    for (int i = 0; i < 2; ++i) { int R, C; stage_rc(tid * 16 + i * 8192, R, C); const int Rb = Epi::PERM ? ((R & ~31) + perm32(R & 31)) : R;
        voffA[i] = (unsigned)(R * K + C) * 2u; voffB[i] = (unsigned)(Rb * K + C) * 2u; }
    const size_t kstep = (size_t)(BK * 2);
    const size_t hstep = (size_t)HALF * K * 2;
    const size_t tstep = 2 * hstep;
    const unsigned ldsw = (unsigned)wid * 1024u;
    const int aoff = lds_byte(wr * 64 + fr, fq * 8), boff = lds_byte(wc * 32 + fr, fq * 8);
#define PG8_SA(b, h) (((b) * 2 + (h)) * HTB)
#define PG8_SB(b, h) ((4 + (b) * 2 + (h)) * HTB)
#define PG8_STAGE(bufoff, gbase, voff) do { _Pragma("unroll") for (int _i = 0; _i < 2; ++_i) \
        __builtin_amdgcn_global_load_lds((const unsigned*)((const char*)(gbase) + (voff)[_i]), (PG8_LAS unsigned*)(lds + (bufoff) + ldsw + _i * 8192), 16, 0, 0); } while (0)
#define PG8_LDA(dst, b, h) do { _Pragma("unroll") for (int m = 0; m < 4; ++m) _Pragma("unroll") for (int k = 0; k < 2; ++k) dst[m][k] = *(const PG8_LAS bf16x8*)(lds + PG8_SA(b, h) + aoff + m * 2048 + k * 1024); } while (0)
#define PG8_LDB(dst, b, h) do { _Pragma("unroll") for (int n = 0; n < 2; ++n) _Pragma("unroll") for (int k = 0; k < 2; ++k) dst[n][k] = *(const PG8_LAS bf16x8*)(lds + PG8_SB(b, h) + boff + n * 2048 + k * 1024); } while (0)
#define PG8_MMA(ai, bj, At, Bt) do { __builtin_amdgcn_s_setprio(1); _Pragma("unroll") for (int m = 0; m < 4; ++m) _Pragma("unroll") for (int n = 0; n < 2; ++n) _Pragma("unroll") for (int k = 0; k < 2; ++k) \
        acc[ai][bj][m][n] = __builtin_amdgcn_mfma_f32_16x16x32_bf16(Bt[n][k], At[m][k], acc[ai][bj][m][n], 0, 0, 0); __builtin_amdgcn_s_setprio(0); } while (0)
#define PG8_WAIT_V(n) asm volatile("s_waitcnt vmcnt(" #n ")" ::: "memory")
#define PG8_WAIT_L(n) asm volatile("s_waitcnt lgkmcnt(" #n ")" ::: "memory")
#define PG8_BAR __builtin_amdgcn_s_barrier()
#define PG8_SCHED __builtin_amdgcn_sched_barrier(0)
    Unit cur, nxt; int ui = 0;
    if (!S.next(0, cur)) return;
    f32x4 acc[2][2][4][2];
#pragma unroll
    for (int a = 0; a < 2; ++a)
#pragma unroll
        for (int b = 0; b < 2; ++b)
#pragma unroll
            for (int m = 0; m < 4; ++m)
#pragma unroll
                for (int n = 0; n < 2; ++n) acc[a][b][m][n] = (f32x4){0.f, 0.f, 0.f, 0.f};
    bf16x8 At[4][2], B0[2][2], B1[2][2];
    const char* cA = (const char*)g.A + (size_t)cur.pm * tstep; const char* cB = (const char*)g.Bt + (size_t)cur.pn * tstep;
    S.a_ready(cur);
    if constexpr (SP2) {
        PG8_STAGE(PG8_SB(0, 0), cB, voffB); PG8_STAGE(PG8_SB(0, 1), cB + hstep, voffB); PG8_STAGE(PG8_SA(0, 0), cA, voffA); PG8_STAGE(PG8_SA(0, 1), cA + hstep, voffA);
        if (wr == 1) PG8_BAR;
        PG8_WAIT_V(2); PG8_BAR;
        PG8_STAGE(PG8_SB(1, 0), cB + kstep, voffB); PG8_STAGE(PG8_SA(1, 0), cA + kstep, voffA); PG8_STAGE(PG8_SB(1, 1), cB + hstep + kstep, voffB);
        PG8_WAIT_V(6); PG8_BAR;
    } else {
        PG8_STAGE(PG8_SB(0, 0), cB, voffB); PG8_STAGE(PG8_SA(0, 0), cA, voffA); PG8_STAGE(PG8_SB(0, 1), cB + hstep, voffB); PG8_STAGE(PG8_SA(0, 1), cA + hstep, voffA);
        if (wr == 1) PG8_BAR;
        PG8_WAIT_V(4); PG8_BAR;
        PG8_STAGE(PG8_SB(1, 0), cB + kstep, voffB); PG8_STAGE(PG8_SA(1, 0), cA + kstep, voffA); PG8_STAGE(PG8_SB(1, 1), cB + hstep + kstep, voffB);
        PG8_WAIT_V(6); PG8_BAR;
    }
    for (;;) {
        const bool has_next = S.next(ui + 1, nxt);
        const char* nA = has_next ? (const char*)g.A + (size_t)nxt.pm * tstep : cA; const char* nB = has_next ? (const char*)g.Bt + (size_t)nxt.pn * tstep : cB;
        for (int t = 0; t < nt; t += 2) {
            const bool last = (t == nt - 2);
            const char* a1 = cA + (size_t)(t + 1) * kstep;
            const char* a2 = last ? nA : cA + (size_t)(t + 2) * kstep; const char* b2 = last ? nB : cB + (size_t)(t + 2) * kstep;
            const char* a3 = a2 + kstep; const char* b3 = b2 + kstep;
            if (last && has_next) S.a_ready(nxt);
            if constexpr (SP2) {
            PG8_LDB(B0, 0, 0); PG8_LDB(B1, 0, 1); PG8_SCHED; PG8_LDA(At, 0, 0); PG8_STAGE(PG8_SA(1, 1), a1 + hstep, voffA);
            PG8_WAIT_V(8); PG8_WAIT_L(0); PG8_BAR; PG8_MMA(0, 0, At, B0); PG8_MMA(0, 1, At, B1); PG8_BAR; PG8_SCHED;
            PG8_LDA(At, 0, 1); PG8_STAGE(PG8_SB(0, 0), b2, voffB); PG8_STAGE(PG8_SB(0, 1), b2 + hstep, voffB); PG8_STAGE(PG8_SA(0, 0), a2, voffA);
            PG8_WAIT_V(8); PG8_WAIT_L(0); PG8_BAR; PG8_MMA(1, 0, At, B0); PG8_MMA(1, 1, At, B1); PG8_BAR; PG8_SCHED;
            PG8_LDB(B0, 1, 0); PG8_LDB(B1, 1, 1); PG8_SCHED; PG8_LDA(At, 1, 0); PG8_STAGE(PG8_SA(0, 1), a2 + hstep, voffA);
            PG8_WAIT_V(8); PG8_WAIT_L(0); PG8_BAR; PG8_MMA(0, 0, At, B0); PG8_MMA(0, 1, At, B1); PG8_BAR; PG8_SCHED;
            PG8_LDA(At, 1, 1); PG8_STAGE(PG8_SB(1, 0), b3, voffB); PG8_STAGE(PG8_SB(1, 1), b3 + hstep, voffB); PG8_STAGE(PG8_SA(1, 0), a3, voffA);
            PG8_WAIT_V(8); PG8_WAIT_L(0); PG8_BAR; PG8_MMA(1, 0, At, B0); PG8_MMA(1, 1, At, B1); PG8_BAR; PG8_SCHED;
            } else {
            PG8_LDB(B0, 0, 0); PG8_SCHED; PG8_LDA(At, 0, 0); PG8_STAGE(PG8_SA(1, 1), a1 + hstep, voffA);
            PG8_WAIT_L(8); PG8_BAR; PG8_WAIT_L(0); PG8_MMA(0, 0, At, B0); PG8_BAR; PG8_SCHED;
            PG8_LDB(B1, 0, 1); PG8_STAGE(PG8_SB(0, 0), b2, voffB);
            PG8_BAR; PG8_WAIT_L(0); PG8_MMA(0, 1, At, B1); PG8_BAR;
            PG8_LDA(At, 0, 1); PG8_STAGE(PG8_SA(0, 0), a2, voffA);
            PG8_BAR; PG8_WAIT_L(0); PG8_MMA(1, 0, At, B0); PG8_BAR; PG8_SCHED;
            PG8_STAGE(PG8_SB(0, 1), b2 + hstep, voffB);
            PG8_WAIT_V(6); PG8_BAR; PG8_MMA(1, 1, At, B1); PG8_BAR;
            PG8_LDB(B0, 1, 0); PG8_SCHED; PG8_LDA(At, 1, 0); PG8_STAGE(PG8_SA(0, 1), a2 + hstep, voffA);
            PG8_WAIT_L(8); PG8_BAR; PG8_WAIT_L(0); PG8_MMA(0, 0, At, B0); PG8_BAR; PG8_SCHED;
            PG8_LDB(B1, 1, 1); PG8_STAGE(PG8_SB(1, 0), b3, voffB);
            PG8_BAR; PG8_WAIT_L(0); PG8_MMA(0, 1, At, B1); PG8_BAR;
            PG8_LDA(At, 1, 1); PG8_STAGE(PG8_SA(1, 0), a3, voffA);
            PG8_BAR; PG8_WAIT_L(0); PG8_MMA(1, 0, At, B0); PG8_BAR; PG8_SCHED;
            PG8_STAGE(PG8_SB(1, 1), b3 + hstep, voffB);
            PG8_WAIT_V(6); PG8_BAR; PG8_MMA(1, 1, At, B1); PG8_BAR;
            }
        }
        if constexpr (ALIGN_EPI) { if (wr == 0) PG8_BAR; }
        if constexpr (!Epi::AFTER_DRAIN) { E(acc, cur, wr, wc, fr, fq); S.done(cur); }
        if (!has_next) break;
#pragma unroll
        for (int a = 0; a < 2; ++a)
#pragma unroll
            for (int b = 0; b < 2; ++b)
#pragma unroll
                for (int m = 0; m < 4; ++m)
#pragma unroll
                    for (int n = 0; n < 2; ++n) acc[a][b][m][n] = (f32x4){0.f, 0.f, 0.f, 0.f};
        cur = nxt; cA = nA; cB = nB; ++ui;
        if constexpr (ALIGN_EPI) { if (wr == 1) PG8_BAR; }
    }
    PG8_WAIT_V(0);
    if constexpr (!ALIGN_EPI) { if (wr == 0) PG8_BAR; }
    PG8_BAR;
    if constexpr (Epi::AFTER_DRAIN) { E.fused(acc, cur, wr, wc, fr, fq, lds, wid, lane); S.done(cur); }
#undef PG8_SA
#undef PG8_SB
#undef PG8_STAGE
#undef PG8_LDA
#undef PG8_LDB
#undef PG8_MMA
#undef PG8_WAIT_V
#undef PG8_WAIT_L
#undef PG8_BAR
#undef PG8_SCHED
}
}

#ifndef PG8_SP2
#define PG8_SP2 true
#endif
#ifndef PG8_ALIGN
#define PG8_ALIGN true
#endif
namespace pg8 {
struct EpiF32 {
    static constexpr bool PERM = false, AFTER_DRAIN = false;
    float* O; int ldc;
    __device__ __forceinline__ void operator()(const f32x4 (&acc)[2][2][4][2], const Unit& u, int wr, int wc, int fr, int fq) const {
        const int row0 = u.pm * BM + wr * 64 + fr, col0 = u.pn * BM + wc * 32 + 4 * fq;
#pragma unroll
        for (int ai = 0; ai < 2; ++ai)
#pragma unroll
            for (int m = 0; m < 4; ++m) { float* rowp = O + (size_t)(row0 + ai * HALF + m * 16) * ldc + col0;
#pragma unroll
                for (int bj = 0; bj < 2; ++bj)
#pragma unroll
                    for (int n = 0; n < 2; ++n) *(f32x4*)(rowp + bj * HALF + n * 16) = acc[ai][bj][m][n]; }
    }
};
}
#define GAS __attribute__((address_space(1)))
#define LAS __attribute__((address_space(3)))
typedef unsigned short bf16;
typedef unsigned v4u __attribute__((ext_vector_type(4)));
typedef float f32x4 __attribute__((ext_vector_type(4)));
typedef short bf16x8 __attribute__((ext_vector_type(8)));
typedef GAS unsigned gu32;
typedef GAS unsigned long long gu64;
#define RLX_AGENT __ATOMIC_RELAXED, __HIP_MEMORY_SCOPE_AGENT
#define LDS_WAIT() asm volatile("s_waitcnt lgkmcnt(0)" ::: "memory")
#define VM_WAIT() asm volatile("s_waitcnt vmcnt(0)" ::: "memory")
__device__ __forceinline__ unsigned long long rt() { return __builtin_amdgcn_s_memrealtime(); }
__device__ __forceinline__ unsigned f2bf(float f) { unsigned u = __builtin_bit_cast(unsigned, f); return (u + 0x7fffu + ((u >> 16) & 1u)) >> 16; }
__device__ __forceinline__ unsigned pk2(float lo, float hi) { return f2bf(lo) | (f2bf(hi) << 16); }

#define XB_TMO      128
#define XB_XCNT(j)  (256  + 64 * (j))
#define XB_XSUB(j)  (1280 + 64 * (j))
#define XB_XGEN(j)  (2304 + 64 * (j))
#define XB_TOP      3328
#define XB_TOPGEN   3392
#define XCD_BAR_WORDS 3456
#define XB_SPIN_CAP (1u << 18)

__device__ __forceinline__ unsigned xb_ld(unsigned* p)              { return __hip_atomic_load(p, __ATOMIC_RELAXED, __HIP_MEMORY_SCOPE_AGENT); }
__device__ __forceinline__ unsigned xb_add(unsigned* p, unsigned v) { return __hip_atomic_fetch_add(p, v, __ATOMIC_RELAXED, __HIP_MEMORY_SCOPE_AGENT); }
__device__ __forceinline__ unsigned xb_xcc_id() { return (unsigned)__builtin_amdgcn_s_getreg((3 << 11) | 20) & 0xFu; }
#define XB_SPIN(cond, bar) do { unsigned _sp = 0; while (cond) { __builtin_amdgcn_s_sleep(1); \
    if ((++_sp & 255u) == 0u) { if (xb_ld(&(bar)[XB_TMO])) break; if (_sp > XB_SPIN_CAP) { atomicAdd(&(bar)[XB_TMO], 1u); break; } } } } while (0)

struct XcdBarrier {
    unsigned* bar; unsigned x;
    volatile LAS unsigned* st;
};

__device__ __forceinline__ XcdBarrier xcd_barrier_post(unsigned* bar, volatile LAS unsigned* st) {
    XcdBarrier b; b.bar = bar; b.x = xb_xcc_id(); b.st = st;
    if (threadIdx.x == 0) (void)xb_add(&bar[XB_XCNT(b.x)], 1u);
    return b;
}
__device__ __forceinline__ void xcd_barrier_complete(unsigned* bar, unsigned x, unsigned& nloc, unsigned& nx) {
    const unsigned G = gridDim.x * gridDim.y * gridDim.z;
    unsigned sum, cnt, mine, sp = 0u;
    for (;;) {
        sum = 0u; cnt = 0u; mine = 0u;
#pragma unroll
        for (unsigned j = 0; j < 16; ++j) { const unsigned c = xb_ld(&bar[XB_XCNT(j)]); sum += c; cnt += (c > 0u) ? 1u : 0u; mine = (j == x) ? c : mine; }
        if (sum == G) break;
        __builtin_amdgcn_s_sleep(1);
        if ((++sp & 255u) == 0u) { if (xb_ld(&bar[XB_TMO])) break; if (sp > XB_SPIN_CAP) { atomicAdd(&bar[XB_TMO], 1u); break; } }
    }
    nloc = mine > 0u ? mine : 1u; nx = cnt > 0u ? cnt : 1u;
}

__device__ __forceinline__ void xcd_barrier(const XcdBarrier& b) {
    asm volatile("s_waitcnt vmcnt(0)" ::: "memory");
    __syncthreads();
    if (threadIdx.x == 0) {
        unsigned* bar = b.bar;
        __builtin_amdgcn_s_waitcnt(0);
        unsigned nloc = b.st[0], nx = b.st[1];
        if (nloc == 0u) { xcd_barrier_complete(bar, b.x, nloc, nx); b.st[0] = nloc; b.st[1] = nx; }
        const unsigned old = xb_add(&bar[XB_XSUB(b.x)], 1u);
        const unsigned gen = old / nloc;
        if (old + 1u == (gen + 1u) * nloc) {
            __builtin_amdgcn_fence(__ATOMIC_RELEASE, "agent");
            asm volatile("s_waitcnt vmcnt(0)" ::: "memory");
            const unsigned og = xb_add(&bar[XB_TOP], 1u);
            const unsigned tg = og / nx;
            if (og + 1u == (tg + 1u) * nx) xb_add(&bar[XB_TOPGEN], 1u);
            else XB_SPIN(xb_ld(&bar[XB_TOPGEN]) == tg, bar);
            __builtin_amdgcn_fence(__ATOMIC_ACQUIRE, "agent");
            xb_add(&bar[XB_XGEN(b.x)], 1u);
            asm volatile("s_waitcnt vmcnt(0)" ::: "memory");
        } else {
            XB_SPIN(xb_ld(&bar[XB_XGEN(b.x)]) == gen, bar);
            __builtin_amdgcn_fence(__ATOMIC_ACQUIRE, "agent");
            asm volatile("s_waitcnt vmcnt(0)" ::: "memory");
        }
    }
    __syncthreads();
}
constexpr int NWAVES = 8, NTHR = NWAVES * 64;
constexpr int BATCH = 4, SEQ = 4096, DM = 1024, M = BATCH * SEQ;
constexpr int HD = 128, NH = 4, DDN = 512, DMB = 512, NPROJ = 3584, DINP = 3592;
constexpr int MBLK = 256, NBLK = SEQ / MBLK;
constexpr int NE = 16, DE = 256;
constexpr float LN_EPS = 1e-5f, RMS_EPS = 1e-6f, ALPHA = 1.189207115002721f, QSCALE = 0.08838834764831845f;

constexpr size_t MiB = 1u << 20;
constexpr size_t WS_CTL = 0, CTL_ZERO_BYTES = 1 * MiB;
constexpr size_t WS_WIN = 2 * MiB;
constexpr size_t WS_WOUT = 10 * MiB;
constexpr size_t WS_WGU = 12 * MiB;
constexpr size_t WS_WD = 28 * MiB;
constexpr size_t WS_ROPE = 36 * MiB;
constexpr size_t WS_KMP = 38 * MiB;
constexpr size_t WS_GATES = 39 * MiB;
constexpr size_t WS_BETA = WS_GATES + 512 * 1024;
constexpr size_t WS_GLOG = WS_BETA + 256 * 1024;
constexpr size_t WS_XB = 48 * MiB;
constexpr size_t WS_DNQN = 48 * MiB, WS_DNKN = 64 * MiB;
constexpr size_t WS_PJ = 80 * MiB;
constexpr size_t PJ_STRIDE = 16 * MiB;
constexpr size_t WS_Y = 192 * MiB;
constexpr size_t WS_DNVN = 224 * MiB;
constexpr size_t WS_END = 256 * MiB;
constexpr int CW_BAR = 4096;

constexpr int RING_OFF = 0, RING_BYTES = 131072;
constexpr int LDSCTL_OFF = RING_BYTES, MISC_OFF = LDSCTL_OFF + 320;
constexpr int LDS_BYTES = 147456;

#define DI __device__ __forceinline__
DI float bf2f(unsigned short v) { return __uint_as_float((unsigned)v << 16); }
DI float bflo(unsigned w) { return __uint_as_float(w << 16); }
DI float bfhi(unsigned w) { return __uint_as_float(w & 0xffff0000u); }
DI float wave_sum(float v) {
#pragma unroll
    for (int o = 1; o < 64; o <<= 1) v += __shfl_xor(v, o);
    return v;
}
DI float wave_max(float v) {
#pragma unroll
    for (int o = 1; o < 64; o <<= 1) v = fmaxf(v, __shfl_xor(v, o));
    return v;
}
DI float silu_f(float v) { return v / (1.f + __expf(-v)); }
DI float softplus_f(float v) { return fmaxf(v, 0.f) + log1pf(__expf(-fabsf(v))); }

struct Args {
    const float* in[18]; float* out; unsigned char* ws; int ph_lo, ph_hi;
};
struct Frame {
    LAS unsigned char* lds;
    int tid, lane, wave, vcu, G;
};

DI void p0_transpose_item(const float* W, int ldw, int src_col0, int K, bf16* WT, int dst_row0, LAS float* scr, int kb, int nb, int lane) {
    const int k0 = 64 * kb, n0 = 32 * nb;
#pragma unroll 8
    for (int i = 0; i < 32; ++i) { const int kk = 2 * i + (lane >> 5); scr[kk * 33 + (lane & 31)] = W[(size_t)(k0 + kk) * ldw + src_col0 + n0 + (lane & 31)]; }
    LDS_WAIT(); asm volatile("" ::: "memory");
    const int c = lane & 7;
#pragma unroll
    for (int j = 0; j < 4; ++j) { const int n = (lane >> 3) + 8 * j; const LAS float* s = scr + (8 * c) * 33 + n;
        v4u o; o.x = pk2(s[0 * 33], s[1 * 33]); o.y = pk2(s[2 * 33], s[3 * 33]); o.z = pk2(s[4 * 33], s[5 * 33]); o.w = pk2(s[6 * 33], s[7 * 33]);
        *(GAS v4u*)(WT + (size_t)(dst_row0 + n0 + n) * K + k0 + 8 * c) = o; }
    LDS_WAIT(); asm volatile("" ::: "memory");
}

DI void p0_prologue(const Frame& F, const Args& A) {
    unsigned char* ws = A.ws;
    const float* x = A.in[0]; const float* w_in = A.in[1]; const float* w_out = A.in[6];
    const int gw = F.vcu * NWAVES + F.wave, NGW = F.G * NWAVES;
    {
        LAS float* wgl = (LAS float*)(F.lds + RING_OFF);
        for (int i = F.tid; i < 1024 * 8; i += NTHR) wgl[i] = w_in[(size_t)(i >> 3) * DINP + 2048 + (i & 7)];
        __syncthreads();
        bf16* XB = (bf16*)(ws + WS_XB); float* GATES = (float*)(ws + WS_GATES);
        for (int m = gw; m < M; m += NGW) {
            const GAS f32x4* xr = (const GAS f32x4*)(x + (size_t)m * DM) + F.lane;
            f32x4 v[4];
#pragma unroll
            for (int j = 0; j < 4; ++j) v[j] = xr[64 * j];
            GAS unsigned long long* o8 = (GAS unsigned long long*)(XB + (size_t)m * DM) + F.lane;
            float g[8];
#pragma unroll
            for (int q = 0; q < 8; ++q) g[q] = 0.f;
#pragma unroll
            for (int j = 0; j < 4; ++j) {
                o8[64 * j] = (unsigned long long)pk2(v[j].x, v[j].y) | ((unsigned long long)pk2(v[j].z, v[j].w) << 32);
#pragma unroll
                for (int e = 0; e < 4; ++e) { const int k = 256 * j + 4 * F.lane + e; const float xv = v[j][e];
                    const f32x4 w0 = *(const LAS f32x4*)(wgl + k * 8), w1 = *(const LAS f32x4*)(wgl + k * 8 + 4);
                    g[0] += xv * w0.x; g[1] += xv * w0.y; g[2] += xv * w0.z; g[3] += xv * w0.w;
                    g[4] += xv * w1.x; g[5] += xv * w1.y; g[6] += xv * w1.z; g[7] += xv * w1.w; }
            }
#pragma unroll
            for (int q = 0; q < 8; ++q) g[q] = wave_sum(g[q]);
            if (F.lane == 0) {
#pragma unroll
                for (int q = 0; q < 8; ++q) GATES[(size_t)m * 8 + q] = g[q];
            }
        }
        __syncthreads();
    }
    {
        LAS float* scr = (LAS float*)(F.lds + RING_OFF + F.wave * 16384);
        bf16* WIN = (bf16*)(ws + WS_WIN); bf16* WOUT = (bf16*)(ws + WS_WOUT);
        constexpr int I_A = 16 * 64, I_B = 16 * 48, I_O = 16 * 32;
        for (int it = gw; it < I_A + I_B + I_O; it += NGW) {
            int r = it;
            if (r < I_A) { p0_transpose_item(w_in, DINP, 0, DM, WIN, 0, scr, r / 64, r % 64, F.lane); continue; } r -= I_A;
            if (r < I_B) { p0_transpose_item(w_in, DINP, 2056, DM, WIN, 2048, scr, r / 48, r % 48, F.lane); continue; } r -= I_B;
            p0_transpose_item(w_out, DM, 0, DM, WOUT, 0, scr, r / 32, r % 32, F.lane);
        }
    }
    {
        float2* ROPE = (float2*)(ws + WS_ROPE);
        for (int i = (F.vcu * NTHR + F.tid); i < SEQ * 64; i += F.G * NTHR) {
            const int pos = i >> 6, j = i & 63;
            const float inv = exp2f(-(float)j * (13.287712379549449f / 64.f));
            const float ang = (float)pos * inv;
            double rev = (double)ang * 0.15915494309189535; rev -= __builtin_rint(rev);
            const float rr = (float)rev;
            ROPE[i] = make_float2(__builtin_amdgcn_cosf(rr), __builtin_amdgcn_sinf(rr));
        }
    }
}

DI void n2a_conv_norm(const Frame& F, const Args& A) {
    unsigned char* ws = A.ws;
    const float* conv_w = A.in[2]; const float* a_log = A.in[3]; const float* dt_bias = A.in[4];
    const bf16* PJ = (const bf16*)(ws + WS_PJ);
    bf16* OUTX[3] = {(bf16*)(ws + WS_DNQN), (bf16*)(ws + WS_DNKN), (bf16*)(ws + WS_DNVN)};
    const float* GATES = (const float*)(ws + WS_GATES); float* BETA = (float*)(ws + WS_BETA); float* GLOG = (float*)(ws + WS_GLOG);
    const int gw = F.vcu * NWAVES + F.wave, NGW = F.G * NWAVES;
    for (int it = gw; it < M * NH; it += NGW) {
        const int m = it >> 2, h = it & 3, t = m & (SEQ - 1), c = 2 * F.lane;
        float val[3][2];
#pragma unroll
        for (int X = 0; X < 3; ++X) {
            float a0 = 0.f, a1 = 0.f;
#pragma unroll
            for (int j = 0; j < 4; ++j) {
                const int tt = t - 3 + j;
                if (tt >= 0) {
                    const unsigned raw = *(const unsigned*)(PJ + X * (PJ_STRIDE / 2) + (size_t)(m - 3 + j) * 512 + h * 128 + c);
                    const float w0 = conv_w[j * 1536 + X * 512 + h * 128 + c], w1 = conv_w[j * 1536 + X * 512 + h * 128 + c + 1];
                    a0 += w0 * bflo(raw); a1 += w1 * bfhi(raw);
                }
            }
            val[X][0] = silu_f(a0); val[X][1] = silu_f(a1);
        }
        const float sq = wave_sum(val[0][0] * val[0][0] + val[0][1] * val[0][1]);
        const float sk = wave_sum(val[1][0] * val[1][0] + val[1][1] * val[1][1]);
        const float rq = rsqrtf(sq + 1e-6f) * QSCALE, rk = rsqrtf(sk + 1e-6f);
        val[0][0] *= rq; val[0][1] *= rq; val[1][0] *= rk; val[1][1] *= rk;
#pragma unroll
        for (int X = 0; X < 3; ++X) *(unsigned*)(OUTX[X] + (size_t)m * 512 + h * 128 + c) = pk2(val[X][0], val[X][1]);
        if (F.lane == 0) {
            const float bb = GATES[(size_t)m * 8 + h], aa = GATES[(size_t)m * 8 + 4 + h];
            BETA[(size_t)m * 4 + h] = 1.f / (1.f + __expf(-bb));
            GLOG[(size_t)m * 4 + h] = -__expf(a_log[h]) * softplus_f(aa + dt_bias[h]);
        }
    }
}

DI void n3a_rope(const Frame& F, const Args& A) {
    unsigned char* ws = A.ws;
    bf16* MBQ = (bf16*)(ws + WS_PJ + 4 * PJ_STRIDE); bf16* MBK = (bf16*)(ws + WS_PJ + 5 * PJ_STRIDE);
    const float2* ROPE = (const float2*)(ws + WS_ROPE); float* KMP = (float*)(ws + WS_KMP);
    const int gw = F.vcu * NWAVES + F.wave, NGW = F.G * NWAVES, d = F.lane;
    for (int it = gw; it < 1024; it += NGW) {
        const int qtr = it & 3, j = (it >> 2) & 15, h = (it >> 6) & 3, b = it >> 8;
        float s1 = 0.f, s2 = 0.f;
        for (int r = 0; r < 64; ++r) {
            const int pos = j * 256 + qtr * 64 + r; const size_t m = (size_t)b * SEQ + pos;
            bf16* p = MBK + m * 512 + h * 128;
            const float k1 = bf2f(p[d]), k2 = bf2f(p[d + 64]); const float2 cs = ROPE[pos * 64 + d];
            const float r1 = k1 * cs.x - k2 * cs.y, r2 = k2 * cs.x + k1 * cs.y;
            p[d] = (bf16)f2bf(r1); p[d + 64] = (bf16)f2bf(r2); s1 += r1; s2 += r2;
        }
        KMP[(size_t)it * 128 + d] = s1; KMP[(size_t)it * 128 + 64 + d] = s2;
    }
    for (int it = gw; it < M * NH; it += NGW) {
        const int m = it >> 2, h = it & 3, pos = m & (SEQ - 1);
        bf16* p = MBQ + (size_t)m * 512 + h * 128;
        const float q1 = bf2f(p[d]), q2 = bf2f(p[d + 64]); const float2 cs = ROPE[pos * 64 + d];
        p[d] = (bf16)f2bf((q1 * cs.x - q2 * cs.y) * QSCALE); p[d + 64] = (bf16)f2bf((q2 * cs.x + q1 * cs.y) * QSCALE);
    }
}

DI void n2b_dn_recurrent(const Frame& F, const Args& A, int item, float* ODN) {
    unsigned char* ws = A.ws;
    const bf16* QN = (const bf16*)(ws + WS_DNQN); const bf16* KN = (const bf16*)(ws + WS_DNKN); const bf16* VN = (const bf16*)(ws + WS_DNVN);
    const float* BETA = (const float*)(ws + WS_BETA); const float* GLOG = (const float*)(ws + WS_GLOG);
    const int b = item >> 2, h = item & 3;
    LAS float* qs = (LAS float*)(F.lds + RING_OFF);
    LAS float* ks = qs + 16 * 128; LAS float* vs = ks + 16 * 128; LAS float* bs = vs + 16 * 128; LAS float* as = bs + 16;
    float S[128];
#pragma unroll
    for (int k = 0; k < 128; ++k) S[k] = 0.f;
    for (int t0 = 0; t0 < SEQ; t0 += 16) {
        __syncthreads();
        for (int idx = F.tid; idx < 16 * 384; idx += NTHR) {
            const int r = idx / 384, c = idx % 384, X = c >> 7, cc = c & 127; const size_t m = (size_t)b * SEQ + t0 + r;
            const bf16* src = X == 0 ? QN : (X == 1 ? KN : VN);
            (X == 0 ? qs : (X == 1 ? ks : vs))[r * 128 + cc] = bf2f(src[m * 512 + h * 128 + cc]);
        }
        if (F.tid < 16) { const size_t m = (size_t)b * SEQ + t0 + F.tid; bs[F.tid] = BETA[m * 4 + h]; as[F.tid] = __expf(GLOG[m * 4 + h]); }
        __syncthreads();
        if (F.tid < 128) {
#pragma unroll 1
            for (int r = 0; r < 16; ++r) {
                const LAS float* kr = ks + r * 128; const LAS float* qr = qs + r * 128;
                float kS = 0.f;
#pragma unroll
                for (int kb = 0; kb < 128; kb += 16) {
#pragma unroll
                    for (int k = 0; k < 16; ++k) kS += kr[kb + k] * S[kb + k];
                    asm volatile("" ::: "memory");
                }
                const float al = as[r], be = bs[r];
                const float vn = be * (vs[r * 128 + F.tid] - al * kS);
                float o = 0.f;
#pragma unroll
                for (int kb = 0; kb < 128; kb += 16) {
#pragma unroll
                    for (int k = 0; k < 16; ++k) { S[kb + k] = al * S[kb + k] + kr[kb + k] * vn; o += qr[kb + k] * S[kb + k]; }
                    asm volatile("" ::: "memory");
                }
                ODN[((size_t)b * SEQ + t0 + r) * 512 + h * 128 + F.tid] = o;
            }
        }
    }
}

DI void n3b_moba_naive(const Frame& F, const Args& A, int w0, int nw) {
    unsigned char* ws = A.ws;
    const bf16* MBQ = (const bf16*)(ws + WS_PJ + 4 * PJ_STRIDE); const bf16* MBK = (const bf16*)(ws + WS_PJ + 5 * PJ_STRIDE); const bf16* MBV = (const bf16*)(ws + WS_PJ + 6 * PJ_STRIDE);
    const float* KMP = (const float*)(ws + WS_KMP); bf16* Y = (bf16*)(ws + WS_Y);
    LAS float* qs = (LAS float*)(F.lds + RING_OFF + 32768) + F.wave * 128;
    const int lane = F.lane;
    for (int it = w0; it < M * NH; it += nw) {
        const int m = it >> 2, h = it & 3, b = m >> 12, t = m & (SEQ - 1), own = t >> 8;
        { const unsigned raw = *(const unsigned*)(MBQ + (size_t)m * 512 + h * 128 + 2 * lane); qs[2 * lane] = bflo(raw); qs[2 * lane + 1] = bfhi(raw); }
        asm volatile("s_waitcnt lgkmcnt(0)" ::: "memory");
        float gate = -3e38f;
        if (lane < own) {
            const float* kp = KMP + (size_t)(((b * 4 + h) * 16 + lane) * 4) * 128; float acc = 0.f;
            for (int dd = 0; dd < 128; ++dd) acc += qs[dd] * ((kp[dd] + kp[128 + dd]) + (kp[256 + dd] + kp[384 + dd]));
            gate = acc * (1.f / 256.f);
        }
        int blist[4] = {-1, -1, -1, own};
#pragma unroll
        for (int r = 0; r < 3; ++r) {
            const float mx = wave_max(gate);
            if (mx > -1e37f) {
                const unsigned long long bal = __ballot(gate == mx); const int idx = __builtin_ctzll(bal);
                blist[r] = idx; if (lane == idx) gate = -3e38f;
            }
        }
        float sc[4][4]; float mloc = -3e38f;
#pragma unroll
        for (int s = 0; s < 4; ++s) {
            const int jb = blist[s];
#pragma unroll
            for (int i = 0; i < 4; ++i) {
                float v = -3e38f;
                if (jb >= 0) {
                    const int key = jb * 256 + i * 64 + lane;
                    if (s < 3 || key <= t) {
                        const bf16* kp = MBK + ((size_t)b * SEQ + key) * 512 + h * 128; float acc = 0.f;
#pragma unroll 4
                        for (int c8 = 0; c8 < 16; ++c8) { const v4u w = *(const v4u*)(kp + c8 * 8); const LAS float* q8 = qs + c8 * 8;
                            acc += q8[0] * bflo(w.x) + q8[1] * bfhi(w.x) + q8[2] * bflo(w.y) + q8[3] * bfhi(w.y) + q8[4] * bflo(w.z) + q8[5] * bfhi(w.z) + q8[6] * bflo(w.w) + q8[7] * bfhi(w.w); }
                        v = acc;
                    }
                }
                sc[s][i] = v; mloc = fmaxf(mloc, v);
            }
        }
        const float mx = wave_max(mloc); float lsum = 0.f;
#pragma unroll
        for (int s = 0; s < 4; ++s)
#pragma unroll
            for (int i = 0; i < 4; ++i) { const float p = sc[s][i] > -1e37f ? __expf(sc[s][i] - mx) : 0.f; sc[s][i] = p; lsum += p; }
        const float l = wave_sum(lsum);
        float o0 = 0.f, o1 = 0.f;
#pragma unroll
        for (int s = 0; s < 4; ++s) {
            const int jb = blist[s];
            if (jb >= 0) {
#pragma unroll
                for (int i = 0; i < 4; ++i) {
                    const bf16* vp = MBV + ((size_t)b * SEQ + jb * 256 + i * 64) * 512 + h * 128 + 2 * lane;
                    for (int src = 0; src < 64; ++src) {
                        const float pv = __shfl(sc[s][i], src);
                        if (pv != 0.f) { const unsigned raw = *(const unsigned*)(vp + (size_t)src * 512); o0 += pv * bflo(raw); o1 += pv * bfhi(raw); }
                    }
                }
            }
        }
        const float il = 1.f / l;
        *(unsigned*)(Y + (size_t)m * 1024 + 512 + h * 128 + 2 * lane) = pk2(o0 * il, o1 * il);
        asm volatile("s_waitcnt lgkmcnt(0)" ::: "memory");
    }
}

DI void n2c_dn_gate(const Frame& F, const Args& A, const float* ODN) {
    unsigned char* ws = A.ws;
    const float* norm_w = A.in[5]; const bf16* DNZ = (const bf16*)(ws + WS_PJ + 3 * PJ_STRIDE); bf16* Y = (bf16*)(ws + WS_Y);
    const int gw = F.vcu * NWAVES + F.wave, NGW = F.G * NWAVES, c = 2 * F.lane;
    for (int it = gw; it < M * NH; it += NGW) {
        const int m = it >> 2, h = it & 3;
        const float2 o = *(const float2*)(ODN + (size_t)m * 512 + h * 128 + c);
        const float ss = wave_sum(o.x * o.x + o.y * o.y) * (1.f / 128.f);
        const float rs = rsqrtf(ss + RMS_EPS);
        const unsigned zr = *(const unsigned*)(DNZ + (size_t)m * 512 + h * 128 + c);
        *(unsigned*)(Y + (size_t)m * 1024 + h * 128 + c) = pk2(o.x * rs * norm_w[c] * silu_f(bflo(zr)), o.y * rs * norm_w[c + 1] * silu_f(bfhi(zr)));
    }
}

DI float block_sum(float v, LAS float* red, int tid) {
    v = wave_sum(v);
    __syncthreads();
    if ((tid & 63) == 0) red[tid >> 6] = v;
    __syncthreads();
    float s = 0.f;
#pragma unroll
    for (int w = 0; w < NWAVES; ++w) s += red[w];
    return s;
}

DI void n5_token_tail(const Frame& F, const Args& A) {
    const float* x = A.in[0]; const float* g1 = A.in[7]; const float* b1 = A.in[8];
    const float* rw1 = A.in[9]; const float* rb1 = A.in[10]; const float* rw2 = A.in[11]; const float* rb2 = A.in[12];
    const float* wg = A.in[13]; const float* wu = A.in[14]; const float* wd = A.in[15]; const float* g2 = A.in[16]; const float* b2 = A.in[17];
    float* out = A.out;
    LAS float* hs = (LAS float*)(F.lds + RING_OFF);
    LAS float* hes = hs + 1024;
    LAS float* lg = hes + 512;
    LAS float* red = lg + 32;
    LAS float* rt_ = red + 8;
    const int tid = F.tid;
    for (int m = blockIdx.x; m < M; m += F.G) {
        __syncthreads();
        const size_t ro = (size_t)m * DM;
        float v0 = ALPHA * x[ro + tid] + out[ro + tid], v1 = ALPHA * x[ro + tid + 512] + out[ro + tid + 512];
        const float mean = block_sum(v0 + v1, red, tid) * (1.f / DM);
        v0 -= mean; v1 -= mean;
        const float var = block_sum(v0 * v0 + v1 * v1, red, tid) * (1.f / DM);
        const float rstd = rsqrtf(var + LN_EPS);
        const float h0 = v0 * rstd * g1[tid] + b1[tid], h1 = v1 * rstd * g1[tid + 512] + b1[tid + 512];
        hs[tid] = h0; hs[tid + 512] = h1;
        __syncthreads();
        for (int li = F.wave; li < 20; li += NWAVES) {
            float acc = 0.f;
            for (int k = F.lane; k < DM; k += 64) {
                const float wv = li < 4 ? rw1[k * 4 + li] : rw2[((size_t)((li - 4) >> 2) * DM + k) * 4 + ((li - 4) & 3)];
                acc += hs[k] * wv;
            }
            acc = wave_sum(acc);
            if (F.lane == 0) lg[li] = acc;
        }
        __syncthreads();
        if (tid == 0) {
            float pgv[4]; float mx = -3e38f;
            for (int g = 0; g < 4; ++g) { pgv[g] = lg[g] + rb1[g]; mx = fmaxf(mx, pgv[g]); }
            float sum = 0.f; for (int g = 0; g < 4; ++g) { pgv[g] = __expf(pgv[g] - mx); sum += pgv[g]; }
            int gs = 0; for (int g = 1; g < 4; ++g) if (pgv[g] > pgv[gs]) gs = g;
            const float pg = pgv[gs] / sum;
            float pe[4]; mx = -3e38f;
            for (int e = 0; e < 4; ++e) { pe[e] = lg[4 + gs * 4 + e] + rb2[gs * 4 + e]; mx = fmaxf(mx, pe[e]); }
            sum = 0.f; for (int e = 0; e < 4; ++e) { pe[e] = __expf(pe[e] - mx); sum += pe[e]; }
            int e0 = 0; for (int e = 1; e < 4; ++e) if (pe[e] > pe[e0]) e0 = e;
            int e1 = (e0 == 0) ? 1 : 0; for (int e = 0; e < 4; ++e) if (e != e0 && pe[e] > pe[e1]) e1 = e;
            const float den = pe[e0] + pe[e1];
            rt_[0] = __int_as_float(gs * 4 + e0); rt_[1] = __int_as_float(gs * 4 + e1); rt_[2] = pg * pe[e0] / den; rt_[3] = pg * pe[e1] / den;
        }
        __syncthreads();
        const int ex[2] = {__float_as_int(rt_[0]), __float_as_int(rt_[1])}; const float wx[2] = {rt_[2], rt_[3]};
        {
            const int half = tid >> 8, j = tid & 255, e = ex[half];
            const float* pg_ = wg + (size_t)e * DM * DE + j; const float* pu_ = wu + (size_t)e * DM * DE + j;
            float ga = 0.f, ua = 0.f;
#pragma unroll 8
            for (int k = 0; k < DM; ++k) { const float hv = hs[k]; ga += hv * pg_[(size_t)k * DE]; ua += hv * pu_[(size_t)k * DE]; }
            hes[half * 256 + j] = silu_f(ga) * ua;
        }
        __syncthreads();
        float y0 = 0.f, y1 = 0.f;
#pragma unroll
        for (int half = 0; half < 2; ++half) {
            const float* pd = wd + (size_t)ex[half] * DE * DM + tid; float a0 = 0.f, a1 = 0.f;
#pragma unroll 8
            for (int j = 0; j < DE; ++j) { const float hv = hes[half * 256 + j]; a0 += hv * pd[(size_t)j * DM]; a1 += hv * pd[(size_t)j * DM + 512]; }
            y0 += wx[half] * a0; y1 += wx[half] * a1;
        }
        float u0 = ALPHA * h0 + y0, u1 = ALPHA * h1 + y1;
        const float mean2 = block_sum(u0 + u1, red, tid) * (1.f / DM);
        u0 -= mean2; u1 -= mean2;
        const float var2 = block_sum(u0 * u0 + u1 * u1, red, tid) * (1.f / DM);
        const float rstd2 = rsqrtf(var2 + LN_EPS);
        out[ro + tid] = u0 * rstd2 * g2[tid] + b2[tid]; out[ro + tid + 512] = u1 * rstd2 * g2[tid + 512] + b2[tid + 512];
    }
}

#ifdef SKIP_N2B
#define n2b_dn_recurrent(...) ((void)0)
#endif
#ifdef SKIP_N3B
#define n3b_moba_naive(...) ((void)0)
#endif
#ifdef SKIP_N5
#define n5_token_tail(...) ((void)0)
#endif
#ifdef SKIP_P0
#define p0_prologue(...) ((void)0)
#endif
#ifdef SKIP_N2A
#define n2a_conv_norm(...) ((void)0)
#endif
#ifdef SKIP_N3A
#define n3a_rope(...) ((void)0)
#endif
#ifdef SKIP_N2C
#define n2c_dn_gate(...) ((void)0)
#endif
constexpr int N_PHASES = 7;
__global__ void __launch_bounds__(NTHR, 2) mk_fwd(Args args) {
    extern __shared__ __attribute__((aligned(16))) unsigned char lds[];
    Frame F;
    F.lds = (LAS unsigned char*)lds;
    F.tid = threadIdx.x; F.lane = F.tid & 63; F.wave = __builtin_amdgcn_readfirstlane(F.tid >> 6);
    F.G = gridDim.x; { const int bx = blockIdx.x; F.vcu = (F.G % 8 == 0) ? (bx % 8) * (F.G / 8) + bx / 8 : bx; }
    unsigned char* ws = args.ws;
    gu32* ctl = (gu32*)(ws + WS_CTL);
    volatile LAS unsigned* MISC = (volatile LAS unsigned*)(F.lds + MISC_OFF);
    for (int u = F.tid; u < (LDS_BYTES - LDSCTL_OFF) / 4; u += NTHR) ((LAS unsigned*)(F.lds + LDSCTL_OFF))[u] = 0u;
    __syncthreads();
    const int lo = args.ph_lo, hi = args.ph_hi;
    const bool multi = (hi - lo) > 1;
    XcdBarrier bar; bar.bar = (unsigned*)(ctl + CW_BAR); bar.x = 0; bar.st = nullptr;
    if (multi) bar = xcd_barrier_post((unsigned*)(ctl + CW_BAR), MISC + 8);
#define IN(k) (lo <= (k) && (k) < hi)
#define SEAM(k) do { if (IN(k) && IN((k) + 1)) xcd_barrier(bar); } while (0)

    if (IN(0)) { p0_prologue(F, args); SEAM(0); }
    if (IN(1)) {
        pg8::Gemm g{(const bf16*)(ws + WS_XB), (const bf16*)(ws + WS_WIN), M, NPROJ, DM}; pg8::StaticOrder S; S.init(M, NPROJ, F.G, (int)blockIdx.x);
        pg8::EpiBf16<0> E{(bf16*)(ws + WS_PJ), 512, nullptr, 512, (size_t)(PJ_STRIDE / 2), 1.f};
        pg8::gemm_phase<pg8::EpiBf16<0>, pg8::StaticOrder, PG8_ALIGN, PG8_SP2>(F.lds + RING_OFF, g, S, E);
        SEAM(1);
    }
    if (IN(2)) { n2a_conv_norm(F, args); n3a_rope(F, args); SEAM(2); }
    if (IN(3)) {
        float* ODN = args.out;
        if (F.G >= 32) {
            if (blockIdx.x < 16) n2b_dn_recurrent(F, args, (int)blockIdx.x, ODN);
            else n3b_moba_naive(F, args, ((int)blockIdx.x - 16) * NWAVES + F.wave, (F.G - 16) * NWAVES);
        } else {
            for (int it = blockIdx.x; it < 16; it += F.G) n2b_dn_recurrent(F, args, it, ODN);
            n3b_moba_naive(F, args, (int)blockIdx.x * NWAVES + F.wave, F.G * NWAVES);
        }
        SEAM(3);
    }
    if (IN(4)) { n2c_dn_gate(F, args, args.out); SEAM(4); }
    if (IN(5)) {
        pg8::Gemm g{(const bf16*)(ws + WS_Y), (const bf16*)(ws + WS_WOUT), M, DM, DM}; pg8::StaticOrder S; S.init(M, DM, F.G, (int)blockIdx.x);
        pg8::EpiF32 E{args.out, DM};
        pg8::gemm_phase<pg8::EpiF32, pg8::StaticOrder, PG8_ALIGN, PG8_SP2>(F.lds + RING_OFF, g, S, E);
        SEAM(5);
    }
    if (IN(6)) { n5_token_tail(F, args); }
#undef IN
#undef SEAM
}

extern "C" void kernel_launch(void* const* d_in, const int* in_sizes, int n_in, void* d_out, int out_size, void* d_ws, size_t ws_size, hipStream_t stream) {
    static int grid = 0;
    if (grid == 0) {
        if (n_in != 18 || in_sizes[0] != M * DM || out_size != M * DM || ws_size < WS_END) { fprintf(stderr, "kernel_launch: unexpected shapes (n_in %d, in0 %d, out %d, ws %zu)\n", n_in, n_in > 0 ? in_sizes[0] : -1, out_size, ws_size); grid = -1; return; }
        int dev = 0, cus = 0;
        if (hipGetDevice(&dev) != hipSuccess || hipDeviceGetAttribute(&cus, hipDeviceAttributeMultiprocessorCount, dev) != hipSuccess) { grid = -1; return; }
        if (hipFuncSetAttribute((const void*)mk_fwd, hipFuncAttributeMaxDynamicSharedMemorySize, LDS_BYTES) != hipSuccess) { fprintf(stderr, "kernel_launch: hipFuncSetAttribute failed\n"); grid = -1; return; }
        int per_cu = 0;
        if (hipOccupancyMaxActiveBlocksPerMultiprocessor(&per_cu, (const void*)mk_fwd, NTHR, LDS_BYTES) != hipSuccess || per_cu < 1) fprintf(stderr, "kernel_launch: occupancy query says %d\n", per_cu);
        (void)hipGetLastError();
        grid = cus;
    }
    if (grid < 0) return;
    (void)hipMemsetAsync((char*)d_ws + WS_CTL, 0, CTL_ZERO_BYTES, stream);
    Args a{};
    for (int i = 0; i < 18; ++i) a.in[i] = (const float*)d_in[i];
    a.out = (float*)d_out; a.ws = (unsigned char*)d_ws;
#ifndef MK_PER_PHASE
    a.ph_lo = 0; a.ph_hi = N_PHASES;
    hipLaunchKernelGGL(mk_fwd, dim3(grid), dim3(NTHR), LDS_BYTES, stream, a);
#else
    for (int p = 0; p < N_PHASES; ++p) { a.ph_lo = p; a.ph_hi = p + 1; hipLaunchKernelGGL(mk_fwd, dim3(grid), dim3(NTHR), LDS_BYTES, stream, a); }
#endif
}
```

```cpp
#define MB_PIPE 1
#include <hip/hip_runtime.h>
#include <cstdio>
#include <cstdint>
#include <cstddef>
namespace pg8 {
#define PG8_LAS __attribute__((address_space(3)))
typedef unsigned short bf16_t;
typedef short bf16x8 __attribute__((ext_vector_type(8)));
typedef float f32x4 __attribute__((ext_vector_type(4)));
typedef unsigned u32x4 __attribute__((ext_vector_type(4)));
constexpr int BM = 256, BK = 64, HALF = 128, HTB = HALF * BK * 2  , STAGE_BYTES = 8 * HTB, NXCD = 8, WGM = 8;

__host__ __device__ __forceinline__ int lds_byte(int r, int c) { const int st = (r >> 4) * 2 + (c >> 5), rr = r & 15, cc = c & 31, ob = rr * 64 + cc * 2; return st * 1024 + (ob ^ (((ob >> 9) & 1) << 5)); }
__host__ __device__ __forceinline__ void stage_rc(int b, int& R, int& C) { const int st = b / 1024, sb = b % 1024, swz = sb ^ (((sb >> 9) & 1) << 5); R = (st >> 1) * 16 + swz / 64; C = (st & 1) * 32 + (swz % 64) / 2; }
__host__ __device__ __forceinline__ int perm32(int rho) { const int n = rho >> 4, i = rho & 15; return 8 * (i >> 2) + 4 * n + (i & 3); }

struct Unit { int pm, pn; };
struct Gemm { const bf16_t* A; const bf16_t* Bt; int M, N, K; };

struct StaticOrder {
    int nM, nN, nwg, G, c;
    __host__ __device__ void init(int M, int N, int G_, int c_) { nM = M / BM; nN = N / BM; nwg = nM * nN; G = G_; c = c_; }
    __host__ __device__ bool next(int i, Unit& u) const {
        const long L = (long)i * G + c; if (L >= nwg) return false;
        int wgid = (int)L; { const int q = nwg / NXCD, r = nwg % NXCD, xcd = wgid % NXCD, off = wgid / NXCD; wgid = (xcd < r ? xcd * (q + 1) : r * (q + 1) + (xcd - r) * q) + off; }
        const int nig = WGM * nN, gid = wgid / nig, fm = gid * WGM, gsz = (nM - fm) < WGM ? (nM - fm) : WGM;
        u.pm = fm + ((wgid % nig) % gsz); u.pn = (wgid % nig) / gsz; return true;
    }
    __device__ __forceinline__ void a_ready(const Unit&) const {}
    __device__ __forceinline__ void done(const Unit&) const {}
    __device__ __forceinline__ size_t bofs(const Unit&) const { return 0; }
};

__device__ __forceinline__ unsigned cvt_pk_bf16(float lo, float hi) { unsigned r; asm volatile("v_cvt_pk_bf16_f32 %0, %1, %2" : "=v"(r) : "v"(lo), "v"(hi)); return r; }
typedef float f32x2 __attribute__((ext_vector_type(2)));
__device__ __forceinline__ f32x2 gelu_pk(f32x2 v) {
    const f32x2 av = __builtin_elementwise_abs(v), d = av * 0.2316418882f + 1.0f;
    f32x2 t; t.x = __builtin_amdgcn_rcpf(d.x); t.y = __builtin_amdgcn_rcpf(d.y);
    f32x2 q = t * 0.5307027145f + (-0.7265760135f); q = q * t + 0.7107068705f; q = q * t + (-0.142248368f); q = q * t + 0.127414796f; q = q * t;
    const f32x2 s = (v * v) * (-0.72134752044f);
    f32x2 e; e.x = __builtin_amdgcn_exp2f(s.x); e.y = __builtin_amdgcn_exp2f(s.y);
    const f32x2 m = v * (q * e), r = v - m;
    f32x2 o; o.x = v.x < 0.f ? m.x : r.x; o.y = v.y < 0.f ? m.y : r.y; return o;
}

template <int ACT  > struct EpiBf16 {
    static constexpr bool PERM = true, AFTER_DRAIN = false; static_assert(ACT == 0 || ACT == 1, "EpiBf16: ACT is 0 (none) or 1 (gelu_pk)");
    bf16_t* O; int ldc; const float* bias; int split_cols; size_t split_stride; float scale0;
    __device__ __forceinline__ void operator()(const f32x4 (&acc)[2][2][4][2], const Unit& u, int wr, int wc, int fr, int fq) const {
        const int row0 = u.pm * BM + wr * 64 + fr; int colt = u.pn * BM; bf16_t* base = O;
        float sc = 1.f; if (split_cols) { const int t = colt / split_cols; base += (size_t)t * split_stride; colt -= t * split_cols; if (t == 0) sc = scale0; }
        const int col0 = colt + wc * 32 + 8 * fq, bcol0 = u.pn * BM + wc * 32 + 8 * fq;
        f32x4 bv[2][2];
#pragma unroll
        for (int bj = 0; bj < 2; ++bj)
#pragma unroll
            for (int n = 0; n < 2; ++n) bv[bj][n] = bias ? *(const f32x4*)(bias + bcol0 + bj * HALF + 4 * n) : (f32x4){0.f, 0.f, 0.f, 0.f};
#pragma unroll
        for (int ai = 0; ai < 2; ++ai)
#pragma unroll
            for (int m = 0; m < 4; ++m) { bf16_t* rowp = base + (size_t)(row0 + ai * HALF + m * 16) * ldc + col0;
#pragma unroll
                for (int bj = 0; bj < 2; ++bj) { f32x4 v0 = acc[ai][bj][m][0] + bv[bj][0], v1 = acc[ai][bj][m][1] + bv[bj][1];
                    if (ACT == 1) { f32x2 a = gelu_pk((f32x2){v0[0], v0[1]}), b = gelu_pk((f32x2){v0[2], v0[3]}), c = gelu_pk((f32x2){v1[0], v1[1]}), d = gelu_pk((f32x2){v1[2], v1[3]});
                        v0 = (f32x4){a.x, a.y, b.x, b.y}; v1 = (f32x4){c.x, c.y, d.x, d.y}; }
                    v0 = v0 * sc; v1 = v1 * sc; u32x4 w; w.x = cvt_pk_bf16(v0[0], v0[1]); w.y = cvt_pk_bf16(v0[2], v0[3]); w.z = cvt_pk_bf16(v1[0], v1[1]); w.w = cvt_pk_bf16(v1[2], v1[3]);
                    *(u32x4*)(rowp + bj * HALF) = w; } }
    }
};

struct PanelStats {
    unsigned* xbuf;
    unsigned* cnt;
    unsigned* tmo;
    int ntn; float eps;
    unsigned code;
    __device__ __forceinline__ bool run(const f32x4 (&v)[2][2][4][2], const Unit& u, int wr, int wc, int fr, int fq, PG8_LAS unsigned char* lds, int wid, int lane) const {
        typedef float f32x2v __attribute__((ext_vector_type(2)));
        PG8_LAS f32x2v* P = (PG8_LAS f32x2v*)lds;
        PG8_LAS f32x2v* S = (PG8_LAS f32x2v*)(lds + 8192);
        PG8_LAS unsigned* flag = (PG8_LAS unsigned*)(lds + 8192 + 2048);
#pragma unroll
        for (int ai = 0; ai < 2; ++ai)
#pragma unroll
            for (int m = 0; m < 4; ++m) {
                float s = 0.f;
#pragma unroll
                for (int bj = 0; bj < 2; ++bj)
#pragma unroll
                    for (int n = 0; n < 2; ++n) { const f32x4 x = v[ai][bj][m][n]; s += (x[0] + x[1]) + (x[2] + x[3]); }
                s += __shfl_xor(s, 16); s += __shfl_xor(s, 32);
                const float mw = s * (1.0f / 64.0f); float q = 0.f;
#pragma unroll
                for (int bj = 0; bj < 2; ++bj)
#pragma unroll
                    for (int n = 0; n < 2; ++n) { const f32x4 d = v[ai][bj][m][n] - mw; q += (d[0] * d[0] + d[1] * d[1]) + (d[2] * d[2] + d[3] * d[3]); }
                q += __shfl_xor(q, 16); q += __shfl_xor(q, 32);
                if (fq == 0) P[(ai * HALF + wr * 64 + m * 16 + fr) * 4 + wc] = (f32x2v){mw, q};
            }
        asm volatile("s_waitcnt lgkmcnt(0)" ::: "memory"); __builtin_amdgcn_s_barrier(); asm volatile("" ::: "memory");
#if defined(BROKEN_EXCHANGE_NO_WAIT)
#warning BROKEN CONTROL BUILD: the row-statistics exchange does not wait; results are wrong by design
        if (blockIdx.x >= 64) { const long long t0_ = clock64(); while (clock64() - t0_ < 60000) __builtin_amdgcn_s_sleep(8); }
#endif
        const int row = wid * 32 + (lane & 31);
        if (lane < 32) {
            const f32x2v a = P[row * 4 + 0], b = P[row * 4 + 1], c = P[row * 4 + 2], d = P[row * 4 + 3];
            const float mt = (a.x + b.x + c.x + d.x) * 0.25f;
            const float da = a.x - mt, db = b.x - mt, dc = c.x - mt, dd = d.x - mt;
            const float m2 = (a.y + b.y) + (c.y + d.y) + 64.0f * ((da * da + db * db) + (dc * dc + dd * dd));
            unsigned long long* slot = (unsigned long long*)xbuf + ((size_t)(u.pm * BM + row) * 4 + u.pn);
            __hip_atomic_store(slot, ((unsigned long long)__float_as_uint(m2) << 32) | __float_as_uint(mt), __ATOMIC_RELAXED, __HIP_MEMORY_SCOPE_AGENT);
        }
        asm volatile("s_waitcnt vmcnt(0)" ::: "memory");
        if (lane == 0) __hip_atomic_fetch_add(cnt + 64 * u.pm, 1u, __ATOMIC_RELAXED, __HIP_MEMORY_SCOPE_AGENT);
        if (wid == 0) {
            bool dead = false; const unsigned long long t0 = __builtin_amdgcn_s_memrealtime(); const unsigned want = 8u * (unsigned)ntn;
            for (;;) {
#if defined(BROKEN_EXCHANGE_NO_WAIT)
                break;
#endif
                if ((unsigned)__builtin_amdgcn_readfirstlane(__hip_atomic_load(cnt + 64 * u.pm, __ATOMIC_RELAXED, __HIP_MEMORY_SCOPE_AGENT)) >= want) break;
                if (__builtin_amdgcn_s_memrealtime() - t0 > 2000000ull) {
                    if (lane == 0) { unsigned expect = 0u; __hip_atomic_compare_exchange_strong(tmo + 1, &expect, code | (unsigned)(u.pm & 0xff), __ATOMIC_RELAXED, __ATOMIC_RELAXED, __HIP_MEMORY_SCOPE_AGENT);
                                     __hip_atomic_store(tmo, 1u, __ATOMIC_RELAXED, __HIP_MEMORY_SCOPE_AGENT); }
                    dead = true; break; }
                __builtin_amdgcn_s_sleep(2);
            }
            __builtin_amdgcn_fence(__ATOMIC_ACQUIRE, "agent");
            if (lane == 0) flag[0] = dead ? 1u : 0u;
        }
        asm volatile("s_waitcnt vmcnt(0) lgkmcnt(0)" ::: "memory"); __builtin_amdgcn_s_barrier(); asm volatile("" ::: "memory");
        const bool bad = flag[0] != 0u;
        if (lane < 32) {
            const unsigned long long* slot = (const unsigned long long*)xbuf + (size_t)(u.pm * BM + row) * 4; float mt[4], m2[4]; float ms = 0.f;
#pragma unroll
            for (int t = 0; t < 4; ++t) { if (t < ntn) { const unsigned long long w = __hip_atomic_load(slot + t, __ATOMIC_RELAXED, __HIP_MEMORY_SCOPE_AGENT); mt[t] = __uint_as_float((unsigned)w); m2[t] = __uint_as_float((unsigned)(w >> 32)); } else { mt[t] = 0.f; m2[t] = 0.f; } ms += mt[t]; }
            const float mean = ms / (float)ntn; float q = 0.f;
#pragma unroll
            for (int t = 0; t < 4; ++t) if (t < ntn) { const float dm = mt[t] - mean; q += m2[t] + 256.0f * dm * dm; }
            S[row] = (f32x2v){mean, 1.0f / sqrtf(q / (256.0f * (float)ntn) + eps)};
        }
        asm volatile("s_waitcnt lgkmcnt(0)" ::: "memory"); __builtin_amdgcn_s_barrier(); asm volatile("" ::: "memory");
        return bad;
    }
};
struct EpiLnRes {
    static constexpr bool PERM = false, AFTER_DRAIN = true;
    const float* base; float* out; int ldc; const float* bias; PanelStats st; unsigned poison;
    __device__ __forceinline__ void fused(f32x4 (&acc)[2][2][4][2], const Unit& u, int wr, int wc, int fr, int fq, PG8_LAS unsigned char* lds, int wid, int lane) const {
        typedef float f32x2v __attribute__((ext_vector_type(2)));
        const PG8_LAS f32x2v* S = (const PG8_LAS f32x2v*)(lds + 8192);
        const int col0 = u.pn * BM + wc * 32 + 4 * fq;
#pragma unroll
        for (int bj = 0; bj < 2; ++bj)
#pragma unroll
            for (int n = 0; n < 2; ++n) { const f32x4 bv = bias ? *(const f32x4*)(bias + col0 + bj * HALF + n * 16) : (f32x4){0.f, 0.f, 0.f, 0.f};
#pragma unroll
                for (int ai = 0; ai < 2; ++ai)
#pragma unroll
                    for (int m = 0; m < 4; ++m) acc[ai][bj][m][n] += bv; }
        f32x4 pre[4][2][2];
#pragma unroll
        for (int m = 0; m < 4; ++m) { const size_t off = (size_t)(u.pm * BM + wr * 64 + m * 16 + fr) * ldc + col0;
#pragma unroll
            for (int bj = 0; bj < 2; ++bj)
#pragma unroll
                for (int n = 0; n < 2; ++n) pre[m][bj][n] = *(const f32x4*)(base + off + bj * HALF + n * 16); }
        const bool bad = st.run(acc, u, wr, wc, fr, fq, lds, wid, lane) || poison != 0u;
        const float qnan = __builtin_nanf("");
#pragma unroll
        for (int ai = 0; ai < 2; ++ai)
#pragma unroll
            for (int m = 0; m < 4; ++m) { const int r = ai * HALF + wr * 64 + m * 16 + fr; const f32x2v sr = S[r]; const size_t off = (size_t)(u.pm * BM + r) * ldc + col0;
#pragma unroll
                for (int bj = 0; bj < 2; ++bj)
#pragma unroll
                    for (int n = 0; n < 2; ++n) { const f32x4 bs = ai == 0 ? pre[m][bj][n] : *(const f32x4*)(base + off + bj * HALF + n * 16); f32x4 o = bs + (acc[ai][bj][m][n] - sr.x) * sr.y;
                        if (bad) o = (f32x4){qnan, qnan, qnan, qnan}; *(f32x4*)(out + off + bj * HALF + n * 16) = o; }
                if (m & 1) asm volatile("" ::: "memory"); }
    }
};
struct EpiLnResLn {
    static constexpr bool PERM = false, AFTER_DRAIN = true;
    const float* base; float* out; bf16_t* xn; int ldc; const float* bias; PanelStats st1, st2; unsigned poison;
    __device__ __forceinline__ void fused(f32x4 (&acc)[2][2][4][2], const Unit& u, int wr, int wc, int fr, int fq, PG8_LAS unsigned char* lds, int wid, int lane) const {
        typedef float f32x2v __attribute__((ext_vector_type(2))); typedef unsigned u32x2v __attribute__((ext_vector_type(2)));
        const PG8_LAS f32x2v* S = (const PG8_LAS f32x2v*)(lds + 8192);
        const int col0 = u.pn * BM + wc * 32 + 4 * fq;
#pragma unroll
        for (int bj = 0; bj < 2; ++bj)
#pragma unroll
            for (int n = 0; n < 2; ++n) { const f32x4 bv = bias ? *(const f32x4*)(bias + col0 + bj * HALF + n * 16) : (f32x4){0.f, 0.f, 0.f, 0.f};
#pragma unroll
                for (int ai = 0; ai < 2; ++ai)
#pragma unroll
                    for (int m = 0; m < 4; ++m) acc[ai][bj][m][n] += bv; }
        bool bad = st1.run(acc, u, wr, wc, fr, fq, lds, wid, lane) || poison != 0u;
        const float qnan = __builtin_nanf("");
#pragma unroll
        for (int ai = 0; ai < 2; ++ai)
#pragma unroll
            for (int m = 0; m < 4; ++m) { const int r = ai * HALF + wr * 64 + m * 16 + fr; const f32x2v sr = S[r]; const size_t off = (size_t)(u.pm * BM + r) * ldc + col0;
#pragma unroll
                for (int bj = 0; bj < 2; ++bj)
#pragma unroll
                    for (int n = 0; n < 2; ++n) { const f32x4 bs = *(const f32x4*)(base + off + bj * HALF + n * 16); acc[ai][bj][m][n] = bs + (acc[ai][bj][m][n] - sr.x) * sr.y; }
                asm volatile("" : "+v"(acc[ai][0][m][0]), "+v"(acc[ai][0][m][1]), "+v"(acc[ai][1][m][0]), "+v"(acc[ai][1][m][1]));
                if (m & 1) asm volatile("" ::: "memory"); }
        const bool bad1 = bad;
        bad = st2.run(acc, u, wr, wc, fr, fq, lds, wid, lane) || bad;
#pragma unroll
        for (int ai = 0; ai < 2; ++ai)
#pragma unroll
            for (int m = 0; m < 4; ++m) { const int r = ai * HALF + wr * 64 + m * 16 + fr; const f32x2v sr = S[r]; const size_t off = (size_t)(u.pm * BM + r) * ldc + col0;
#pragma unroll
                for (int bj = 0; bj < 2; ++bj)
#pragma unroll
                    for (int n = 0; n < 2; ++n) { const f32x4 x1 = acc[ai][bj][m][n]; *(f32x4*)(out + off + bj * HALF + n * 16) = bad1 ? (f32x4){qnan, qnan, qnan, qnan} : x1;
                        const f32x4 o = (x1 - sr.x) * sr.y; u32x2v w; w.x = cvt_pk_bf16(o[0], o[1]); w.y = cvt_pk_bf16(o[2], o[3]);
                        if (bad) { w.x = 0x7fc07fc0u; w.y = 0x7fc07fc0u; } *(u32x2v*)(xn + off + bj * HALF + n * 16) = w; }
                asm volatile("" ::: "memory"); }
    }
};

template <class Epi, class Sched, bool ALIGN_EPI = false, bool SP2 = false>
__device__ __forceinline__ void gemm_phase(PG8_LAS unsigned char* lds, const Gemm g, const Sched& S, const Epi& E) {
    const int tid = threadIdx.x, wid = __builtin_amdgcn_readfirstlane(tid >> 6), lane = tid & 63, wr = wid >> 2, wc = wid & 3, fr = lane & 15, fq = lane >> 4;
    const int K = g.K, nt = K / BK;
    unsigned voffA[2], voffB[2];
#pragma unroll
    for (int i = 0; i < 2; ++i) { int R, C; stage_rc(tid * 16 + i * 8192, R, C); const int Rb = Epi::PERM ? ((R & ~31) + perm32(R & 31)) : R;
        voffA[i] = (unsigned)(R * K + C) * 2u; voffB[i] = (unsigned)(Rb * K + C) * 2u; }
    const size_t kstep = (size_t)(BK * 2);
    const size_t hstep = (size_t)HALF * K * 2;
    const size_t tstep = 2 * hstep;
    const unsigned ldsw = (unsigned)wid * 1024u;
    const int aoff = lds_byte(wr * 64 + fr, fq * 8), boff = lds_byte(wc * 32 + fr, fq * 8);
#define PG8_SA(b, h) (((b) * 2 + (h)) * HTB)
#define PG8_SB(b, h) ((4 + (b) * 2 + (h)) * HTB)
#define PG8_STAGE(bufoff, gbase, voff) do { _Pragma("unroll") for (int _i = 0; _i < 2; ++_i) \
        __builtin_amdgcn_global_load_lds((const unsigned*)((const char*)(gbase) + (voff)[_i]), (PG8_LAS unsigned*)(lds + (bufoff) + ldsw + _i * 8192), 16, 0, 0); } while (0)
#define PG8_LDA(dst, b, h) do { _Pragma("unroll") for (int m = 0; m < 4; ++m) _Pragma("unroll") for (int k = 0; k < 2; ++k) dst[m][k] = *(const PG8_LAS bf16x8*)(lds + PG8_SA(b, h) + aoff + m * 2048 + k * 1024); } while (0)
#define PG8_LDB(dst, b, h) do { _Pragma("unroll") for (int n = 0; n < 2; ++n) _Pragma("unroll") for (int k = 0; k < 2; ++k) dst[n][k] = *(const PG8_LAS bf16x8*)(lds + PG8_SB(b, h) + boff + n * 2048 + k * 1024); } while (0)
#define PG8_MMA(ai, bj, At, Bt) do { __builtin_amdgcn_s_setprio(1); _Pragma("unroll") for (int m = 0; m < 4; ++m) _Pragma("unroll") for (int n = 0; n < 2; ++n) _Pragma("unroll") for (int k = 0; k < 2; ++k) \
        acc[ai][bj][m][n] = __builtin_amdgcn_mfma_f32_16x16x32_bf16(Bt[n][k], At[m][k], acc[ai][bj][m][n], 0, 0, 0); __builtin_amdgcn_s_setprio(0); } while (0)
#define PG8_WAIT_V(n) asm volatile("s_waitcnt vmcnt(" #n ")" ::: "memory")
#define PG8_WAIT_L(n) asm volatile("s_waitcnt lgkmcnt(" #n ")" ::: "memory")
#define PG8_BAR __builtin_amdgcn_s_barrier()
#define PG8_SCHED __builtin_amdgcn_sched_barrier(0)
    Unit cur, nxt; int ui = 0;
    if (!S.next(0, cur)) return;
    f32x4 acc[2][2][4][2];
#pragma unroll
    for (int a = 0; a < 2; ++a)
#pragma unroll
        for (int b = 0; b < 2; ++b)
#pragma unroll
            for (int m = 0; m < 4; ++m)
#pragma unroll
                for (int n = 0; n < 2; ++n) acc[a][b][m][n] = (f32x4){0.f, 0.f, 0.f, 0.f};
    bf16x8 At[4][2], B0[2][2], B1[2][2];
    const char* cA = (const char*)g.A + (size_t)cur.pm * tstep; const char* cB = (const char*)g.Bt + S.bofs(cur) + (size_t)cur.pn * tstep;
    S.a_ready(cur);
    if constexpr (SP2) {
        PG8_STAGE(PG8_SB(0, 0), cB, voffB); PG8_STAGE(PG8_SB(0, 1), cB + hstep, voffB); PG8_STAGE(PG8_SA(0, 0), cA, voffA); PG8_STAGE(PG8_SA(0, 1), cA + hstep, voffA);
        if (wr == 1) PG8_BAR;
        PG8_WAIT_V(2); PG8_BAR;
        PG8_STAGE(PG8_SB(1, 0), cB + kstep, voffB); PG8_STAGE(PG8_SA(1, 0), cA + kstep, voffA); PG8_STAGE(PG8_SB(1, 1), cB + hstep + kstep, voffB);
        PG8_WAIT_V(6); PG8_BAR;
    } else {
        PG8_STAGE(PG8_SB(0, 0), cB, voffB); PG8_STAGE(PG8_SA(0, 0), cA, voffA); PG8_STAGE(PG8_SB(0, 1), cB + hstep, voffB); PG8_STAGE(PG8_SA(0, 1), cA + hstep, voffA);
        if (wr == 1) PG8_BAR;
        PG8_WAIT_V(4); PG8_BAR;
        PG8_STAGE(PG8_SB(1, 0), cB + kstep, voffB); PG8_STAGE(PG8_SA(1, 0), cA + kstep, voffA); PG8_STAGE(PG8_SB(1, 1), cB + hstep + kstep, voffB);
        PG8_WAIT_V(6); PG8_BAR;
    }
    for (;;) {
        const bool has_next = S.next(ui + 1, nxt);
        const char* nA = has_next ? (const char*)g.A + (size_t)nxt.pm * tstep : cA; const char* nB = has_next ? (const char*)g.Bt + S.bofs(nxt) + (size_t)nxt.pn * tstep : cB;
        for (int t = 0; t < nt; t += 2) {
            const bool last = (t == nt - 2);
            const char* a1 = cA + (size_t)(t + 1) * kstep;
            const char* a2 = last ? nA : cA + (size_t)(t + 2) * kstep; const char* b2 = last ? nB : cB + (size_t)(t + 2) * kstep;
            const char* a3 = a2 + kstep; const char* b3 = b2 + kstep;
            if (last && has_next) S.a_ready(nxt);
            if constexpr (SP2) {
            PG8_LDB(B0, 0, 0); PG8_LDB(B1, 0, 1); PG8_SCHED; PG8_LDA(At, 0, 0); PG8_STAGE(PG8_SA(1, 1), a1 + hstep, voffA);
            PG8_WAIT_V(8); PG8_WAIT_L(0); PG8_BAR; PG8_MMA(0, 0, At, B0); PG8_MMA(0, 1, At, B1); PG8_BAR; PG8_SCHED;
            PG8_LDA(At, 0, 1); PG8_STAGE(PG8_SB(0, 0), b2, voffB); PG8_STAGE(PG8_SB(0, 1), b2 + hstep, voffB); PG8_STAGE(PG8_SA(0, 0), a2, voffA);
            PG8_WAIT_V(8); PG8_WAIT_L(0); PG8_BAR; PG8_MMA(1, 0, At, B0); PG8_MMA(1, 1, At, B1); PG8_BAR; PG8_SCHED;
            PG8_LDB(B0, 1, 0); PG8_LDB(B1, 1, 1); PG8_SCHED; PG8_LDA(At, 1, 0); PG8_STAGE(PG8_SA(0, 1), a2 + hstep, voffA);
            PG8_WAIT_V(8); PG8_WAIT_L(0); PG8_BAR; PG8_MMA(0, 0, At, B0); PG8_MMA(0, 1, At, B1); PG8_BAR; PG8_SCHED;
            PG8_LDA(At, 1, 1); PG8_STAGE(PG8_SB(1, 0), b3, voffB); PG8_STAGE(PG8_SB(1, 1), b3 + hstep, voffB); PG8_STAGE(PG8_SA(1, 0), a3, voffA);
            PG8_WAIT_V(8); PG8_WAIT_L(0); PG8_BAR; PG8_MMA(1, 0, At, B0); PG8_MMA(1, 1, At, B1); PG8_BAR; PG8_SCHED;
            } else {
            PG8_LDB(B0, 0, 0); PG8_SCHED; PG8_LDA(At, 0, 0); PG8_STAGE(PG8_SA(1, 1), a1 + hstep, voffA);
            PG8_WAIT_L(8); PG8_BAR; PG8_WAIT_L(0); PG8_MMA(0, 0, At, B0); PG8_BAR; PG8_SCHED;
            PG8_LDB(B1, 0, 1); PG8_STAGE(PG8_SB(0, 0), b2, voffB);
            PG8_BAR; PG8_WAIT_L(0); PG8_MMA(0, 1, At, B1); PG8_BAR;
            PG8_LDA(At, 0, 1); PG8_STAGE(PG8_SA(0, 0), a2, voffA);
            PG8_BAR; PG8_WAIT_L(0); PG8_MMA(1, 0, At, B0); PG8_BAR; PG8_SCHED;
            PG8_STAGE(PG8_SB(0, 1), b2 + hstep, voffB);
            PG8_WAIT_V(6); PG8_BAR; PG8_MMA(1, 1, At, B1); PG8_BAR;
            PG8_LDB(B0, 1, 0); PG8_SCHED; PG8_LDA(At, 1, 0); PG8_STAGE(PG8_SA(0, 1), a2 + hstep, voffA);
            PG8_WAIT_L(8); PG8_BAR; PG8_WAIT_L(0); PG8_MMA(0, 0, At, B0); PG8_BAR; PG8_SCHED;
            PG8_LDB(B1, 1, 1); PG8_STAGE(PG8_SB(1, 0), b3, voffB);
            PG8_BAR; PG8_WAIT_L(0); PG8_MMA(0, 1, At, B1); PG8_BAR;
            PG8_LDA(At, 1, 1); PG8_STAGE(PG8_SA(1, 0), a3, voffA);
            PG8_BAR; PG8_WAIT_L(0); PG8_MMA(1, 0, At, B0); PG8_BAR; PG8_SCHED;
            PG8_STAGE(PG8_SB(1, 1), b3 + hstep, voffB);
            PG8_WAIT_V(6); PG8_BAR; PG8_MMA(1, 1, At, B1); PG8_BAR;
            }
        }
        if constexpr (ALIGN_EPI) { if (wr == 0) PG8_BAR; }
        if constexpr (!Epi::AFTER_DRAIN) { E(acc, cur, wr, wc, fr, fq); S.done(cur); }
        if (!has_next) break;
#pragma unroll
        for (int a = 0; a < 2; ++a)
#pragma unroll
            for (int b = 0; b < 2; ++b)
#pragma unroll
                for (int m = 0; m < 4; ++m)
#pragma unroll
                    for (int n = 0; n < 2; ++n) acc[a][b][m][n] = (f32x4){0.f, 0.f, 0.f, 0.f};
        cur = nxt; cA = nA; cB = nB; ++ui;
        if constexpr (ALIGN_EPI) { if (wr == 1) PG8_BAR; }
    }
    PG8_WAIT_V(0);
    if constexpr (!ALIGN_EPI) { if (wr == 0) PG8_BAR; }
    PG8_BAR;
    if constexpr (Epi::AFTER_DRAIN) { E.fused(acc, cur, wr, wc, fr, fq, lds, wid, lane); S.done(cur); }
#undef PG8_SA
#undef PG8_SB
#undef PG8_STAGE
#undef PG8_LDA
#undef PG8_LDB
#undef PG8_MMA
#undef PG8_WAIT_V
#undef PG8_WAIT_L
#undef PG8_BAR
#undef PG8_SCHED
}
}

#ifndef PG8_SP2
#define PG8_SP2 true
#endif
#ifndef PG8_ALIGN
#define PG8_ALIGN true
#endif
namespace pg8 {
struct EpiF32 {
    static constexpr bool PERM = false, AFTER_DRAIN = false;
    float* O; int ldc;
    __device__ __forceinline__ void operator()(const f32x4 (&acc)[2][2][4][2], const Unit& u, int wr, int wc, int fr, int fq) const {
        const int row0 = u.pm * BM + wr * 64 + fr, col0 = u.pn * BM + wc * 32 + 4 * fq;
#pragma unroll
        for (int ai = 0; ai < 2; ++ai)
#pragma unroll
            for (int m = 0; m < 4; ++m) { float* rowp = O + (size_t)(row0 + ai * HALF + m * 16) * ldc + col0;
#pragma unroll
                for (int bj = 0; bj < 2; ++bj)
#pragma unroll
                    for (int n = 0; n < 2; ++n) *(f32x4*)(rowp + bj * HALF + n * 16) = acc[ai][bj][m][n]; }
    }
};
struct MoeOrder {
    const PG8_LAS int* tb; int ncol, G, c; size_t estride;
    __device__ __forceinline__ bool next(int i, Unit& u) const { const int L = i * G + c, t = L / ncol; if (t >= __builtin_amdgcn_readfirstlane(tb[16])) return false; u.pm = t; u.pn = L - t * ncol; return true; }
    __device__ __forceinline__ void a_ready(const Unit&) const {}
    __device__ __forceinline__ void done(const Unit&) const {}
    __device__ __forceinline__ size_t bofs(const Unit& u) const { int e = 0;
#pragma unroll
        for (int k = 1; k < 16; ++k) e += (u.pm >= tb[k]) ? 1 : 0;
        return (size_t)__builtin_amdgcn_readfirstlane(e) * estride; }
};
struct EpiSwiGLU {
    static constexpr bool PERM = true, AFTER_DRAIN = false;
    bf16_t* O;
    __device__ __forceinline__ void operator()(const f32x4 (&acc)[2][2][4][2], const Unit& u, int wr, int wc, int fr, int fq) const {
        const int row0 = u.pm * BM + wr * 64 + fr, col0 = u.pn * 128 + wc * 32 + 8 * fq;
#pragma unroll
        for (int ai = 0; ai < 2; ++ai)
#pragma unroll
            for (int m = 0; m < 4; ++m) { bf16_t* rowp = O + (size_t)(row0 + ai * HALF + m * 16) * 256 + col0;
                f32x4 v[2];
#pragma unroll
                for (int n = 0; n < 2; ++n)
#pragma unroll
                    for (int e = 0; e < 4; ++e) { const float gt = acc[ai][0][m][n][e]; v[n][e] = gt / (1.f + __expf(-gt)) * acc[ai][1][m][n][e]; }
                u32x4 w; w.x = cvt_pk_bf16(v[0][0], v[0][1]); w.y = cvt_pk_bf16(v[0][2], v[0][3]); w.z = cvt_pk_bf16(v[1][0], v[1][1]); w.w = cvt_pk_bf16(v[1][2], v[1][3]);
                *(u32x4*)rowp = w; }
    }
};
struct EpiLn1 {
    static constexpr bool PERM = false, AFTER_DRAIN = true;
    const float* x; float* hout; bf16_t* hb; const float* gam; const float* bet; float alpha; PanelStats st; unsigned poison;
    __device__ __forceinline__ void fused(f32x4 (&acc)[2][2][4][2], const Unit& u, int wr, int wc, int fr, int fq, PG8_LAS unsigned char* lds, int wid, int lane) const {
        typedef float f32x2v __attribute__((ext_vector_type(2))); typedef unsigned u32x2v __attribute__((ext_vector_type(2)));
        const PG8_LAS f32x2v* S = (const PG8_LAS f32x2v*)(lds + 8192);
        const int col0 = u.pn * BM + wc * 32 + 4 * fq, ldc = 1024;
#pragma unroll
        for (int ai = 0; ai < 2; ++ai)
#pragma unroll
            for (int m = 0; m < 4; ++m) { const size_t off = (size_t)(u.pm * BM + ai * HALF + wr * 64 + m * 16 + fr) * ldc + col0;
#pragma unroll
                for (int bj = 0; bj < 2; ++bj)
#pragma unroll
                    for (int n = 0; n < 2; ++n) { const f32x4 xv = *(const f32x4*)(x + off + bj * HALF + n * 16); acc[ai][bj][m][n] = xv * alpha + acc[ai][bj][m][n]; }
                asm volatile("" : "+v"(acc[ai][0][m][0]), "+v"(acc[ai][0][m][1]), "+v"(acc[ai][1][m][0]), "+v"(acc[ai][1][m][1]));
                if (m & 1) asm volatile("" ::: "memory"); }
        const bool bad = st.run(acc, u, wr, wc, fr, fq, lds, wid, lane) || poison != 0u;
        const float qnan = __builtin_nanf("");
        f32x4 gv[2][2], bv[2][2];
#pragma unroll
        for (int bj = 0; bj < 2; ++bj)
#pragma unroll
            for (int n = 0; n < 2; ++n) { gv[bj][n] = *(const f32x4*)(gam + col0 + bj * HALF + n * 16); bv[bj][n] = *(const f32x4*)(bet + col0 + bj * HALF + n * 16); }
#pragma unroll
        for (int ai = 0; ai < 2; ++ai)
#pragma unroll
            for (int m = 0; m < 4; ++m) { const int r = ai * HALF + wr * 64 + m * 16 + fr; const f32x2v sr = S[r]; const size_t off = (size_t)(u.pm * BM + r) * ldc + col0;
#pragma unroll
                for (int bj = 0; bj < 2; ++bj)
#pragma unroll
                    for (int n = 0; n < 2; ++n) { f32x4 o = (acc[ai][bj][m][n] - sr.x) * sr.y * gv[bj][n] + bv[bj][n];
                        if (bad) o = (f32x4){qnan, qnan, qnan, qnan};
                        *(f32x4*)(hout + off + bj * HALF + n * 16) = o;
                        u32x2v w; w.x = cvt_pk_bf16(o[0], o[1]); w.y = cvt_pk_bf16(o[2], o[3]); *(u32x2v*)(hb + off + bj * HALF + n * 16) = w; }
                asm volatile("" ::: "memory"); }
    }
};
}
#define GAS __attribute__((address_space(1)))
#define LAS __attribute__((address_space(3)))
typedef unsigned short bf16;
typedef unsigned v4u __attribute__((ext_vector_type(4)));
typedef float f32x4 __attribute__((ext_vector_type(4)));
typedef short bf16x8 __attribute__((ext_vector_type(8)));
typedef GAS unsigned gu32;
typedef GAS unsigned long long gu64;
#define RLX_AGENT __ATOMIC_RELAXED, __HIP_MEMORY_SCOPE_AGENT
#define LDS_WAIT() asm volatile("s_waitcnt lgkmcnt(0)" ::: "memory")
#define VM_WAIT() asm volatile("s_waitcnt vmcnt(0)" ::: "memory")
__device__ __forceinline__ unsigned long long rt() { return __builtin_amdgcn_s_memrealtime(); }
__device__ __forceinline__ unsigned f2bf(float f) { unsigned u = __builtin_bit_cast(unsigned, f); return (u + 0x7fffu + ((u >> 16) & 1u)) >> 16; }
__device__ __forceinline__ unsigned pk2(float lo, float hi) { return f2bf(lo) | (f2bf(hi) << 16); }

#define XB_TMO      128
#define XB_XCNT(j)  (256  + 64 * (j))
#define XB_XSUB(j)  (1280 + 64 * (j))
#define XB_XGEN(j)  (2304 + 64 * (j))
#define XB_TOP      3328
#define XB_TOPGEN   3392
#define XCD_BAR_WORDS 3456
#define XB_SPIN_CAP (1u << 18)

__device__ __forceinline__ unsigned xb_ld(unsigned* p)              { return __hip_atomic_load(p, __ATOMIC_RELAXED, __HIP_MEMORY_SCOPE_AGENT); }
__device__ __forceinline__ unsigned xb_add(unsigned* p, unsigned v) { return __hip_atomic_fetch_add(p, v, __ATOMIC_RELAXED, __HIP_MEMORY_SCOPE_AGENT); }
__device__ __forceinline__ unsigned xb_xcc_id() { return (unsigned)__builtin_amdgcn_s_getreg((3 << 11) | 20) & 0xFu; }
#define XB_SPIN(cond, bar) do { unsigned _sp = 0; while (cond) { __builtin_amdgcn_s_sleep(1); \
    if ((++_sp & 255u) == 0u) { if (xb_ld(&(bar)[XB_TMO])) break; if (_sp > XB_SPIN_CAP) { atomicAdd(&(bar)[XB_TMO], 1u); break; } } } } while (0)

struct XcdBarrier {
    unsigned* bar; unsigned x;
    volatile LAS unsigned* st;
};

__device__ __forceinline__ XcdBarrier xcd_barrier_post(unsigned* bar, volatile LAS unsigned* st) {
    XcdBarrier b; b.bar = bar; b.x = xb_xcc_id(); b.st = st;
    if (threadIdx.x == 0) (void)xb_add(&bar[XB_XCNT(b.x)], 1u);
    return b;
}
__device__ __forceinline__ void xcd_barrier_complete(unsigned* bar, unsigned x, unsigned& nloc, unsigned& nx) {
    const unsigned G = gridDim.x * gridDim.y * gridDim.z;
    unsigned sum, cnt, mine, sp = 0u;
    for (;;) {
        sum = 0u; cnt = 0u; mine = 0u;
#pragma unroll
        for (unsigned j = 0; j < 16; ++j) { const unsigned c = xb_ld(&bar[XB_XCNT(j)]); sum += c; cnt += (c > 0u) ? 1u : 0u; mine = (j == x) ? c : mine; }
        if (sum == G) break;
        __builtin_amdgcn_s_sleep(1);
        if ((++sp & 255u) == 0u) { if (xb_ld(&bar[XB_TMO])) break; if (sp > XB_SPIN_CAP) { atomicAdd(&bar[XB_TMO], 1u); break; } }
    }
    nloc = mine > 0u ? mine : 1u; nx = cnt > 0u ? cnt : 1u;
}

__device__ __forceinline__ void xcd_barrier(const XcdBarrier& b) {
    asm volatile("s_waitcnt vmcnt(0)" ::: "memory");
    __syncthreads();
    if (threadIdx.x == 0) {
        unsigned* bar = b.bar;
        __builtin_amdgcn_s_waitcnt(0);
        unsigned nloc = b.st[0], nx = b.st[1];
        if (nloc == 0u) { xcd_barrier_complete(bar, b.x, nloc, nx); b.st[0] = nloc; b.st[1] = nx; }
        const unsigned old = xb_add(&bar[XB_XSUB(b.x)], 1u);
        const unsigned gen = old / nloc;
        if (old + 1u == (gen + 1u) * nloc) {
            __builtin_amdgcn_fence(__ATOMIC_RELEASE, "agent");
            asm volatile("s_waitcnt vmcnt(0)" ::: "memory");
            const unsigned og = xb_add(&bar[XB_TOP], 1u);
            const unsigned tg = og / nx;
            if (og + 1u == (tg + 1u) * nx) xb_add(&bar[XB_TOPGEN], 1u);
            else XB_SPIN(xb_ld(&bar[XB_TOPGEN]) == tg, bar);
            __builtin_amdgcn_fence(__ATOMIC_ACQUIRE, "agent");
            xb_add(&bar[XB_XGEN(b.x)], 1u);
            asm volatile("s_waitcnt vmcnt(0)" ::: "memory");
        } else {
            XB_SPIN(xb_ld(&bar[XB_XGEN(b.x)]) == gen, bar);
            __builtin_amdgcn_fence(__ATOMIC_ACQUIRE, "agent");
            asm volatile("s_waitcnt vmcnt(0)" ::: "memory");
        }
    }
    __syncthreads();
}
namespace mb {
constexpr int D = 128, PITCH = 512, OPITCH = 1024;
constexpr float THR = 8.f;
constexpr bool WSKIP = false;
constexpr int KM_OFF = 69632;
constexpr float SCALE = 0.08838834764831845f;
constexpr int NW = 8, QBLK = 32, KVBLK = 64, QB = NW * QBLK;
constexpr int SHM_V = KVBLK * D * 2, SHM_K = KVBLK * D * 2;
constexpr int LDS_BYTES = 2 * SHM_V + 2 * SHM_K + NW * 64 * 4;

typedef short bf16x8 __attribute__((ext_vector_type(8)));
typedef short s16x4 __attribute__((ext_vector_type(4)));
typedef float f32x16 __attribute__((ext_vector_type(16)));
typedef float f32x4 __attribute__((ext_vector_type(4)));
typedef unsigned u32x4 __attribute__((ext_vector_type(4)));
template <class A, class Bt> struct same_t { static constexpr bool v = false; };
template <class A> struct same_t<A, A> { static constexpr bool v = true; };

typedef const GAS char* gcptr;
__device__ __forceinline__ gcptr uni(const void* p) {
    const unsigned long long u = (unsigned long long)p;
    const unsigned lo = __builtin_amdgcn_readfirstlane((unsigned)u), hi = __builtin_amdgcn_readfirstlane((unsigned)(u >> 32));
    return (gcptr)(((unsigned long long)hi << 32) | lo);
}
#define KSWZ(row, colB) ((row) * 256 + ((colB) ^ (((row) & 7) << 4)))
#define SBAR() __builtin_amdgcn_sched_barrier(0)
__device__ __forceinline__ int v_st(int k, int c) { const int kk = (k & ~0xC) | ((k & 4) << 1) | ((k & 8) >> 1); return ((kk >> 3) * 4 + (c >> 5)) * 512 + ((kk & 7) * 32 + (c & 31)) * 2; }
__device__ __forceinline__ int v_rd_base(int lane) { return ((lane & 3) << 3) | (((lane >> 2) & 3) << 6) | (((lane >> 4) & 1) << 5) | (((lane >> 5) & 1) << 8); }
constexpr int v_rd_off(int d0, int ks, int half) { return d0 * 512 + ks * 4096 + half * 2048; }
__device__ __forceinline__ int crow(int r, int hi) { return (r & 3) + 8 * (r >> 2) + 4 * hi; }
__device__ __forceinline__ unsigned cvtpk(float lo, float hi) {
    unsigned r; asm volatile("v_cvt_pk_bf16_f32 %0, %1, %2" : "=v"(r) : "v"(lo), "v"(hi)); return r;
}
__device__ __forceinline__ bf16x8 pack8(f32x4 a, f32x4 b) {
    u32x4 w = {cvtpk(a[0], a[1]), cvtpk(a[2], a[3]), cvtpk(b[0], b[1]), cvtpk(b[2], b[3])};
    return *reinterpret_cast<bf16x8*>(&w);
}
template <class T> __device__ __forceinline__ bf16x8 load8(const T* p) {
    if constexpr (same_t<T, float>::v) { return pack8(*(const f32x4*)p, *(const f32x4*)(p + 4)); }
    else { return *reinterpret_cast<const bf16x8*>(p); }
}
__device__ __forceinline__ void mask_tile(f32x16& p0, f32x16& p1, int dq, unsigned W) {
    const float NEG = -__builtin_inff();
#pragma unroll
    for (int r = 0; r < 16; ++r) {
        const int c = (r & 3) + 8 * (r >> 2);
        if ((unsigned)(dq - c) >= W) p0[r] = NEG;
        if ((unsigned)(dq - c - 32) >= W) p1[r] = NEG;
    }
}
__device__ __forceinline__ void partialSM(f32x16& p0, f32x16& p1, float& m_reg, float& mn, float& alpha) {
    float pmax = p0[0]; for (int r = 1; r < 16; ++r) pmax = fmaxf(pmax, p0[r]); for (int r = 0; r < 16; ++r) pmax = fmaxf(pmax, p1[r]);
    { auto rr = __builtin_amdgcn_permlane32_swap(__float_as_uint(pmax), __float_as_uint(pmax), false, false);
      pmax = fmaxf(__uint_as_float(rr[0]), __uint_as_float(rr[1])); }
    constexpr float C2 = 1.4426950408889634f * SCALE;
    if (__builtin_expect(__all((pmax - m_reg) * SCALE <= THR), 1)) { mn = m_reg; alpha = 1.f; }
    else { mn = fmaxf(m_reg, pmax); alpha = __builtin_amdgcn_exp2f((m_reg - mn) * C2); m_reg = mn; }
    const float mnL = -mn * C2;
    for (int r = 0; r < 16; ++r) p0[r] = fmaf(p0[r], C2, mnL); for (int r = 0; r < 16; ++r) p1[r] = fmaf(p1[r], C2, mnL);
    for (int r = 0; r < 16; ++r) p0[r] = __builtin_amdgcn_exp2f(p0[r]);
}
__device__ __forceinline__ void finishSM(f32x16& p0, f32x16& p1, float alpha, float& l_reg, bf16x8& pa0, bf16x8& pa1, bf16x8& pa2, bf16x8& pa3) {
    for (int r = 0; r < 16; ++r) p1[r] = __builtin_amdgcn_exp2f(p1[r]);
    float ps = 0; for (int r = 0; r < 16; ++r) ps += p0[r]; for (int r = 0; r < 16; ++r) ps += p1[r];
    { auto rr = __builtin_amdgcn_permlane32_swap(__float_as_uint(ps), __float_as_uint(ps), false, false);
      ps = __uint_as_float(rr[0]) + __uint_as_float(rr[1]); }
    l_reg = l_reg * alpha + ps;
#define PK4(P, B_, OUT) do { unsigned a0 = cvtpk(P[B_+0], P[B_+1]), a1 = cvtpk(P[B_+2], P[B_+3]);                          \
        unsigned b0 = cvtpk(P[B_+4], P[B_+5]), b1 = cvtpk(P[B_+6], P[B_+7]);                                             \
        auto r0 = __builtin_amdgcn_permlane32_swap(a0, b0, false, false); auto r1 = __builtin_amdgcn_permlane32_swap(a1, b1, false, false); \
        u32x4 w = {r0[0], r1[0], r0[1], r1[1]}; OUT = *reinterpret_cast<bf16x8*>(&w); } while (0)
    PK4(p0, 0, pa0); PK4(p0, 8, pa1); PK4(p1, 0, pa2); PK4(p1, 8, pa3);
#undef PK4
}
template <int KB, bool SK>
__device__ __forceinline__ void qkt(f32x16& p0, f32x16& p1, const char* K_lds, int r32, int hi, const bf16x8* qr, bool act) {
    if (SK && !act) { const float NEG = -__builtin_inff();
#pragma unroll
        for (int r = 0; r < 16; ++r) { p0[r] = NEG; p1[r] = NEG; } return; }
    p0 = f32x16{}; p1 = f32x16{};
    const char* kb[4];
#pragma unroll
    for (int dd = 0; dd < 4; ++dd) kb[dd] = K_lds + KB * SHM_K + KSWZ(r32, (dd * 16 + hi * 8) * 2);
#pragma unroll
    for (int d0 = 0; d0 < 8; ++d0) { const char* a = kb[d0 & 3] + (d0 >> 2) * 128;
        bf16x8 b0 = *reinterpret_cast<const bf16x8*>(a);
        bf16x8 b1 = *reinterpret_cast<const bf16x8*>(a + 32 * 256);
        p0 = __builtin_amdgcn_mfma_f32_32x32x16_bf16(b0, qr[d0], p0, 0, 0, 0);
        p1 = __builtin_amdgcn_mfma_f32_32x32x16_bf16(b1, qr[d0], p1, 0, 0, 0); }
}
template <int VB, bool SK>
__device__ __forceinline__ void pv_tile(f32x16* o, int vb0, bf16x8 pa0, bf16x8 pa1, bf16x8 pa2, bf16x8 pa3, bool act) {
    if (SK && !act) return;
#define TRRD(dst, off) asm volatile("ds_read_b64_tr_b16 %0, %1 offset:%2" : "=&v"(dst) : "v"(vb0), "i"(off) : "memory")
#define PV_D0(d0) do { s16x4 l0, l1, l2, l3, h0, h1, h2, h3; constexpr int b_ = VB * SHM_V + v_rd_off(d0, 0, 0);     \
        TRRD(l0, b_); TRRD(h0, b_ + 2048); TRRD(l1, b_ + 4096); TRRD(h1, b_ + 6144); TRRD(l2, b_ + 8192); TRRD(h2, b_ + 10240); TRRD(l3, b_ + 12288); TRRD(h3, b_ + 14336); \
        asm volatile("s_waitcnt lgkmcnt(0)" ::: "memory"); SBAR();                 \
        o[d0] = __builtin_amdgcn_mfma_f32_32x32x16_bf16(pa0, (bf16x8){l0[0], l0[1], l0[2], l0[3], h0[0], h0[1], h0[2], h0[3]}, o[d0], 0, 0, 0);   \
        o[d0] = __builtin_amdgcn_mfma_f32_32x32x16_bf16(pa1, (bf16x8){l1[0], l1[1], l1[2], l1[3], h1[0], h1[1], h1[2], h1[3]}, o[d0], 0, 0, 0);   \
        o[d0] = __builtin_amdgcn_mfma_f32_32x32x16_bf16(pa2, (bf16x8){l2[0], l2[1], l2[2], l2[3], h2[0], h2[1], h2[2], h2[3]}, o[d0], 0, 0, 0);   \
        o[d0] = __builtin_amdgcn_mfma_f32_32x32x16_bf16(pa3, (bf16x8){l3[0], l3[1], l3[2], l3[3], h3[0], h3[1], h3[2], h3[3]}, o[d0], 0, 0, 0); } while (0)
    PV_D0(0); PV_D0(1); PV_D0(2); PV_D0(3);
#undef PV_D0
#undef TRRD
}

template <class TIn, class TOut> struct BlockRef { const TIn* Q; const TIn* K; const TIn* V; TOut* O; const float* KM; int P0; int t_lo, t_hi; TOut* OP; float* LSE; };
template <class TIn> struct Seam {
    bf16x8 qr[8];
    bf16x8 st_v0, st_v1, st_k0, st_k1; f32x4 sf0, sf1, sf2, sf3;
    f32x4 tq[16];
};
__device__ __forceinline__ int swa_jlo(int P0, int W) { const int lowk = P0 - W + 1; return lowk > 0 ? lowk / KVBLK : 0; }
#define ROW(p, k0, rr) ((p) + (size_t)((k0) + (rr)) * PITCH + sc)
#define VMW() asm volatile("s_waitcnt vmcnt(0)" ::: "memory")
#define VMWN(n) asm volatile("s_waitcnt vmcnt(%0)" :: "i"(n) : "memory")
#define LD16U(base, boff) (*(const GAS bf16x8*)(uni((const char*)(base) + (size_t)(boff)) + voff))
#define SLOAD_H(Kp, Vp, k0) do { S.st_v0 = LD16U(Vp, (size_t)(k0) * (PITCH * 2)); S.st_v1 = LD16U(Vp, (size_t)((k0) + 32) * (PITCH * 2));              \
                         S.st_k0 = LD16U(Kp, (size_t)(k0) * (PITCH * 2)); S.st_k1 = LD16U(Kp, (size_t)((k0) + 32) * (PITCH * 2)); } while (0)
#define SWRITE_HK(bf) do { *(bf16x8*)(K_lds + (bf) * SHM_K + kws) = S.st_k0; *(bf16x8*)(K_lds + (bf) * SHM_K + kws + 32 * 256) = S.st_k1; } while (0)
#define SWRITE_HV(bf) do { *(bf16x8*)(V_lds + (bf) * SHM_V + vst0) = S.st_v0; *(bf16x8*)(V_lds + (bf) * SHM_V + vst1) = S.st_v1; } while (0)
#define SWRITE_H(bf) do { SWRITE_HV(bf); SWRITE_HK(bf); } while (0)
#define SLOAD_F(p, k0) do { S.sf0 = *(const f32x4*)ROW(p, k0, sr); S.sf1 = *(const f32x4*)(ROW(p, k0, sr) + 4);                \
                            S.sf2 = *(const f32x4*)ROW(p, k0, 32 + sr); S.sf3 = *(const f32x4*)(ROW(p, k0, 32 + sr) + 4); } while (0)
#define SWRITE_KF(bf) do { *(bf16x8*)(K_lds + (bf) * SHM_K + kws) = pack8(S.sf0, S.sf1); *(bf16x8*)(K_lds + (bf) * SHM_K + kws + 32 * 256) = pack8(S.sf2, S.sf3); } while (0)
#define SWRITE_VF(bf) do { *(bf16x8*)(V_lds + (bf) * SHM_V + vst0) = pack8(S.sf0, S.sf1); *(bf16x8*)(V_lds + (bf) * SHM_V + vst1) = pack8(S.sf2, S.sf3); } while (0)
template <class TIn, class TOut>
__device__ __forceinline__ void causal_swa_prime(const BlockRef<TIn, TOut>& cur, int W, char* lds, Seam<TIn>& S) {
    constexpr bool F32 = same_t<TIn, float>::v;
    int tid = threadIdx.x; asm volatile("" : "+v"(tid));
    const int wid = __builtin_amdgcn_readfirstlane(tid >> 6), lane = tid & 63, r32 = lane & 31, hi = lane >> 5;
    const int sr = tid >> 4, sc = (tid & 15) * 8, kws = KSWZ(sr, sc * 2); char* K_lds = lds + 2 * SHM_V;
    const unsigned voff = (unsigned)(sr * PITCH + sc) * 2u, qoff = (unsigned)((wid * QBLK + r32) * PITCH + hi * 8) * 2u;
    const int kb0 = cur.t_lo * KVBLK;
    for (int d0 = 0; d0 < 8; ++d0) S.qr[d0] = *(const GAS bf16x8*)(uni((const char*)cur.Q + d0 * 32) + qoff);
    if constexpr (F32) { SLOAD_F((const float*)cur.K, kb0); VMW(); SWRITE_KF(0); SBAR(); SLOAD_F((const float*)cur.V, kb0); }
    else { SLOAD_H(cur.K, cur.V, kb0); VMW(); SWRITE_HK(0); }
    __syncthreads();
}
template <class TIn, class TOut>
__device__ __forceinline__ void causal_swa_block(const BlockRef<TIn, TOut>& cur, const BlockRef<TIn, TOut>& nxt, int skv, int W, char* lds, Seam<TIn>& S) {
    constexpr bool F32 = same_t<TIn, float>::v;
    int tid = threadIdx.x; asm volatile("" : "+v"(tid));
    const int wid = __builtin_amdgcn_readfirstlane(tid >> 6), lane = tid & 63, r32 = lane & 31, hi = lane >> 5;
    const int j_lo = cur.t_lo, j_hi = cur.t_hi;
    const int NT = j_hi - j_lo;
    const int kbn = nxt.t_lo * KVBLK;
    const int qlo = cur.P0 + wid * QBLK, qm = qlo + r32 - 4 * hi;
    char* V_lds = lds; char* K_lds = lds + 2 * SHM_V;
    float* ws = (float*)(lds + 2 * SHM_V + 2 * SHM_K) + wid * 64; float* li_l = ws, * al_l = ws + 32;
    float m_reg = -1e30f, l_reg = 0; f32x16 o[4] = {};
    const int sr = tid >> 4, sc = (tid & 15) * 8, vst0 = v_st(sr, sc), vst1 = v_st(32 + sr, sc), kws = KSWZ(sr, sc * 2);
    const unsigned voff = (unsigned)(sr * PITCH + sc) * 2u, qoff = (unsigned)((wid * QBLK + r32) * PITCH + hi * 8) * 2u;
    const int vb0 = (int)(uintptr_t)V_lds + v_rd_base(lane);
    const TIn* Kh = cur.K; const TIn* Vh = cur.V;
    const int own = cur.P0 / QB, own4 = cur.P0 / KVBLK;
    unsigned sel = 0u;
    {
        float* km = (float*)(lds + KM_OFF);
        for (int i = tid; i < 16 * 128; i += 64 * NW) { const GAS float* p = (const GAS float*)(uni(cur.KM) + (unsigned)(((i >> 7) * 512 + (i & 127)) * 4)); km[i] = (p[0] + p[128]) + (p[256] + p[384]); }
        __syncthreads();
        float best[3] = {-3e38f, -3e38f, -3e38f}; int bidx[3] = {0, 0, 0};
#pragma unroll 1
        for (int j = 0; j < own; ++j) {
            float a = 0.f;
#pragma unroll
            for (int d0 = 0; d0 < 8; ++d0) {
                const f32x4 k0 = *(const f32x4*)(km + j * 128 + d0 * 16 + hi * 8), k1 = *(const f32x4*)(km + j * 128 + d0 * 16 + hi * 8 + 4);
                const u32x4 qw = *reinterpret_cast<const u32x4*>(&S.qr[d0]);
                a += __uint_as_float(qw[0] << 16) * k0[0] + __uint_as_float(qw[0] & 0xffff0000u) * k0[1] + __uint_as_float(qw[1] << 16) * k0[2] + __uint_as_float(qw[1] & 0xffff0000u) * k0[3]
                   + __uint_as_float(qw[2] << 16) * k1[0] + __uint_as_float(qw[2] & 0xffff0000u) * k1[1] + __uint_as_float(qw[3] << 16) * k1[2] + __uint_as_float(qw[3] & 0xffff0000u) * k1[3];
            }
            a += __shfl_xor(a, 32);
            if (a > best[0]) { best[2] = best[1]; bidx[2] = bidx[1]; best[1] = best[0]; bidx[1] = bidx[0]; best[0] = a; bidx[0] = j; }
            else if (a > best[1]) { best[2] = best[1]; bidx[2] = bidx[1]; best[1] = a; bidx[1] = j; }
            else if (a > best[2]) { best[2] = a; bidx[2] = j; }
        }
#pragma unroll
        for (int r = 0; r < 3; ++r) if (best[r] > -1e37f) sel |= 1u << bidx[r];
    }
#define RESC(a) do { if (__any((a) < 1.f)) { if (hi == 0) al_l[r32] = (a); asm volatile("s_waitcnt lgkmcnt(0)" ::: "memory");              \
                     for (int d_ = 0; d_ < 4; ++d_) for (int r = 0; r < 16; ++r) o[d_][r] *= al_l[crow(r, hi)]; } } while (0)
#define KBASE(t) ((j_lo + (t)) * KVBLK)
#define ACT(t) (KBASE(t) <= qlo + QBLK - 1 && KBASE(t) + KVBLK - 1 >= qlo - W + 1)
#define MASKT(P0_, P1_, t) do { const int kb_ = KBASE(t), gt_ = j_lo + (t); if (gt_ >= own4) { if (kb_ + KVBLK - 1 > qlo) mask_tile(P0_, P1_, qm - kb_, 0x3fffffffu); } else if (!((sel >> (gt_ >> 2)) & 1u)) { const float NEG_ = -__builtin_inff(); _Pragma("unroll") for (int r_ = 0; r_ < 16; ++r_) { P0_[r_] = NEG_; P1_[r_] = NEG_; } } } while (0)
    constexpr int NQL = F32 ? 16 : 8;
    constexpr bool SK = WSKIP && !F32;
#define SEAM_K0() do { VMWN(NQL); if constexpr (F32) { SWRITE_KF(0); SBAR(); SLOAD_F((const float*)nxt.V, kbn); } else { SWRITE_HK(0); } SBAR(); } while (0)
    f32x16 pA0, pA1, pB0, pB1; float mnA, mnB, alA, alB; bf16x8 pa0, pa1, pa2, pa3;
    if constexpr (F32) { VMW(); SWRITE_VF(0); SBAR(); } else { SWRITE_HV(0); SBAR(); }
    if (NT > 1) { if constexpr (F32) SLOAD_F((const float*)Kh, KBASE(1)); else SLOAD_H(Kh, Vh, KBASE(1)); }
    SBAR(); qkt<0, SK>(pA0, pA1, K_lds, r32, hi, S.qr, ACT(0));
    if constexpr (F32) { if (NT > 1) { VMW(); SWRITE_KF(1); SBAR(); SLOAD_F((const float*)Vh, KBASE(1)); } }
    MASKT(pA0, pA1, 0); partialSM(pA0, pA1, m_reg, mnA, alA);
    if (NT > 1) { VMW(); if constexpr (F32) { SWRITE_VF(1); SBAR(); if (NT > 2) SLOAD_F((const float*)Kh, KBASE(2)); } else SWRITE_H(1); }
    __syncthreads();
#define HALF_STEP(PX0, PX1, mnX, alX, PY0, PY1, alY, t, KB, VB, SB) do {                                                      \
        SBAR(); qkt<KB, SK>(PX0, PX1, K_lds, r32, hi, S.qr, ACT(t));                                             \
        finishSM(PY0, PY1, alY, l_reg, pa0, pa1, pa2, pa3); SBAR();                                                           \
        if ((t) + 1 < NT) { if constexpr (F32) { VMW(); SWRITE_KF(SB); SBAR(); SLOAD_F((const float*)Vh, KBASE((t) + 1)); }  \
                            else { SLOAD_H(Kh, Vh, KBASE((t) + 1)); } SBAR(); }                                               \
        pv_tile<VB, SK>(o, vb0, pa0, pa1, pa2, pa3, ACT((t) - 1)); MASKT(PX0, PX1, (t)); partialSM(PX0, PX1, m_reg, mnX, alX);                                        \
        __syncthreads();                                                                                                      \
        if ((t) + 1 < NT) { VMW(); if constexpr (F32) { SWRITE_VF(SB); SBAR(); if ((t) + 2 < NT) SLOAD_F((const float*)Kh, KBASE((t) + 2)); } \
                            else { SWRITE_H(SB); } }                                                                          \
        RESC(alX); __syncthreads(); } while (0)
    for (int t = 1; t + 1 < NT; t += 2) {
        HALF_STEP(pB0, pB1, mnB, alB, pA0, pA1, alA, t, 1, 0, 0);
        HALF_STEP(pA0, pA1, mnA, alA, pB0, pB1, alB, t + 1, 0, 1, 1);
    }
    const bool even = (NT & 1) == 0;
    if (even) { SBAR(); qkt<1, SK>(pB0, pB1, K_lds, r32, hi, S.qr, ACT(NT - 1)); SBAR(); }
#define QROW(e) (nxt.Q + (size_t)(wid * QBLK + r32) * PITCH + ((e) >> 1) * 16 + hi * 8 + ((e) & 1) * 4)
    if constexpr (F32) { SLOAD_F((const float*)nxt.K, kbn); SBAR();
#pragma unroll
        for (int e = 0; e < 8; ++e) S.tq[e] = *(const f32x4*)QROW(e); }
    else { SLOAD_H(nxt.K, nxt.V, kbn); SBAR();
#pragma unroll
        for (int d0 = 0; d0 < 8; ++d0) S.qr[d0] = *(const GAS bf16x8*)(uni((const char*)nxt.Q + d0 * 32) + qoff); }
    SBAR();
    finishSM(pA0, pA1, alA, l_reg, pa0, pa1, pa2, pa3); SBAR();
    if constexpr (F32) {
#pragma unroll
        for (int e = 8; e < 16; ++e) S.tq[e] = *(const f32x4*)QROW(e); SBAR(); }
#undef QROW
    pv_tile<0, SK>(o, vb0, pa0, pa1, pa2, pa3, ACT(even ? NT - 2 : NT - 1));
    if (even) { MASKT(pB0, pB1, NT - 1); partialSM(pB0, pB1, m_reg, mnB, alB); __syncthreads(); RESC(alB);
        finishSM(pB0, pB1, alB, l_reg, pa0, pa1, pa2, pa3); SBAR(); pv_tile<1, SK>(o, vb0, pa0, pa1, pa2, pa3, ACT(NT - 1)); }
    SBAR(); SEAM_K0();
    if (hi == 0) li_l[r32] = l_reg; asm volatile("s_waitcnt lgkmcnt(0)" ::: "memory");
    float rli[16];
#pragma unroll
    for (int r = 0; r < 16; ++r) { const float li_ = li_l[crow(r, hi)]; rli[r] = li_ > 0.f ? __builtin_amdgcn_rcpf(li_) : 0.f; }
    if (cur.OP) {
        if (hi == 0) cur.LSE[wid * QBLK + r32] = l_reg > 0.f ? m_reg * (1.4426950408889634f * SCALE) + __builtin_amdgcn_logf(l_reg) : -__builtin_inff();
        GAS char* Ow = (GAS char*)uni(cur.OP + (size_t)(wid * QBLK) * 128);
        unsigned obase = (unsigned)((4 * hi * 128 + r32) * 2); asm volatile("" : "+v"(obase));
#pragma unroll
        for (int r = 0; r < 16; ++r) {
#pragma unroll
            for (int d0 = 0; d0 < 4; ++d0) { const float v = o[d0][r] * rli[r];
                const float vn = __shfl_xor(v, 1);
                if ((r32 & 1) == 0) *(GAS unsigned*)(Ow + (obase + (unsigned)((((r & 3) + 8 * (r >> 2)) * 128 + d0 * 32) * 2))) = cvtpk(v, vn); } }
    } else {
        GAS char* Ow = (GAS char*)uni(cur.O + (size_t)(wid * QBLK) * OPITCH);
        unsigned obase = (unsigned)((4 * hi * OPITCH + r32) * 2); asm volatile("" : "+v"(obase));
#pragma unroll
        for (int r = 0; r < 16; ++r) {
#pragma unroll
            for (int d0 = 0; d0 < 4; ++d0) { const float v = o[d0][r] * rli[r];
                const float vn = __shfl_xor(v, 1);
                if ((r32 & 1) == 0) *(GAS unsigned*)(Ow + (obase + (unsigned)((((r & 3) + 8 * (r >> 2)) * OPITCH + d0 * 32) * 2))) = cvtpk(v, vn); } }
    }
    if constexpr (F32) {
#pragma unroll
        for (int d0 = 0; d0 < 8; ++d0) S.qr[d0] = pack8(S.tq[2 * d0], S.tq[2 * d0 + 1]); }
    __syncthreads();
#undef RESC
#undef KBASE
#undef ACT
#undef MASKT
#undef SEAM_K0
#undef HALF_STEP
}
#undef ROW
#undef VMW
#undef VMWN
#undef SLOAD_H
#undef LD16U
#undef SWRITE_HK
#undef SWRITE_HV
#undef SWRITE_H
#undef SLOAD_F
#undef SWRITE_KF
#undef SWRITE_VF
}
namespace dn {
typedef short bf16x8 __attribute__((ext_vector_type(8)));
typedef float f32x16 __attribute__((ext_vector_type(16)));
typedef float f32x4 __attribute__((ext_vector_type(4)));
typedef unsigned u32x4 __attribute__((ext_vector_type(4)));
typedef unsigned u32x2 __attribute__((ext_vector_type(2)));
#define DNI __device__ __forceinline__
#define DN_MFMA(a, b, c) __builtin_amdgcn_mfma_f32_32x32x16_bf16((a), (b), (c), 0, 0, 0)
constexpr int LQ = 136, LT = 72;
constexpr int BLOB_FRAGS = 56, BLOB_BYTES = BLOB_FRAGS * 1024, UF_BYTES = 16384;
constexpr int L_QS = 0, L_KS = 17408, L_KST = 34816, L_VST = 53248, L_AF = 71680, L_ABF = 89088, L_TRM = 98304, L_TW = 107520, L_TU = 116736,
              L_T00T = 125952, L_GATE = 128512, L_CONVW = 129536, L_END = 135680;
DNI int crow(int i, int h) { return (i & 3) + 8 * (i >> 2) + 4 * h; }
DNI unsigned cvtpk2(float lo, float hi) {
    typedef float f2_t __attribute__((ext_vector_type(2))); typedef __bf16 b2_t __attribute__((ext_vector_type(2)));
    f2_t v = {lo, hi}; b2_t b = __builtin_convertvector(v, b2_t); return __builtin_bit_cast(unsigned, b);
}
template <int SS> DNI bf16x8 pack_acc(const f32x16& x) {
    u32x4 p = {cvtpk2(x[8 * SS], x[8 * SS + 1]), cvtpk2(x[8 * SS + 2], x[8 * SS + 3]), cvtpk2(x[8 * SS + 4], x[8 * SS + 5]), cvtpk2(x[8 * SS + 6], x[8 * SS + 7])};
    return __builtin_bit_cast(bf16x8, p);
}
DNI bf16x8 lds16(const LAS unsigned char* p) { return *(const LAS bf16x8*)p; }
DNI bf16x8 lds_perm8(const LAS unsigned char* rowp, int colbase, int h) {
    const u32x2 a = *(const LAS u32x2*)(rowp + (colbase + 4 * h) * 2), b = *(const LAS u32x2*)(rowp + (colbase + 8 + 4 * h) * 2);
    u32x4 p = {a.x, a.y, b.x, b.y}; return __builtin_bit_cast(bf16x8, p);
}
DNI float bflo_(unsigned w) { return __uint_as_float(w << 16); }
DNI float bfhi_(unsigned w) { return __uint_as_float(w & 0xffff0000u); }

DNI void chunk_local(LAS unsigned char* lds, int item, const bf16* PJ, size_t pj_stride, const float* GATES, const float* conv_w, const float* a_log, const float* dt_bias,
                     unsigned char* BLOB, unsigned char* UF, float* GL) {
    int tid = threadIdx.x; asm volatile("" : "+v"(tid));
    const int wid = __builtin_amdgcn_readfirstlane(tid >> 6), lane = tid & 63, r = lane & 31, h2 = lane >> 5;
    const int n = item & 63, hd = (item >> 6) & 3, b = item >> 8;
    const size_t row0 = (size_t)b * 4096 + (size_t)n * 64;
    LAS float* gate = (LAS float*)(lds + L_GATE);
    LAS float* convw = (LAS float*)(lds + L_CONVW);
    unsigned char* blob = BLOB + (size_t)item * BLOB_BYTES;
    for (int i = tid; i < 4 * 384; i += 512) { const int j = i / 384, c = i % 384; convw[i] = conv_w[j * 1536 + (c >> 7) * 512 + hd * 128 + (c & 127)]; }
    if (wid == 0) {
        const size_t m = row0 + lane;
        const float braw = GATES[m * 8 + hd], araw = GATES[m * 8 + 4 + hd];
        const float beta = 1.f / (1.f + __expf(-braw));
        const float sp = fmaxf(araw + dt_bias[hd], 0.f) + log1pf(__expf(-fabsf(araw + dt_bias[hd])));
        float g = -__expf(a_log[hd]) * sp;
#pragma unroll
        for (int d = 1; d < 64; d <<= 1) { const float t = __shfl_up(g, d); if (lane >= d) g += t; }
        const float glast = __shfl(g, 63);
        gate[lane] = beta; gate[64 + lane] = g; gate[128 + lane] = __expf(g); gate[192 + lane] = __expf(glast - g);
        if (lane == 63) GL[item] = __expf(glast);
    }
    __syncthreads();
    {
        const int row = tid >> 3, seg = tid & 7, c0 = seg * 16, t = n * 64 + row;
        float val[3][16];
#pragma unroll
        for (int X = 0; X < 3; ++X) {
#pragma unroll
            for (int e = 0; e < 16; ++e) val[X][e] = 0.f;
#pragma unroll
            for (int j = 0; j < 4; ++j) {
                if (t - 3 + j >= 0) {
                    const bf16* src = PJ + (size_t)X * pj_stride + (row0 + row - 3 + j) * 512 + hd * 128 + c0;
                    const u32x4 w0 = *(const u32x4*)src, w1 = *(const u32x4*)(src + 8);
                    const LAS float* cw = convw + j * 384 + X * 128 + c0;
#pragma unroll
                    for (int e = 0; e < 4; ++e) { val[X][2 * e] += cw[2 * e] * bflo_(w0[e]); val[X][2 * e + 1] += cw[2 * e + 1] * bfhi_(w0[e]);
                                                  val[X][8 + 2 * e] += cw[8 + 2 * e] * bflo_(w1[e]); val[X][8 + 2 * e + 1] += cw[8 + 2 * e + 1] * bfhi_(w1[e]); }
                }
            }
#pragma unroll
            for (int e = 0; e < 16; ++e) val[X][e] = val[X][e] / (1.f + __expf(-val[X][e]));
        }
        float sq = 0.f, sk = 0.f;
#pragma unroll
        for (int e = 0; e < 16; ++e) { sq += val[0][e] * val[0][e]; sk += val[1][e] * val[1][e]; }
        sq += __shfl_xor(sq, 1); sq += __shfl_xor(sq, 2); sq += __shfl_xor(sq, 4);
        sk += __shfl_xor(sk, 1); sk += __shfl_xor(sk, 2); sk += __shfl_xor(sk, 4);
        const float rq = rsqrtf(sq + 1e-6f) * 0.08838834764831845f, rk = rsqrtf(sk + 1e-6f);
        u32x4 qa, qb, ka, kb;
#pragma unroll
        for (int e = 0; e < 4; ++e) { qa[e] = cvtpk2(val[0][2 * e] * rq, val[0][2 * e + 1] * rq); qb[e] = cvtpk2(val[0][8 + 2 * e] * rq, val[0][8 + 2 * e + 1] * rq);
                                      ka[e] = cvtpk2(val[1][2 * e] * rk, val[1][2 * e + 1] * rk); kb[e] = cvtpk2(val[1][8 + 2 * e] * rk, val[1][8 + 2 * e + 1] * rk); }
        *(LAS u32x4*)(lds + L_QS + (row * LQ + c0) * 2) = qa; *(LAS u32x4*)(lds + L_QS + (row * LQ + c0 + 8) * 2) = qb;
        *(LAS u32x4*)(lds + L_KS + (row * LQ + c0) * 2) = ka; *(LAS u32x4*)(lds + L_KS + (row * LQ + c0 + 8) * 2) = kb;
#pragma unroll
        for (int e = 0; e < 16; ++e) {
            const unsigned kw = (e < 8) ? ka[e >> 1] : kb[(e - 8) >> 1];
            *(LAS unsigned short*)(lds + L_KST + ((c0 + e) * LT + row) * 2) = (unsigned short)((e & 1) ? (kw >> 16) : (kw & 0xffffu));
            *(LAS unsigned short*)(lds + L_VST + ((c0 + e) * LT + row) * 2) = (unsigned short)(cvtpk2(val[2][e], 0.f) & 0xffffu);
        }
    }
    __syncthreads();
    {
        const int p = wid >> 2, ri = (wid >> 1) & 1, ci = wid & 1;
        const LAS unsigned char* Ap = lds + L_KS + ((32 * ri + r) * LQ + 8 * h2) * 2;
        const LAS unsigned char* Bp = lds + (p == 0 ? L_KS : L_QS) + ((32 * ci + r) * LQ + 8 * h2) * 2;
        f32x16 acc = {};
        const bool live = (p == 0) ? (ri >= ci) : (ri <= ci);
        if (live) {
#pragma unroll
            for (int ks = 0; ks < 8; ++ks) acc = DN_MFMA(lds16(Ap + ks * 32), lds16(Bp + ks * 32), acc);
        }
        const int colg = 32 * ci + r;
        const float gcol = gate[64 + colg];
        if (p == 0) {
#pragma unroll
            for (int i = 0; i < 16; ++i) {
                const int c = 32 * ri + crow(i, h2);
                const float a = (c > colg) ? gate[c] * acc[i] * __expf(gate[64 + c] - gcol) : 0.f;
                *(LAS float*)(lds + L_AF + (c * 68 + colg) * 4) = a;
                *(LAS unsigned short*)(lds + L_ABF + (c * LT + colg) * 2) = (unsigned short)(cvtpk2(a, 0.f) & 0xffffu);
            }
        } else {
            f32x16 x;
#pragma unroll
            for (int i = 0; i < 16; ++i) { const int s = 32 * ri + crow(i, h2); x[i] = (colg >= s) ? acc[i] * __expf(gcol - gate[64 + s]) : 0.f; }
            *(u32x4*)(blob + (32 + ci * 4 + 2 * ri + 0) * 1024 + lane * 16) = __builtin_bit_cast(u32x4, pack_acc<0>(x));
            *(u32x4*)(blob + (32 + ci * 4 + 2 * ri + 1) * 1024 + lane * 16) = __builtin_bit_cast(u32x4, pack_acc<1>(x));
        }
    }
    __syncthreads();
    if (wid == 0) {
        const int blk = h2, j = r, jg = 32 * blk + j;
        float x[32];
#pragma unroll
        for (int c = 0; c < 32; ++c) {
            float a = (c == j) ? 1.f : 0.f;
            const LAS float* arow = (const LAS float*)(lds + L_AF) + (32 * blk + c) * 68 + 32 * blk;
#pragma unroll
            for (int s = 0; s < c; ++s) a -= arow[s] * x[s];
            x[c] = a;
        }
        const float sw = gate[jg] * gate[128 + jg], su = gate[jg];
#pragma unroll
        for (int c = 0; c < 32; ++c) {
            const int off = ((32 * blk + c) * LT + jg) * 2;
            *(LAS unsigned short*)(lds + L_TRM + off) = (unsigned short)(cvtpk2(x[c], 0.f) & 0xffffu);
            *(LAS unsigned short*)(lds + L_TW + off) = (unsigned short)(cvtpk2(x[c] * sw, 0.f) & 0xffffu);
            *(LAS unsigned short*)(lds + L_TU + off) = (unsigned short)(cvtpk2(x[c] * su, 0.f) & 0xffffu);
        }
        if (blk == 0) {
#pragma unroll
            for (int c4 = 0; c4 < 4; ++c4) { u32x4 w = {cvtpk2(x[8 * c4], x[8 * c4 + 1]), cvtpk2(x[8 * c4 + 2], x[8 * c4 + 3]), cvtpk2(x[8 * c4 + 4], x[8 * c4 + 5]), cvtpk2(x[8 * c4 + 6], x[8 * c4 + 7])};
                *(LAS u32x4*)(lds + L_T00T + (j * 40 + 8 * c4) * 2) = w; }
        }
        asm volatile("s_waitcnt lgkmcnt(0)" ::: "memory");
        f32x16 m1 = {};
#pragma unroll
        for (int ks = 0; ks < 2; ++ks) m1 = DN_MFMA(lds16(lds + L_ABF + ((32 + r) * LT + 16 * ks + 8 * h2) * 2), lds16(lds + L_T00T + (r * 40 + 16 * ks + 8 * h2) * 2), m1);
        f32x16 t10 = {};
        t10 = DN_MFMA(lds_perm8(lds + L_TRM + ((32 + r) * LT) * 2, 32 + 0, h2), pack_acc<0>(m1), t10);
        t10 = DN_MFMA(lds_perm8(lds + L_TRM + ((32 + r) * LT) * 2, 32 + 16, h2), pack_acc<1>(m1), t10);
        const float sw0 = gate[r] * gate[128 + r], su0 = gate[r];
#pragma unroll
        for (int i = 0; i < 16; ++i) {
            const int off = ((32 + crow(i, h2)) * LT + r) * 2; const float tv = -t10[i];
            *(LAS unsigned short*)(lds + L_TW + off) = (unsigned short)(cvtpk2(tv * sw0, 0.f) & 0xffffu);
            *(LAS unsigned short*)(lds + L_TU + off) = (unsigned short)(cvtpk2(tv * su0, 0.f) & 0xffffu);
        }
    } else {
        for (int f = wid - 1; f < 32; f += 7) {
            bf16x8 v; float sc[8];
            if (f < 16) {
                const int mt = f >> 3, s = f & 7, row = 32 * mt + r;
                v = lds_perm8(lds + L_QS + (row * LQ) * 2, 32 * (s >> 1) + 16 * (s & 1), h2);
                const float e = gate[128 + row];
#pragma unroll
                for (int jj = 0; jj < 8; ++jj) sc[jj] = e;
            } else {
                const int kt = (f - 16) >> 2, s2 = (f - 16) & 3, row = 32 * kt + r, cb = 32 * (s2 >> 1) + 16 * (s2 & 1);
                v = lds_perm8(lds + L_KST + (row * LT) * 2, cb, h2);
#pragma unroll
                for (int jj = 0; jj < 8; ++jj) sc[jj] = gate[192 + cb + 8 * (jj >> 2) + 4 * h2 + (jj & 3)];
            }
            const u32x4 w = __builtin_bit_cast(u32x4, v);
            u32x4 o;
#pragma unroll
            for (int e = 0; e < 4; ++e) o[e] = cvtpk2(bflo_(w[e]) * sc[2 * e], bfhi_(w[e]) * sc[2 * e + 1]);
            *(u32x4*)(blob + (f < 16 ? 16 + f : 40 + (f - 16)) * 1024 + lane * 16) = o;
        }
    }
    __syncthreads();
    {
        const int kt = wid >> 1, mt = wid & 1;
        f32x16 wt = {}, ut = {};
        const int nks = mt == 0 ? 2 : 4;
        for (int ks = 0; ks < nks; ++ks) {
            wt = DN_MFMA(lds16(lds + L_KST + ((32 * kt + r) * LT + 16 * ks + 8 * h2) * 2), lds16(lds + L_TW + ((32 * mt + r) * LT + 16 * ks + 8 * h2) * 2), wt);
            ut = DN_MFMA(lds16(lds + L_TU + ((32 * mt + r) * LT + 16 * ks + 8 * h2) * 2), lds16(lds + L_VST + ((32 * kt + r) * LT + 16 * ks + 8 * h2) * 2), ut);
        }
#pragma unroll
        for (int i = 0; i < 16; ++i) wt[i] = -wt[i];
        *(u32x4*)(blob + (mt * 8 + 2 * kt + 0) * 1024 + lane * 16) = __builtin_bit_cast(u32x4, pack_acc<0>(wt));
        *(u32x4*)(blob + (mt * 8 + 2 * kt + 1) * 1024 + lane * 16) = __builtin_bit_cast(u32x4, pack_acc<1>(wt));
        unsigned char* uf = UF + (size_t)item * UF_BYTES + ((kt * 2 + mt) * 64 + lane) * 32;
        *(u32x4*)uf = __builtin_bit_cast(u32x4, pack_acc<0>(ut)); *(u32x4*)(uf + 16) = __builtin_bit_cast(u32x4, pack_acc<1>(ut));
    }
    __syncthreads();
}

constexpr int S_SLOT = 32768, S_END = 4 * S_SLOT;
DNI void glds16(const void* gsrc, LAS unsigned char* dst) { __builtin_amdgcn_global_load_lds((const GAS unsigned*)gsrc, (LAS unsigned*)dst, 16, 0, 0); }
DNI void scan_bh(LAS unsigned char* lds, int bh, const unsigned char* BLOB, const unsigned char* UF, const float* GL, unsigned char* SF, unsigned char* VF) {
    int tid = threadIdx.x; asm volatile("" : "+v"(tid));
    const int wid = __builtin_amdgcn_readfirstlane(tid >> 6), lane = tid & 63;
    const unsigned char* blob0 = BLOB + (size_t)bh * 64 * BLOB_BYTES;
    unsigned lane16 = (unsigned)lane * 16u; asm volatile("" : "+v"(lane16));
#define DN_B() do { __builtin_amdgcn_s_barrier(); asm volatile("" ::: "memory"); } while (0)
    if (wid >= 4) {
        const int lw = wid - 4;
#define DN_ISSUE(c) do { const unsigned char* bc_ = blob0 + (size_t)(c) * BLOB_BYTES + lw * 1024; LAS unsigned char* sl_ = lds + ((c) & 3) * S_SLOT + lw * 1024; _Pragma("unroll") for (int i_ = 0; i_ < 4; ++i_) { \
        glds16(bc_ + i_ * 4096 + lane16, sl_ + i_ * 4096); glds16(bc_ + 40960 + i_ * 4096 + lane16, sl_ + 16384 + i_ * 4096); } } while (0)
        DN_ISSUE(0); DN_ISSUE(1); DN_ISSUE(2);
        asm volatile("s_waitcnt vmcnt(16)" ::: "memory"); DN_B();
#pragma unroll 1
        for (int c = 0; c < 64; ++c) {
            if (c + 3 < 64) { DN_ISSUE(c + 3); asm volatile("s_waitcnt vmcnt(16)" ::: "memory"); }
            else if (c + 2 < 64) asm volatile("s_waitcnt vmcnt(8)" ::: "memory");
            else asm volatile("s_waitcnt vmcnt(0)" ::: "memory");
            DN_B();
        }
#undef DN_ISSUE
    } else {
        const float glv = GL[bh * 64 + lane];
        const unsigned char* uf0 = UF + (size_t)bh * 64 * UF_BYTES + (wid * 128 + lane) * 32;
        unsigned char* sf0 = SF + ((size_t)(bh * 64) * 4 + wid) * 8192 + lane * 16;
        unsigned char* vf0 = VF + ((size_t)(bh * 64) * 4 + wid) * 4096 + lane * 16;
        f32x16 S0 = {}, S1 = {}, S2 = {}, S3 = {};
        u32x4 ua[4], ub[4];
#define DN_ULOAD(U, c) do { const unsigned char* u_ = uf0 + (size_t)(c) * UF_BYTES; U[0] = *(const u32x4*)u_; U[1] = *(const u32x4*)(u_ + 16); U[2] = *(const u32x4*)(u_ + 2048); U[3] = *(const u32x4*)(u_ + 2048 + 16); } while (0)
        DN_ULOAD(ua, 0); DN_ULOAD(ub, 1);
        DN_B();
#define RD4(X, f0, f1, f2, f3) do { asm volatile("ds_read_b128 %0, %4 offset:%5\n\tds_read_b128 %1, %4 offset:%6\n\tds_read_b128 %2, %4 offset:%7\n\tds_read_b128 %3, %4 offset:%8" \
        : "=&v"(X##0), "=&v"(X##1), "=&v"(X##2), "=&v"(X##3) : "v"(fba), "i"((f0) * 1024), "i"((f1) * 1024), "i"((f2) * 1024), "i"((f3) * 1024)); __builtin_amdgcn_sched_barrier(0); } while (0)
#define PIN2(a, b) asm volatile("" : "+v"(a), "+v"(b))
#define PIN4(a, b, c, d) asm volatile("" : "+v"(a), "+v"(b), "+v"(c), "+v"(d))
#define LWAIT() do { asm volatile("s_waitcnt lgkmcnt(0)" ::: "memory"); __builtin_amdgcn_sched_barrier(0); } while (0)
#define DN_STEP(U, c) do { \
            const unsigned fba = (unsigned)(uintptr_t)(lds + ((c) & 3) * S_SLOT) + lane16; \
            const float gl = __builtin_bit_cast(float, __builtin_amdgcn_readlane(__builtin_bit_cast(int, glv), (c))); \
            f32x16 v0, v1; \
            _Pragma("unroll") for (int i = 0; i < 8; ++i) { v0[2 * i] = bflo_(U[i >> 2][i & 3]); v0[2 * i + 1] = bfhi_(U[i >> 2][i & 3]); v1[2 * i] = bflo_(U[2 + (i >> 2)][i & 3]); v1[2 * i + 1] = bfhi_(U[2 + (i >> 2)][i & 3]); } \
            PIN2(v0, v1); \
            if ((c) + 2 < 64) DN_ULOAD(U, (c) + 2); \
            asm volatile("s_waitcnt lgkmcnt(0)" ::: "memory"); \
            unsigned char* sfc = sf0 + (size_t)(c) * 32768; unsigned char* vfc = vf0 + (size_t)(c) * 16384; \
            bf16x8 A0, A1, A2, A3, B0, B1, B2, B3; \
            RD4(A, 0, 8, 1, 9); LWAIT(); \
              \
            { const bf16x8 s0_ = pack_acc<0>(S0), s1_ = pack_acc<1>(S0); *(u32x4*)(sfc) = __builtin_bit_cast(u32x4, s0_); *(u32x4*)(sfc + 1024) = __builtin_bit_cast(u32x4, s1_); RD4(B, 2, 10, 3, 11); \
              v0 = DN_MFMA(A0, s0_, v0); v1 = DN_MFMA(A1, s0_, v1); v0 = DN_MFMA(A2, s1_, v0); v1 = DN_MFMA(A3, s1_, v1); PIN2(v0, v1); LWAIT(); } \
            { const bf16x8 s0_ = pack_acc<0>(S1), s1_ = pack_acc<1>(S1); *(u32x4*)(sfc + 2048) = __builtin_bit_cast(u32x4, s0_); *(u32x4*)(sfc + 3072) = __builtin_bit_cast(u32x4, s1_); RD4(A, 4, 12, 5, 13); \
              v0 = DN_MFMA(B0, s0_, v0); v1 = DN_MFMA(B1, s0_, v1); v0 = DN_MFMA(B2, s1_, v0); v1 = DN_MFMA(B3, s1_, v1); PIN2(v0, v1); LWAIT(); } \
            { const bf16x8 s0_ = pack_acc<0>(S2), s1_ = pack_acc<1>(S2); *(u32x4*)(sfc + 4096) = __builtin_bit_cast(u32x4, s0_); *(u32x4*)(sfc + 5120) = __builtin_bit_cast(u32x4, s1_); RD4(B, 6, 14, 7, 15); \
              v0 = DN_MFMA(A0, s0_, v0); v1 = DN_MFMA(A1, s0_, v1); v0 = DN_MFMA(A2, s1_, v0); v1 = DN_MFMA(A3, s1_, v1); PIN2(v0, v1); LWAIT(); } \
            { const bf16x8 s0_ = pack_acc<0>(S3), s1_ = pack_acc<1>(S3); *(u32x4*)(sfc + 6144) = __builtin_bit_cast(u32x4, s0_); *(u32x4*)(sfc + 7168) = __builtin_bit_cast(u32x4, s1_); RD4(A, 16, 20, 24, 28); \
              v0 = DN_MFMA(B0, s0_, v0); v1 = DN_MFMA(B1, s0_, v1); v0 = DN_MFMA(B2, s1_, v0); v1 = DN_MFMA(B3, s1_, v1); PIN2(v0, v1); LWAIT(); } \
            const bf16x8 vf0_ = pack_acc<0>(v0), vf1_ = pack_acc<1>(v0), vf2_ = pack_acc<0>(v1), vf3_ = pack_acc<1>(v1); \
            *(u32x4*)(vfc) = __builtin_bit_cast(u32x4, vf0_); *(u32x4*)(vfc + 1024) = __builtin_bit_cast(u32x4, vf1_); *(u32x4*)(vfc + 2048) = __builtin_bit_cast(u32x4, vf2_); *(u32x4*)(vfc + 3072) = __builtin_bit_cast(u32x4, vf3_); \
            _Pragma("unroll") for (int i = 0; i < 16; ++i) { S0[i] *= gl; S1[i] *= gl; S2[i] *= gl; S3[i] *= gl; } \
              \
            RD4(B, 17, 21, 25, 29); \
            S0 = DN_MFMA(A0, vf0_, S0); S1 = DN_MFMA(A1, vf0_, S1); S2 = DN_MFMA(A2, vf0_, S2); S3 = DN_MFMA(A3, vf0_, S3); PIN4(S0, S1, S2, S3); LWAIT(); \
            RD4(A, 18, 22, 26, 30); \
            S0 = DN_MFMA(B0, vf1_, S0); S1 = DN_MFMA(B1, vf1_, S1); S2 = DN_MFMA(B2, vf1_, S2); S3 = DN_MFMA(B3, vf1_, S3); PIN4(S0, S1, S2, S3); LWAIT(); \
            RD4(B, 19, 23, 27, 31); \
            S0 = DN_MFMA(A0, vf2_, S0); S1 = DN_MFMA(A1, vf2_, S1); S2 = DN_MFMA(A2, vf2_, S2); S3 = DN_MFMA(A3, vf2_, S3); PIN4(S0, S1, S2, S3); LWAIT(); \
            S0 = DN_MFMA(B0, vf3_, S0); S1 = DN_MFMA(B1, vf3_, S1); S2 = DN_MFMA(B2, vf3_, S2); S3 = DN_MFMA(B3, vf3_, S3); PIN4(S0, S1, S2, S3); \
            __builtin_amdgcn_sched_barrier(0); \
            DN_B(); } while (0)
#pragma unroll 1
        for (int c = 0; c < 64; c += 2) { DN_STEP(ua, c); DN_STEP(ub, c + 1); }
#undef DN_STEP
#undef RD4
#undef PIN2
#undef PIN4
#undef LWAIT
#undef DN_ULOAD
    }
    __syncthreads();
#undef DN_B
}

constexpr int O_OT = 0, O_NW = 2 * 64 * LQ * 2, O_END = O_NW + 512;
DNI void chunk_out(LAS unsigned char* lds, int item, const unsigned char* BLOB, const unsigned char* SF, const unsigned char* VF, const bf16* DNZ, const float* norm_w, bf16* Y) {
    int tid = threadIdx.x; asm volatile("" : "+v"(tid));
    const int wid = __builtin_amdgcn_readfirstlane(tid >> 6), lane = tid & 63, r = lane & 31, h2 = lane >> 5, half = wid >> 2, w = wid & 3;
    const int ck = 2 * item + half;
    const int n = ck & 63, hd = (ck >> 6) & 3, b = ck >> 8;
    if (tid < 128) ((LAS float*)(lds + O_NW))[tid] = norm_w[tid];
    const unsigned char* blob = BLOB + (size_t)ck * BLOB_BYTES + lane * 16;
    const unsigned char* sfp = SF + ((size_t)ck * 4 + w) * 8192 + lane * 16;
    const unsigned char* vfp = VF + ((size_t)ck * 4 + w) * 4096 + lane * 16;
    f32x16 o0 = {}, o1 = {};
#define GF(f) (*(const bf16x8*)(blob + (f) * 1024))
#pragma unroll
    for (int s = 0; s < 8; ++s) { const bf16x8 sf = *(const bf16x8*)(sfp + s * 1024); o0 = DN_MFMA(GF(16 + s), sf, o0); o1 = DN_MFMA(GF(24 + s), sf, o1); }
#pragma unroll
    for (int s2 = 0; s2 < 4; ++s2) { const bf16x8 vf = *(const bf16x8*)(vfp + s2 * 1024); o0 = DN_MFMA(GF(32 + s2), vf, o0); o1 = DN_MFMA(GF(36 + s2), vf, o1); }
#undef GF
    {
        LAS unsigned char* obp = lds + O_OT + half * (64 * LQ * 2) + ((4 * h2) * LQ + 32 * w + r) * 2;
#pragma unroll
        for (int i = 0; i < 16; ++i) {
            *(LAS unsigned short*)(obp + ((i & 3) + 8 * (i >> 2)) * (LQ * 2)) = (unsigned short)(cvtpk2(o0[i], 0.f) & 0xffffu);
            *(LAS unsigned short*)(obp + (32 + (i & 3) + 8 * (i >> 2)) * (LQ * 2)) = (unsigned short)(cvtpk2(o1[i], 0.f) & 0xffffu);
        }
    }
    __syncthreads();
    {
        const int t4 = tid & 255, pos = t4 >> 2, seg = t4 & 3;
        const LAS unsigned char* op = lds + O_OT + half * (64 * LQ * 2) + (pos * LQ + seg * 32) * 2;
        u32x4 wv[4];
#pragma unroll
        for (int q = 0; q < 4; ++q) wv[q] = *(const LAS u32x4*)(op + q * 16);
        float ss = 0.f;
#pragma unroll
        for (int q = 0; q < 4; ++q)
#pragma unroll
            for (int e = 0; e < 4; ++e) { const float a = bflo_(wv[q][e]), c = bfhi_(wv[q][e]); ss += a * a + c * c; }
        ss += __shfl_xor(ss, 1); ss += __shfl_xor(ss, 2);
        const float rs = rsqrtf(ss * (1.f / 128.f) + 1e-6f);
        const size_t m = (size_t)b * 4096 + (size_t)n * 64 + pos;
        const bf16* zp = DNZ + m * 512 + hd * 128 + seg * 32; bf16* yp = Y + m * 1024 + hd * 128 + seg * 32; const LAS float* nw = (const LAS float*)(lds + O_NW) + seg * 32;
#pragma unroll
        for (int q = 0; q < 4; ++q) {
            const u32x4 z = *(const u32x4*)(zp + q * 8); u32x4 o;
#pragma unroll
            for (int e = 0; e < 4; ++e) {
                const float z0 = bflo_(z[e]), z1 = bfhi_(z[e]);
                o[e] = cvtpk2(bflo_(wv[q][e]) * rs * nw[q * 8 + 2 * e] * (z0 / (1.f + __expf(-z0))), bfhi_(wv[q][e]) * rs * nw[q * 8 + 2 * e + 1] * (z1 / (1.f + __expf(-z1))));
            }
            *(u32x4*)(yp + q * 8) = o;
        }
    }
    __syncthreads();
}
#undef DN_MFMA
#undef DNI
}
constexpr int NWAVES = 8, NTHR = NWAVES * 64;
constexpr int BATCH = 4, SEQ = 4096, DM = 1024, M = BATCH * SEQ;
constexpr int HD = 128, NH = 4, DDN = 512, DMB = 512, NPROJ = 3584, DINP = 3592;
constexpr int MBLK = 256, NBLK = SEQ / MBLK;
constexpr int NE = 16, DE = 256;
constexpr float LN_EPS = 1e-5f, RMS_EPS = 1e-6f, ALPHA = 1.189207115002721f, QSCALE = 0.08838834764831845f;

constexpr size_t MiB = 1u << 20;
constexpr size_t WS_CTL = 0, CTL_ZERO_BYTES = 1 * MiB;
constexpr size_t WS_WIN = 2 * MiB;
constexpr size_t WS_WOUT = 10 * MiB;
constexpr size_t WS_WGU = 12 * MiB;
constexpr size_t WS_WD = 28 * MiB;
constexpr size_t WS_ROPE = 36 * MiB;
constexpr size_t WS_KMP = 38 * MiB;
constexpr size_t WS_GATES = 39 * MiB;
constexpr size_t WS_BETA = WS_GATES + 512 * 1024;
constexpr size_t WS_GLOG = WS_BETA + 256 * 1024;
constexpr size_t WS_XB = 48 * MiB;
constexpr size_t WS_DNQN = 48 * MiB, WS_DNKN = 64 * MiB;
constexpr size_t WS_PJ = 80 * MiB;
constexpr size_t PJ_STRIDE = 16 * MiB;
constexpr size_t WS_Y = 192 * MiB;
constexpr size_t WS_DNVN = 224 * MiB;
constexpr size_t WS_GL = 40 * MiB;
constexpr size_t WS_SF = 48 * MiB;
constexpr size_t WS_VF = 224 * MiB;
constexpr size_t WS_UF = 240 * MiB;
constexpr size_t WS_TOKE = 41 * MiB;
constexpr size_t WS_TOKP = WS_TOKE + 256 * 1024;
constexpr size_t WS_TOKW = WS_TOKP + 256 * 1024;
constexpr size_t WS_HB = 48 * MiB;
constexpr size_t WS_HS = 80 * MiB;
constexpr size_t WS_HE = 152 * MiB;
constexpr size_t WS_Y2 = 170 * MiB;
constexpr size_t WS_END = 256 * MiB;
constexpr int CW_CNT = 64;
constexpr int CW_SEAM = 16384;
constexpr size_t WS_XBUF = 42 * MiB;
constexpr int CW_BAR = 4096;

constexpr int RING_OFF = 0, RING_BYTES = 139264;
constexpr int LDSCTL_OFF = RING_BYTES, MISC_OFF = LDSCTL_OFF + 320;
constexpr int LDS_BYTES = 147456;

#define DI __device__ __forceinline__
DI float bf2f(unsigned short v) { return __uint_as_float((unsigned)v << 16); }
DI float bflo(unsigned w) { return __uint_as_float(w << 16); }
DI float bfhi(unsigned w) { return __uint_as_float(w & 0xffff0000u); }
DI float wave_sum(float v) {
#pragma unroll
    for (int o = 1; o < 64; o <<= 1) v += __shfl_xor(v, o);
    return v;
}
DI float wave_max(float v) {
#pragma unroll
    for (int o = 1; o < 64; o <<= 1) v = fmaxf(v, __shfl_xor(v, o));
    return v;
}
DI float silu_f(float v) { return v / (1.f + __expf(-v)); }
DI float softplus_f(float v) { return fmaxf(v, 0.f) + log1pf(__expf(-fabsf(v))); }

struct Args {
    const GAS float* in_[18]; GAS float* out_; GAS unsigned char* ws_; int ph_lo, ph_hi;
    DI const float* I(int k) const { return (const float*)in_[k]; }
    DI float* O() const { return (float*)out_; }
    DI unsigned char* W() const { return (unsigned char*)ws_; }
};
#define CAS __attribute__((address_space(4)))
struct KA {
    const CAS unsigned char* p;
    DI const float* I(int k) const { return (const float*)(*(const GAS float* const CAS*)(p + 8 * k)); }
    DI float* O() const { return (float*)(*(GAS float* const CAS*)(p + 144)); }
    DI unsigned char* W() const { return (unsigned char*)(*(GAS unsigned char* const CAS*)(p + 152)); }
    DI int lo() const { return *(const CAS int*)(p + 160); }
    DI int hi() const { return *(const CAS int*)(p + 164); }
};
static_assert(offsetof(Args, out_) == 144 && offsetof(Args, ws_) == 152 && offsetof(Args, ph_lo) == 160 && offsetof(Args, ph_hi) == 164, "Args layout");
DI KA kargs() { KA a; a.p = (const CAS unsigned char*)__builtin_amdgcn_kernarg_segment_ptr(); asm volatile("" : "+s"(a.p)); return a; }
struct Frame {
    LAS unsigned char* lds;
    int tid, lane, wave, vcu, G;
};

DI void p0_transpose_item(const float* W, int ldw, int src_col0, int K, bf16* WT, int dst_row0, LAS float* scr, int kb, int nb, int lane) {
    const int k0 = 64 * kb, n0 = 32 * nb;
#pragma unroll 8
    for (int i = 0; i < 32; ++i) { const int kk = 2 * i + (lane >> 5); scr[kk * 33 + (lane & 31)] = W[(size_t)(k0 + kk) * ldw + src_col0 + n0 + (lane & 31)]; }
    LDS_WAIT(); asm volatile("" ::: "memory");
    const int c = lane & 7;
#pragma unroll
    for (int j = 0; j < 4; ++j) { const int n = (lane >> 3) + 8 * j; const LAS float* s = scr + (8 * c) * 33 + n;
        v4u o; o.x = pk2(s[0 * 33], s[1 * 33]); o.y = pk2(s[2 * 33], s[3 * 33]); o.z = pk2(s[4 * 33], s[5 * 33]); o.w = pk2(s[6 * 33], s[7 * 33]);
        *(GAS v4u*)(WT + (size_t)(dst_row0 + n0 + n) * K + k0 + 8 * c) = o; }
    LDS_WAIT(); asm volatile("" ::: "memory");
}

DI void p0_prologue(const Frame& F, const KA& A) {
    unsigned char* ws = A.W();
    const float* x = A.I(0); const float* w_in = A.I(1); const float* w_out = A.I(6);
    const int gw = F.vcu * NWAVES + F.wave, NGW = F.G * NWAVES;
    {
        LAS float* wgl = (LAS float*)(F.lds + RING_OFF);
        for (int i = F.tid; i < 1024 * 8; i += NTHR) wgl[i] = w_in[(size_t)(i >> 3) * DINP + 2048 + (i & 7)];
        __syncthreads();
        bf16* XB = (bf16*)(ws + WS_XB); float* GATES = (float*)(ws + WS_GATES);
        for (int m = gw; m < M; m += NGW) {
            const GAS f32x4* xr = (const GAS f32x4*)(x + (size_t)m * DM) + F.lane;
            f32x4 v[4];
#pragma unroll
            for (int j = 0; j < 4; ++j) v[j] = xr[64 * j];
            GAS unsigned long long* o8 = (GAS unsigned long long*)(XB + (size_t)m * DM) + F.lane;
            float g[8];
#pragma unroll
            for (int q = 0; q < 8; ++q) g[q] = 0.f;
#pragma unroll
            for (int j = 0; j < 4; ++j) {
                o8[64 * j] = (unsigned long long)pk2(v[j].x, v[j].y) | ((unsigned long long)pk2(v[j].z, v[j].w) << 32);
#pragma unroll
                for (int e = 0; e < 4; ++e) { const int k = 256 * j + 4 * F.lane + e; const float xv = v[j][e];
                    const f32x4 w0 = *(const LAS f32x4*)(wgl + k * 8), w1 = *(const LAS f32x4*)(wgl + k * 8 + 4);
                    g[0] += xv * w0.x; g[1] += xv * w0.y; g[2] += xv * w0.z; g[3] += xv * w0.w;
                    g[4] += xv * w1.x; g[5] += xv * w1.y; g[6] += xv * w1.z; g[7] += xv * w1.w; }
            }
#pragma unroll
            for (int q = 0; q < 8; ++q) g[q] = wave_sum(g[q]);
            if (F.lane == 0) {
#pragma unroll
                for (int q = 0; q < 8; ++q) GATES[(size_t)m * 8 + q] = g[q];
            }
        }
        __syncthreads();
    }
    {
        LAS float* scr = (LAS float*)(F.lds + RING_OFF + F.wave * 16384);
        bf16* WIN = (bf16*)(ws + WS_WIN); bf16* WOUT = (bf16*)(ws + WS_WOUT);
        constexpr int I_A = 16 * 64, I_B = 16 * 48, I_O = 16 * 32, I_GU = NE * 4 * 64, I_D = NE * 128;
        const float* wgate = A.I(13); const float* wup = A.I(14); const float* wdn = A.I(15);
        bf16* WGU = (bf16*)(ws + WS_WGU); bf16* WD = (bf16*)(ws + WS_WD);
        for (int it = gw; it < I_A + I_B + I_O + I_GU + I_D; it += NGW) {
            int r = it;
            if (r < I_A) { p0_transpose_item(w_in, DINP, 0, DM, WIN, 0, scr, r / 64, r % 64, F.lane); continue; } r -= I_A;
            if (r < I_B) { p0_transpose_item(w_in, DINP, 2056, DM, WIN, 2048, scr, r / 48, r % 48, F.lane); continue; } r -= I_B;
            if (r < I_O) { p0_transpose_item(w_out, DM, 0, DM, WOUT, 0, scr, r / 32, r % 32, F.lane); continue; } r -= I_O;
            if (r < I_GU) {
                const int e = r >> 8, q = (r >> 6) & 3, pn = q >> 1, up = q & 1, kb = (r >> 2) & 15, nb = r & 3;
                p0_transpose_item((up ? wup : wgate) + (size_t)e * DM * DE, DE, pn * 128, DM, WGU, e * 512 + pn * 256 + up * 128, scr, kb, nb, F.lane); continue; } r -= I_GU;
            { const int e = r >> 7, kb = (r >> 5) & 3, nb = r & 31;
              p0_transpose_item(wdn + (size_t)e * DE * DM, DM, 0, DE, WD + (size_t)e * DM * DE, 0, scr, kb, nb, F.lane); }
        }
    }
    {
        float2* ROPE = (float2*)(ws + WS_ROPE);
        for (int i = (F.vcu * NTHR + F.tid); i < SEQ * 64; i += F.G * NTHR) {
            const int pos = i >> 6, j = i & 63;
            const float inv = exp2f(-(float)j * (13.287712379549449f / 64.f));
            const float ang = (float)pos * inv;
            double rev = (double)ang * 0.15915494309189535; rev -= __builtin_rint(rev);
            const float rr = (float)rev;
            ROPE[i] = make_float2(__builtin_amdgcn_cosf(rr), __builtin_amdgcn_sinf(rr));
        }
    }
}

DI void n2a_conv_norm(const Frame& F, const KA& A) {
    unsigned char* ws = A.W();
    const float* conv_w = A.I(2); const float* a_log = A.I(3); const float* dt_bias = A.I(4);
    const bf16* PJ = (const bf16*)(ws + WS_PJ);
    bf16* OUTX[3] = {(bf16*)(ws + WS_DNQN), (bf16*)(ws + WS_DNKN), (bf16*)(ws + WS_DNVN)};
    const float* GATES = (const float*)(ws + WS_GATES); float* BETA = (float*)(ws + WS_BETA); float* GLOG = (float*)(ws + WS_GLOG);
    const int gw = F.vcu * NWAVES + F.wave, NGW = F.G * NWAVES;
    for (int it = gw; it < M * NH; it += NGW) {
        const int m = it >> 2, h = it & 3, t = m & (SEQ - 1), c = 2 * F.lane;
        float val[3][2];
#pragma unroll
        for (int X = 0; X < 3; ++X) {
            float a0 = 0.f, a1 = 0.f;
#pragma unroll
            for (int j = 0; j < 4; ++j) {
                const int tt = t - 3 + j;
                if (tt >= 0) {
                    const unsigned raw = *(const unsigned*)(PJ + X * (PJ_STRIDE / 2) + (size_t)(m - 3 + j) * 512 + h * 128 + c);
                    const float w0 = conv_w[j * 1536 + X * 512 + h * 128 + c], w1 = conv_w[j * 1536 + X * 512 + h * 128 + c + 1];
                    a0 += w0 * bflo(raw); a1 += w1 * bfhi(raw);
                }
            }
            val[X][0] = silu_f(a0); val[X][1] = silu_f(a1);
        }
        const float sq = wave_sum(val[0][0] * val[0][0] + val[0][1] * val[0][1]);
        const float sk = wave_sum(val[1][0] * val[1][0] + val[1][1] * val[1][1]);
        const float rq = rsqrtf(sq + 1e-6f) * QSCALE, rk = rsqrtf(sk + 1e-6f);
        val[0][0] *= rq; val[0][1] *= rq; val[1][0] *= rk; val[1][1] *= rk;
#pragma unroll
        for (int X = 0; X < 3; ++X) *(unsigned*)(OUTX[X] + (size_t)m * 512 + h * 128 + c) = pk2(val[X][0], val[X][1]);
        if (F.lane == 0) {
            const float bb = GATES[(size_t)m * 8 + h], aa = GATES[(size_t)m * 8 + 4 + h];
            BETA[(size_t)m * 4 + h] = 1.f / (1.f + __expf(-bb));
            GLOG[(size_t)m * 4 + h] = -__expf(a_log[h]) * softplus_f(aa + dt_bias[h]);
        }
    }
}

DI void rope8(bf16* p, const float2* rp, float* s1, float* s2) {
    const v4u lo = *(const v4u*)p, hi = *(const v4u*)(p + 64);
    const f32x4 c0 = *(const f32x4*)rp, c1 = *(const f32x4*)(rp + 2), c2 = *(const f32x4*)(rp + 4), c3 = *(const f32x4*)(rp + 6);
    const float cs[8] = {c0.x, c0.z, c1.x, c1.z, c2.x, c2.z, c3.x, c3.z}, sn[8] = {c0.y, c0.w, c1.y, c1.w, c2.y, c2.w, c3.y, c3.w};
    float r1[8], r2[8];
#pragma unroll
    for (int e = 0; e < 4; ++e) {
        const float a0 = bflo(lo[e]), a1 = bfhi(lo[e]), b0 = bflo(hi[e]), b1 = bfhi(hi[e]);
        r1[2 * e] = a0 * cs[2 * e] - b0 * sn[2 * e]; r2[2 * e] = b0 * cs[2 * e] + a0 * sn[2 * e];
        r1[2 * e + 1] = a1 * cs[2 * e + 1] - b1 * sn[2 * e + 1]; r2[2 * e + 1] = b1 * cs[2 * e + 1] + a1 * sn[2 * e + 1];
    }
    v4u o1, o2;
#pragma unroll
    for (int e = 0; e < 4; ++e) { o1[e] = pk2(r1[2 * e], r1[2 * e + 1]); o2[e] = pk2(r2[2 * e], r2[2 * e + 1]); }
    *(v4u*)p = o1; *(v4u*)(p + 64) = o2;
    if (s1) {
#pragma unroll
        for (int e = 0; e < 8; ++e) { s1[e] += r1[e]; s2[e] += r2[e]; }
    }
}
DI void n3a_rope(const Frame& F, const KA& A) {
    unsigned char* ws = A.W();
    bf16* MBQ = (bf16*)(ws + WS_PJ + 4 * PJ_STRIDE); bf16* MBK = (bf16*)(ws + WS_PJ + 5 * PJ_STRIDE);
    const float2* ROPE = (const float2*)(ws + WS_ROPE); float* KMP = (float*)(ws + WS_KMP);
    const int gw = F.vcu * NWAVES + F.wave, NGW = F.G * NWAVES, rr = F.lane >> 3, dseg = F.lane & 7;
    for (int it = gw; it < 1024; it += NGW) {
        const int qtr = it & 3, j = (it >> 2) & 15, h = (it >> 6) & 3, b = it >> 8;
        float s1[8], s2[8];
#pragma unroll
        for (int e = 0; e < 8; ++e) { s1[e] = 0.f; s2[e] = 0.f; }
#pragma unroll 2
        for (int r8 = 0; r8 < 8; ++r8) {
            const int pos = j * 256 + qtr * 64 + r8 * 8 + rr; const size_t m = (size_t)b * SEQ + pos;
            rope8(MBK + m * 512 + h * 128 + dseg * 8, ROPE + pos * 64 + dseg * 8, s1, s2);
        }
#pragma unroll
        for (int e = 0; e < 8; ++e) { s1[e] += __shfl_xor(s1[e], 8); s1[e] += __shfl_xor(s1[e], 16); s1[e] += __shfl_xor(s1[e], 32);
                                      s2[e] += __shfl_xor(s2[e], 8); s2[e] += __shfl_xor(s2[e], 16); s2[e] += __shfl_xor(s2[e], 32); }
        if (rr == 0) {
#pragma unroll
            for (int e = 0; e < 8; ++e) { KMP[(size_t)it * 128 + dseg * 8 + e] = s1[e]; KMP[(size_t)it * 128 + 64 + dseg * 8 + e] = s2[e]; }
        }
    }
    for (int it = gw; it < (M / 8) * NH; it += NGW) {
        const int m8 = it >> 2, h = it & 3; const size_t m = (size_t)m8 * 8 + rr; const int pos = (int)(m & (SEQ - 1));
        rope8(MBQ + m * 512 + h * 128 + dseg * 8, ROPE + pos * 64 + dseg * 8, nullptr, nullptr);
    }
}

DI void n2b_dn_recurrent(const Frame& F, const KA& A, int item, float* ODN) {
    unsigned char* ws = A.W();
    const bf16* QN = (const bf16*)(ws + WS_DNQN); const bf16* KN = (const bf16*)(ws + WS_DNKN); const bf16* VN = (const bf16*)(ws + WS_DNVN);
    const float* BETA = (const float*)(ws + WS_BETA); const float* GLOG = (const float*)(ws + WS_GLOG);
    const int b = item >> 2, h = item & 3;
    LAS float* qs = (LAS float*)(F.lds + RING_OFF);
    LAS float* ks = qs + 16 * 128; LAS float* vs = ks + 16 * 128; LAS float* bs = vs + 16 * 128; LAS float* as = bs + 16;
    float S[128];
#pragma unroll
    for (int k = 0; k < 128; ++k) S[k] = 0.f;
    for (int t0 = 0; t0 < SEQ; t0 += 16) {
        __syncthreads();
        for (int idx = F.tid; idx < 16 * 384; idx += NTHR) {
            const int r = idx / 384, c = idx % 384, X = c >> 7, cc = c & 127; const size_t m = (size_t)b * SEQ + t0 + r;
            const bf16* src = X == 0 ? QN : (X == 1 ? KN : VN);
            (X == 0 ? qs : (X == 1 ? ks : vs))[r * 128 + cc] = bf2f(src[m * 512 + h * 128 + cc]);
        }
        if (F.tid < 16) { const size_t m = (size_t)b * SEQ + t0 + F.tid; bs[F.tid] = BETA[m * 4 + h]; as[F.tid] = __expf(GLOG[m * 4 + h]); }
        __syncthreads();
        if (F.tid < 128) {
#pragma unroll 1
            for (int r = 0; r < 16; ++r) {
                const LAS float* kr = ks + r * 128; const LAS float* qr = qs + r * 128;
                float kS = 0.f;
#pragma unroll
                for (int kb = 0; kb < 128; kb += 16) {
#pragma unroll
                    for (int k = 0; k < 16; ++k) kS += kr[kb + k] * S[kb + k];
                    asm volatile("" ::: "memory");
                }
                const float al = as[r], be = bs[r];
                const float vn = be * (vs[r * 128 + F.tid] - al * kS);
                float o = 0.f;
#pragma unroll
                for (int kb = 0; kb < 128; kb += 16) {
#pragma unroll
                    for (int k = 0; k < 16; ++k) { S[kb + k] = al * S[kb + k] + kr[kb + k] * vn; o += qr[kb + k] * S[kb + k]; }
                    asm volatile("" ::: "memory");
                }
                ODN[((size_t)b * SEQ + t0 + r) * 512 + h * 128 + F.tid] = o;
            }
        }
    }
}

DI void n3b_moba_naive(const Frame& F, const KA& A, int w0, int nw, bf16* Yo, int ypitch, int ycol0) {
    unsigned char* ws = A.W();
    const bf16* MBQ = (const bf16*)(ws + WS_PJ + 4 * PJ_STRIDE); const bf16* MBK = (const bf16*)(ws + WS_PJ + 5 * PJ_STRIDE); const bf16* MBV = (const bf16*)(ws + WS_PJ + 6 * PJ_STRIDE);
    const float* KMP = (const float*)(ws + WS_KMP);
    LAS float* qs = (LAS float*)(F.lds + RING_OFF + 32768) + F.wave * 128;
    const int lane = F.lane;
    for (int it = w0; it < M * NH; it += nw) {
        const int m = it >> 2, h = it & 3, b = m >> 12, t = m & (SEQ - 1), own = t >> 8;
        { const unsigned raw = *(const unsigned*)(MBQ + (size_t)m * 512 + h * 128 + 2 * lane); qs[2 * lane] = bflo(raw) * QSCALE; qs[2 * lane + 1] = bfhi(raw) * QSCALE; }
        asm volatile("s_waitcnt lgkmcnt(0)" ::: "memory");
        float gate = -3e38f;
        if (lane < own) {
            const float* kp = KMP + (size_t)(((b * 4 + h) * 16 + lane) * 4) * 128; float acc = 0.f;
            for (int dd = 0; dd < 128; ++dd) acc += qs[dd] * ((kp[dd] + kp[128 + dd]) + (kp[256 + dd] + kp[384 + dd]));
            gate = acc * (1.f / 256.f);
        }
        int blist[4] = {-1, -1, -1, own};
#pragma unroll
        for (int r = 0; r < 3; ++r) {
            const float mx = wave_max(gate);
            if (mx > -1e37f) {
                const unsigned long long bal = __ballot(gate == mx); const int idx = __builtin_ctzll(bal);
                blist[r] = idx; if (lane == idx) gate = -3e38f;
            }
        }
        float sc[4][4]; float mloc = -3e38f;
#pragma unroll
        for (int s = 0; s < 4; ++s) {
            const int jb = blist[s];
#pragma unroll
            for (int i = 0; i < 4; ++i) {
                float v = -3e38f;
                if (jb >= 0) {
                    const int key = jb * 256 + i * 64 + lane;
                    if (s < 3 || key <= t) {
                        const bf16* kp = MBK + ((size_t)b * SEQ + key) * 512 + h * 128; float acc = 0.f;
#pragma unroll 4
                        for (int c8 = 0; c8 < 16; ++c8) { const v4u w = *(const v4u*)(kp + c8 * 8); const LAS float* q8 = qs + c8 * 8;
                            acc += q8[0] * bflo(w.x) + q8[1] * bfhi(w.x) + q8[2] * bflo(w.y) + q8[3] * bfhi(w.y) + q8[4] * bflo(w.z) + q8[5] * bfhi(w.z) + q8[6] * bflo(w.w) + q8[7] * bfhi(w.w); }
                        v = acc;
                    }
                }
                sc[s][i] = v; mloc = fmaxf(mloc, v);
            }
        }
        const float mx = wave_max(mloc); float lsum = 0.f;
#pragma unroll
        for (int s = 0; s < 4; ++s)
#pragma unroll
            for (int i = 0; i < 4; ++i) { const float p = sc[s][i] > -1e37f ? __expf(sc[s][i] - mx) : 0.f; sc[s][i] = p; lsum += p; }
        const float l = wave_sum(lsum);
        float o0 = 0.f, o1 = 0.f;
#pragma unroll
        for (int s = 0; s < 4; ++s) {
            const int jb = blist[s];
            if (jb >= 0) {
#pragma unroll
                for (int i = 0; i < 4; ++i) {
                    const bf16* vp = MBV + ((size_t)b * SEQ + jb * 256 + i * 64) * 512 + h * 128 + 2 * lane;
                    for (int src = 0; src < 64; ++src) {
                        const float pv = __shfl(sc[s][i], src);
                        if (pv != 0.f) { const unsigned raw = *(const unsigned*)(vp + (size_t)src * 512); o0 += pv * bflo(raw); o1 += pv * bfhi(raw); }
                    }
                }
            }
        }
        const float il = 1.f / l;
        *(unsigned*)(Yo + (size_t)m * ypitch + ycol0 + h * 128 + 2 * lane) = pk2(o0 * il, o1 * il);
        asm volatile("s_waitcnt lgkmcnt(0)" ::: "memory");
    }
}

DI void n2c_dn_gate(const Frame& F, const KA& A, const float* ODN, bf16* Yo, int ypitch) {
    unsigned char* ws = A.W();
    const float* norm_w = A.I(5); const bf16* DNZ = (const bf16*)(ws + WS_PJ + 3 * PJ_STRIDE);
    const int gw = F.vcu * NWAVES + F.wave, NGW = F.G * NWAVES, c = 2 * F.lane;
    for (int it = gw; it < M * NH; it += NGW) {
        const int m = it >> 2, h = it & 3;
        const float2 o = *(const float2*)(ODN + (size_t)m * 512 + h * 128 + c);
        const float ss = wave_sum(o.x * o.x + o.y * o.y) * (1.f / 128.f);
        const float rs = rsqrtf(ss + RMS_EPS);
        const unsigned zr = *(const unsigned*)(DNZ + (size_t)m * 512 + h * 128 + c);
        *(unsigned*)(Yo + (size_t)m * ypitch + h * 128 + c) = pk2(o.x * rs * norm_w[c] * silu_f(bflo(zr)), o.y * rs * norm_w[c + 1] * silu_f(bfhi(zr)));
    }
}

constexpr int CW_DBG = 16;
DI void dbg_compare(const Frame& F, unsigned char* ws, const bf16* T, int tp, int tc0, const bf16* R, int rp, int rc0) {
    float sd = 0.f, sr = 0.f;
    for (int i = F.vcu * NTHR + F.tid; i < M * 256; i += F.G * NTHR) {
        const int m = i >> 8, c = (i & 255) * 2;
        const unsigned a = *(const unsigned*)(T + (size_t)m * tp + tc0 + c), b = *(const unsigned*)(R + (size_t)m * rp + rc0 + c);
        const float d0 = bflo(a) - bflo(b), d1 = bfhi(a) - bfhi(b); sd += d0 * d0 + d1 * d1; sr += bflo(b) * bflo(b) + bfhi(b) * bfhi(b);
    }
    sd = wave_sum(sd); sr = wave_sum(sr);
    if (F.lane == 0) { atomicAdd((float*)(ws + WS_CTL) + CW_DBG, sd); atomicAdd((float*)(ws + WS_CTL) + CW_DBG + 1, sr); }
}
DI float block_sum(float v, LAS float* red, int tid) {
    v = wave_sum(v);
    __syncthreads();
    if ((tid & 63) == 0) red[tid >> 6] = v;
    __syncthreads();
    float s = 0.f;
#pragma unroll
    for (int w = 0; w < NWAVES; ++w) s += red[w];
    return s;
}

DI void n5_token_tail(const Frame& F, const KA& A) {
    const float* x = A.I(0); const float* g1 = A.I(7); const float* b1 = A.I(8);
    const float* rw1 = A.I(9); const float* rb1 = A.I(10); const float* rw2 = A.I(11); const float* rb2 = A.I(12);
    const float* wg = A.I(13); const float* wu = A.I(14); const float* wd = A.I(15); const float* g2 = A.I(16); const float* b2 = A.I(17);
    float* out = A.O();
    LAS float* hs = (LAS float*)(F.lds + RING_OFF);
    LAS float* hes = hs + 1024;
    LAS float* lg = hes + 512;
    LAS float* red = lg + 32;
    LAS float* rt_ = red + 8;
    const int tid = F.tid;
    for (int m = blockIdx.x; m < M; m += F.G) {
        __syncthreads();
        const size_t ro = (size_t)m * DM;
        float v0 = ALPHA * x[ro + tid] + out[ro + tid], v1 = ALPHA * x[ro + tid + 512] + out[ro + tid + 512];
        const float mean = block_sum(v0 + v1, red, tid) * (1.f / DM);
        v0 -= mean; v1 -= mean;
        const float var = block_sum(v0 * v0 + v1 * v1, red, tid) * (1.f / DM);
        const float rstd = rsqrtf(var + LN_EPS);
        const float h0 = v0 * rstd * g1[tid] + b1[tid], h1 = v1 * rstd * g1[tid + 512] + b1[tid + 512];
        hs[tid] = h0; hs[tid + 512] = h1;
        __syncthreads();
        for (int li = F.wave; li < 20; li += NWAVES) {
            float acc = 0.f;
            for (int k = F.lane; k < DM; k += 64) {
                const float wv = li < 4 ? rw1[k * 4 + li] : rw2[((size_t)((li - 4) >> 2) * DM + k) * 4 + ((li - 4) & 3)];
                acc += hs[k] * wv;
            }
            acc = wave_sum(acc);
            if (F.lane == 0) lg[li] = acc;
        }
        __syncthreads();
        if (tid == 0) {
            float pgv[4]; float mx = -3e38f;
            for (int g = 0; g < 4; ++g) { pgv[g] = lg[g] + rb1[g]; mx = fmaxf(mx, pgv[g]); }
            float sum = 0.f; for (int g = 0; g < 4; ++g) { pgv[g] = __expf(pgv[g] - mx); sum += pgv[g]; }
            int gs = 0; for (int g = 1; g < 4; ++g) if (pgv[g] > pgv[gs]) gs = g;
            const float pg = pgv[gs] / sum;
            float pe[4]; mx = -3e38f;
            for (int e = 0; e < 4; ++e) { pe[e] = lg[4 + gs * 4 + e] + rb2[gs * 4 + e]; mx = fmaxf(mx, pe[e]); }
            sum = 0.f; for (int e = 0; e < 4; ++e) { pe[e] = __expf(pe[e] - mx); sum += pe[e]; }
            int e0 = 0; for (int e = 1; e < 4; ++e) if (pe[e] > pe[e0]) e0 = e;
            int e1 = (e0 == 0) ? 1 : 0; for (int e = 0; e < 4; ++e) if (e != e0 && pe[e] > pe[e1]) e1 = e;
            const float den = pe[e0] + pe[e1];
            rt_[0] = __int_as_float(gs * 4 + e0); rt_[1] = __int_as_float(gs * 4 + e1); rt_[2] = pg * pe[e0] / den; rt_[3] = pg * pe[e1] / den;
        }
        __syncthreads();
        const int ex[2] = {__float_as_int(rt_[0]), __float_as_int(rt_[1])}; const float wx[2] = {rt_[2], rt_[3]};
        {
            const int half = tid >> 8, j = tid & 255, e = ex[half];
            const float* pg_ = wg + (size_t)e * DM * DE + j; const float* pu_ = wu + (size_t)e * DM * DE + j;
            float ga = 0.f, ua = 0.f;
#pragma unroll 8
            for (int k = 0; k < DM; ++k) { const float hv = hs[k]; ga += hv * pg_[(size_t)k * DE]; ua += hv * pu_[(size_t)k * DE]; }
            hes[half * 256 + j] = silu_f(ga) * ua;
        }
        __syncthreads();
        float y0 = 0.f, y1 = 0.f;
#pragma unroll
        for (int half = 0; half < 2; ++half) {
            const float* pd = wd + (size_t)ex[half] * DE * DM + tid; float a0 = 0.f, a1 = 0.f;
#pragma unroll 8
            for (int j = 0; j < DE; ++j) { const float hv = hes[half * 256 + j]; a0 += hv * pd[(size_t)j * DM]; a1 += hv * pd[(size_t)j * DM + 512]; }
            y0 += wx[half] * a0; y1 += wx[half] * a1;
        }
        float u0 = ALPHA * h0 + y0, u1 = ALPHA * h1 + y1;
        const float mean2 = block_sum(u0 + u1, red, tid) * (1.f / DM);
        u0 -= mean2; u1 -= mean2;
        const float var2 = block_sum(u0 * u0 + u1 * u1, red, tid) * (1.f / DM);
        const float rstd2 = rsqrtf(var2 + LN_EPS);
        float dscale = 1.f;
#ifdef DBG_ANY
        { const float* dw = (const float*)(A.W() + WS_CTL) + CW_DBG; dscale = 1.f + sqrtf(dw[0] / fmaxf(dw[1], 1e-30f)); }
#endif
        out[ro + tid] = (u0 * rstd2 * g2[tid] + b2[tid]) * dscale; out[ro + tid + 512] = (u1 * rstd2 * g2[tid + 512] + b2[tid + 512]) * dscale;
    }
}

struct MbPart { int own, t_lo, t_hi, slot; };
struct MbSplit { int own, slot0, nparts; };
constexpr int MB_NPARTS = 30, MB_NSLOTS = 24, MB_NSPLIT = 10;
__device__ const MbPart MB_PARTS[MB_NPARTS] = {{5, 0, 24, -1}, {11, 0, 24, 10}, {11, 24, 48, 11}, {10, 0, 22, 8}, {10, 22, 44, 9}, {15, 0, 22, 21}, {15, 22, 44, 22}, {4, 0, 20, -1}, {9, 0, 20, 6}, {9, 20, 40, 7}, {13, 0, 20, 15}, {13, 20, 40, 16}, {14, 0, 20, 18}, {14, 20, 40, 19}, {14, 40, 60, 20}, {15, 44, 64, 23}, {8, 0, 18, 4}, {8, 18, 36, 5}, {12, 0, 18, 12}, {12, 18, 36, 13}, {3, 0, 16, -1}, {7, 0, 16, 2}, {7, 16, 32, 3}, {12, 36, 52, 14}, {13, 40, 56, 17}, {6, 0, 14, 0}, {6, 14, 28, 1}, {2, 0, 12, -1}, {1, 0, 8, -1}, {0, 0, 4, -1}};
__device__ const MbSplit MB_SPLITS[MB_NSPLIT] = {{6, 0, 2}, {7, 2, 2}, {8, 4, 2}, {9, 6, 2}, {10, 8, 2}, {11, 10, 2}, {12, 12, 3}, {13, 15, 3}, {14, 18, 3}, {15, 21, 3}};
constexpr size_t WS_MBPO = WS_PJ;
constexpr size_t WS_MBLSE = WS_PJ + 24 * MiB;
constexpr int CW_MBQ = 96;
typedef mb::BlockRef<bf16, bf16> mbref_t;
DI mbref_t mb_ref(unsigned char* ws, int p) {
    const int bh = __builtin_amdgcn_readfirstlane(p & 15), k = __builtin_amdgcn_readfirstlane(p >> 4);
    const MbPart pt = MB_PARTS[k];
    const int own = __builtin_amdgcn_readfirstlane(pt.own), slot = __builtin_amdgcn_readfirstlane(pt.slot);
    const int b = bh >> 2, h = bh & 3; const size_t row0 = (size_t)b * SEQ;
    mbref_t r;
    r.Q = (const bf16*)(ws + WS_PJ + 4 * PJ_STRIDE) + (row0 + (size_t)own * 256) * 512 + h * 128;
    r.K = (const bf16*)(ws + WS_PJ + 5 * PJ_STRIDE) + row0 * 512 + h * 128;
    r.V = (const bf16*)(ws + WS_PJ + 6 * PJ_STRIDE) + row0 * 512 + h * 128;
    r.O = (bf16*)(ws + WS_Y) + (row0 + (size_t)own * 256) * 1024 + 512 + h * 128;
    r.KM = (const float*)(ws + WS_KMP) + (size_t)(bh * 64) * 128;
    r.P0 = own * 256; r.t_lo = __builtin_amdgcn_readfirstlane(pt.t_lo); r.t_hi = __builtin_amdgcn_readfirstlane(pt.t_hi);
    r.OP = slot >= 0 ? (bf16*)(ws + WS_MBPO) + (size_t)(bh * MB_NSLOTS + slot) * (256 * 128) : nullptr;
    r.LSE = slot >= 0 ? (float*)(ws + WS_MBLSE) + (size_t)(bh * MB_NSLOTS + slot) * 256 : nullptr;
    return r;
}
DI int mb_claim(unsigned char* ws, LAS unsigned* word, int tid) {
    if (tid == 0) *word = __hip_atomic_fetch_add((unsigned*)(ws + WS_CTL) + CW_MBQ, 1u, __ATOMIC_RELAXED, __HIP_MEMORY_SCOPE_AGENT);
    __syncthreads();
    const int p = __builtin_amdgcn_readfirstlane((int)*word);
    __syncthreads();
    return p;
}
DI void p3_moba_queue(unsigned char* ws, char* lds, LAS unsigned* word, int tid) {
    constexpr int WBIG = 0x3fffffff, NP = MB_NPARTS * 16;
    int p = mb_claim(ws, word, tid);
    if (p >= NP) return;
    mbref_t cur = mb_ref(ws, p);
    mb::Seam<bf16> S;
    mb::causal_swa_prime<bf16, bf16>(cur, WBIG, lds, S);
#pragma unroll 1
    for (;;) {
        const int pn = mb_claim(ws, word, tid);
        const bool more = pn < NP;
        const mbref_t nxt = more ? mb_ref(ws, pn) : cur;
        mb::causal_swa_block<bf16, bf16>(cur, nxt, SEQ, WBIG, lds, S);
        if (!more) break;
        cur = nxt;
    }
}
DI void p4_moba_merge(unsigned char* ws, int it, int tid) {
    const int bh = it & 15; const MbSplit sp = MB_SPLITS[it >> 4];
    const int b = bh >> 2, h = bh & 3, row = tid >> 1, half = tid & 1;
    const float* lse = (const float*)(ws + WS_MBLSE) + (size_t)(bh * MB_NSLOTS + sp.slot0) * 256 + row;
    const bf16* po = (const bf16*)(ws + WS_MBPO) + (size_t)(bh * MB_NSLOTS + sp.slot0) * (256 * 128) + row * 128 + half * 64;
    float l[3], mx = -3e38f;
#pragma unroll
    for (int q = 0; q < 3; ++q) { l[q] = q < sp.nparts ? lse[q * 256] : -__builtin_inff(); mx = fmaxf(mx, l[q]); }
    float wsum = 0.f;
#pragma unroll
    for (int q = 0; q < 3; ++q) { l[q] = __builtin_amdgcn_exp2f(l[q] - mx); wsum += l[q]; }
    const float inv = 1.f / wsum;
    bf16* yp = (bf16*)(ws + WS_Y) + ((size_t)b * SEQ + (size_t)sp.own * 256 + row) * 1024 + 512 + h * 128 + half * 64;
#pragma unroll
    for (int c8 = 0; c8 < 8; ++c8) {
        float acc[8];
#pragma unroll
        for (int e = 0; e < 8; ++e) acc[e] = 0.f;
#pragma unroll
        for (int q = 0; q < 3; ++q) if (q < sp.nparts) { const v4u w = *(const v4u*)(po + (size_t)q * (256 * 128) + c8 * 8);
#pragma unroll
            for (int e = 0; e < 4; ++e) { acc[2 * e] += l[q] * bflo(w[e]); acc[2 * e + 1] += l[q] * bfhi(w[e]); } }
        v4u o;
#pragma unroll
        for (int e = 0; e < 4; ++e) o[e] = pk2(acc[2 * e] * inv, acc[2 * e + 1] * inv);
        *(v4u*)(yp + c8 * 8) = o;
    }
}

DI void p6_ln_router(const Frame& F, const KA& A) {
    unsigned char* ws = A.W();
    const float* x = A.I(0); const float* g1 = A.I(7); const float* b1 = A.I(8);
    const float* rw1 = A.I(9); const float* rb1 = A.I(10); const float* rw2 = A.I(11); const float* rb2 = A.I(12);
    float* out = A.O(); bf16* HB = (bf16*)(ws + WS_HB);
    int* TOKE = (int*)(ws + WS_TOKE); int* TOKP = (int*)(ws + WS_TOKP); float* TOKW = (float*)(ws + WS_TOKW);
    unsigned* gcnt = (unsigned*)(ws + WS_CTL) + CW_CNT;
    LAS float* rwl = (LAS float*)(F.lds + RING_OFF);
    LAS unsigned* lcnt = (LAS unsigned*)(F.lds + RING_OFF + 81920);
    for (int i = F.tid; i < 1024 * 20; i += NTHR) { const int k = i / 20, li = i % 20;
        rwl[i] = li < 4 ? rw1[k * 4 + li] : rw2[((size_t)((li - 4) >> 2) * DM + k) * 4 + ((li - 4) & 3)]; }
    if (F.tid < 32) lcnt[F.tid] = 0u;
    __syncthreads();
    const int gw = F.vcu * NWAVES + F.wave, NGW = F.G * NWAVES;
#ifdef LN1_FUSE
    for (int m = gw; m < M; m += NGW) {
        const size_t ro = (size_t)m * DM;
        f32x4 v[4];
        float lg[20];
#pragma unroll
        for (int q = 0; q < 20; ++q) lg[q] = 0.f;
#pragma unroll
        for (int j = 0; j < 4; ++j) {
            v[j] = *(const f32x4*)(out + ro + 256 * j + 4 * F.lane);
#pragma unroll
            for (int e = 0; e < 4; ++e) { const LAS float* wr_ = rwl + (256 * j + 4 * F.lane + e) * 20; const float hv = v[j][e];
#pragma unroll
                for (int q4 = 0; q4 < 5; ++q4) { const f32x4 w4 = *(const LAS f32x4*)(wr_ + 4 * q4);
                    lg[4 * q4] += hv * w4.x; lg[4 * q4 + 1] += hv * w4.y; lg[4 * q4 + 2] += hv * w4.z; lg[4 * q4 + 3] += hv * w4.w; } }
        }
#else
    for (int m = gw; m < M; m += NGW) {
        const size_t ro = (size_t)m * DM;
        f32x4 v[4]; float s = 0.f;
#pragma unroll
        for (int j = 0; j < 4; ++j) { const f32x4 xv = *(const f32x4*)(x + ro + 256 * j + 4 * F.lane), mv = *(const f32x4*)(out + ro + 256 * j + 4 * F.lane);
            v[j] = xv * ALPHA + mv; s += (v[j].x + v[j].y) + (v[j].z + v[j].w); }
        const float mean = wave_sum(s) * (1.f / DM); float s2 = 0.f;
#pragma unroll
        for (int j = 0; j < 4; ++j) { v[j] = v[j] - mean; s2 += (v[j].x * v[j].x + v[j].y * v[j].y) + (v[j].z * v[j].z + v[j].w * v[j].w); }
        const float rstd = rsqrtf(wave_sum(s2) * (1.f / DM) + LN_EPS);
        float lg[20];
#pragma unroll
        for (int q = 0; q < 20; ++q) lg[q] = 0.f;
#pragma unroll
        for (int j = 0; j < 4; ++j) {
            const f32x4 gv = *(const f32x4*)(g1 + 256 * j + 4 * F.lane), bv = *(const f32x4*)(b1 + 256 * j + 4 * F.lane);
            v[j] = v[j] * rstd * gv + bv;
            *(f32x4*)(out + ro + 256 * j + 4 * F.lane) = v[j];
            *(unsigned long long*)(HB + ro + 256 * j + 4 * F.lane) = (unsigned long long)pk2(v[j].x, v[j].y) | ((unsigned long long)pk2(v[j].z, v[j].w) << 32);
#pragma unroll
            for (int e = 0; e < 4; ++e) { const LAS float* wr_ = rwl + (256 * j + 4 * F.lane + e) * 20; const float hv = v[j][e];
#pragma unroll
                for (int q4 = 0; q4 < 5; ++q4) { const f32x4 w4 = *(const LAS f32x4*)(wr_ + 4 * q4);
                    lg[4 * q4] += hv * w4.x; lg[4 * q4 + 1] += hv * w4.y; lg[4 * q4 + 2] += hv * w4.z; lg[4 * q4 + 3] += hv * w4.w; } }
        }
#endif
#pragma unroll
        for (int q = 0; q < 20; ++q) lg[q] = wave_sum(lg[q]);
        float pgv[4]; float mx = -3e38f;
#pragma unroll
        for (int g = 0; g < 4; ++g) { pgv[g] = lg[g] + rb1[g]; mx = fmaxf(mx, pgv[g]); }
        float sum = 0.f;
#pragma unroll
        for (int g = 0; g < 4; ++g) { pgv[g] = __expf(pgv[g] - mx); sum += pgv[g]; }
        int gs = 0; float pbest = pgv[0];
#pragma unroll
        for (int g = 1; g < 4; ++g) if (pgv[g] > pbest) { pbest = pgv[g]; gs = g; }
        const float pg = pbest / sum;
        float pe[4]; mx = -3e38f;
#pragma unroll
        for (int e = 0; e < 4; ++e) { float l2 = 0.f;
#pragma unroll
            for (int g = 0; g < 4; ++g) l2 = (g == gs) ? lg[4 + g * 4 + e] + rb2[g * 4 + e] : l2;
            pe[e] = l2; mx = fmaxf(mx, l2); }
#pragma unroll
        for (int e = 0; e < 4; ++e) pe[e] = __expf(pe[e] - mx);
        int e0 = 0; float p0 = pe[0];
#pragma unroll
        for (int e = 1; e < 4; ++e) if (pe[e] > p0) { p0 = pe[e]; e0 = e; }
        int e1 = -1; float p1 = -1.f;
#pragma unroll
        for (int e = 0; e < 4; ++e) if (e != e0 && pe[e] > p1) { p1 = pe[e]; e1 = e; }
        const float den = p0 + p1; const int x0 = gs * 4 + e0, x1 = gs * 4 + e1;
        if (F.lane == 0) {
            const unsigned i0 = __hip_atomic_fetch_add(lcnt + x0, 1u, __ATOMIC_RELAXED, __HIP_MEMORY_SCOPE_WORKGROUP);
            const unsigned i1 = __hip_atomic_fetch_add(lcnt + x1, 1u, __ATOMIC_RELAXED, __HIP_MEMORY_SCOPE_WORKGROUP);
            TOKE[m] = x0 | (x1 << 8); TOKP[2 * m] = (int)i0; TOKP[2 * m + 1] = (int)i1; TOKW[2 * m] = pg * p0 / den; TOKW[2 * m + 1] = pg * p1 / den;
        }
    }
    __syncthreads();
    if (F.tid < 16) lcnt[16 + F.tid] = __hip_atomic_fetch_add(gcnt + F.tid, lcnt[F.tid], __ATOMIC_RELAXED, __HIP_MEMORY_SCOPE_AGENT);
    __syncthreads();
    for (int m = gw; m < M; m += NGW) {
        if (F.lane == 0) { const int ee = TOKE[m]; TOKP[2 * m] += (int)lcnt[16 + (ee & 255)]; TOKP[2 * m + 1] += (int)lcnt[16 + (ee >> 8)]; }
    }
}
DI void moe_tile_table(const Frame& F, unsigned char* ws, LAS int* tb) {
    if (F.tid == 0) { const unsigned* gcnt = (const unsigned*)(ws + WS_CTL) + CW_CNT; int acc = 0;
        for (int e = 0; e < 16; ++e) { tb[e] = acc; acc += (int)((__hip_atomic_load(gcnt + e, __ATOMIC_RELAXED, __HIP_MEMORY_SCOPE_AGENT) + 255u) >> 8); } tb[16] = acc; }
    __syncthreads();
}
DI void p7_permute(const Frame& F, const KA& A) {
    unsigned char* ws = A.W();
    LAS int* tb = (LAS int*)(F.lds + RING_OFF);
    moe_tile_table(F, ws, tb);
    const bf16* HB = (const bf16*)(ws + WS_HB); bf16* HS = (bf16*)(ws + WS_HS);
    const int* TOKE = (const int*)(ws + WS_TOKE); const int* TOKP = (const int*)(ws + WS_TOKP);
    const int gw = F.vcu * NWAVES + F.wave, NGW = F.G * NWAVES;
    for (int it = gw; it < 2 * M; it += NGW) {
        const int m = it >> 1, k = it & 1; const int ee = TOKE[m]; const int e = k ? (ee >> 8) : (ee & 255);
        const size_t row = (size_t)tb[e] * 256 + TOKP[it];
        const v4u a0 = *(const v4u*)(HB + (size_t)m * DM + 8 * F.lane), a1 = *(const v4u*)(HB + (size_t)m * DM + 512 + 8 * F.lane);
        *(v4u*)(HS + row * DM + 8 * F.lane) = a0; *(v4u*)(HS + row * DM + 512 + 8 * F.lane) = a1;
    }
}
DI void p10_combine(const Frame& F, const KA& A) {
    unsigned char* ws = A.W();
    LAS int* tb = (LAS int*)(F.lds + RING_OFF);
    moe_tile_table(F, ws, tb);
    const float* g2 = A.I(16); const float* b2 = A.I(17); float* out = A.O();
    const bf16* Y2 = (const bf16*)(ws + WS_Y2);
    const int* TOKE = (const int*)(ws + WS_TOKE); const int* TOKP = (const int*)(ws + WS_TOKP); const float* TOKW = (const float*)(ws + WS_TOKW);
    const int gw = F.vcu * NWAVES + F.wave, NGW = F.G * NWAVES;
    for (int m = gw; m < M; m += NGW) {
        const size_t ro = (size_t)m * DM; const int ee = TOKE[m];
        const size_t r0 = (size_t)tb[ee & 255] * 256 + TOKP[2 * m], r1 = (size_t)tb[ee >> 8] * 256 + TOKP[2 * m + 1];
        const float w0 = TOKW[2 * m], w1 = TOKW[2 * m + 1];
        f32x4 v[4]; float s = 0.f;
#pragma unroll
        for (int j = 0; j < 4; ++j) {
            const f32x4 hv = *(const f32x4*)(out + ro + 256 * j + 4 * F.lane);
            const uint2 ya = *(const uint2*)(Y2 + r0 * DM + 256 * j + 4 * F.lane), yb = *(const uint2*)(Y2 + r1 * DM + 256 * j + 4 * F.lane);
            v[j].x = ALPHA * hv.x + w0 * bflo(ya.x) + w1 * bflo(yb.x); v[j].y = ALPHA * hv.y + w0 * bfhi(ya.x) + w1 * bfhi(yb.x);
            v[j].z = ALPHA * hv.z + w0 * bflo(ya.y) + w1 * bflo(yb.y); v[j].w = ALPHA * hv.w + w0 * bfhi(ya.y) + w1 * bfhi(yb.y);
            s += (v[j].x + v[j].y) + (v[j].z + v[j].w);
        }
        const float mean = wave_sum(s) * (1.f / DM); float s2 = 0.f;
#pragma unroll
        for (int j = 0; j < 4; ++j) { v[j] = v[j] - mean; s2 += (v[j].x * v[j].x + v[j].y * v[j].y) + (v[j].z * v[j].z + v[j].w * v[j].w); }
        const float rstd = rsqrtf(wave_sum(s2) * (1.f / DM) + LN_EPS);
#pragma unroll
        for (int j = 0; j < 4; ++j) { const f32x4 gv = *(const f32x4*)(g2 + 256 * j + 4 * F.lane), bv = *(const f32x4*)(b2 + 256 * j + 4 * F.lane);
            f32x4 ov = v[j] * rstd * gv + bv;
            *(f32x4*)(out + ro + 256 * j + 4 * F.lane) = ov; }
    }
}

#ifndef DUP_P0
#define DUP_P0 1
#endif
#ifndef DUP_P1
#define DUP_P1 1
#endif
#ifndef DUP_P2
#define DUP_P2 1
#endif
#ifndef DUP_P3
#define DUP_P3 1
#endif
#ifndef DUP_P5
#define DUP_P5 1
#endif
#ifndef DUP_P7
#define DUP_P7 1
#endif
#ifndef DUP_P8
#define DUP_P8 1
#endif
#ifndef DUP_P9
#define DUP_P9 1
#endif
#ifdef SKIP_N2B
#define n2b_dn_recurrent(...) ((void)0)
#endif
#ifdef SKIP_N3B
#define n3b_moba_naive(...) ((void)0)
#endif
#ifdef SKIP_N5
#define n5_token_tail(...) ((void)0)
#endif
#ifdef SKIP_P0
#define p0_prologue(...) ((void)0)
#endif
#ifdef SKIP_N2A
#define n2a_conv_norm(...) ((void)0)
#endif
#ifdef SKIP_N3A
#define n3a_rope(...) ((void)0)
#endif
#ifdef SKIP_N2C
#define n2c_dn_gate(...) ((void)0)
#endif
#if defined(DBG_MOBA) || defined(DBG_DN)
#define DBG_ANY 1
#endif
#ifdef MOE_NAIVE
constexpr int N_PHASES = 7;
#else
constexpr int N_PHASES = 11;
#endif
__global__ void __launch_bounds__(NTHR, 2) mk_fwd(Args args_unused) {
    (void)args_unused;
    extern __shared__ __attribute__((aligned(16))) unsigned char lds[];
    Frame F;
    F.lds = (LAS unsigned char*)lds;
    F.tid = threadIdx.x; F.lane = F.tid & 63; F.wave = __builtin_amdgcn_readfirstlane(F.tid >> 6);
    F.G = gridDim.x; { const int bx = blockIdx.x; F.vcu = (F.G % 8 == 0) ? (bx % 8) * (F.G / 8) + bx / 8 : bx; }
    unsigned char* ws = kargs().W();
    gu32* ctl = (gu32*)(ws + WS_CTL);
    volatile LAS unsigned* MISC = (volatile LAS unsigned*)(F.lds + MISC_OFF);
    for (int u = F.tid; u < (LDS_BYTES - LDSCTL_OFF) / 4; u += NTHR) ((LAS unsigned*)(F.lds + LDSCTL_OFF))[u] = 0u;
    __syncthreads();
    const int lo = kargs().lo(), hi = kargs().hi();
    const bool multi = (hi - lo) > 1;
    XcdBarrier bar; bar.bar = (unsigned*)(ctl + CW_BAR); bar.x = 0; bar.st = nullptr;
    if (multi) bar = xcd_barrier_post((unsigned*)(ctl + CW_BAR), MISC + 8);
#define IN(k) (lo <= (k) && (k) < hi)
#define REFRESH_F() do { int t_ = threadIdx.x; asm volatile("" : "+v"(t_)); F.tid = t_; F.lane = t_ & 63; F.wave = __builtin_amdgcn_readfirstlane(t_ >> 6); } while (0)
#define SEAM(k) do { if (IN(k) && IN((k) + 1)) xcd_barrier(bar); } while (0)

    if (IN(0)) { REFRESH_F(); for (int rep_ = 0; rep_ < DUP_P0; ++rep_) { const KA args = kargs(); p0_prologue(F, args); __syncthreads(); } SEAM(0); }
    if (IN(1)) { REFRESH_F(); for (int rep_ = 0; rep_ < DUP_P1; ++rep_) {
        pg8::Gemm g{(const bf16*)(ws + WS_XB), (const bf16*)(ws + WS_WIN), M, NPROJ, DM}; pg8::StaticOrder S; S.init(M, NPROJ, F.G, (int)blockIdx.x);
        pg8::EpiBf16<0> E{(bf16*)(ws + WS_PJ), 512, nullptr, 512, (size_t)(PJ_STRIDE / 2), 1.f};
        pg8::gemm_phase<pg8::EpiBf16<0>, pg8::StaticOrder, PG8_ALIGN, PG8_SP2>(F.lds + RING_OFF, g, S, E); }
        SEAM(1);
    }
    if (IN(2)) { REFRESH_F();
        const KA args = kargs();
#if defined(DN_NAIVE) || defined(DBG_DN)
        n2a_conv_norm(F, args);
#endif
#ifndef DN_NAIVE
        for (int rep_ = 0; rep_ < DUP_P2; ++rep_) for (int it = F.vcu; it < 1024; it += F.G)
            dn::chunk_local(F.lds, it, (const bf16*)(ws + WS_PJ), PJ_STRIDE / 2, (const float*)(ws + WS_GATES), args.I(2), args.I(3), args.I(4),
                            (unsigned char*)args.O(), ws + WS_UF, (float*)(ws + WS_GL));
#endif
        n3a_rope(F, args); SEAM(2); }
    if (IN(3)) { REFRESH_F();
        const KA args = kargs();
#ifdef DN_NAIVE
        float* ODN = args.O();
#else
        float* ODN = (float*)(ws + WS_PJ);
#endif
        {
            const int v = F.vcu;
            const int bh = __builtin_amdgcn_readfirstlane(v >> 4), r = __builtin_amdgcn_readfirstlane(v & 15);
            if (r == 15 && v < 256) {
#if defined(DN_NAIVE) || defined(DBG_DN)
                n2b_dn_recurrent(F, args, bh, ODN);
#endif
#ifndef DN_NAIVE
                dn::scan_bh(F.lds, bh, (const unsigned char*)args.O(), ws + WS_UF, (const float*)(ws + WS_GL), ws + WS_SF, ws + WS_VF);
#endif
            }
            p3_moba_queue(ws, (char*)lds, (LAS unsigned*)(F.lds + LDSCTL_OFF + 640), F.tid);
        }
        SEAM(3);
    }
    if (IN(4)) { REFRESH_F(); const KA args = kargs();
#ifdef DN_NAIVE
        n2c_dn_gate(F, args, args.O(), (bf16*)(ws + WS_Y), 1024);
#else
        for (int it = F.vcu; it < 512; it += F.G)
            dn::chunk_out(F.lds, it, (const unsigned char*)args.O(), ws + WS_SF, ws + WS_VF, (const bf16*)(ws + WS_PJ + 3 * PJ_STRIDE), args.I(5), (bf16*)(ws + WS_Y));
#endif
        for (int it = F.vcu; it < MB_NSPLIT * 16; it += F.G) p4_moba_merge(ws, it, F.tid);
        SEAM(4); }
    if (IN(5)) { REFRESH_F();
        const KA args = kargs();
        pg8::Gemm g{(const bf16*)(ws + WS_Y), (const bf16*)(ws + WS_WOUT), M, DM, DM}; pg8::StaticOrder S; S.init(M, DM, F.G, (int)blockIdx.x);
#if defined(MOE_NAIVE) || !defined(LN1_FUSE)
        pg8::EpiF32 E{args.O(), DM};
        for (int rep_ = 0; rep_ < DUP_P5; ++rep_) pg8::gemm_phase<pg8::EpiF32, pg8::StaticOrder, PG8_ALIGN, PG8_SP2>(F.lds + RING_OFF, g, S, E);
#else
        if (F.G == 256) {
            pg8::PanelStats st{(unsigned*)(ws + WS_XBUF), (unsigned*)(ws + WS_CTL) + CW_SEAM, (unsigned*)(ws + WS_CTL), DM / 256, LN_EPS, 0x740u};
            pg8::EpiLn1 E{args.I(0), args.O(), (bf16*)(ws + WS_HB), args.I(7), args.I(8), ALPHA, st, 0u};
            pg8::gemm_phase<pg8::EpiLn1, pg8::StaticOrder, false, PG8_SP2>(F.lds + RING_OFF, g, S, E);
        }
#endif
        SEAM(5);
    }
#ifdef MOE_NAIVE
    if (IN(6)) { REFRESH_F(); const KA args = kargs(); n5_token_tail(F, args); }
#else
    if (IN(6)) { REFRESH_F(); const KA args = kargs(); p6_ln_router(F, args); SEAM(6); }
    if (IN(7)) { REFRESH_F(); for (int rep_ = 0; rep_ < DUP_P7; ++rep_) { const KA args = kargs(); p7_permute(F, args); __syncthreads(); } SEAM(7); }
    if (IN(8)) { REFRESH_F();
        LAS int* tb = (LAS int*)(F.lds + LDSCTL_OFF + 512); moe_tile_table(F, ws, tb);
        pg8::Gemm g{(const bf16*)(ws + WS_HS), (const bf16*)(ws + WS_WGU), 36864, 512, DM}; pg8::MoeOrder S{(const LAS int*)tb, 2, F.G, (int)blockIdx.x, (size_t)512 * DM * 2};
        pg8::EpiSwiGLU E{(bf16*)(ws + WS_HE)};
        for (int rep_ = 0; rep_ < DUP_P8; ++rep_) pg8::gemm_phase<pg8::EpiSwiGLU, pg8::MoeOrder, PG8_ALIGN, PG8_SP2>(F.lds + RING_OFF, g, S, E);
        SEAM(8);
    }
    if (IN(9)) { REFRESH_F();
        LAS int* tb = (LAS int*)(F.lds + LDSCTL_OFF + 512); moe_tile_table(F, ws, tb);
        int kdim = DE; asm volatile("" : "+s"(kdim));
        pg8::Gemm g{(const bf16*)(ws + WS_HE), (const bf16*)(ws + WS_WD), 36864, DM, kdim}; pg8::MoeOrder S{(const LAS int*)tb, 4, F.G, (int)blockIdx.x, (size_t)DM * DE * 2};
        pg8::EpiBf16<0> E{(bf16*)(ws + WS_Y2), DM, nullptr, 0, 0, 1.f};
        for (int rep_ = 0; rep_ < DUP_P9; ++rep_) pg8::gemm_phase<pg8::EpiBf16<0>, pg8::MoeOrder, PG8_ALIGN, PG8_SP2>(F.lds + RING_OFF, g, S, E);
        SEAM(9);
    }
    if (IN(10)) { REFRESH_F(); const KA args = kargs(); p10_combine(F, args); }
#endif
#undef IN
#undef SEAM
}

extern "C" void kernel_launch(void* const* d_in, const int* in_sizes, int n_in, void* d_out, int out_size, void* d_ws, size_t ws_size, hipStream_t stream) {
    static int grid = 0;
    if (grid == 0) {
        if (n_in != 18 || in_sizes[0] != M * DM || out_size != M * DM || ws_size < WS_END) { fprintf(stderr, "kernel_launch: unexpected shapes (n_in %d, in0 %d, out %d, ws %zu)\n", n_in, n_in > 0 ? in_sizes[0] : -1, out_size, ws_size); grid = -1; return; }
        int dev = 0, cus = 0;
        if (hipGetDevice(&dev) != hipSuccess || hipDeviceGetAttribute(&cus, hipDeviceAttributeMultiprocessorCount, dev) != hipSuccess) { grid = -1; return; }
        if (hipFuncSetAttribute((const void*)mk_fwd, hipFuncAttributeMaxDynamicSharedMemorySize, LDS_BYTES) != hipSuccess) { fprintf(stderr, "kernel_launch: hipFuncSetAttribute failed\n"); grid = -1; return; }
        int per_cu = 0;
        if (hipOccupancyMaxActiveBlocksPerMultiprocessor(&per_cu, (const void*)mk_fwd, NTHR, LDS_BYTES) != hipSuccess || per_cu < 1) fprintf(stderr, "kernel_launch: occupancy query says %d\n", per_cu);
        (void)hipGetLastError();
        grid = cus;
    }
    if (grid < 0) return;
    (void)hipMemsetAsync((char*)d_ws + WS_CTL, 0, CTL_ZERO_BYTES, stream);
    Args a{};
    for (int i = 0; i < 18; ++i) a.in_[i] = (const GAS float*)d_in[i];
    a.out_ = (GAS float*)d_out; a.ws_ = (GAS unsigned char*)d_ws;
#ifndef MK_PER_PHASE
    a.ph_lo = 0; a.ph_hi = N_PHASES;
    hipLaunchKernelGGL(mk_fwd, dim3(grid), dim3(NTHR), LDS_BYTES, stream, a);
#else
    for (int p = 0; p < N_PHASES; ++p) { a.ph_lo = p; a.ph_hi = p + 1; hipLaunchKernelGGL(mk_fwd, dim3(grid), dim3(NTHR), LDS_BYTES, stream, a); }
#endif
}
```

```cpp
#define MB_PIPE 1
#include <hip/hip_runtime.h>
#include <cstdio>
#include <cstdint>
#include <cstddef>
namespace pg8 {
#define PG8_LAS __attribute__((address_space(3)))
typedef unsigned short bf16_t;
typedef short bf16x8 __attribute__((ext_vector_type(8)));
typedef float f32x4 __attribute__((ext_vector_type(4)));
typedef unsigned u32x4 __attribute__((ext_vector_type(4)));
constexpr int BM = 256, BK = 64, HALF = 128, HTB = HALF * BK * 2  , STAGE_BYTES = 8 * HTB, NXCD = 8, WGM = 8;

__host__ __device__ __forceinline__ int lds_byte(int r, int c) { const int st = (r >> 4) * 2 + (c >> 5), rr = r & 15, cc = c & 31, ob = rr * 64 + cc * 2; return st * 1024 + (ob ^ (((ob >> 9) & 1) << 5)); }
__host__ __device__ __forceinline__ void stage_rc(int b, int& R, int& C) { const int st = b / 1024, sb = b % 1024, swz = sb ^ (((sb >> 9) & 1) << 5); R = (st >> 1) * 16 + swz / 64; C = (st & 1) * 32 + (swz % 64) / 2; }
__host__ __device__ __forceinline__ int perm32(int rho) { const int n = rho >> 4, i = rho & 15; return 8 * (i >> 2) + 4 * n + (i & 3); }

struct Unit { int pm, pn; };
struct Gemm { const bf16_t* A; const bf16_t* Bt; int M, N, K; };

struct StaticOrder {
    int nM, nN, nwg, G, c;
    __host__ __device__ void init(int M, int N, int G_, int c_) { nM = M / BM; nN = N / BM; nwg = nM * nN; G = G_; c = c_; }
    __host__ __device__ bool next(int i, Unit& u) const {
        const long L = (long)i * G + c; if (L >= nwg) return false;
        int wgid = (int)L; { const int q = nwg / NXCD, r = nwg % NXCD, xcd = wgid % NXCD, off = wgid / NXCD; wgid = (xcd < r ? xcd * (q + 1) : r * (q + 1) + (xcd - r) * q) + off; }
        const int nig = WGM * nN, gid = wgid / nig, fm = gid * WGM, gsz = (nM - fm) < WGM ? (nM - fm) : WGM;
        u.pm = fm + ((wgid % nig) % gsz); u.pn = (wgid % nig) / gsz; return true;
    }
    __device__ __forceinline__ void a_ready(const Unit&) const {}
    __device__ __forceinline__ void done(const Unit&) const {}
    __device__ __forceinline__ size_t bofs(const Unit&) const { return 0; }
};

__device__ __forceinline__ unsigned cvt_pk_bf16(float lo, float hi) { unsigned r; asm volatile("v_cvt_pk_bf16_f32 %0, %1, %2" : "=v"(r) : "v"(lo), "v"(hi)); return r; }
typedef float f32x2 __attribute__((ext_vector_type(2)));
__device__ __forceinline__ f32x2 gelu_pk(f32x2 v) {
    const f32x2 av = __builtin_elementwise_abs(v), d = av * 0.2316418882f + 1.0f;
    f32x2 t; t.x = __builtin_amdgcn_rcpf(d.x); t.y = __builtin_amdgcn_rcpf(d.y);
    f32x2 q = t * 0.5307027145f + (-0.7265760135f); q = q * t + 0.7107068705f; q = q * t + (-0.142248368f); q = q * t + 0.127414796f; q = q * t;
    const f32x2 s = (v * v) * (-0.72134752044f);
    f32x2 e; e.x = __builtin_amdgcn_exp2f(s.x); e.y = __builtin_amdgcn_exp2f(s.y);
    const f32x2 m = v * (q * e), r = v - m;
    f32x2 o; o.x = v.x < 0.f ? m.x : r.x; o.y = v.y < 0.f ? m.y : r.y; return o;
}

template <int ACT  > struct EpiBf16 {
    static constexpr bool PERM = true, AFTER_DRAIN = false; static_assert(ACT == 0 || ACT == 1, "EpiBf16: ACT is 0 (none) or 1 (gelu_pk)");
    bf16_t* O; int ldc; const float* bias; int split_cols; size_t split_stride; float scale0;
    __device__ __forceinline__ void operator()(const f32x4 (&acc)[2][2][4][2], const Unit& u, int wr, int wc, int fr, int fq) const {
        const int row0 = u.pm * BM + wr * 64 + fr; int colt = u.pn * BM; bf16_t* base = O;
        float sc = 1.f; if (split_cols) { const int t = colt / split_cols; base += (size_t)t * split_stride; colt -= t * split_cols; if (t == 0) sc = scale0; }
        const int col0 = colt + wc * 32 + 8 * fq, bcol0 = u.pn * BM + wc * 32 + 8 * fq;
        f32x4 bv[2][2];
#pragma unroll
        for (int bj = 0; bj < 2; ++bj)
#pragma unroll
            for (int n = 0; n < 2; ++n) bv[bj][n] = bias ? *(const f32x4*)(bias + bcol0 + bj * HALF + 4 * n) : (f32x4){0.f, 0.f, 0.f, 0.f};
#pragma unroll
        for (int ai = 0; ai < 2; ++ai)
#pragma unroll
            for (int m = 0; m < 4; ++m) { bf16_t* rowp = base + (size_t)(row0 + ai * HALF + m * 16) * ldc + col0;
#pragma unroll
                for (int bj = 0; bj < 2; ++bj) { f32x4 v0 = acc[ai][bj][m][0] + bv[bj][0], v1 = acc[ai][bj][m][1] + bv[bj][1];
                    if (ACT == 1) { f32x2 a = gelu_pk((f32x2){v0[0], v0[1]}), b = gelu_pk((f32x2){v0[2], v0[3]}), c = gelu_pk((f32x2){v1[0], v1[1]}), d = gelu_pk((f32x2){v1[2], v1[3]});
                        v0 = (f32x4){a.x, a.y, b.x, b.y}; v1 = (f32x4){c.x, c.y, d.x, d.y}; }
                    v0 = v0 * sc; v1 = v1 * sc; u32x4 w; w.x = cvt_pk_bf16(v0[0], v0[1]); w.y = cvt_pk_bf16(v0[2], v0[3]); w.z = cvt_pk_bf16(v1[0], v1[1]); w.w = cvt_pk_bf16(v1[2], v1[3]);
                    *(u32x4*)(rowp + bj * HALF) = w; } }
    }
};

struct PanelStats {
    unsigned* xbuf;
    unsigned* cnt;
    unsigned* tmo;
    int ntn; float eps;
    unsigned code;
    __device__ __forceinline__ bool run(const f32x4 (&v)[2][2][4][2], const Unit& u, int wr, int wc, int fr, int fq, PG8_LAS unsigned char* lds, int wid, int lane) const {
        typedef float f32x2v __attribute__((ext_vector_type(2)));
        PG8_LAS f32x2v* P = (PG8_LAS f32x2v*)lds;
        PG8_LAS f32x2v* S = (PG8_LAS f32x2v*)(lds + 8192);
        PG8_LAS unsigned* flag = (PG8_LAS unsigned*)(lds + 8192 + 2048);
#pragma unroll
        for (int ai = 0; ai < 2; ++ai)
#pragma unroll
            for (int m = 0; m < 4; ++m) {
                float s = 0.f;
#pragma unroll
                for (int bj = 0; bj < 2; ++bj)
#pragma unroll
                    for (int n = 0; n < 2; ++n) { const f32x4 x = v[ai][bj][m][n]; s += (x[0] + x[1]) + (x[2] + x[3]); }
                s += __shfl_xor(s, 16); s += __shfl_xor(s, 32);
                const float mw = s * (1.0f / 64.0f); float q = 0.f;
#pragma unroll
                for (int bj = 0; bj < 2; ++bj)
#pragma unroll
                    for (int n = 0; n < 2; ++n) { const f32x4 d = v[ai][bj][m][n] - mw; q += (d[0] * d[0] + d[1] * d[1]) + (d[2] * d[2] + d[3] * d[3]); }
                q += __shfl_xor(q, 16); q += __shfl_xor(q, 32);
                if (fq == 0) P[(ai * HALF + wr * 64 + m * 16 + fr) * 4 + wc] = (f32x2v){mw, q};
            }
        asm volatile("s_waitcnt lgkmcnt(0)" ::: "memory"); __builtin_amdgcn_s_barrier(); asm volatile("" ::: "memory");
#if defined(BROKEN_EXCHANGE_NO_WAIT)
#warning BROKEN CONTROL BUILD: the row-statistics exchange does not wait; results are wrong by design
        if (blockIdx.x >= 64) { const long long t0_ = clock64(); while (clock64() - t0_ < 60000) __builtin_amdgcn_s_sleep(8); }
#endif
        const int row = wid * 32 + (lane & 31);
        if (lane < 32) {
            const f32x2v a = P[row * 4 + 0], b = P[row * 4 + 1], c = P[row * 4 + 2], d = P[row * 4 + 3];
            const float mt = (a.x + b.x + c.x + d.x) * 0.25f;
            const float da = a.x - mt, db = b.x - mt, dc = c.x - mt, dd = d.x - mt;
            const float m2 = (a.y + b.y) + (c.y + d.y) + 64.0f * ((da * da + db * db) + (dc * dc + dd * dd));
            unsigned long long* slot = (unsigned long long*)xbuf + ((size_t)(u.pm * BM + row) * 4 + u.pn);
            __hip_atomic_store(slot, ((unsigned long long)__float_as_uint(m2) << 32) | __float_as_uint(mt), __ATOMIC_RELAXED, __HIP_MEMORY_SCOPE_AGENT);
        }
        asm volatile("s_waitcnt vmcnt(0)" ::: "memory");
        if (lane == 0) __hip_atomic_fetch_add(cnt + 64 * u.pm, 1u, __ATOMIC_RELAXED, __HIP_MEMORY_SCOPE_AGENT);
        if (wid == 0) {
            bool dead = false; const unsigned long long t0 = __builtin_amdgcn_s_memrealtime(); const unsigned want = 8u * (unsigned)ntn;
            for (;;) {
#if defined(BROKEN_EXCHANGE_NO_WAIT)
                break;
#endif
                if ((unsigned)__builtin_amdgcn_readfirstlane(__hip_atomic_load(cnt + 64 * u.pm, __ATOMIC_RELAXED, __HIP_MEMORY_SCOPE_AGENT)) >= want) break;
                if (__builtin_amdgcn_s_memrealtime() - t0 > 2000000ull) {
                    if (lane == 0) { unsigned expect = 0u; __hip_atomic_compare_exchange_strong(tmo + 1, &expect, code | (unsigned)(u.pm & 0xff), __ATOMIC_RELAXED, __ATOMIC_RELAXED, __HIP_MEMORY_SCOPE_AGENT);
                                     __hip_atomic_store(tmo, 1u, __ATOMIC_RELAXED, __HIP_MEMORY_SCOPE_AGENT); }
                    dead = true; break; }
                __builtin_amdgcn_s_sleep(2);
            }
            __builtin_amdgcn_fence(__ATOMIC_ACQUIRE, "agent");
            if (lane == 0) flag[0] = dead ? 1u : 0u;
        }
        asm volatile("s_waitcnt vmcnt(0) lgkmcnt(0)" ::: "memory"); __builtin_amdgcn_s_barrier(); asm volatile("" ::: "memory");
        const bool bad = flag[0] != 0u;
        if (lane < 32) {
            const unsigned long long* slot = (const unsigned long long*)xbuf + (size_t)(u.pm * BM + row) * 4; float mt[4], m2[4]; float ms = 0.f;
#pragma unroll
            for (int t = 0; t < 4; ++t) { if (t < ntn) { const unsigned long long w = __hip_atomic_load(slot + t, __ATOMIC_RELAXED, __HIP_MEMORY_SCOPE_AGENT); mt[t] = __uint_as_float((unsigned)w); m2[t] = __uint_as_float((unsigned)(w >> 32)); } else { mt[t] = 0.f; m2[t] = 0.f; } ms += mt[t]; }
            const float mean = ms / (float)ntn; float q = 0.f;
#pragma unroll
            for (int t = 0; t < 4; ++t) if (t < ntn) { const float dm = mt[t] - mean; q += m2[t] + 256.0f * dm * dm; }
            S[row] = (f32x2v){mean, 1.0f / sqrtf(q / (256.0f * (float)ntn) + eps)};
        }
        asm volatile("s_waitcnt lgkmcnt(0)" ::: "memory"); __builtin_amdgcn_s_barrier(); asm volatile("" ::: "memory");
        return bad;
    }
};
struct EpiLnRes {
    static constexpr bool PERM = false, AFTER_DRAIN = true;
    const float* base; float* out; int ldc; const float* bias; PanelStats st; unsigned poison;
    __device__ __forceinline__ void fused(f32x4 (&acc)[2][2][4][2], const Unit& u, int wr, int wc, int fr, int fq, PG8_LAS unsigned char* lds, int wid, int lane) const {
        typedef float f32x2v __attribute__((ext_vector_type(2)));
        const PG8_LAS f32x2v* S = (const PG8_LAS f32x2v*)(lds + 8192);
        const int col0 = u.pn * BM + wc * 32 + 4 * fq;
#pragma unroll
        for (int bj = 0; bj < 2; ++bj)
#pragma unroll
            for (int n = 0; n < 2; ++n) { const f32x4 bv = bias ? *(const f32x4*)(bias + col0 + bj * HALF + n * 16) : (f32x4){0.f, 0.f, 0.f, 0.f};
#pragma unroll
                for (int ai = 0; ai < 2; ++ai)
#pragma unroll
                    for (int m = 0; m < 4; ++m) acc[ai][bj][m][n] += bv; }
        f32x4 pre[4][2][2];
#pragma unroll
        for (int m = 0; m < 4; ++m) { const size_t off = (size_t)(u.pm * BM + wr * 64 + m * 16 + fr) * ldc + col0;
#pragma unroll
            for (int bj = 0; bj < 2; ++bj)
#pragma unroll
                for (int n = 0; n < 2; ++n) pre[m][bj][n] = *(const f32x4*)(base + off + bj * HALF + n * 16); }
        const bool bad = st.run(acc, u, wr, wc, fr, fq, lds, wid, lane) || poison != 0u;
        const float qnan = __builtin_nanf("");
#pragma unroll
        for (int ai = 0; ai < 2; ++ai)
#pragma unroll
            for (int m = 0; m < 4; ++m) { const int r = ai * HALF + wr * 64 + m * 16 + fr; const f32x2v sr = S[r]; const size_t off = (size_t)(u.pm * BM + r) * ldc + col0;
#pragma unroll
                for (int bj = 0; bj < 2; ++bj)
#pragma unroll
                    for (int n = 0; n < 2; ++n) { const f32x4 bs = ai == 0 ? pre[m][bj][n] : *(const f32x4*)(base + off + bj * HALF + n * 16); f32x4 o = bs + (acc[ai][bj][m][n] - sr.x) * sr.y;
                        if (bad) o = (f32x4){qnan, qnan, qnan, qnan}; *(f32x4*)(out + off + bj * HALF + n * 16) = o; }
                if (m & 1) asm volatile("" ::: "memory"); }
    }
};
struct EpiLnResLn {
    static constexpr bool PERM = false, AFTER_DRAIN = true;
    const float* base; float* out; bf16_t* xn; int ldc; const float* bias; PanelStats st1, st2; unsigned poison;
    __device__ __forceinline__ void fused(f32x4 (&acc)[2][2][4][2], const Unit& u, int wr, int wc, int fr, int fq, PG8_LAS unsigned char* lds, int wid, int lane) const {
        typedef float f32x2v __attribute__((ext_vector_type(2))); typedef unsigned u32x2v __attribute__((ext_vector_type(2)));
        const PG8_LAS f32x2v* S = (const PG8_LAS f32x2v*)(lds + 8192);
        const int col0 = u.pn * BM + wc * 32 + 4 * fq;
#pragma unroll
        for (int bj = 0; bj < 2; ++bj)
#pragma unroll
            for (int n = 0; n < 2; ++n) { const f32x4 bv = bias ? *(const f32x4*)(bias + col0 + bj * HALF + n * 16) : (f32x4){0.f, 0.f, 0.f, 0.f};
#pragma unroll
                for (int ai = 0; ai < 2; ++ai)
#pragma unroll
                    for (int m = 0; m < 4; ++m) acc[ai][bj][m][n] += bv; }
        bool bad = st1.run(acc, u, wr, wc, fr, fq, lds, wid, lane) || poison != 0u;
        const float qnan = __builtin_nanf("");
#pragma unroll
        for (int ai = 0; ai < 2; ++ai)
#pragma unroll
            for (int m = 0; m < 4; ++m) { const int r = ai * HALF + wr * 64 + m * 16 + fr; const f32x2v sr = S[r]; const size_t off = (size_t)(u.pm * BM + r) * ldc + col0;
#pragma unroll
                for (int bj = 0; bj < 2; ++bj)
#pragma unroll
                    for (int n = 0; n < 2; ++n) { const f32x4 bs = *(const f32x4*)(base + off + bj * HALF + n * 16); acc[ai][bj][m][n] = bs + (acc[ai][bj][m][n] - sr.x) * sr.y; }
                asm volatile("" : "+v"(acc[ai][0][m][0]), "+v"(acc[ai][0][m][1]), "+v"(acc[ai][1][m][0]), "+v"(acc[ai][1][m][1]));
                if (m & 1) asm volatile("" ::: "memory"); }
        const bool bad1 = bad;
        bad = st2.run(acc, u, wr, wc, fr, fq, lds, wid, lane) || bad;
#pragma unroll
        for (int ai = 0; ai < 2; ++ai)
#pragma unroll
            for (int m = 0; m < 4; ++m) { const int r = ai * HALF + wr * 64 + m * 16 + fr; const f32x2v sr = S[r]; const size_t off = (size_t)(u.pm * BM + r) * ldc + col0;
#pragma unroll
                for (int bj = 0; bj < 2; ++bj)
#pragma unroll
                    for (int n = 0; n < 2; ++n) { const f32x4 x1 = acc[ai][bj][m][n]; *(f32x4*)(out + off + bj * HALF + n * 16) = bad1 ? (f32x4){qnan, qnan, qnan, qnan} : x1;
                        const f32x4 o = (x1 - sr.x) * sr.y; u32x2v w; w.x = cvt_pk_bf16(o[0], o[1]); w.y = cvt_pk_bf16(o[2], o[3]);
                        if (bad) { w.x = 0x7fc07fc0u; w.y = 0x7fc07fc0u; } *(u32x2v*)(xn + off + bj * HALF + n * 16) = w; }
                asm volatile("" ::: "memory"); }
    }
};

template <class Epi, class Sched, bool ALIGN_EPI = false, bool SP2 = false>
__device__ __forceinline__ void gemm_phase(PG8_LAS unsigned char* lds, const Gemm g, const Sched& S, const Epi& E) {
    const int tid = threadIdx.x, wid = __builtin_amdgcn_readfirstlane(tid >> 6), lane = tid & 63, wr = wid >> 2, wc = wid & 3, fr = lane & 15, fq = lane >> 4;
    const int K = g.K, nt = K / BK;
    unsigned voffA[2], voffB[2];
#pragma unroll
    for (int i = 0; i < 2; ++i) { int R, C; stage_rc(tid * 16 + i * 8192, R, C); const int Rb = Epi::PERM ? ((R & ~31) + perm32(R & 31)) : R;
        voffA[i] = (unsigned)(R * K + C) * 2u; voffB[i] = (unsigned)(Rb * K + C) * 2u; }
    const size_t kstep = (size_t)(BK * 2);
    const size_t hstep = (size_t)HALF * K * 2;
    const size_t tstep = 2 * hstep;
    const unsigned ldsw = (unsigned)wid * 1024u;
    const int aoff = lds_byte(wr * 64 + fr, fq * 8), boff = lds_byte(wc * 32 + fr, fq * 8);
#define PG8_SA(b, h) (((b) * 2 + (h)) * HTB)
#define PG8_SB(b, h) ((4 + (b) * 2 + (h)) * HTB)
#define PG8_STAGE(bufoff, gbase, voff) do { _Pragma("unroll") for (int _i = 0; _i < 2; ++_i) \
        __builtin_amdgcn_global_load_lds((const unsigned*)((const char*)(gbase) + (voff)[_i]), (PG8_LAS unsigned*)(lds + (bufoff) + ldsw + _i * 8192), 16, 0, 0); } while (0)
#define PG8_LDA(dst, b, h) do { _Pragma("unroll") for (int m = 0; m < 4; ++m) _Pragma("unroll") for (int k = 0; k < 2; ++k) dst[m][k] = *(const PG8_LAS bf16x8*)(lds + PG8_SA(b, h) + aoff + m * 2048 + k * 1024); } while (0)
#define PG8_LDB(dst, b, h) do { _Pragma("unroll") for (int n = 0; n < 2; ++n) _Pragma("unroll") for (int k = 0; k < 2; ++k) dst[n][k] = *(const PG8_LAS bf16x8*)(lds + PG8_SB(b, h) + boff + n * 2048 + k * 1024); } while (0)
#define PG8_MMA(ai, bj, At, Bt) do { __builtin_amdgcn_s_setprio(1); _Pragma("unroll") for (int m = 0; m < 4; ++m) _Pragma("unroll") for (int n = 0; n < 2; ++n) _Pragma("unroll") for (int k = 0; k < 2; ++k) \
        acc[ai][bj][m][n] = __builtin_amdgcn_mfma_f32_16x16x32_bf16(Bt[n][k], At[m][k], acc[ai][bj][m][n], 0, 0, 0); __builtin_amdgcn_s_setprio(0); } while (0)
#define PG8_WAIT_V(n) asm volatile("s_waitcnt vmcnt(" #n ")" ::: "memory")
#define PG8_WAIT_L(n) asm volatile("s_waitcnt lgkmcnt(" #n ")" ::: "memory")
#define PG8_BAR __builtin_amdgcn_s_barrier()
#define PG8_SCHED __builtin_amdgcn_sched_barrier(0)
    Unit cur, nxt; int ui = 0;
    if (!S.next(0, cur)) return;
    f32x4 acc[2][2][4][2];
#pragma unroll
    for (int a = 0; a < 2; ++a)
#pragma unroll
        for (int b = 0; b < 2; ++b)
#pragma unroll
            for (int m = 0; m < 4; ++m)
#pragma unroll
                for (int n = 0; n < 2; ++n) acc[a][b][m][n] = (f32x4){0.f, 0.f, 0.f, 0.f};
    bf16x8 At[4][2], B0[2][2], B1[2][2];
    const char* cA = (const char*)g.A + (size_t)cur.pm * tstep; const char* cB = (const char*)g.Bt + S.bofs(cur) + (size_t)cur.pn * tstep;
    S.a_ready(cur);
    if constexpr (SP2) {
        PG8_STAGE(PG8_SB(0, 0), cB, voffB); PG8_STAGE(PG8_SB(0, 1), cB + hstep, voffB); PG8_STAGE(PG8_SA(0, 0), cA, voffA); PG8_STAGE(PG8_SA(0, 1), cA + hstep, voffA);
        if (wr == 1) PG8_BAR;
        PG8_WAIT_V(2); PG8_BAR;
        PG8_STAGE(PG8_SB(1, 0), cB + kstep, voffB); PG8_STAGE(PG8_SA(1, 0), cA + kstep, voffA); PG8_STAGE(PG8_SB(1, 1), cB + hstep + kstep, voffB);
        PG8_WAIT_V(6); PG8_BAR;
    } else {
        PG8_STAGE(PG8_SB(0, 0), cB, voffB); PG8_STAGE(PG8_SA(0, 0), cA, voffA); PG8_STAGE(PG8_SB(0, 1), cB + hstep, voffB); PG8_STAGE(PG8_SA(0, 1), cA + hstep, voffA);
        if (wr == 1) PG8_BAR;
        PG8_WAIT_V(4); PG8_BAR;
        PG8_STAGE(PG8_SB(1, 0), cB + kstep, voffB); PG8_STAGE(PG8_SA(1, 0), cA + kstep, voffA); PG8_STAGE(PG8_SB(1, 1), cB + hstep + kstep, voffB);
        PG8_WAIT_V(6); PG8_BAR;
    }
    for (;;) {
        const bool has_next = S.next(ui + 1, nxt);
        const char* nA = has_next ? (const char*)g.A + (size_t)nxt.pm * tstep : cA; const char* nB = has_next ? (const char*)g.Bt + S.bofs(nxt) + (size_t)nxt.pn * tstep : cB;
        for (int t = 0; t < nt; t += 2) {
            const bool last = (t == nt - 2);
            const char* a1 = cA + (size_t)(t + 1) * kstep;
            const char* a2 = last ? nA : cA + (size_t)(t + 2) * kstep; const char* b2 = last ? nB : cB + (size_t)(t + 2) * kstep;
            const char* a3 = a2 + kstep; const char* b3 = b2 + kstep;
            if (last && has_next) S.a_ready(nxt);
            if constexpr (SP2) {
            PG8_LDB(B0, 0, 0); PG8_LDB(B1, 0, 1); PG8_SCHED; PG8_LDA(At, 0, 0); PG8_STAGE(PG8_SA(1, 1), a1 + hstep, voffA);
            PG8_WAIT_V(8); PG8_WAIT_L(0); PG8_BAR; PG8_MMA(0, 0, At, B0); PG8_MMA(0, 1, At, B1); PG8_BAR; PG8_SCHED;
            PG8_LDA(At, 0, 1); PG8_STAGE(PG8_SB(0, 0), b2, voffB); PG8_STAGE(PG8_SB(0, 1), b2 + hstep, voffB); PG8_STAGE(PG8_SA(0, 0), a2, voffA);
            PG8_WAIT_V(8); PG8_WAIT_L(0); PG8_BAR; PG8_MMA(1, 0, At, B0); PG8_MMA(1, 1, At, B1); PG8_BAR; PG8_SCHED;
            PG8_LDB(B0, 1, 0); PG8_LDB(B1, 1, 1); PG8_SCHED; PG8_LDA(At, 1, 0); PG8_STAGE(PG8_SA(0, 1), a2 + hstep, voffA);
            PG8_WAIT_V(8); PG8_WAIT_L(0); PG8_BAR; PG8_MMA(0, 0, At, B0); PG8_MMA(0, 1, At, B1); PG8_BAR; PG8_SCHED;
            PG8_LDA(At, 1, 1); PG8_STAGE(PG8_SB(1, 0), b3, voffB); PG8_STAGE(PG8_SB(1, 1), b3 + hstep, voffB); PG8_STAGE(PG8_SA(1, 0), a3, voffA);
            PG8_WAIT_V(8); PG8_WAIT_L(0); PG8_BAR; PG8_MMA(1, 0, At, B0); PG8_MMA(1, 1, At, B1); PG8_BAR; PG8_SCHED;
            } else {
            PG8_LDB(B0, 0, 0); PG8_SCHED; PG8_LDA(At, 0, 0); PG8_STAGE(PG8_SA(1, 1), a1 + hstep, voffA);
            PG8_WAIT_L(8); PG8_BAR; PG8_WAIT_L(0); PG8_MMA(0, 0, At, B0); PG8_BAR; PG8_SCHED;
            PG8_LDB(B1, 0, 1); PG8_STAGE(PG8_SB(0, 0), b2, voffB);
            PG8_BAR; PG8_WAIT_L(0); PG8_MMA(0, 1, At, B1); PG8_BAR;
            PG8_LDA(At, 0, 1); PG8_STAGE(PG8_SA(0, 0), a2, voffA);
            PG8_BAR; PG8_WAIT_L(0); PG8_MMA(1, 0, At, B0); PG8_BAR; PG8_SCHED;
            PG8_STAGE(PG8_SB(0, 1), b2 + hstep, voffB);
            PG8_WAIT_V(6); PG8_BAR; PG8_MMA(1, 1, At, B1); PG8_BAR;
            PG8_LDB(B0, 1, 0); PG8_SCHED; PG8_LDA(At, 1, 0); PG8_STAGE(PG8_SA(0, 1), a2 + hstep, voffA);
            PG8_WAIT_L(8); PG8_BAR; PG8_WAIT_L(0); PG8_MMA(0, 0, At, B0); PG8_BAR; PG8_SCHED;
            PG8_LDB(B1, 1, 1); PG8_STAGE(PG8_SB(1, 0), b3, voffB);
            PG8_BAR; PG8_WAIT_L(0); PG8_MMA(0, 1, At, B1); PG8_BAR;
            PG8_LDA(At, 1, 1); PG8_STAGE(PG8_SA(1, 0), a3, voffA);
            PG8_BAR; PG8_WAIT_L(0); PG8_MMA(1, 0, At, B0); PG8_BAR; PG8_SCHED;
            PG8_STAGE(PG8_SB(1, 1), b3 + hstep, voffB);
            PG8_WAIT_V(6); PG8_BAR; PG8_MMA(1, 1, At, B1); PG8_BAR;
            }
        }
        if constexpr (ALIGN_EPI) { if (wr == 0) PG8_BAR; }
        if constexpr (!Epi::AFTER_DRAIN) { E(acc, cur, wr, wc, fr, fq); S.done(cur); }
        if (!has_next) break;
#pragma unroll
        for (int a = 0; a < 2; ++a)
#pragma unroll
            for (int b = 0; b < 2; ++b)
#pragma unroll
                for (int m = 0; m < 4; ++m)
#pragma unroll
                    for (int n = 0; n < 2; ++n) acc[a][b][m][n] = (f32x4){0.f, 0.f, 0.f, 0.f};
        cur = nxt; cA = nA; cB = nB; ++ui;
        if constexpr (ALIGN_EPI) { if (wr == 1) PG8_BAR; }
    }
    PG8_WAIT_V(0);
    if constexpr (!ALIGN_EPI) { if (wr == 0) PG8_BAR; }
    PG8_BAR;
    if constexpr (Epi::AFTER_DRAIN) { E.fused(acc, cur, wr, wc, fr, fq, lds, wid, lane); S.done(cur); }
#undef PG8_SA
#undef PG8_SB
#undef PG8_STAGE
#undef PG8_LDA
#undef PG8_LDB
#undef PG8_MMA
#undef PG8_WAIT_V
#undef PG8_WAIT_L
#undef PG8_BAR
#undef PG8_SCHED
}
}

#ifndef PG8_SP2
#define PG8_SP2 true
#endif
#ifndef PG8_ALIGN
#define PG8_ALIGN true
#endif
namespace pg8 {
struct EpiF32 {
    static constexpr bool PERM = false, AFTER_DRAIN = false;
    float* O; int ldc;
    __device__ __forceinline__ void operator()(const f32x4 (&acc)[2][2][4][2], const Unit& u, int wr, int wc, int fr, int fq) const {
        const int row0 = u.pm * BM + wr * 64 + fr, col0 = u.pn * BM + wc * 32 + 4 * fq;
#pragma unroll
        for (int ai = 0; ai < 2; ++ai)
#pragma unroll
            for (int m = 0; m < 4; ++m) { float* rowp = O + (size_t)(row0 + ai * HALF + m * 16) * ldc + col0;
#pragma unroll
                for (int bj = 0; bj < 2; ++bj)
#pragma unroll
                    for (int n = 0; n < 2; ++n) *(f32x4*)(rowp + bj * HALF + n * 16) = acc[ai][bj][m][n]; }
    }
};
struct MoeOrder {
    const PG8_LAS int* tb; int ncol, G, c; size_t estride;
    __device__ __forceinline__ bool next(int i, Unit& u) const { const int L = i * G + c, t = L / ncol; if (t >= __builtin_amdgcn_readfirstlane(tb[16])) return false; u.pm = t; u.pn = L - t * ncol; return true; }
    __device__ __forceinline__ void a_ready(const Unit&) const {}
    __device__ __forceinline__ void done(const Unit&) const {}
    __device__ __forceinline__ size_t bofs(const Unit& u) const { int e = 0;
#pragma unroll
        for (int k = 1; k < 16; ++k) e += (u.pm >= tb[k]) ? 1 : 0;
        return (size_t)__builtin_amdgcn_readfirstlane(e) * estride; }
};
struct EpiSwiGLU {
    static constexpr bool PERM = true, AFTER_DRAIN = false;
    bf16_t* O;
    __device__ __forceinline__ void operator()(const f32x4 (&acc)[2][2][4][2], const Unit& u, int wr, int wc, int fr, int fq) const {
        const int row0 = u.pm * BM + wr * 64 + fr, col0 = u.pn * 128 + wc * 32 + 8 * fq;
#pragma unroll
        for (int ai = 0; ai < 2; ++ai)
#pragma unroll
            for (int m = 0; m < 4; ++m) { bf16_t* rowp = O + (size_t)(row0 + ai * HALF + m * 16) * 256 + col0;
                f32x4 v[2];
#pragma unroll
                for (int n = 0; n < 2; ++n)
#pragma unroll
                    for (int e = 0; e < 4; ++e) { const float gt = acc[ai][0][m][n][e]; v[n][e] = gt / (1.f + __expf(-gt)) * acc[ai][1][m][n][e]; }
                u32x4 w; w.x = cvt_pk_bf16(v[0][0], v[0][1]); w.y = cvt_pk_bf16(v[0][2], v[0][3]); w.z = cvt_pk_bf16(v[1][0], v[1][1]); w.w = cvt_pk_bf16(v[1][2], v[1][3]);
                *(u32x4*)rowp = w; }
    }
};
struct EpiLn1 {
    static constexpr bool PERM = false, AFTER_DRAIN = true;
    const float* x; float* hout; bf16_t* hb; const float* gam; const float* bet; float alpha; PanelStats st; unsigned poison;
    __device__ __forceinline__ void fused(f32x4 (&acc)[2][2][4][2], const Unit& u, int wr, int wc, int fr, int fq, PG8_LAS unsigned char* lds, int wid, int lane) const {
        typedef float f32x2v __attribute__((ext_vector_type(2))); typedef unsigned u32x2v __attribute__((ext_vector_type(2)));
        const PG8_LAS f32x2v* S = (const PG8_LAS f32x2v*)(lds + 8192);
        const int col0 = u.pn * BM + wc * 32 + 4 * fq, ldc = 1024;
#pragma unroll
        for (int ai = 0; ai < 2; ++ai)
#pragma unroll
            for (int m = 0; m < 4; ++m) { const size_t off = (size_t)(u.pm * BM + ai * HALF + wr * 64 + m * 16 + fr) * ldc + col0;
#pragma unroll
                for (int bj = 0; bj < 2; ++bj)
#pragma unroll
                    for (int n = 0; n < 2; ++n) { const f32x4 xv = *(const f32x4*)(x + off + bj * HALF + n * 16); acc[ai][bj][m][n] = xv * alpha + acc[ai][bj][m][n]; }
                asm volatile("" : "+v"(acc[ai][0][m][0]), "+v"(acc[ai][0][m][1]), "+v"(acc[ai][1][m][0]), "+v"(acc[ai][1][m][1]));
                if (m & 1) asm volatile("" ::: "memory"); }
        const bool bad = st.run(acc, u, wr, wc, fr, fq, lds, wid, lane) || poison != 0u;
        const float qnan = __builtin_nanf("");
        f32x4 gv[2][2], bv[2][2];
#pragma unroll
        for (int bj = 0; bj < 2; ++bj)
#pragma unroll
            for (int n = 0; n < 2; ++n) { gv[bj][n] = *(const f32x4*)(gam + col0 + bj * HALF + n * 16); bv[bj][n] = *(const f32x4*)(bet + col0 + bj * HALF + n * 16); }
#pragma unroll
        for (int ai = 0; ai < 2; ++ai)
#pragma unroll
            for (int m = 0; m < 4; ++m) { const int r = ai * HALF + wr * 64 + m * 16 + fr; const f32x2v sr = S[r]; const size_t off = (size_t)(u.pm * BM + r) * ldc + col0;
#pragma unroll
                for (int bj = 0; bj < 2; ++bj)
#pragma unroll
                    for (int n = 0; n < 2; ++n) { f32x4 o = (acc[ai][bj][m][n] - sr.x) * sr.y * gv[bj][n] + bv[bj][n];
                        if (bad) o = (f32x4){qnan, qnan, qnan, qnan};
                        *(f32x4*)(hout + off + bj * HALF + n * 16) = o;
                        u32x2v w; w.x = cvt_pk_bf16(o[0], o[1]); w.y = cvt_pk_bf16(o[2], o[3]); *(u32x2v*)(hb + off + bj * HALF + n * 16) = w; }
                asm volatile("" ::: "memory"); }
    }
};
}
#define GAS __attribute__((address_space(1)))
#define LAS __attribute__((address_space(3)))
typedef unsigned short bf16;
typedef unsigned v4u __attribute__((ext_vector_type(4)));
typedef float f32x4 __attribute__((ext_vector_type(4)));
typedef short bf16x8 __attribute__((ext_vector_type(8)));
typedef GAS unsigned gu32;
typedef GAS unsigned long long gu64;
#define RLX_AGENT __ATOMIC_RELAXED, __HIP_MEMORY_SCOPE_AGENT
#define LDS_WAIT() asm volatile("s_waitcnt lgkmcnt(0)" ::: "memory")
#define VM_WAIT() asm volatile("s_waitcnt vmcnt(0)" ::: "memory")
__device__ __forceinline__ unsigned long long rt() { return __builtin_amdgcn_s_memrealtime(); }
__device__ __forceinline__ unsigned f2bf(float f) { unsigned u = __builtin_bit_cast(unsigned, f); return (u + 0x7fffu + ((u >> 16) & 1u)) >> 16; }
__device__ __forceinline__ unsigned pk2(float lo, float hi) { return f2bf(lo) | (f2bf(hi) << 16); }

#define XB_TMO      128
#define XB_XCNT(j)  (256  + 64 * (j))
#define XB_XSUB(j)  (1280 + 64 * (j))
#define XB_XGEN(j)  (2304 + 64 * (j))
#define XB_TOP      3328
#define XB_TOPGEN   3392
#define XCD_BAR_WORDS 3456
#define XB_SPIN_CAP (1u << 18)

__device__ __forceinline__ unsigned xb_ld(unsigned* p)              { return __hip_atomic_load(p, __ATOMIC_RELAXED, __HIP_MEMORY_SCOPE_AGENT); }
__device__ __forceinline__ unsigned xb_add(unsigned* p, unsigned v) { return __hip_atomic_fetch_add(p, v, __ATOMIC_RELAXED, __HIP_MEMORY_SCOPE_AGENT); }
__device__ __forceinline__ unsigned xb_xcc_id() { return (unsigned)__builtin_amdgcn_s_getreg((3 << 11) | 20) & 0xFu; }
#define XB_SPIN(cond, bar) do { unsigned _sp = 0; while (cond) { __builtin_amdgcn_s_sleep(1); \
    if ((++_sp & 255u) == 0u) { if (xb_ld(&(bar)[XB_TMO])) break; if (_sp > XB_SPIN_CAP) { atomicAdd(&(bar)[XB_TMO], 1u); break; } } } } while (0)

struct XcdBarrier {
    unsigned* bar; unsigned x;
    volatile LAS unsigned* st;
};

__device__ __forceinline__ XcdBarrier xcd_barrier_post(unsigned* bar, volatile LAS unsigned* st) {
    XcdBarrier b; b.bar = bar; b.x = xb_xcc_id(); b.st = st;
    if (threadIdx.x == 0) (void)xb_add(&bar[XB_XCNT(b.x)], 1u);
    return b;
}
__device__ __forceinline__ void xcd_barrier_complete(unsigned* bar, unsigned x, unsigned& nloc, unsigned& nx) {
    const unsigned G = gridDim.x * gridDim.y * gridDim.z;
    unsigned sum, cnt, mine, sp = 0u;
    for (;;) {
        sum = 0u; cnt = 0u; mine = 0u;
#pragma unroll
        for (unsigned j = 0; j < 16; ++j) { const unsigned c = xb_ld(&bar[XB_XCNT(j)]); sum += c; cnt += (c > 0u) ? 1u : 0u; mine = (j == x) ? c : mine; }
        if (sum == G) break;
        __builtin_amdgcn_s_sleep(1);
        if ((++sp & 255u) == 0u) { if (xb_ld(&bar[XB_TMO])) break; if (sp > XB_SPIN_CAP) { atomicAdd(&bar[XB_TMO], 1u); break; } }
    }
    nloc = mine > 0u ? mine : 1u; nx = cnt > 0u ? cnt : 1u;
}

__device__ __forceinline__ void xcd_barrier(const XcdBarrier& b) {
    asm volatile("s_waitcnt vmcnt(0)" ::: "memory");
    __syncthreads();
    if (threadIdx.x == 0) {
        unsigned* bar = b.bar;
        __builtin_amdgcn_s_waitcnt(0);
        unsigned nloc = b.st[0], nx = b.st[1];
        if (nloc == 0u) { xcd_barrier_complete(bar, b.x, nloc, nx); b.st[0] = nloc; b.st[1] = nx; }
        const unsigned old = xb_add(&bar[XB_XSUB(b.x)], 1u);
        const unsigned gen = old / nloc;
        if (old + 1u == (gen + 1u) * nloc) {
            __builtin_amdgcn_fence(__ATOMIC_RELEASE, "agent");
            asm volatile("s_waitcnt vmcnt(0)" ::: "memory");
            const unsigned og = xb_add(&bar[XB_TOP], 1u);
            const unsigned tg = og / nx;
            if (og + 1u == (tg + 1u) * nx) xb_add(&bar[XB_TOPGEN], 1u);
            else XB_SPIN(xb_ld(&bar[XB_TOPGEN]) == tg, bar);
            __builtin_amdgcn_fence(__ATOMIC_ACQUIRE, "agent");
            xb_add(&bar[XB_XGEN(b.x)], 1u);
            asm volatile("s_waitcnt vmcnt(0)" ::: "memory");
        } else {
            XB_SPIN(xb_ld(&bar[XB_XGEN(b.x)]) == gen, bar);
            __builtin_amdgcn_fence(__ATOMIC_ACQUIRE, "agent");
            asm volatile("s_waitcnt vmcnt(0)" ::: "memory");
        }
    }
    __syncthreads();
}
namespace mb {
constexpr int D = 128, PITCH = 512, OPITCH = 1024;
constexpr float THR = 8.f;
constexpr bool WSKIP = false;
constexpr int KM_OFF = 69632;
constexpr float SCALE = 0.08838834764831845f;
constexpr int NW = 8, QBLK = 32, KVBLK = 64, QB = NW * QBLK;
constexpr int SHM_V = KVBLK * D * 2, SHM_K = KVBLK * D * 2;
constexpr int LDS_BYTES = 2 * SHM_V + 2 * SHM_K + NW * 64 * 4;

typedef short bf16x8 __attribute__((ext_vector_type(8)));
typedef short s16x4 __attribute__((ext_vector_type(4)));
typedef float f32x16 __attribute__((ext_vector_type(16)));
typedef float f32x4 __attribute__((ext_vector_type(4)));
typedef unsigned u32x4 __attribute__((ext_vector_type(4)));
template <class A, class Bt> struct same_t { static constexpr bool v = false; };
template <class A> struct same_t<A, A> { static constexpr bool v = true; };

typedef const GAS char* gcptr;
__device__ __forceinline__ gcptr uni(const void* p) {
    const unsigned long long u = (unsigned long long)p;
    const unsigned lo = __builtin_amdgcn_readfirstlane((unsigned)u), hi = __builtin_amdgcn_readfirstlane((unsigned)(u >> 32));
    return (gcptr)(((unsigned long long)hi << 32) | lo);
}
#define KSWZ(row, colB) ((row) * 256 + ((colB) ^ (((row) & 7) << 4)))
#define SBAR() __builtin_amdgcn_sched_barrier(0)
__device__ __forceinline__ int v_st(int k, int c) { const int kk = (k & ~0xC) | ((k & 4) << 1) | ((k & 8) >> 1); return ((kk >> 3) * 4 + (c >> 5)) * 512 + ((kk & 7) * 32 + (c & 31)) * 2; }
__device__ __forceinline__ int v_rd_base(int lane) { return ((lane & 3) << 3) | (((lane >> 2) & 3) << 6) | (((lane >> 4) & 1) << 5) | (((lane >> 5) & 1) << 8); }
constexpr int v_rd_off(int d0, int ks, int half) { return d0 * 512 + ks * 4096 + half * 2048; }
__device__ __forceinline__ int crow(int r, int hi) { return (r & 3) + 8 * (r >> 2) + 4 * hi; }
__device__ __forceinline__ unsigned cvtpk(float lo, float hi) {
    unsigned r; asm volatile("v_cvt_pk_bf16_f32 %0, %1, %2" : "=v"(r) : "v"(lo), "v"(hi)); return r;
}
__device__ __forceinline__ bf16x8 pack8(f32x4 a, f32x4 b) {
    u32x4 w = {cvtpk(a[0], a[1]), cvtpk(a[2], a[3]), cvtpk(b[0], b[1]), cvtpk(b[2], b[3])};
    return *reinterpret_cast<bf16x8*>(&w);
}
template <class T> __device__ __forceinline__ bf16x8 load8(const T* p) {
    if constexpr (same_t<T, float>::v) { return pack8(*(const f32x4*)p, *(const f32x4*)(p + 4)); }
    else { return *reinterpret_cast<const bf16x8*>(p); }
}
__device__ __forceinline__ void mask_tile(f32x16& p0, f32x16& p1, int dq, unsigned W) {
    const float NEG = -__builtin_inff();
#pragma unroll
    for (int r = 0; r < 16; ++r) {
        const int c = (r & 3) + 8 * (r >> 2);
        if ((unsigned)(dq - c) >= W) p0[r] = NEG;
        if ((unsigned)(dq - c - 32) >= W) p1[r] = NEG;
    }
}
__device__ __forceinline__ void partialSM(f32x16& p0, f32x16& p1, float& m_reg, float& mn, float& alpha) {
    float pmax = p0[0]; for (int r = 1; r < 16; ++r) pmax = fmaxf(pmax, p0[r]); for (int r = 0; r < 16; ++r) pmax = fmaxf(pmax, p1[r]);
    { auto rr = __builtin_amdgcn_permlane32_swap(__float_as_uint(pmax), __float_as_uint(pmax), false, false);
      pmax = fmaxf(__uint_as_float(rr[0]), __uint_as_float(rr[1])); }
    constexpr float C2 = 1.4426950408889634f * SCALE;
    if (__builtin_expect(__all((pmax - m_reg) * SCALE <= THR), 1)) { mn = m_reg; alpha = 1.f; }
    else { mn = fmaxf(m_reg, pmax); alpha = __builtin_amdgcn_exp2f((m_reg - mn) * C2); m_reg = mn; }
    const float mnL = -mn * C2;
    for (int r = 0; r < 16; ++r) p0[r] = fmaf(p0[r], C2, mnL); for (int r = 0; r < 16; ++r) p1[r] = fmaf(p1[r], C2, mnL);
    for (int r = 0; r < 16; ++r) p0[r] = __builtin_amdgcn_exp2f(p0[r]);
}
__device__ __forceinline__ void finishSM(f32x16& p0, f32x16& p1, float alpha, float& l_reg, bf16x8& pa0, bf16x8& pa1, bf16x8& pa2, bf16x8& pa3) {
    for (int r = 0; r < 16; ++r) p1[r] = __builtin_amdgcn_exp2f(p1[r]);
    float ps = 0; for (int r = 0; r < 16; ++r) ps += p0[r]; for (int r = 0; r < 16; ++r) ps += p1[r];
    { auto rr = __builtin_amdgcn_permlane32_swap(__float_as_uint(ps), __float_as_uint(ps), false, false);
      ps = __uint_as_float(rr[0]) + __uint_as_float(rr[1]); }
    l_reg = l_reg * alpha + ps;
#define PK4(P, B_, OUT) do { unsigned a0 = cvtpk(P[B_+0], P[B_+1]), a1 = cvtpk(P[B_+2], P[B_+3]);                          \
        unsigned b0 = cvtpk(P[B_+4], P[B_+5]), b1 = cvtpk(P[B_+6], P[B_+7]);                                             \
        auto r0 = __builtin_amdgcn_permlane32_swap(a0, b0, false, false); auto r1 = __builtin_amdgcn_permlane32_swap(a1, b1, false, false); \
        u32x4 w = {r0[0], r1[0], r0[1], r1[1]}; OUT = *reinterpret_cast<bf16x8*>(&w); } while (0)
    PK4(p0, 0, pa0); PK4(p0, 8, pa1); PK4(p1, 0, pa2); PK4(p1, 8, pa3);
#undef PK4
}
template <int KB, bool SK>
__device__ __forceinline__ void qkt(f32x16& p0, f32x16& p1, const char* K_lds, int r32, int hi, const bf16x8* qr, bool act) {
    if (SK && !act) { const float NEG = -__builtin_inff();
#pragma unroll
        for (int r = 0; r < 16; ++r) { p0[r] = NEG; p1[r] = NEG; } return; }
    p0 = f32x16{}; p1 = f32x16{};
    const char* kb[4];
#pragma unroll
    for (int dd = 0; dd < 4; ++dd) kb[dd] = K_lds + KB * SHM_K + KSWZ(r32, (dd * 16 + hi * 8) * 2);
#pragma unroll
    for (int d0 = 0; d0 < 8; ++d0) { const char* a = kb[d0 & 3] + (d0 >> 2) * 128;
        bf16x8 b0 = *reinterpret_cast<const bf16x8*>(a);
        bf16x8 b1 = *reinterpret_cast<const bf16x8*>(a + 32 * 256);
        p0 = __builtin_amdgcn_mfma_f32_32x32x16_bf16(b0, qr[d0], p0, 0, 0, 0);
        p1 = __builtin_amdgcn_mfma_f32_32x32x16_bf16(b1, qr[d0], p1, 0, 0, 0); }
}
template <int VB, bool SK>
__device__ __forceinline__ void pv_tile(f32x16* o, int vb0, bf16x8 pa0, bf16x8 pa1, bf16x8 pa2, bf16x8 pa3, bool act) {
    if (SK && !act) return;
#define TRRD(dst, off) asm volatile("ds_read_b64_tr_b16 %0, %1 offset:%2" : "=&v"(dst) : "v"(vb0), "i"(off) : "memory")
#define PV_D0(d0) do { s16x4 l0, l1, l2, l3, h0, h1, h2, h3; constexpr int b_ = VB * SHM_V + v_rd_off(d0, 0, 0);     \
        TRRD(l0, b_); TRRD(h0, b_ + 2048); TRRD(l1, b_ + 4096); TRRD(h1, b_ + 6144); TRRD(l2, b_ + 8192); TRRD(h2, b_ + 10240); TRRD(l3, b_ + 12288); TRRD(h3, b_ + 14336); \
        asm volatile("s_waitcnt lgkmcnt(0)" ::: "memory"); SBAR();                 \
        o[d0] = __builtin_amdgcn_mfma_f32_32x32x16_bf16(pa0, (bf16x8){l0[0], l0[1], l0[2], l0[3], h0[0], h0[1], h0[2], h0[3]}, o[d0], 0, 0, 0);   \
        o[d0] = __builtin_amdgcn_mfma_f32_32x32x16_bf16(pa1, (bf16x8){l1[0], l1[1], l1[2], l1[3], h1[0], h1[1], h1[2], h1[3]}, o[d0], 0, 0, 0);   \
        o[d0] = __builtin_amdgcn_mfma_f32_32x32x16_bf16(pa2, (bf16x8){l2[0], l2[1], l2[2], l2[3], h2[0], h2[1], h2[2], h2[3]}, o[d0], 0, 0, 0);   \
        o[d0] = __builtin_amdgcn_mfma_f32_32x32x16_bf16(pa3, (bf16x8){l3[0], l3[1], l3[2], l3[3], h3[0], h3[1], h3[2], h3[3]}, o[d0], 0, 0, 0); } while (0)
    PV_D0(0); PV_D0(1); PV_D0(2); PV_D0(3);
#undef PV_D0
#undef TRRD
}

template <class TIn, class TOut> struct BlockRef { const TIn* Q; const TIn* K; const TIn* V; TOut* O; const float* KM; int P0; int t_lo, t_hi; TOut* OP; float* LSE; };
template <class TIn> struct Seam {
    bf16x8 qr[8];
    bf16x8 st_v0, st_v1, st_k0, st_k1; f32x4 sf0, sf1, sf2, sf3;
    f32x4 tq[16];
};
__device__ __forceinline__ int swa_jlo(int P0, int W) { const int lowk = P0 - W + 1; return lowk > 0 ? lowk / KVBLK : 0; }
#define ROW(p, k0, rr) ((p) + (size_t)((k0) + (rr)) * PITCH + sc)
#define VMW() asm volatile("s_waitcnt vmcnt(0)" ::: "memory")
#define VMWN(n) asm volatile("s_waitcnt vmcnt(%0)" :: "i"(n) : "memory")
#define LD16U(base, boff) (*(const GAS bf16x8*)(uni((const char*)(base) + (size_t)(boff)) + voff))
#define SLOAD_H(Kp, Vp, k0) do { S.st_v0 = LD16U(Vp, (size_t)(k0) * (PITCH * 2)); S.st_v1 = LD16U(Vp, (size_t)((k0) + 32) * (PITCH * 2));              \
                         S.st_k0 = LD16U(Kp, (size_t)(k0) * (PITCH * 2)); S.st_k1 = LD16U(Kp, (size_t)((k0) + 32) * (PITCH * 2)); } while (0)
#define SWRITE_HK(bf) do { *(bf16x8*)(K_lds + (bf) * SHM_K + kws) = S.st_k0; *(bf16x8*)(K_lds + (bf) * SHM_K + kws + 32 * 256) = S.st_k1; } while (0)
#define SWRITE_HV(bf) do { *(bf16x8*)(V_lds + (bf) * SHM_V + vst0) = S.st_v0; *(bf16x8*)(V_lds + (bf) * SHM_V + vst1) = S.st_v1; } while (0)
#define SWRITE_H(bf) do { SWRITE_HV(bf); SWRITE_HK(bf); } while (0)
#define SLOAD_F(p, k0) do { S.sf0 = *(const f32x4*)ROW(p, k0, sr); S.sf1 = *(const f32x4*)(ROW(p, k0, sr) + 4);                \
                            S.sf2 = *(const f32x4*)ROW(p, k0, 32 + sr); S.sf3 = *(const f32x4*)(ROW(p, k0, 32 + sr) + 4); } while (0)
#define SWRITE_KF(bf) do { *(bf16x8*)(K_lds + (bf) * SHM_K + kws) = pack8(S.sf0, S.sf1); *(bf16x8*)(K_lds + (bf) * SHM_K + kws + 32 * 256) = pack8(S.sf2, S.sf3); } while (0)
#define SWRITE_VF(bf) do { *(bf16x8*)(V_lds + (bf) * SHM_V + vst0) = pack8(S.sf0, S.sf1); *(bf16x8*)(V_lds + (bf) * SHM_V + vst1) = pack8(S.sf2, S.sf3); } while (0)
template <class TIn, class TOut>
__device__ __forceinline__ void causal_swa_prime(const BlockRef<TIn, TOut>& cur, int W, char* lds, Seam<TIn>& S) {
    constexpr bool F32 = same_t<TIn, float>::v;
    int tid = threadIdx.x; asm volatile("" : "+v"(tid));
    const int wid = __builtin_amdgcn_readfirstlane(tid >> 6), lane = tid & 63, r32 = lane & 31, hi = lane >> 5;
    const int sr = tid >> 4, sc = (tid & 15) * 8, kws = KSWZ(sr, sc * 2); char* K_lds = lds + 2 * SHM_V;
    const unsigned voff = (unsigned)(sr * PITCH + sc) * 2u, qoff = (unsigned)((wid * QBLK + r32) * PITCH + hi * 8) * 2u;
    const int kb0 = cur.t_lo * KVBLK;
    for (int d0 = 0; d0 < 8; ++d0) S.qr[d0] = *(const GAS bf16x8*)(uni((const char*)cur.Q + d0 * 32) + qoff);
    if constexpr (F32) { SLOAD_F((const float*)cur.K, kb0); VMW(); SWRITE_KF(0); SBAR(); SLOAD_F((const float*)cur.V, kb0); }
    else { SLOAD_H(cur.K, cur.V, kb0); VMW(); SWRITE_HK(0); }
    __syncthreads();
}
template <class TIn, class TOut>
__device__ __forceinline__ void causal_swa_block(const BlockRef<TIn, TOut>& cur, const BlockRef<TIn, TOut>& nxt, int skv, int W, char* lds, Seam<TIn>& S) {
    constexpr bool F32 = same_t<TIn, float>::v;
    int tid = threadIdx.x; asm volatile("" : "+v"(tid));
    const int wid = __builtin_amdgcn_readfirstlane(tid >> 6), lane = tid & 63, r32 = lane & 31, hi = lane >> 5;
    const int j_lo = cur.t_lo, j_hi = cur.t_hi;
    const int NT = j_hi - j_lo;
    const int kbn = nxt.t_lo * KVBLK;
    const int qlo = cur.P0 + wid * QBLK, qm = qlo + r32 - 4 * hi;
    char* V_lds = lds; char* K_lds = lds + 2 * SHM_V;
    float* ws = (float*)(lds + 2 * SHM_V + 2 * SHM_K) + wid * 64; float* li_l = ws, * al_l = ws + 32;
    float m_reg = -1e30f, l_reg = 0; f32x16 o[4] = {};
    const int sr = tid >> 4, sc = (tid & 15) * 8, vst0 = v_st(sr, sc), vst1 = v_st(32 + sr, sc), kws = KSWZ(sr, sc * 2);
    const unsigned voff = (unsigned)(sr * PITCH + sc) * 2u, qoff = (unsigned)((wid * QBLK + r32) * PITCH + hi * 8) * 2u;
    const int vb0 = (int)(uintptr_t)V_lds + v_rd_base(lane);
    const TIn* Kh = cur.K; const TIn* Vh = cur.V;
    const int own = cur.P0 / QB, own4 = cur.P0 / KVBLK;
    unsigned sel = 0u;
    {
        float* km = (float*)(lds + KM_OFF);
        for (int i = tid; i < 16 * 128; i += 64 * NW) { const GAS float* p = (const GAS float*)(uni(cur.KM) + (unsigned)(((i >> 7) * 512 + (i & 127)) * 4)); km[i] = (p[0] + p[128]) + (p[256] + p[384]); }
        __syncthreads();
        float best[3] = {-3e38f, -3e38f, -3e38f}; int bidx[3] = {0, 0, 0};
#pragma unroll 1
        for (int j = 0; j < own; ++j) {
            float a = 0.f;
#pragma unroll
            for (int d0 = 0; d0 < 8; ++d0) {
                const f32x4 k0 = *(const f32x4*)(km + j * 128 + d0 * 16 + hi * 8), k1 = *(const f32x4*)(km + j * 128 + d0 * 16 + hi * 8 + 4);
                const u32x4 qw = *reinterpret_cast<const u32x4*>(&S.qr[d0]);
                a += __uint_as_float(qw[0] << 16) * k0[0] + __uint_as_float(qw[0] & 0xffff0000u) * k0[1] + __uint_as_float(qw[1] << 16) * k0[2] + __uint_as_float(qw[1] & 0xffff0000u) * k0[3]
                   + __uint_as_float(qw[2] << 16) * k1[0] + __uint_as_float(qw[2] & 0xffff0000u) * k1[1] + __uint_as_float(qw[3] << 16) * k1[2] + __uint_as_float(qw[3] & 0xffff0000u) * k1[3];
            }
            a += __shfl_xor(a, 32);
            if (a > best[0]) { best[2] = best[1]; bidx[2] = bidx[1]; best[1] = best[0]; bidx[1] = bidx[0]; best[0] = a; bidx[0] = j; }
            else if (a > best[1]) { best[2] = best[1]; bidx[2] = bidx[1]; best[1] = a; bidx[1] = j; }
            else if (a > best[2]) { best[2] = a; bidx[2] = j; }
        }
#pragma unroll
        for (int r = 0; r < 3; ++r) if (best[r] > -1e37f) sel |= 1u << bidx[r];
    }
#define RESC(a) do { if (__any((a) < 1.f)) { if (hi == 0) al_l[r32] = (a); asm volatile("s_waitcnt lgkmcnt(0)" ::: "memory");              \
                     for (int d_ = 0; d_ < 4; ++d_) for (int r = 0; r < 16; ++r) o[d_][r] *= al_l[crow(r, hi)]; } } while (0)
#define KBASE(t) ((j_lo + (t)) * KVBLK)
#define ACT(t) (KBASE(t) <= qlo + QBLK - 1 && KBASE(t) + KVBLK - 1 >= qlo - W + 1)
#define MASKT(P0_, P1_, t) do { const int kb_ = KBASE(t), gt_ = j_lo + (t); if (gt_ >= own4) { if (kb_ + KVBLK - 1 > qlo) mask_tile(P0_, P1_, qm - kb_, 0x3fffffffu); } else if (!((sel >> (gt_ >> 2)) & 1u)) { const float NEG_ = -__builtin_inff(); _Pragma("unroll") for (int r_ = 0; r_ < 16; ++r_) { P0_[r_] = NEG_; P1_[r_] = NEG_; } } } while (0)
    constexpr int NQL = F32 ? 16 : 8;
    constexpr bool SK = WSKIP && !F32;
#define SEAM_K0() do { VMWN(NQL); if constexpr (F32) { SWRITE_KF(0); SBAR(); SLOAD_F((const float*)nxt.V, kbn); } else { SWRITE_HK(0); } SBAR(); } while (0)
    f32x16 pA0, pA1, pB0, pB1; float mnA, mnB, alA, alB; bf16x8 pa0, pa1, pa2, pa3;
    if constexpr (F32) { VMW(); SWRITE_VF(0); SBAR(); } else { SWRITE_HV(0); SBAR(); }
    if (NT > 1) { if constexpr (F32) SLOAD_F((const float*)Kh, KBASE(1)); else SLOAD_H(Kh, Vh, KBASE(1)); }
    SBAR(); qkt<0, SK>(pA0, pA1, K_lds, r32, hi, S.qr, ACT(0));
    if constexpr (F32) { if (NT > 1) { VMW(); SWRITE_KF(1); SBAR(); SLOAD_F((const float*)Vh, KBASE(1)); } }
    MASKT(pA0, pA1, 0); partialSM(pA0, pA1, m_reg, mnA, alA);
    if (NT > 1) { VMW(); if constexpr (F32) { SWRITE_VF(1); SBAR(); if (NT > 2) SLOAD_F((const float*)Kh, KBASE(2)); } else SWRITE_H(1); }
    __syncthreads();
#define HALF_STEP(PX0, PX1, mnX, alX, PY0, PY1, alY, t, KB, VB, SB) do {                                                      \
        SBAR(); qkt<KB, SK>(PX0, PX1, K_lds, r32, hi, S.qr, ACT(t));                                             \
        finishSM(PY0, PY1, alY, l_reg, pa0, pa1, pa2, pa3); SBAR();                                                           \
        if ((t) + 1 < NT) { if constexpr (F32) { VMW(); SWRITE_KF(SB); SBAR(); SLOAD_F((const float*)Vh, KBASE((t) + 1)); }  \
                            else { SLOAD_H(Kh, Vh, KBASE((t) + 1)); } SBAR(); }                                               \
        pv_tile<VB, SK>(o, vb0, pa0, pa1, pa2, pa3, ACT((t) - 1)); MASKT(PX0, PX1, (t)); partialSM(PX0, PX1, m_reg, mnX, alX);                                        \
        __syncthreads();                                                                                                      \
        if ((t) + 1 < NT) { VMW(); if constexpr (F32) { SWRITE_VF(SB); SBAR(); if ((t) + 2 < NT) SLOAD_F((const float*)Kh, KBASE((t) + 2)); } \
                            else { SWRITE_H(SB); } }                                                                          \
        RESC(alX); __syncthreads(); } while (0)
    for (int t = 1; t + 1 < NT; t += 2) {
        HALF_STEP(pB0, pB1, mnB, alB, pA0, pA1, alA, t, 1, 0, 0);
        HALF_STEP(pA0, pA1, mnA, alA, pB0, pB1, alB, t + 1, 0, 1, 1);
    }
    const bool even = (NT & 1) == 0;
    if (even) { SBAR(); qkt<1, SK>(pB0, pB1, K_lds, r32, hi, S.qr, ACT(NT - 1)); SBAR(); }
#define QROW(e) (nxt.Q + (size_t)(wid * QBLK + r32) * PITCH + ((e) >> 1) * 16 + hi * 8 + ((e) & 1) * 4)
    if constexpr (F32) { SLOAD_F((const float*)nxt.K, kbn); SBAR();
#pragma unroll
        for (int e = 0; e < 8; ++e) S.tq[e] = *(const f32x4*)QROW(e); }
    else { SLOAD_H(nxt.K, nxt.V, kbn); SBAR();
#pragma unroll
        for (int d0 = 0; d0 < 8; ++d0) S.qr[d0] = *(const GAS bf16x8*)(uni((const char*)nxt.Q + d0 * 32) + qoff); }
    SBAR();
    finishSM(pA0, pA1, alA, l_reg, pa0, pa1, pa2, pa3); SBAR();
    if constexpr (F32) {
#pragma unroll
        for (int e = 8; e < 16; ++e) S.tq[e] = *(const f32x4*)QROW(e); SBAR(); }
#undef QROW
    pv_tile<0, SK>(o, vb0, pa0, pa1, pa2, pa3, ACT(even ? NT - 2 : NT - 1));
    if (even) { MASKT(pB0, pB1, NT - 1); partialSM(pB0, pB1, m_reg, mnB, alB); __syncthreads(); RESC(alB);
        finishSM(pB0, pB1, alB, l_reg, pa0, pa1, pa2, pa3); SBAR(); pv_tile<1, SK>(o, vb0, pa0, pa1, pa2, pa3, ACT(NT - 1)); }
    SBAR(); SEAM_K0();
    if (hi == 0) li_l[r32] = l_reg; asm volatile("s_waitcnt lgkmcnt(0)" ::: "memory");
    float rli[16];
#pragma unroll
    for (int r = 0; r < 16; ++r) { const float li_ = li_l[crow(r, hi)]; rli[r] = li_ > 0.f ? __builtin_amdgcn_rcpf(li_) : 0.f; }
    if (cur.OP) {
        if (hi == 0) cur.LSE[wid * QBLK + r32] = l_reg > 0.f ? m_reg * (1.4426950408889634f * SCALE) + __builtin_amdgcn_logf(l_reg) : -__builtin_inff();
        GAS char* Ow = (GAS char*)uni(cur.OP + (size_t)(wid * QBLK) * 128);
        unsigned obase = (unsigned)((4 * hi * 128 + r32) * 2); asm volatile("" : "+v"(obase));
#pragma unroll
        for (int r = 0; r < 16; ++r) {
#pragma unroll
            for (int d0 = 0; d0 < 4; ++d0) { const float v = o[d0][r] * rli[r];
                const float vn = __shfl_xor(v, 1);
                if ((r32 & 1) == 0) *(GAS unsigned*)(Ow + (obase + (unsigned)((((r & 3) + 8 * (r >> 2)) * 128 + d0 * 32) * 2))) = cvtpk(v, vn); } }
    } else {
        GAS char* Ow = (GAS char*)uni(cur.O + (size_t)(wid * QBLK) * OPITCH);
        unsigned obase = (unsigned)((4 * hi * OPITCH + r32) * 2); asm volatile("" : "+v"(obase));
#pragma unroll
        for (int r = 0; r < 16; ++r) {
#pragma unroll
            for (int d0 = 0; d0 < 4; ++d0) { const float v = o[d0][r] * rli[r];
                const float vn = __shfl_xor(v, 1);
                if ((r32 & 1) == 0) *(GAS unsigned*)(Ow + (obase + (unsigned)((((r & 3) + 8 * (r >> 2)) * OPITCH + d0 * 32) * 2))) = cvtpk(v, vn); } }
    }
    if constexpr (F32) {
#pragma unroll
        for (int d0 = 0; d0 < 8; ++d0) S.qr[d0] = pack8(S.tq[2 * d0], S.tq[2 * d0 + 1]); }
    __syncthreads();
#undef RESC
#undef KBASE
#undef ACT
#undef MASKT
#undef SEAM_K0
#undef HALF_STEP
}
#undef ROW
#undef VMW
#undef VMWN
#undef SLOAD_H
#undef LD16U
#undef SWRITE_HK
#undef SWRITE_HV
#undef SWRITE_H
#undef SLOAD_F
#undef SWRITE_KF
#undef SWRITE_VF
}
namespace dn {
typedef short bf16x8 __attribute__((ext_vector_type(8)));
typedef float f32x16 __attribute__((ext_vector_type(16)));
typedef float f32x4 __attribute__((ext_vector_type(4)));
typedef unsigned u32x4 __attribute__((ext_vector_type(4)));
typedef unsigned u32x2 __attribute__((ext_vector_type(2)));
#define DNI __device__ __forceinline__
#define DN_MFMA(a, b, c) __builtin_amdgcn_mfma_f32_32x32x16_bf16((a), (b), (c), 0, 0, 0)
constexpr int LQ = 136, LT = 72;
constexpr int BLOB_FRAGS = 56, BLOB_BYTES = BLOB_FRAGS * 1024, UF_BYTES = 16384;
constexpr int L_QS = 0, L_KS = 17408, L_KST = 34816, L_VST = 53248, L_AF = 71680, L_ABF = 89088, L_TRM = 98304, L_TW = 107520, L_TU = 116736,
              L_T00T = 125952, L_GATE = 128512, L_CONVW = 129536, L_END = 135680;
DNI int crow(int i, int h) { return (i & 3) + 8 * (i >> 2) + 4 * h; }
DNI unsigned cvtpk2(float lo, float hi) {
    typedef float f2_t __attribute__((ext_vector_type(2))); typedef __bf16 b2_t __attribute__((ext_vector_type(2)));
    f2_t v = {lo, hi}; b2_t b = __builtin_convertvector(v, b2_t); return __builtin_bit_cast(unsigned, b);
}
template <int SS> DNI bf16x8 pack_acc(const f32x16& x) {
    u32x4 p = {cvtpk2(x[8 * SS], x[8 * SS + 1]), cvtpk2(x[8 * SS + 2], x[8 * SS + 3]), cvtpk2(x[8 * SS + 4], x[8 * SS + 5]), cvtpk2(x[8 * SS + 6], x[8 * SS + 7])};
    return __builtin_bit_cast(bf16x8, p);
}
DNI bf16x8 lds16(const LAS unsigned char* p) { return *(const LAS bf16x8*)p; }
DNI bf16x8 lds_perm8(const LAS unsigned char* rowp, int colbase, int h) {
    const u32x2 a = *(const LAS u32x2*)(rowp + (colbase + 4 * h) * 2), b = *(const LAS u32x2*)(rowp + (colbase + 8 + 4 * h) * 2);
    u32x4 p = {a.x, a.y, b.x, b.y}; return __builtin_bit_cast(bf16x8, p);
}
DNI float bflo_(unsigned w) { return __uint_as_float(w << 16); }
DNI float bfhi_(unsigned w) { return __uint_as_float(w & 0xffff0000u); }

DNI void chunk_local(LAS unsigned char* lds, int item, const bf16* PJ, size_t pj_stride, const float* GATES, const float* conv_w, const float* a_log, const float* dt_bias,
                     unsigned char* BLOB, unsigned char* UF, float* GL) {
    int tid = threadIdx.x; asm volatile("" : "+v"(tid));
    const int wid = __builtin_amdgcn_readfirstlane(tid >> 6), lane = tid & 63, r = lane & 31, h2 = lane >> 5;
    const int n = item & 63, hd = (item >> 6) & 3, b = item >> 8;
    const size_t row0 = (size_t)b * 4096 + (size_t)n * 64;
    LAS float* gate = (LAS float*)(lds + L_GATE);
    LAS float* convw = (LAS float*)(lds + L_CONVW);
    unsigned char* blob = BLOB + (size_t)item * BLOB_BYTES;
    for (int i = tid; i < 4 * 384; i += 512) { const int j = i / 384, c = i % 384; convw[i] = conv_w[j * 1536 + (c >> 7) * 512 + hd * 128 + (c & 127)]; }
    if (wid == 0) {
        const size_t m = row0 + lane;
        const float braw = GATES[m * 8 + hd], araw = GATES[m * 8 + 4 + hd];
        const float beta = 1.f / (1.f + __expf(-braw));
        const float sp = fmaxf(araw + dt_bias[hd], 0.f) + log1pf(__expf(-fabsf(araw + dt_bias[hd])));
        float g = -__expf(a_log[hd]) * sp;
#pragma unroll
        for (int d = 1; d < 64; d <<= 1) { const float t = __shfl_up(g, d); if (lane >= d) g += t; }
        const float glast = __shfl(g, 63);
        gate[lane] = beta; gate[64 + lane] = g; gate[128 + lane] = __expf(g); gate[192 + lane] = __expf(glast - g);
        if (lane == 63) GL[item] = __expf(glast);
    }
    __syncthreads();
    {
        const int row = tid >> 3, seg = tid & 7, c0 = seg * 16, t = n * 64 + row;
        float val[3][16];
#pragma unroll
        for (int X = 0; X < 3; ++X) {
#pragma unroll
            for (int e = 0; e < 16; ++e) val[X][e] = 0.f;
#pragma unroll
            for (int j = 0; j < 4; ++j) {
                if (t - 3 + j >= 0) {
                    const bf16* src = PJ + (size_t)X * pj_stride + (row0 + row - 3 + j) * 512 + hd * 128 + c0;
                    const u32x4 w0 = *(const u32x4*)src, w1 = *(const u32x4*)(src + 8);
                    const LAS float* cw = convw + j * 384 + X * 128 + c0;
#pragma unroll
                    for (int e = 0; e < 4; ++e) { val[X][2 * e] += cw[2 * e] * bflo_(w0[e]); val[X][2 * e + 1] += cw[2 * e + 1] * bfhi_(w0[e]);
                                                  val[X][8 + 2 * e] += cw[8 + 2 * e] * bflo_(w1[e]); val[X][8 + 2 * e + 1] += cw[8 + 2 * e + 1] * bfhi_(w1[e]); }
                }
            }
#pragma unroll
            for (int e = 0; e < 16; ++e) val[X][e] = val[X][e] / (1.f + __expf(-val[X][e]));
        }
        float sq = 0.f, sk = 0.f;
#pragma unroll
        for (int e = 0; e < 16; ++e) { sq += val[0][e] * val[0][e]; sk += val[1][e] * val[1][e]; }
        sq += __shfl_xor(sq, 1); sq += __shfl_xor(sq, 2); sq += __shfl_xor(sq, 4);
        sk += __shfl_xor(sk, 1); sk += __shfl_xor(sk, 2); sk += __shfl_xor(sk, 4);
        const float rq = rsqrtf(sq + 1e-6f) * 0.08838834764831845f, rk = rsqrtf(sk + 1e-6f);
        u32x4 qa, qb, ka, kb;
#pragma unroll
        for (int e = 0; e < 4; ++e) { qa[e] = cvtpk2(val[0][2 * e] * rq, val[0][2 * e + 1] * rq); qb[e] = cvtpk2(val[0][8 + 2 * e] * rq, val[0][8 + 2 * e + 1] * rq);
                                      ka[e] = cvtpk2(val[1][2 * e] * rk, val[1][2 * e + 1] * rk); kb[e] = cvtpk2(val[1][8 + 2 * e] * rk, val[1][8 + 2 * e + 1] * rk); }
        *(LAS u32x4*)(lds + L_QS + (row * LQ + c0) * 2) = qa; *(LAS u32x4*)(lds + L_QS + (row * LQ + c0 + 8) * 2) = qb;
        *(LAS u32x4*)(lds + L_KS + (row * LQ + c0) * 2) = ka; *(LAS u32x4*)(lds + L_KS + (row * LQ + c0 + 8) * 2) = kb;
#pragma unroll
        for (int e = 0; e < 16; ++e) {
            const unsigned kw = (e < 8) ? ka[e >> 1] : kb[(e - 8) >> 1];
            *(LAS unsigned short*)(lds + L_KST + ((c0 + e) * LT + row) * 2) = (unsigned short)((e & 1) ? (kw >> 16) : (kw & 0xffffu));
            *(LAS unsigned short*)(lds + L_VST + ((c0 + e) * LT + row) * 2) = (unsigned short)(cvtpk2(val[2][e], 0.f) & 0xffffu);
        }
    }
    __syncthreads();
    {
        const int p = wid >> 2, ri = (wid >> 1) & 1, ci = wid & 1;
        const LAS unsigned char* Ap = lds + L_KS + ((32 * ri + r) * LQ + 8 * h2) * 2;
        const LAS unsigned char* Bp = lds + (p == 0 ? L_KS : L_QS) + ((32 * ci + r) * LQ + 8 * h2) * 2;
        f32x16 acc = {};
        const bool live = (p == 0) ? (ri >= ci) : (ri <= ci);
        if (live) {
#pragma unroll
            for (int ks = 0; ks < 8; ++ks) acc = DN_MFMA(lds16(Ap + ks * 32), lds16(Bp + ks * 32), acc);
        }
        const int colg = 32 * ci + r;
        const float gcol = gate[64 + colg];
        if (p == 0) {
#pragma unroll
            for (int i = 0; i < 16; ++i) {
                const int c = 32 * ri + crow(i, h2);
                const float a = (c > colg) ? gate[c] * acc[i] * __expf(gate[64 + c] - gcol) : 0.f;
                *(LAS float*)(lds + L_AF + (c * 68 + colg) * 4) = a;
                *(LAS unsigned short*)(lds + L_ABF + (c * LT + colg) * 2) = (unsigned short)(cvtpk2(a, 0.f) & 0xffffu);
            }
        } else {
            f32x16 x;
#pragma unroll
            for (int i = 0; i < 16; ++i) { const int s = 32 * ri + crow(i, h2); x[i] = (colg >= s) ? acc[i] * __expf(gcol - gate[64 + s]) : 0.f; }
            *(u32x4*)(blob + (32 + ci * 4 + 2 * ri + 0) * 1024 + lane * 16) = __builtin_bit_cast(u32x4, pack_acc<0>(x));
            *(u32x4*)(blob + (32 + ci * 4 + 2 * ri + 1) * 1024 + lane * 16) = __builtin_bit_cast(u32x4, pack_acc<1>(x));
        }
    }
    __syncthreads();
    if (wid == 0) {
        const int blk = h2, j = r, jg = 32 * blk + j;
        float x[32];
#pragma unroll
        for (int c = 0; c < 32; ++c) {
            float a = (c == j) ? 1.f : 0.f;
            const LAS float* arow = (const LAS float*)(lds + L_AF) + (32 * blk + c) * 68 + 32 * blk;
#pragma unroll
            for (int s = 0; s < c; ++s) a -= arow[s] * x[s];
            x[c] = a;
        }
        const float sw = gate[jg] * gate[128 + jg], su = gate[jg];
#pragma unroll
        for (int c = 0; c < 32; ++c) {
            const int off = ((32 * blk + c) * LT + jg) * 2;
            *(LAS unsigned short*)(lds + L_TRM + off) = (unsigned short)(cvtpk2(x[c], 0.f) & 0xffffu);
            *(LAS unsigned short*)(lds + L_TW + off) = (unsigned short)(cvtpk2(x[c] * sw, 0.f) & 0xffffu);
            *(LAS unsigned short*)(lds + L_TU + off) = (unsigned short)(cvtpk2(x[c] * su, 0.f) & 0xffffu);
        }
        if (blk == 0) {
#pragma unroll
            for (int c4 = 0; c4 < 4; ++c4) { u32x4 w = {cvtpk2(x[8 * c4], x[8 * c4 + 1]), cvtpk2(x[8 * c4 + 2], x[8 * c4 + 3]), cvtpk2(x[8 * c4 + 4], x[8 * c4 + 5]), cvtpk2(x[8 * c4 + 6], x[8 * c4 + 7])};
                *(LAS u32x4*)(lds + L_T00T + (j * 40 + 8 * c4) * 2) = w; }
        }
        asm volatile("s_waitcnt lgkmcnt(0)" ::: "memory");
        f32x16 m1 = {};
#pragma unroll
        for (int ks = 0; ks < 2; ++ks) m1 = DN_MFMA(lds16(lds + L_ABF + ((32 + r) * LT + 16 * ks + 8 * h2) * 2), lds16(lds + L_T00T + (r * 40 + 16 * ks + 8 * h2) * 2), m1);
        f32x16 t10 = {};
        t10 = DN_MFMA(lds_perm8(lds + L_TRM + ((32 + r) * LT) * 2, 32 + 0, h2), pack_acc<0>(m1), t10);
        t10 = DN_MFMA(lds_perm8(lds + L_TRM + ((32 + r) * LT) * 2, 32 + 16, h2), pack_acc<1>(m1), t10);
        const float sw0 = gate[r] * gate[128 + r], su0 = gate[r];
#pragma unroll
        for (int i = 0; i < 16; ++i) {
            const int off = ((32 + crow(i, h2)) * LT + r) * 2; const float tv = -t10[i];
            *(LAS unsigned short*)(lds + L_TW + off) = (unsigned short)(cvtpk2(tv * sw0, 0.f) & 0xffffu);
            *(LAS unsigned short*)(lds + L_TU + off) = (unsigned short)(cvtpk2(tv * su0, 0.f) & 0xffffu);
        }
    } else {
        for (int f = wid - 1; f < 32; f += 7) {
            bf16x8 v; float sc[8];
            if (f < 16) {
                const int mt = f >> 3, s = f & 7, row = 32 * mt + r;
                v = lds_perm8(lds + L_QS + (row * LQ) * 2, 32 * (s >> 1) + 16 * (s & 1), h2);
                const float e = gate[128 + row];
#pragma unroll
                for (int jj = 0; jj < 8; ++jj) sc[jj] = e;
            } else {
                const int kt = (f - 16) >> 2, s2 = (f - 16) & 3, row = 32 * kt + r, cb = 32 * (s2 >> 1) + 16 * (s2 & 1);
                v = lds_perm8(lds + L_KST + (row * LT) * 2, cb, h2);
#pragma unroll
                for (int jj = 0; jj < 8; ++jj) sc[jj] = gate[192 + cb + 8 * (jj >> 2) + 4 * h2 + (jj & 3)];
            }
            const u32x4 w = __builtin_bit_cast(u32x4, v);
            u32x4 o;
#pragma unroll
            for (int e = 0; e < 4; ++e) o[e] = cvtpk2(bflo_(w[e]) * sc[2 * e], bfhi_(w[e]) * sc[2 * e + 1]);
            *(u32x4*)(blob + (f < 16 ? 16 + f : 40 + (f - 16)) * 1024 + lane * 16) = o;
        }
    }
    __syncthreads();
    {
        const int kt = wid >> 1, mt = wid & 1;
        f32x16 wt = {}, ut = {};
        const int nks = mt == 0 ? 2 : 4;
        for (int ks = 0; ks < nks; ++ks) {
            wt = DN_MFMA(lds16(lds + L_KST + ((32 * kt + r) * LT + 16 * ks + 8 * h2) * 2), lds16(lds + L_TW + ((32 * mt + r) * LT + 16 * ks + 8 * h2) * 2), wt);
            ut = DN_MFMA(lds16(lds + L_TU + ((32 * mt + r) * LT + 16 * ks + 8 * h2) * 2), lds16(lds + L_VST + ((32 * kt + r) * LT + 16 * ks + 8 * h2) * 2), ut);
        }
#pragma unroll
        for (int i = 0; i < 16; ++i) wt[i] = -wt[i];
        *(u32x4*)(blob + (mt * 8 + 2 * kt + 0) * 1024 + lane * 16) = __builtin_bit_cast(u32x4, pack_acc<0>(wt));
        *(u32x4*)(blob + (mt * 8 + 2 * kt + 1) * 1024 + lane * 16) = __builtin_bit_cast(u32x4, pack_acc<1>(wt));
        unsigned char* uf = UF + (size_t)item * UF_BYTES + ((kt * 2 + mt) * 64 + lane) * 32;
        *(u32x4*)uf = __builtin_bit_cast(u32x4, pack_acc<0>(ut)); *(u32x4*)(uf + 16) = __builtin_bit_cast(u32x4, pack_acc<1>(ut));
    }
    __syncthreads();
}

constexpr int S_SLOT = 32768, S_END = 4 * S_SLOT;
DNI void glds16(const void* gsrc, LAS unsigned char* dst) { __builtin_amdgcn_global_load_lds((const GAS unsigned*)gsrc, (LAS unsigned*)dst, 16, 0, 0); }
DNI void scan_bh(LAS unsigned char* lds, int bh, const unsigned char* BLOB, const unsigned char* UF, const float* GL, unsigned char* SF, unsigned char* VF) {
    int tid = threadIdx.x; asm volatile("" : "+v"(tid));
    const int wid = __builtin_amdgcn_readfirstlane(tid >> 6), lane = tid & 63;
    const unsigned char* blob0 = BLOB + (size_t)bh * 64 * BLOB_BYTES;
    unsigned lane16 = (unsigned)lane * 16u; asm volatile("" : "+v"(lane16));
#define DN_B() do { __builtin_amdgcn_s_barrier(); asm volatile("" ::: "memory"); } while (0)
    if (wid >= 4) {
        const int lw = wid - 4;
#define DN_ISSUE(c) do { const unsigned char* bc_ = blob0 + (size_t)(c) * BLOB_BYTES + lw * 1024; LAS unsigned char* sl_ = lds + ((c) & 3) * S_SLOT + lw * 1024; _Pragma("unroll") for (int i_ = 0; i_ < 4; ++i_) { \
        glds16(bc_ + i_ * 4096 + lane16, sl_ + i_ * 4096); glds16(bc_ + 40960 + i_ * 4096 + lane16, sl_ + 16384 + i_ * 4096); } } while (0)
        DN_ISSUE(0); DN_ISSUE(1); DN_ISSUE(2);
        asm volatile("s_waitcnt vmcnt(16)" ::: "memory"); DN_B();
#pragma unroll 1
        for (int c = 0; c < 64; ++c) {
            if (c + 3 < 64) { DN_ISSUE(c + 3); asm volatile("s_waitcnt vmcnt(16)" ::: "memory"); }
            else if (c + 2 < 64) asm volatile("s_waitcnt vmcnt(8)" ::: "memory");
            else asm volatile("s_waitcnt vmcnt(0)" ::: "memory");
            DN_B();
        }
#undef DN_ISSUE
    } else {
        const float glv = GL[bh * 64 + lane];
        const unsigned char* uf0 = UF + (size_t)bh * 64 * UF_BYTES + (wid * 128 + lane) * 32;
        unsigned char* sf0 = SF + ((size_t)(bh * 64) * 4 + wid) * 8192 + lane * 16;
        unsigned char* vf0 = VF + ((size_t)(bh * 64) * 4 + wid) * 4096 + lane * 16;
        f32x16 S0 = {}, S1 = {}, S2 = {}, S3 = {};
        u32x4 ua[4], ub[4];
#define DN_ULOAD(U, c) do { const unsigned char* u_ = uf0 + (size_t)(c) * UF_BYTES; U[0] = *(const u32x4*)u_; U[1] = *(const u32x4*)(u_ + 16); U[2] = *(const u32x4*)(u_ + 2048); U[3] = *(const u32x4*)(u_ + 2048 + 16); } while (0)
        DN_ULOAD(ua, 0); DN_ULOAD(ub, 1);
        DN_B();
#define RD4(X, f0, f1, f2, f3) do { asm volatile("ds_read_b128 %0, %4 offset:%5\n\tds_read_b128 %1, %4 offset:%6\n\tds_read_b128 %2, %4 offset:%7\n\tds_read_b128 %3, %4 offset:%8" \
        : "=&v"(X##0), "=&v"(X##1), "=&v"(X##2), "=&v"(X##3) : "v"(fba), "i"((f0) * 1024), "i"((f1) * 1024), "i"((f2) * 1024), "i"((f3) * 1024)); __builtin_amdgcn_sched_barrier(0); } while (0)
#define PIN2(a, b) asm volatile("" : "+v"(a), "+v"(b))
#define PIN4(a, b, c, d) asm volatile("" : "+v"(a), "+v"(b), "+v"(c), "+v"(d))
#define LWAIT() do { asm volatile("s_waitcnt lgkmcnt(0)" ::: "memory"); __builtin_amdgcn_sched_barrier(0); } while (0)
#define DN_STEP(U, c) do { \
            const unsigned fba = (unsigned)(uintptr_t)(lds + ((c) & 3) * S_SLOT) + lane16; \
            const float gl = __builtin_bit_cast(float, __builtin_amdgcn_readlane(__builtin_bit_cast(int, glv), (c))); \
            f32x16 v0, v1; \
            _Pragma("unroll") for (int i = 0; i < 8; ++i) { v0[2 * i] = bflo_(U[i >> 2][i & 3]); v0[2 * i + 1] = bfhi_(U[i >> 2][i & 3]); v1[2 * i] = bflo_(U[2 + (i >> 2)][i & 3]); v1[2 * i + 1] = bfhi_(U[2 + (i >> 2)][i & 3]); } \
            PIN2(v0, v1); \
            if ((c) + 2 < 64) DN_ULOAD(U, (c) + 2); \
            asm volatile("s_waitcnt lgkmcnt(0)" ::: "memory"); \
            unsigned char* sfc = sf0 + (size_t)(c) * 32768; unsigned char* vfc = vf0 + (size_t)(c) * 16384; \
            bf16x8 A0, A1, A2, A3, B0, B1, B2, B3; \
            RD4(A, 0, 8, 1, 9); LWAIT(); \
              \
            { const bf16x8 s0_ = pack_acc<0>(S0), s1_ = pack_acc<1>(S0); *(u32x4*)(sfc) = __builtin_bit_cast(u32x4, s0_); *(u32x4*)(sfc + 1024) = __builtin_bit_cast(u32x4, s1_); RD4(B, 2, 10, 3, 11); \
              v0 = DN_MFMA(A0, s0_, v0); v1 = DN_MFMA(A1, s0_, v1); v0 = DN_MFMA(A2, s1_, v0); v1 = DN_MFMA(A3, s1_, v1); PIN2(v0, v1); LWAIT(); } \
            { const bf16x8 s0_ = pack_acc<0>(S1), s1_ = pack_acc<1>(S1); *(u32x4*)(sfc + 2048) = __builtin_bit_cast(u32x4, s0_); *(u32x4*)(sfc + 3072) = __builtin_bit_cast(u32x4, s1_); RD4(A, 4, 12, 5, 13); \
              v0 = DN_MFMA(B0, s0_, v0); v1 = DN_MFMA(B1, s0_, v1); v0 = DN_MFMA(B2, s1_, v0); v1 = DN_MFMA(B3, s1_, v1); PIN2(v0, v1); LWAIT(); } \
            { const bf16x8 s0_ = pack_acc<0>(S2), s1_ = pack_acc<1>(S2); *(u32x4*)(sfc + 4096) = __builtin_bit_cast(u32x4, s0_); *(u32x4*)(sfc + 5120) = __builtin_bit_cast(u32x4, s1_); RD4(B, 6, 14, 7, 15); \
              v0 = DN_MFMA(A0, s0_, v0); v1 = DN_MFMA(A1, s0_, v1); v0 = DN_MFMA(A2, s1_, v0); v1 = DN_MFMA(A3, s1_, v1); PIN2(v0, v1); LWAIT(); } \
            { const bf16x8 s0_ = pack_acc<0>(S3), s1_ = pack_acc<1>(S3); *(u32x4*)(sfc + 6144) = __builtin_bit_cast(u32x4, s0_); *(u32x4*)(sfc + 7168) = __builtin_bit_cast(u32x4, s1_); RD4(A, 16, 20, 24, 28); \
              v0 = DN_MFMA(B0, s0_, v0); v1 = DN_MFMA(B1, s0_, v1); v0 = DN_MFMA(B2, s1_, v0); v1 = DN_MFMA(B3, s1_, v1); PIN2(v0, v1); LWAIT(); } \
            const bf16x8 vf0_ = pack_acc<0>(v0), vf1_ = pack_acc<1>(v0), vf2_ = pack_acc<0>(v1), vf3_ = pack_acc<1>(v1); \
            *(u32x4*)(vfc) = __builtin_bit_cast(u32x4, vf0_); *(u32x4*)(vfc + 1024) = __builtin_bit_cast(u32x4, vf1_); *(u32x4*)(vfc + 2048) = __builtin_bit_cast(u32x4, vf2_); *(u32x4*)(vfc + 3072) = __builtin_bit_cast(u32x4, vf3_); \
            _Pragma("unroll") for (int i = 0; i < 16; ++i) { S0[i] *= gl; S1[i] *= gl; S2[i] *= gl; S3[i] *= gl; } \
              \
            RD4(B, 17, 21, 25, 29); \
            S0 = DN_MFMA(A0, vf0_, S0); S1 = DN_MFMA(A1, vf0_, S1); S2 = DN_MFMA(A2, vf0_, S2); S3 = DN_MFMA(A3, vf0_, S3); PIN4(S0, S1, S2, S3); LWAIT(); \
            RD4(A, 18, 22, 26, 30); \
            S0 = DN_MFMA(B0, vf1_, S0); S1 = DN_MFMA(B1, vf1_, S1); S2 = DN_MFMA(B2, vf1_, S2); S3 = DN_MFMA(B3, vf1_, S3); PIN4(S0, S1, S2, S3); LWAIT(); \
            RD4(B, 19, 23, 27, 31); \
            S0 = DN_MFMA(A0, vf2_, S0); S1 = DN_MFMA(A1, vf2_, S1); S2 = DN_MFMA(A2, vf2_, S2); S3 = DN_MFMA(A3, vf2_, S3); PIN4(S0, S1, S2, S3); LWAIT(); \
            S0 = DN_MFMA(B0, vf3_, S0); S1 = DN_MFMA(B1, vf3_, S1); S2 = DN_MFMA(B2, vf3_, S2); S3 = DN_MFMA(B3, vf3_, S3); PIN4(S0, S1, S2, S3); \
            __builtin_amdgcn_sched_barrier(0); \
            DN_B(); } while (0)
#pragma unroll 1
        for (int c = 0; c < 64; c += 2) { DN_STEP(ua, c); DN_STEP(ub, c + 1); }
#undef DN_STEP
#undef RD4
#undef PIN2
#undef PIN4
#undef LWAIT
#undef DN_ULOAD
    }
    __syncthreads();
#undef DN_B
}

constexpr int O_OT = 0, O_NW = 2 * 64 * LQ * 2, O_END = O_NW + 512;
DNI void chunk_out(LAS unsigned char* lds, int item, const unsigned char* BLOB, const unsigned char* SF, const unsigned char* VF, const bf16* DNZ, const float* norm_w, bf16* Y) {
    int tid = threadIdx.x; asm volatile("" : "+v"(tid));
    const int wid = __builtin_amdgcn_readfirstlane(tid >> 6), lane = tid & 63, r = lane & 31, h2 = lane >> 5, half = wid >> 2, w = wid & 3;
    const int ck = 2 * item + half;
    const int n = ck & 63, hd = (ck >> 6) & 3, b = ck >> 8;
    if (tid < 128) ((LAS float*)(lds + O_NW))[tid] = norm_w[tid];
    const unsigned char* blob = BLOB + (size_t)ck * BLOB_BYTES + lane * 16;
    const unsigned char* sfp = SF + ((size_t)ck * 4 + w) * 8192 + lane * 16;
    const unsigned char* vfp = VF + ((size_t)ck * 4 + w) * 4096 + lane * 16;
    f32x16 o0 = {}, o1 = {};
#define GF(f) (*(const bf16x8*)(blob + (f) * 1024))
#pragma unroll
    for (int s = 0; s < 8; ++s) { const bf16x8 sf = *(const bf16x8*)(sfp + s * 1024); o0 = DN_MFMA(GF(16 + s), sf, o0); o1 = DN_MFMA(GF(24 + s), sf, o1); }
#pragma unroll
    for (int s2 = 0; s2 < 4; ++s2) { const bf16x8 vf = *(const bf16x8*)(vfp + s2 * 1024); o0 = DN_MFMA(GF(32 + s2), vf, o0); o1 = DN_MFMA(GF(36 + s2), vf, o1); }
#undef GF
    {
        LAS unsigned char* obp = lds + O_OT + half * (64 * LQ * 2) + ((4 * h2) * LQ + 32 * w + r) * 2;
#pragma unroll
        for (int i = 0; i < 16; ++i) {
            *(LAS unsigned short*)(obp + ((i & 3) + 8 * (i >> 2)) * (LQ * 2)) = (unsigned short)(cvtpk2(o0[i], 0.f) & 0xffffu);
            *(LAS unsigned short*)(obp + (32 + (i & 3) + 8 * (i >> 2)) * (LQ * 2)) = (unsigned short)(cvtpk2(o1[i], 0.f) & 0xffffu);
        }
    }
    __syncthreads();
    {
        const int t4 = tid & 255, pos = t4 >> 2, seg = t4 & 3;
        const LAS unsigned char* op = lds + O_OT + half * (64 * LQ * 2) + (pos * LQ + seg * 32) * 2;
        u32x4 wv[4];
#pragma unroll
        for (int q = 0; q < 4; ++q) wv[q] = *(const LAS u32x4*)(op + q * 16);
        float ss = 0.f;
#pragma unroll
        for (int q = 0; q < 4; ++q)
#pragma unroll
            for (int e = 0; e < 4; ++e) { const float a = bflo_(wv[q][e]), c = bfhi_(wv[q][e]); ss += a * a + c * c; }
        ss += __shfl_xor(ss, 1); ss += __shfl_xor(ss, 2);
        const float rs = rsqrtf(ss * (1.f / 128.f) + 1e-6f);
        const size_t m = (size_t)b * 4096 + (size_t)n * 64 + pos;
        const bf16* zp = DNZ + m * 512 + hd * 128 + seg * 32; bf16* yp = Y + m * 1024 + hd * 128 + seg * 32; const LAS float* nw = (const LAS float*)(lds + O_NW) + seg * 32;
#pragma unroll
        for (int q = 0; q < 4; ++q) {
            const u32x4 z = *(const u32x4*)(zp + q * 8); u32x4 o;
#pragma unroll
            for (int e = 0; e < 4; ++e) {
                const float z0 = bflo_(z[e]), z1 = bfhi_(z[e]);
                o[e] = cvtpk2(bflo_(wv[q][e]) * rs * nw[q * 8 + 2 * e] * (z0 / (1.f + __expf(-z0))), bfhi_(wv[q][e]) * rs * nw[q * 8 + 2 * e + 1] * (z1 / (1.f + __expf(-z1))));
            }
            *(u32x4*)(yp + q * 8) = o;
        }
    }
    __syncthreads();
}
#undef DN_MFMA
#undef DNI
}
constexpr int NWAVES = 8, NTHR = NWAVES * 64;
constexpr int BATCH = 4, SEQ = 4096, DM = 1024, M = BATCH * SEQ;
constexpr int HD = 128, NH = 4, DDN = 512, DMB = 512, NPROJ = 3584, DINP = 3592;
constexpr int MBLK = 256, NBLK = SEQ / MBLK;
constexpr int NE = 16, DE = 256;
constexpr float LN_EPS = 1e-5f, RMS_EPS = 1e-6f, ALPHA = 1.189207115002721f, QSCALE = 0.08838834764831845f;

constexpr size_t MiB = 1u << 20;
constexpr size_t WS_CTL = 0, CTL_ZERO_BYTES = 1 * MiB;
constexpr size_t WS_WIN = 2 * MiB;
constexpr size_t WS_WOUT = 10 * MiB;
constexpr size_t WS_WGU = 12 * MiB;
constexpr size_t WS_WD = 28 * MiB;
constexpr size_t WS_ROPE = 36 * MiB;
constexpr size_t WS_KMP = 38 * MiB;
constexpr size_t WS_GATES = 39 * MiB;
constexpr size_t WS_BETA = WS_GATES + 512 * 1024;
constexpr size_t WS_GLOG = WS_BETA + 256 * 1024;
constexpr size_t WS_XB = 48 * MiB;
constexpr size_t WS_DNQN = 48 * MiB, WS_DNKN = 64 * MiB;
constexpr size_t WS_PJ = 80 * MiB;
constexpr size_t PJ_STRIDE = 16 * MiB;
constexpr size_t WS_Y = 192 * MiB;
constexpr size_t WS_DNVN = 224 * MiB;
constexpr size_t WS_GL = 40 * MiB;
constexpr size_t WS_SF = 48 * MiB;
constexpr size_t WS_VF = 224 * MiB;
constexpr size_t WS_UF = 240 * MiB;
constexpr size_t WS_TOKE = 41 * MiB;
constexpr size_t WS_TOKP = WS_TOKE + 256 * 1024;
constexpr size_t WS_TOKW = WS_TOKP + 256 * 1024;
constexpr size_t WS_HB = 48 * MiB;
constexpr size_t WS_HS = 80 * MiB;
constexpr size_t WS_HE = 152 * MiB;
constexpr size_t WS_Y2 = 170 * MiB;
constexpr size_t WS_MIXB = 224 * MiB;
constexpr size_t WS_END = 256 * MiB;
constexpr int CW_CNT = 64;
constexpr int CW_SEAM = 16384;
constexpr size_t WS_XBUF = 42 * MiB;
constexpr int CW_BAR = 4096;

constexpr int RING_OFF = 0, RING_BYTES = 139264;
constexpr int LDSCTL_OFF = RING_BYTES, MISC_OFF = LDSCTL_OFF + 320;
constexpr int LDS_BYTES = 147456;

#define DI __device__ __forceinline__
DI float bf2f(unsigned short v) { return __uint_as_float((unsigned)v << 16); }
DI float bflo(unsigned w) { return __uint_as_float(w << 16); }
DI float bfhi(unsigned w) { return __uint_as_float(w & 0xffff0000u); }
DI float wave_sum(float v) {
#pragma unroll
    for (int o = 1; o < 64; o <<= 1) v += __shfl_xor(v, o);
    return v;
}
DI float wave_max(float v) {
#pragma unroll
    for (int o = 1; o < 64; o <<= 1) v = fmaxf(v, __shfl_xor(v, o));
    return v;
}
DI float silu_f(float v) { return v / (1.f + __expf(-v)); }
DI float softplus_f(float v) { return fmaxf(v, 0.f) + log1pf(__expf(-fabsf(v))); }

struct Args {
    const GAS float* in_[18]; GAS float* out_; GAS unsigned char* ws_; int ph_lo, ph_hi;
    DI const float* I(int k) const { return (const float*)in_[k]; }
    DI float* O() const { return (float*)out_; }
    DI unsigned char* W() const { return (unsigned char*)ws_; }
};
#define CAS __attribute__((address_space(4)))
struct KA {
    const CAS unsigned char* p;
    DI const float* I(int k) const { return (const float*)(*(const GAS float* const CAS*)(p + 8 * k)); }
    DI float* O() const { return (float*)(*(GAS float* const CAS*)(p + 144)); }
    DI unsigned char* W() const { return (unsigned char*)(*(GAS unsigned char* const CAS*)(p + 152)); }
    DI int lo() const { return *(const CAS int*)(p + 160); }
    DI int hi() const { return *(const CAS int*)(p + 164); }
};
static_assert(offsetof(Args, out_) == 144 && offsetof(Args, ws_) == 152 && offsetof(Args, ph_lo) == 160 && offsetof(Args, ph_hi) == 164, "Args layout");
DI KA kargs() { KA a; a.p = (const CAS unsigned char*)__builtin_amdgcn_kernarg_segment_ptr(); asm volatile("" : "+s"(a.p)); return a; }
struct Frame {
    LAS unsigned char* lds;
    int tid, lane, wave, vcu, G;
};

DI void p0_transpose_item(const float* W, int ldw, int src_col0, int K, bf16* WT, int dst_row0, LAS float* scr, int kb, int nb, int lane) {
    const int k0 = 64 * kb, n0 = 32 * nb;
#pragma unroll 8
    for (int i = 0; i < 32; ++i) { const int kk = 2 * i + (lane >> 5); scr[kk * 33 + (lane & 31)] = W[(size_t)(k0 + kk) * ldw + src_col0 + n0 + (lane & 31)]; }
    LDS_WAIT(); asm volatile("" ::: "memory");
    const int c = lane & 7;
#pragma unroll
    for (int j = 0; j < 4; ++j) { const int n = (lane >> 3) + 8 * j; const LAS float* s = scr + (8 * c) * 33 + n;
        v4u o; o.x = pk2(s[0 * 33], s[1 * 33]); o.y = pk2(s[2 * 33], s[3 * 33]); o.z = pk2(s[4 * 33], s[5 * 33]); o.w = pk2(s[6 * 33], s[7 * 33]);
        *(GAS v4u*)(WT + (size_t)(dst_row0 + n0 + n) * K + k0 + 8 * c) = o; }
    LDS_WAIT(); asm volatile("" ::: "memory");
}

DI void p0_prologue(const Frame& F, const KA& A) {
    unsigned char* ws = A.W();
    const float* x = A.I(0); const float* w_in = A.I(1); const float* w_out = A.I(6);
    const int gw = F.vcu * NWAVES + F.wave, NGW = F.G * NWAVES;
    {
        LAS float* wgl = (LAS float*)(F.lds + RING_OFF);
        for (int i = F.tid; i < 1024 * 8; i += NTHR) wgl[i] = w_in[(size_t)(i >> 3) * DINP + 2048 + (i & 7)];
        __syncthreads();
        bf16* XB = (bf16*)(ws + WS_XB); float* GATES = (float*)(ws + WS_GATES);
        for (int m = gw; m < M; m += NGW) {
            const GAS f32x4* xr = (const GAS f32x4*)(x + (size_t)m * DM) + F.lane;
            f32x4 v[4];
#pragma unroll
            for (int j = 0; j < 4; ++j) v[j] = xr[64 * j];
            GAS unsigned long long* o8 = (GAS unsigned long long*)(XB + (size_t)m * DM) + F.lane;
            float g[8];
#pragma unroll
            for (int q = 0; q < 8; ++q) g[q] = 0.f;
#pragma unroll
            for (int j = 0; j < 4; ++j) {
                o8[64 * j] = (unsigned long long)pk2(v[j].x, v[j].y) | ((unsigned long long)pk2(v[j].z, v[j].w) << 32);
#pragma unroll
                for (int e = 0; e < 4; ++e) { const int k = 256 * j + 4 * F.lane + e; const float xv = v[j][e];
                    const f32x4 w0 = *(const LAS f32x4*)(wgl + k * 8), w1 = *(const LAS f32x4*)(wgl + k * 8 + 4);
                    g[0] += xv * w0.x; g[1] += xv * w0.y; g[2] += xv * w0.z; g[3] += xv * w0.w;
                    g[4] += xv * w1.x; g[5] += xv * w1.y; g[6] += xv * w1.z; g[7] += xv * w1.w; }
            }
#pragma unroll
            for (int q = 0; q < 8; ++q) g[q] = wave_sum(g[q]);
            if (F.lane == 0) {
#pragma unroll
                for (int q = 0; q < 8; ++q) GATES[(size_t)m * 8 + q] = g[q];
            }
        }
        __syncthreads();
    }
    {
        LAS float* scr = (LAS float*)(F.lds + RING_OFF + F.wave * 16384);
        bf16* WIN = (bf16*)(ws + WS_WIN); bf16* WOUT = (bf16*)(ws + WS_WOUT);
        constexpr int I_A = 16 * 64, I_B = 16 * 48, I_O = 16 * 32, I_GU = NE * 4 * 64, I_D = NE * 128;
        const float* wgate = A.I(13); const float* wup = A.I(14); const float* wdn = A.I(15);
        bf16* WGU = (bf16*)(ws + WS_WGU); bf16* WD = (bf16*)(ws + WS_WD);
        for (int it = gw; it < I_A + I_B + I_O + I_GU + I_D; it += NGW) {
            int r = it;
            if (r < I_A) { p0_transpose_item(w_in, DINP, 0, DM, WIN, 0, scr, r / 64, r % 64, F.lane); continue; } r -= I_A;
            if (r < I_B) { p0_transpose_item(w_in, DINP, 2056, DM, WIN, 2048, scr, r / 48, r % 48, F.lane); continue; } r -= I_B;
            if (r < I_O) { p0_transpose_item(w_out, DM, 0, DM, WOUT, 0, scr, r / 32, r % 32, F.lane); continue; } r -= I_O;
            if (r < I_GU) {
                const int e = r >> 8, q = (r >> 6) & 3, pn = q >> 1, up = q & 1, kb = (r >> 2) & 15, nb = r & 3;
                p0_transpose_item((up ? wup : wgate) + (size_t)e * DM * DE, DE, pn * 128, DM, WGU, e * 512 + pn * 256 + up * 128, scr, kb, nb, F.lane); continue; } r -= I_GU;
            { const int e = r >> 7, kb = (r >> 5) & 3, nb = r & 31;
              p0_transpose_item(wdn + (size_t)e * DE * DM, DM, 0, DE, WD + (size_t)e * DM * DE, 0, scr, kb, nb, F.lane); }
        }
    }
    {
        float2* ROPE = (float2*)(ws + WS_ROPE);
        for (int i = (F.vcu * NTHR + F.tid); i < SEQ * 64; i += F.G * NTHR) {
            const int pos = i >> 6, j = i & 63;
            const float inv = exp2f(-(float)j * (13.287712379549449f / 64.f));
            const float ang = (float)pos * inv;
            double rev = (double)ang * 0.15915494309189535; rev -= __builtin_rint(rev);
            const float rr = (float)rev;
            ROPE[i] = make_float2(__builtin_amdgcn_cosf(rr), __builtin_amdgcn_sinf(rr));
        }
    }
}

DI void n2a_conv_norm(const Frame& F, const KA& A) {
    unsigned char* ws = A.W();
    const float* conv_w = A.I(2); const float* a_log = A.I(3); const float* dt_bias = A.I(4);
    const bf16* PJ = (const bf16*)(ws + WS_PJ);
    bf16* OUTX[3] = {(bf16*)(ws + WS_DNQN), (bf16*)(ws + WS_DNKN), (bf16*)(ws + WS_DNVN)};
    const float* GATES = (const float*)(ws + WS_GATES); float* BETA = (float*)(ws + WS_BETA); float* GLOG = (float*)(ws + WS_GLOG);
    const int gw = F.vcu * NWAVES + F.wave, NGW = F.G * NWAVES;
    for (int it = gw; it < M * NH; it += NGW) {
        const int m = it >> 2, h = it & 3, t = m & (SEQ - 1), c = 2 * F.lane;
        float val[3][2];
#pragma unroll
        for (int X = 0; X < 3; ++X) {
            float a0 = 0.f, a1 = 0.f;
#pragma unroll
            for (int j = 0; j < 4; ++j) {
                const int tt = t - 3 + j;
                if (tt >= 0) {
                    const unsigned raw = *(const unsigned*)(PJ + X * (PJ_STRIDE / 2) + (size_t)(m - 3 + j) * 512 + h * 128 + c);
                    const float w0 = conv_w[j * 1536 + X * 512 + h * 128 + c], w1 = conv_w[j * 1536 + X * 512 + h * 128 + c + 1];
                    a0 += w0 * bflo(raw); a1 += w1 * bfhi(raw);
                }
            }
            val[X][0] = silu_f(a0); val[X][1] = silu_f(a1);
        }
        const float sq = wave_sum(val[0][0] * val[0][0] + val[0][1] * val[0][1]);
        const float sk = wave_sum(val[1][0] * val[1][0] + val[1][1] * val[1][1]);
        const float rq = rsqrtf(sq + 1e-6f) * QSCALE, rk = rsqrtf(sk + 1e-6f);
        val[0][0] *= rq; val[0][1] *= rq; val[1][0] *= rk; val[1][1] *= rk;
#pragma unroll
        for (int X = 0; X < 3; ++X) *(unsigned*)(OUTX[X] + (size_t)m * 512 + h * 128 + c) = pk2(val[X][0], val[X][1]);
        if (F.lane == 0) {
            const float bb = GATES[(size_t)m * 8 + h], aa = GATES[(size_t)m * 8 + 4 + h];
            BETA[(size_t)m * 4 + h] = 1.f / (1.f + __expf(-bb));
            GLOG[(size_t)m * 4 + h] = -__expf(a_log[h]) * softplus_f(aa + dt_bias[h]);
        }
    }
}

DI void rope8(bf16* p, const float2* rp, float* s1, float* s2) {
    const v4u lo = *(const v4u*)p, hi = *(const v4u*)(p + 64);
    const f32x4 c0 = *(const f32x4*)rp, c1 = *(const f32x4*)(rp + 2), c2 = *(const f32x4*)(rp + 4), c3 = *(const f32x4*)(rp + 6);
    const float cs[8] = {c0.x, c0.z, c1.x, c1.z, c2.x, c2.z, c3.x, c3.z}, sn[8] = {c0.y, c0.w, c1.y, c1.w, c2.y, c2.w, c3.y, c3.w};
    float r1[8], r2[8];
#pragma unroll
    for (int e = 0; e < 4; ++e) {
        const float a0 = bflo(lo[e]), a1 = bfhi(lo[e]), b0 = bflo(hi[e]), b1 = bfhi(hi[e]);
        r1[2 * e] = a0 * cs[2 * e] - b0 * sn[2 * e]; r2[2 * e] = b0 * cs[2 * e] + a0 * sn[2 * e];
        r1[2 * e + 1] = a1 * cs[2 * e + 1] - b1 * sn[2 * e + 1]; r2[2 * e + 1] = b1 * cs[2 * e + 1] + a1 * sn[2 * e + 1];
    }
    v4u o1, o2;
#pragma unroll
    for (int e = 0; e < 4; ++e) { o1[e] = pk2(r1[2 * e], r1[2 * e + 1]); o2[e] = pk2(r2[2 * e], r2[2 * e + 1]); }
    *(v4u*)p = o1; *(v4u*)(p + 64) = o2;
    if (s1) {
#pragma unroll
        for (int e = 0; e < 8; ++e) { s1[e] += r1[e]; s2[e] += r2[e]; }
    }
}
DI void n3a_rope(const Frame& F, const KA& A) {
    unsigned char* ws = A.W();
    bf16* MBQ = (bf16*)(ws + WS_PJ + 4 * PJ_STRIDE); bf16* MBK = (bf16*)(ws + WS_PJ + 5 * PJ_STRIDE);
    const float2* ROPE = (const float2*)(ws + WS_ROPE); float* KMP = (float*)(ws + WS_KMP);
    const int gw = F.vcu * NWAVES + F.wave, NGW = F.G * NWAVES, rr = F.lane >> 3, dseg = F.lane & 7;
    for (int it = gw; it < 1024; it += NGW) {
        const int qtr = it & 3, j = (it >> 2) & 15, h = (it >> 6) & 3, b = it >> 8;
        float s1[8], s2[8];
#pragma unroll
        for (int e = 0; e < 8; ++e) { s1[e] = 0.f; s2[e] = 0.f; }
#pragma unroll 2
        for (int r8 = 0; r8 < 8; ++r8) {
            const int pos = j * 256 + qtr * 64 + r8 * 8 + rr; const size_t m = (size_t)b * SEQ + pos;
            rope8(MBK + m * 512 + h * 128 + dseg * 8, ROPE + pos * 64 + dseg * 8, s1, s2);
        }
#pragma unroll
        for (int e = 0; e < 8; ++e) { s1[e] += __shfl_xor(s1[e], 8); s1[e] += __shfl_xor(s1[e], 16); s1[e] += __shfl_xor(s1[e], 32);
                                      s2[e] += __shfl_xor(s2[e], 8); s2[e] += __shfl_xor(s2[e], 16); s2[e] += __shfl_xor(s2[e], 32); }
        if (rr == 0) {
#pragma unroll
            for (int e = 0; e < 8; ++e) { KMP[(size_t)it * 128 + dseg * 8 + e] = s1[e]; KMP[(size_t)it * 128 + 64 + dseg * 8 + e] = s2[e]; }
        }
    }
    for (int it = gw; it < (M / 8) * NH; it += NGW) {
        const int m8 = it >> 2, h = it & 3; const size_t m = (size_t)m8 * 8 + rr; const int pos = (int)(m & (SEQ - 1));
        rope8(MBQ + m * 512 + h * 128 + dseg * 8, ROPE + pos * 64 + dseg * 8, nullptr, nullptr);
    }
}

DI void n2b_dn_recurrent(const Frame& F, const KA& A, int item, float* ODN) {
    unsigned char* ws = A.W();
    const bf16* QN = (const bf16*)(ws + WS_DNQN); const bf16* KN = (const bf16*)(ws + WS_DNKN); const bf16* VN = (const bf16*)(ws + WS_DNVN);
    const float* BETA = (const float*)(ws + WS_BETA); const float* GLOG = (const float*)(ws + WS_GLOG);
    const int b = item >> 2, h = item & 3;
    LAS float* qs = (LAS float*)(F.lds + RING_OFF);
    LAS float* ks = qs + 16 * 128; LAS float* vs = ks + 16 * 128; LAS float* bs = vs + 16 * 128; LAS float* as = bs + 16;
    float S[128];
#pragma unroll
    for (int k = 0; k < 128; ++k) S[k] = 0.f;
    for (int t0 = 0; t0 < SEQ; t0 += 16) {
        __syncthreads();
        for (int idx = F.tid; idx < 16 * 384; idx += NTHR) {
            const int r = idx / 384, c = idx % 384, X = c >> 7, cc = c & 127; const size_t m = (size_t)b * SEQ + t0 + r;
            const bf16* src = X == 0 ? QN : (X == 1 ? KN : VN);
            (X == 0 ? qs : (X == 1 ? ks : vs))[r * 128 + cc] = bf2f(src[m * 512 + h * 128 + cc]);
        }
        if (F.tid < 16) { const size_t m = (size_t)b * SEQ + t0 + F.tid; bs[F.tid] = BETA[m * 4 + h]; as[F.tid] = __expf(GLOG[m * 4 + h]); }
        __syncthreads();
        if (F.tid < 128) {
#pragma unroll 1
            for (int r = 0; r < 16; ++r) {
                const LAS float* kr = ks + r * 128; const LAS float* qr = qs + r * 128;
                float kS = 0.f;
#pragma unroll
                for (int kb = 0; kb < 128; kb += 16) {
#pragma unroll
                    for (int k = 0; k < 16; ++k) kS += kr[kb + k] * S[kb + k];
                    asm volatile("" ::: "memory");
                }
                const float al = as[r], be = bs[r];
                const float vn = be * (vs[r * 128 + F.tid] - al * kS);
                float o = 0.f;
#pragma unroll
                for (int kb = 0; kb < 128; kb += 16) {
#pragma unroll
                    for (int k = 0; k < 16; ++k) { S[kb + k] = al * S[kb + k] + kr[kb + k] * vn; o += qr[kb + k] * S[kb + k]; }
                    asm volatile("" ::: "memory");
                }
                ODN[((size_t)b * SEQ + t0 + r) * 512 + h * 128 + F.tid] = o;
            }
        }
    }
}

DI void n3b_moba_naive(const Frame& F, const KA& A, int w0, int nw, bf16* Yo, int ypitch, int ycol0) {
    unsigned char* ws = A.W();
    const bf16* MBQ = (const bf16*)(ws + WS_PJ + 4 * PJ_STRIDE); const bf16* MBK = (const bf16*)(ws + WS_PJ + 5 * PJ_STRIDE); const bf16* MBV = (const bf16*)(ws + WS_PJ + 6 * PJ_STRIDE);
    const float* KMP = (const float*)(ws + WS_KMP);
    LAS float* qs = (LAS float*)(F.lds + RING_OFF + 32768) + F.wave * 128;
    const int lane = F.lane;
    for (int it = w0; it < M * NH; it += nw) {
        const int m = it >> 2, h = it & 3, b = m >> 12, t = m & (SEQ - 1), own = t >> 8;
        { const unsigned raw = *(const unsigned*)(MBQ + (size_t)m * 512 + h * 128 + 2 * lane); qs[2 * lane] = bflo(raw) * QSCALE; qs[2 * lane + 1] = bfhi(raw) * QSCALE; }
        asm volatile("s_waitcnt lgkmcnt(0)" ::: "memory");
        float gate = -3e38f;
        if (lane < own) {
            const float* kp = KMP + (size_t)(((b * 4 + h) * 16 + lane) * 4) * 128; float acc = 0.f;
            for (int dd = 0; dd < 128; ++dd) acc += qs[dd] * ((kp[dd] + kp[128 + dd]) + (kp[256 + dd] + kp[384 + dd]));
            gate = acc * (1.f / 256.f);
        }
        int blist[4] = {-1, -1, -1, own};
#pragma unroll
        for (int r = 0; r < 3; ++r) {
            const float mx = wave_max(gate);
            if (mx > -1e37f) {
                const unsigned long long bal = __ballot(gate == mx); const int idx = __builtin_ctzll(bal);
                blist[r] = idx; if (lane == idx) gate = -3e38f;
            }
        }
        float sc[4][4]; float mloc = -3e38f;
#pragma unroll
        for (int s = 0; s < 4; ++s) {
            const int jb = blist[s];
#pragma unroll
            for (int i = 0; i < 4; ++i) {
                float v = -3e38f;
                if (jb >= 0) {
                    const int key = jb * 256 + i * 64 + lane;
                    if (s < 3 || key <= t) {
                        const bf16* kp = MBK + ((size_t)b * SEQ + key) * 512 + h * 128; float acc = 0.f;
#pragma unroll 4
                        for (int c8 = 0; c8 < 16; ++c8) { const v4u w = *(const v4u*)(kp + c8 * 8); const LAS float* q8 = qs + c8 * 8;
                            acc += q8[0] * bflo(w.x) + q8[1] * bfhi(w.x) + q8[2] * bflo(w.y) + q8[3] * bfhi(w.y) + q8[4] * bflo(w.z) + q8[5] * bfhi(w.z) + q8[6] * bflo(w.w) + q8[7] * bfhi(w.w); }
                        v = acc;
                    }
                }
                sc[s][i] = v; mloc = fmaxf(mloc, v);
            }
        }
        const float mx = wave_max(mloc); float lsum = 0.f;
#pragma unroll
        for (int s = 0; s < 4; ++s)
#pragma unroll
            for (int i = 0; i < 4; ++i) { const float p = sc[s][i] > -1e37f ? __expf(sc[s][i] - mx) : 0.f; sc[s][i] = p; lsum += p; }
        const float l = wave_sum(lsum);
        float o0 = 0.f, o1 = 0.f;
#pragma unroll
        for (int s = 0; s < 4; ++s) {
            const int jb = blist[s];
            if (jb >= 0) {
#pragma unroll
                for (int i = 0; i < 4; ++i) {
                    const bf16* vp = MBV + ((size_t)b * SEQ + jb * 256 + i * 64) * 512 + h * 128 + 2 * lane;
                    for (int src = 0; src < 64; ++src) {
                        const float pv = __shfl(sc[s][i], src);
                        if (pv != 0.f) { const unsigned raw = *(const unsigned*)(vp + (size_t)src * 512); o0 += pv * bflo(raw); o1 += pv * bfhi(raw); }
                    }
                }
            }
        }
        const float il = 1.f / l;
        *(unsigned*)(Yo + (size_t)m * ypitch + ycol0 + h * 128 + 2 * lane) = pk2(o0 * il, o1 * il);
        asm volatile("s_waitcnt lgkmcnt(0)" ::: "memory");
    }
}

DI void n2c_dn_gate(const Frame& F, const KA& A, const float* ODN, bf16* Yo, int ypitch) {
    unsigned char* ws = A.W();
    const float* norm_w = A.I(5); const bf16* DNZ = (const bf16*)(ws + WS_PJ + 3 * PJ_STRIDE);
    const int gw = F.vcu * NWAVES + F.wave, NGW = F.G * NWAVES, c = 2 * F.lane;
    for (int it = gw; it < M * NH; it += NGW) {
        const int m = it >> 2, h = it & 3;
        const float2 o = *(const float2*)(ODN + (size_t)m * 512 + h * 128 + c);
        const float ss = wave_sum(o.x * o.x + o.y * o.y) * (1.f / 128.f);
        const float rs = rsqrtf(ss + RMS_EPS);
        const unsigned zr = *(const unsigned*)(DNZ + (size_t)m * 512 + h * 128 + c);
        *(unsigned*)(Yo + (size_t)m * ypitch + h * 128 + c) = pk2(o.x * rs * norm_w[c] * silu_f(bflo(zr)), o.y * rs * norm_w[c + 1] * silu_f(bfhi(zr)));
    }
}

constexpr int CW_DBG = 16;
DI void dbg_compare(const Frame& F, unsigned char* ws, const bf16* T, int tp, int tc0, const bf16* R, int rp, int rc0) {
    float sd = 0.f, sr = 0.f;
    for (int i = F.vcu * NTHR + F.tid; i < M * 256; i += F.G * NTHR) {
        const int m = i >> 8, c = (i & 255) * 2;
        const unsigned a = *(const unsigned*)(T + (size_t)m * tp + tc0 + c), b = *(const unsigned*)(R + (size_t)m * rp + rc0 + c);
        const float d0 = bflo(a) - bflo(b), d1 = bfhi(a) - bfhi(b); sd += d0 * d0 + d1 * d1; sr += bflo(b) * bflo(b) + bfhi(b) * bfhi(b);
    }
    sd = wave_sum(sd); sr = wave_sum(sr);
    if (F.lane == 0) { atomicAdd((float*)(ws + WS_CTL) + CW_DBG, sd); atomicAdd((float*)(ws + WS_CTL) + CW_DBG + 1, sr); }
}
DI float block_sum(float v, LAS float* red, int tid) {
    v = wave_sum(v);
    __syncthreads();
    if ((tid & 63) == 0) red[tid >> 6] = v;
    __syncthreads();
    float s = 0.f;
#pragma unroll
    for (int w = 0; w < NWAVES; ++w) s += red[w];
    return s;
}

DI void n5_token_tail(const Frame& F, const KA& A) {
    const float* x = A.I(0); const float* g1 = A.I(7); const float* b1 = A.I(8);
    const float* rw1 = A.I(9); const float* rb1 = A.I(10); const float* rw2 = A.I(11); const float* rb2 = A.I(12);
    const float* wg = A.I(13); const float* wu = A.I(14); const float* wd = A.I(15); const float* g2 = A.I(16); const float* b2 = A.I(17);
    float* out = A.O();
    LAS float* hs = (LAS float*)(F.lds + RING_OFF);
    LAS float* hes = hs + 1024;
    LAS float* lg = hes + 512;
    LAS float* red = lg + 32;
    LAS float* rt_ = red + 8;
    const int tid = F.tid;
    for (int m = blockIdx.x; m < M; m += F.G) {
        __syncthreads();
        const size_t ro = (size_t)m * DM;
        float v0 = ALPHA * x[ro + tid] + out[ro + tid], v1 = ALPHA * x[ro + tid + 512] + out[ro + tid + 512];
        const float mean = block_sum(v0 + v1, red, tid) * (1.f / DM);
        v0 -= mean; v1 -= mean;
        const float var = block_sum(v0 * v0 + v1 * v1, red, tid) * (1.f / DM);
        const float rstd = rsqrtf(var + LN_EPS);
        const float h0 = v0 * rstd * g1[tid] + b1[tid], h1 = v1 * rstd * g1[tid + 512] + b1[tid + 512];
        hs[tid] = h0; hs[tid + 512] = h1;
        __syncthreads();
        for (int li = F.wave; li < 20; li += NWAVES) {
            float acc = 0.f;
            for (int k = F.lane; k < DM; k += 64) {
                const float wv = li < 4 ? rw1[k * 4 + li] : rw2[((size_t)((li - 4) >> 2) * DM + k) * 4 + ((li - 4) & 3)];
                acc += hs[k] * wv;
            }
            acc = wave_sum(acc);
            if (F.lane == 0) lg[li] = acc;
        }
        __syncthreads();
        if (tid == 0) {
            float pgv[4]; float mx = -3e38f;
            for (int g = 0; g < 4; ++g) { pgv[g] = lg[g] + rb1[g]; mx = fmaxf(mx, pgv[g]); }
            float sum = 0.f; for (int g = 0; g < 4; ++g) { pgv[g] = __expf(pgv[g] - mx); sum += pgv[g]; }
            int gs = 0; for (int g = 1; g < 4; ++g) if (pgv[g] > pgv[gs]) gs = g;
            const float pg = pgv[gs] / sum;
            float pe[4]; mx = -3e38f;
            for (int e = 0; e < 4; ++e) { pe[e] = lg[4 + gs * 4 + e] + rb2[gs * 4 + e]; mx = fmaxf(mx, pe[e]); }
            sum = 0.f; for (int e = 0; e < 4; ++e) { pe[e] = __expf(pe[e] - mx); sum += pe[e]; }
            int e0 = 0; for (int e = 1; e < 4; ++e) if (pe[e] > pe[e0]) e0 = e;
            int e1 = (e0 == 0) ? 1 : 0; for (int e = 0; e < 4; ++e) if (e != e0 && pe[e] > pe[e1]) e1 = e;
            const float den = pe[e0] + pe[e1];
            rt_[0] = __int_as_float(gs * 4 + e0); rt_[1] = __int_as_float(gs * 4 + e1); rt_[2] = pg * pe[e0] / den; rt_[3] = pg * pe[e1] / den;
        }
        __syncthreads();
        const int ex[2] = {__float_as_int(rt_[0]), __float_as_int(rt_[1])}; const float wx[2] = {rt_[2], rt_[3]};
        {
            const int half = tid >> 8, j = tid & 255, e = ex[half];
            const float* pg_ = wg + (size_t)e * DM * DE + j; const float* pu_ = wu + (size_t)e * DM * DE + j;
            float ga = 0.f, ua = 0.f;
#pragma unroll 8
            for (int k = 0; k < DM; ++k) { const float hv = hs[k]; ga += hv * pg_[(size_t)k * DE]; ua += hv * pu_[(size_t)k * DE]; }
            hes[half * 256 + j] = silu_f(ga) * ua;
        }
        __syncthreads();
        float y0 = 0.f, y1 = 0.f;
#pragma unroll
        for (int half = 0; half < 2; ++half) {
            const float* pd = wd + (size_t)ex[half] * DE * DM + tid; float a0 = 0.f, a1 = 0.f;
#pragma unroll 8
            for (int j = 0; j < DE; ++j) { const float hv = hes[half * 256 + j]; a0 += hv * pd[(size_t)j * DM]; a1 += hv * pd[(size_t)j * DM + 512]; }
            y0 += wx[half] * a0; y1 += wx[half] * a1;
        }
        float u0 = ALPHA * h0 + y0, u1 = ALPHA * h1 + y1;
        const float mean2 = block_sum(u0 + u1, red, tid) * (1.f / DM);
        u0 -= mean2; u1 -= mean2;
        const float var2 = block_sum(u0 * u0 + u1 * u1, red, tid) * (1.f / DM);
        const float rstd2 = rsqrtf(var2 + LN_EPS);
        float dscale = 1.f;
#ifdef DBG_ANY
        { const float* dw = (const float*)(A.W() + WS_CTL) + CW_DBG; dscale = 1.f + sqrtf(dw[0] / fmaxf(dw[1], 1e-30f)); }
#endif
        out[ro + tid] = (u0 * rstd2 * g2[tid] + b2[tid]) * dscale; out[ro + tid + 512] = (u1 * rstd2 * g2[tid + 512] + b2[tid + 512]) * dscale;
    }
}

struct MbPart { int own, t_lo, t_hi, slot; };
struct MbSplit { int own, slot0, nparts; };
constexpr int MB_NPARTS = 30, MB_NSLOTS = 24, MB_NSPLIT = 10;
__device__ const MbPart MB_PARTS[MB_NPARTS] = {{5, 0, 24, -1}, {11, 0, 24, 10}, {11, 24, 48, 11}, {10, 0, 22, 8}, {10, 22, 44, 9}, {15, 0, 22, 21}, {15, 22, 44, 22}, {4, 0, 20, -1}, {9, 0, 20, 6}, {9, 20, 40, 7}, {13, 0, 20, 15}, {13, 20, 40, 16}, {14, 0, 20, 18}, {14, 20, 40, 19}, {14, 40, 60, 20}, {15, 44, 64, 23}, {8, 0, 18, 4}, {8, 18, 36, 5}, {12, 0, 18, 12}, {12, 18, 36, 13}, {3, 0, 16, -1}, {7, 0, 16, 2}, {7, 16, 32, 3}, {12, 36, 52, 14}, {13, 40, 56, 17}, {6, 0, 14, 0}, {6, 14, 28, 1}, {2, 0, 12, -1}, {1, 0, 8, -1}, {0, 0, 4, -1}};
__device__ const MbSplit MB_SPLITS[MB_NSPLIT] = {{6, 0, 2}, {7, 2, 2}, {8, 4, 2}, {9, 6, 2}, {10, 8, 2}, {11, 10, 2}, {12, 12, 3}, {13, 15, 3}, {14, 18, 3}, {15, 21, 3}};
constexpr size_t WS_MBPO = WS_PJ;
constexpr size_t WS_MBLSE = WS_PJ + 24 * MiB;
constexpr int CW_MBQ = 96;
typedef mb::BlockRef<bf16, bf16> mbref_t;
DI mbref_t mb_ref(unsigned char* ws, int p, int xq) {
    const int bh = __builtin_amdgcn_readfirstlane(2 * xq + (p & 1)), k = __builtin_amdgcn_readfirstlane(p >> 1);
    const MbPart pt = MB_PARTS[k];
    const int own = __builtin_amdgcn_readfirstlane(pt.own), slot = __builtin_amdgcn_readfirstlane(pt.slot);
    const int b = bh >> 2, h = bh & 3; const size_t row0 = (size_t)b * SEQ;
    mbref_t r;
    r.Q = (const bf16*)(ws + WS_PJ + 4 * PJ_STRIDE) + (row0 + (size_t)own * 256) * 512 + h * 128;
    r.K = (const bf16*)(ws + WS_PJ + 5 * PJ_STRIDE) + row0 * 512 + h * 128;
    r.V = (const bf16*)(ws + WS_PJ + 6 * PJ_STRIDE) + row0 * 512 + h * 128;
    r.O = (bf16*)(ws + WS_Y) + (row0 + (size_t)own * 256) * 1024 + 512 + h * 128;
    r.KM = (const float*)(ws + WS_KMP) + (size_t)(bh * 64) * 128;
    r.P0 = own * 256; r.t_lo = __builtin_amdgcn_readfirstlane(pt.t_lo); r.t_hi = __builtin_amdgcn_readfirstlane(pt.t_hi);
    r.OP = slot >= 0 ? (bf16*)(ws + WS_MBPO) + (size_t)(bh * MB_NSLOTS + slot) * (256 * 128) : nullptr;
    r.LSE = slot >= 0 ? (float*)(ws + WS_MBLSE) + (size_t)(bh * MB_NSLOTS + slot) * 256 : nullptr;
    return r;
}
DI int mb_claim(unsigned char* ws, LAS unsigned* word, int tid, int xq) {
    if (tid == 0) *word = __hip_atomic_fetch_add((unsigned*)(ws + WS_CTL) + CW_MBQ + 64 * xq, 1u, __ATOMIC_RELAXED, __HIP_MEMORY_SCOPE_AGENT);
    __syncthreads();
    const int p = __builtin_amdgcn_readfirstlane((int)*word);
    __syncthreads();
    return p;
}
DI void p3_moba_queue(unsigned char* ws, char* lds, LAS unsigned* word, int tid, int xq) {
    constexpr int WBIG = 0x3fffffff, NP = MB_NPARTS * 2;
    int p = mb_claim(ws, word, tid, xq);
    if (p >= NP) return;
    mbref_t cur = mb_ref(ws, p, xq);
    mb::Seam<bf16> S;
    mb::causal_swa_prime<bf16, bf16>(cur, WBIG, lds, S);
#pragma unroll 1
    for (;;) {
        const int pn = mb_claim(ws, word, tid, xq);
        const bool more = pn < NP;
        const mbref_t nxt = more ? mb_ref(ws, pn, xq) : cur;
        mb::causal_swa_block<bf16, bf16>(cur, nxt, SEQ, WBIG, lds, S);
        if (!more) break;
        cur = nxt;
    }
}
DI mbref_t mb_ref_full(unsigned char* ws, int bh, int own_) {
    const int own = __builtin_amdgcn_readfirstlane(own_); const int b = bh >> 2, h = bh & 3; const size_t row0 = (size_t)b * SEQ;
    mbref_t r;
    r.Q = (const bf16*)(ws + WS_PJ + 4 * PJ_STRIDE) + (row0 + (size_t)own * 256) * 512 + h * 128;
    r.K = (const bf16*)(ws + WS_PJ + 5 * PJ_STRIDE) + row0 * 512 + h * 128;
    r.V = (const bf16*)(ws + WS_PJ + 6 * PJ_STRIDE) + row0 * 512 + h * 128;
    r.O = (bf16*)(ws + WS_Y) + (row0 + (size_t)own * 256) * 1024 + 512 + h * 128;
    r.KM = (const float*)(ws + WS_KMP) + (size_t)(bh * 64) * 128;
    r.P0 = own * 256; r.t_lo = 0; r.t_hi = 4 * (own + 1); r.OP = nullptr; r.LSE = nullptr;
    return r;
}
DI void p3_moba_static(unsigned char* ws, char* lds, int bh, int own0, int own1) {
    constexpr int WBIG = 0x3fffffff;
    const int n = own1 >= 0 ? 2 : 1;
    mbref_t cur = mb_ref_full(ws, bh, own0);
    mb::Seam<bf16> S;
    mb::causal_swa_prime<bf16, bf16>(cur, WBIG, lds, S);
#pragma unroll 1
    for (int i = 0; i < n; ++i) {
        const mbref_t nxt = (i + 1 < n) ? mb_ref_full(ws, bh, own1) : cur;
        mb::causal_swa_block<bf16, bf16>(cur, nxt, SEQ, WBIG, lds, S);
        cur = nxt;
    }
}
DI void p4_moba_merge(unsigned char* ws, int it, int tid) {
    const int bh = it & 15; const MbSplit sp = MB_SPLITS[it >> 4];
    const int b = bh >> 2, h = bh & 3, row = tid >> 1, half = tid & 1;
    const float* lse = (const float*)(ws + WS_MBLSE) + (size_t)(bh * MB_NSLOTS + sp.slot0) * 256 + row;
    const bf16* po = (const bf16*)(ws + WS_MBPO) + (size_t)(bh * MB_NSLOTS + sp.slot0) * (256 * 128) + row * 128 + half * 64;
    float l[3], mx = -3e38f;
#pragma unroll
    for (int q = 0; q < 3; ++q) { l[q] = q < sp.nparts ? lse[q * 256] : -__builtin_inff(); mx = fmaxf(mx, l[q]); }
    float wsum = 0.f;
#pragma unroll
    for (int q = 0; q < 3; ++q) { l[q] = __builtin_amdgcn_exp2f(l[q] - mx); wsum += l[q]; }
    const float inv = 1.f / wsum;
    bf16* yp = (bf16*)(ws + WS_Y) + ((size_t)b * SEQ + (size_t)sp.own * 256 + row) * 1024 + 512 + h * 128 + half * 64;
#pragma unroll
    for (int c8 = 0; c8 < 8; ++c8) {
        float acc[8];
#pragma unroll
        for (int e = 0; e < 8; ++e) acc[e] = 0.f;
#pragma unroll
        for (int q = 0; q < 3; ++q) if (q < sp.nparts) { const v4u w = *(const v4u*)(po + (size_t)q * (256 * 128) + c8 * 8);
#pragma unroll
            for (int e = 0; e < 4; ++e) { acc[2 * e] += l[q] * bflo(w[e]); acc[2 * e + 1] += l[q] * bfhi(w[e]); } }
        v4u o;
#pragma unroll
        for (int e = 0; e < 4; ++e) o[e] = pk2(acc[2 * e] * inv, acc[2 * e + 1] * inv);
        *(v4u*)(yp + c8 * 8) = o;
    }
}

DI void p6_ln_router(const Frame& F, const KA& A) {
    unsigned char* ws = A.W();
    const float* x = A.I(0); const float* g1 = A.I(7); const float* b1 = A.I(8);
    const float* rw1 = A.I(9); const float* rb1 = A.I(10); const float* rw2 = A.I(11); const float* rb2 = A.I(12);
    float* out = A.O(); bf16* HB = (bf16*)(ws + WS_HB); const bf16* MIXB = (const bf16*)(ws + WS_MIXB); (void)out; (void)MIXB;
    int* TOKE = (int*)(ws + WS_TOKE); int* TOKP = (int*)(ws + WS_TOKP); float* TOKW = (float*)(ws + WS_TOKW);
    unsigned* gcnt = (unsigned*)(ws + WS_CTL) + CW_CNT;
    LAS float* rwl = (LAS float*)(F.lds + RING_OFF);
    LAS unsigned* lcnt = (LAS unsigned*)(F.lds + RING_OFF + 81920);
    for (int i = F.tid; i < 1024 * 20; i += NTHR) { const int k = i / 20, li = i % 20;
        rwl[i] = li < 4 ? rw1[k * 4 + li] : rw2[((size_t)((li - 4) >> 2) * DM + k) * 4 + ((li - 4) & 3)]; }
    if (F.tid < 32) lcnt[F.tid] = 0u;
    __syncthreads();
    const int gw = F.vcu * NWAVES + F.wave, NGW = F.G * NWAVES;
#ifdef LN1_FUSE
    for (int m = gw; m < M; m += NGW) {
        const size_t ro = (size_t)m * DM;
        f32x4 v[4];
        float lg[20];
#pragma unroll
        for (int q = 0; q < 20; ++q) lg[q] = 0.f;
#pragma unroll
        for (int j = 0; j < 4; ++j) {
            v[j] = *(const f32x4*)(out + ro + 256 * j + 4 * F.lane);
#pragma unroll
            for (int e = 0; e < 4; ++e) { const LAS float* wr_ = rwl + (256 * j + 4 * F.lane + e) * 20; const float hv = v[j][e];
#pragma unroll
                for (int q4 = 0; q4 < 5; ++q4) { const f32x4 w4 = *(const LAS f32x4*)(wr_ + 4 * q4);
                    lg[4 * q4] += hv * w4.x; lg[4 * q4 + 1] += hv * w4.y; lg[4 * q4 + 2] += hv * w4.z; lg[4 * q4 + 3] += hv * w4.w; } }
        }
#else
    for (int m = gw; m < M; m += NGW) {
        const size_t ro = (size_t)m * DM;
        f32x4 v[4]; float s = 0.f;
#pragma unroll
        for (int j = 0; j < 4; ++j) { const f32x4 xv = *(const f32x4*)(x + ro + 256 * j + 4 * F.lane); const uint2 mr = *(const uint2*)(MIXB + ro + 256 * j + 4 * F.lane);
            v[j].x = xv.x * ALPHA + bflo(mr.x); v[j].y = xv.y * ALPHA + bfhi(mr.x); v[j].z = xv.z * ALPHA + bflo(mr.y); v[j].w = xv.w * ALPHA + bfhi(mr.y); s += (v[j].x + v[j].y) + (v[j].z + v[j].w); }
        const float mean = wave_sum(s) * (1.f / DM); float s2 = 0.f;
#pragma unroll
        for (int j = 0; j < 4; ++j) { v[j] = v[j] - mean; s2 += (v[j].x * v[j].x + v[j].y * v[j].y) + (v[j].z * v[j].z + v[j].w * v[j].w); }
        const float rstd = rsqrtf(wave_sum(s2) * (1.f / DM) + LN_EPS);
        float lg[20];
#pragma unroll
        for (int q = 0; q < 20; ++q) lg[q] = 0.f;
#pragma unroll
        for (int j = 0; j < 4; ++j) {
            const f32x4 gv = *(const f32x4*)(g1 + 256 * j + 4 * F.lane), bv = *(const f32x4*)(b1 + 256 * j + 4 * F.lane);
            v[j] = v[j] * rstd * gv + bv;
            *(unsigned long long*)(HB + ro + 256 * j + 4 * F.lane) = (unsigned long long)pk2(v[j].x, v[j].y) | ((unsigned long long)pk2(v[j].z, v[j].w) << 32);
#pragma unroll
            for (int e = 0; e < 4; ++e) { const LAS float* wr_ = rwl + (256 * j + 4 * F.lane + e) * 20; const float hv = v[j][e];
#pragma unroll
                for (int q4 = 0; q4 < 5; ++q4) { const f32x4 w4 = *(const LAS f32x4*)(wr_ + 4 * q4);
                    lg[4 * q4] += hv * w4.x; lg[4 * q4 + 1] += hv * w4.y; lg[4 * q4 + 2] += hv * w4.z; lg[4 * q4 + 3] += hv * w4.w; } }
        }
#endif
#pragma unroll
        for (int q = 0; q < 20; ++q) lg[q] = wave_sum(lg[q]);
        float pgv[4]; float mx = -3e38f;
#pragma unroll
        for (int g = 0; g < 4; ++g) { pgv[g] = lg[g] + rb1[g]; mx = fmaxf(mx, pgv[g]); }
        float sum = 0.f;
#pragma unroll
        for (int g = 0; g < 4; ++g) { pgv[g] = __expf(pgv[g] - mx); sum += pgv[g]; }
        int gs = 0; float pbest = pgv[0];
#pragma unroll
        for (int g = 1; g < 4; ++g) if (pgv[g] > pbest) { pbest = pgv[g]; gs = g; }
        const float pg = pbest / sum;
        float pe[4]; mx = -3e38f;
#pragma unroll
        for (int e = 0; e < 4; ++e) { float l2 = 0.f;
#pragma unroll
            for (int g = 0; g < 4; ++g) l2 = (g == gs) ? lg[4 + g * 4 + e] + rb2[g * 4 + e] : l2;
            pe[e] = l2; mx = fmaxf(mx, l2); }
#pragma unroll
        for (int e = 0; e < 4; ++e) pe[e] = __expf(pe[e] - mx);
        int e0 = 0; float p0 = pe[0];
#pragma unroll
        for (int e = 1; e < 4; ++e) if (pe[e] > p0) { p0 = pe[e]; e0 = e; }
        int e1 = -1; float p1 = -1.f;
#pragma unroll
        for (int e = 0; e < 4; ++e) if (e != e0 && pe[e] > p1) { p1 = pe[e]; e1 = e; }
        const float den = p0 + p1; const int x0 = gs * 4 + e0, x1 = gs * 4 + e1;
        if (F.lane == 0) {
            const unsigned i0 = __hip_atomic_fetch_add(lcnt + x0, 1u, __ATOMIC_RELAXED, __HIP_MEMORY_SCOPE_WORKGROUP);
            const unsigned i1 = __hip_atomic_fetch_add(lcnt + x1, 1u, __ATOMIC_RELAXED, __HIP_MEMORY_SCOPE_WORKGROUP);
            TOKE[m] = x0 | (x1 << 8); TOKP[2 * m] = (int)i0; TOKP[2 * m + 1] = (int)i1; TOKW[2 * m] = pg * p0 / den; TOKW[2 * m + 1] = pg * p1 / den;
        }
    }
    __syncthreads();
    if (F.tid < 16) lcnt[16 + F.tid] = __hip_atomic_fetch_add(gcnt + F.tid, lcnt[F.tid], __ATOMIC_RELAXED, __HIP_MEMORY_SCOPE_AGENT);
    __syncthreads();
    for (int m = gw; m < M; m += NGW) {
        if (F.lane == 0) { const int ee = TOKE[m]; TOKP[2 * m] += (int)lcnt[16 + (ee & 255)]; TOKP[2 * m + 1] += (int)lcnt[16 + (ee >> 8)]; }
    }
}
DI void moe_tile_table(const Frame& F, unsigned char* ws, LAS int* tb) {
    if (F.tid == 0) { const unsigned* gcnt = (const unsigned*)(ws + WS_CTL) + CW_CNT; int acc = 0;
        for (int e = 0; e < 16; ++e) { tb[e] = acc; acc += (int)((__hip_atomic_load(gcnt + e, __ATOMIC_RELAXED, __HIP_MEMORY_SCOPE_AGENT) + 255u) >> 8); } tb[16] = acc; }
    __syncthreads();
}
DI void p7_permute(const Frame& F, const KA& A) {
    unsigned char* ws = A.W();
    LAS int* tb = (LAS int*)(F.lds + RING_OFF);
    moe_tile_table(F, ws, tb);
    const bf16* HB = (const bf16*)(ws + WS_HB); bf16* HS = (bf16*)(ws + WS_HS);
    const int* TOKE = (const int*)(ws + WS_TOKE); const int* TOKP = (const int*)(ws + WS_TOKP);
    const int gw = F.vcu * NWAVES + F.wave, NGW = F.G * NWAVES;
    for (int it = gw; it < 2 * M; it += NGW) {
        const int m = it >> 1, k = it & 1; const int ee = TOKE[m]; const int e = k ? (ee >> 8) : (ee & 255);
        const size_t row = (size_t)tb[e] * 256 + TOKP[it];
        const v4u a0 = *(const v4u*)(HB + (size_t)m * DM + 8 * F.lane), a1 = *(const v4u*)(HB + (size_t)m * DM + 512 + 8 * F.lane);
        *(v4u*)(HS + row * DM + 8 * F.lane) = a0; *(v4u*)(HS + row * DM + 512 + 8 * F.lane) = a1;
    }
}
DI void p10_combine(const Frame& F, const KA& A) {
    unsigned char* ws = A.W();
    LAS int* tb = (LAS int*)(F.lds + RING_OFF);
    moe_tile_table(F, ws, tb);
    const float* g2 = A.I(16); const float* b2 = A.I(17); float* out = A.O();
    const bf16* Y2 = (const bf16*)(ws + WS_Y2);
    const bf16* HBc = (const bf16*)(ws + WS_HB); (void)HBc;
    const int* TOKE = (const int*)(ws + WS_TOKE); const int* TOKP = (const int*)(ws + WS_TOKP); const float* TOKW = (const float*)(ws + WS_TOKW);
    const int gw = F.vcu * NWAVES + F.wave, NGW = F.G * NWAVES;
    for (int m = gw; m < M; m += NGW) {
        const size_t ro = (size_t)m * DM; const int ee = TOKE[m];
        const size_t r0 = (size_t)tb[ee & 255] * 256 + TOKP[2 * m], r1 = (size_t)tb[ee >> 8] * 256 + TOKP[2 * m + 1];
        const float w0 = TOKW[2 * m], w1 = TOKW[2 * m + 1];
        f32x4 v[4]; float s = 0.f;
#pragma unroll
        for (int j = 0; j < 4; ++j) {
#ifdef LN1_FUSE
            const f32x4 hv = *(const f32x4*)(out + ro + 256 * j + 4 * F.lane);
#else
            const uint2 hr = *(const uint2*)(HBc + ro + 256 * j + 4 * F.lane); const f32x4 hv = {bflo(hr.x), bfhi(hr.x), bflo(hr.y), bfhi(hr.y)};
#endif
            const uint2 ya = *(const uint2*)(Y2 + r0 * DM + 256 * j + 4 * F.lane), yb = *(const uint2*)(Y2 + r1 * DM + 256 * j + 4 * F.lane);
            v[j].x = ALPHA * hv.x + w0 * bflo(ya.x) + w1 * bflo(yb.x); v[j].y = ALPHA * hv.y + w0 * bfhi(ya.x) + w1 * bfhi(yb.x);
            v[j].z = ALPHA * hv.z + w0 * bflo(ya.y) + w1 * bflo(yb.y); v[j].w = ALPHA * hv.w + w0 * bfhi(ya.y) + w1 * bfhi(yb.y);
            s += (v[j].x + v[j].y) + (v[j].z + v[j].w);
        }
        const float mean = wave_sum(s) * (1.f / DM); float s2 = 0.f;
#pragma unroll
        for (int j = 0; j < 4; ++j) { v[j] = v[j] - mean; s2 += (v[j].x * v[j].x + v[j].y * v[j].y) + (v[j].z * v[j].z + v[j].w * v[j].w); }
        const float rstd = rsqrtf(wave_sum(s2) * (1.f / DM) + LN_EPS);
#pragma unroll
        for (int j = 0; j < 4; ++j) { const f32x4 gv = *(const f32x4*)(g2 + 256 * j + 4 * F.lane), bv = *(const f32x4*)(b2 + 256 * j + 4 * F.lane);
            f32x4 ov = v[j] * rstd * gv + bv;
            *(f32x4*)(out + ro + 256 * j + 4 * F.lane) = ov; }
    }
}

#ifndef DUP_P0
#define DUP_P0 1
#endif
#ifndef DUP_P1
#define DUP_P1 1
#endif
#ifndef DUP_P2
#define DUP_P2 1
#endif
#ifndef DUP_P3
#define DUP_P3 1
#endif
#ifndef DUP_P5
#define DUP_P5 1
#endif
#ifndef DUP_P7
#define DUP_P7 1
#endif
#ifndef DUP_P8
#define DUP_P8 1
#endif
#ifndef DUP_P9
#define DUP_P9 1
#endif
#ifdef SKIP_N2B
#define n2b_dn_recurrent(...) ((void)0)
#endif
#ifdef SKIP_N3B
#define n3b_moba_naive(...) ((void)0)
#endif
#ifdef SKIP_N5
#define n5_token_tail(...) ((void)0)
#endif
#ifdef SKIP_P0
#define p0_prologue(...) ((void)0)
#endif
#ifdef SKIP_N2A
#define n2a_conv_norm(...) ((void)0)
#endif
#ifdef SKIP_N3A
#define n3a_rope(...) ((void)0)
#endif
#ifdef SKIP_N2C
#define n2c_dn_gate(...) ((void)0)
#endif
#if defined(DBG_MOBA) || defined(DBG_DN)
#define DBG_ANY 1
#endif
#ifdef MOE_NAIVE
constexpr int N_PHASES = 7;
#else
constexpr int N_PHASES = 11;
#endif
__global__ void __launch_bounds__(NTHR, 2) mk_fwd(Args args_unused) {
    (void)args_unused;
    extern __shared__ __attribute__((aligned(16))) unsigned char lds[];
    Frame F;
    F.lds = (LAS unsigned char*)lds;
    F.tid = threadIdx.x; F.lane = F.tid & 63; F.wave = __builtin_amdgcn_readfirstlane(F.tid >> 6);
    F.G = gridDim.x; { const int bx = blockIdx.x; F.vcu = (F.G % 8 == 0) ? (bx % 8) * (F.G / 8) + bx / 8 : bx; }
    unsigned char* ws = kargs().W();
    gu32* ctl = (gu32*)(ws + WS_CTL);
    volatile LAS unsigned* MISC = (volatile LAS unsigned*)(F.lds + MISC_OFF);
    for (int u = F.tid; u < (LDS_BYTES - LDSCTL_OFF) / 4; u += NTHR) ((LAS unsigned*)(F.lds + LDSCTL_OFF))[u] = 0u;
    __syncthreads();
    const int lo = kargs().lo(), hi = kargs().hi();
    const bool multi = (hi - lo) > 1;
    XcdBarrier bar; bar.bar = (unsigned*)(ctl + CW_BAR); bar.x = 0; bar.st = nullptr;
    if (multi) bar = xcd_barrier_post((unsigned*)(ctl + CW_BAR), MISC + 8);
#define IN(k) (lo <= (k) && (k) < hi)
#define REFRESH_F() do { int t_ = threadIdx.x; asm volatile("" : "+v"(t_)); F.tid = t_; F.lane = t_ & 63; F.wave = __builtin_amdgcn_readfirstlane(t_ >> 6); } while (0)
#define SEAM(k) do { if (IN(k) && IN((k) + 1)) xcd_barrier(bar); } while (0)

    if (IN(0)) { REFRESH_F(); for (int rep_ = 0; rep_ < DUP_P0; ++rep_) { const KA args = kargs(); p0_prologue(F, args); __syncthreads(); } SEAM(0); }
    if (IN(1)) { REFRESH_F(); for (int rep_ = 0; rep_ < DUP_P1; ++rep_) {
        pg8::Gemm g{(const bf16*)(ws + WS_XB), (const bf16*)(ws + WS_WIN), M, NPROJ, DM}; pg8::StaticOrder S; S.init(M, NPROJ, F.G, (int)blockIdx.x);
        pg8::EpiBf16<0> E{(bf16*)(ws + WS_PJ), 512, nullptr, 512, (size_t)(PJ_STRIDE / 2), 1.f};
        pg8::gemm_phase<pg8::EpiBf16<0>, pg8::StaticOrder, PG8_ALIGN, PG8_SP2>(F.lds + RING_OFF, g, S, E); }
        SEAM(1);
    }
    if (IN(2)) { REFRESH_F();
        const KA args = kargs();
#if defined(DN_NAIVE) || defined(DBG_DN)
        n2a_conv_norm(F, args);
#endif
#ifndef DN_NAIVE
        for (int rep_ = 0; rep_ < DUP_P2; ++rep_) for (int it = F.vcu; it < 1024; it += F.G)
            dn::chunk_local(F.lds, it, (const bf16*)(ws + WS_PJ), PJ_STRIDE / 2, (const float*)(ws + WS_GATES), args.I(2), args.I(3), args.I(4),
                            (unsigned char*)args.O(), ws + WS_UF, (float*)(ws + WS_GL));
#endif
        n3a_rope(F, args); SEAM(2); }
    if (IN(3)) { REFRESH_F();
        const KA args = kargs();
#ifdef DN_NAIVE
        float* ODN = args.O();
#else
        float* ODN = (float*)(ws + WS_PJ);
#endif
        {
            const int v = F.vcu;
            const int bh = __builtin_amdgcn_readfirstlane(v >> 4), r = __builtin_amdgcn_readfirstlane(v & 15);
            if (r == 15 && v < 256) {
#if defined(DN_NAIVE) || defined(DBG_DN)
                n2b_dn_recurrent(F, args, bh, ODN);
#endif
#ifndef DN_NAIVE
                dn::scan_bh(F.lds, bh, (const unsigned char*)args.O(), ws + WS_UF, (const float*)(ws + WS_GL), ws + WS_SF, ws + WS_VF);
#endif
            }
#ifdef MB_QUEUE
            p3_moba_queue(ws, (char*)lds, (LAS unsigned*)(F.lds + LDSCTL_OFF + 640), F.tid, __builtin_amdgcn_readfirstlane((v >> 5) & 7));
#else
            if (r != 15) p3_moba_static(ws, (char*)lds, bh, 15 - r, r == 14 ? 0 : -1);
#endif
        }
        SEAM(3);
    }
    if (IN(4)) { REFRESH_F(); const KA args = kargs();
#ifdef DN_NAIVE
        n2c_dn_gate(F, args, args.O(), (bf16*)(ws + WS_Y), 1024);
#else
        for (int it = F.vcu; it < 512; it += F.G)
            dn::chunk_out(F.lds, it, (const unsigned char*)args.O(), ws + WS_SF, ws + WS_VF, (const bf16*)(ws + WS_PJ + 3 * PJ_STRIDE), args.I(5), (bf16*)(ws + WS_Y));
#endif
#ifdef MB_QUEUE
        for (int it = F.vcu; it < MB_NSPLIT * 16; it += F.G) p4_moba_merge(ws, it, F.tid);
#endif
        SEAM(4); }
    if (IN(5)) { REFRESH_F();
        const KA args = kargs();
        pg8::Gemm g{(const bf16*)(ws + WS_Y), (const bf16*)(ws + WS_WOUT), M, DM, DM}; pg8::StaticOrder S; S.init(M, DM, F.G, (int)blockIdx.x);
#if defined(MOE_NAIVE)
        pg8::EpiF32 E{args.O(), DM};
        for (int rep_ = 0; rep_ < DUP_P5; ++rep_) pg8::gemm_phase<pg8::EpiF32, pg8::StaticOrder, PG8_ALIGN, PG8_SP2>(F.lds + RING_OFF, g, S, E);
#elif !defined(LN1_FUSE)
        pg8::EpiBf16<0> E{(bf16*)(ws + WS_MIXB), DM, nullptr, 0, 0, 1.f};
        pg8::gemm_phase<pg8::EpiBf16<0>, pg8::StaticOrder, PG8_ALIGN, PG8_SP2>(F.lds + RING_OFF, g, S, E);
#else
        if (F.G == 256) {
            pg8::PanelStats st{(unsigned*)(ws + WS_XBUF), (unsigned*)(ws + WS_CTL) + CW_SEAM, (unsigned*)(ws + WS_CTL), DM / 256, LN_EPS, 0x740u};
            pg8::EpiLn1 E{args.I(0), args.O(), (bf16*)(ws + WS_HB), args.I(7), args.I(8), ALPHA, st, 0u};
            pg8::gemm_phase<pg8::EpiLn1, pg8::StaticOrder, false, PG8_SP2>(F.lds + RING_OFF, g, S, E);
        }
#endif
        SEAM(5);
    }
#ifdef MOE_NAIVE
    if (IN(6)) { REFRESH_F(); const KA args = kargs(); n5_token_tail(F, args); }
#else
    if (IN(6)) { REFRESH_F(); const KA args = kargs(); p6_ln_router(F, args); SEAM(6); }
    if (IN(7)) { REFRESH_F(); for (int rep_ = 0; rep_ < DUP_P7; ++rep_) { const KA args = kargs(); p7_permute(F, args); __syncthreads(); } SEAM(7); }
    if (IN(8)) { REFRESH_F();
        LAS int* tb = (LAS int*)(F.lds + LDSCTL_OFF + 512); moe_tile_table(F, ws, tb);
        pg8::Gemm g{(const bf16*)(ws + WS_HS), (const bf16*)(ws + WS_WGU), 36864, 512, DM}; pg8::MoeOrder S{(const LAS int*)tb, 2, F.G, (int)blockIdx.x, (size_t)512 * DM * 2};
        pg8::EpiSwiGLU E{(bf16*)(ws + WS_HE)};
        for (int rep_ = 0; rep_ < DUP_P8; ++rep_) pg8::gemm_phase<pg8::EpiSwiGLU, pg8::MoeOrder, PG8_ALIGN, PG8_SP2>(F.lds + RING_OFF, g, S, E);
        SEAM(8);
    }
    if (IN(9)) { REFRESH_F();
        LAS int* tb = (LAS int*)(F.lds + LDSCTL_OFF + 512); moe_tile_table(F, ws, tb);
        int kdim = DE; asm volatile("" : "+s"(kdim));
        pg8::Gemm g{(const bf16*)(ws + WS_HE), (const bf16*)(ws + WS_WD), 36864, DM, kdim}; pg8::MoeOrder S{(const LAS int*)tb, 4, F.G, (int)blockIdx.x, (size_t)DM * DE * 2};
        pg8::EpiBf16<0> E{(bf16*)(ws + WS_Y2), DM, nullptr, 0, 0, 1.f};
        for (int rep_ = 0; rep_ < DUP_P9; ++rep_) pg8::gemm_phase<pg8::EpiBf16<0>, pg8::MoeOrder, PG8_ALIGN, PG8_SP2>(F.lds + RING_OFF, g, S, E);
        SEAM(9);
    }
    if (IN(10)) { REFRESH_F(); const KA args = kargs(); p10_combine(F, args); }
#endif
#undef IN
#undef SEAM
}

extern "C" void kernel_launch(void* const* d_in, const int* in_sizes, int n_in, void* d_out, int out_size, void* d_ws, size_t ws_size, hipStream_t stream) {
    static int grid = 0;
    if (grid == 0) {
        if (n_in != 18 || in_sizes[0] != M * DM || out_size != M * DM || ws_size < WS_END) { fprintf(stderr, "kernel_launch: unexpected shapes (n_in %d, in0 %d, out %d, ws %zu)\n", n_in, n_in > 0 ? in_sizes[0] : -1, out_size, ws_size); grid = -1; return; }
        int dev = 0, cus = 0;
        if (hipGetDevice(&dev) != hipSuccess || hipDeviceGetAttribute(&cus, hipDeviceAttributeMultiprocessorCount, dev) != hipSuccess) { grid = -1; return; }
        if (hipFuncSetAttribute((const void*)mk_fwd, hipFuncAttributeMaxDynamicSharedMemorySize, LDS_BYTES) != hipSuccess) { fprintf(stderr, "kernel_launch: hipFuncSetAttribute failed\n"); grid = -1; return; }
        int per_cu = 0;
        if (hipOccupancyMaxActiveBlocksPerMultiprocessor(&per_cu, (const void*)mk_fwd, NTHR, LDS_BYTES) != hipSuccess || per_cu < 1) fprintf(stderr, "kernel_launch: occupancy query says %d\n", per_cu);
        (void)hipGetLastError();
        grid = cus;
    }
    if (grid < 0) return;
    (void)hipMemsetAsync((char*)d_ws + WS_CTL, 0, CTL_ZERO_BYTES, stream);
    Args a{};
    for (int i = 0; i < 18; ++i) a.in_[i] = (const GAS float*)d_in[i];
    a.out_ = (GAS float*)d_out; a.ws_ = (GAS unsigned char*)d_ws;
#ifndef MK_PER_PHASE
    a.ph_lo = 0; a.ph_hi = N_PHASES;
    hipLaunchKernelGGL(mk_fwd, dim3(grid), dim3(NTHR), LDS_BYTES, stream, a);
#else
    for (int p = 0; p < N_PHASES; ++p) { a.ph_lo = p; a.ph_hi = p + 1; hipLaunchKernelGGL(mk_fwd, dim3(grid), dim3(NTHR), LDS_BYTES, stream, a); }
#endif
}
```

```cpp
#define MB_PIPE 1
#define MB_QUEUE 1
#include <hip/hip_runtime.h>
#include <cstdio>
#include <cstdint>
#include <cstddef>
namespace pg8 {
#define PG8_LAS __attribute__((address_space(3)))
typedef unsigned short bf16_t;
typedef short bf16x8 __attribute__((ext_vector_type(8)));
typedef float f32x4 __attribute__((ext_vector_type(4)));
typedef unsigned u32x4 __attribute__((ext_vector_type(4)));
constexpr int BM = 256, BK = 64, HALF = 128, HTB = HALF * BK * 2  , STAGE_BYTES = 8 * HTB, NXCD = 8, WGM = 8;

__host__ __device__ __forceinline__ int lds_byte(int r, int c) { const int st = (r >> 4) * 2 + (c >> 5), rr = r & 15, cc = c & 31, ob = rr * 64 + cc * 2; return st * 1024 + (ob ^ (((ob >> 9) & 1) << 5)); }
__host__ __device__ __forceinline__ void stage_rc(int b, int& R, int& C) { const int st = b / 1024, sb = b % 1024, swz = sb ^ (((sb >> 9) & 1) << 5); R = (st >> 1) * 16 + swz / 64; C = (st & 1) * 32 + (swz % 64) / 2; }
__host__ __device__ __forceinline__ int perm32(int rho) { const int n = rho >> 4, i = rho & 15; return 8 * (i >> 2) + 4 * n + (i & 3); }

struct Unit { int pm, pn; };
struct Gemm { const bf16_t* A; const bf16_t* Bt; int M, N, K; };

struct StaticOrder {
    int nM, nN, nwg, G, c;
    __host__ __device__ void init(int M, int N, int G_, int c_) { nM = M / BM; nN = N / BM; nwg = nM * nN; G = G_; c = c_; }
    __host__ __device__ bool next(int i, Unit& u) const {
        const long L = (long)i * G + c; if (L >= nwg) return false;
        int wgid = (int)L; { const int q = nwg / NXCD, r = nwg % NXCD, xcd = wgid % NXCD, off = wgid / NXCD; wgid = (xcd < r ? xcd * (q + 1) : r * (q + 1) + (xcd - r) * q) + off; }
        const int nig = WGM * nN, gid = wgid / nig, fm = gid * WGM, gsz = (nM - fm) < WGM ? (nM - fm) : WGM;
        u.pm = fm + ((wgid % nig) % gsz); u.pn = (wgid % nig) / gsz; return true;
    }
    __device__ __forceinline__ void a_ready(const Unit&) const {}
    __device__ __forceinline__ void done(const Unit&) const {}
    __device__ __forceinline__ size_t bofs(const Unit&) const { return 0; }
};

__device__ __forceinline__ unsigned cvt_pk_bf16(float lo, float hi) { unsigned r; asm volatile("v_cvt_pk_bf16_f32 %0, %1, %2" : "=v"(r) : "v"(lo), "v"(hi)); return r; }
typedef float f32x2 __attribute__((ext_vector_type(2)));
__device__ __forceinline__ f32x2 gelu_pk(f32x2 v) {
    const f32x2 av = __builtin_elementwise_abs(v), d = av * 0.2316418882f + 1.0f;
    f32x2 t; t.x = __builtin_amdgcn_rcpf(d.x); t.y = __builtin_amdgcn_rcpf(d.y);
    f32x2 q = t * 0.5307027145f + (-0.7265760135f); q = q * t + 0.7107068705f; q = q * t + (-0.142248368f); q = q * t + 0.127414796f; q = q * t;
    const f32x2 s = (v * v) * (-0.72134752044f);
    f32x2 e; e.x = __builtin_amdgcn_exp2f(s.x); e.y = __builtin_amdgcn_exp2f(s.y);
    const f32x2 m = v * (q * e), r = v - m;
    f32x2 o; o.x = v.x < 0.f ? m.x : r.x; o.y = v.y < 0.f ? m.y : r.y; return o;
}

template <int ACT  > struct EpiBf16 {
    static constexpr bool PERM = true, AFTER_DRAIN = false; static_assert(ACT == 0 || ACT == 1, "EpiBf16: ACT is 0 (none) or 1 (gelu_pk)");
    bf16_t* O; int ldc; const float* bias; int split_cols; size_t split_stride; float scale0;
    __device__ __forceinline__ void operator()(const f32x4 (&acc)[2][2][4][2], const Unit& u, int wr, int wc, int fr, int fq) const {
        const int row0 = u.pm * BM + wr * 64 + fr; int colt = u.pn * BM; bf16_t* base = O;
        float sc = 1.f; if (split_cols) { const int t = colt / split_cols; base += (size_t)t * split_stride; colt -= t * split_cols; if (t == 0) sc = scale0; }
        const int col0 = colt + wc * 32 + 8 * fq, bcol0 = u.pn * BM + wc * 32 + 8 * fq;
        f32x4 bv[2][2];
#pragma unroll
        for (int bj = 0; bj < 2; ++bj)
#pragma unroll
            for (int n = 0; n < 2; ++n) bv[bj][n] = bias ? *(const f32x4*)(bias + bcol0 + bj * HALF + 4 * n) : (f32x4){0.f, 0.f, 0.f, 0.f};
#pragma unroll
        for (int ai = 0; ai < 2; ++ai)
#pragma unroll
            for (int m = 0; m < 4; ++m) { bf16_t* rowp = base + (size_t)(row0 + ai * HALF + m * 16) * ldc + col0;
#pragma unroll
                for (int bj = 0; bj < 2; ++bj) { f32x4 v0 = acc[ai][bj][m][0] + bv[bj][0], v1 = acc[ai][bj][m][1] + bv[bj][1];
                    if (ACT == 1) { f32x2 a = gelu_pk((f32x2){v0[0], v0[1]}), b = gelu_pk((f32x2){v0[2], v0[3]}), c = gelu_pk((f32x2){v1[0], v1[1]}), d = gelu_pk((f32x2){v1[2], v1[3]});
                        v0 = (f32x4){a.x, a.y, b.x, b.y}; v1 = (f32x4){c.x, c.y, d.x, d.y}; }
                    v0 = v0 * sc; v1 = v1 * sc; u32x4 w; w.x = cvt_pk_bf16(v0[0], v0[1]); w.y = cvt_pk_bf16(v0[2], v0[3]); w.z = cvt_pk_bf16(v1[0], v1[1]); w.w = cvt_pk_bf16(v1[2], v1[3]);
                    *(u32x4*)(rowp + bj * HALF) = w; } }
    }
};

struct PanelStats {
    unsigned* xbuf;
    unsigned* cnt;
    unsigned* tmo;
    int ntn; float eps;
    unsigned code;
    __device__ __forceinline__ bool run(const f32x4 (&v)[2][2][4][2], const Unit& u, int wr, int wc, int fr, int fq, PG8_LAS unsigned char* lds, int wid, int lane) const {
        typedef float f32x2v __attribute__((ext_vector_type(2)));
        PG8_LAS f32x2v* P = (PG8_LAS f32x2v*)lds;
        PG8_LAS f32x2v* S = (PG8_LAS f32x2v*)(lds + 8192);
        PG8_LAS unsigned* flag = (PG8_LAS unsigned*)(lds + 8192 + 2048);
#pragma unroll
        for (int ai = 0; ai < 2; ++ai)
#pragma unroll
            for (int m = 0; m < 4; ++m) {
                float s = 0.f;
#pragma unroll
                for (int bj = 0; bj < 2; ++bj)
#pragma unroll
                    for (int n = 0; n < 2; ++n) { const f32x4 x = v[ai][bj][m][n]; s += (x[0] + x[1]) + (x[2] + x[3]); }
                s += __shfl_xor(s, 16); s += __shfl_xor(s, 32);
                const float mw = s * (1.0f / 64.0f); float q = 0.f;
#pragma unroll
                for (int bj = 0; bj < 2; ++bj)
#pragma unroll
                    for (int n = 0; n < 2; ++n) { const f32x4 d = v[ai][bj][m][n] - mw; q += (d[0] * d[0] + d[1] * d[1]) + (d[2] * d[2] + d[3] * d[3]); }
                q += __shfl_xor(q, 16); q += __shfl_xor(q, 32);
                if (fq == 0) P[(ai * HALF + wr * 64 + m * 16 + fr) * 4 + wc] = (f32x2v){mw, q};
            }
        asm volatile("s_waitcnt lgkmcnt(0)" ::: "memory"); __builtin_amdgcn_s_barrier(); asm volatile("" ::: "memory");
#if defined(BROKEN_EXCHANGE_NO_WAIT)
#warning BROKEN CONTROL BUILD: the row-statistics exchange does not wait; results are wrong by design
        if (blockIdx.x >= 64) { const long long t0_ = clock64(); while (clock64() - t0_ < 60000) __builtin_amdgcn_s_sleep(8); }
#endif
        const int row = wid * 32 + (lane & 31);
        if (lane < 32) {
            const f32x2v a = P[row * 4 + 0], b = P[row * 4 + 1], c = P[row * 4 + 2], d = P[row * 4 + 3];
            const float mt = (a.x + b.x + c.x + d.x) * 0.25f;
            const float da = a.x - mt, db = b.x - mt, dc = c.x - mt, dd = d.x - mt;
            const float m2 = (a.y + b.y) + (c.y + d.y) + 64.0f * ((da * da + db * db) + (dc * dc + dd * dd));
            unsigned long long* slot = (unsigned long long*)xbuf + ((size_t)(u.pm * BM + row) * 4 + u.pn);
            __hip_atomic_store(slot, ((unsigned long long)__float_as_uint(m2) << 32) | __float_as_uint(mt), __ATOMIC_RELAXED, __HIP_MEMORY_SCOPE_AGENT);
        }
        asm volatile("s_waitcnt vmcnt(0)" ::: "memory");
        if (lane == 0) __hip_atomic_fetch_add(cnt + 64 * u.pm, 1u, __ATOMIC_RELAXED, __HIP_MEMORY_SCOPE_AGENT);
        if (wid == 0) {
            bool dead = false; const unsigned long long t0 = __builtin_amdgcn_s_memrealtime(); const unsigned want = 8u * (unsigned)ntn;
            for (;;) {
#if defined(BROKEN_EXCHANGE_NO_WAIT)
                break;
#endif
                if ((unsigned)__builtin_amdgcn_readfirstlane(__hip_atomic_load(cnt + 64 * u.pm, __ATOMIC_RELAXED, __HIP_MEMORY_SCOPE_AGENT)) >= want) break;
                if (__builtin_amdgcn_s_memrealtime() - t0 > 2000000ull) {
                    if (lane == 0) { unsigned expect = 0u; __hip_atomic_compare_exchange_strong(tmo + 1, &expect, code | (unsigned)(u.pm & 0xff), __ATOMIC_RELAXED, __ATOMIC_RELAXED, __HIP_MEMORY_SCOPE_AGENT);
                                     __hip_atomic_store(tmo, 1u, __ATOMIC_RELAXED, __HIP_MEMORY_SCOPE_AGENT); }
                    dead = true; break; }
                __builtin_amdgcn_s_sleep(2);
            }
            __builtin_amdgcn_fence(__ATOMIC_ACQUIRE, "agent");
            if (lane == 0) flag[0] = dead ? 1u : 0u;
        }
        asm volatile("s_waitcnt vmcnt(0) lgkmcnt(0)" ::: "memory"); __builtin_amdgcn_s_barrier(); asm volatile("" ::: "memory");
        const bool bad = flag[0] != 0u;
        if (lane < 32) {
            const unsigned long long* slot = (const unsigned long long*)xbuf + (size_t)(u.pm * BM + row) * 4; float mt[4], m2[4]; float ms = 0.f;
#pragma unroll
            for (int t = 0; t < 4; ++t) { if (t < ntn) { const unsigned long long w = __hip_atomic_load(slot + t, __ATOMIC_RELAXED, __HIP_MEMORY_SCOPE_AGENT); mt[t] = __uint_as_float((unsigned)w); m2[t] = __uint_as_float((unsigned)(w >> 32)); } else { mt[t] = 0.f; m2[t] = 0.f; } ms += mt[t]; }
            const float mean = ms / (float)ntn; float q = 0.f;
#pragma unroll
            for (int t = 0; t < 4; ++t) if (t < ntn) { const float dm = mt[t] - mean; q += m2[t] + 256.0f * dm * dm; }
            S[row] = (f32x2v){mean, 1.0f / sqrtf(q / (256.0f * (float)ntn) + eps)};
        }
        asm volatile("s_waitcnt lgkmcnt(0)" ::: "memory"); __builtin_amdgcn_s_barrier(); asm volatile("" ::: "memory");
        return bad;
    }
};
struct EpiLnRes {
    static constexpr bool PERM = false, AFTER_DRAIN = true;
    const float* base; float* out; int ldc; const float* bias; PanelStats st; unsigned poison;
    __device__ __forceinline__ void fused(f32x4 (&acc)[2][2][4][2], const Unit& u, int wr, int wc, int fr, int fq, PG8_LAS unsigned char* lds, int wid, int lane) const {
        typedef float f32x2v __attribute__((ext_vector_type(2)));
        const PG8_LAS f32x2v* S = (const PG8_LAS f32x2v*)(lds + 8192);
        const int col0 = u.pn * BM + wc * 32 + 4 * fq;
#pragma unroll
        for (int bj = 0; bj < 2; ++bj)
#pragma unroll
            for (int n = 0; n < 2; ++n) { const f32x4 bv = bias ? *(const f32x4*)(bias + col0 + bj * HALF + n * 16) : (f32x4){0.f, 0.f, 0.f, 0.f};
#pragma unroll
                for (int ai = 0; ai < 2; ++ai)
#pragma unroll
                    for (int m = 0; m < 4; ++m) acc[ai][bj][m][n] += bv; }
        f32x4 pre[4][2][2];
#pragma unroll
        for (int m = 0; m < 4; ++m) { const size_t off = (size_t)(u.pm * BM + wr * 64 + m * 16 + fr) * ldc + col0;
#pragma unroll
            for (int bj = 0; bj < 2; ++bj)
#pragma unroll
                for (int n = 0; n < 2; ++n) pre[m][bj][n] = *(const f32x4*)(base + off + bj * HALF + n * 16); }
        const bool bad = st.run(acc, u, wr, wc, fr, fq, lds, wid, lane) || poison != 0u;
        const float qnan = __builtin_nanf("");
#pragma unroll
        for (int ai = 0; ai < 2; ++ai)
#pragma unroll
            for (int m = 0; m < 4; ++m) { const int r = ai * HALF + wr * 64 + m * 16 + fr; const f32x2v sr = S[r]; const size_t off = (size_t)(u.pm * BM + r) * ldc + col0;
#pragma unroll
                for (int bj = 0; bj < 2; ++bj)
#pragma unroll
                    for (int n = 0; n < 2; ++n) { const f32x4 bs = ai == 0 ? pre[m][bj][n] : *(const f32x4*)(base + off + bj * HALF + n * 16); f32x4 o = bs + (acc[ai][bj][m][n] - sr.x) * sr.y;
                        if (bad) o = (f32x4){qnan, qnan, qnan, qnan}; *(f32x4*)(out + off + bj * HALF + n * 16) = o; }
                if (m & 1) asm volatile("" ::: "memory"); }
    }
};
struct EpiLnResLn {
    static constexpr bool PERM = false, AFTER_DRAIN = true;
    const float* base; float* out; bf16_t* xn; int ldc; const float* bias; PanelStats st1, st2; unsigned poison;
    __device__ __forceinline__ void fused(f32x4 (&acc)[2][2][4][2], const Unit& u, int wr, int wc, int fr, int fq, PG8_LAS unsigned char* lds, int wid, int lane) const {
        typedef float f32x2v __attribute__((ext_vector_type(2))); typedef unsigned u32x2v __attribute__((ext_vector_type(2)));
        const PG8_LAS f32x2v* S = (const PG8_LAS f32x2v*)(lds + 8192);
        const int col0 = u.pn * BM + wc * 32 + 4 * fq;
#pragma unroll
        for (int bj = 0; bj < 2; ++bj)
#pragma unroll
            for (int n = 0; n < 2; ++n) { const f32x4 bv = bias ? *(const f32x4*)(bias + col0 + bj * HALF + n * 16) : (f32x4){0.f, 0.f, 0.f, 0.f};
#pragma unroll
                for (int ai = 0; ai < 2; ++ai)
#pragma unroll
                    for (int m = 0; m < 4; ++m) acc[ai][bj][m][n] += bv; }
        bool bad = st1.run(acc, u, wr, wc, fr, fq, lds, wid, lane) || poison != 0u;
        const float qnan = __builtin_nanf("");
#pragma unroll
        for (int ai = 0; ai < 2; ++ai)
#pragma unroll
            for (int m = 0; m < 4; ++m) { const int r = ai * HALF + wr * 64 + m * 16 + fr; const f32x2v sr = S[r]; const size_t off = (size_t)(u.pm * BM + r) * ldc + col0;
#pragma unroll
                for (int bj = 0; bj < 2; ++bj)
#pragma unroll
                    for (int n = 0; n < 2; ++n) { const f32x4 bs = *(const f32x4*)(base + off + bj * HALF + n * 16); acc[ai][bj][m][n] = bs + (acc[ai][bj][m][n] - sr.x) * sr.y; }
                asm volatile("" : "+v"(acc[ai][0][m][0]), "+v"(acc[ai][0][m][1]), "+v"(acc[ai][1][m][0]), "+v"(acc[ai][1][m][1]));
                if (m & 1) asm volatile("" ::: "memory"); }
        const bool bad1 = bad;
        bad = st2.run(acc, u, wr, wc, fr, fq, lds, wid, lane) || bad;
#pragma unroll
        for (int ai = 0; ai < 2; ++ai)
#pragma unroll
            for (int m = 0; m < 4; ++m) { const int r = ai * HALF + wr * 64 + m * 16 + fr; const f32x2v sr = S[r]; const size_t off = (size_t)(u.pm * BM + r) * ldc + col0;
#pragma unroll
                for (int bj = 0; bj < 2; ++bj)
#pragma unroll
                    for (int n = 0; n < 2; ++n) { const f32x4 x1 = acc[ai][bj][m][n]; *(f32x4*)(out + off + bj * HALF + n * 16) = bad1 ? (f32x4){qnan, qnan, qnan, qnan} : x1;
                        const f32x4 o = (x1 - sr.x) * sr.y; u32x2v w; w.x = cvt_pk_bf16(o[0], o[1]); w.y = cvt_pk_bf16(o[2], o[3]);
                        if (bad) { w.x = 0x7fc07fc0u; w.y = 0x7fc07fc0u; } *(u32x2v*)(xn + off + bj * HALF + n * 16) = w; }
                asm volatile("" ::: "memory"); }
    }
};

template <class Epi, class Sched, bool ALIGN_EPI = false, bool SP2 = false>
__device__ __forceinline__ void gemm_phase(PG8_LAS unsigned char* lds, const Gemm g, const Sched& S, const Epi& E) {
    const int tid = threadIdx.x, wid = __builtin_amdgcn_readfirstlane(tid >> 6), lane = tid & 63, wr = wid >> 2, wc = wid & 3, fr = lane & 15, fq = lane >> 4;
    const int K = g.K, nt = K / BK;
    unsigned voffA[2], voffB[2];
#pragma unroll
    for (int i = 0; i < 2; ++i) { int R, C; stage_rc(tid * 16 + i * 8192, R, C); const int Rb = Epi::PERM ? ((R & ~31) + perm32(R & 31)) : R;
        voffA[i] = (unsigned)(R * K + C) * 2u; voffB[i] = (unsigned)(Rb * K + C) * 2u; }
    const size_t kstep = (size_t)(BK * 2);
    const size_t hstep = (size_t)HALF * K * 2;
    const size_t tstep = 2 * hstep;
    const unsigned ldsw = (unsigned)wid * 1024u;
    const int aoff = lds_byte(wr * 64 + fr, fq * 8), boff = lds_byte(wc * 32 + fr, fq * 8);
#define PG8_SA(b, h) (((b) * 2 + (h)) * HTB)
#define PG8_SB(b, h) ((4 + (b) * 2 + (h)) * HTB)
#define PG8_STAGE(bufoff, gbase, voff) do { _Pragma("unroll") for (int _i = 0; _i < 2; ++_i) \
        __builtin_amdgcn_global_load_lds((const unsigned*)((const char*)(gbase) + (voff)[_i]), (PG8_LAS unsigned*)(lds + (bufoff) + ldsw + _i * 8192), 16, 0, 0); } while (0)
#define PG8_LDA(dst, b, h) do { _Pragma("unroll") for (int m = 0; m < 4; ++m) _Pragma("unroll") for (int k = 0; k < 2; ++k) dst[m][k] = *(const PG8_LAS bf16x8*)(lds + PG8_SA(b, h) + aoff + m * 2048 + k * 1024); } while (0)
#define PG8_LDB(dst, b, h) do { _Pragma("unroll") for (int n = 0; n < 2; ++n) _Pragma("unroll") for (int k = 0; k < 2; ++k) dst[n][k] = *(const PG8_LAS bf16x8*)(lds + PG8_SB(b, h) + boff + n * 2048 + k * 1024); } while (0)
#define PG8_MMA(ai, bj, At, Bt) do { __builtin_amdgcn_s_setprio(1); _Pragma("unroll") for (int m = 0; m < 4; ++m) _Pragma("unroll") for (int n = 0; n < 2; ++n) _Pragma("unroll") for (int k = 0; k < 2; ++k) \
        acc[ai][bj][m][n] = __builtin_amdgcn_mfma_f32_16x16x32_bf16(Bt[n][k], At[m][k], acc[ai][bj][m][n], 0, 0, 0); __builtin_amdgcn_s_setprio(0); } while (0)
#define PG8_WAIT_V(n) asm volatile("s_waitcnt vmcnt(" #n ")" ::: "memory")
#define PG8_WAIT_L(n) asm volatile("s_waitcnt lgkmcnt(" #n ")" ::: "memory")
#define PG8_BAR __builtin_amdgcn_s_barrier()
#define PG8_SCHED __builtin_amdgcn_sched_barrier(0)
    Unit cur, nxt; int ui = 0;
    if (!S.next(0, cur)) return;
    f32x4 acc[2][2][4][2];
#pragma unroll
    for (int a = 0; a < 2; ++a)
#pragma unroll
        for (int b = 0; b < 2; ++b)
#pragma unroll
            for (int m = 0; m < 4; ++m)
#pragma unroll
                for (int n = 0; n < 2; ++n) acc[a][b][m][n] = (f32x4){0.f, 0.f, 0.f, 0.f};
    bf16x8 At[4][2], B0[2][2], B1[2][2];
    const char* cA = (const char*)g.A + (size_t)cur.pm * tstep; const char* cB = (const char*)g.Bt + S.bofs(cur) + (size_t)cur.pn * tstep;
    S.a_ready(cur);
    if constexpr (SP2) {
        PG8_STAGE(PG8_SB(0, 0), cB, voffB); PG8_STAGE(PG8_SB(0, 1), cB + hstep, voffB); PG8_STAGE(PG8_SA(0, 0), cA, voffA); PG8_STAGE(PG8_SA(0, 1), cA + hstep, voffA);
        if (wr == 1) PG8_BAR;
        PG8_WAIT_V(2); PG8_BAR;
        PG8_STAGE(PG8_SB(1, 0), cB + kstep, voffB); PG8_STAGE(PG8_SA(1, 0), cA + kstep, voffA); PG8_STAGE(PG8_SB(1, 1), cB + hstep + kstep, voffB);
        PG8_WAIT_V(6); PG8_BAR;
    } else {
        PG8_STAGE(PG8_SB(0, 0), cB, voffB); PG8_STAGE(PG8_SA(0, 0), cA, voffA); PG8_STAGE(PG8_SB(0, 1), cB + hstep, voffB); PG8_STAGE(PG8_SA(0, 1), cA + hstep, voffA);
        if (wr == 1) PG8_BAR;
        PG8_WAIT_V(4); PG8_BAR;
        PG8_STAGE(PG8_SB(1, 0), cB + kstep, voffB); PG8_STAGE(PG8_SA(1, 0), cA + kstep, voffA); PG8_STAGE(PG8_SB(1, 1), cB + hstep + kstep, voffB);
        PG8_WAIT_V(6); PG8_BAR;
    }
    for (;;) {
        const bool has_next = S.next(ui + 1, nxt);
        const char* nA = has_next ? (const char*)g.A + (size_t)nxt.pm * tstep : cA; const char* nB = has_next ? (const char*)g.Bt + S.bofs(nxt) + (size_t)nxt.pn * tstep : cB;
        for (int t = 0; t < nt; t += 2) {
            const bool last = (t == nt - 2);
            const char* a1 = cA + (size_t)(t + 1) * kstep;
            const char* a2 = last ? nA : cA + (size_t)(t + 2) * kstep; const char* b2 = last ? nB : cB + (size_t)(t + 2) * kstep;
            const char* a3 = a2 + kstep; const char* b3 = b2 + kstep;
            if (last && has_next) S.a_ready(nxt);
            if constexpr (SP2) {
            PG8_LDB(B0, 0, 0); PG8_LDB(B1, 0, 1); PG8_SCHED; PG8_LDA(At, 0, 0); PG8_STAGE(PG8_SA(1, 1), a1 + hstep, voffA);
            PG8_WAIT_V(8); PG8_WAIT_L(0); PG8_BAR; PG8_MMA(0, 0, At, B0); PG8_MMA(0, 1, At, B1); PG8_BAR; PG8_SCHED;
            PG8_LDA(At, 0, 1); PG8_STAGE(PG8_SB(0, 0), b2, voffB); PG8_STAGE(PG8_SB(0, 1), b2 + hstep, voffB); PG8_STAGE(PG8_SA(0, 0), a2, voffA);
            PG8_WAIT_V(8); PG8_WAIT_L(0); PG8_BAR; PG8_MMA(1, 0, At, B0); PG8_MMA(1, 1, At, B1); PG8_BAR; PG8_SCHED;
            PG8_LDB(B0, 1, 0); PG8_LDB(B1, 1, 1); PG8_SCHED; PG8_LDA(At, 1, 0); PG8_STAGE(PG8_SA(0, 1), a2 + hstep, voffA);
            PG8_WAIT_V(8); PG8_WAIT_L(0); PG8_BAR; PG8_MMA(0, 0, At, B0); PG8_MMA(0, 1, At, B1); PG8_BAR; PG8_SCHED;
            PG8_LDA(At, 1, 1); PG8_STAGE(PG8_SB(1, 0), b3, voffB); PG8_STAGE(PG8_SB(1, 1), b3 + hstep, voffB); PG8_STAGE(PG8_SA(1, 0), a3, voffA);
            PG8_WAIT_V(8); PG8_WAIT_L(0); PG8_BAR; PG8_MMA(1, 0, At, B0); PG8_MMA(1, 1, At, B1); PG8_BAR; PG8_SCHED;
            } else {
            PG8_LDB(B0, 0, 0); PG8_SCHED; PG8_LDA(At, 0, 0); PG8_STAGE(PG8_SA(1, 1), a1 + hstep, voffA);
            PG8_WAIT_L(8); PG8_BAR; PG8_WAIT_L(0); PG8_MMA(0, 0, At, B0); PG8_BAR; PG8_SCHED;
            PG8_LDB(B1, 0, 1); PG8_STAGE(PG8_SB(0, 0), b2, voffB);
            PG8_BAR; PG8_WAIT_L(0); PG8_MMA(0, 1, At, B1); PG8_BAR;
            PG8_LDA(At, 0, 1); PG8_STAGE(PG8_SA(0, 0), a2, voffA);
            PG8_BAR; PG8_WAIT_L(0); PG8_MMA(1, 0, At, B0); PG8_BAR; PG8_SCHED;
            PG8_STAGE(PG8_SB(0, 1), b2 + hstep, voffB);
            PG8_WAIT_V(6); PG8_BAR; PG8_MMA(1, 1, At, B1); PG8_BAR;
            PG8_LDB(B0, 1, 0); PG8_SCHED; PG8_LDA(At, 1, 0); PG8_STAGE(PG8_SA(0, 1), a2 + hstep, voffA);
            PG8_WAIT_L(8); PG8_BAR; PG8_WAIT_L(0); PG8_MMA(0, 0, At, B0); PG8_BAR; PG8_SCHED;
            PG8_LDB(B1, 1, 1); PG8_STAGE(PG8_SB(1, 0), b3, voffB);
            PG8_BAR; PG8_WAIT_L(0); PG8_MMA(0, 1, At, B1); PG8_BAR;
            PG8_LDA(At, 1, 1); PG8_STAGE(PG8_SA(1, 0), a3, voffA);
            PG8_BAR; PG8_WAIT_L(0); PG8_MMA(1, 0, At, B0); PG8_BAR; PG8_SCHED;
            PG8_STAGE(PG8_SB(1, 1), b3 + hstep, voffB);
            PG8_WAIT_V(6); PG8_BAR; PG8_MMA(1, 1, At, B1); PG8_BAR;
            }
        }
        if constexpr (ALIGN_EPI) { if (wr == 0) PG8_BAR; }
        if constexpr (!Epi::AFTER_DRAIN) { E(acc, cur, wr, wc, fr, fq); S.done(cur); }
        if (!has_next) break;
#pragma unroll
        for (int a = 0; a < 2; ++a)
#pragma unroll
            for (int b = 0; b < 2; ++b)
#pragma unroll
                for (int m = 0; m < 4; ++m)
#pragma unroll
                    for (int n = 0; n < 2; ++n) acc[a][b][m][n] = (f32x4){0.f, 0.f, 0.f, 0.f};
        cur = nxt; cA = nA; cB = nB; ++ui;
        if constexpr (ALIGN_EPI) { if (wr == 1) PG8_BAR; }
    }
    PG8_WAIT_V(0);
    if constexpr (!ALIGN_EPI) { if (wr == 0) PG8_BAR; }
    PG8_BAR;
    if constexpr (Epi::AFTER_DRAIN) { E.fused(acc, cur, wr, wc, fr, fq, lds, wid, lane); S.done(cur); }
#undef PG8_SA
#undef PG8_SB
#undef PG8_STAGE
#undef PG8_LDA
#undef PG8_LDB
#undef PG8_MMA
#undef PG8_WAIT_V
#undef PG8_WAIT_L
#undef PG8_BAR
#undef PG8_SCHED
}
}

#ifndef PG8_SP2
#define PG8_SP2 true
#endif
#ifndef PG8_ALIGN
#define PG8_ALIGN true
#endif
namespace pg8 {
struct EpiF32 {
    static constexpr bool PERM = false, AFTER_DRAIN = false;
    float* O; int ldc;
    __device__ __forceinline__ void operator()(const f32x4 (&acc)[2][2][4][2], const Unit& u, int wr, int wc, int fr, int fq) const {
        const int row0 = u.pm * BM + wr * 64 + fr, col0 = u.pn * BM + wc * 32 + 4 * fq;
#pragma unroll
        for (int ai = 0; ai < 2; ++ai)
#pragma unroll
            for (int m = 0; m < 4; ++m) { float* rowp = O + (size_t)(row0 + ai * HALF + m * 16) * ldc + col0;
#pragma unroll
                for (int bj = 0; bj < 2; ++bj)
#pragma unroll
                    for (int n = 0; n < 2; ++n) *(f32x4*)(rowp + bj * HALF + n * 16) = acc[ai][bj][m][n]; }
    }
};
struct MoeOrder {
    const PG8_LAS int* tb; int ncol, G, c; size_t estride;
    __device__ __forceinline__ bool next(int i, Unit& u) const { const int L = i * G + c, t = L / ncol; if (t >= __builtin_amdgcn_readfirstlane(tb[16])) return false; u.pm = t; u.pn = L - t * ncol; return true; }
    __device__ __forceinline__ void a_ready(const Unit&) const {}
    __device__ __forceinline__ void done(const Unit&) const {}
    __device__ __forceinline__ size_t bofs(const Unit& u) const { int e = 0;
#pragma unroll
        for (int k = 1; k < 16; ++k) e += (u.pm >= tb[k]) ? 1 : 0;
        return (size_t)__builtin_amdgcn_readfirstlane(e) * estride; }
};
struct EpiSwiGLU {
    static constexpr bool PERM = true, AFTER_DRAIN = false;
    bf16_t* O;
    __device__ __forceinline__ void operator()(const f32x4 (&acc)[2][2][4][2], const Unit& u, int wr, int wc, int fr, int fq) const {
        const int row0 = u.pm * BM + wr * 64 + fr, col0 = u.pn * 128 + wc * 32 + 8 * fq;
#pragma unroll
        for (int ai = 0; ai < 2; ++ai)
#pragma unroll
            for (int m = 0; m < 4; ++m) { bf16_t* rowp = O + (size_t)(row0 + ai * HALF + m * 16) * 256 + col0;
                f32x4 v[2];
#pragma unroll
                for (int n = 0; n < 2; ++n)
#pragma unroll
                    for (int e = 0; e < 4; ++e) { const float gt = acc[ai][0][m][n][e]; v[n][e] = gt / (1.f + __expf(-gt)) * acc[ai][1][m][n][e]; }
                u32x4 w; w.x = cvt_pk_bf16(v[0][0], v[0][1]); w.y = cvt_pk_bf16(v[0][2], v[0][3]); w.z = cvt_pk_bf16(v[1][0], v[1][1]); w.w = cvt_pk_bf16(v[1][2], v[1][3]);
                *(u32x4*)rowp = w; }
    }
};
struct EpiLn1 {
    static constexpr bool PERM = false, AFTER_DRAIN = true;
    const float* x; float* hout; bf16_t* hb; const float* gam; const float* bet; float alpha; PanelStats st; unsigned poison;
    __device__ __forceinline__ void fused(f32x4 (&acc)[2][2][4][2], const Unit& u, int wr, int wc, int fr, int fq, PG8_LAS unsigned char* lds, int wid, int lane) const {
        typedef float f32x2v __attribute__((ext_vector_type(2))); typedef unsigned u32x2v __attribute__((ext_vector_type(2)));
        const PG8_LAS f32x2v* S = (const PG8_LAS f32x2v*)(lds + 8192);
        const int col0 = u.pn * BM + wc * 32 + 4 * fq, ldc = 1024;
#pragma unroll
        for (int ai = 0; ai < 2; ++ai)
#pragma unroll
            for (int m = 0; m < 4; ++m) { const size_t off = (size_t)(u.pm * BM + ai * HALF + wr * 64 + m * 16 + fr) * ldc + col0;
#pragma unroll
                for (int bj = 0; bj < 2; ++bj)
#pragma unroll
                    for (int n = 0; n < 2; ++n) { const f32x4 xv = *(const f32x4*)(x + off + bj * HALF + n * 16); acc[ai][bj][m][n] = xv * alpha + acc[ai][bj][m][n]; }
                asm volatile("" : "+v"(acc[ai][0][m][0]), "+v"(acc[ai][0][m][1]), "+v"(acc[ai][1][m][0]), "+v"(acc[ai][1][m][1]));
                if (m & 1) asm volatile("" ::: "memory"); }
        const bool bad = st.run(acc, u, wr, wc, fr, fq, lds, wid, lane) || poison != 0u;
        const float qnan = __builtin_nanf("");
        f32x4 gv[2][2], bv[2][2];
#pragma unroll
        for (int bj = 0; bj < 2; ++bj)
#pragma unroll
            for (int n = 0; n < 2; ++n) { gv[bj][n] = *(const f32x4*)(gam + col0 + bj * HALF + n * 16); bv[bj][n] = *(const f32x4*)(bet + col0 + bj * HALF + n * 16); }
#pragma unroll
        for (int ai = 0; ai < 2; ++ai)
#pragma unroll
            for (int m = 0; m < 4; ++m) { const int r = ai * HALF + wr * 64 + m * 16 + fr; const f32x2v sr = S[r]; const size_t off = (size_t)(u.pm * BM + r) * ldc + col0;
#pragma unroll
                for (int bj = 0; bj < 2; ++bj)
#pragma unroll
                    for (int n = 0; n < 2; ++n) { f32x4 o = (acc[ai][bj][m][n] - sr.x) * sr.y * gv[bj][n] + bv[bj][n];
                        if (bad) o = (f32x4){qnan, qnan, qnan, qnan};
                        *(f32x4*)(hout + off + bj * HALF + n * 16) = o;
                        u32x2v w; w.x = cvt_pk_bf16(o[0], o[1]); w.y = cvt_pk_bf16(o[2], o[3]); *(u32x2v*)(hb + off + bj * HALF + n * 16) = w; }
                asm volatile("" ::: "memory"); }
    }
};
}
#define GAS __attribute__((address_space(1)))
#define LAS __attribute__((address_space(3)))
typedef unsigned short bf16;
typedef unsigned v4u __attribute__((ext_vector_type(4)));
typedef float f32x4 __attribute__((ext_vector_type(4)));
typedef short bf16x8 __attribute__((ext_vector_type(8)));
typedef GAS unsigned gu32;
typedef GAS unsigned long long gu64;
#define RLX_AGENT __ATOMIC_RELAXED, __HIP_MEMORY_SCOPE_AGENT
#define LDS_WAIT() asm volatile("s_waitcnt lgkmcnt(0)" ::: "memory")
#define VM_WAIT() asm volatile("s_waitcnt vmcnt(0)" ::: "memory")
__device__ __forceinline__ unsigned long long rt() { return __builtin_amdgcn_s_memrealtime(); }
__device__ __forceinline__ unsigned f2bf(float f) { unsigned u = __builtin_bit_cast(unsigned, f); return (u + 0x7fffu + ((u >> 16) & 1u)) >> 16; }
__device__ __forceinline__ unsigned pk2(float lo, float hi) { return f2bf(lo) | (f2bf(hi) << 16); }

#define XB_TMO      128
#define XB_XCNT(j)  (256  + 64 * (j))
#define XB_XSUB(j)  (1280 + 64 * (j))
#define XB_XGEN(j)  (2304 + 64 * (j))
#define XB_TOP      3328
#define XB_TOPGEN   3392
#define XCD_BAR_WORDS 3456
#define XB_SPIN_CAP (1u << 18)

__device__ __forceinline__ unsigned xb_ld(unsigned* p)              { return __hip_atomic_load(p, __ATOMIC_RELAXED, __HIP_MEMORY_SCOPE_AGENT); }
__device__ __forceinline__ unsigned xb_add(unsigned* p, unsigned v) { return __hip_atomic_fetch_add(p, v, __ATOMIC_RELAXED, __HIP_MEMORY_SCOPE_AGENT); }
__device__ __forceinline__ unsigned xb_xcc_id() { return (unsigned)__builtin_amdgcn_s_getreg((3 << 11) | 20) & 0xFu; }
#define XB_SPIN(cond, bar) do { unsigned _sp = 0; while (cond) { __builtin_amdgcn_s_sleep(1); \
    if ((++_sp & 255u) == 0u) { if (xb_ld(&(bar)[XB_TMO])) break; if (_sp > XB_SPIN_CAP) { atomicAdd(&(bar)[XB_TMO], 1u); break; } } } } while (0)

struct XcdBarrier {
    unsigned* bar; unsigned x;
    volatile LAS unsigned* st;
};

__device__ __forceinline__ XcdBarrier xcd_barrier_post(unsigned* bar, volatile LAS unsigned* st) {
    XcdBarrier b; b.bar = bar; b.x = xb_xcc_id(); b.st = st;
    if (threadIdx.x == 0) (void)xb_add(&bar[XB_XCNT(b.x)], 1u);
    return b;
}
__device__ __forceinline__ void xcd_barrier_complete(unsigned* bar, unsigned x, unsigned& nloc, unsigned& nx) {
    const unsigned G = gridDim.x * gridDim.y * gridDim.z;
    unsigned sum, cnt, mine, sp = 0u;
    for (;;) {
        sum = 0u; cnt = 0u; mine = 0u;
#pragma unroll
        for (unsigned j = 0; j < 16; ++j) { const unsigned c = xb_ld(&bar[XB_XCNT(j)]); sum += c; cnt += (c > 0u) ? 1u : 0u; mine = (j == x) ? c : mine; }
        if (sum == G) break;
        __builtin_amdgcn_s_sleep(1);
        if ((++sp & 255u) == 0u) { if (xb_ld(&bar[XB_TMO])) break; if (sp > XB_SPIN_CAP) { atomicAdd(&bar[XB_TMO], 1u); break; } }
    }
    nloc = mine > 0u ? mine : 1u; nx = cnt > 0u ? cnt : 1u;
}

__device__ __forceinline__ void xcd_barrier(const XcdBarrier& b) {
    asm volatile("s_waitcnt vmcnt(0)" ::: "memory");
    __syncthreads();
    if (threadIdx.x == 0) {
        unsigned* bar = b.bar;
        __builtin_amdgcn_s_waitcnt(0);
        unsigned nloc = b.st[0], nx = b.st[1];
        if (nloc == 0u) { xcd_barrier_complete(bar, b.x, nloc, nx); b.st[0] = nloc; b.st[1] = nx; }
        const unsigned old = xb_add(&bar[XB_XSUB(b.x)], 1u);
        const unsigned gen = old / nloc;
        if (old + 1u == (gen + 1u) * nloc) {
            __builtin_amdgcn_fence(__ATOMIC_RELEASE, "agent");
            asm volatile("s_waitcnt vmcnt(0)" ::: "memory");
            const unsigned og = xb_add(&bar[XB_TOP], 1u);
            const unsigned tg = og / nx;
            if (og + 1u == (tg + 1u) * nx) xb_add(&bar[XB_TOPGEN], 1u);
            else XB_SPIN(xb_ld(&bar[XB_TOPGEN]) == tg, bar);
            __builtin_amdgcn_fence(__ATOMIC_ACQUIRE, "agent");
            xb_add(&bar[XB_XGEN(b.x)], 1u);
            asm volatile("s_waitcnt vmcnt(0)" ::: "memory");
        } else {
            XB_SPIN(xb_ld(&bar[XB_XGEN(b.x)]) == gen, bar);
            __builtin_amdgcn_fence(__ATOMIC_ACQUIRE, "agent");
            asm volatile("s_waitcnt vmcnt(0)" ::: "memory");
        }
    }
    __syncthreads();
}
namespace mb {
constexpr int D = 128, PITCH = 512, OPITCH = 1024;
constexpr float THR = 8.f;
constexpr bool WSKIP = false;
constexpr int KM_OFF = 69632;
constexpr float SCALE = 0.08838834764831845f;
constexpr int NW = 8, QBLK = 32, KVBLK = 64, QB = NW * QBLK;
constexpr int SHM_V = KVBLK * D * 2, SHM_K = KVBLK * D * 2;
constexpr int LDS_BYTES = 2 * SHM_V + 2 * SHM_K + NW * 64 * 4;

typedef short bf16x8 __attribute__((ext_vector_type(8)));
typedef short s16x4 __attribute__((ext_vector_type(4)));
typedef float f32x16 __attribute__((ext_vector_type(16)));
typedef float f32x4 __attribute__((ext_vector_type(4)));
typedef unsigned u32x4 __attribute__((ext_vector_type(4)));
template <class A, class Bt> struct same_t { static constexpr bool v = false; };
template <class A> struct same_t<A, A> { static constexpr bool v = true; };

typedef const GAS char* gcptr;
__device__ __forceinline__ gcptr uni(const void* p) {
    const unsigned long long u = (unsigned long long)p;
    const unsigned lo = __builtin_amdgcn_readfirstlane((unsigned)u), hi = __builtin_amdgcn_readfirstlane((unsigned)(u >> 32));
    return (gcptr)(((unsigned long long)hi << 32) | lo);
}
#define KSWZ(row, colB) ((row) * 256 + ((colB) ^ (((row) & 7) << 4)))
#define SBAR() __builtin_amdgcn_sched_barrier(0)
__device__ __forceinline__ int v_st(int k, int c) { const int kk = (k & ~0xC) | ((k & 4) << 1) | ((k & 8) >> 1); return ((kk >> 3) * 4 + (c >> 5)) * 512 + ((kk & 7) * 32 + (c & 31)) * 2; }
__device__ __forceinline__ int v_rd_base(int lane) { return ((lane & 3) << 3) | (((lane >> 2) & 3) << 6) | (((lane >> 4) & 1) << 5) | (((lane >> 5) & 1) << 8); }
constexpr int v_rd_off(int d0, int ks, int half) { return d0 * 512 + ks * 4096 + half * 2048; }
__device__ __forceinline__ int crow(int r, int hi) { return (r & 3) + 8 * (r >> 2) + 4 * hi; }
__device__ __forceinline__ unsigned cvtpk(float lo, float hi) {
    unsigned r; asm volatile("v_cvt_pk_bf16_f32 %0, %1, %2" : "=v"(r) : "v"(lo), "v"(hi)); return r;
}
__device__ __forceinline__ bf16x8 pack8(f32x4 a, f32x4 b) {
    u32x4 w = {cvtpk(a[0], a[1]), cvtpk(a[2], a[3]), cvtpk(b[0], b[1]), cvtpk(b[2], b[3])};
    return *reinterpret_cast<bf16x8*>(&w);
}
template <class T> __device__ __forceinline__ bf16x8 load8(const T* p) {
    if constexpr (same_t<T, float>::v) { return pack8(*(const f32x4*)p, *(const f32x4*)(p + 4)); }
    else { return *reinterpret_cast<const bf16x8*>(p); }
}
__device__ __forceinline__ void mask_tile(f32x16& p0, f32x16& p1, int dq, unsigned W) {
    const float NEG = -__builtin_inff();
#pragma unroll
    for (int r = 0; r < 16; ++r) {
        const int c = (r & 3) + 8 * (r >> 2);
        if ((unsigned)(dq - c) >= W) p0[r] = NEG;
        if ((unsigned)(dq - c - 32) >= W) p1[r] = NEG;
    }
}
__device__ __forceinline__ void partialSM(f32x16& p0, f32x16& p1, float& m_reg, float& mn, float& alpha) {
    float pmax = p0[0]; for (int r = 1; r < 16; ++r) pmax = fmaxf(pmax, p0[r]); for (int r = 0; r < 16; ++r) pmax = fmaxf(pmax, p1[r]);
    { auto rr = __builtin_amdgcn_permlane32_swap(__float_as_uint(pmax), __float_as_uint(pmax), false, false);
      pmax = fmaxf(__uint_as_float(rr[0]), __uint_as_float(rr[1])); }
    constexpr float C2 = 1.4426950408889634f * SCALE;
    if (__builtin_expect(__all((pmax - m_reg) * SCALE <= THR), 1)) { mn = m_reg; alpha = 1.f; }
    else { mn = fmaxf(m_reg, pmax); alpha = __builtin_amdgcn_exp2f((m_reg - mn) * C2); m_reg = mn; }
    const float mnL = -mn * C2;
    for (int r = 0; r < 16; ++r) p0[r] = fmaf(p0[r], C2, mnL); for (int r = 0; r < 16; ++r) p1[r] = fmaf(p1[r], C2, mnL);
    for (int r = 0; r < 16; ++r) p0[r] = __builtin_amdgcn_exp2f(p0[r]);
}
__device__ __forceinline__ void finishSM(f32x16& p0, f32x16& p1, float alpha, float& l_reg, bf16x8& pa0, bf16x8& pa1, bf16x8& pa2, bf16x8& pa3) {
    for (int r = 0; r < 16; ++r) p1[r] = __builtin_amdgcn_exp2f(p1[r]);
    float ps = 0; for (int r = 0; r < 16; ++r) ps += p0[r]; for (int r = 0; r < 16; ++r) ps += p1[r];
    { auto rr = __builtin_amdgcn_permlane32_swap(__float_as_uint(ps), __float_as_uint(ps), false, false);
      ps = __uint_as_float(rr[0]) + __uint_as_float(rr[1]); }
    l_reg = l_reg * alpha + ps;
#define PK4(P, B_, OUT) do { unsigned a0 = cvtpk(P[B_+0], P[B_+1]), a1 = cvtpk(P[B_+2], P[B_+3]);                          \
        unsigned b0 = cvtpk(P[B_+4], P[B_+5]), b1 = cvtpk(P[B_+6], P[B_+7]);                                             \
        auto r0 = __builtin_amdgcn_permlane32_swap(a0, b0, false, false); auto r1 = __builtin_amdgcn_permlane32_swap(a1, b1, false, false); \
        u32x4 w = {r0[0], r1[0], r0[1], r1[1]}; OUT = *reinterpret_cast<bf16x8*>(&w); } while (0)
    PK4(p0, 0, pa0); PK4(p0, 8, pa1); PK4(p1, 0, pa2); PK4(p1, 8, pa3);
#undef PK4
}
template <int KB, bool SK>
__device__ __forceinline__ void qkt(f32x16& p0, f32x16& p1, const char* K_lds, int r32, int hi, const bf16x8* qr, bool act) {
    if (SK && !act) { const float NEG = -__builtin_inff();
#pragma unroll
        for (int r = 0; r < 16; ++r) { p0[r] = NEG; p1[r] = NEG; } return; }
    p0 = f32x16{}; p1 = f32x16{};
    const char* kb[4];
#pragma unroll
    for (int dd = 0; dd < 4; ++dd) kb[dd] = K_lds + KB * SHM_K + KSWZ(r32, (dd * 16 + hi * 8) * 2);
#pragma unroll
    for (int d0 = 0; d0 < 8; ++d0) { const char* a = kb[d0 & 3] + (d0 >> 2) * 128;
        bf16x8 b0 = *reinterpret_cast<const bf16x8*>(a);
        bf16x8 b1 = *reinterpret_cast<const bf16x8*>(a + 32 * 256);
        p0 = __builtin_amdgcn_mfma_f32_32x32x16_bf16(b0, qr[d0], p0, 0, 0, 0);
        p1 = __builtin_amdgcn_mfma_f32_32x32x16_bf16(b1, qr[d0], p1, 0, 0, 0); }
}
template <int VB, bool SK>
__device__ __forceinline__ void pv_tile(f32x16* o, int vb0, bf16x8 pa0, bf16x8 pa1, bf16x8 pa2, bf16x8 pa3, bool act) {
    if (SK && !act) return;
#define TRRD(dst, off) asm volatile("ds_read_b64_tr_b16 %0, %1 offset:%2" : "=&v"(dst) : "v"(vb0), "i"(off) : "memory")
#define PV_D0(d0) do { s16x4 l0, l1, l2, l3, h0, h1, h2, h3; constexpr int b_ = VB * SHM_V + v_rd_off(d0, 0, 0);     \
        TRRD(l0, b_); TRRD(h0, b_ + 2048); TRRD(l1, b_ + 4096); TRRD(h1, b_ + 6144); TRRD(l2, b_ + 8192); TRRD(h2, b_ + 10240); TRRD(l3, b_ + 12288); TRRD(h3, b_ + 14336); \
        asm volatile("s_waitcnt lgkmcnt(0)" ::: "memory"); SBAR();                 \
        o[d0] = __builtin_amdgcn_mfma_f32_32x32x16_bf16(pa0, (bf16x8){l0[0], l0[1], l0[2], l0[3], h0[0], h0[1], h0[2], h0[3]}, o[d0], 0, 0, 0);   \
        o[d0] = __builtin_amdgcn_mfma_f32_32x32x16_bf16(pa1, (bf16x8){l1[0], l1[1], l1[2], l1[3], h1[0], h1[1], h1[2], h1[3]}, o[d0], 0, 0, 0);   \
        o[d0] = __builtin_amdgcn_mfma_f32_32x32x16_bf16(pa2, (bf16x8){l2[0], l2[1], l2[2], l2[3], h2[0], h2[1], h2[2], h2[3]}, o[d0], 0, 0, 0);   \
        o[d0] = __builtin_amdgcn_mfma_f32_32x32x16_bf16(pa3, (bf16x8){l3[0], l3[1], l3[2], l3[3], h3[0], h3[1], h3[2], h3[3]}, o[d0], 0, 0, 0); } while (0)
    PV_D0(0); PV_D0(1); PV_D0(2); PV_D0(3);
#undef PV_D0
#undef TRRD
}

template <class TIn, class TOut> struct BlockRef { const TIn* Q; const TIn* K; const TIn* V; TOut* O; const float* KM; int P0; int t_lo, t_hi; TOut* OP; float* LSE; };
template <class TIn> struct Seam {
    bf16x8 qr[8];
    bf16x8 st_v0, st_v1, st_k0, st_k1; f32x4 sf0, sf1, sf2, sf3;
    f32x4 tq[16];
};
__device__ __forceinline__ int swa_jlo(int P0, int W) { const int lowk = P0 - W + 1; return lowk > 0 ? lowk / KVBLK : 0; }
#define ROW(p, k0, rr) ((p) + (size_t)((k0) + (rr)) * PITCH + sc)
#define VMW() asm volatile("s_waitcnt vmcnt(0)" ::: "memory")
#define VMWN(n) asm volatile("s_waitcnt vmcnt(%0)" :: "i"(n) : "memory")
#define LD16U(base, boff) (*(const GAS bf16x8*)(uni((const char*)(base) + (size_t)(boff)) + voff))
#define SLOAD_H(Kp, Vp, k0) do { S.st_v0 = LD16U(Vp, (size_t)(k0) * (PITCH * 2)); S.st_v1 = LD16U(Vp, (size_t)((k0) + 32) * (PITCH * 2));              \
                         S.st_k0 = LD16U(Kp, (size_t)(k0) * (PITCH * 2)); S.st_k1 = LD16U(Kp, (size_t)((k0) + 32) * (PITCH * 2)); } while (0)
#define SWRITE_HK(bf) do { *(bf16x8*)(K_lds + (bf) * SHM_K + kws) = S.st_k0; *(bf16x8*)(K_lds + (bf) * SHM_K + kws + 32 * 256) = S.st_k1; } while (0)
#define SWRITE_HV(bf) do { *(bf16x8*)(V_lds + (bf) * SHM_V + vst0) = S.st_v0; *(bf16x8*)(V_lds + (bf) * SHM_V + vst1) = S.st_v1; } while (0)
#define SWRITE_H(bf) do { SWRITE_HV(bf); SWRITE_HK(bf); } while (0)
#define SLOAD_F(p, k0) do { S.sf0 = *(const f32x4*)ROW(p, k0, sr); S.sf1 = *(const f32x4*)(ROW(p, k0, sr) + 4);                \
                            S.sf2 = *(const f32x4*)ROW(p, k0, 32 + sr); S.sf3 = *(const f32x4*)(ROW(p, k0, 32 + sr) + 4); } while (0)
#define SWRITE_KF(bf) do { *(bf16x8*)(K_lds + (bf) * SHM_K + kws) = pack8(S.sf0, S.sf1); *(bf16x8*)(K_lds + (bf) * SHM_K + kws + 32 * 256) = pack8(S.sf2, S.sf3); } while (0)
#define SWRITE_VF(bf) do { *(bf16x8*)(V_lds + (bf) * SHM_V + vst0) = pack8(S.sf0, S.sf1); *(bf16x8*)(V_lds + (bf) * SHM_V + vst1) = pack8(S.sf2, S.sf3); } while (0)
template <class TIn, class TOut>
__device__ __forceinline__ void causal_swa_prime(const BlockRef<TIn, TOut>& cur, int W, char* lds, Seam<TIn>& S) {
    constexpr bool F32 = same_t<TIn, float>::v;
    int tid = threadIdx.x; asm volatile("" : "+v"(tid));
    const int wid = __builtin_amdgcn_readfirstlane(tid >> 6), lane = tid & 63, r32 = lane & 31, hi = lane >> 5;
    const int sr = tid >> 4, sc = (tid & 15) * 8, kws = KSWZ(sr, sc * 2); char* K_lds = lds + 2 * SHM_V;
    const unsigned voff = (unsigned)(sr * PITCH + sc) * 2u, qoff = (unsigned)((wid * QBLK + r32) * PITCH + hi * 8) * 2u;
    const int kb0 = cur.t_lo * KVBLK;
    for (int d0 = 0; d0 < 8; ++d0) S.qr[d0] = *(const GAS bf16x8*)(uni((const char*)cur.Q + d0 * 32) + qoff);
    if constexpr (F32) { SLOAD_F((const float*)cur.K, kb0); VMW(); SWRITE_KF(0); SBAR(); SLOAD_F((const float*)cur.V, kb0); }
    else { SLOAD_H(cur.K, cur.V, kb0); VMW(); SWRITE_HK(0); }
    __syncthreads();
}
template <class TIn, class TOut>
__device__ __forceinline__ void causal_swa_block(const BlockRef<TIn, TOut>& cur, const BlockRef<TIn, TOut>& nxt, int skv, int W, char* lds, Seam<TIn>& S) {
    constexpr bool F32 = same_t<TIn, float>::v;
    int tid = threadIdx.x; asm volatile("" : "+v"(tid));
    const int wid = __builtin_amdgcn_readfirstlane(tid >> 6), lane = tid & 63, r32 = lane & 31, hi = lane >> 5;
    const int j_lo = cur.t_lo, j_hi = cur.t_hi;
    const int NT = j_hi - j_lo;
    const int kbn = nxt.t_lo * KVBLK;
    const int qlo = cur.P0 + wid * QBLK, qm = qlo + r32 - 4 * hi;
    char* V_lds = lds; char* K_lds = lds + 2 * SHM_V;
    float* ws = (float*)(lds + 2 * SHM_V + 2 * SHM_K) + wid * 64; float* li_l = ws, * al_l = ws + 32;
    float m_reg = -1e30f, l_reg = 0; f32x16 o[4] = {};
    const int sr = tid >> 4, sc = (tid & 15) * 8, vst0 = v_st(sr, sc), vst1 = v_st(32 + sr, sc), kws = KSWZ(sr, sc * 2);
    const unsigned voff = (unsigned)(sr * PITCH + sc) * 2u, qoff = (unsigned)((wid * QBLK + r32) * PITCH + hi * 8) * 2u;
    const int vb0 = (int)(uintptr_t)V_lds + v_rd_base(lane);
    const TIn* Kh = cur.K; const TIn* Vh = cur.V;
    const int own = cur.P0 / QB, own4 = cur.P0 / KVBLK;
    unsigned sel = 0u;
    {
        float* km = (float*)(lds + KM_OFF);
        for (int i = tid; i < 16 * 128; i += 64 * NW) { const GAS float* p = (const GAS float*)(uni(cur.KM) + (unsigned)(((i >> 7) * 512 + (i & 127)) * 4)); km[i] = (p[0] + p[128]) + (p[256] + p[384]); }
        __syncthreads();
        float best[3] = {-3e38f, -3e38f, -3e38f}; int bidx[3] = {0, 0, 0};
#pragma unroll 1
        for (int j = 0; j < own; ++j) {
            float a = 0.f;
#pragma unroll
            for (int d0 = 0; d0 < 8; ++d0) {
                const f32x4 k0 = *(const f32x4*)(km + j * 128 + d0 * 16 + hi * 8), k1 = *(const f32x4*)(km + j * 128 + d0 * 16 + hi * 8 + 4);
                const u32x4 qw = *reinterpret_cast<const u32x4*>(&S.qr[d0]);
                a += __uint_as_float(qw[0] << 16) * k0[0] + __uint_as_float(qw[0] & 0xffff0000u) * k0[1] + __uint_as_float(qw[1] << 16) * k0[2] + __uint_as_float(qw[1] & 0xffff0000u) * k0[3]
                   + __uint_as_float(qw[2] << 16) * k1[0] + __uint_as_float(qw[2] & 0xffff0000u) * k1[1] + __uint_as_float(qw[3] << 16) * k1[2] + __uint_as_float(qw[3] & 0xffff0000u) * k1[3];
            }
            a += __shfl_xor(a, 32);
            if (a > best[0]) { best[2] = best[1]; bidx[2] = bidx[1]; best[1] = best[0]; bidx[1] = bidx[0]; best[0] = a; bidx[0] = j; }
            else if (a > best[1]) { best[2] = best[1]; bidx[2] = bidx[1]; best[1] = a; bidx[1] = j; }
            else if (a > best[2]) { best[2] = a; bidx[2] = j; }
        }
#pragma unroll
        for (int r = 0; r < 3; ++r) if (best[r] > -1e37f) sel |= 1u << bidx[r];
    }
#define RESC(a) do { if (__any((a) < 1.f)) { if (hi == 0) al_l[r32] = (a); asm volatile("s_waitcnt lgkmcnt(0)" ::: "memory");              \
                     for (int d_ = 0; d_ < 4; ++d_) for (int r = 0; r < 16; ++r) o[d_][r] *= al_l[crow(r, hi)]; } } while (0)
#define KBASE(t) ((j_lo + (t)) * KVBLK)
#define ACT(t) (KBASE(t) <= qlo + QBLK - 1 && KBASE(t) + KVBLK - 1 >= qlo - W + 1)
#define MASKT(P0_, P1_, t) do { const int kb_ = KBASE(t), gt_ = j_lo + (t); if (gt_ >= own4) { if (kb_ + KVBLK - 1 > qlo) mask_tile(P0_, P1_, qm - kb_, 0x3fffffffu); } else if (!((sel >> (gt_ >> 2)) & 1u)) { const float NEG_ = -__builtin_inff(); _Pragma("unroll") for (int r_ = 0; r_ < 16; ++r_) { P0_[r_] = NEG_; P1_[r_] = NEG_; } } } while (0)
    constexpr int NQL = F32 ? 16 : 8;
    constexpr bool SK = WSKIP && !F32;
#define SEAM_K0() do { VMWN(NQL); if constexpr (F32) { SWRITE_KF(0); SBAR(); SLOAD_F((const float*)nxt.V, kbn); } else { SWRITE_HK(0); } SBAR(); } while (0)
    f32x16 pA0, pA1, pB0, pB1; float mnA, mnB, alA, alB; bf16x8 pa0, pa1, pa2, pa3;
    if constexpr (F32) { VMW(); SWRITE_VF(0); SBAR(); } else { SWRITE_HV(0); SBAR(); }
    if (NT > 1) { if constexpr (F32) SLOAD_F((const float*)Kh, KBASE(1)); else SLOAD_H(Kh, Vh, KBASE(1)); }
    SBAR(); qkt<0, SK>(pA0, pA1, K_lds, r32, hi, S.qr, ACT(0));
    if constexpr (F32) { if (NT > 1) { VMW(); SWRITE_KF(1); SBAR(); SLOAD_F((const float*)Vh, KBASE(1)); } }
    MASKT(pA0, pA1, 0); partialSM(pA0, pA1, m_reg, mnA, alA);
    if (NT > 1) { VMW(); if constexpr (F32) { SWRITE_VF(1); SBAR(); if (NT > 2) SLOAD_F((const float*)Kh, KBASE(2)); } else SWRITE_H(1); }
    __syncthreads();
#define HALF_STEP(PX0, PX1, mnX, alX, PY0, PY1, alY, t, KB, VB, SB) do {                                                      \
        SBAR(); qkt<KB, SK>(PX0, PX1, K_lds, r32, hi, S.qr, ACT(t));                                             \
        finishSM(PY0, PY1, alY, l_reg, pa0, pa1, pa2, pa3); SBAR();                                                           \
        if ((t) + 1 < NT) { if constexpr (F32) { VMW(); SWRITE_KF(SB); SBAR(); SLOAD_F((const float*)Vh, KBASE((t) + 1)); }  \
                            else { SLOAD_H(Kh, Vh, KBASE((t) + 1)); } SBAR(); }                                               \
        pv_tile<VB, SK>(o, vb0, pa0, pa1, pa2, pa3, ACT((t) - 1)); MASKT(PX0, PX1, (t)); partialSM(PX0, PX1, m_reg, mnX, alX);                                        \
        __syncthreads();                                                                                                      \
        if ((t) + 1 < NT) { VMW(); if constexpr (F32) { SWRITE_VF(SB); SBAR(); if ((t) + 2 < NT) SLOAD_F((const float*)Kh, KBASE((t) + 2)); } \
                            else { SWRITE_H(SB); } }                                                                          \
        RESC(alX); __syncthreads(); } while (0)
    for (int t = 1; t + 1 < NT; t += 2) {
        HALF_STEP(pB0, pB1, mnB, alB, pA0, pA1, alA, t, 1, 0, 0);
        HALF_STEP(pA0, pA1, mnA, alA, pB0, pB1, alB, t + 1, 0, 1, 1);
    }
    const bool even = (NT & 1) == 0;
    if (even) { SBAR(); qkt<1, SK>(pB0, pB1, K_lds, r32, hi, S.qr, ACT(NT - 1)); SBAR(); }
#define QROW(e) (nxt.Q + (size_t)(wid * QBLK + r32) * PITCH + ((e) >> 1) * 16 + hi * 8 + ((e) & 1) * 4)
    if constexpr (F32) { SLOAD_F((const float*)nxt.K, kbn); SBAR();
#pragma unroll
        for (int e = 0; e < 8; ++e) S.tq[e] = *(const f32x4*)QROW(e); }
    else { SLOAD_H(nxt.K, nxt.V, kbn); SBAR();
#pragma unroll
        for (int d0 = 0; d0 < 8; ++d0) S.qr[d0] = *(const GAS bf16x8*)(uni((const char*)nxt.Q + d0 * 32) + qoff); }
    SBAR();
    finishSM(pA0, pA1, alA, l_reg, pa0, pa1, pa2, pa3); SBAR();
    if constexpr (F32) {
#pragma unroll
        for (int e = 8; e < 16; ++e) S.tq[e] = *(const f32x4*)QROW(e); SBAR(); }
#undef QROW
    pv_tile<0, SK>(o, vb0, pa0, pa1, pa2, pa3, ACT(even ? NT - 2 : NT - 1));
    if (even) { MASKT(pB0, pB1, NT - 1); partialSM(pB0, pB1, m_reg, mnB, alB); __syncthreads(); RESC(alB);
        finishSM(pB0, pB1, alB, l_reg, pa0, pa1, pa2, pa3); SBAR(); pv_tile<1, SK>(o, vb0, pa0, pa1, pa2, pa3, ACT(NT - 1)); }
    SBAR(); SEAM_K0();
    if (hi == 0) li_l[r32] = l_reg; asm volatile("s_waitcnt lgkmcnt(0)" ::: "memory");
    float rli[16];
#pragma unroll
    for (int r = 0; r < 16; ++r) { const float li_ = li_l[crow(r, hi)]; rli[r] = li_ > 0.f ? __builtin_amdgcn_rcpf(li_) : 0.f; }
    if (cur.OP) {
        if (hi == 0) cur.LSE[wid * QBLK + r32] = l_reg > 0.f ? m_reg * (1.4426950408889634f * SCALE) + __builtin_amdgcn_logf(l_reg) : -__builtin_inff();
        GAS char* Ow = (GAS char*)uni(cur.OP + (size_t)(wid * QBLK) * 128);
        unsigned obase = (unsigned)((4 * hi * 128 + r32) * 2); asm volatile("" : "+v"(obase));
#pragma unroll
        for (int r = 0; r < 16; ++r) {
#pragma unroll
            for (int d0 = 0; d0 < 4; ++d0) { const float v = o[d0][r] * rli[r];
                const float vn = __shfl_xor(v, 1);
                if ((r32 & 1) == 0) *(GAS unsigned*)(Ow + (obase + (unsigned)((((r & 3) + 8 * (r >> 2)) * 128 + d0 * 32) * 2))) = cvtpk(v, vn); } }
    } else {
        GAS char* Ow = (GAS char*)uni(cur.O + (size_t)(wid * QBLK) * OPITCH);
        unsigned obase = (unsigned)((4 * hi * OPITCH + r32) * 2); asm volatile("" : "+v"(obase));
#pragma unroll
        for (int r = 0; r < 16; ++r) {
#pragma unroll
            for (int d0 = 0; d0 < 4; ++d0) { const float v = o[d0][r] * rli[r];
                const float vn = __shfl_xor(v, 1);
                if ((r32 & 1) == 0) *(GAS unsigned*)(Ow + (obase + (unsigned)((((r & 3) + 8 * (r >> 2)) * OPITCH + d0 * 32) * 2))) = cvtpk(v, vn); } }
    }
    if constexpr (F32) {
#pragma unroll
        for (int d0 = 0; d0 < 8; ++d0) S.qr[d0] = pack8(S.tq[2 * d0], S.tq[2 * d0 + 1]); }
    __syncthreads();
#undef RESC
#undef KBASE
#undef ACT
#undef MASKT
#undef SEAM_K0
#undef HALF_STEP
}
#undef ROW
#undef VMW
#undef VMWN
#undef SLOAD_H
#undef LD16U
#undef SWRITE_HK
#undef SWRITE_HV
#undef SWRITE_H
#undef SLOAD_F
#undef SWRITE_KF
#undef SWRITE_VF
}
namespace dn {
typedef short bf16x8 __attribute__((ext_vector_type(8)));
typedef float f32x16 __attribute__((ext_vector_type(16)));
typedef float f32x4 __attribute__((ext_vector_type(4)));
typedef unsigned u32x4 __attribute__((ext_vector_type(4)));
typedef unsigned u32x2 __attribute__((ext_vector_type(2)));
#define DNI __device__ __forceinline__
#define DN_MFMA(a, b, c) __builtin_amdgcn_mfma_f32_32x32x16_bf16((a), (b), (c), 0, 0, 0)
constexpr int LQ = 136, LT = 72;
constexpr int BLOB_FRAGS = 56, BLOB_BYTES = BLOB_FRAGS * 1024, UF_BYTES = 16384;
constexpr int L_QS = 0, L_KS = 17408, L_KST = 34816, L_VST = 53248, L_AF = 71680, L_ABF = 89088, L_TRM = 98304, L_TW = 107520, L_TU = 116736,
              L_T00T = 125952, L_GATE = 128512, L_CONVW = 129536, L_END = 135680;
DNI int crow(int i, int h) { return (i & 3) + 8 * (i >> 2) + 4 * h; }
DNI unsigned cvtpk2(float lo, float hi) {
    typedef float f2_t __attribute__((ext_vector_type(2))); typedef __bf16 b2_t __attribute__((ext_vector_type(2)));
    f2_t v = {lo, hi}; b2_t b = __builtin_convertvector(v, b2_t); return __builtin_bit_cast(unsigned, b);
}
template <int SS> DNI bf16x8 pack_acc(const f32x16& x) {
    u32x4 p = {cvtpk2(x[8 * SS], x[8 * SS + 1]), cvtpk2(x[8 * SS + 2], x[8 * SS + 3]), cvtpk2(x[8 * SS + 4], x[8 * SS + 5]), cvtpk2(x[8 * SS + 6], x[8 * SS + 7])};
    return __builtin_bit_cast(bf16x8, p);
}
DNI bf16x8 lds16(const LAS unsigned char* p) { return *(const LAS bf16x8*)p; }
DNI bf16x8 lds_perm8(const LAS unsigned char* rowp, int colbase, int h) {
    const u32x2 a = *(const LAS u32x2*)(rowp + (colbase + 4 * h) * 2), b = *(const LAS u32x2*)(rowp + (colbase + 8 + 4 * h) * 2);
    u32x4 p = {a.x, a.y, b.x, b.y}; return __builtin_bit_cast(bf16x8, p);
}
DNI float bflo_(unsigned w) { return __uint_as_float(w << 16); }
DNI float bfhi_(unsigned w) { return __uint_as_float(w & 0xffff0000u); }

DNI void chunk_local(LAS unsigned char* lds, int item, const bf16* PJ, size_t pj_stride, const float* GATES, const float* conv_w, const float* a_log, const float* dt_bias,
                     unsigned char* BLOB, unsigned char* UF, float* GL) {
    int tid = threadIdx.x; asm volatile("" : "+v"(tid));
    const int wid = __builtin_amdgcn_readfirstlane(tid >> 6), lane = tid & 63, r = lane & 31, h2 = lane >> 5;
    const int n = item & 63, hd = (item >> 6) & 3, b = item >> 8;
    const size_t row0 = (size_t)b * 4096 + (size_t)n * 64;
    LAS float* gate = (LAS float*)(lds + L_GATE);
    LAS float* convw = (LAS float*)(lds + L_CONVW);
    unsigned char* blob = BLOB + (size_t)item * BLOB_BYTES;
    for (int i = tid; i < 4 * 384; i += 512) { const int j = i / 384, c = i % 384; convw[i] = conv_w[j * 1536 + (c >> 7) * 512 + hd * 128 + (c & 127)]; }
    if (wid == 0) {
        const size_t m = row0 + lane;
        const float braw = GATES[m * 8 + hd], araw = GATES[m * 8 + 4 + hd];
        const float beta = 1.f / (1.f + __expf(-braw));
        const float sp = fmaxf(araw + dt_bias[hd], 0.f) + log1pf(__expf(-fabsf(araw + dt_bias[hd])));
        float g = -__expf(a_log[hd]) * sp;
#pragma unroll
        for (int d = 1; d < 64; d <<= 1) { const float t = __shfl_up(g, d); if (lane >= d) g += t; }
        const float glast = __shfl(g, 63);
        gate[lane] = beta; gate[64 + lane] = g; gate[128 + lane] = __expf(g); gate[192 + lane] = __expf(glast - g);
        if (lane == 63) GL[item] = __expf(glast);
    }
    __syncthreads();
    {
        const int row = tid >> 3, seg = tid & 7, c0 = seg * 16, t = n * 64 + row;
        float val[3][16];
#pragma unroll
        for (int X = 0; X < 3; ++X) {
#pragma unroll
            for (int e = 0; e < 16; ++e) val[X][e] = 0.f;
#pragma unroll
            for (int j = 0; j < 4; ++j) {
                if (t - 3 + j >= 0) {
                    const bf16* src = PJ + (size_t)X * pj_stride + (row0 + row - 3 + j) * 512 + hd * 128 + c0;
                    const u32x4 w0 = *(const u32x4*)src, w1 = *(const u32x4*)(src + 8);
                    const LAS float* cw = convw + j * 384 + X * 128 + c0;
#pragma unroll
                    for (int e = 0; e < 4; ++e) { val[X][2 * e] += cw[2 * e] * bflo_(w0[e]); val[X][2 * e + 1] += cw[2 * e + 1] * bfhi_(w0[e]);
                                                  val[X][8 + 2 * e] += cw[8 + 2 * e] * bflo_(w1[e]); val[X][8 + 2 * e + 1] += cw[8 + 2 * e + 1] * bfhi_(w1[e]); }
                }
            }
#pragma unroll
            for (int e = 0; e < 16; ++e) val[X][e] = val[X][e] / (1.f + __expf(-val[X][e]));
        }
        float sq = 0.f, sk = 0.f;
#pragma unroll
        for (int e = 0; e < 16; ++e) { sq += val[0][e] * val[0][e]; sk += val[1][e] * val[1][e]; }
        sq += __shfl_xor(sq, 1); sq += __shfl_xor(sq, 2); sq += __shfl_xor(sq, 4);
        sk += __shfl_xor(sk, 1); sk += __shfl_xor(sk, 2); sk += __shfl_xor(sk, 4);
        const float rq = rsqrtf(sq + 1e-6f) * 0.08838834764831845f, rk = rsqrtf(sk + 1e-6f);
        u32x4 qa, qb, ka, kb;
#pragma unroll
        for (int e = 0; e < 4; ++e) { qa[e] = cvtpk2(val[0][2 * e] * rq, val[0][2 * e + 1] * rq); qb[e] = cvtpk2(val[0][8 + 2 * e] * rq, val[0][8 + 2 * e + 1] * rq);
                                      ka[e] = cvtpk2(val[1][2 * e] * rk, val[1][2 * e + 1] * rk); kb[e] = cvtpk2(val[1][8 + 2 * e] * rk, val[1][8 + 2 * e + 1] * rk); }
        *(LAS u32x4*)(lds + L_QS + (row * LQ + c0) * 2) = qa; *(LAS u32x4*)(lds + L_QS + (row * LQ + c0 + 8) * 2) = qb;
        *(LAS u32x4*)(lds + L_KS + (row * LQ + c0) * 2) = ka; *(LAS u32x4*)(lds + L_KS + (row * LQ + c0 + 8) * 2) = kb;
#pragma unroll
        for (int e = 0; e < 16; ++e) {
            const unsigned kw = (e < 8) ? ka[e >> 1] : kb[(e - 8) >> 1];
            *(LAS unsigned short*)(lds + L_KST + ((c0 + e) * LT + row) * 2) = (unsigned short)((e & 1) ? (kw >> 16) : (kw & 0xffffu));
            *(LAS unsigned short*)(lds + L_VST + ((c0 + e) * LT + row) * 2) = (unsigned short)(cvtpk2(val[2][e], 0.f) & 0xffffu);
        }
    }
    __syncthreads();
    {
        const int p = wid >> 2, ri = (wid >> 1) & 1, ci = wid & 1;
        const LAS unsigned char* Ap = lds + L_KS + ((32 * ri + r) * LQ + 8 * h2) * 2;
        const LAS unsigned char* Bp = lds + (p == 0 ? L_KS : L_QS) + ((32 * ci + r) * LQ + 8 * h2) * 2;
        f32x16 acc = {};
        const bool live = (p == 0) ? (ri >= ci) : (ri <= ci);
        if (live) {
#pragma unroll
            for (int ks = 0; ks < 8; ++ks) acc = DN_MFMA(lds16(Ap + ks * 32), lds16(Bp + ks * 32), acc);
        }
        const int colg = 32 * ci + r;
        const float gcol = gate[64 + colg];
        if (p == 0) {
#pragma unroll
            for (int i = 0; i < 16; ++i) {
                const int c = 32 * ri + crow(i, h2);
                const float a = (c > colg) ? gate[c] * acc[i] * __expf(gate[64 + c] - gcol) : 0.f;
                *(LAS float*)(lds + L_AF + (c * 68 + colg) * 4) = a;
                *(LAS unsigned short*)(lds + L_ABF + (c * LT + colg) * 2) = (unsigned short)(cvtpk2(a, 0.f) & 0xffffu);
            }
        } else {
            f32x16 x;
#pragma unroll
            for (int i = 0; i < 16; ++i) { const int s = 32 * ri + crow(i, h2); x[i] = (colg >= s) ? acc[i] * __expf(gcol - gate[64 + s]) : 0.f; }
            *(u32x4*)(blob + (32 + ci * 4 + 2 * ri + 0) * 1024 + lane * 16) = __builtin_bit_cast(u32x4, pack_acc<0>(x));
            *(u32x4*)(blob + (32 + ci * 4 + 2 * ri + 1) * 1024 + lane * 16) = __builtin_bit_cast(u32x4, pack_acc<1>(x));
        }
    }
    __syncthreads();
    if (wid == 0) {
        const int blk = h2, j = r, jg = 32 * blk + j;
        float x[32];
#pragma unroll
        for (int c = 0; c < 32; ++c) {
            float a = (c == j) ? 1.f : 0.f;
            const LAS float* arow = (const LAS float*)(lds + L_AF) + (32 * blk + c) * 68 + 32 * blk;
#pragma unroll
            for (int s = 0; s < c; ++s) a -= arow[s] * x[s];
            x[c] = a;
        }
        const float sw = gate[jg] * gate[128 + jg], su = gate[jg];
#pragma unroll
        for (int c = 0; c < 32; ++c) {
            const int off = ((32 * blk + c) * LT + jg) * 2;
            *(LAS unsigned short*)(lds + L_TRM + off) = (unsigned short)(cvtpk2(x[c], 0.f) & 0xffffu);
            *(LAS unsigned short*)(lds + L_TW + off) = (unsigned short)(cvtpk2(x[c] * sw, 0.f) & 0xffffu);
            *(LAS unsigned short*)(lds + L_TU + off) = (unsigned short)(cvtpk2(x[c] * su, 0.f) & 0xffffu);
        }
        if (blk == 0) {
#pragma unroll
            for (int c4 = 0; c4 < 4; ++c4) { u32x4 w = {cvtpk2(x[8 * c4], x[8 * c4 + 1]), cvtpk2(x[8 * c4 + 2], x[8 * c4 + 3]), cvtpk2(x[8 * c4 + 4], x[8 * c4 + 5]), cvtpk2(x[8 * c4 + 6], x[8 * c4 + 7])};
                *(LAS u32x4*)(lds + L_T00T + (j * 40 + 8 * c4) * 2) = w; }
        }
        asm volatile("s_waitcnt lgkmcnt(0)" ::: "memory");
        f32x16 m1 = {};
#pragma unroll
        for (int ks = 0; ks < 2; ++ks) m1 = DN_MFMA(lds16(lds + L_ABF + ((32 + r) * LT + 16 * ks + 8 * h2) * 2), lds16(lds + L_T00T + (r * 40 + 16 * ks + 8 * h2) * 2), m1);
        f32x16 t10 = {};
        t10 = DN_MFMA(lds_perm8(lds + L_TRM + ((32 + r) * LT) * 2, 32 + 0, h2), pack_acc<0>(m1), t10);
        t10 = DN_MFMA(lds_perm8(lds + L_TRM + ((32 + r) * LT) * 2, 32 + 16, h2), pack_acc<1>(m1), t10);
        const float sw0 = gate[r] * gate[128 + r], su0 = gate[r];
#pragma unroll
        for (int i = 0; i < 16; ++i) {
            const int off = ((32 + crow(i, h2)) * LT + r) * 2; const float tv = -t10[i];
            *(LAS unsigned short*)(lds + L_TW + off) = (unsigned short)(cvtpk2(tv * sw0, 0.f) & 0xffffu);
            *(LAS unsigned short*)(lds + L_TU + off) = (unsigned short)(cvtpk2(tv * su0, 0.f) & 0xffffu);
        }
    } else {
        for (int f = wid - 1; f < 32; f += 7) {
            bf16x8 v; float sc[8];
            if (f < 16) {
                const int mt = f >> 3, s = f & 7, row = 32 * mt + r;
                v = lds_perm8(lds + L_QS + (row * LQ) * 2, 32 * (s >> 1) + 16 * (s & 1), h2);
                const float e = gate[128 + row];
#pragma unroll
                for (int jj = 0; jj < 8; ++jj) sc[jj] = e;
            } else {
                const int kt = (f - 16) >> 2, s2 = (f - 16) & 3, row = 32 * kt + r, cb = 32 * (s2 >> 1) + 16 * (s2 & 1);
                v = lds_perm8(lds + L_KST + (row * LT) * 2, cb, h2);
#pragma unroll
                for (int jj = 0; jj < 8; ++jj) sc[jj] = gate[192 + cb + 8 * (jj >> 2) + 4 * h2 + (jj & 3)];
            }
            const u32x4 w = __builtin_bit_cast(u32x4, v);
            u32x4 o;
#pragma unroll
            for (int e = 0; e < 4; ++e) o[e] = cvtpk2(bflo_(w[e]) * sc[2 * e], bfhi_(w[e]) * sc[2 * e + 1]);
            *(u32x4*)(blob + (f < 16 ? 16 + f : 40 + (f - 16)) * 1024 + lane * 16) = o;
        }
    }
    __syncthreads();
    {
        const int kt = wid >> 1, mt = wid & 1;
        f32x16 wt = {}, ut = {};
        const int nks = mt == 0 ? 2 : 4;
        for (int ks = 0; ks < nks; ++ks) {
            wt = DN_MFMA(lds16(lds + L_KST + ((32 * kt + r) * LT + 16 * ks + 8 * h2) * 2), lds16(lds + L_TW + ((32 * mt + r) * LT + 16 * ks + 8 * h2) * 2), wt);
            ut = DN_MFMA(lds16(lds + L_TU + ((32 * mt + r) * LT + 16 * ks + 8 * h2) * 2), lds16(lds + L_VST + ((32 * kt + r) * LT + 16 * ks + 8 * h2) * 2), ut);
        }
#pragma unroll
        for (int i = 0; i < 16; ++i) wt[i] = -wt[i];
        *(u32x4*)(blob + (mt * 8 + 2 * kt + 0) * 1024 + lane * 16) = __builtin_bit_cast(u32x4, pack_acc<0>(wt));
        *(u32x4*)(blob + (mt * 8 + 2 * kt + 1) * 1024 + lane * 16) = __builtin_bit_cast(u32x4, pack_acc<1>(wt));
        unsigned char* uf = UF + (size_t)item * UF_BYTES + ((kt * 2 + mt) * 64 + lane) * 32;
        *(u32x4*)uf = __builtin_bit_cast(u32x4, pack_acc<0>(ut)); *(u32x4*)(uf + 16) = __builtin_bit_cast(u32x4, pack_acc<1>(ut));
    }
    __syncthreads();
}

constexpr int S_SLOT = 32768, S_END = 4 * S_SLOT;
DNI void glds16(const void* gsrc, LAS unsigned char* dst) { __builtin_amdgcn_global_load_lds((const GAS unsigned*)gsrc, (LAS unsigned*)dst, 16, 0, 0); }
DNI void scan_bh(LAS unsigned char* lds, int bh, const unsigned char* BLOB, const unsigned char* UF, const float* GL, unsigned char* SF, unsigned char* VF) {
    int tid = threadIdx.x; asm volatile("" : "+v"(tid));
    const int wid = __builtin_amdgcn_readfirstlane(tid >> 6), lane = tid & 63;
    const unsigned char* blob0 = BLOB + (size_t)bh * 64 * BLOB_BYTES;
    unsigned lane16 = (unsigned)lane * 16u; asm volatile("" : "+v"(lane16));
#define DN_B() do { __builtin_amdgcn_s_barrier(); asm volatile("" ::: "memory"); } while (0)
    if (wid >= 4) {
        const int lw = wid - 4;
#define DN_ISSUE(c) do { const unsigned char* bc_ = blob0 + (size_t)(c) * BLOB_BYTES + lw * 1024; LAS unsigned char* sl_ = lds + ((c) & 3) * S_SLOT + lw * 1024; _Pragma("unroll") for (int i_ = 0; i_ < 4; ++i_) { \
        glds16(bc_ + i_ * 4096 + lane16, sl_ + i_ * 4096); glds16(bc_ + 40960 + i_ * 4096 + lane16, sl_ + 16384 + i_ * 4096); } } while (0)
        DN_ISSUE(0); DN_ISSUE(1); DN_ISSUE(2);
        asm volatile("s_waitcnt vmcnt(16)" ::: "memory"); DN_B();
#pragma unroll 1
        for (int c = 0; c < 64; ++c) {
            if (c + 3 < 64) { DN_ISSUE(c + 3); asm volatile("s_waitcnt vmcnt(16)" ::: "memory"); }
            else if (c + 2 < 64) asm volatile("s_waitcnt vmcnt(8)" ::: "memory");
            else asm volatile("s_waitcnt vmcnt(0)" ::: "memory");
            DN_B();
        }
#undef DN_ISSUE
    } else {
        const float glv = GL[bh * 64 + lane];
        const unsigned char* uf0 = UF + (size_t)bh * 64 * UF_BYTES + (wid * 128 + lane) * 32;
        unsigned char* sf0 = SF + ((size_t)(bh * 64) * 4 + wid) * 8192 + lane * 16;
        unsigned char* vf0 = VF + ((size_t)(bh * 64) * 4 + wid) * 4096 + lane * 16;
        f32x16 S0 = {}, S1 = {}, S2 = {}, S3 = {};
        u32x4 ua[4], ub[4];
#define DN_ULOAD(U, c) do { const unsigned char* u_ = uf0 + (size_t)(c) * UF_BYTES; U[0] = *(const u32x4*)u_; U[1] = *(const u32x4*)(u_ + 16); U[2] = *(const u32x4*)(u_ + 2048); U[3] = *(const u32x4*)(u_ + 2048 + 16); } while (0)
        DN_ULOAD(ua, 0); DN_ULOAD(ub, 1);
        DN_B();
#define RD4(X, f0, f1, f2, f3) do { asm volatile("ds_read_b128 %0, %4 offset:%5\n\tds_read_b128 %1, %4 offset:%6\n\tds_read_b128 %2, %4 offset:%7\n\tds_read_b128 %3, %4 offset:%8" \
        : "=&v"(X##0), "=&v"(X##1), "=&v"(X##2), "=&v"(X##3) : "v"(fba), "i"((f0) * 1024), "i"((f1) * 1024), "i"((f2) * 1024), "i"((f3) * 1024)); __builtin_amdgcn_sched_barrier(0); } while (0)
#define PIN2(a, b) asm volatile("" : "+v"(a), "+v"(b))
#define PIN4(a, b, c, d) asm volatile("" : "+v"(a), "+v"(b), "+v"(c), "+v"(d))
#define LWAIT() do { asm volatile("s_waitcnt lgkmcnt(0)" ::: "memory"); __builtin_amdgcn_sched_barrier(0); } while (0)
#define DN_STEP(U, c) do { \
            const unsigned fba = (unsigned)(uintptr_t)(lds + ((c) & 3) * S_SLOT) + lane16; \
            const float gl = __builtin_bit_cast(float, __builtin_amdgcn_readlane(__builtin_bit_cast(int, glv), (c))); \
            f32x16 v0, v1; \
            _Pragma("unroll") for (int i = 0; i < 8; ++i) { v0[2 * i] = bflo_(U[i >> 2][i & 3]); v0[2 * i + 1] = bfhi_(U[i >> 2][i & 3]); v1[2 * i] = bflo_(U[2 + (i >> 2)][i & 3]); v1[2 * i + 1] = bfhi_(U[2 + (i >> 2)][i & 3]); } \
            PIN2(v0, v1); \
            if ((c) + 2 < 64) DN_ULOAD(U, (c) + 2); \
            asm volatile("s_waitcnt lgkmcnt(0)" ::: "memory"); \
            unsigned char* sfc = sf0 + (size_t)(c) * 32768; unsigned char* vfc = vf0 + (size_t)(c) * 16384; \
            bf16x8 A0, A1, A2, A3, B0, B1, B2, B3; \
            RD4(A, 0, 8, 1, 9); LWAIT(); \
              \
            { const bf16x8 s0_ = pack_acc<0>(S0), s1_ = pack_acc<1>(S0); *(u32x4*)(sfc) = __builtin_bit_cast(u32x4, s0_); *(u32x4*)(sfc + 1024) = __builtin_bit_cast(u32x4, s1_); RD4(B, 2, 10, 3, 11); \
              v0 = DN_MFMA(A0, s0_, v0); v1 = DN_MFMA(A1, s0_, v1); v0 = DN_MFMA(A2, s1_, v0); v1 = DN_MFMA(A3, s1_, v1); PIN2(v0, v1); LWAIT(); } \
            { const bf16x8 s0_ = pack_acc<0>(S1), s1_ = pack_acc<1>(S1); *(u32x4*)(sfc + 2048) = __builtin_bit_cast(u32x4, s0_); *(u32x4*)(sfc + 3072) = __builtin_bit_cast(u32x4, s1_); RD4(A, 4, 12, 5, 13); \
              v0 = DN_MFMA(B0, s0_, v0); v1 = DN_MFMA(B1, s0_, v1); v0 = DN_MFMA(B2, s1_, v0); v1 = DN_MFMA(B3, s1_, v1); PIN2(v0, v1); LWAIT(); } \
            { const bf16x8 s0_ = pack_acc<0>(S2), s1_ = pack_acc<1>(S2); *(u32x4*)(sfc + 4096) = __builtin_bit_cast(u32x4, s0_); *(u32x4*)(sfc + 5120) = __builtin_bit_cast(u32x4, s1_); RD4(B, 6, 14, 7, 15); \
              v0 = DN_MFMA(A0, s0_, v0); v1 = DN_MFMA(A1, s0_, v1); v0 = DN_MFMA(A2, s1_, v0); v1 = DN_MFMA(A3, s1_, v1); PIN2(v0, v1); LWAIT(); } \
            { const bf16x8 s0_ = pack_acc<0>(S3), s1_ = pack_acc<1>(S3); *(u32x4*)(sfc + 6144) = __builtin_bit_cast(u32x4, s0_); *(u32x4*)(sfc + 7168) = __builtin_bit_cast(u32x4, s1_); RD4(A, 16, 20, 24, 28); \
              v0 = DN_MFMA(B0, s0_, v0); v1 = DN_MFMA(B1, s0_, v1); v0 = DN_MFMA(B2, s1_, v0); v1 = DN_MFMA(B3, s1_, v1); PIN2(v0, v1); LWAIT(); } \
            const bf16x8 vf0_ = pack_acc<0>(v0), vf1_ = pack_acc<1>(v0), vf2_ = pack_acc<0>(v1), vf3_ = pack_acc<1>(v1); \
            *(u32x4*)(vfc) = __builtin_bit_cast(u32x4, vf0_); *(u32x4*)(vfc + 1024) = __builtin_bit_cast(u32x4, vf1_); *(u32x4*)(vfc + 2048) = __builtin_bit_cast(u32x4, vf2_); *(u32x4*)(vfc + 3072) = __builtin_bit_cast(u32x4, vf3_); \
            _Pragma("unroll") for (int i = 0; i < 16; ++i) { S0[i] *= gl; S1[i] *= gl; S2[i] *= gl; S3[i] *= gl; } \
              \
            RD4(B, 17, 21, 25, 29); \
            S0 = DN_MFMA(A0, vf0_, S0); S1 = DN_MFMA(A1, vf0_, S1); S2 = DN_MFMA(A2, vf0_, S2); S3 = DN_MFMA(A3, vf0_, S3); PIN4(S0, S1, S2, S3); LWAIT(); \
            RD4(A, 18, 22, 26, 30); \
            S0 = DN_MFMA(B0, vf1_, S0); S1 = DN_MFMA(B1, vf1_, S1); S2 = DN_MFMA(B2, vf1_, S2); S3 = DN_MFMA(B3, vf1_, S3); PIN4(S0, S1, S2, S3); LWAIT(); \
            RD4(B, 19, 23, 27, 31); \
            S0 = DN_MFMA(A0, vf2_, S0); S1 = DN_MFMA(A1, vf2_, S1); S2 = DN_MFMA(A2, vf2_, S2); S3 = DN_MFMA(A3, vf2_, S3); PIN4(S0, S1, S2, S3); LWAIT(); \
            S0 = DN_MFMA(B0, vf3_, S0); S1 = DN_MFMA(B1, vf3_, S1); S2 = DN_MFMA(B2, vf3_, S2); S3 = DN_MFMA(B3, vf3_, S3); PIN4(S0, S1, S2, S3); \
            __builtin_amdgcn_sched_barrier(0); \
            DN_B(); } while (0)
#pragma unroll 1
        for (int c = 0; c < 64; c += 2) { DN_STEP(ua, c); DN_STEP(ub, c + 1); }
#undef DN_STEP
#undef RD4
#undef PIN2
#undef PIN4
#undef LWAIT
#undef DN_ULOAD
    }
    __syncthreads();
#undef DN_B
}

constexpr int O_OT = 0, O_NW = 2 * 64 * LQ * 2, O_END = O_NW + 512;
DNI void chunk_out(LAS unsigned char* lds, int item, const unsigned char* BLOB, const unsigned char* SF, const unsigned char* VF, const bf16* DNZ, const float* norm_w, bf16* Y) {
    int tid = threadIdx.x; asm volatile("" : "+v"(tid));
    const int wid = __builtin_amdgcn_readfirstlane(tid >> 6), lane = tid & 63, r = lane & 31, h2 = lane >> 5, half = wid >> 2, w = wid & 3;
    const int ck = 2 * item + half;
    const int n = ck & 63, hd = (ck >> 6) & 3, b = ck >> 8;
    if (tid < 128) ((LAS float*)(lds + O_NW))[tid] = norm_w[tid];
    const unsigned char* blob = BLOB + (size_t)ck * BLOB_BYTES + lane * 16;
    const unsigned char* sfp = SF + ((size_t)ck * 4 + w) * 8192 + lane * 16;
    const unsigned char* vfp = VF + ((size_t)ck * 4 + w) * 4096 + lane * 16;
    f32x16 o0 = {}, o1 = {};
#define GF(f) (*(const bf16x8*)(blob + (f) * 1024))
#pragma unroll
    for (int s = 0; s < 8; ++s) { const bf16x8 sf = *(const bf16x8*)(sfp + s * 1024); o0 = DN_MFMA(GF(16 + s), sf, o0); o1 = DN_MFMA(GF(24 + s), sf, o1); }
#pragma unroll
    for (int s2 = 0; s2 < 4; ++s2) { const bf16x8 vf = *(const bf16x8*)(vfp + s2 * 1024); o0 = DN_MFMA(GF(32 + s2), vf, o0); o1 = DN_MFMA(GF(36 + s2), vf, o1); }
#undef GF
    {
        LAS unsigned char* obp = lds + O_OT + half * (64 * LQ * 2) + ((4 * h2) * LQ + 32 * w + r) * 2;
#pragma unroll
        for (int i = 0; i < 16; ++i) {
            *(LAS unsigned short*)(obp + ((i & 3) + 8 * (i >> 2)) * (LQ * 2)) = (unsigned short)(cvtpk2(o0[i], 0.f) & 0xffffu);
            *(LAS unsigned short*)(obp + (32 + (i & 3) + 8 * (i >> 2)) * (LQ * 2)) = (unsigned short)(cvtpk2(o1[i], 0.f) & 0xffffu);
        }
    }
    __syncthreads();
    {
        const int t4 = tid & 255, pos = t4 >> 2, seg = t4 & 3;
        const LAS unsigned char* op = lds + O_OT + half * (64 * LQ * 2) + (pos * LQ + seg * 32) * 2;
        u32x4 wv[4];
#pragma unroll
        for (int q = 0; q < 4; ++q) wv[q] = *(const LAS u32x4*)(op + q * 16);
        float ss = 0.f;
#pragma unroll
        for (int q = 0; q < 4; ++q)
#pragma unroll
            for (int e = 0; e < 4; ++e) { const float a = bflo_(wv[q][e]), c = bfhi_(wv[q][e]); ss += a * a + c * c; }
        ss += __shfl_xor(ss, 1); ss += __shfl_xor(ss, 2);
        const float rs = rsqrtf(ss * (1.f / 128.f) + 1e-6f);
        const size_t m = (size_t)b * 4096 + (size_t)n * 64 + pos;
        const bf16* zp = DNZ + m * 512 + hd * 128 + seg * 32; bf16* yp = Y + m * 1024 + hd * 128 + seg * 32; const LAS float* nw = (const LAS float*)(lds + O_NW) + seg * 32;
#pragma unroll
        for (int q = 0; q < 4; ++q) {
            const u32x4 z = *(const u32x4*)(zp + q * 8); u32x4 o;
#pragma unroll
            for (int e = 0; e < 4; ++e) {
                const float z0 = bflo_(z[e]), z1 = bfhi_(z[e]);
                o[e] = cvtpk2(bflo_(wv[q][e]) * rs * nw[q * 8 + 2 * e] * (z0 / (1.f + __expf(-z0))), bfhi_(wv[q][e]) * rs * nw[q * 8 + 2 * e + 1] * (z1 / (1.f + __expf(-z1))));
            }
            *(u32x4*)(yp + q * 8) = o;
        }
    }
    __syncthreads();
}
#undef DN_MFMA
#undef DNI
}
constexpr int NWAVES = 8, NTHR = NWAVES * 64;
constexpr int BATCH = 4, SEQ = 4096, DM = 1024, M = BATCH * SEQ;
constexpr int HD = 128, NH = 4, DDN = 512, DMB = 512, NPROJ = 3584, DINP = 3592;
constexpr int MBLK = 256, NBLK = SEQ / MBLK;
constexpr int NE = 16, DE = 256;
constexpr float LN_EPS = 1e-5f, RMS_EPS = 1e-6f, ALPHA = 1.189207115002721f, QSCALE = 0.08838834764831845f;

constexpr size_t MiB = 1u << 20;
constexpr size_t WS_CTL = 0, CTL_ZERO_BYTES = 1 * MiB;
constexpr size_t WS_WIN = 2 * MiB;
constexpr size_t WS_WOUT = 10 * MiB;
constexpr size_t WS_WGU = 12 * MiB;
constexpr size_t WS_WD = 28 * MiB;
constexpr size_t WS_ROPE = 36 * MiB;
constexpr size_t WS_KMP = 38 * MiB;
constexpr size_t WS_GATES = 39 * MiB;
constexpr size_t WS_BETA = WS_GATES + 512 * 1024;
constexpr size_t WS_GLOG = WS_BETA + 256 * 1024;
constexpr size_t WS_XB = 48 * MiB;
constexpr size_t WS_DNQN = 48 * MiB, WS_DNKN = 64 * MiB;
constexpr size_t WS_PJ = 80 * MiB;
constexpr size_t PJ_STRIDE = 16 * MiB;
constexpr size_t WS_Y = 192 * MiB;
constexpr size_t WS_DNVN = 224 * MiB;
constexpr size_t WS_GL = 40 * MiB;
constexpr size_t WS_SF = 48 * MiB;
constexpr size_t WS_VF = 224 * MiB;
constexpr size_t WS_UF = 240 * MiB;
constexpr size_t WS_TOKE = 41 * MiB;
constexpr size_t WS_TOKP = WS_TOKE + 256 * 1024;
constexpr size_t WS_TOKW = WS_TOKP + 256 * 1024;
constexpr size_t WS_HB = 48 * MiB;
constexpr size_t WS_HS = 80 * MiB;
constexpr size_t WS_HE = 152 * MiB;
constexpr size_t WS_Y2 = 170 * MiB;
constexpr size_t WS_MIXB = 224 * MiB;
constexpr size_t WS_END = 256 * MiB;
constexpr int CW_CNT = 64;
constexpr int CW_SEAM = 16384;
constexpr size_t WS_XBUF = 42 * MiB;
constexpr int CW_BAR = 4096;

constexpr int RING_OFF = 0, RING_BYTES = 139264;
constexpr int LDSCTL_OFF = RING_BYTES, MISC_OFF = LDSCTL_OFF + 320;
constexpr int LDS_BYTES = 147456;

#define DI __device__ __forceinline__
DI float bf2f(unsigned short v) { return __uint_as_float((unsigned)v << 16); }
DI float bflo(unsigned w) { return __uint_as_float(w << 16); }
DI float bfhi(unsigned w) { return __uint_as_float(w & 0xffff0000u); }
DI float wave_sum(float v) {
#pragma unroll
    for (int o = 1; o < 64; o <<= 1) v += __shfl_xor(v, o);
    return v;
}
DI float wave_max(float v) {
#pragma unroll
    for (int o = 1; o < 64; o <<= 1) v = fmaxf(v, __shfl_xor(v, o));
    return v;
}
DI float silu_f(float v) { return v / (1.f + __expf(-v)); }
DI float softplus_f(float v) { return fmaxf(v, 0.f) + log1pf(__expf(-fabsf(v))); }

struct Args {
    const GAS float* in_[18]; GAS float* out_; GAS unsigned char* ws_; int ph_lo, ph_hi;
    DI const float* I(int k) const { return (const float*)in_[k]; }
    DI float* O() const { return (float*)out_; }
    DI unsigned char* W() const { return (unsigned char*)ws_; }
};
#define CAS __attribute__((address_space(4)))
struct KA {
    const CAS unsigned char* p;
    DI const float* I(int k) const { return (const float*)(*(const GAS float* const CAS*)(p + 8 * k)); }
    DI float* O() const { return (float*)(*(GAS float* const CAS*)(p + 144)); }
    DI unsigned char* W() const { return (unsigned char*)(*(GAS unsigned char* const CAS*)(p + 152)); }
    DI int lo() const { return *(const CAS int*)(p + 160); }
    DI int hi() const { return *(const CAS int*)(p + 164); }
};
static_assert(offsetof(Args, out_) == 144 && offsetof(Args, ws_) == 152 && offsetof(Args, ph_lo) == 160 && offsetof(Args, ph_hi) == 164, "Args layout");
DI KA kargs() { KA a; a.p = (const CAS unsigned char*)__builtin_amdgcn_kernarg_segment_ptr(); asm volatile("" : "+s"(a.p)); return a; }
struct Frame {
    LAS unsigned char* lds;
    int tid, lane, wave, vcu, G;
};

DI void p0_transpose_item(const float* W, int ldw, int src_col0, int K, bf16* WT, int dst_row0, LAS float* scr, int kb, int nb, int lane) {
    const int k0 = 64 * kb, n0 = 32 * nb;
#pragma unroll 8
    for (int i = 0; i < 32; ++i) { const int kk = 2 * i + (lane >> 5); scr[kk * 33 + (lane & 31)] = W[(size_t)(k0 + kk) * ldw + src_col0 + n0 + (lane & 31)]; }
    LDS_WAIT(); asm volatile("" ::: "memory");
    const int c = lane & 7;
#pragma unroll
    for (int j = 0; j < 4; ++j) { const int n = (lane >> 3) + 8 * j; const LAS float* s = scr + (8 * c) * 33 + n;
        v4u o; o.x = pk2(s[0 * 33], s[1 * 33]); o.y = pk2(s[2 * 33], s[3 * 33]); o.z = pk2(s[4 * 33], s[5 * 33]); o.w = pk2(s[6 * 33], s[7 * 33]);
        *(GAS v4u*)(WT + (size_t)(dst_row0 + n0 + n) * K + k0 + 8 * c) = o; }
    LDS_WAIT(); asm volatile("" ::: "memory");
}

DI void p0_prologue(const Frame& F, const KA& A) {
    unsigned char* ws = A.W();
    const float* x = A.I(0); const float* w_in = A.I(1); const float* w_out = A.I(6);
    const int gw = F.vcu * NWAVES + F.wave, NGW = F.G * NWAVES;
    {
        LAS float* wgl = (LAS float*)(F.lds + RING_OFF);
        for (int i = F.tid; i < 1024 * 8; i += NTHR) wgl[i] = w_in[(size_t)(i >> 3) * DINP + 2048 + (i & 7)];
        __syncthreads();
        bf16* XB = (bf16*)(ws + WS_XB); float* GATES = (float*)(ws + WS_GATES);
        for (int m = gw; m < M; m += NGW) {
            const GAS f32x4* xr = (const GAS f32x4*)(x + (size_t)m * DM) + F.lane;
            f32x4 v[4];
#pragma unroll
            for (int j = 0; j < 4; ++j) v[j] = xr[64 * j];
            GAS unsigned long long* o8 = (GAS unsigned long long*)(XB + (size_t)m * DM) + F.lane;
            float g[8];
#pragma unroll
            for (int q = 0; q < 8; ++q) g[q] = 0.f;
#pragma unroll
            for (int j = 0; j < 4; ++j) {
                o8[64 * j] = (unsigned long long)pk2(v[j].x, v[j].y) | ((unsigned long long)pk2(v[j].z, v[j].w) << 32);
#pragma unroll
                for (int e = 0; e < 4; ++e) { const int k = 256 * j + 4 * F.lane + e; const float xv = v[j][e];
                    const f32x4 w0 = *(const LAS f32x4*)(wgl + k * 8), w1 = *(const LAS f32x4*)(wgl + k * 8 + 4);
                    g[0] += xv * w0.x; g[1] += xv * w0.y; g[2] += xv * w0.z; g[3] += xv * w0.w;
                    g[4] += xv * w1.x; g[5] += xv * w1.y; g[6] += xv * w1.z; g[7] += xv * w1.w; }
            }
#pragma unroll
            for (int q = 0; q < 8; ++q) g[q] = wave_sum(g[q]);
            if (F.lane == 0) {
#pragma unroll
                for (int q = 0; q < 8; ++q) GATES[(size_t)m * 8 + q] = g[q];
            }
        }
        __syncthreads();
    }
    {
        LAS float* scr = (LAS float*)(F.lds + RING_OFF + F.wave * 16384);
        bf16* WIN = (bf16*)(ws + WS_WIN); bf16* WOUT = (bf16*)(ws + WS_WOUT);
        constexpr int I_A = 16 * 64, I_B = 16 * 48, I_O = 16 * 32, I_GU = NE * 4 * 64, I_D = NE * 128;
        const float* wgate = A.I(13); const float* wup = A.I(14); const float* wdn = A.I(15);
        bf16* WGU = (bf16*)(ws + WS_WGU); bf16* WD = (bf16*)(ws + WS_WD);
        for (int it = gw; it < I_A + I_B + I_O + I_GU + I_D; it += NGW) {
            int r = it;
            if (r < I_A) { p0_transpose_item(w_in, DINP, 0, DM, WIN, 0, scr, r / 64, r % 64, F.lane); continue; } r -= I_A;
            if (r < I_B) { p0_transpose_item(w_in, DINP, 2056, DM, WIN, 2048, scr, r / 48, r % 48, F.lane); continue; } r -= I_B;
            if (r < I_O) { p0_transpose_item(w_out, DM, 0, DM, WOUT, 0, scr, r / 32, r % 32, F.lane); continue; } r -= I_O;
            if (r < I_GU) {
                const int e = r >> 8, q = (r >> 6) & 3, pn = q >> 1, up = q & 1, kb = (r >> 2) & 15, nb = r & 3;
                p0_transpose_item((up ? wup : wgate) + (size_t)e * DM * DE, DE, pn * 128, DM, WGU, e * 512 + pn * 256 + up * 128, scr, kb, nb, F.lane); continue; } r -= I_GU;
            { const int e = r >> 7, kb = (r >> 5) & 3, nb = r & 31;
              p0_transpose_item(wdn + (size_t)e * DE * DM, DM, 0, DE, WD + (size_t)e * DM * DE, 0, scr, kb, nb, F.lane); }
        }
    }
    {
        float2* ROPE = (float2*)(ws + WS_ROPE);
        for (int i = (F.vcu * NTHR + F.tid); i < SEQ * 64; i += F.G * NTHR) {
            const int pos = i >> 6, j = i & 63;
            const float inv = exp2f(-(float)j * (13.287712379549449f / 64.f));
            const float ang = (float)pos * inv;
            double rev = (double)ang * 0.15915494309189535; rev -= __builtin_rint(rev);
            const float rr = (float)rev;
            ROPE[i] = make_float2(__builtin_amdgcn_cosf(rr), __builtin_amdgcn_sinf(rr));
        }
    }
}

DI void n2a_conv_norm(const Frame& F, const KA& A) {
    unsigned char* ws = A.W();
    const float* conv_w = A.I(2); const float* a_log = A.I(3); const float* dt_bias = A.I(4);
    const bf16* PJ = (const bf16*)(ws + WS_PJ);
    bf16* OUTX[3] = {(bf16*)(ws + WS_DNQN), (bf16*)(ws + WS_DNKN), (bf16*)(ws + WS_DNVN)};
    const float* GATES = (const float*)(ws + WS_GATES); float* BETA = (float*)(ws + WS_BETA); float* GLOG = (float*)(ws + WS_GLOG);
    const int gw = F.vcu * NWAVES + F.wave, NGW = F.G * NWAVES;
    for (int it = gw; it < M * NH; it += NGW) {
        const int m = it >> 2, h = it & 3, t = m & (SEQ - 1), c = 2 * F.lane;
        float val[3][2];
#pragma unroll
        for (int X = 0; X < 3; ++X) {
            float a0 = 0.f, a1 = 0.f;
#pragma unroll
            for (int j = 0; j < 4; ++j) {
                const int tt = t - 3 + j;
                if (tt >= 0) {
                    const unsigned raw = *(const unsigned*)(PJ + X * (PJ_STRIDE / 2) + (size_t)(m - 3 + j) * 512 + h * 128 + c);
                    const float w0 = conv_w[j * 1536 + X * 512 + h * 128 + c], w1 = conv_w[j * 1536 + X * 512 + h * 128 + c + 1];
                    a0 += w0 * bflo(raw); a1 += w1 * bfhi(raw);
                }
            }
            val[X][0] = silu_f(a0); val[X][1] = silu_f(a1);
        }
        const float sq = wave_sum(val[0][0] * val[0][0] + val[0][1] * val[0][1]);
        const float sk = wave_sum(val[1][0] * val[1][0] + val[1][1] * val[1][1]);
        const float rq = rsqrtf(sq + 1e-6f) * QSCALE, rk = rsqrtf(sk + 1e-6f);
        val[0][0] *= rq; val[0][1] *= rq; val[1][0] *= rk; val[1][1] *= rk;
#pragma unroll
        for (int X = 0; X < 3; ++X) *(unsigned*)(OUTX[X] + (size_t)m * 512 + h * 128 + c) = pk2(val[X][0], val[X][1]);
        if (F.lane == 0) {
            const float bb = GATES[(size_t)m * 8 + h], aa = GATES[(size_t)m * 8 + 4 + h];
            BETA[(size_t)m * 4 + h] = 1.f / (1.f + __expf(-bb));
            GLOG[(size_t)m * 4 + h] = -__expf(a_log[h]) * softplus_f(aa + dt_bias[h]);
        }
    }
}

DI void rope8(bf16* p, const float2* rp, float* s1, float* s2) {
    const v4u lo = *(const v4u*)p, hi = *(const v4u*)(p + 64);
    const f32x4 c0 = *(const f32x4*)rp, c1 = *(const f32x4*)(rp + 2), c2 = *(const f32x4*)(rp + 4), c3 = *(const f32x4*)(rp + 6);
    const float cs[8] = {c0.x, c0.z, c1.x, c1.z, c2.x, c2.z, c3.x, c3.z}, sn[8] = {c0.y, c0.w, c1.y, c1.w, c2.y, c2.w, c3.y, c3.w};
    float r1[8], r2[8];
#pragma unroll
    for (int e = 0; e < 4; ++e) {
        const float a0 = bflo(lo[e]), a1 = bfhi(lo[e]), b0 = bflo(hi[e]), b1 = bfhi(hi[e]);
        r1[2 * e] = a0 * cs[2 * e] - b0 * sn[2 * e]; r2[2 * e] = b0 * cs[2 * e] + a0 * sn[2 * e];
        r1[2 * e + 1] = a1 * cs[2 * e + 1] - b1 * sn[2 * e + 1]; r2[2 * e + 1] = b1 * cs[2 * e + 1] + a1 * sn[2 * e + 1];
    }
    v4u o1, o2;
#pragma unroll
    for (int e = 0; e < 4; ++e) { o1[e] = pk2(r1[2 * e], r1[2 * e + 1]); o2[e] = pk2(r2[2 * e], r2[2 * e + 1]); }
    *(v4u*)p = o1; *(v4u*)(p + 64) = o2;
    if (s1) {
#pragma unroll
        for (int e = 0; e < 8; ++e) { s1[e] += r1[e]; s2[e] += r2[e]; }
    }
}
DI void n3a_rope(const Frame& F, const KA& A) {
    unsigned char* ws = A.W();
    bf16* MBQ = (bf16*)(ws + WS_PJ + 4 * PJ_STRIDE); bf16* MBK = (bf16*)(ws + WS_PJ + 5 * PJ_STRIDE);
    const float2* ROPE = (const float2*)(ws + WS_ROPE); float* KMP = (float*)(ws + WS_KMP);
    const int gw = F.vcu * NWAVES + F.wave, NGW = F.G * NWAVES, rr = F.lane >> 3, dseg = F.lane & 7;
    for (int it = gw; it < 1024; it += NGW) {
        const int qtr = it & 3, j = (it >> 2) & 15, h = (it >> 6) & 3, b = it >> 8;
        float s1[8], s2[8];
#pragma unroll
        for (int e = 0; e < 8; ++e) { s1[e] = 0.f; s2[e] = 0.f; }
#pragma unroll 2
        for (int r8 = 0; r8 < 8; ++r8) {
            const int pos = j * 256 + qtr * 64 + r8 * 8 + rr; const size_t m = (size_t)b * SEQ + pos;
            rope8(MBK + m * 512 + h * 128 + dseg * 8, ROPE + pos * 64 + dseg * 8, s1, s2);
        }
#pragma unroll
        for (int e = 0; e < 8; ++e) { s1[e] += __shfl_xor(s1[e], 8); s1[e] += __shfl_xor(s1[e], 16); s1[e] += __shfl_xor(s1[e], 32);
                                      s2[e] += __shfl_xor(s2[e], 8); s2[e] += __shfl_xor(s2[e], 16); s2[e] += __shfl_xor(s2[e], 32); }
        if (rr == 0) {
#pragma unroll
            for (int e = 0; e < 8; ++e) { KMP[(size_t)it * 128 + dseg * 8 + e] = s1[e]; KMP[(size_t)it * 128 + 64 + dseg * 8 + e] = s2[e]; }
        }
    }
    for (int it = gw; it < (M / 8) * NH; it += NGW) {
        const int m8 = it >> 2, h = it & 3; const size_t m = (size_t)m8 * 8 + rr; const int pos = (int)(m & (SEQ - 1));
        rope8(MBQ + m * 512 + h * 128 + dseg * 8, ROPE + pos * 64 + dseg * 8, nullptr, nullptr);
    }
}

DI void n2b_dn_recurrent(const Frame& F, const KA& A, int item, float* ODN) {
    unsigned char* ws = A.W();
    const bf16* QN = (const bf16*)(ws + WS_DNQN); const bf16* KN = (const bf16*)(ws + WS_DNKN); const bf16* VN = (const bf16*)(ws + WS_DNVN);
    const float* BETA = (const float*)(ws + WS_BETA); const float* GLOG = (const float*)(ws + WS_GLOG);
    const int b = item >> 2, h = item & 3;
    LAS float* qs = (LAS float*)(F.lds + RING_OFF);
    LAS float* ks = qs + 16 * 128; LAS float* vs = ks + 16 * 128; LAS float* bs = vs + 16 * 128; LAS float* as = bs + 16;
    float S[128];
#pragma unroll
    for (int k = 0; k < 128; ++k) S[k] = 0.f;
    for (int t0 = 0; t0 < SEQ; t0 += 16) {
        __syncthreads();
        for (int idx = F.tid; idx < 16 * 384; idx += NTHR) {
            const int r = idx / 384, c = idx % 384, X = c >> 7, cc = c & 127; const size_t m = (size_t)b * SEQ + t0 + r;
            const bf16* src = X == 0 ? QN : (X == 1 ? KN : VN);
            (X == 0 ? qs : (X == 1 ? ks : vs))[r * 128 + cc] = bf2f(src[m * 512 + h * 128 + cc]);
        }
        if (F.tid < 16) { const size_t m = (size_t)b * SEQ + t0 + F.tid; bs[F.tid] = BETA[m * 4 + h]; as[F.tid] = __expf(GLOG[m * 4 + h]); }
        __syncthreads();
        if (F.tid < 128) {
#pragma unroll 1
            for (int r = 0; r < 16; ++r) {
                const LAS float* kr = ks + r * 128; const LAS float* qr = qs + r * 128;
                float kS = 0.f;
#pragma unroll
                for (int kb = 0; kb < 128; kb += 16) {
#pragma unroll
                    for (int k = 0; k < 16; ++k) kS += kr[kb + k] * S[kb + k];
                    asm volatile("" ::: "memory");
                }
                const float al = as[r], be = bs[r];
                const float vn = be * (vs[r * 128 + F.tid] - al * kS);
                float o = 0.f;
#pragma unroll
                for (int kb = 0; kb < 128; kb += 16) {
#pragma unroll
                    for (int k = 0; k < 16; ++k) { S[kb + k] = al * S[kb + k] + kr[kb + k] * vn; o += qr[kb + k] * S[kb + k]; }
                    asm volatile("" ::: "memory");
                }
                ODN[((size_t)b * SEQ + t0 + r) * 512 + h * 128 + F.tid] = o;
            }
        }
    }
}

DI void n3b_moba_naive(const Frame& F, const KA& A, int w0, int nw, bf16* Yo, int ypitch, int ycol0) {
    unsigned char* ws = A.W();
    const bf16* MBQ = (const bf16*)(ws + WS_PJ + 4 * PJ_STRIDE); const bf16* MBK = (const bf16*)(ws + WS_PJ + 5 * PJ_STRIDE); const bf16* MBV = (const bf16*)(ws + WS_PJ + 6 * PJ_STRIDE);
    const float* KMP = (const float*)(ws + WS_KMP);
    LAS float* qs = (LAS float*)(F.lds + RING_OFF + 32768) + F.wave * 128;
    const int lane = F.lane;
    for (int it = w0; it < M * NH; it += nw) {
        const int m = it >> 2, h = it & 3, b = m >> 12, t = m & (SEQ - 1), own = t >> 8;
        { const unsigned raw = *(const unsigned*)(MBQ + (size_t)m * 512 + h * 128 + 2 * lane); qs[2 * lane] = bflo(raw) * QSCALE; qs[2 * lane + 1] = bfhi(raw) * QSCALE; }
        asm volatile("s_waitcnt lgkmcnt(0)" ::: "memory");
        float gate = -3e38f;
        if (lane < own) {
            const float* kp = KMP + (size_t)(((b * 4 + h) * 16 + lane) * 4) * 128; float acc = 0.f;
            for (int dd = 0; dd < 128; ++dd) acc += qs[dd] * ((kp[dd] + kp[128 + dd]) + (kp[256 + dd] + kp[384 + dd]));
            gate = acc * (1.f / 256.f);
        }
        int blist[4] = {-1, -1, -1, own};
#pragma unroll
        for (int r = 0; r < 3; ++r) {
            const float mx = wave_max(gate);
            if (mx > -1e37f) {
                const unsigned long long bal = __ballot(gate == mx); const int idx = __builtin_ctzll(bal);
                blist[r] = idx; if (lane == idx) gate = -3e38f;
            }
        }
        float sc[4][4]; float mloc = -3e38f;
#pragma unroll
        for (int s = 0; s < 4; ++s) {
            const int jb = blist[s];
#pragma unroll
            for (int i = 0; i < 4; ++i) {
                float v = -3e38f;
                if (jb >= 0) {
                    const int key = jb * 256 + i * 64 + lane;
                    if (s < 3 || key <= t) {
                        const bf16* kp = MBK + ((size_t)b * SEQ + key) * 512 + h * 128; float acc = 0.f;
#pragma unroll 4
                        for (int c8 = 0; c8 < 16; ++c8) { const v4u w = *(const v4u*)(kp + c8 * 8); const LAS float* q8 = qs + c8 * 8;
                            acc += q8[0] * bflo(w.x) + q8[1] * bfhi(w.x) + q8[2] * bflo(w.y) + q8[3] * bfhi(w.y) + q8[4] * bflo(w.z) + q8[5] * bfhi(w.z) + q8[6] * bflo(w.w) + q8[7] * bfhi(w.w); }
                        v = acc;
                    }
                }
                sc[s][i] = v; mloc = fmaxf(mloc, v);
            }
        }
        const float mx = wave_max(mloc); float lsum = 0.f;
#pragma unroll
        for (int s = 0; s < 4; ++s)
#pragma unroll
            for (int i = 0; i < 4; ++i) { const float p = sc[s][i] > -1e37f ? __expf(sc[s][i] - mx) : 0.f; sc[s][i] = p; lsum += p; }
        const float l = wave_sum(lsum);
        float o0 = 0.f, o1 = 0.f;
#pragma unroll
        for (int s = 0; s < 4; ++s) {
            const int jb = blist[s];
            if (jb >= 0) {
#pragma unroll
                for (int i = 0; i < 4; ++i) {
                    const bf16* vp = MBV + ((size_t)b * SEQ + jb * 256 + i * 64) * 512 + h * 128 + 2 * lane;
                    for (int src = 0; src < 64; ++src) {
                        const float pv = __shfl(sc[s][i], src);
                        if (pv != 0.f) { const unsigned raw = *(const unsigned*)(vp + (size_t)src * 512); o0 += pv * bflo(raw); o1 += pv * bfhi(raw); }
                    }
                }
            }
        }
        const float il = 1.f / l;
        *(unsigned*)(Yo + (size_t)m * ypitch + ycol0 + h * 128 + 2 * lane) = pk2(o0 * il, o1 * il);
        asm volatile("s_waitcnt lgkmcnt(0)" ::: "memory");
    }
}

DI void n2c_dn_gate(const Frame& F, const KA& A, const float* ODN, bf16* Yo, int ypitch) {
    unsigned char* ws = A.W();
    const float* norm_w = A.I(5); const bf16* DNZ = (const bf16*)(ws + WS_PJ + 3 * PJ_STRIDE);
    const int gw = F.vcu * NWAVES + F.wave, NGW = F.G * NWAVES, c = 2 * F.lane;
    for (int it = gw; it < M * NH; it += NGW) {
        const int m = it >> 2, h = it & 3;
        const float2 o = *(const float2*)(ODN + (size_t)m * 512 + h * 128 + c);
        const float ss = wave_sum(o.x * o.x + o.y * o.y) * (1.f / 128.f);
        const float rs = rsqrtf(ss + RMS_EPS);
        const unsigned zr = *(const unsigned*)(DNZ + (size_t)m * 512 + h * 128 + c);
        *(unsigned*)(Yo + (size_t)m * ypitch + h * 128 + c) = pk2(o.x * rs * norm_w[c] * silu_f(bflo(zr)), o.y * rs * norm_w[c + 1] * silu_f(bfhi(zr)));
    }
}

constexpr int CW_DBG = 16;
DI void dbg_compare(const Frame& F, unsigned char* ws, const bf16* T, int tp, int tc0, const bf16* R, int rp, int rc0) {
    float sd = 0.f, sr = 0.f;
    for (int i = F.vcu * NTHR + F.tid; i < M * 256; i += F.G * NTHR) {
        const int m = i >> 8, c = (i & 255) * 2;
        const unsigned a = *(const unsigned*)(T + (size_t)m * tp + tc0 + c), b = *(const unsigned*)(R + (size_t)m * rp + rc0 + c);
        const float d0 = bflo(a) - bflo(b), d1 = bfhi(a) - bfhi(b); sd += d0 * d0 + d1 * d1; sr += bflo(b) * bflo(b) + bfhi(b) * bfhi(b);
    }
    sd = wave_sum(sd); sr = wave_sum(sr);
    if (F.lane == 0) { atomicAdd((float*)(ws + WS_CTL) + CW_DBG, sd); atomicAdd((float*)(ws + WS_CTL) + CW_DBG + 1, sr); }
}
DI float block_sum(float v, LAS float* red, int tid) {
    v = wave_sum(v);
    __syncthreads();
    if ((tid & 63) == 0) red[tid >> 6] = v;
    __syncthreads();
    float s = 0.f;
#pragma unroll
    for (int w = 0; w < NWAVES; ++w) s += red[w];
    return s;
}

DI void n5_token_tail(const Frame& F, const KA& A) {
    const float* x = A.I(0); const float* g1 = A.I(7); const float* b1 = A.I(8);
    const float* rw1 = A.I(9); const float* rb1 = A.I(10); const float* rw2 = A.I(11); const float* rb2 = A.I(12);
    const float* wg = A.I(13); const float* wu = A.I(14); const float* wd = A.I(15); const float* g2 = A.I(16); const float* b2 = A.I(17);
    float* out = A.O();
    LAS float* hs = (LAS float*)(F.lds + RING_OFF);
    LAS float* hes = hs + 1024;
    LAS float* lg = hes + 512;
    LAS float* red = lg + 32;
    LAS float* rt_ = red + 8;
    const int tid = F.tid;
    for (int m = blockIdx.x; m < M; m += F.G) {
        __syncthreads();
        const size_t ro = (size_t)m * DM;
        float v0 = ALPHA * x[ro + tid] + out[ro + tid], v1 = ALPHA * x[ro + tid + 512] + out[ro + tid + 512];
        const float mean = block_sum(v0 + v1, red, tid) * (1.f / DM);
        v0 -= mean; v1 -= mean;
        const float var = block_sum(v0 * v0 + v1 * v1, red, tid) * (1.f / DM);
        const float rstd = rsqrtf(var + LN_EPS);
        const float h0 = v0 * rstd * g1[tid] + b1[tid], h1 = v1 * rstd * g1[tid + 512] + b1[tid + 512];
        hs[tid] = h0; hs[tid + 512] = h1;
        __syncthreads();
        for (int li = F.wave; li < 20; li += NWAVES) {
            float acc = 0.f;
            for (int k = F.lane; k < DM; k += 64) {
                const float wv = li < 4 ? rw1[k * 4 + li] : rw2[((size_t)((li - 4) >> 2) * DM + k) * 4 + ((li - 4) & 3)];
                acc += hs[k] * wv;
            }
            acc = wave_sum(acc);
            if (F.lane == 0) lg[li] = acc;
        }
        __syncthreads();
        if (tid == 0) {
            float pgv[4]; float mx = -3e38f;
            for (int g = 0; g < 4; ++g) { pgv[g] = lg[g] + rb1[g]; mx = fmaxf(mx, pgv[g]); }
            float sum = 0.f; for (int g = 0; g < 4; ++g) { pgv[g] = __expf(pgv[g] - mx); sum += pgv[g]; }
            int gs = 0; for (int g = 1; g < 4; ++g) if (pgv[g] > pgv[gs]) gs = g;
            const float pg = pgv[gs] / sum;
            float pe[4]; mx = -3e38f;
            for (int e = 0; e < 4; ++e) { pe[e] = lg[4 + gs * 4 + e] + rb2[gs * 4 + e]; mx = fmaxf(mx, pe[e]); }
            sum = 0.f; for (int e = 0; e < 4; ++e) { pe[e] = __expf(pe[e] - mx); sum += pe[e]; }
            int e0 = 0; for (int e = 1; e < 4; ++e) if (pe[e] > pe[e0]) e0 = e;
            int e1 = (e0 == 0) ? 1 : 0; for (int e = 0; e < 4; ++e) if (e != e0 && pe[e] > pe[e1]) e1 = e;
            const float den = pe[e0] + pe[e1];
            rt_[0] = __int_as_float(gs * 4 + e0); rt_[1] = __int_as_float(gs * 4 + e1); rt_[2] = pg * pe[e0] / den; rt_[3] = pg * pe[e1] / den;
        }
        __syncthreads();
        const int ex[2] = {__float_as_int(rt_[0]), __float_as_int(rt_[1])}; const float wx[2] = {rt_[2], rt_[3]};
        {
            const int half = tid >> 8, j = tid & 255, e = ex[half];
            const float* pg_ = wg + (size_t)e * DM * DE + j; const float* pu_ = wu + (size_t)e * DM * DE + j;
            float ga = 0.f, ua = 0.f;
#pragma unroll 8
            for (int k = 0; k < DM; ++k) { const float hv = hs[k]; ga += hv * pg_[(size_t)k * DE]; ua += hv * pu_[(size_t)k * DE]; }
            hes[half * 256 + j] = silu_f(ga) * ua;
        }
        __syncthreads();
        float y0 = 0.f, y1 = 0.f;
#pragma unroll
        for (int half = 0; half < 2; ++half) {
            const float* pd = wd + (size_t)ex[half] * DE * DM + tid; float a0 = 0.f, a1 = 0.f;
#pragma unroll 8
            for (int j = 0; j < DE; ++j) { const float hv = hes[half * 256 + j]; a0 += hv * pd[(size_t)j * DM]; a1 += hv * pd[(size_t)j * DM + 512]; }
            y0 += wx[half] * a0; y1 += wx[half] * a1;
        }
        float u0 = ALPHA * h0 + y0, u1 = ALPHA * h1 + y1;
        const float mean2 = block_sum(u0 + u1, red, tid) * (1.f / DM);
        u0 -= mean2; u1 -= mean2;
        const float var2 = block_sum(u0 * u0 + u1 * u1, red, tid) * (1.f / DM);
        const float rstd2 = rsqrtf(var2 + LN_EPS);
        float dscale = 1.f;
#ifdef DBG_ANY
        { const float* dw = (const float*)(A.W() + WS_CTL) + CW_DBG; dscale = 1.f + sqrtf(dw[0] / fmaxf(dw[1], 1e-30f)); }
#endif
        out[ro + tid] = (u0 * rstd2 * g2[tid] + b2[tid]) * dscale; out[ro + tid + 512] = (u1 * rstd2 * g2[tid + 512] + b2[tid + 512]) * dscale;
    }
}

struct MbPart { int own, t_lo, t_hi, slot; };
struct MbSplit { int own, slot0, nparts; };
constexpr int MB_NPARTS = 30, MB_NSLOTS = 24, MB_NSPLIT = 10;
__device__ const MbPart MB_PARTS[MB_NPARTS] = {{5, 0, 24, -1}, {11, 0, 24, 10}, {11, 24, 48, 11}, {10, 0, 22, 8}, {10, 22, 44, 9}, {15, 0, 22, 21}, {15, 22, 44, 22}, {4, 0, 20, -1}, {9, 0, 20, 6}, {9, 20, 40, 7}, {13, 0, 20, 15}, {13, 20, 40, 16}, {14, 0, 20, 18}, {14, 20, 40, 19}, {14, 40, 60, 20}, {15, 44, 64, 23}, {8, 0, 18, 4}, {8, 18, 36, 5}, {12, 0, 18, 12}, {12, 18, 36, 13}, {3, 0, 16, -1}, {7, 0, 16, 2}, {7, 16, 32, 3}, {12, 36, 52, 14}, {13, 40, 56, 17}, {6, 0, 14, 0}, {6, 14, 28, 1}, {2, 0, 12, -1}, {1, 0, 8, -1}, {0, 0, 4, -1}};
__device__ const MbSplit MB_SPLITS[MB_NSPLIT] = {{6, 0, 2}, {7, 2, 2}, {8, 4, 2}, {9, 6, 2}, {10, 8, 2}, {11, 10, 2}, {12, 12, 3}, {13, 15, 3}, {14, 18, 3}, {15, 21, 3}};
constexpr size_t WS_MBPO = WS_PJ;
constexpr size_t WS_MBLSE = WS_PJ + 24 * MiB;
constexpr int CW_MBQ = 96;
typedef mb::BlockRef<bf16, bf16> mbref_t;
DI mbref_t mb_ref(unsigned char* ws, int p, int xq) {
    const int bh = __builtin_amdgcn_readfirstlane(2 * xq + (p & 1)), k = __builtin_amdgcn_readfirstlane(p >> 1);
    const MbPart pt = MB_PARTS[k];
    const int own = __builtin_amdgcn_readfirstlane(pt.own), slot = __builtin_amdgcn_readfirstlane(pt.slot);
    const int b = bh >> 2, h = bh & 3; const size_t row0 = (size_t)b * SEQ;
    mbref_t r;
    r.Q = (const bf16*)(ws + WS_PJ + 4 * PJ_STRIDE) + (row0 + (size_t)own * 256) * 512 + h * 128;
    r.K = (const bf16*)(ws + WS_PJ + 5 * PJ_STRIDE) + row0 * 512 + h * 128;
    r.V = (const bf16*)(ws + WS_PJ + 6 * PJ_STRIDE) + row0 * 512 + h * 128;
    r.O = (bf16*)(ws + WS_Y) + (row0 + (size_t)own * 256) * 1024 + 512 + h * 128;
    r.KM = (const float*)(ws + WS_KMP) + (size_t)(bh * 64) * 128;
    r.P0 = own * 256; r.t_lo = __builtin_amdgcn_readfirstlane(pt.t_lo); r.t_hi = __builtin_amdgcn_readfirstlane(pt.t_hi);
    r.OP = slot >= 0 ? (bf16*)(ws + WS_MBPO) + (size_t)(bh * MB_NSLOTS + slot) * (256 * 128) : nullptr;
    r.LSE = slot >= 0 ? (float*)(ws + WS_MBLSE) + (size_t)(bh * MB_NSLOTS + slot) * 256 : nullptr;
    return r;
}
DI int mb_claim(unsigned char* ws, LAS unsigned* word, int tid, int xq) {
    if (tid == 0) *word = __hip_atomic_fetch_add((unsigned*)(ws + WS_CTL) + CW_MBQ + 64 * xq, 1u, __ATOMIC_RELAXED, __HIP_MEMORY_SCOPE_AGENT);
    __syncthreads();
    const int p = __builtin_amdgcn_readfirstlane((int)*word);
    __syncthreads();
    return p;
}
DI void p3_moba_queue(unsigned char* ws, char* lds, LAS unsigned* word, int tid, int xq) {
    constexpr int WBIG = 0x3fffffff, NP = MB_NPARTS * 2;
    int p = mb_claim(ws, word, tid, xq);
    if (p >= NP) return;
    mbref_t cur = mb_ref(ws, p, xq);
    mb::Seam<bf16> S;
    mb::causal_swa_prime<bf16, bf16>(cur, WBIG, lds, S);
#pragma unroll 1
    for (;;) {
        const int pn = mb_claim(ws, word, tid, xq);
        const bool more = pn < NP;
        const mbref_t nxt = more ? mb_ref(ws, pn, xq) : cur;
        mb::causal_swa_block<bf16, bf16>(cur, nxt, SEQ, WBIG, lds, S);
        if (!more) break;
        cur = nxt;
    }
}
DI mbref_t mb_ref_full(unsigned char* ws, int bh, int own_) {
    const int own = __builtin_amdgcn_readfirstlane(own_); const int b = bh >> 2, h = bh & 3; const size_t row0 = (size_t)b * SEQ;
    mbref_t r;
    r.Q = (const bf16*)(ws + WS_PJ + 4 * PJ_STRIDE) + (row0 + (size_t)own * 256) * 512 + h * 128;
    r.K = (const bf16*)(ws + WS_PJ + 5 * PJ_STRIDE) + row0 * 512 + h * 128;
    r.V = (const bf16*)(ws + WS_PJ + 6 * PJ_STRIDE) + row0 * 512 + h * 128;
    r.O = (bf16*)(ws + WS_Y) + (row0 + (size_t)own * 256) * 1024 + 512 + h * 128;
    r.KM = (const float*)(ws + WS_KMP) + (size_t)(bh * 64) * 128;
    r.P0 = own * 256; r.t_lo = 0; r.t_hi = 4 * (own + 1); r.OP = nullptr; r.LSE = nullptr;
    return r;
}
DI void p3_moba_static(unsigned char* ws, char* lds, int bh, int own0, int own1) {
    constexpr int WBIG = 0x3fffffff;
    const int n = own1 >= 0 ? 2 : 1;
    mbref_t cur = mb_ref_full(ws, bh, own0);
    mb::Seam<bf16> S;
    mb::causal_swa_prime<bf16, bf16>(cur, WBIG, lds, S);
#pragma unroll 1
    for (int i = 0; i < n; ++i) {
        const mbref_t nxt = (i + 1 < n) ? mb_ref_full(ws, bh, own1) : cur;
        mb::causal_swa_block<bf16, bf16>(cur, nxt, SEQ, WBIG, lds, S);
        cur = nxt;
    }
}
DI void p4_moba_merge(unsigned char* ws, int it, int tid) {
    const int rh = it & 1, bh = (it >> 1) & 15; const MbSplit sp = MB_SPLITS[it >> 5];
    const int np = __builtin_amdgcn_readfirstlane(sp.nparts);
    const int b = bh >> 2, h = bh & 3, row = rh * 128 + (tid >> 2), qc = tid & 3;
    const float* lse = (const float*)(ws + WS_MBLSE) + (size_t)(bh * MB_NSLOTS + sp.slot0) * 256 + row;
    const bf16* po = (const bf16*)(ws + WS_MBPO) + (size_t)(bh * MB_NSLOTS + sp.slot0) * (256 * 128) + row * 128 + qc * 32;
    float l[3]; v4u w[3][4];
#pragma unroll
    for (int q = 0; q < 3; ++q) {
        const int qq = q < np ? q : 0;
        l[q] = lse[qq * 256];
#pragma unroll
        for (int c8 = 0; c8 < 4; ++c8) w[q][c8] = *(const v4u*)(po + (size_t)qq * (256 * 128) + c8 * 8);
    }
    float mx = -3e38f;
#pragma unroll
    for (int q = 0; q < 3; ++q) { l[q] = q < np ? l[q] : -__builtin_inff(); mx = fmaxf(mx, l[q]); }
    float wsum = 0.f;
#pragma unroll
    for (int q = 0; q < 3; ++q) { l[q] = __builtin_amdgcn_exp2f(l[q] - mx); wsum += l[q]; }
    const float inv = 1.f / wsum;
    bf16* yp = (bf16*)(ws + WS_Y) + ((size_t)b * SEQ + (size_t)sp.own * 256 + row) * 1024 + 512 + h * 128 + qc * 32;
#pragma unroll
    for (int c8 = 0; c8 < 4; ++c8) {
        v4u o;
#pragma unroll
        for (int e = 0; e < 4; ++e) {
            const float a0 = l[0] * bflo(w[0][c8][e]) + l[1] * bflo(w[1][c8][e]) + l[2] * bflo(w[2][c8][e]);
            const float a1 = l[0] * bfhi(w[0][c8][e]) + l[1] * bfhi(w[1][c8][e]) + l[2] * bfhi(w[2][c8][e]);
            o[e] = pk2(a0 * inv, a1 * inv);
        }
        *(v4u*)(yp + c8 * 8) = o;
    }
}

DI void p6_ln_router(const Frame& F, const KA& A) {
    unsigned char* ws = A.W();
    const float* x = A.I(0); const float* g1 = A.I(7); const float* b1 = A.I(8);
    const float* rw1 = A.I(9); const float* rb1 = A.I(10); const float* rw2 = A.I(11); const float* rb2 = A.I(12);
    float* out = A.O(); bf16* HB = (bf16*)(ws + WS_HB); const bf16* MIXB = (const bf16*)(ws + WS_MIXB); (void)out; (void)MIXB;
    int* TOKE = (int*)(ws + WS_TOKE); int* TOKP = (int*)(ws + WS_TOKP); float* TOKW = (float*)(ws + WS_TOKW);
    unsigned* gcnt = (unsigned*)(ws + WS_CTL) + CW_CNT;
    LAS float* rwl = (LAS float*)(F.lds + RING_OFF);
    LAS unsigned* lcnt = (LAS unsigned*)(F.lds + RING_OFF + 81920);
    for (int i = F.tid; i < 1024 * 20; i += NTHR) { const int k = i / 20, li = i % 20;
        rwl[i] = li < 4 ? rw1[k * 4 + li] : rw2[((size_t)((li - 4) >> 2) * DM + k) * 4 + ((li - 4) & 3)]; }
    if (F.tid < 32) lcnt[F.tid] = 0u;
    __syncthreads();
    const int gw = F.vcu * NWAVES + F.wave, NGW = F.G * NWAVES;
#ifdef LN1_FUSE
    for (int m = gw; m < M; m += NGW) {
        const size_t ro = (size_t)m * DM;
        f32x4 v[4];
        float lg[20];
#pragma unroll
        for (int q = 0; q < 20; ++q) lg[q] = 0.f;
#pragma unroll
        for (int j = 0; j < 4; ++j) {
            v[j] = *(const f32x4*)(out + ro + 256 * j + 4 * F.lane);
#pragma unroll
            for (int e = 0; e < 4; ++e) { const LAS float* wr_ = rwl + (256 * j + 4 * F.lane + e) * 20; const float hv = v[j][e];
#pragma unroll
                for (int q4 = 0; q4 < 5; ++q4) { const f32x4 w4 = *(const LAS f32x4*)(wr_ + 4 * q4);
                    lg[4 * q4] += hv * w4.x; lg[4 * q4 + 1] += hv * w4.y; lg[4 * q4 + 2] += hv * w4.z; lg[4 * q4 + 3] += hv * w4.w; } }
        }
#else
    for (int m = gw; m < M; m += NGW) {
        const size_t ro = (size_t)m * DM;
        f32x4 v[4]; float s = 0.f;
#pragma unroll
        for (int j = 0; j < 4; ++j) { const f32x4 xv = *(const f32x4*)(x + ro + 256 * j + 4 * F.lane); const uint2 mr = *(const uint2*)(MIXB + ro + 256 * j + 4 * F.lane);
            v[j].x = xv.x * ALPHA + bflo(mr.x); v[j].y = xv.y * ALPHA + bfhi(mr.x); v[j].z = xv.z * ALPHA + bflo(mr.y); v[j].w = xv.w * ALPHA + bfhi(mr.y); s += (v[j].x + v[j].y) + (v[j].z + v[j].w); }
        const float mean = wave_sum(s) * (1.f / DM); float s2 = 0.f;
#pragma unroll
        for (int j = 0; j < 4; ++j) { v[j] = v[j] - mean; s2 += (v[j].x * v[j].x + v[j].y * v[j].y) + (v[j].z * v[j].z + v[j].w * v[j].w); }
        const float rstd = rsqrtf(wave_sum(s2) * (1.f / DM) + LN_EPS);
        float lg[20];
#pragma unroll
        for (int q = 0; q < 20; ++q) lg[q] = 0.f;
#pragma unroll
        for (int j = 0; j < 4; ++j) {
            const f32x4 gv = *(const f32x4*)(g1 + 256 * j + 4 * F.lane), bv = *(const f32x4*)(b1 + 256 * j + 4 * F.lane);
            v[j] = v[j] * rstd * gv + bv;
            *(unsigned long long*)(HB + ro + 256 * j + 4 * F.lane) = (unsigned long long)pk2(v[j].x, v[j].y) | ((unsigned long long)pk2(v[j].z, v[j].w) << 32);
#pragma unroll
            for (int e = 0; e < 4; ++e) { const LAS float* wr_ = rwl + (256 * j + 4 * F.lane + e) * 20; const float hv = v[j][e];
#pragma unroll
                for (int q4 = 0; q4 < 5; ++q4) { const f32x4 w4 = *(const LAS f32x4*)(wr_ + 4 * q4);
                    lg[4 * q4] += hv * w4.x; lg[4 * q4 + 1] += hv * w4.y; lg[4 * q4 + 2] += hv * w4.z; lg[4 * q4 + 3] += hv * w4.w; } }
        }
#endif
#pragma unroll
        for (int q = 0; q < 20; ++q) lg[q] = wave_sum(lg[q]);
        float pgv[4]; float mx = -3e38f;
#pragma unroll
        for (int g = 0; g < 4; ++g) { pgv[g] = lg[g] + rb1[g]; mx = fmaxf(mx, pgv[g]); }
        float sum = 0.f;
#pragma unroll
        for (int g = 0; g < 4; ++g) { pgv[g] = __expf(pgv[g] - mx); sum += pgv[g]; }
        int gs = 0; float pbest = pgv[0];
#pragma unroll
        for (int g = 1; g < 4; ++g) if (pgv[g] > pbest) { pbest = pgv[g]; gs = g; }
        const float pg = pbest / sum;
        float pe[4]; mx = -3e38f;
#pragma unroll
        for (int e = 0; e < 4; ++e) { float l2 = 0.f;
#pragma unroll
            for (int g = 0; g < 4; ++g) l2 = (g == gs) ? lg[4 + g * 4 + e] + rb2[g * 4 + e] : l2;
            pe[e] = l2; mx = fmaxf(mx, l2); }
#pragma unroll
        for (int e = 0; e < 4; ++e) pe[e] = __expf(pe[e] - mx);
        int e0 = 0; float p0 = pe[0];
#pragma unroll
        for (int e = 1; e < 4; ++e) if (pe[e] > p0) { p0 = pe[e]; e0 = e; }
        int e1 = -1; float p1 = -1.f;
#pragma unroll
        for (int e = 0; e < 4; ++e) if (e != e0 && pe[e] > p1) { p1 = pe[e]; e1 = e; }
        const float den = p0 + p1; const int x0 = gs * 4 + e0, x1 = gs * 4 + e1;
        if (F.lane == 0) {
            const unsigned i0 = __hip_atomic_fetch_add(lcnt + x0, 1u, __ATOMIC_RELAXED, __HIP_MEMORY_SCOPE_WORKGROUP);
            const unsigned i1 = __hip_atomic_fetch_add(lcnt + x1, 1u, __ATOMIC_RELAXED, __HIP_MEMORY_SCOPE_WORKGROUP);
            TOKE[m] = x0 | (x1 << 8); TOKP[2 * m] = (int)i0; TOKP[2 * m + 1] = (int)i1; TOKW[2 * m] = pg * p0 / den; TOKW[2 * m + 1] = pg * p1 / den;
        }
    }
    __syncthreads();
    if (F.tid < 16) lcnt[16 + F.tid] = __hip_atomic_fetch_add(gcnt + F.tid, lcnt[F.tid], __ATOMIC_RELAXED, __HIP_MEMORY_SCOPE_AGENT);
    __syncthreads();
    for (int m = gw; m < M; m += NGW) {
        if (F.lane == 0) { const int ee = TOKE[m]; TOKP[2 * m] += (int)lcnt[16 + (ee & 255)]; TOKP[2 * m + 1] += (int)lcnt[16 + (ee >> 8)]; }
    }
}
DI void moe_tile_table(const Frame& F, unsigned char* ws, LAS int* tb) {
    if (F.tid == 0) { const unsigned* gcnt = (const unsigned*)(ws + WS_CTL) + CW_CNT; int acc = 0;
        for (int e = 0; e < 16; ++e) { tb[e] = acc; acc += (int)((__hip_atomic_load(gcnt + e, __ATOMIC_RELAXED, __HIP_MEMORY_SCOPE_AGENT) + 255u) >> 8); } tb[16] = acc; }
    __syncthreads();
}
DI void p7_permute(const Frame& F, const KA& A) {
    unsigned char* ws = A.W();
    LAS int* tb = (LAS int*)(F.lds + RING_OFF);
    moe_tile_table(F, ws, tb);
    const bf16* HB = (const bf16*)(ws + WS_HB); bf16* HS = (bf16*)(ws + WS_HS);
    const int* TOKE = (const int*)(ws + WS_TOKE); const int* TOKP = (const int*)(ws + WS_TOKP);
    const int gw = F.vcu * NWAVES + F.wave, NGW = F.G * NWAVES;
    for (int it = gw; it < 2 * M; it += NGW) {
        const int m = it >> 1, k = it & 1; const int ee = TOKE[m]; const int e = k ? (ee >> 8) : (ee & 255);
        const size_t row = (size_t)tb[e] * 256 + TOKP[it];
        const v4u a0 = *(const v4u*)(HB + (size_t)m * DM + 8 * F.lane), a1 = *(const v4u*)(HB + (size_t)m * DM + 512 + 8 * F.lane);
        *(v4u*)(HS + row * DM + 8 * F.lane) = a0; *(v4u*)(HS + row * DM + 512 + 8 * F.lane) = a1;
    }
}
DI void p10_combine(const Frame& F, const KA& A) {
    unsigned char* ws = A.W();
    LAS int* tb = (LAS int*)(F.lds + RING_OFF);
    moe_tile_table(F, ws, tb);
    const float* g2 = A.I(16); const float* b2 = A.I(17); float* out = A.O();
    const bf16* Y2 = (const bf16*)(ws + WS_Y2);
    const bf16* HBc = (const bf16*)(ws + WS_HB); (void)HBc;
    const int* TOKE = (const int*)(ws + WS_TOKE); const int* TOKP = (const int*)(ws + WS_TOKP); const float* TOKW = (const float*)(ws + WS_TOKW);
    const int gw = F.vcu * NWAVES + F.wave, NGW = F.G * NWAVES;
    for (int m = gw; m < M; m += NGW) {
        const size_t ro = (size_t)m * DM; const int ee = TOKE[m];
        const size_t r0 = (size_t)tb[ee & 255] * 256 + TOKP[2 * m], r1 = (size_t)tb[ee >> 8] * 256 + TOKP[2 * m + 1];
        const float w0 = TOKW[2 * m], w1 = TOKW[2 * m + 1];
        f32x4 v[4]; float s = 0.f;
#pragma unroll
        for (int j = 0; j < 4; ++j) {
#ifdef LN1_FUSE
            const f32x4 hv = *(const f32x4*)(out + ro + 256 * j + 4 * F.lane);
#else
            const uint2 hr = *(const uint2*)(HBc + ro + 256 * j + 4 * F.lane); const f32x4 hv = {bflo(hr.x), bfhi(hr.x), bflo(hr.y), bfhi(hr.y)};
#endif
            const uint2 ya = *(const uint2*)(Y2 + r0 * DM + 256 * j + 4 * F.lane), yb = *(const uint2*)(Y2 + r1 * DM + 256 * j + 4 * F.lane);
            v[j].x = ALPHA * hv.x + w0 * bflo(ya.x) + w1 * bflo(yb.x); v[j].y = ALPHA * hv.y + w0 * bfhi(ya.x) + w1 * bfhi(yb.x);
            v[j].z = ALPHA * hv.z + w0 * bflo(ya.y) + w1 * bflo(yb.y); v[j].w = ALPHA * hv.w + w0 * bfhi(ya.y) + w1 * bfhi(yb.y);
            s += (v[j].x + v[j].y) + (v[j].z + v[j].w);
        }
        const float mean = wave_sum(s) * (1.f / DM); float s2 = 0.f;
#pragma unroll
        for (int j = 0; j < 4; ++j) { v[j] = v[j] - mean; s2 += (v[j].x * v[j].x + v[j].y * v[j].y) + (v[j].z * v[j].z + v[j].w * v[j].w); }
        const float rstd = rsqrtf(wave_sum(s2) * (1.f / DM) + LN_EPS);
#pragma unroll
        for (int j = 0; j < 4; ++j) { const f32x4 gv = *(const f32x4*)(g2 + 256 * j + 4 * F.lane), bv = *(const f32x4*)(b2 + 256 * j + 4 * F.lane);
            f32x4 ov = v[j] * rstd * gv + bv;
            *(f32x4*)(out + ro + 256 * j + 4 * F.lane) = ov; }
    }
}

#ifndef DUP_P0
#define DUP_P0 1
#endif
#ifndef DUP_P1
#define DUP_P1 1
#endif
#ifndef DUP_P2
#define DUP_P2 1
#endif
#ifndef DUP_P3
#define DUP_P3 1
#endif
#ifndef DUP_P5
#define DUP_P5 1
#endif
#ifndef DUP_P7
#define DUP_P7 1
#endif
#ifndef DUP_P8
#define DUP_P8 1
#endif
#ifndef DUP_P9
#define DUP_P9 1
#endif
#ifdef SKIP_N2B
#define n2b_dn_recurrent(...) ((void)0)
#endif
#ifdef SKIP_N3B
#define n3b_moba_naive(...) ((void)0)
#endif
#ifdef SKIP_N5
#define n5_token_tail(...) ((void)0)
#endif
#ifdef SKIP_P0
#define p0_prologue(...) ((void)0)
#endif
#ifdef SKIP_N2A
#define n2a_conv_norm(...) ((void)0)
#endif
#ifdef SKIP_N3A
#define n3a_rope(...) ((void)0)
#endif
#ifdef SKIP_N2C
#define n2c_dn_gate(...) ((void)0)
#endif
#if defined(DBG_MOBA) || defined(DBG_DN)
#define DBG_ANY 1
#endif
#ifdef MOE_NAIVE
constexpr int N_PHASES = 7;
#else
constexpr int N_PHASES = 11;
#endif
__global__ void __launch_bounds__(NTHR, 2) mk_fwd(Args args_unused) {
    (void)args_unused;
    extern __shared__ __attribute__((aligned(16))) unsigned char lds[];
    Frame F;
    F.lds = (LAS unsigned char*)lds;
    F.tid = threadIdx.x; F.lane = F.tid & 63; F.wave = __builtin_amdgcn_readfirstlane(F.tid >> 6);
    F.G = gridDim.x; { const int bx = blockIdx.x; F.vcu = (F.G % 8 == 0) ? (bx % 8) * (F.G / 8) + bx / 8 : bx; }
    unsigned char* ws = kargs().W();
    gu32* ctl = (gu32*)(ws + WS_CTL);
    volatile LAS unsigned* MISC = (volatile LAS unsigned*)(F.lds + MISC_OFF);
    for (int u = F.tid; u < (LDS_BYTES - LDSCTL_OFF) / 4; u += NTHR) ((LAS unsigned*)(F.lds + LDSCTL_OFF))[u] = 0u;
    __syncthreads();
    const int lo = kargs().lo(), hi = kargs().hi();
    const bool multi = (hi - lo) > 1;
    XcdBarrier bar; bar.bar = (unsigned*)(ctl + CW_BAR); bar.x = 0; bar.st = nullptr;
    if (multi) bar = xcd_barrier_post((unsigned*)(ctl + CW_BAR), MISC + 8);
#define IN(k) (lo <= (k) && (k) < hi)
#define REFRESH_F() do { int t_ = threadIdx.x; asm volatile("" : "+v"(t_)); F.tid = t_; F.lane = t_ & 63; F.wave = __builtin_amdgcn_readfirstlane(t_ >> 6); } while (0)
#define SEAM(k) do { if (IN(k) && IN((k) + 1)) xcd_barrier(bar); } while (0)

    if (IN(0)) { REFRESH_F(); for (int rep_ = 0; rep_ < DUP_P0; ++rep_) { const KA args = kargs(); p0_prologue(F, args); __syncthreads(); } SEAM(0); }
    if (IN(1)) { REFRESH_F(); for (int rep_ = 0; rep_ < DUP_P1; ++rep_) {
        pg8::Gemm g{(const bf16*)(ws + WS_XB), (const bf16*)(ws + WS_WIN), M, NPROJ, DM}; pg8::StaticOrder S; S.init(M, NPROJ, F.G, (int)blockIdx.x);
        pg8::EpiBf16<0> E{(bf16*)(ws + WS_PJ), 512, nullptr, 512, (size_t)(PJ_STRIDE / 2), 1.f};
        pg8::gemm_phase<pg8::EpiBf16<0>, pg8::StaticOrder, PG8_ALIGN, PG8_SP2>(F.lds + RING_OFF, g, S, E); }
        SEAM(1);
    }
    if (IN(2)) { REFRESH_F();
        const KA args = kargs();
#if defined(DN_NAIVE) || defined(DBG_DN)
        n2a_conv_norm(F, args);
#endif
#ifndef DN_NAIVE
        for (int rep_ = 0; rep_ < DUP_P2; ++rep_) for (int it = F.vcu; it < 1024; it += F.G)
            dn::chunk_local(F.lds, it, (const bf16*)(ws + WS_PJ), PJ_STRIDE / 2, (const float*)(ws + WS_GATES), args.I(2), args.I(3), args.I(4),
                            (unsigned char*)args.O(), ws + WS_UF, (float*)(ws + WS_GL));
#endif
        n3a_rope(F, args); SEAM(2); }
    if (IN(3)) { REFRESH_F();
        const KA args = kargs();
#ifdef DN_NAIVE
        float* ODN = args.O();
#else
        float* ODN = (float*)(ws + WS_PJ);
#endif
        {
            const int v = F.vcu;
            const int bh = __builtin_amdgcn_readfirstlane(v >> 4), r = __builtin_amdgcn_readfirstlane(v & 15);
            if (r == 15 && v < 256) {
#if defined(DN_NAIVE) || defined(DBG_DN)
                n2b_dn_recurrent(F, args, bh, ODN);
#endif
#ifndef DN_NAIVE
                dn::scan_bh(F.lds, bh, (const unsigned char*)args.O(), ws + WS_UF, (const float*)(ws + WS_GL), ws + WS_SF, ws + WS_VF);
#endif
            }
#ifdef MB_QUEUE
            p3_moba_queue(ws, (char*)lds, (LAS unsigned*)(F.lds + LDSCTL_OFF + 640), F.tid, __builtin_amdgcn_readfirstlane((v >> 5) & 7));
#else
            if (r != 15) p3_moba_static(ws, (char*)lds, bh, 15 - r, r == 14 ? 0 : -1);
#endif
        }
        SEAM(3);
    }
    if (IN(4)) { REFRESH_F(); const KA args = kargs();
#ifdef DN_NAIVE
        n2c_dn_gate(F, args, args.O(), (bf16*)(ws + WS_Y), 1024);
#else
        for (int it = F.vcu; it < 512; it += F.G)
            dn::chunk_out(F.lds, it, (const unsigned char*)args.O(), ws + WS_SF, ws + WS_VF, (const bf16*)(ws + WS_PJ + 3 * PJ_STRIDE), args.I(5), (bf16*)(ws + WS_Y));
#endif
#ifdef MB_QUEUE
        for (int it = F.vcu; it < MB_NSPLIT * 32; it += F.G) p4_moba_merge(ws, it, F.tid);
#endif
        SEAM(4); }
    if (IN(5)) { REFRESH_F();
        const KA args = kargs();
        pg8::Gemm g{(const bf16*)(ws + WS_Y), (const bf16*)(ws + WS_WOUT), M, DM, DM}; pg8::StaticOrder S; S.init(M, DM, F.G, (int)blockIdx.x);
#if defined(MOE_NAIVE)
        pg8::EpiF32 E{args.O(), DM};
        for (int rep_ = 0; rep_ < DUP_P5; ++rep_) pg8::gemm_phase<pg8::EpiF32, pg8::StaticOrder, PG8_ALIGN, PG8_SP2>(F.lds + RING_OFF, g, S, E);
#elif !defined(LN1_FUSE)
        pg8::EpiBf16<0> E{(bf16*)(ws + WS_MIXB), DM, nullptr, 0, 0, 1.f};
        pg8::gemm_phase<pg8::EpiBf16<0>, pg8::StaticOrder, PG8_ALIGN, PG8_SP2>(F.lds + RING_OFF, g, S, E);
#else
        if (F.G == 256) {
            pg8::PanelStats st{(unsigned*)(ws + WS_XBUF), (unsigned*)(ws + WS_CTL) + CW_SEAM, (unsigned*)(ws + WS_CTL), DM / 256, LN_EPS, 0x740u};
            pg8::EpiLn1 E{args.I(0), args.O(), (bf16*)(ws + WS_HB), args.I(7), args.I(8), ALPHA, st, 0u};
            pg8::gemm_phase<pg8::EpiLn1, pg8::StaticOrder, false, PG8_SP2>(F.lds + RING_OFF, g, S, E);
        }
#endif
        SEAM(5);
    }
#ifdef MOE_NAIVE
    if (IN(6)) { REFRESH_F(); const KA args = kargs(); n5_token_tail(F, args); }
#else
    if (IN(6)) { REFRESH_F(); const KA args = kargs(); p6_ln_router(F, args); SEAM(6); }
    if (IN(7)) { REFRESH_F(); for (int rep_ = 0; rep_ < DUP_P7; ++rep_) { const KA args = kargs(); p7_permute(F, args); __syncthreads(); } SEAM(7); }
    if (IN(8)) { REFRESH_F();
        LAS int* tb = (LAS int*)(F.lds + LDSCTL_OFF + 512); moe_tile_table(F, ws, tb);
        pg8::Gemm g{(const bf16*)(ws + WS_HS), (const bf16*)(ws + WS_WGU), 36864, 512, DM}; pg8::MoeOrder S{(const LAS int*)tb, 2, F.G, (int)blockIdx.x, (size_t)512 * DM * 2};
        pg8::EpiSwiGLU E{(bf16*)(ws + WS_HE)};
        for (int rep_ = 0; rep_ < DUP_P8; ++rep_) pg8::gemm_phase<pg8::EpiSwiGLU, pg8::MoeOrder, PG8_ALIGN, PG8_SP2>(F.lds + RING_OFF, g, S, E);
        SEAM(8);
    }
    if (IN(9)) { REFRESH_F();
        LAS int* tb = (LAS int*)(F.lds + LDSCTL_OFF + 512); moe_tile_table(F, ws, tb);
        int kdim = DE; asm volatile("" : "+s"(kdim));
        pg8::Gemm g{(const bf16*)(ws + WS_HE), (const bf16*)(ws + WS_WD), 36864, DM, kdim}; pg8::MoeOrder S{(const LAS int*)tb, 4, F.G, (int)blockIdx.x, (size_t)DM * DE * 2};
        pg8::EpiBf16<0> E{(bf16*)(ws + WS_Y2), DM, nullptr, 0, 0, 1.f};
        for (int rep_ = 0; rep_ < DUP_P9; ++rep_) pg8::gemm_phase<pg8::EpiBf16<0>, pg8::MoeOrder, PG8_ALIGN, PG8_SP2>(F.lds + RING_OFF, g, S, E);
        SEAM(9);
    }
    if (IN(10)) { REFRESH_F(); const KA args = kargs(); p10_combine(F, args); }
#endif
#undef IN
#undef SEAM
}

extern "C" void kernel_launch(void* const* d_in, const int* in_sizes, int n_in, void* d_out, int out_size, void* d_ws, size_t ws_size, hipStream_t stream) {
    static int grid = 0;
    if (grid == 0) {
        if (n_in != 18 || in_sizes[0] != M * DM || out_size != M * DM || ws_size < WS_END) { fprintf(stderr, "kernel_launch: unexpected shapes (n_in %d, in0 %d, out %d, ws %zu)\n", n_in, n_in > 0 ? in_sizes[0] : -1, out_size, ws_size); grid = -1; return; }
        int dev = 0, cus = 0;
        if (hipGetDevice(&dev) != hipSuccess || hipDeviceGetAttribute(&cus, hipDeviceAttributeMultiprocessorCount, dev) != hipSuccess) { grid = -1; return; }
        if (hipFuncSetAttribute((const void*)mk_fwd, hipFuncAttributeMaxDynamicSharedMemorySize, LDS_BYTES) != hipSuccess) { fprintf(stderr, "kernel_launch: hipFuncSetAttribute failed\n"); grid = -1; return; }
        int per_cu = 0;
        if (hipOccupancyMaxActiveBlocksPerMultiprocessor(&per_cu, (const void*)mk_fwd, NTHR, LDS_BYTES) != hipSuccess || per_cu < 1) fprintf(stderr, "kernel_launch: occupancy query says %d\n", per_cu);
        (void)hipGetLastError();
        grid = cus;
    }
    if (grid < 0) return;
    (void)hipMemsetAsync((char*)d_ws + WS_CTL, 0, CTL_ZERO_BYTES, stream);
    Args a{};
    for (int i = 0; i < 18; ++i) a.in_[i] = (const GAS float*)d_in[i];
    a.out_ = (GAS float*)d_out; a.ws_ = (GAS unsigned char*)d_ws;
#ifndef MK_PER_PHASE
    a.ph_lo = 0; a.ph_hi = N_PHASES;
    hipLaunchKernelGGL(mk_fwd, dim3(grid), dim3(NTHR), LDS_BYTES, stream, a);
#else
    for (int p = 0; p < N_PHASES; ++p) { a.ph_lo = p; a.ph_hi = p + 1; hipLaunchKernelGGL(mk_fwd, dim3(grid), dim3(NTHR), LDS_BYTES, stream, a); }
#endif
}
```

```cpp
#define MB_PIPE 1
#define MB_QUEUE 1
#include <hip/hip_runtime.h>
#include <cstdio>
#include <cstdint>
#include <cstddef>
namespace pg8 {
#define PG8_LAS __attribute__((address_space(3)))
typedef unsigned short bf16_t;
typedef short bf16x8 __attribute__((ext_vector_type(8)));
typedef float f32x4 __attribute__((ext_vector_type(4)));
typedef unsigned u32x4 __attribute__((ext_vector_type(4)));
__device__ __forceinline__ void st16_wt(void* p, u32x4 v) {
#ifdef WT_STORES
    asm volatile("global_store_dwordx4 %0, %1, off sc1\n\ts_nop 1" :: "v"((__attribute__((address_space(1))) void*)p), "v"(v) : "memory");
#else
    *(u32x4*)p = v;
#endif
}
constexpr int BM = 256, BK = 64, HALF = 128, HTB = HALF * BK * 2  , STAGE_BYTES = 8 * HTB, NXCD = 8, WGM = 8;

__host__ __device__ __forceinline__ int lds_byte(int r, int c) { const int st = (r >> 4) * 2 + (c >> 5), rr = r & 15, cc = c & 31, ob = rr * 64 + cc * 2; return st * 1024 + (ob ^ (((ob >> 9) & 1) << 5)); }
__host__ __device__ __forceinline__ void stage_rc(int b, int& R, int& C) { const int st = b / 1024, sb = b % 1024, swz = sb ^ (((sb >> 9) & 1) << 5); R = (st >> 1) * 16 + swz / 64; C = (st & 1) * 32 + (swz % 64) / 2; }
__host__ __device__ __forceinline__ int perm32(int rho) { const int n = rho >> 4, i = rho & 15; return 8 * (i >> 2) + 4 * n + (i & 3); }

struct Unit { int pm, pn; };
struct Gemm { const bf16_t* A; const bf16_t* Bt; int M, N, K; };

struct StaticOrder {
    int nM, nN, nwg, G, c;
    __host__ __device__ void init(int M, int N, int G_, int c_) { nM = M / BM; nN = N / BM; nwg = nM * nN; G = G_; c = c_; }
    __host__ __device__ bool next(int i, Unit& u) const {
        const long L = (long)i * G + c; if (L >= nwg) return false;
        int wgid = (int)L; { const int q = nwg / NXCD, r = nwg % NXCD, xcd = wgid % NXCD, off = wgid / NXCD; wgid = (xcd < r ? xcd * (q + 1) : r * (q + 1) + (xcd - r) * q) + off; }
        const int nig = WGM * nN, gid = wgid / nig, fm = gid * WGM, gsz = (nM - fm) < WGM ? (nM - fm) : WGM;
        u.pm = fm + ((wgid % nig) % gsz); u.pn = (wgid % nig) / gsz; return true;
    }
    __device__ __forceinline__ void a_ready(const Unit&) const {}
    __device__ __forceinline__ void done(const Unit&) const {}
    __device__ __forceinline__ size_t bofs(const Unit&) const { return 0; }
    static constexpr bool GATHER = false;
    __device__ __forceinline__ int arow(const Unit&, int) const { return 0; }
};

__device__ __forceinline__ unsigned cvt_pk_bf16(float lo, float hi) { unsigned r; asm volatile("v_cvt_pk_bf16_f32 %0, %1, %2" : "=v"(r) : "v"(lo), "v"(hi)); return r; }
typedef float f32x2 __attribute__((ext_vector_type(2)));
__device__ __forceinline__ f32x2 gelu_pk(f32x2 v) {
    const f32x2 av = __builtin_elementwise_abs(v), d = av * 0.2316418882f + 1.0f;
    f32x2 t; t.x = __builtin_amdgcn_rcpf(d.x); t.y = __builtin_amdgcn_rcpf(d.y);
    f32x2 q = t * 0.5307027145f + (-0.7265760135f); q = q * t + 0.7107068705f; q = q * t + (-0.142248368f); q = q * t + 0.127414796f; q = q * t;
    const f32x2 s = (v * v) * (-0.72134752044f);
    f32x2 e; e.x = __builtin_amdgcn_exp2f(s.x); e.y = __builtin_amdgcn_exp2f(s.y);
    const f32x2 m = v * (q * e), r = v - m;
    f32x2 o; o.x = v.x < 0.f ? m.x : r.x; o.y = v.y < 0.f ? m.y : r.y; return o;
}

template <int ACT  > struct EpiBf16 {
    static constexpr bool PERM = true, AFTER_DRAIN = false; static_assert(ACT == 0 || ACT == 1, "EpiBf16: ACT is 0 (none) or 1 (gelu_pk)");
    bf16_t* O; int ldc; const float* bias; int split_cols; size_t split_stride; float scale0;
    __device__ __forceinline__ void operator()(const f32x4 (&acc)[2][2][4][2], const Unit& u, int wr, int wc, int fr, int fq) const {
        const int row0 = u.pm * BM + wr * 64 + fr; int colt = u.pn * BM; bf16_t* base = O;
        float sc = 1.f; if (split_cols) { const int t = colt / split_cols; base += (size_t)t * split_stride; colt -= t * split_cols; if (t == 0) sc = scale0; }
        const int col0 = colt + wc * 32 + 8 * fq, bcol0 = u.pn * BM + wc * 32 + 8 * fq;
        f32x4 bv[2][2];
#pragma unroll
        for (int bj = 0; bj < 2; ++bj)
#pragma unroll
            for (int n = 0; n < 2; ++n) bv[bj][n] = bias ? *(const f32x4*)(bias + bcol0 + bj * HALF + 4 * n) : (f32x4){0.f, 0.f, 0.f, 0.f};
#pragma unroll
        for (int ai = 0; ai < 2; ++ai)
#pragma unroll
            for (int m = 0; m < 4; ++m) { bf16_t* rowp = base + (size_t)(row0 + ai * HALF + m * 16) * ldc + col0;
#pragma unroll
                for (int bj = 0; bj < 2; ++bj) { f32x4 v0 = acc[ai][bj][m][0] + bv[bj][0], v1 = acc[ai][bj][m][1] + bv[bj][1];
                    if (ACT == 1) { f32x2 a = gelu_pk((f32x2){v0[0], v0[1]}), b = gelu_pk((f32x2){v0[2], v0[3]}), c = gelu_pk((f32x2){v1[0], v1[1]}), d = gelu_pk((f32x2){v1[2], v1[3]});
                        v0 = (f32x4){a.x, a.y, b.x, b.y}; v1 = (f32x4){c.x, c.y, d.x, d.y}; }
                    v0 = v0 * sc; v1 = v1 * sc; u32x4 w; w.x = cvt_pk_bf16(v0[0], v0[1]); w.y = cvt_pk_bf16(v0[2], v0[3]); w.z = cvt_pk_bf16(v1[0], v1[1]); w.w = cvt_pk_bf16(v1[2], v1[3]);
                    st16_wt(rowp + bj * HALF, w); } }
    }
};

struct PanelStats {
    unsigned* xbuf;
    unsigned* cnt;
    unsigned* tmo;
    int ntn; float eps;
    unsigned code;
    __device__ __forceinline__ bool run(const f32x4 (&v)[2][2][4][2], const Unit& u, int wr, int wc, int fr, int fq, PG8_LAS unsigned char* lds, int wid, int lane) const {
        typedef float f32x2v __attribute__((ext_vector_type(2)));
        PG8_LAS f32x2v* P = (PG8_LAS f32x2v*)lds;
        PG8_LAS f32x2v* S = (PG8_LAS f32x2v*)(lds + 8192);
        PG8_LAS unsigned* flag = (PG8_LAS unsigned*)(lds + 8192 + 2048);
#pragma unroll
        for (int ai = 0; ai < 2; ++ai)
#pragma unroll
            for (int m = 0; m < 4; ++m) {
                float s = 0.f;
#pragma unroll
                for (int bj = 0; bj < 2; ++bj)
#pragma unroll
                    for (int n = 0; n < 2; ++n) { const f32x4 x = v[ai][bj][m][n]; s += (x[0] + x[1]) + (x[2] + x[3]); }
                s += __shfl_xor(s, 16); s += __shfl_xor(s, 32);
                const float mw = s * (1.0f / 64.0f); float q = 0.f;
#pragma unroll
                for (int bj = 0; bj < 2; ++bj)
#pragma unroll
                    for (int n = 0; n < 2; ++n) { const f32x4 d = v[ai][bj][m][n] - mw; q += (d[0] * d[0] + d[1] * d[1]) + (d[2] * d[2] + d[3] * d[3]); }
                q += __shfl_xor(q, 16); q += __shfl_xor(q, 32);
                if (fq == 0) P[(ai * HALF + wr * 64 + m * 16 + fr) * 4 + wc] = (f32x2v){mw, q};
            }
        asm volatile("s_waitcnt lgkmcnt(0)" ::: "memory"); __builtin_amdgcn_s_barrier(); asm volatile("" ::: "memory");
#if defined(BROKEN_EXCHANGE_NO_WAIT)
#warning BROKEN CONTROL BUILD: the row-statistics exchange does not wait; results are wrong by design
        if (blockIdx.x >= 64) { const long long t0_ = clock64(); while (clock64() - t0_ < 60000) __builtin_amdgcn_s_sleep(8); }
#endif
        const int row = wid * 32 + (lane & 31);
        if (lane < 32) {
            const f32x2v a = P[row * 4 + 0], b = P[row * 4 + 1], c = P[row * 4 + 2], d = P[row * 4 + 3];
            const float mt = (a.x + b.x + c.x + d.x) * 0.25f;
            const float da = a.x - mt, db = b.x - mt, dc = c.x - mt, dd = d.x - mt;
            const float m2 = (a.y + b.y) + (c.y + d.y) + 64.0f * ((da * da + db * db) + (dc * dc + dd * dd));
            unsigned long long* slot = (unsigned long long*)xbuf + ((size_t)(u.pm * BM + row) * 4 + u.pn);
            __hip_atomic_store(slot, ((unsigned long long)__float_as_uint(m2) << 32) | __float_as_uint(mt), __ATOMIC_RELAXED, __HIP_MEMORY_SCOPE_AGENT);
        }
        asm volatile("s_waitcnt vmcnt(0)" ::: "memory");
        if (lane == 0) __hip_atomic_fetch_add(cnt + 64 * u.pm, 1u, __ATOMIC_RELAXED, __HIP_MEMORY_SCOPE_AGENT);
        if (wid == 0) {
            bool dead = false; const unsigned long long t0 = __builtin_amdgcn_s_memrealtime(); const unsigned want = 8u * (unsigned)ntn;
            for (;;) {
#if defined(BROKEN_EXCHANGE_NO_WAIT)
                break;
#endif
                if ((unsigned)__builtin_amdgcn_readfirstlane(__hip_atomic_load(cnt + 64 * u.pm, __ATOMIC_RELAXED, __HIP_MEMORY_SCOPE_AGENT)) >= want) break;
                if (__builtin_amdgcn_s_memrealtime() - t0 > 2000000ull) {
                    if (lane == 0) { unsigned expect = 0u; __hip_atomic_compare_exchange_strong(tmo + 1, &expect, code | (unsigned)(u.pm & 0xff), __ATOMIC_RELAXED, __ATOMIC_RELAXED, __HIP_MEMORY_SCOPE_AGENT);
                                     __hip_atomic_store(tmo, 1u, __ATOMIC_RELAXED, __HIP_MEMORY_SCOPE_AGENT); }
                    dead = true; break; }
                __builtin_amdgcn_s_sleep(2);
            }
            __builtin_amdgcn_fence(__ATOMIC_ACQUIRE, "agent");
            if (lane == 0) flag[0] = dead ? 1u : 0u;
        }
        asm volatile("s_waitcnt vmcnt(0) lgkmcnt(0)" ::: "memory"); __builtin_amdgcn_s_barrier(); asm volatile("" ::: "memory");
        const bool bad = flag[0] != 0u;
        if (lane < 32) {
            const unsigned long long* slot = (const unsigned long long*)xbuf + (size_t)(u.pm * BM + row) * 4; float mt[4], m2[4]; float ms = 0.f;
#pragma unroll
            for (int t = 0; t < 4; ++t) { if (t < ntn) { const unsigned long long w = __hip_atomic_load(slot + t, __ATOMIC_RELAXED, __HIP_MEMORY_SCOPE_AGENT); mt[t] = __uint_as_float((unsigned)w); m2[t] = __uint_as_float((unsigned)(w >> 32)); } else { mt[t] = 0.f; m2[t] = 0.f; } ms += mt[t]; }
            const float mean = ms / (float)ntn; float q = 0.f;
#pragma unroll
            for (int t = 0; t < 4; ++t) if (t < ntn) { const float dm = mt[t] - mean; q += m2[t] + 256.0f * dm * dm; }
            S[row] = (f32x2v){mean, 1.0f / sqrtf(q / (256.0f * (float)ntn) + eps)};
        }
        asm volatile("s_waitcnt lgkmcnt(0)" ::: "memory"); __builtin_amdgcn_s_barrier(); asm volatile("" ::: "memory");
        return bad;
    }
};
struct EpiLnRes {
    static constexpr bool PERM = false, AFTER_DRAIN = true;
    const float* base; float* out; int ldc; const float* bias; PanelStats st; unsigned poison;
    __device__ __forceinline__ void fused(f32x4 (&acc)[2][2][4][2], const Unit& u, int wr, int wc, int fr, int fq, PG8_LAS unsigned char* lds, int wid, int lane) const {
        typedef float f32x2v __attribute__((ext_vector_type(2)));
        const PG8_LAS f32x2v* S = (const PG8_LAS f32x2v*)(lds + 8192);
        const int col0 = u.pn * BM + wc * 32 + 4 * fq;
#pragma unroll
        for (int bj = 0; bj < 2; ++bj)
#pragma unroll
            for (int n = 0; n < 2; ++n) { const f32x4 bv = bias ? *(const f32x4*)(bias + col0 + bj * HALF + n * 16) : (f32x4){0.f, 0.f, 0.f, 0.f};
#pragma unroll
                for (int ai = 0; ai < 2; ++ai)
#pragma unroll
                    for (int m = 0; m < 4; ++m) acc[ai][bj][m][n] += bv; }
        f32x4 pre[4][2][2];
#pragma unroll
        for (int m = 0; m < 4; ++m) { const size_t off = (size_t)(u.pm * BM + wr * 64 + m * 16 + fr) * ldc + col0;
#pragma unroll
            for (int bj = 0; bj < 2; ++bj)
#pragma unroll
                for (int n = 0; n < 2; ++n) pre[m][bj][n] = *(const f32x4*)(base + off + bj * HALF + n * 16); }
        const bool bad = st.run(acc, u, wr, wc, fr, fq, lds, wid, lane) || poison != 0u;
        const float qnan = __builtin_nanf("");
#pragma unroll
        for (int ai = 0; ai < 2; ++ai)
#pragma unroll
            for (int m = 0; m < 4; ++m) { const int r = ai * HALF + wr * 64 + m * 16 + fr; const f32x2v sr = S[r]; const size_t off = (size_t)(u.pm * BM + r) * ldc + col0;
#pragma unroll
                for (int bj = 0; bj < 2; ++bj)
#pragma unroll
                    for (int n = 0; n < 2; ++n) { const f32x4 bs = ai == 0 ? pre[m][bj][n] : *(const f32x4*)(base + off + bj * HALF + n * 16); f32x4 o = bs + (acc[ai][bj][m][n] - sr.x) * sr.y;
                        if (bad) o = (f32x4){qnan, qnan, qnan, qnan}; *(f32x4*)(out + off + bj * HALF + n * 16) = o; }
                if (m & 1) asm volatile("" ::: "memory"); }
    }
};
struct EpiLnResLn {
    static constexpr bool PERM = false, AFTER_DRAIN = true;
    const float* base; float* out; bf16_t* xn; int ldc; const float* bias; PanelStats st1, st2; unsigned poison;
    __device__ __forceinline__ void fused(f32x4 (&acc)[2][2][4][2], const Unit& u, int wr, int wc, int fr, int fq, PG8_LAS unsigned char* lds, int wid, int lane) const {
        typedef float f32x2v __attribute__((ext_vector_type(2))); typedef unsigned u32x2v __attribute__((ext_vector_type(2)));
        const PG8_LAS f32x2v* S = (const PG8_LAS f32x2v*)(lds + 8192);
        const int col0 = u.pn * BM + wc * 32 + 4 * fq;
#pragma unroll
        for (int bj = 0; bj < 2; ++bj)
#pragma unroll
            for (int n = 0; n < 2; ++n) { const f32x4 bv = bias ? *(const f32x4*)(bias + col0 + bj * HALF + n * 16) : (f32x4){0.f, 0.f, 0.f, 0.f};
#pragma unroll
                for (int ai = 0; ai < 2; ++ai)
#pragma unroll
                    for (int m = 0; m < 4; ++m) acc[ai][bj][m][n] += bv; }
        bool bad = st1.run(acc, u, wr, wc, fr, fq, lds, wid, lane) || poison != 0u;
        const float qnan = __builtin_nanf("");
#pragma unroll
        for (int ai = 0; ai < 2; ++ai)
#pragma unroll
            for (int m = 0; m < 4; ++m) { const int r = ai * HALF + wr * 64 + m * 16 + fr; const f32x2v sr = S[r]; const size_t off = (size_t)(u.pm * BM + r) * ldc + col0;
#pragma unroll
                for (int bj = 0; bj < 2; ++bj)
#pragma unroll
                    for (int n = 0; n < 2; ++n) { const f32x4 bs = *(const f32x4*)(base + off + bj * HALF + n * 16); acc[ai][bj][m][n] = bs + (acc[ai][bj][m][n] - sr.x) * sr.y; }
                asm volatile("" : "+v"(acc[ai][0][m][0]), "+v"(acc[ai][0][m][1]), "+v"(acc[ai][1][m][0]), "+v"(acc[ai][1][m][1]));
                if (m & 1) asm volatile("" ::: "memory"); }
        const bool bad1 = bad;
        bad = st2.run(acc, u, wr, wc, fr, fq, lds, wid, lane) || bad;
#pragma unroll
        for (int ai = 0; ai < 2; ++ai)
#pragma unroll
            for (int m = 0; m < 4; ++m) { const int r = ai * HALF + wr * 64 + m * 16 + fr; const f32x2v sr = S[r]; const size_t off = (size_t)(u.pm * BM + r) * ldc + col0;
#pragma unroll
                for (int bj = 0; bj < 2; ++bj)
#pragma unroll
                    for (int n = 0; n < 2; ++n) { const f32x4 x1 = acc[ai][bj][m][n]; *(f32x4*)(out + off + bj * HALF + n * 16) = bad1 ? (f32x4){qnan, qnan, qnan, qnan} : x1;
                        const f32x4 o = (x1 - sr.x) * sr.y; u32x2v w; w.x = cvt_pk_bf16(o[0], o[1]); w.y = cvt_pk_bf16(o[2], o[3]);
                        if (bad) { w.x = 0x7fc07fc0u; w.y = 0x7fc07fc0u; } *(u32x2v*)(xn + off + bj * HALF + n * 16) = w; }
                asm volatile("" ::: "memory"); }
    }
};

template <class Epi, class Sched, bool ALIGN_EPI = false, bool SP2 = false>
__device__ __forceinline__ void gemm_phase(PG8_LAS unsigned char* lds, const Gemm g, const Sched& S, const Epi& E) {
    const int tid = threadIdx.x, wid = __builtin_amdgcn_readfirstlane(tid >> 6), lane = tid & 63, wr = wid >> 2, wc = wid & 3, fr = lane & 15, fq = lane >> 4;
    const int K = g.K, nt = K / BK;
    unsigned voffA[2], voffB[2];
    unsigned cvo[2][2], nvo[2][2];
    int RA[2], CA[2];
#pragma unroll
    for (int i = 0; i < 2; ++i) { int R, C; stage_rc(tid * 16 + i * 8192, R, C); const int Rb = Epi::PERM ? ((R & ~31) + perm32(R & 31)) : R;
        voffA[i] = (unsigned)(R * K + C) * 2u; voffB[i] = (unsigned)(Rb * K + C) * 2u; RA[i] = R; CA[i] = C; }
    const size_t kstep = (size_t)(BK * 2);
    const size_t hstep = (size_t)HALF * K * 2;
    const size_t tstep = 2 * hstep;
    constexpr bool GATHER = Sched::GATHER;
    const size_t hstepA = GATHER ? 0 : hstep, tstepA = GATHER ? 0 : tstep;
#define PG8_VOA(h, nx) (GATHER ? ((nx) ? nvo[h] : cvo[h]) : voffA)
#define PG8_GOFFS(dst, u) do { _Pragma("unroll") for (int h_ = 0; h_ < 2; ++h_) _Pragma("unroll") for (int i_ = 0; i_ < 2; ++i_) dst[h_][i_] = (unsigned)((size_t)S.arow(u, h_ * HALF + RA[i_]) * K + CA[i_]) * 2u; } while (0)
    const unsigned ldsw = (unsigned)wid * 1024u;
    const int aoff = lds_byte(wr * 64 + fr, fq * 8), boff = lds_byte(wc * 32 + fr, fq * 8);
#define PG8_SA(b, h) (((b) * 2 + (h)) * HTB)
#define PG8_SB(b, h) ((4 + (b) * 2 + (h)) * HTB)
#define PG8_STAGE(bufoff, gbase, voff) do { _Pragma("unroll") for (int _i = 0; _i < 2; ++_i) \
        __builtin_amdgcn_global_load_lds((const unsigned*)((const char*)(gbase) + (voff)[_i]), (PG8_LAS unsigned*)(lds + (bufoff) + ldsw + _i * 8192), 16, 0, 0); } while (0)
#define PG8_LDA(dst, b, h) do { _Pragma("unroll") for (int m = 0; m < 4; ++m) _Pragma("unroll") for (int k = 0; k < 2; ++k) dst[m][k] = *(const PG8_LAS bf16x8*)(lds + PG8_SA(b, h) + aoff + m * 2048 + k * 1024); } while (0)
#define PG8_LDB(dst, b, h) do { _Pragma("unroll") for (int n = 0; n < 2; ++n) _Pragma("unroll") for (int k = 0; k < 2; ++k) dst[n][k] = *(const PG8_LAS bf16x8*)(lds + PG8_SB(b, h) + boff + n * 2048 + k * 1024); } while (0)
#define PG8_MMA(ai, bj, At, Bt) do { __builtin_amdgcn_s_setprio(1); _Pragma("unroll") for (int m = 0; m < 4; ++m) _Pragma("unroll") for (int n = 0; n < 2; ++n) _Pragma("unroll") for (int k = 0; k < 2; ++k) \
        acc[ai][bj][m][n] = __builtin_amdgcn_mfma_f32_16x16x32_bf16(Bt[n][k], At[m][k], acc[ai][bj][m][n], 0, 0, 0); __builtin_amdgcn_s_setprio(0); } while (0)
#define PG8_WAIT_V(n) asm volatile("s_waitcnt vmcnt(" #n ")" ::: "memory")
#define PG8_WAIT_L(n) asm volatile("s_waitcnt lgkmcnt(" #n ")" ::: "memory")
#define PG8_BAR __builtin_amdgcn_s_barrier()
#define PG8_SCHED __builtin_amdgcn_sched_barrier(0)
    Unit cur, nxt; int ui = 0;
    if (!S.next(0, cur)) return;
    f32x4 acc[2][2][4][2];
#pragma unroll
    for (int a = 0; a < 2; ++a)
#pragma unroll
        for (int b = 0; b < 2; ++b)
#pragma unroll
            for (int m = 0; m < 4; ++m)
#pragma unroll
                for (int n = 0; n < 2; ++n) acc[a][b][m][n] = (f32x4){0.f, 0.f, 0.f, 0.f};
    bf16x8 At[4][2], B0[2][2], B1[2][2];
    const char* cA = (const char*)g.A + (size_t)cur.pm * tstepA; const char* cB = (const char*)g.Bt + S.bofs(cur) + (size_t)cur.pn * tstep;
    if constexpr (GATHER) { PG8_GOFFS(cvo, cur); Unit u1_; if (S.next(1, u1_)) PG8_GOFFS(nvo, u1_); else { _Pragma("unroll") for (int h_ = 0; h_ < 2; ++h_) _Pragma("unroll") for (int i_ = 0; i_ < 2; ++i_) nvo[h_][i_] = cvo[h_][i_]; } }
    S.a_ready(cur);
    if constexpr (SP2) {
        PG8_STAGE(PG8_SB(0, 0), cB, voffB); PG8_STAGE(PG8_SB(0, 1), cB + hstep, voffB); PG8_STAGE(PG8_SA(0, 0), cA, PG8_VOA(0, false)); PG8_STAGE(PG8_SA(0, 1), cA + hstepA, PG8_VOA(1, false));
        if (wr == 1) PG8_BAR;
        PG8_WAIT_V(2); PG8_BAR;
        PG8_STAGE(PG8_SB(1, 0), cB + kstep, voffB); PG8_STAGE(PG8_SA(1, 0), cA + kstep, PG8_VOA(0, false)); PG8_STAGE(PG8_SB(1, 1), cB + hstep + kstep, voffB);
        PG8_WAIT_V(6); PG8_BAR;
    } else {
        PG8_STAGE(PG8_SB(0, 0), cB, voffB); PG8_STAGE(PG8_SA(0, 0), cA, PG8_VOA(0, false)); PG8_STAGE(PG8_SB(0, 1), cB + hstep, voffB); PG8_STAGE(PG8_SA(0, 1), cA + hstepA, PG8_VOA(1, false));
        if (wr == 1) PG8_BAR;
        PG8_WAIT_V(4); PG8_BAR;
        PG8_STAGE(PG8_SB(1, 0), cB + kstep, voffB); PG8_STAGE(PG8_SA(1, 0), cA + kstep, PG8_VOA(0, false)); PG8_STAGE(PG8_SB(1, 1), cB + hstep + kstep, voffB);
        PG8_WAIT_V(6); PG8_BAR;
    }
    for (;;) {
        const bool has_next = S.next(ui + 1, nxt);
        const char* nA = has_next ? (const char*)g.A + (size_t)nxt.pm * tstepA : cA;
        if constexpr (GATHER) { if (ui > 0) { if (has_next) PG8_GOFFS(nvo, nxt); else { _Pragma("unroll") for (int h_ = 0; h_ < 2; ++h_) _Pragma("unroll") for (int i_ = 0; i_ < 2; ++i_) nvo[h_][i_] = cvo[h_][i_]; } } } const char* nB = has_next ? (const char*)g.Bt + S.bofs(nxt) + (size_t)nxt.pn * tstep : cB;
        for (int t = 0; t < nt; t += 2) {
            const bool last = (t == nt - 2);
            const char* a1 = cA + (size_t)(t + 1) * kstep;
            const char* a2 = last ? nA : cA + (size_t)(t + 2) * kstep; const char* b2 = last ? nB : cB + (size_t)(t + 2) * kstep;
            const char* a3 = a2 + kstep; const char* b3 = b2 + kstep;
            if (last && has_next) S.a_ready(nxt);
            if constexpr (SP2) {
            PG8_LDB(B0, 0, 0); PG8_LDB(B1, 0, 1); PG8_SCHED; PG8_LDA(At, 0, 0); PG8_STAGE(PG8_SA(1, 1), a1 + hstepA, PG8_VOA(1, false));
            PG8_WAIT_V(8); PG8_WAIT_L(0); PG8_BAR; PG8_MMA(0, 0, At, B0); PG8_MMA(0, 1, At, B1); PG8_BAR; PG8_SCHED;
            PG8_LDA(At, 0, 1); PG8_STAGE(PG8_SB(0, 0), b2, voffB); PG8_STAGE(PG8_SB(0, 1), b2 + hstep, voffB); PG8_STAGE(PG8_SA(0, 0), a2, PG8_VOA(0, last));
            PG8_WAIT_V(8); PG8_WAIT_L(0); PG8_BAR; PG8_MMA(1, 0, At, B0); PG8_MMA(1, 1, At, B1); PG8_BAR; PG8_SCHED;
            PG8_LDB(B0, 1, 0); PG8_LDB(B1, 1, 1); PG8_SCHED; PG8_LDA(At, 1, 0); PG8_STAGE(PG8_SA(0, 1), a2 + hstepA, PG8_VOA(1, last));
            PG8_WAIT_V(8); PG8_WAIT_L(0); PG8_BAR; PG8_MMA(0, 0, At, B0); PG8_MMA(0, 1, At, B1); PG8_BAR; PG8_SCHED;
            PG8_LDA(At, 1, 1); PG8_STAGE(PG8_SB(1, 0), b3, voffB); PG8_STAGE(PG8_SB(1, 1), b3 + hstep, voffB); PG8_STAGE(PG8_SA(1, 0), a3, PG8_VOA(0, last));
            PG8_WAIT_V(8); PG8_WAIT_L(0); PG8_BAR; PG8_MMA(1, 0, At, B0); PG8_MMA(1, 1, At, B1); PG8_BAR; PG8_SCHED;
            } else {
            PG8_LDB(B0, 0, 0); PG8_SCHED; PG8_LDA(At, 0, 0); PG8_STAGE(PG8_SA(1, 1), a1 + hstepA, PG8_VOA(1, false));
            PG8_WAIT_L(8); PG8_BAR; PG8_WAIT_L(0); PG8_MMA(0, 0, At, B0); PG8_BAR; PG8_SCHED;
            PG8_LDB(B1, 0, 1); PG8_STAGE(PG8_SB(0, 0), b2, voffB);
            PG8_BAR; PG8_WAIT_L(0); PG8_MMA(0, 1, At, B1); PG8_BAR;
            PG8_LDA(At, 0, 1); PG8_STAGE(PG8_SA(0, 0), a2, PG8_VOA(0, last));
            PG8_BAR; PG8_WAIT_L(0); PG8_MMA(1, 0, At, B0); PG8_BAR; PG8_SCHED;
            PG8_STAGE(PG8_SB(0, 1), b2 + hstep, voffB);
            PG8_WAIT_V(6); PG8_BAR; PG8_MMA(1, 1, At, B1); PG8_BAR;
            PG8_LDB(B0, 1, 0); PG8_SCHED; PG8_LDA(At, 1, 0); PG8_STAGE(PG8_SA(0, 1), a2 + hstepA, PG8_VOA(1, last));
            PG8_WAIT_L(8); PG8_BAR; PG8_WAIT_L(0); PG8_MMA(0, 0, At, B0); PG8_BAR; PG8_SCHED;
            PG8_LDB(B1, 1, 1); PG8_STAGE(PG8_SB(1, 0), b3, voffB);
            PG8_BAR; PG8_WAIT_L(0); PG8_MMA(0, 1, At, B1); PG8_BAR;
            PG8_LDA(At, 1, 1); PG8_STAGE(PG8_SA(1, 0), a3, PG8_VOA(0, last));
            PG8_BAR; PG8_WAIT_L(0); PG8_MMA(1, 0, At, B0); PG8_BAR; PG8_SCHED;
            PG8_STAGE(PG8_SB(1, 1), b3 + hstep, voffB);
            PG8_WAIT_V(6); PG8_BAR; PG8_MMA(1, 1, At, B1); PG8_BAR;
            }
        }
        if constexpr (ALIGN_EPI) { if (wr == 0) PG8_BAR; }
        if constexpr (!Epi::AFTER_DRAIN) { E(acc, cur, wr, wc, fr, fq); S.done(cur); }
        if (!has_next) break;
#pragma unroll
        for (int a = 0; a < 2; ++a)
#pragma unroll
            for (int b = 0; b < 2; ++b)
#pragma unroll
                for (int m = 0; m < 4; ++m)
#pragma unroll
                    for (int n = 0; n < 2; ++n) acc[a][b][m][n] = (f32x4){0.f, 0.f, 0.f, 0.f};
        cur = nxt; cA = nA; cB = nB; ++ui;
        if constexpr (GATHER) { _Pragma("unroll") for (int h_ = 0; h_ < 2; ++h_) _Pragma("unroll") for (int i_ = 0; i_ < 2; ++i_) cvo[h_][i_] = nvo[h_][i_]; }
        if constexpr (ALIGN_EPI) { if (wr == 1) PG8_BAR; }
    }
    PG8_WAIT_V(0);
    if constexpr (!ALIGN_EPI) { if (wr == 0) PG8_BAR; }
    PG8_BAR;
    if constexpr (Epi::AFTER_DRAIN) { E.fused(acc, cur, wr, wc, fr, fq, lds, wid, lane); S.done(cur); }
#undef PG8_SA
#undef PG8_VOA
#undef PG8_GOFFS
#undef PG8_SB
#undef PG8_STAGE
#undef PG8_LDA
#undef PG8_LDB
#undef PG8_MMA
#undef PG8_WAIT_V
#undef PG8_WAIT_L
#undef PG8_BAR
#undef PG8_SCHED
}
}

#ifndef PG8_SP2
#define PG8_SP2 true
#endif
#ifndef PG8_ALIGN
#define PG8_ALIGN true
#endif
namespace pg8 {
struct EpiF32 {
    static constexpr bool PERM = false, AFTER_DRAIN = false;
    float* O; int ldc;
    __device__ __forceinline__ void operator()(const f32x4 (&acc)[2][2][4][2], const Unit& u, int wr, int wc, int fr, int fq) const {
        const int row0 = u.pm * BM + wr * 64 + fr, col0 = u.pn * BM + wc * 32 + 4 * fq;
#pragma unroll
        for (int ai = 0; ai < 2; ++ai)
#pragma unroll
            for (int m = 0; m < 4; ++m) { float* rowp = O + (size_t)(row0 + ai * HALF + m * 16) * ldc + col0;
#pragma unroll
                for (int bj = 0; bj < 2; ++bj)
#pragma unroll
                    for (int n = 0; n < 2; ++n) *(f32x4*)(rowp + bj * HALF + n * 16) = acc[ai][bj][m][n]; }
    }
};
template <bool GATHER_> struct MoeOrder {
    const PG8_LAS int* tb; int ncol, G, c; size_t estride; const int* list; const unsigned* cnt;
    static constexpr bool GATHER = GATHER_;
    __device__ __forceinline__ int arow(const Unit& u, int r) const { int e = 0;
#pragma unroll
        for (int k = 1; k < 16; ++k) e += (u.pm >= tb[k]) ? 1 : 0;
        const int pos = (u.pm - tb[e]) * 256 + r; return pos < (int)cnt[e] ? list[e * 16384 + pos] : 0; }
    __device__ __forceinline__ bool next(int i, Unit& u) const { const int L = i * G + c, t = L / ncol; if (t >= __builtin_amdgcn_readfirstlane(tb[16])) return false; u.pm = t; u.pn = L - t * ncol; return true; }
    __device__ __forceinline__ void a_ready(const Unit&) const {}
    __device__ __forceinline__ void done(const Unit&) const {}
    __device__ __forceinline__ size_t bofs(const Unit& u) const { int e = 0;
#pragma unroll
        for (int k = 1; k < 16; ++k) e += (u.pm >= tb[k]) ? 1 : 0;
        return (size_t)__builtin_amdgcn_readfirstlane(e) * estride; }
};
struct EpiSwiGLU {
    static constexpr bool PERM = true, AFTER_DRAIN = false;
    bf16_t* O;
    __device__ __forceinline__ void operator()(const f32x4 (&acc)[2][2][4][2], const Unit& u, int wr, int wc, int fr, int fq) const {
        const int row0 = u.pm * BM + wr * 64 + fr, col0 = u.pn * 128 + wc * 32 + 8 * fq;
#pragma unroll
        for (int ai = 0; ai < 2; ++ai)
#pragma unroll
            for (int m = 0; m < 4; ++m) { bf16_t* rowp = O + (size_t)(row0 + ai * HALF + m * 16) * 256 + col0;
                f32x4 v[2];
#pragma unroll
                for (int n = 0; n < 2; ++n)
#pragma unroll
                    for (int e = 0; e < 4; ++e) { const float gt = acc[ai][0][m][n][e]; v[n][e] = gt / (1.f + __expf(-gt)) * acc[ai][1][m][n][e]; }
                u32x4 w; w.x = cvt_pk_bf16(v[0][0], v[0][1]); w.y = cvt_pk_bf16(v[0][2], v[0][3]); w.z = cvt_pk_bf16(v[1][0], v[1][1]); w.w = cvt_pk_bf16(v[1][2], v[1][3]);
                st16_wt(rowp, w); }
    }
};
struct EpiLn1 {
    static constexpr bool PERM = false, AFTER_DRAIN = true;
    const float* x; float* hout; bf16_t* hb; const float* gam; const float* bet; float alpha; PanelStats st; unsigned poison;
    __device__ __forceinline__ void fused(f32x4 (&acc)[2][2][4][2], const Unit& u, int wr, int wc, int fr, int fq, PG8_LAS unsigned char* lds, int wid, int lane) const {
        typedef float f32x2v __attribute__((ext_vector_type(2))); typedef unsigned u32x2v __attribute__((ext_vector_type(2)));
        const PG8_LAS f32x2v* S = (const PG8_LAS f32x2v*)(lds + 8192);
        const int col0 = u.pn * BM + wc * 32 + 4 * fq, ldc = 1024;
#pragma unroll
        for (int ai = 0; ai < 2; ++ai)
#pragma unroll
            for (int m = 0; m < 4; ++m) { const size_t off = (size_t)(u.pm * BM + ai * HALF + wr * 64 + m * 16 + fr) * ldc + col0;
#pragma unroll
                for (int bj = 0; bj < 2; ++bj)
#pragma unroll
                    for (int n = 0; n < 2; ++n) { const f32x4 xv = *(const f32x4*)(x + off + bj * HALF + n * 16); acc[ai][bj][m][n] = xv * alpha + acc[ai][bj][m][n]; }
                asm volatile("" : "+v"(acc[ai][0][m][0]), "+v"(acc[ai][0][m][1]), "+v"(acc[ai][1][m][0]), "+v"(acc[ai][1][m][1]));
                if (m & 1) asm volatile("" ::: "memory"); }
        const bool bad = st.run(acc, u, wr, wc, fr, fq, lds, wid, lane) || poison != 0u;
        const float qnan = __builtin_nanf("");
        f32x4 gv[2][2], bv[2][2];
#pragma unroll
        for (int bj = 0; bj < 2; ++bj)
#pragma unroll
            for (int n = 0; n < 2; ++n) { gv[bj][n] = *(const f32x4*)(gam + col0 + bj * HALF + n * 16); bv[bj][n] = *(const f32x4*)(bet + col0 + bj * HALF + n * 16); }
#pragma unroll
        for (int ai = 0; ai < 2; ++ai)
#pragma unroll
            for (int m = 0; m < 4; ++m) { const int r = ai * HALF + wr * 64 + m * 16 + fr; const f32x2v sr = S[r]; const size_t off = (size_t)(u.pm * BM + r) * ldc + col0;
#pragma unroll
                for (int bj = 0; bj < 2; ++bj)
#pragma unroll
                    for (int n = 0; n < 2; ++n) { f32x4 o = (acc[ai][bj][m][n] - sr.x) * sr.y * gv[bj][n] + bv[bj][n];
                        if (bad) o = (f32x4){qnan, qnan, qnan, qnan};
                        *(f32x4*)(hout + off + bj * HALF + n * 16) = o;
                        u32x2v w; w.x = cvt_pk_bf16(o[0], o[1]); w.y = cvt_pk_bf16(o[2], o[3]); *(u32x2v*)(hb + off + bj * HALF + n * 16) = w; }
                asm volatile("" ::: "memory"); }
    }
};
}
#define GAS __attribute__((address_space(1)))
#define LAS __attribute__((address_space(3)))
typedef unsigned short bf16;
typedef unsigned v4u __attribute__((ext_vector_type(4)));
typedef float f32x4 __attribute__((ext_vector_type(4)));
typedef short bf16x8 __attribute__((ext_vector_type(8)));
typedef GAS unsigned gu32;
typedef GAS unsigned long long gu64;
#define RLX_AGENT __ATOMIC_RELAXED, __HIP_MEMORY_SCOPE_AGENT
#define LDS_WAIT() asm volatile("s_waitcnt lgkmcnt(0)" ::: "memory")
#define VM_WAIT() asm volatile("s_waitcnt vmcnt(0)" ::: "memory")
__device__ __forceinline__ unsigned long long rt() { return __builtin_amdgcn_s_memrealtime(); }
__device__ __forceinline__ unsigned f2bf(float f) { unsigned u = __builtin_bit_cast(unsigned, f); return (u + 0x7fffu + ((u >> 16) & 1u)) >> 16; }
__device__ __forceinline__ unsigned pk2(float lo, float hi) { return f2bf(lo) | (f2bf(hi) << 16); }

#define XB_TMO      128
#define XB_XCNT(j)  (256  + 64 * (j))
#define XB_XSUB(j)  (1280 + 64 * (j))
#define XB_XGEN(j)  (2304 + 64 * (j))
#define XB_TOP      3328
#define XB_TOPGEN   3392
#define XCD_BAR_WORDS 3456
#define XB_SPIN_CAP (1u << 18)

__device__ __forceinline__ unsigned xb_ld(unsigned* p)              { return __hip_atomic_load(p, __ATOMIC_RELAXED, __HIP_MEMORY_SCOPE_AGENT); }
__device__ __forceinline__ unsigned xb_add(unsigned* p, unsigned v) { return __hip_atomic_fetch_add(p, v, __ATOMIC_RELAXED, __HIP_MEMORY_SCOPE_AGENT); }
__device__ __forceinline__ unsigned xb_xcc_id() { return (unsigned)__builtin_amdgcn_s_getreg((3 << 11) | 20) & 0xFu; }
#define XB_SPIN(cond, bar) do { unsigned _sp = 0; while (cond) { __builtin_amdgcn_s_sleep(1); \
    if ((++_sp & 255u) == 0u) { if (xb_ld(&(bar)[XB_TMO])) break; if (_sp > XB_SPIN_CAP) { atomicAdd(&(bar)[XB_TMO], 1u); break; } } } } while (0)

struct XcdBarrier {
    unsigned* bar; unsigned x;
    volatile LAS unsigned* st;
};

__device__ __forceinline__ XcdBarrier xcd_barrier_post(unsigned* bar, volatile LAS unsigned* st) {
    XcdBarrier b; b.bar = bar; b.x = xb_xcc_id(); b.st = st;
    if (threadIdx.x == 0) (void)xb_add(&bar[XB_XCNT(b.x)], 1u);
    return b;
}
__device__ __forceinline__ void xcd_barrier_complete(unsigned* bar, unsigned x, unsigned& nloc, unsigned& nx) {
    const unsigned G = gridDim.x * gridDim.y * gridDim.z;
    unsigned sum, cnt, mine, sp = 0u;
    for (;;) {
        sum = 0u; cnt = 0u; mine = 0u;
#pragma unroll
        for (unsigned j = 0; j < 16; ++j) { const unsigned c = xb_ld(&bar[XB_XCNT(j)]); sum += c; cnt += (c > 0u) ? 1u : 0u; mine = (j == x) ? c : mine; }
        if (sum == G) break;
        __builtin_amdgcn_s_sleep(1);
        if ((++sp & 255u) == 0u) { if (xb_ld(&bar[XB_TMO])) break; if (sp > XB_SPIN_CAP) { atomicAdd(&bar[XB_TMO], 1u); break; } }
    }
    nloc = mine > 0u ? mine : 1u; nx = cnt > 0u ? cnt : 1u;
}

__device__ __forceinline__ void xcd_barrier(const XcdBarrier& b) {
    asm volatile("s_waitcnt vmcnt(0)" ::: "memory");
    __syncthreads();
    if (threadIdx.x == 0) {
        unsigned* bar = b.bar;
        __builtin_amdgcn_s_waitcnt(0);
        unsigned nloc = b.st[0], nx = b.st[1];
        if (nloc == 0u) { xcd_barrier_complete(bar, b.x, nloc, nx); b.st[0] = nloc; b.st[1] = nx; }
        const unsigned old = xb_add(&bar[XB_XSUB(b.x)], 1u);
        const unsigned gen = old / nloc;
        if (old + 1u == (gen + 1u) * nloc) {
            __builtin_amdgcn_fence(__ATOMIC_RELEASE, "agent");
            asm volatile("s_waitcnt vmcnt(0)" ::: "memory");
            const unsigned og = xb_add(&bar[XB_TOP], 1u);
            const unsigned tg = og / nx;
            if (og + 1u == (tg + 1u) * nx) xb_add(&bar[XB_TOPGEN], 1u);
            else XB_SPIN(xb_ld(&bar[XB_TOPGEN]) == tg, bar);
            __builtin_amdgcn_fence(__ATOMIC_ACQUIRE, "agent");
            xb_add(&bar[XB_XGEN(b.x)], 1u);
            asm volatile("s_waitcnt vmcnt(0)" ::: "memory");
        } else {
            XB_SPIN(xb_ld(&bar[XB_XGEN(b.x)]) == gen, bar);
            __builtin_amdgcn_fence(__ATOMIC_ACQUIRE, "agent");
            asm volatile("s_waitcnt vmcnt(0)" ::: "memory");
        }
    }
    __syncthreads();
}
namespace mb {
constexpr int D = 128, PITCH = 512, OPITCH = 1024;
constexpr float THR = 8.f;
constexpr bool WSKIP = false;
constexpr int KM_OFF = 69632;
constexpr float SCALE = 0.08838834764831845f;
constexpr int NW = 8, QBLK = 32, KVBLK = 64, QB = NW * QBLK;
constexpr int SHM_V = KVBLK * D * 2, SHM_K = KVBLK * D * 2;
constexpr int LDS_BYTES = 2 * SHM_V + 2 * SHM_K + NW * 64 * 4;

typedef short bf16x8 __attribute__((ext_vector_type(8)));
typedef short s16x4 __attribute__((ext_vector_type(4)));
typedef float f32x16 __attribute__((ext_vector_type(16)));
typedef float f32x4 __attribute__((ext_vector_type(4)));
typedef unsigned u32x4 __attribute__((ext_vector_type(4)));
template <class A, class Bt> struct same_t { static constexpr bool v = false; };
template <class A> struct same_t<A, A> { static constexpr bool v = true; };

typedef const GAS char* gcptr;
__device__ __forceinline__ gcptr uni(const void* p) {
    const unsigned long long u = (unsigned long long)p;
    const unsigned lo = __builtin_amdgcn_readfirstlane((unsigned)u), hi = __builtin_amdgcn_readfirstlane((unsigned)(u >> 32));
    return (gcptr)(((unsigned long long)hi << 32) | lo);
}
#define KSWZ(row, colB) ((row) * 256 + ((colB) ^ (((row) & 7) << 4)))
#define SBAR() __builtin_amdgcn_sched_barrier(0)
__device__ __forceinline__ int v_st(int k, int c) { const int kk = (k & ~0xC) | ((k & 4) << 1) | ((k & 8) >> 1); return ((kk >> 3) * 4 + (c >> 5)) * 512 + ((kk & 7) * 32 + (c & 31)) * 2; }
__device__ __forceinline__ int v_rd_base(int lane) { return ((lane & 3) << 3) | (((lane >> 2) & 3) << 6) | (((lane >> 4) & 1) << 5) | (((lane >> 5) & 1) << 8); }
constexpr int v_rd_off(int d0, int ks, int half) { return d0 * 512 + ks * 4096 + half * 2048; }
__device__ __forceinline__ int crow(int r, int hi) { return (r & 3) + 8 * (r >> 2) + 4 * hi; }
__device__ __forceinline__ unsigned cvtpk(float lo, float hi) {
    unsigned r; asm volatile("v_cvt_pk_bf16_f32 %0, %1, %2" : "=v"(r) : "v"(lo), "v"(hi)); return r;
}
__device__ __forceinline__ bf16x8 pack8(f32x4 a, f32x4 b) {
    u32x4 w = {cvtpk(a[0], a[1]), cvtpk(a[2], a[3]), cvtpk(b[0], b[1]), cvtpk(b[2], b[3])};
    return *reinterpret_cast<bf16x8*>(&w);
}
template <class T> __device__ __forceinline__ bf16x8 load8(const T* p) {
    if constexpr (same_t<T, float>::v) { return pack8(*(const f32x4*)p, *(const f32x4*)(p + 4)); }
    else { return *reinterpret_cast<const bf16x8*>(p); }
}
__device__ __forceinline__ void mask_tile(f32x16& p0, f32x16& p1, int dq, unsigned W) {
    const float NEG = -__builtin_inff();
#pragma unroll
    for (int r = 0; r < 16; ++r) {
        const int c = (r & 3) + 8 * (r >> 2);
        if ((unsigned)(dq - c) >= W) p0[r] = NEG;
        if ((unsigned)(dq - c - 32) >= W) p1[r] = NEG;
    }
}
__device__ __forceinline__ void partialSM(f32x16& p0, f32x16& p1, float& m_reg, float& mn, float& alpha) {
    float pmax = p0[0]; for (int r = 1; r < 16; ++r) pmax = fmaxf(pmax, p0[r]); for (int r = 0; r < 16; ++r) pmax = fmaxf(pmax, p1[r]);
    { auto rr = __builtin_amdgcn_permlane32_swap(__float_as_uint(pmax), __float_as_uint(pmax), false, false);
      pmax = fmaxf(__uint_as_float(rr[0]), __uint_as_float(rr[1])); }
    constexpr float C2 = 1.4426950408889634f * SCALE;
    if (__builtin_expect(__all((pmax - m_reg) * SCALE <= THR), 1)) { mn = m_reg; alpha = 1.f; }
    else { mn = fmaxf(m_reg, pmax); alpha = __builtin_amdgcn_exp2f((m_reg - mn) * C2); m_reg = mn; }
    const float mnL = -mn * C2;
    for (int r = 0; r < 16; ++r) p0[r] = fmaf(p0[r], C2, mnL); for (int r = 0; r < 16; ++r) p1[r] = fmaf(p1[r], C2, mnL);
    for (int r = 0; r < 16; ++r) p0[r] = __builtin_amdgcn_exp2f(p0[r]);
}
__device__ __forceinline__ void finishSM(f32x16& p0, f32x16& p1, float alpha, float& l_reg, bf16x8& pa0, bf16x8& pa1, bf16x8& pa2, bf16x8& pa3) {
    for (int r = 0; r < 16; ++r) p1[r] = __builtin_amdgcn_exp2f(p1[r]);
    float ps = 0; for (int r = 0; r < 16; ++r) ps += p0[r]; for (int r = 0; r < 16; ++r) ps += p1[r];
    { auto rr = __builtin_amdgcn_permlane32_swap(__float_as_uint(ps), __float_as_uint(ps), false, false);
      ps = __uint_as_float(rr[0]) + __uint_as_float(rr[1]); }
    l_reg = l_reg * alpha + ps;
#define PK4(P, B_, OUT) do { unsigned a0 = cvtpk(P[B_+0], P[B_+1]), a1 = cvtpk(P[B_+2], P[B_+3]);                          \
        unsigned b0 = cvtpk(P[B_+4], P[B_+5]), b1 = cvtpk(P[B_+6], P[B_+7]);                                             \
        auto r0 = __builtin_amdgcn_permlane32_swap(a0, b0, false, false); auto r1 = __builtin_amdgcn_permlane32_swap(a1, b1, false, false); \
        u32x4 w = {r0[0], r1[0], r0[1], r1[1]}; OUT = *reinterpret_cast<bf16x8*>(&w); } while (0)
    PK4(p0, 0, pa0); PK4(p0, 8, pa1); PK4(p1, 0, pa2); PK4(p1, 8, pa3);
#undef PK4
}
template <int KB, bool SK>
__device__ __forceinline__ void qkt(f32x16& p0, f32x16& p1, const char* K_lds, int r32, int hi, const bf16x8* qr, bool act) {
    if (SK && !act) { const float NEG = -__builtin_inff();
#pragma unroll
        for (int r = 0; r < 16; ++r) { p0[r] = NEG; p1[r] = NEG; } return; }
    p0 = f32x16{}; p1 = f32x16{};
    const char* kb[4];
#pragma unroll
    for (int dd = 0; dd < 4; ++dd) kb[dd] = K_lds + KB * SHM_K + KSWZ(r32, (dd * 16 + hi * 8) * 2);
#pragma unroll
    for (int d0 = 0; d0 < 8; ++d0) { const char* a = kb[d0 & 3] + (d0 >> 2) * 128;
        bf16x8 b0 = *reinterpret_cast<const bf16x8*>(a);
        bf16x8 b1 = *reinterpret_cast<const bf16x8*>(a + 32 * 256);
        p0 = __builtin_amdgcn_mfma_f32_32x32x16_bf16(b0, qr[d0], p0, 0, 0, 0);
        p1 = __builtin_amdgcn_mfma_f32_32x32x16_bf16(b1, qr[d0], p1, 0, 0, 0); }
}
template <int VB, bool SK>
__device__ __forceinline__ void pv_tile(f32x16* o, int vb0, bf16x8 pa0, bf16x8 pa1, bf16x8 pa2, bf16x8 pa3, bool act) {
    if (SK && !act) return;
#define TRRD(dst, off) asm volatile("ds_read_b64_tr_b16 %0, %1 offset:%2" : "=&v"(dst) : "v"(vb0), "i"(off) : "memory")
#define PV_D0(d0) do { s16x4 l0, l1, l2, l3, h0, h1, h2, h3; constexpr int b_ = VB * SHM_V + v_rd_off(d0, 0, 0);     \
        TRRD(l0, b_); TRRD(h0, b_ + 2048); TRRD(l1, b_ + 4096); TRRD(h1, b_ + 6144); TRRD(l2, b_ + 8192); TRRD(h2, b_ + 10240); TRRD(l3, b_ + 12288); TRRD(h3, b_ + 14336); \
        asm volatile("s_waitcnt lgkmcnt(0)" ::: "memory"); SBAR();                 \
        o[d0] = __builtin_amdgcn_mfma_f32_32x32x16_bf16(pa0, (bf16x8){l0[0], l0[1], l0[2], l0[3], h0[0], h0[1], h0[2], h0[3]}, o[d0], 0, 0, 0);   \
        o[d0] = __builtin_amdgcn_mfma_f32_32x32x16_bf16(pa1, (bf16x8){l1[0], l1[1], l1[2], l1[3], h1[0], h1[1], h1[2], h1[3]}, o[d0], 0, 0, 0);   \
        o[d0] = __builtin_amdgcn_mfma_f32_32x32x16_bf16(pa2, (bf16x8){l2[0], l2[1], l2[2], l2[3], h2[0], h2[1], h2[2], h2[3]}, o[d0], 0, 0, 0);   \
        o[d0] = __builtin_amdgcn_mfma_f32_32x32x16_bf16(pa3, (bf16x8){l3[0], l3[1], l3[2], l3[3], h3[0], h3[1], h3[2], h3[3]}, o[d0], 0, 0, 0); } while (0)
    PV_D0(0); PV_D0(1); PV_D0(2); PV_D0(3);
#undef PV_D0
#undef TRRD
}

template <class TIn, class TOut> struct BlockRef { const TIn* Q; const TIn* K; const TIn* V; TOut* O; const float* KM; int P0; int t_lo, t_hi; TOut* OP; float* LSE; };
template <class TIn> struct Seam {
    bf16x8 qr[8];
    bf16x8 st_v0, st_v1, st_k0, st_k1; f32x4 sf0, sf1, sf2, sf3;
    f32x4 tq[16];
};
__device__ __forceinline__ int swa_jlo(int P0, int W) { const int lowk = P0 - W + 1; return lowk > 0 ? lowk / KVBLK : 0; }
#define ROW(p, k0, rr) ((p) + (size_t)((k0) + (rr)) * PITCH + sc)
#define VMW() asm volatile("s_waitcnt vmcnt(0)" ::: "memory")
#define VMWN(n) asm volatile("s_waitcnt vmcnt(%0)" :: "i"(n) : "memory")
#define LD16U(base, boff) (*(const GAS bf16x8*)(uni((const char*)(base) + (size_t)(boff)) + voff))
#define SLOAD_H(Kp, Vp, k0) do { S.st_v0 = LD16U(Vp, (size_t)(k0) * (PITCH * 2)); S.st_v1 = LD16U(Vp, (size_t)((k0) + 32) * (PITCH * 2));              \
                         S.st_k0 = LD16U(Kp, (size_t)(k0) * (PITCH * 2)); S.st_k1 = LD16U(Kp, (size_t)((k0) + 32) * (PITCH * 2)); } while (0)
#define SWRITE_HK(bf) do { *(bf16x8*)(K_lds + (bf) * SHM_K + kws) = S.st_k0; *(bf16x8*)(K_lds + (bf) * SHM_K + kws + 32 * 256) = S.st_k1; } while (0)
#define SWRITE_HV(bf) do { *(bf16x8*)(V_lds + (bf) * SHM_V + vst0) = S.st_v0; *(bf16x8*)(V_lds + (bf) * SHM_V + vst1) = S.st_v1; } while (0)
#define SWRITE_H(bf) do { SWRITE_HV(bf); SWRITE_HK(bf); } while (0)
#define SLOAD_F(p, k0) do { S.sf0 = *(const f32x4*)ROW(p, k0, sr); S.sf1 = *(const f32x4*)(ROW(p, k0, sr) + 4);                \
                            S.sf2 = *(const f32x4*)ROW(p, k0, 32 + sr); S.sf3 = *(const f32x4*)(ROW(p, k0, 32 + sr) + 4); } while (0)
#define SWRITE_KF(bf) do { *(bf16x8*)(K_lds + (bf) * SHM_K + kws) = pack8(S.sf0, S.sf1); *(bf16x8*)(K_lds + (bf) * SHM_K + kws + 32 * 256) = pack8(S.sf2, S.sf3); } while (0)
#define SWRITE_VF(bf) do { *(bf16x8*)(V_lds + (bf) * SHM_V + vst0) = pack8(S.sf0, S.sf1); *(bf16x8*)(V_lds + (bf) * SHM_V + vst1) = pack8(S.sf2, S.sf3); } while (0)
template <class TIn, class TOut>
__device__ __forceinline__ void causal_swa_prime(const BlockRef<TIn, TOut>& cur, int W, char* lds, Seam<TIn>& S) {
    constexpr bool F32 = same_t<TIn, float>::v;
    int tid = threadIdx.x; asm volatile("" : "+v"(tid));
    const int wid = __builtin_amdgcn_readfirstlane(tid >> 6), lane = tid & 63, r32 = lane & 31, hi = lane >> 5;
    const int sr = tid >> 4, sc = (tid & 15) * 8, kws = KSWZ(sr, sc * 2); char* K_lds = lds + 2 * SHM_V;
    const unsigned voff = (unsigned)(sr * PITCH + sc) * 2u, qoff = (unsigned)((wid * QBLK + r32) * PITCH + hi * 8) * 2u;
    const int kb0 = cur.t_lo * KVBLK;
    for (int d0 = 0; d0 < 8; ++d0) S.qr[d0] = *(const GAS bf16x8*)(uni((const char*)cur.Q + d0 * 32) + qoff);
    if constexpr (F32) { SLOAD_F((const float*)cur.K, kb0); VMW(); SWRITE_KF(0); SBAR(); SLOAD_F((const float*)cur.V, kb0); }
    else { SLOAD_H(cur.K, cur.V, kb0); VMW(); SWRITE_HK(0); }
    __syncthreads();
}
template <class TIn, class TOut>
__device__ __forceinline__ void causal_swa_block(const BlockRef<TIn, TOut>& cur, const BlockRef<TIn, TOut>& nxt, int skv, int W, char* lds, Seam<TIn>& S) {
    constexpr bool F32 = same_t<TIn, float>::v;
    int tid = threadIdx.x; asm volatile("" : "+v"(tid));
    const int wid = __builtin_amdgcn_readfirstlane(tid >> 6), lane = tid & 63, r32 = lane & 31, hi = lane >> 5;
    const int j_lo = cur.t_lo, j_hi = cur.t_hi;
    const int NT = j_hi - j_lo;
    const int kbn = nxt.t_lo * KVBLK;
    const int qlo = cur.P0 + wid * QBLK, qm = qlo + r32 - 4 * hi;
    char* V_lds = lds; char* K_lds = lds + 2 * SHM_V;
    float* ws = (float*)(lds + 2 * SHM_V + 2 * SHM_K) + wid * 64; float* li_l = ws, * al_l = ws + 32;
    float m_reg = -1e30f, l_reg = 0; f32x16 o[4] = {};
    const int sr = tid >> 4, sc = (tid & 15) * 8, vst0 = v_st(sr, sc), vst1 = v_st(32 + sr, sc), kws = KSWZ(sr, sc * 2);
    const unsigned voff = (unsigned)(sr * PITCH + sc) * 2u, qoff = (unsigned)((wid * QBLK + r32) * PITCH + hi * 8) * 2u;
    const int vb0 = (int)(uintptr_t)V_lds + v_rd_base(lane);
    const TIn* Kh = cur.K; const TIn* Vh = cur.V;
    const int own = cur.P0 / QB, own4 = cur.P0 / KVBLK;
    unsigned sel = 0u;
    {
        float* km = (float*)(lds + KM_OFF);
        for (int i = tid; i < 16 * 128; i += 64 * NW) { const GAS float* p = (const GAS float*)(uni(cur.KM) + (unsigned)(((i >> 7) * 512 + (i & 127)) * 4)); km[i] = (p[0] + p[128]) + (p[256] + p[384]); }
        __syncthreads();
        float best[3] = {-3e38f, -3e38f, -3e38f}; int bidx[3] = {0, 0, 0};
#pragma unroll 1
        for (int j = 0; j < own; ++j) {
            float a = 0.f;
#pragma unroll
            for (int d0 = 0; d0 < 8; ++d0) {
                const f32x4 k0 = *(const f32x4*)(km + j * 128 + d0 * 16 + hi * 8), k1 = *(const f32x4*)(km + j * 128 + d0 * 16 + hi * 8 + 4);
                const u32x4 qw = *reinterpret_cast<const u32x4*>(&S.qr[d0]);
                a += __uint_as_float(qw[0] << 16) * k0[0] + __uint_as_float(qw[0] & 0xffff0000u) * k0[1] + __uint_as_float(qw[1] << 16) * k0[2] + __uint_as_float(qw[1] & 0xffff0000u) * k0[3]
                   + __uint_as_float(qw[2] << 16) * k1[0] + __uint_as_float(qw[2] & 0xffff0000u) * k1[1] + __uint_as_float(qw[3] << 16) * k1[2] + __uint_as_float(qw[3] & 0xffff0000u) * k1[3];
            }
            a += __shfl_xor(a, 32);
            if (a > best[0]) { best[2] = best[1]; bidx[2] = bidx[1]; best[1] = best[0]; bidx[1] = bidx[0]; best[0] = a; bidx[0] = j; }
            else if (a > best[1]) { best[2] = best[1]; bidx[2] = bidx[1]; best[1] = a; bidx[1] = j; }
            else if (a > best[2]) { best[2] = a; bidx[2] = j; }
        }
#pragma unroll
        for (int r = 0; r < 3; ++r) if (best[r] > -1e37f) sel |= 1u << bidx[r];
    }
#define RESC(a) do { if (__any((a) < 1.f)) { if (hi == 0) al_l[r32] = (a); asm volatile("s_waitcnt lgkmcnt(0)" ::: "memory");              \
                     for (int d_ = 0; d_ < 4; ++d_) for (int r = 0; r < 16; ++r) o[d_][r] *= al_l[crow(r, hi)]; } } while (0)
#define KBASE(t) ((j_lo + (t)) * KVBLK)
#define ACT(t) (KBASE(t) <= qlo + QBLK - 1 && KBASE(t) + KVBLK - 1 >= qlo - W + 1)
#define MASKT(P0_, P1_, t) do { const int kb_ = KBASE(t), gt_ = j_lo + (t); if (gt_ >= own4) { if (kb_ + KVBLK - 1 > qlo) mask_tile(P0_, P1_, qm - kb_, 0x3fffffffu); } else if (!((sel >> (gt_ >> 2)) & 1u)) { const float NEG_ = -__builtin_inff(); _Pragma("unroll") for (int r_ = 0; r_ < 16; ++r_) { P0_[r_] = NEG_; P1_[r_] = NEG_; } } } while (0)
    constexpr int NQL = F32 ? 16 : 8;
    constexpr bool SK = WSKIP && !F32;
#define SEAM_K0() do { VMWN(NQL); if constexpr (F32) { SWRITE_KF(0); SBAR(); SLOAD_F((const float*)nxt.V, kbn); } else { SWRITE_HK(0); } SBAR(); } while (0)
    f32x16 pA0, pA1, pB0, pB1; float mnA, mnB, alA, alB; bf16x8 pa0, pa1, pa2, pa3;
    if constexpr (F32) { VMW(); SWRITE_VF(0); SBAR(); } else { SWRITE_HV(0); SBAR(); }
    if (NT > 1) { if constexpr (F32) SLOAD_F((const float*)Kh, KBASE(1)); else SLOAD_H(Kh, Vh, KBASE(1)); }
    SBAR(); qkt<0, SK>(pA0, pA1, K_lds, r32, hi, S.qr, ACT(0));
    if constexpr (F32) { if (NT > 1) { VMW(); SWRITE_KF(1); SBAR(); SLOAD_F((const float*)Vh, KBASE(1)); } }
    MASKT(pA0, pA1, 0); partialSM(pA0, pA1, m_reg, mnA, alA);
    if (NT > 1) { VMW(); if constexpr (F32) { SWRITE_VF(1); SBAR(); if (NT > 2) SLOAD_F((const float*)Kh, KBASE(2)); } else SWRITE_H(1); }
    __syncthreads();
#define HALF_STEP(PX0, PX1, mnX, alX, PY0, PY1, alY, t, KB, VB, SB) do {                                                      \
        SBAR(); qkt<KB, SK>(PX0, PX1, K_lds, r32, hi, S.qr, ACT(t));                                             \
        finishSM(PY0, PY1, alY, l_reg, pa0, pa1, pa2, pa3); SBAR();                                                           \
        if ((t) + 1 < NT) { if constexpr (F32) { VMW(); SWRITE_KF(SB); SBAR(); SLOAD_F((const float*)Vh, KBASE((t) + 1)); }  \
                            else { SLOAD_H(Kh, Vh, KBASE((t) + 1)); } SBAR(); }                                               \
        pv_tile<VB, SK>(o, vb0, pa0, pa1, pa2, pa3, ACT((t) - 1)); MASKT(PX0, PX1, (t)); partialSM(PX0, PX1, m_reg, mnX, alX);                                        \
        __syncthreads();                                                                                                      \
        if ((t) + 1 < NT) { VMW(); if constexpr (F32) { SWRITE_VF(SB); SBAR(); if ((t) + 2 < NT) SLOAD_F((const float*)Kh, KBASE((t) + 2)); } \
                            else { SWRITE_H(SB); } }                                                                          \
        RESC(alX); __syncthreads(); } while (0)
    for (int t = 1; t + 1 < NT; t += 2) {
        HALF_STEP(pB0, pB1, mnB, alB, pA0, pA1, alA, t, 1, 0, 0);
        HALF_STEP(pA0, pA1, mnA, alA, pB0, pB1, alB, t + 1, 0, 1, 1);
    }
    const bool even = (NT & 1) == 0;
    if (even) { SBAR(); qkt<1, SK>(pB0, pB1, K_lds, r32, hi, S.qr, ACT(NT - 1)); SBAR(); }
#define QROW(e) (nxt.Q + (size_t)(wid * QBLK + r32) * PITCH + ((e) >> 1) * 16 + hi * 8 + ((e) & 1) * 4)
    if constexpr (F32) { SLOAD_F((const float*)nxt.K, kbn); SBAR();
#pragma unroll
        for (int e = 0; e < 8; ++e) S.tq[e] = *(const f32x4*)QROW(e); }
    else { SLOAD_H(nxt.K, nxt.V, kbn); SBAR();
#pragma unroll
        for (int d0 = 0; d0 < 8; ++d0) S.qr[d0] = *(const GAS bf16x8*)(uni((const char*)nxt.Q + d0 * 32) + qoff); }
    SBAR();
    finishSM(pA0, pA1, alA, l_reg, pa0, pa1, pa2, pa3); SBAR();
    if constexpr (F32) {
#pragma unroll
        for (int e = 8; e < 16; ++e) S.tq[e] = *(const f32x4*)QROW(e); SBAR(); }
#undef QROW
    pv_tile<0, SK>(o, vb0, pa0, pa1, pa2, pa3, ACT(even ? NT - 2 : NT - 1));
    if (even) { MASKT(pB0, pB1, NT - 1); partialSM(pB0, pB1, m_reg, mnB, alB); __syncthreads(); RESC(alB);
        finishSM(pB0, pB1, alB, l_reg, pa0, pa1, pa2, pa3); SBAR(); pv_tile<1, SK>(o, vb0, pa0, pa1, pa2, pa3, ACT(NT - 1)); }
    SBAR(); SEAM_K0();
    if (hi == 0) li_l[r32] = l_reg; asm volatile("s_waitcnt lgkmcnt(0)" ::: "memory");
    float rli[16];
#pragma unroll
    for (int r = 0; r < 16; ++r) { const float li_ = li_l[crow(r, hi)]; rli[r] = li_ > 0.f ? __builtin_amdgcn_rcpf(li_) : 0.f; }
    if (cur.OP) {
        if (hi == 0) cur.LSE[wid * QBLK + r32] = l_reg > 0.f ? m_reg * (1.4426950408889634f * SCALE) + __builtin_amdgcn_logf(l_reg) : -__builtin_inff();
        GAS char* Ow = (GAS char*)uni(cur.OP + (size_t)(wid * QBLK) * 128);
        unsigned obase = (unsigned)((4 * hi * 128 + r32) * 2); asm volatile("" : "+v"(obase));
#pragma unroll
        for (int r = 0; r < 16; ++r) {
#pragma unroll
            for (int d0 = 0; d0 < 4; ++d0) { const float v = o[d0][r] * rli[r];
                const float vn = __shfl_xor(v, 1);
                if ((r32 & 1) == 0) *(GAS unsigned*)(Ow + (obase + (unsigned)((((r & 3) + 8 * (r >> 2)) * 128 + d0 * 32) * 2))) = cvtpk(v, vn); } }
    } else {
        GAS char* Ow = (GAS char*)uni(cur.O + (size_t)(wid * QBLK) * OPITCH);
        unsigned obase = (unsigned)((4 * hi * OPITCH + r32) * 2); asm volatile("" : "+v"(obase));
#pragma unroll
        for (int r = 0; r < 16; ++r) {
#pragma unroll
            for (int d0 = 0; d0 < 4; ++d0) { const float v = o[d0][r] * rli[r];
                const float vn = __shfl_xor(v, 1);
                if ((r32 & 1) == 0) *(GAS unsigned*)(Ow + (obase + (unsigned)((((r & 3) + 8 * (r >> 2)) * OPITCH + d0 * 32) * 2))) = cvtpk(v, vn); } }
    }
    if constexpr (F32) {
#pragma unroll
        for (int d0 = 0; d0 < 8; ++d0) S.qr[d0] = pack8(S.tq[2 * d0], S.tq[2 * d0 + 1]); }
    __syncthreads();
#undef RESC
#undef KBASE
#undef ACT
#undef MASKT
#undef SEAM_K0
#undef HALF_STEP
}
#undef ROW
#undef VMW
#undef VMWN
#undef SLOAD_H
#undef LD16U
#undef SWRITE_HK
#undef SWRITE_HV
#undef SWRITE_H
#undef SLOAD_F
#undef SWRITE_KF
#undef SWRITE_VF
}
namespace dn {
typedef short bf16x8 __attribute__((ext_vector_type(8)));
typedef float f32x16 __attribute__((ext_vector_type(16)));
typedef float f32x4 __attribute__((ext_vector_type(4)));
typedef unsigned u32x4 __attribute__((ext_vector_type(4)));
typedef unsigned u32x2 __attribute__((ext_vector_type(2)));
#define DNI __device__ __forceinline__
#define DN_MFMA(a, b, c) __builtin_amdgcn_mfma_f32_32x32x16_bf16((a), (b), (c), 0, 0, 0)
constexpr int LQ = 136, LT = 72;
constexpr int BLOB_FRAGS = 56, BLOB_BYTES = BLOB_FRAGS * 1024, UF_BYTES = 16384;
constexpr int L_QS = 0, L_KS = 17408, L_KST = 34816, L_VST = 53248, L_AF = 71680, L_ABF = 89088, L_TRM = 98304, L_TW = 107520, L_TU = 116736,
              L_T00T = 125952, L_GATE = 128512, L_CONVW = 129536, L_END = 135680;
DNI int crow(int i, int h) { return (i & 3) + 8 * (i >> 2) + 4 * h; }
DNI unsigned cvtpk2(float lo, float hi) {
    typedef float f2_t __attribute__((ext_vector_type(2))); typedef __bf16 b2_t __attribute__((ext_vector_type(2)));
    f2_t v = {lo, hi}; b2_t b = __builtin_convertvector(v, b2_t); return __builtin_bit_cast(unsigned, b);
}
template <int SS> DNI bf16x8 pack_acc(const f32x16& x) {
    u32x4 p = {cvtpk2(x[8 * SS], x[8 * SS + 1]), cvtpk2(x[8 * SS + 2], x[8 * SS + 3]), cvtpk2(x[8 * SS + 4], x[8 * SS + 5]), cvtpk2(x[8 * SS + 6], x[8 * SS + 7])};
    return __builtin_bit_cast(bf16x8, p);
}
DNI bf16x8 lds16(const LAS unsigned char* p) { return *(const LAS bf16x8*)p; }
DNI bf16x8 lds_perm8(const LAS unsigned char* rowp, int colbase, int h) {
    const u32x2 a = *(const LAS u32x2*)(rowp + (colbase + 4 * h) * 2), b = *(const LAS u32x2*)(rowp + (colbase + 8 + 4 * h) * 2);
    u32x4 p = {a.x, a.y, b.x, b.y}; return __builtin_bit_cast(bf16x8, p);
}
DNI float bflo_(unsigned w) { return __uint_as_float(w << 16); }
DNI float bfhi_(unsigned w) { return __uint_as_float(w & 0xffff0000u); }

DNI void chunk_local(LAS unsigned char* lds, int item, const bf16* PJ, size_t pj_stride, const float* GATES, const float* conv_w, const float* a_log, const float* dt_bias,
                     unsigned char* BLOB, unsigned char* UF, float* GL) {
    int tid = threadIdx.x; asm volatile("" : "+v"(tid));
    const int wid = __builtin_amdgcn_readfirstlane(tid >> 6), lane = tid & 63, r = lane & 31, h2 = lane >> 5;
    const int n = item & 63, hd = (item >> 6) & 3, b = item >> 8;
    const size_t row0 = (size_t)b * 4096 + (size_t)n * 64;
    LAS float* gate = (LAS float*)(lds + L_GATE);
    LAS float* convw = (LAS float*)(lds + L_CONVW);
    unsigned char* blob = BLOB + (size_t)item * BLOB_BYTES;
    for (int i = tid; i < 4 * 384; i += 512) { const int j = i / 384, c = i % 384; convw[i] = conv_w[j * 1536 + (c >> 7) * 512 + hd * 128 + (c & 127)]; }
    if (wid == 0) {
        const size_t m = row0 + lane;
        const float braw = GATES[m * 8 + hd], araw = GATES[m * 8 + 4 + hd];
        const float beta = 1.f / (1.f + __expf(-braw));
        const float sp = fmaxf(araw + dt_bias[hd], 0.f) + log1pf(__expf(-fabsf(araw + dt_bias[hd])));
        float g = -__expf(a_log[hd]) * sp;
#pragma unroll
        for (int d = 1; d < 64; d <<= 1) { const float t = __shfl_up(g, d); if (lane >= d) g += t; }
        const float glast = __shfl(g, 63);
        gate[lane] = beta; gate[64 + lane] = g; gate[128 + lane] = __expf(g); gate[192 + lane] = __expf(glast - g);
        if (lane == 63) GL[item] = __expf(glast);
    }
    __syncthreads();
    {
        const int row = tid >> 3, seg = tid & 7, c0 = seg * 16, t = n * 64 + row;
        float val[3][16];
#pragma unroll
        for (int X = 0; X < 3; ++X) {
#pragma unroll
            for (int e = 0; e < 16; ++e) val[X][e] = 0.f;
#pragma unroll
            for (int j = 0; j < 4; ++j) {
                if (t - 3 + j >= 0) {
                    const bf16* src = PJ + (size_t)X * pj_stride + (row0 + row - 3 + j) * 512 + hd * 128 + c0;
                    const u32x4 w0 = *(const u32x4*)src, w1 = *(const u32x4*)(src + 8);
                    const LAS float* cw = convw + j * 384 + X * 128 + c0;
#pragma unroll
                    for (int e = 0; e < 4; ++e) { val[X][2 * e] += cw[2 * e] * bflo_(w0[e]); val[X][2 * e + 1] += cw[2 * e + 1] * bfhi_(w0[e]);
                                                  val[X][8 + 2 * e] += cw[8 + 2 * e] * bflo_(w1[e]); val[X][8 + 2 * e + 1] += cw[8 + 2 * e + 1] * bfhi_(w1[e]); }
                }
            }
#pragma unroll
            for (int e = 0; e < 16; ++e) val[X][e] = val[X][e] / (1.f + __expf(-val[X][e]));
        }
        float sq = 0.f, sk = 0.f;
#pragma unroll
        for (int e = 0; e < 16; ++e) { sq += val[0][e] * val[0][e]; sk += val[1][e] * val[1][e]; }
        sq += __shfl_xor(sq, 1); sq += __shfl_xor(sq, 2); sq += __shfl_xor(sq, 4);
        sk += __shfl_xor(sk, 1); sk += __shfl_xor(sk, 2); sk += __shfl_xor(sk, 4);
        const float rq = rsqrtf(sq + 1e-6f) * 0.08838834764831845f, rk = rsqrtf(sk + 1e-6f);
        u32x4 qa, qb, ka, kb;
#pragma unroll
        for (int e = 0; e < 4; ++e) { qa[e] = cvtpk2(val[0][2 * e] * rq, val[0][2 * e + 1] * rq); qb[e] = cvtpk2(val[0][8 + 2 * e] * rq, val[0][8 + 2 * e + 1] * rq);
                                      ka[e] = cvtpk2(val[1][2 * e] * rk, val[1][2 * e + 1] * rk); kb[e] = cvtpk2(val[1][8 + 2 * e] * rk, val[1][8 + 2 * e + 1] * rk); }
        *(LAS u32x4*)(lds + L_QS + (row * LQ + c0) * 2) = qa; *(LAS u32x4*)(lds + L_QS + (row * LQ + c0 + 8) * 2) = qb;
        *(LAS u32x4*)(lds + L_KS + (row * LQ + c0) * 2) = ka; *(LAS u32x4*)(lds + L_KS + (row * LQ + c0 + 8) * 2) = kb;
#pragma unroll
        for (int e = 0; e < 16; ++e) {
            const unsigned kw = (e < 8) ? ka[e >> 1] : kb[(e - 8) >> 1];
            *(LAS unsigned short*)(lds + L_KST + ((c0 + e) * LT + row) * 2) = (unsigned short)((e & 1) ? (kw >> 16) : (kw & 0xffffu));
            *(LAS unsigned short*)(lds + L_VST + ((c0 + e) * LT + row) * 2) = (unsigned short)(cvtpk2(val[2][e], 0.f) & 0xffffu);
        }
    }
    __syncthreads();
    {
        const int p = wid >> 2, ri = (wid >> 1) & 1, ci = wid & 1;
        const LAS unsigned char* Ap = lds + L_KS + ((32 * ri + r) * LQ + 8 * h2) * 2;
        const LAS unsigned char* Bp = lds + (p == 0 ? L_KS : L_QS) + ((32 * ci + r) * LQ + 8 * h2) * 2;
        f32x16 acc = {};
        const bool live = (p == 0) ? (ri >= ci) : (ri <= ci);
        if (live) {
#pragma unroll
            for (int ks = 0; ks < 8; ++ks) acc = DN_MFMA(lds16(Ap + ks * 32), lds16(Bp + ks * 32), acc);
        }
        const int colg = 32 * ci + r;
        const float gcol = gate[64 + colg];
        if (p == 0) {
#pragma unroll
            for (int i = 0; i < 16; ++i) {
                const int c = 32 * ri + crow(i, h2);
                const float a = (c > colg) ? gate[c] * acc[i] * __expf(gate[64 + c] - gcol) : 0.f;
                *(LAS float*)(lds + L_AF + (c * 68 + colg) * 4) = a;
                *(LAS unsigned short*)(lds + L_ABF + (c * LT + colg) * 2) = (unsigned short)(cvtpk2(a, 0.f) & 0xffffu);
            }
        } else {
            f32x16 x;
#pragma unroll
            for (int i = 0; i < 16; ++i) { const int s = 32 * ri + crow(i, h2); x[i] = (colg >= s) ? acc[i] * __expf(gcol - gate[64 + s]) : 0.f; }
            *(u32x4*)(blob + (32 + ci * 4 + 2 * ri + 0) * 1024 + lane * 16) = __builtin_bit_cast(u32x4, pack_acc<0>(x));
            *(u32x4*)(blob + (32 + ci * 4 + 2 * ri + 1) * 1024 + lane * 16) = __builtin_bit_cast(u32x4, pack_acc<1>(x));
        }
    }
    __syncthreads();
    if (wid == 0) {
        const int blk = h2, j = r, jg = 32 * blk + j;
        float x[32];
#pragma unroll
        for (int c = 0; c < 32; ++c) {
            float a0 = (c == j) ? 1.f : 0.f, a1 = 0.f, a2 = 0.f, a3 = 0.f;
            const LAS float* arow = (const LAS float*)(lds + L_AF) + (32 * blk + c) * 68 + 32 * blk;
#pragma unroll
            for (int s = 0; s < c; ++s) { const float t_ = arow[s] * x[s]; if ((s & 3) == 0) a0 -= t_; else if ((s & 3) == 1) a1 -= t_; else if ((s & 3) == 2) a2 -= t_; else a3 -= t_; }
            x[c] = (a0 + a1) + (a2 + a3);
        }
        const float sw = gate[jg] * gate[128 + jg], su = gate[jg];
#pragma unroll
        for (int c = 0; c < 32; ++c) {
            const int off = ((32 * blk + c) * LT + jg) * 2;
            *(LAS unsigned short*)(lds + L_TRM + off) = (unsigned short)(cvtpk2(x[c], 0.f) & 0xffffu);
            *(LAS unsigned short*)(lds + L_TW + off) = (unsigned short)(cvtpk2(x[c] * sw, 0.f) & 0xffffu);
            *(LAS unsigned short*)(lds + L_TU + off) = (unsigned short)(cvtpk2(x[c] * su, 0.f) & 0xffffu);
        }
        if (blk == 0) {
#pragma unroll
            for (int c4 = 0; c4 < 4; ++c4) { u32x4 w = {cvtpk2(x[8 * c4], x[8 * c4 + 1]), cvtpk2(x[8 * c4 + 2], x[8 * c4 + 3]), cvtpk2(x[8 * c4 + 4], x[8 * c4 + 5]), cvtpk2(x[8 * c4 + 6], x[8 * c4 + 7])};
                *(LAS u32x4*)(lds + L_T00T + (j * 40 + 8 * c4) * 2) = w; }
        }
        asm volatile("s_waitcnt lgkmcnt(0)" ::: "memory");
        f32x16 m1 = {};
#pragma unroll
        for (int ks = 0; ks < 2; ++ks) m1 = DN_MFMA(lds16(lds + L_ABF + ((32 + r) * LT + 16 * ks + 8 * h2) * 2), lds16(lds + L_T00T + (r * 40 + 16 * ks + 8 * h2) * 2), m1);
        f32x16 t10 = {};
        t10 = DN_MFMA(lds_perm8(lds + L_TRM + ((32 + r) * LT) * 2, 32 + 0, h2), pack_acc<0>(m1), t10);
        t10 = DN_MFMA(lds_perm8(lds + L_TRM + ((32 + r) * LT) * 2, 32 + 16, h2), pack_acc<1>(m1), t10);
        const float sw0 = gate[r] * gate[128 + r], su0 = gate[r];
#pragma unroll
        for (int i = 0; i < 16; ++i) {
            const int off = ((32 + crow(i, h2)) * LT + r) * 2; const float tv = -t10[i];
            *(LAS unsigned short*)(lds + L_TW + off) = (unsigned short)(cvtpk2(tv * sw0, 0.f) & 0xffffu);
            *(LAS unsigned short*)(lds + L_TU + off) = (unsigned short)(cvtpk2(tv * su0, 0.f) & 0xffffu);
        }
    } else {
        for (int f = wid - 1; f < 32; f += 7) {
            bf16x8 v; float sc[8];
            if (f < 16) {
                const int mt = f >> 3, s = f & 7, row = 32 * mt + r;
                v = lds_perm8(lds + L_QS + (row * LQ) * 2, 32 * (s >> 1) + 16 * (s & 1), h2);
                const float e = gate[128 + row];
#pragma unroll
                for (int jj = 0; jj < 8; ++jj) sc[jj] = e;
            } else {
                const int kt = (f - 16) >> 2, s2 = (f - 16) & 3, row = 32 * kt + r, cb = 32 * (s2 >> 1) + 16 * (s2 & 1);
                v = lds_perm8(lds + L_KST + (row * LT) * 2, cb, h2);
#pragma unroll
                for (int jj = 0; jj < 8; ++jj) sc[jj] = gate[192 + cb + 8 * (jj >> 2) + 4 * h2 + (jj & 3)];
            }
            const u32x4 w = __builtin_bit_cast(u32x4, v);
            u32x4 o;
#pragma unroll
            for (int e = 0; e < 4; ++e) o[e] = cvtpk2(bflo_(w[e]) * sc[2 * e], bfhi_(w[e]) * sc[2 * e + 1]);
            *(u32x4*)(blob + (f < 16 ? 16 + f : 40 + (f - 16)) * 1024 + lane * 16) = o;
        }
    }
    __syncthreads();
    {
        const int kt = wid >> 1, mt = wid & 1;
        f32x16 wt = {}, ut = {};
        const int nks = mt == 0 ? 2 : 4;
        for (int ks = 0; ks < nks; ++ks) {
            wt = DN_MFMA(lds16(lds + L_KST + ((32 * kt + r) * LT + 16 * ks + 8 * h2) * 2), lds16(lds + L_TW + ((32 * mt + r) * LT + 16 * ks + 8 * h2) * 2), wt);
            ut = DN_MFMA(lds16(lds + L_TU + ((32 * mt + r) * LT + 16 * ks + 8 * h2) * 2), lds16(lds + L_VST + ((32 * kt + r) * LT + 16 * ks + 8 * h2) * 2), ut);
        }
#pragma unroll
        for (int i = 0; i < 16; ++i) wt[i] = -wt[i];
        *(u32x4*)(blob + (mt * 8 + 2 * kt + 0) * 1024 + lane * 16) = __builtin_bit_cast(u32x4, pack_acc<0>(wt));
        *(u32x4*)(blob + (mt * 8 + 2 * kt + 1) * 1024 + lane * 16) = __builtin_bit_cast(u32x4, pack_acc<1>(wt));
        unsigned char* uf = UF + (size_t)item * UF_BYTES + ((kt * 2 + mt) * 64 + lane) * 32;
        *(u32x4*)uf = __builtin_bit_cast(u32x4, pack_acc<0>(ut)); *(u32x4*)(uf + 16) = __builtin_bit_cast(u32x4, pack_acc<1>(ut));
    }
    __syncthreads();
}

constexpr int S_SLOT = 32768, S_END = 4 * S_SLOT;
DNI void glds16(const void* gsrc, LAS unsigned char* dst) { __builtin_amdgcn_global_load_lds((const GAS unsigned*)gsrc, (LAS unsigned*)dst, 16, 0, 0); }
DNI void scan_bh(LAS unsigned char* lds, int bh, const unsigned char* BLOB, const unsigned char* UF, const float* GL, unsigned char* SF, unsigned char* VF) {
    int tid = threadIdx.x; asm volatile("" : "+v"(tid));
    const int wid = __builtin_amdgcn_readfirstlane(tid >> 6), lane = tid & 63;
    const unsigned char* blob0 = BLOB + (size_t)bh * 64 * BLOB_BYTES;
    unsigned lane16 = (unsigned)lane * 16u; asm volatile("" : "+v"(lane16));
#define DN_B() do { __builtin_amdgcn_s_barrier(); asm volatile("" ::: "memory"); } while (0)
    if (wid >= 4) {
        const int lw = wid - 4;
#define DN_ISSUE(c) do { const unsigned char* bc_ = blob0 + (size_t)(c) * BLOB_BYTES + lw * 1024; LAS unsigned char* sl_ = lds + ((c) & 3) * S_SLOT + lw * 1024; _Pragma("unroll") for (int i_ = 0; i_ < 4; ++i_) { \
        glds16(bc_ + i_ * 4096 + lane16, sl_ + i_ * 4096); glds16(bc_ + 40960 + i_ * 4096 + lane16, sl_ + 16384 + i_ * 4096); } } while (0)
        DN_ISSUE(0); DN_ISSUE(1); DN_ISSUE(2);
        asm volatile("s_waitcnt vmcnt(16)" ::: "memory"); DN_B();
#pragma unroll 1
        for (int c = 0; c < 64; ++c) {
            if (c + 3 < 64) { DN_ISSUE(c + 3); asm volatile("s_waitcnt vmcnt(16)" ::: "memory"); }
            else if (c + 2 < 64) asm volatile("s_waitcnt vmcnt(8)" ::: "memory");
            else asm volatile("s_waitcnt vmcnt(0)" ::: "memory");
            DN_B();
        }
#undef DN_ISSUE
    } else {
        const float glv = GL[bh * 64 + lane];
        const unsigned char* uf0 = UF + (size_t)bh * 64 * UF_BYTES + (wid * 128 + lane) * 32;
        unsigned char* sf0 = SF + ((size_t)(bh * 64) * 4 + wid) * 8192 + lane * 16;
        unsigned char* vf0 = VF + ((size_t)(bh * 64) * 4 + wid) * 4096 + lane * 16;
        f32x16 S0 = {}, S1 = {}, S2 = {}, S3 = {};
        u32x4 ua[4], ub[4];
#define DN_ULOAD(U, c) do { const unsigned char* u_ = uf0 + (size_t)(c) * UF_BYTES; U[0] = *(const u32x4*)u_; U[1] = *(const u32x4*)(u_ + 16); U[2] = *(const u32x4*)(u_ + 2048); U[3] = *(const u32x4*)(u_ + 2048 + 16); } while (0)
        DN_ULOAD(ua, 0); DN_ULOAD(ub, 1);
        DN_B();
#define RD4(X, f0, f1, f2, f3) do { asm volatile("ds_read_b128 %0, %4 offset:%5\n\tds_read_b128 %1, %4 offset:%6\n\tds_read_b128 %2, %4 offset:%7\n\tds_read_b128 %3, %4 offset:%8" \
        : "=&v"(X##0), "=&v"(X##1), "=&v"(X##2), "=&v"(X##3) : "v"(fba), "i"((f0) * 1024), "i"((f1) * 1024), "i"((f2) * 1024), "i"((f3) * 1024)); __builtin_amdgcn_sched_barrier(0); } while (0)
#define PIN2(a, b) asm volatile("" : "+v"(a), "+v"(b))
#define PIN4(a, b, c, d) asm volatile("" : "+v"(a), "+v"(b), "+v"(c), "+v"(d))
#define LWAIT() do { asm volatile("s_waitcnt lgkmcnt(0)" ::: "memory"); __builtin_amdgcn_sched_barrier(0); } while (0)
#define DN_STEP(U, c) do { \
            const unsigned fba = (unsigned)(uintptr_t)(lds + ((c) & 3) * S_SLOT) + lane16; \
            const float gl = __builtin_bit_cast(float, __builtin_amdgcn_readlane(__builtin_bit_cast(int, glv), (c))); \
            f32x16 v0, v1; \
            _Pragma("unroll") for (int i = 0; i < 8; ++i) { v0[2 * i] = bflo_(U[i >> 2][i & 3]); v0[2 * i + 1] = bfhi_(U[i >> 2][i & 3]); v1[2 * i] = bflo_(U[2 + (i >> 2)][i & 3]); v1[2 * i + 1] = bfhi_(U[2 + (i >> 2)][i & 3]); } \
            PIN2(v0, v1); \
            if ((c) + 2 < 64) DN_ULOAD(U, (c) + 2); \
            asm volatile("s_waitcnt lgkmcnt(0)" ::: "memory"); \
            unsigned char* sfc = sf0 + (size_t)(c) * 32768; unsigned char* vfc = vf0 + (size_t)(c) * 16384; \
            bf16x8 A0, A1, A2, A3, B0, B1, B2, B3; \
            RD4(A, 0, 8, 1, 9); LWAIT(); \
              \
            { const bf16x8 s0_ = pack_acc<0>(S0), s1_ = pack_acc<1>(S0); *(u32x4*)(sfc) = __builtin_bit_cast(u32x4, s0_); *(u32x4*)(sfc + 1024) = __builtin_bit_cast(u32x4, s1_); RD4(B, 2, 10, 3, 11); \
              v0 = DN_MFMA(A0, s0_, v0); v1 = DN_MFMA(A1, s0_, v1); v0 = DN_MFMA(A2, s1_, v0); v1 = DN_MFMA(A3, s1_, v1); PIN2(v0, v1); LWAIT(); } \
            { const bf16x8 s0_ = pack_acc<0>(S1), s1_ = pack_acc<1>(S1); *(u32x4*)(sfc + 2048) = __builtin_bit_cast(u32x4, s0_); *(u32x4*)(sfc + 3072) = __builtin_bit_cast(u32x4, s1_); RD4(A, 4, 12, 5, 13); \
              v0 = DN_MFMA(B0, s0_, v0); v1 = DN_MFMA(B1, s0_, v1); v0 = DN_MFMA(B2, s1_, v0); v1 = DN_MFMA(B3, s1_, v1); PIN2(v0, v1); LWAIT(); } \
            { const bf16x8 s0_ = pack_acc<0>(S2), s1_ = pack_acc<1>(S2); *(u32x4*)(sfc + 4096) = __builtin_bit_cast(u32x4, s0_); *(u32x4*)(sfc + 5120) = __builtin_bit_cast(u32x4, s1_); RD4(B, 6, 14, 7, 15); \
              v0 = DN_MFMA(A0, s0_, v0); v1 = DN_MFMA(A1, s0_, v1); v0 = DN_MFMA(A2, s1_, v0); v1 = DN_MFMA(A3, s1_, v1); PIN2(v0, v1); LWAIT(); } \
            { const bf16x8 s0_ = pack_acc<0>(S3), s1_ = pack_acc<1>(S3); *(u32x4*)(sfc + 6144) = __builtin_bit_cast(u32x4, s0_); *(u32x4*)(sfc + 7168) = __builtin_bit_cast(u32x4, s1_); RD4(A, 16, 20, 24, 28); \
              v0 = DN_MFMA(B0, s0_, v0); v1 = DN_MFMA(B1, s0_, v1); v0 = DN_MFMA(B2, s1_, v0); v1 = DN_MFMA(B3, s1_, v1); PIN2(v0, v1); LWAIT(); } \
            const bf16x8 vf0_ = pack_acc<0>(v0), vf1_ = pack_acc<1>(v0), vf2_ = pack_acc<0>(v1), vf3_ = pack_acc<1>(v1); \
            *(u32x4*)(vfc) = __builtin_bit_cast(u32x4, vf0_); *(u32x4*)(vfc + 1024) = __builtin_bit_cast(u32x4, vf1_); *(u32x4*)(vfc + 2048) = __builtin_bit_cast(u32x4, vf2_); *(u32x4*)(vfc + 3072) = __builtin_bit_cast(u32x4, vf3_); \
            _Pragma("unroll") for (int i = 0; i < 16; ++i) { S0[i] *= gl; S1[i] *= gl; S2[i] *= gl; S3[i] *= gl; } \
              \
            RD4(B, 17, 21, 25, 29); \
            S0 = DN_MFMA(A0, vf0_, S0); S1 = DN_MFMA(A1, vf0_, S1); S2 = DN_MFMA(A2, vf0_, S2); S3 = DN_MFMA(A3, vf0_, S3); PIN4(S0, S1, S2, S3); LWAIT(); \
            RD4(A, 18, 22, 26, 30); \
            S0 = DN_MFMA(B0, vf1_, S0); S1 = DN_MFMA(B1, vf1_, S1); S2 = DN_MFMA(B2, vf1_, S2); S3 = DN_MFMA(B3, vf1_, S3); PIN4(S0, S1, S2, S3); LWAIT(); \
            RD4(B, 19, 23, 27, 31); \
            S0 = DN_MFMA(A0, vf2_, S0); S1 = DN_MFMA(A1, vf2_, S1); S2 = DN_MFMA(A2, vf2_, S2); S3 = DN_MFMA(A3, vf2_, S3); PIN4(S0, S1, S2, S3); LWAIT(); \
            S0 = DN_MFMA(B0, vf3_, S0); S1 = DN_MFMA(B1, vf3_, S1); S2 = DN_MFMA(B2, vf3_, S2); S3 = DN_MFMA(B3, vf3_, S3); PIN4(S0, S1, S2, S3); \
            __builtin_amdgcn_sched_barrier(0); \
            DN_B(); } while (0)
#pragma unroll 1
        for (int c = 0; c < 64; c += 2) { DN_STEP(ua, c); DN_STEP(ub, c + 1); }
#undef DN_STEP
#undef RD4
#undef PIN2
#undef PIN4
#undef LWAIT
#undef DN_ULOAD
    }
    __syncthreads();
#undef DN_B
}

constexpr int O_OT = 0, O_NW = 2 * 64 * LQ * 2, O_END = O_NW + 512;
DNI void chunk_out(LAS unsigned char* lds, int item, const unsigned char* BLOB, const unsigned char* SF, const unsigned char* VF, const bf16* DNZ, const float* norm_w, bf16* Y) {
    int tid = threadIdx.x; asm volatile("" : "+v"(tid));
    const int wid = __builtin_amdgcn_readfirstlane(tid >> 6), lane = tid & 63, r = lane & 31, h2 = lane >> 5, half = wid >> 2, w = wid & 3;
    const int ck = 2 * item + half;
    const int n = ck & 63, hd = (ck >> 6) & 3, b = ck >> 8;
    if (tid < 128) ((LAS float*)(lds + O_NW))[tid] = norm_w[tid];
    const unsigned char* blob = BLOB + (size_t)ck * BLOB_BYTES + lane * 16;
    const unsigned char* sfp = SF + ((size_t)ck * 4 + w) * 8192 + lane * 16;
    const unsigned char* vfp = VF + ((size_t)ck * 4 + w) * 4096 + lane * 16;
    f32x16 o0 = {}, o1 = {};
#define GF(f) (*(const bf16x8*)(blob + (f) * 1024))
    {
        bf16x8 sf[8], vf[4], qa[8], qb[8];
#pragma unroll
        for (int s = 0; s < 8; ++s) { sf[s] = *(const bf16x8*)(sfp + s * 1024); qa[s] = GF(16 + s); }
#pragma unroll
        for (int s = 0; s < 8; ++s) qb[s] = GF(24 + s);
#pragma unroll
        for (int s2 = 0; s2 < 4; ++s2) vf[s2] = *(const bf16x8*)(vfp + s2 * 1024);
#pragma unroll
        for (int s = 0; s < 8; ++s) o0 = DN_MFMA(qa[s], sf[s], o0);
#pragma unroll
        for (int s2 = 0; s2 < 4; ++s2) { qa[s2] = GF(32 + s2); qa[4 + s2] = GF(36 + s2); }
#pragma unroll
        for (int s = 0; s < 8; ++s) o1 = DN_MFMA(qb[s], sf[s], o1);
#pragma unroll
        for (int s2 = 0; s2 < 4; ++s2) { o0 = DN_MFMA(qa[s2], vf[s2], o0); o1 = DN_MFMA(qa[4 + s2], vf[s2], o1); }
    }
#undef GF
    {
        LAS unsigned char* obp = lds + O_OT + half * (64 * LQ * 2) + ((4 * h2) * LQ + 32 * w + r) * 2;
#pragma unroll
        for (int i = 0; i < 16; ++i) {
            *(LAS unsigned short*)(obp + ((i & 3) + 8 * (i >> 2)) * (LQ * 2)) = (unsigned short)(cvtpk2(o0[i], 0.f) & 0xffffu);
            *(LAS unsigned short*)(obp + (32 + (i & 3) + 8 * (i >> 2)) * (LQ * 2)) = (unsigned short)(cvtpk2(o1[i], 0.f) & 0xffffu);
        }
    }
    __syncthreads();
    {
        const int t4 = tid & 255, pos = t4 >> 2, seg = t4 & 3;
        const LAS unsigned char* op = lds + O_OT + half * (64 * LQ * 2) + (pos * LQ + seg * 32) * 2;
        u32x4 wv[4];
#pragma unroll
        for (int q = 0; q < 4; ++q) wv[q] = *(const LAS u32x4*)(op + q * 16);
        float ss = 0.f;
#pragma unroll
        for (int q = 0; q < 4; ++q)
#pragma unroll
            for (int e = 0; e < 4; ++e) { const float a = bflo_(wv[q][e]), c = bfhi_(wv[q][e]); ss += a * a + c * c; }
        ss += __shfl_xor(ss, 1); ss += __shfl_xor(ss, 2);
        const float rs = rsqrtf(ss * (1.f / 128.f) + 1e-6f);
        const size_t m = (size_t)b * 4096 + (size_t)n * 64 + pos;
        const bf16* zp = DNZ + m * 512 + hd * 128 + seg * 32; bf16* yp = Y + m * 1024 + hd * 128 + seg * 32; const LAS float* nw = (const LAS float*)(lds + O_NW) + seg * 32;
#pragma unroll
        for (int q = 0; q < 4; ++q) {
            const u32x4 z = *(const u32x4*)(zp + q * 8); u32x4 o;
#pragma unroll
            for (int e = 0; e < 4; ++e) {
                const float z0 = bflo_(z[e]), z1 = bfhi_(z[e]);
                o[e] = cvtpk2(bflo_(wv[q][e]) * rs * nw[q * 8 + 2 * e] * (z0 / (1.f + __expf(-z0))), bfhi_(wv[q][e]) * rs * nw[q * 8 + 2 * e + 1] * (z1 / (1.f + __expf(-z1))));
            }
            *(u32x4*)(yp + q * 8) = o;
        }
    }
    __syncthreads();
}
#undef DN_MFMA
#undef DNI
}
constexpr int NWAVES = 8, NTHR = NWAVES * 64;
constexpr int BATCH = 4, SEQ = 4096, DM = 1024, M = BATCH * SEQ;
constexpr int HD = 128, NH = 4, DDN = 512, DMB = 512, NPROJ = 3584, DINP = 3592;
constexpr int MBLK = 256, NBLK = SEQ / MBLK;
constexpr int NE = 16, DE = 256;
constexpr float LN_EPS = 1e-5f, RMS_EPS = 1e-6f, ALPHA = 1.189207115002721f, QSCALE = 0.08838834764831845f;

constexpr size_t MiB = 1u << 20;
constexpr size_t WS_CTL = 0, CTL_ZERO_BYTES = 1 * MiB;
constexpr size_t WS_WIN = 2 * MiB;
constexpr size_t WS_WOUT = 10 * MiB;
constexpr size_t WS_WGU = 12 * MiB;
constexpr size_t WS_WD = 28 * MiB;
constexpr size_t WS_ROPE = 36 * MiB;
constexpr size_t WS_KMP = 38 * MiB;
constexpr size_t WS_GATES = 39 * MiB;
constexpr size_t WS_BETA = WS_GATES + 512 * 1024;
constexpr size_t WS_GLOG = WS_BETA + 256 * 1024;
constexpr size_t WS_XB = 48 * MiB;
constexpr size_t WS_DNQN = 48 * MiB, WS_DNKN = 64 * MiB;
constexpr size_t WS_PJ = 80 * MiB;
constexpr size_t PJ_STRIDE = 16 * MiB;
constexpr size_t WS_Y = 192 * MiB;
constexpr size_t WS_DNVN = 224 * MiB;
constexpr size_t WS_GL = 40 * MiB;
constexpr size_t WS_SF = 48 * MiB;
constexpr size_t WS_VF = 224 * MiB;
constexpr size_t WS_UF = 240 * MiB;
constexpr size_t WS_TOKE = 41 * MiB;
constexpr size_t WS_TOKP = WS_TOKE + 256 * 1024;
constexpr size_t WS_TOKW = WS_TOKP + 256 * 1024;
constexpr size_t WS_HB = 48 * MiB;
constexpr size_t WS_HS = 80 * MiB;
constexpr size_t WS_HE = 152 * MiB;
constexpr size_t WS_Y2 = 170 * MiB;
constexpr size_t WS_MIXB = 224 * MiB;
constexpr size_t WS_END = 256 * MiB;
constexpr int CW_CNT = 64;
constexpr int CW_SEAM = 16384;
constexpr size_t WS_LIST = 43 * MiB;
constexpr size_t WS_XBUF = 42 * MiB;
constexpr int CW_BAR = 4096;

constexpr int RING_OFF = 0, RING_BYTES = 139264;
constexpr int LDSCTL_OFF = RING_BYTES, MISC_OFF = LDSCTL_OFF + 320;
constexpr int LDS_BYTES = 147456;

#define DI __device__ __forceinline__
DI float bf2f(unsigned short v) { return __uint_as_float((unsigned)v << 16); }
DI float bflo(unsigned w) { return __uint_as_float(w << 16); }
DI float bfhi(unsigned w) { return __uint_as_float(w & 0xffff0000u); }
DI float wave_sum(float v) {
#pragma unroll
    for (int o = 1; o < 64; o <<= 1) v += __shfl_xor(v, o);
    return v;
}
DI float wave_max(float v) {
#pragma unroll
    for (int o = 1; o < 64; o <<= 1) v = fmaxf(v, __shfl_xor(v, o));
    return v;
}
DI float silu_f(float v) { return v / (1.f + __expf(-v)); }
DI float softplus_f(float v) { return fmaxf(v, 0.f) + log1pf(__expf(-fabsf(v))); }

struct Args {
    const GAS float* in_[18]; GAS float* out_; GAS unsigned char* ws_; int ph_lo, ph_hi;
    DI const float* I(int k) const { return (const float*)in_[k]; }
    DI float* O() const { return (float*)out_; }
    DI unsigned char* W() const { return (unsigned char*)ws_; }
};
#define CAS __attribute__((address_space(4)))
struct KA {
    const CAS unsigned char* p;
    DI const float* I(int k) const { return (const float*)(*(const GAS float* const CAS*)(p + 8 * k)); }
    DI float* O() const { return (float*)(*(GAS float* const CAS*)(p + 144)); }
    DI unsigned char* W() const { return (unsigned char*)(*(GAS unsigned char* const CAS*)(p + 152)); }
    DI int lo() const { return *(const CAS int*)(p + 160); }
    DI int hi() const { return *(const CAS int*)(p + 164); }
};
static_assert(offsetof(Args, out_) == 144 && offsetof(Args, ws_) == 152 && offsetof(Args, ph_lo) == 160 && offsetof(Args, ph_hi) == 164, "Args layout");
DI KA kargs() { KA a; a.p = (const CAS unsigned char*)__builtin_amdgcn_kernarg_segment_ptr(); asm volatile("" : "+s"(a.p)); return a; }
struct Frame {
    LAS unsigned char* lds;
    int tid, lane, wave, vcu, G;
};

DI void p0_transpose_item(const float* W, int ldw, int src_col0, int K, bf16* WT, int dst_row0, LAS float* scr, int kb, int nb, int lane) {
    const int k0 = 64 * kb, n0 = 32 * nb;
#pragma unroll 8
    for (int i = 0; i < 32; ++i) { const int kk = 2 * i + (lane >> 5); scr[kk * 33 + (lane & 31)] = W[(size_t)(k0 + kk) * ldw + src_col0 + n0 + (lane & 31)]; }
    LDS_WAIT(); asm volatile("" ::: "memory");
    const int c = lane & 7;
#pragma unroll
    for (int j = 0; j < 4; ++j) { const int n = (lane >> 3) + 8 * j; const LAS float* s = scr + (8 * c) * 33 + n;
        v4u o; o.x = pk2(s[0 * 33], s[1 * 33]); o.y = pk2(s[2 * 33], s[3 * 33]); o.z = pk2(s[4 * 33], s[5 * 33]); o.w = pk2(s[6 * 33], s[7 * 33]);
        pg8::st16_wt(WT + (size_t)(dst_row0 + n0 + n) * K + k0 + 8 * c, o); }
    LDS_WAIT(); asm volatile("" ::: "memory");
}

DI void p0_prologue(const Frame& F, const KA& A) {
    unsigned char* ws = A.W();
    const float* x = A.I(0); const float* w_in = A.I(1); const float* w_out = A.I(6);
    const int gw = F.vcu * NWAVES + F.wave, NGW = F.G * NWAVES;
    {
        LAS float* wgl = (LAS float*)(F.lds + RING_OFF);
        for (int i = F.tid; i < 1024 * 8; i += NTHR) wgl[i] = w_in[(size_t)(i >> 3) * DINP + 2048 + (i & 7)];
        __syncthreads();
        bf16* XB = (bf16*)(ws + WS_XB); float* GATES = (float*)(ws + WS_GATES);
        for (int m0 = gw * 2; m0 < M; m0 += NGW * 2) {
            f32x4 v[2][4];
#pragma unroll
            for (int rr = 0; rr < 2; ++rr) { const GAS f32x4* xr = (const GAS f32x4*)(x + (size_t)(m0 + rr) * DM) + F.lane;
#pragma unroll
                for (int j = 0; j < 4; ++j) v[rr][j] = xr[64 * j]; }
#pragma unroll
            for (int rr = 0; rr < 2; ++rr) {
                const int m = m0 + rr;
                GAS unsigned long long* o8 = (GAS unsigned long long*)(XB + (size_t)m * DM) + F.lane;
                float g[8];
#pragma unroll
                for (int q = 0; q < 8; ++q) g[q] = 0.f;
#pragma unroll
                for (int j = 0; j < 4; ++j) {
                    o8[64 * j] = (unsigned long long)pk2(v[rr][j].x, v[rr][j].y) | ((unsigned long long)pk2(v[rr][j].z, v[rr][j].w) << 32);
#pragma unroll
                    for (int e = 0; e < 4; ++e) { const int k = 256 * j + 4 * F.lane + e; const float xv = v[rr][j][e];
                        const f32x4 w0 = *(const LAS f32x4*)(wgl + k * 8), w1 = *(const LAS f32x4*)(wgl + k * 8 + 4);
                        g[0] += xv * w0.x; g[1] += xv * w0.y; g[2] += xv * w0.z; g[3] += xv * w0.w;
                        g[4] += xv * w1.x; g[5] += xv * w1.y; g[6] += xv * w1.z; g[7] += xv * w1.w; }
                }
#pragma unroll
                for (int q = 0; q < 8; ++q) g[q] = wave_sum(g[q]);
                if (F.lane == 0) {
#pragma unroll
                    for (int q = 0; q < 8; ++q) GATES[(size_t)m * 8 + q] = g[q];
                }
            }
        }
        __syncthreads();
    }
    {
        LAS float* scr = (LAS float*)(F.lds + RING_OFF + F.wave * 16384);
        bf16* WIN = (bf16*)(ws + WS_WIN); bf16* WOUT = (bf16*)(ws + WS_WOUT);
        constexpr int I_A = 16 * 64, I_B = 16 * 48, I_O = 16 * 32, I_GU = NE * 4 * 64, I_D = NE * 128;
        const float* wgate = A.I(13); const float* wup = A.I(14); const float* wdn = A.I(15);
        bf16* WGU = (bf16*)(ws + WS_WGU); bf16* WD = (bf16*)(ws + WS_WD);
        for (int it = gw; it < I_A + I_B + I_O + I_GU + I_D; it += NGW) {
            int r = it;
            if (r < I_A) { p0_transpose_item(w_in, DINP, 0, DM, WIN, 0, scr, r / 64, r % 64, F.lane); continue; } r -= I_A;
            if (r < I_B) { p0_transpose_item(w_in, DINP, 2056, DM, WIN, 2048, scr, r / 48, r % 48, F.lane); continue; } r -= I_B;
            if (r < I_O) { p0_transpose_item(w_out, DM, 0, DM, WOUT, 0, scr, r / 32, r % 32, F.lane); continue; } r -= I_O;
            if (r < I_GU) {
                const int e = r >> 8, q = (r >> 6) & 3, pn = q >> 1, up = q & 1, kb = (r >> 2) & 15, nb = r & 3;
                p0_transpose_item((up ? wup : wgate) + (size_t)e * DM * DE, DE, pn * 128, DM, WGU, e * 512 + pn * 256 + up * 128, scr, kb, nb, F.lane); continue; } r -= I_GU;
            { const int e = r >> 7, kb = (r >> 5) & 3, nb = r & 31;
              p0_transpose_item(wdn + (size_t)e * DE * DM, DM, 0, DE, WD + (size_t)e * DM * DE, 0, scr, kb, nb, F.lane); }
        }
    }
    {
        float2* ROPE = (float2*)(ws + WS_ROPE);
        for (int i = (F.vcu * NTHR + F.tid); i < SEQ * 64; i += F.G * NTHR) {
            const int pos = i >> 6, j = i & 63;
            const float inv = exp2f(-(float)j * (13.287712379549449f / 64.f));
            const float ang = (float)pos * inv;
            double rev = (double)ang * 0.15915494309189535; rev -= __builtin_rint(rev);
            const float rr = (float)rev;
            ROPE[i] = make_float2(__builtin_amdgcn_cosf(rr), __builtin_amdgcn_sinf(rr));
        }
    }
}

DI void n2a_conv_norm(const Frame& F, const KA& A) {
    unsigned char* ws = A.W();
    const float* conv_w = A.I(2); const float* a_log = A.I(3); const float* dt_bias = A.I(4);
    const bf16* PJ = (const bf16*)(ws + WS_PJ);
    bf16* OUTX[3] = {(bf16*)(ws + WS_DNQN), (bf16*)(ws + WS_DNKN), (bf16*)(ws + WS_DNVN)};
    const float* GATES = (const float*)(ws + WS_GATES); float* BETA = (float*)(ws + WS_BETA); float* GLOG = (float*)(ws + WS_GLOG);
    const int gw = F.vcu * NWAVES + F.wave, NGW = F.G * NWAVES;
    for (int it = gw; it < M * NH; it += NGW) {
        const int m = it >> 2, h = it & 3, t = m & (SEQ - 1), c = 2 * F.lane;
        float val[3][2];
#pragma unroll
        for (int X = 0; X < 3; ++X) {
            float a0 = 0.f, a1 = 0.f;
#pragma unroll
            for (int j = 0; j < 4; ++j) {
                const int tt = t - 3 + j;
                if (tt >= 0) {
                    const unsigned raw = *(const unsigned*)(PJ + X * (PJ_STRIDE / 2) + (size_t)(m - 3 + j) * 512 + h * 128 + c);
                    const float w0 = conv_w[j * 1536 + X * 512 + h * 128 + c], w1 = conv_w[j * 1536 + X * 512 + h * 128 + c + 1];
                    a0 += w0 * bflo(raw); a1 += w1 * bfhi(raw);
                }
            }
            val[X][0] = silu_f(a0); val[X][1] = silu_f(a1);
        }
        const float sq = wave_sum(val[0][0] * val[0][0] + val[0][1] * val[0][1]);
        const float sk = wave_sum(val[1][0] * val[1][0] + val[1][1] * val[1][1]);
        const float rq = rsqrtf(sq + 1e-6f) * QSCALE, rk = rsqrtf(sk + 1e-6f);
        val[0][0] *= rq; val[0][1] *= rq; val[1][0] *= rk; val[1][1] *= rk;
#pragma unroll
        for (int X = 0; X < 3; ++X) *(unsigned*)(OUTX[X] + (size_t)m * 512 + h * 128 + c) = pk2(val[X][0], val[X][1]);
        if (F.lane == 0) {
            const float bb = GATES[(size_t)m * 8 + h], aa = GATES[(size_t)m * 8 + 4 + h];
            BETA[(size_t)m * 4 + h] = 1.f / (1.f + __expf(-bb));
            GLOG[(size_t)m * 4 + h] = -__expf(a_log[h]) * softplus_f(aa + dt_bias[h]);
        }
    }
}

DI void rope8(bf16* p, const float2* rp, float* s1, float* s2) {
    const v4u lo = *(const v4u*)p, hi = *(const v4u*)(p + 64);
    const f32x4 c0 = *(const f32x4*)rp, c1 = *(const f32x4*)(rp + 2), c2 = *(const f32x4*)(rp + 4), c3 = *(const f32x4*)(rp + 6);
    const float cs[8] = {c0.x, c0.z, c1.x, c1.z, c2.x, c2.z, c3.x, c3.z}, sn[8] = {c0.y, c0.w, c1.y, c1.w, c2.y, c2.w, c3.y, c3.w};
    float r1[8], r2[8];
#pragma unroll
    for (int e = 0; e < 4; ++e) {
        const float a0 = bflo(lo[e]), a1 = bfhi(lo[e]), b0 = bflo(hi[e]), b1 = bfhi(hi[e]);
        r1[2 * e] = a0 * cs[2 * e] - b0 * sn[2 * e]; r2[2 * e] = b0 * cs[2 * e] + a0 * sn[2 * e];
        r1[2 * e + 1] = a1 * cs[2 * e + 1] - b1 * sn[2 * e + 1]; r2[2 * e + 1] = b1 * cs[2 * e + 1] + a1 * sn[2 * e + 1];
    }
    v4u o1, o2;
#pragma unroll
    for (int e = 0; e < 4; ++e) { o1[e] = pk2(r1[2 * e], r1[2 * e + 1]); o2[e] = pk2(r2[2 * e], r2[2 * e + 1]); }
    *(v4u*)p = o1; *(v4u*)(p + 64) = o2;
    if (s1) {
#pragma unroll
        for (int e = 0; e < 8; ++e) { s1[e] += r1[e]; s2[e] += r2[e]; }
    }
}
DI void n3a_rope(const Frame& F, const KA& A) {
    unsigned char* ws = A.W();
    bf16* MBQ = (bf16*)(ws + WS_PJ + 4 * PJ_STRIDE); bf16* MBK = (bf16*)(ws + WS_PJ + 5 * PJ_STRIDE);
    const float2* ROPE = (const float2*)(ws + WS_ROPE); float* KMP = (float*)(ws + WS_KMP);
    const int gw = F.vcu * NWAVES + F.wave, NGW = F.G * NWAVES, rr = F.lane >> 3, dseg = F.lane & 7;
    for (int it = gw; it < 1024; it += NGW) {
        const int qtr = it & 3, j = (it >> 2) & 15, h = (it >> 6) & 3, b = it >> 8;
        float s1[8], s2[8];
#pragma unroll
        for (int e = 0; e < 8; ++e) { s1[e] = 0.f; s2[e] = 0.f; }
#pragma unroll 2
        for (int r8 = 0; r8 < 8; ++r8) {
            const int pos = j * 256 + qtr * 64 + r8 * 8 + rr; const size_t m = (size_t)b * SEQ + pos;
            rope8(MBK + m * 512 + h * 128 + dseg * 8, ROPE + pos * 64 + dseg * 8, s1, s2);
        }
#pragma unroll
        for (int e = 0; e < 8; ++e) { s1[e] += __shfl_xor(s1[e], 8); s1[e] += __shfl_xor(s1[e], 16); s1[e] += __shfl_xor(s1[e], 32);
                                      s2[e] += __shfl_xor(s2[e], 8); s2[e] += __shfl_xor(s2[e], 16); s2[e] += __shfl_xor(s2[e], 32); }
        if (rr == 0) {
#pragma unroll
            for (int e = 0; e < 8; ++e) { KMP[(size_t)it * 128 + dseg * 8 + e] = s1[e]; KMP[(size_t)it * 128 + 64 + dseg * 8 + e] = s2[e]; }
        }
    }
    for (int it = gw; it < (M / 8) * NH; it += NGW) {
        const int m8 = it >> 2, h = it & 3; const size_t m = (size_t)m8 * 8 + rr; const int pos = (int)(m & (SEQ - 1));
        rope8(MBQ + m * 512 + h * 128 + dseg * 8, ROPE + pos * 64 + dseg * 8, nullptr, nullptr);
    }
}

DI void n2b_dn_recurrent(const Frame& F, const KA& A, int item, float* ODN) {
    unsigned char* ws = A.W();
    const bf16* QN = (const bf16*)(ws + WS_DNQN); const bf16* KN = (const bf16*)(ws + WS_DNKN); const bf16* VN = (const bf16*)(ws + WS_DNVN);
    const float* BETA = (const float*)(ws + WS_BETA); const float* GLOG = (const float*)(ws + WS_GLOG);
    const int b = item >> 2, h = item & 3;
    LAS float* qs = (LAS float*)(F.lds + RING_OFF);
    LAS float* ks = qs + 16 * 128; LAS float* vs = ks + 16 * 128; LAS float* bs = vs + 16 * 128; LAS float* as = bs + 16;
    float S[128];
#pragma unroll
    for (int k = 0; k < 128; ++k) S[k] = 0.f;
    for (int t0 = 0; t0 < SEQ; t0 += 16) {
        __syncthreads();
        for (int idx = F.tid; idx < 16 * 384; idx += NTHR) {
            const int r = idx / 384, c = idx % 384, X = c >> 7, cc = c & 127; const size_t m = (size_t)b * SEQ + t0 + r;
            const bf16* src = X == 0 ? QN : (X == 1 ? KN : VN);
            (X == 0 ? qs : (X == 1 ? ks : vs))[r * 128 + cc] = bf2f(src[m * 512 + h * 128 + cc]);
        }
        if (F.tid < 16) { const size_t m = (size_t)b * SEQ + t0 + F.tid; bs[F.tid] = BETA[m * 4 + h]; as[F.tid] = __expf(GLOG[m * 4 + h]); }
        __syncthreads();
        if (F.tid < 128) {
#pragma unroll 1
            for (int r = 0; r < 16; ++r) {
                const LAS float* kr = ks + r * 128; const LAS float* qr = qs + r * 128;
                float kS = 0.f;
#pragma unroll
                for (int kb = 0; kb < 128; kb += 16) {
#pragma unroll
                    for (int k = 0; k < 16; ++k) kS += kr[kb + k] * S[kb + k];
                    asm volatile("" ::: "memory");
                }
                const float al = as[r], be = bs[r];
                const float vn = be * (vs[r * 128 + F.tid] - al * kS);
                float o = 0.f;
#pragma unroll
                for (int kb = 0; kb < 128; kb += 16) {
#pragma unroll
                    for (int k = 0; k < 16; ++k) { S[kb + k] = al * S[kb + k] + kr[kb + k] * vn; o += qr[kb + k] * S[kb + k]; }
                    asm volatile("" ::: "memory");
                }
                ODN[((size_t)b * SEQ + t0 + r) * 512 + h * 128 + F.tid] = o;
            }
        }
    }
}

DI void n3b_moba_naive(const Frame& F, const KA& A, int w0, int nw, bf16* Yo, int ypitch, int ycol0) {
    unsigned char* ws = A.W();
    const bf16* MBQ = (const bf16*)(ws + WS_PJ + 4 * PJ_STRIDE); const bf16* MBK = (const bf16*)(ws + WS_PJ + 5 * PJ_STRIDE); const bf16* MBV = (const bf16*)(ws + WS_PJ + 6 * PJ_STRIDE);
    const float* KMP = (const float*)(ws + WS_KMP);
    LAS float* qs = (LAS float*)(F.lds + RING_OFF + 32768) + F.wave * 128;
    const int lane = F.lane;
    for (int it = w0; it < M * NH; it += nw) {
        const int m = it >> 2, h = it & 3, b = m >> 12, t = m & (SEQ - 1), own = t >> 8;
        { const unsigned raw = *(const unsigned*)(MBQ + (size_t)m * 512 + h * 128 + 2 * lane); qs[2 * lane] = bflo(raw) * QSCALE; qs[2 * lane + 1] = bfhi(raw) * QSCALE; }
        asm volatile("s_waitcnt lgkmcnt(0)" ::: "memory");
        float gate = -3e38f;
        if (lane < own) {
            const float* kp = KMP + (size_t)(((b * 4 + h) * 16 + lane) * 4) * 128; float acc = 0.f;
            for (int dd = 0; dd < 128; ++dd) acc += qs[dd] * ((kp[dd] + kp[128 + dd]) + (kp[256 + dd] + kp[384 + dd]));
            gate = acc * (1.f / 256.f);
        }
        int blist[4] = {-1, -1, -1, own};
#pragma unroll
        for (int r = 0; r < 3; ++r) {
            const float mx = wave_max(gate);
            if (mx > -1e37f) {
                const unsigned long long bal = __ballot(gate == mx); const int idx = __builtin_ctzll(bal);
                blist[r] = idx; if (lane == idx) gate = -3e38f;
            }
        }
        float sc[4][4]; float mloc = -3e38f;
#pragma unroll
        for (int s = 0; s < 4; ++s) {
            const int jb = blist[s];
#pragma unroll
            for (int i = 0; i < 4; ++i) {
                float v = -3e38f;
                if (jb >= 0) {
                    const int key = jb * 256 + i * 64 + lane;
                    if (s < 3 || key <= t) {
                        const bf16* kp = MBK + ((size_t)b * SEQ + key) * 512 + h * 128; float acc = 0.f;
#pragma unroll 4
                        for (int c8 = 0; c8 < 16; ++c8) { const v4u w = *(const v4u*)(kp + c8 * 8); const LAS float* q8 = qs + c8 * 8;
                            acc += q8[0] * bflo(w.x) + q8[1] * bfhi(w.x) + q8[2] * bflo(w.y) + q8[3] * bfhi(w.y) + q8[4] * bflo(w.z) + q8[5] * bfhi(w.z) + q8[6] * bflo(w.w) + q8[7] * bfhi(w.w); }
                        v = acc;
                    }
                }
                sc[s][i] = v; mloc = fmaxf(mloc, v);
            }
        }
        const float mx = wave_max(mloc); float lsum = 0.f;
#pragma unroll
        for (int s = 0; s < 4; ++s)
#pragma unroll
            for (int i = 0; i < 4; ++i) { const float p = sc[s][i] > -1e37f ? __expf(sc[s][i] - mx) : 0.f; sc[s][i] = p; lsum += p; }
        const float l = wave_sum(lsum);
        float o0 = 0.f, o1 = 0.f;
#pragma unroll
        for (int s = 0; s < 4; ++s) {
            const int jb = blist[s];
            if (jb >= 0) {
#pragma unroll
                for (int i = 0; i < 4; ++i) {
                    const bf16* vp = MBV + ((size_t)b * SEQ + jb * 256 + i * 64) * 512 + h * 128 + 2 * lane;
                    for (int src = 0; src < 64; ++src) {
                        const float pv = __shfl(sc[s][i], src);
                        if (pv != 0.f) { const unsigned raw = *(const unsigned*)(vp + (size_t)src * 512); o0 += pv * bflo(raw); o1 += pv * bfhi(raw); }
                    }
                }
            }
        }
        const float il = 1.f / l;
        *(unsigned*)(Yo + (size_t)m * ypitch + ycol0 + h * 128 + 2 * lane) = pk2(o0 * il, o1 * il);
        asm volatile("s_waitcnt lgkmcnt(0)" ::: "memory");
    }
}

DI void n2c_dn_gate(const Frame& F, const KA& A, const float* ODN, bf16* Yo, int ypitch) {
    unsigned char* ws = A.W();
    const float* norm_w = A.I(5); const bf16* DNZ = (const bf16*)(ws + WS_PJ + 3 * PJ_STRIDE);
    const int gw = F.vcu * NWAVES + F.wave, NGW = F.G * NWAVES, c = 2 * F.lane;
    for (int it = gw; it < M * NH; it += NGW) {
        const int m = it >> 2, h = it & 3;
        const float2 o = *(const float2*)(ODN + (size_t)m * 512 + h * 128 + c);
        const float ss = wave_sum(o.x * o.x + o.y * o.y) * (1.f / 128.f);
        const float rs = rsqrtf(ss + RMS_EPS);
        const unsigned zr = *(const unsigned*)(DNZ + (size_t)m * 512 + h * 128 + c);
        *(unsigned*)(Yo + (size_t)m * ypitch + h * 128 + c) = pk2(o.x * rs * norm_w[c] * silu_f(bflo(zr)), o.y * rs * norm_w[c + 1] * silu_f(bfhi(zr)));
    }
}

constexpr int CW_DBG = 16;
DI void dbg_compare(const Frame& F, unsigned char* ws, const bf16* T, int tp, int tc0, const bf16* R, int rp, int rc0) {
    float sd = 0.f, sr = 0.f;
    for (int i = F.vcu * NTHR + F.tid; i < M * 256; i += F.G * NTHR) {
        const int m = i >> 8, c = (i & 255) * 2;
        const unsigned a = *(const unsigned*)(T + (size_t)m * tp + tc0 + c), b = *(const unsigned*)(R + (size_t)m * rp + rc0 + c);
        const float d0 = bflo(a) - bflo(b), d1 = bfhi(a) - bfhi(b); sd += d0 * d0 + d1 * d1; sr += bflo(b) * bflo(b) + bfhi(b) * bfhi(b);
    }
    sd = wave_sum(sd); sr = wave_sum(sr);
    if (F.lane == 0) { atomicAdd((float*)(ws + WS_CTL) + CW_DBG, sd); atomicAdd((float*)(ws + WS_CTL) + CW_DBG + 1, sr); }
}
DI float block_sum(float v, LAS float* red, int tid) {
    v = wave_sum(v);
    __syncthreads();
    if ((tid & 63) == 0) red[tid >> 6] = v;
    __syncthreads();
    float s = 0.f;
#pragma unroll
    for (int w = 0; w < NWAVES; ++w) s += red[w];
    return s;
}

DI void n5_token_tail(const Frame& F, const KA& A) {
    const float* x = A.I(0); const float* g1 = A.I(7); const float* b1 = A.I(8);
    const float* rw1 = A.I(9); const float* rb1 = A.I(10); const float* rw2 = A.I(11); const float* rb2 = A.I(12);
    const float* wg = A.I(13); const float* wu = A.I(14); const float* wd = A.I(15); const float* g2 = A.I(16); const float* b2 = A.I(17);
    float* out = A.O();
    LAS float* hs = (LAS float*)(F.lds + RING_OFF);
    LAS float* hes = hs + 1024;
    LAS float* lg = hes + 512;
    LAS float* red = lg + 32;
    LAS float* rt_ = red + 8;
    const int tid = F.tid;
    for (int m = blockIdx.x; m < M; m += F.G) {
        __syncthreads();
        const size_t ro = (size_t)m * DM;
        float v0 = ALPHA * x[ro + tid] + out[ro + tid], v1 = ALPHA * x[ro + tid + 512] + out[ro + tid + 512];
        const float mean = block_sum(v0 + v1, red, tid) * (1.f / DM);
        v0 -= mean; v1 -= mean;
        const float var = block_sum(v0 * v0 + v1 * v1, red, tid) * (1.f / DM);
        const float rstd = rsqrtf(var + LN_EPS);
        const float h0 = v0 * rstd * g1[tid] + b1[tid], h1 = v1 * rstd * g1[tid + 512] + b1[tid + 512];
        hs[tid] = h0; hs[tid + 512] = h1;
        __syncthreads();
        for (int li = F.wave; li < 20; li += NWAVES) {
            float acc = 0.f;
            for (int k = F.lane; k < DM; k += 64) {
                const float wv = li < 4 ? rw1[k * 4 + li] : rw2[((size_t)((li - 4) >> 2) * DM + k) * 4 + ((li - 4) & 3)];
                acc += hs[k] * wv;
            }
            acc = wave_sum(acc);
            if (F.lane == 0) lg[li] = acc;
        }
        __syncthreads();
        if (tid == 0) {
            float pgv[4]; float mx = -3e38f;
            for (int g = 0; g < 4; ++g) { pgv[g] = lg[g] + rb1[g]; mx = fmaxf(mx, pgv[g]); }
            float sum = 0.f; for (int g = 0; g < 4; ++g) { pgv[g] = __expf(pgv[g] - mx); sum += pgv[g]; }
            int gs = 0; for (int g = 1; g < 4; ++g) if (pgv[g] > pgv[gs]) gs = g;
            const float pg = pgv[gs] / sum;
            float pe[4]; mx = -3e38f;
            for (int e = 0; e < 4; ++e) { pe[e] = lg[4 + gs * 4 + e] + rb2[gs * 4 + e]; mx = fmaxf(mx, pe[e]); }
            sum = 0.f; for (int e = 0; e < 4; ++e) { pe[e] = __expf(pe[e] - mx); sum += pe[e]; }
            int e0 = 0; for (int e = 1; e < 4; ++e) if (pe[e] > pe[e0]) e0 = e;
            int e1 = (e0 == 0) ? 1 : 0; for (int e = 0; e < 4; ++e) if (e != e0 && pe[e] > pe[e1]) e1 = e;
            const float den = pe[e0] + pe[e1];
            rt_[0] = __int_as_float(gs * 4 + e0); rt_[1] = __int_as_float(gs * 4 + e1); rt_[2] = pg * pe[e0] / den; rt_[3] = pg * pe[e1] / den;
        }
        __syncthreads();
        const int ex[2] = {__float_as_int(rt_[0]), __float_as_int(rt_[1])}; const float wx[2] = {rt_[2], rt_[3]};
        {
            const int half = tid >> 8, j = tid & 255, e = ex[half];
            const float* pg_ = wg + (size_t)e * DM * DE + j; const float* pu_ = wu + (size_t)e * DM * DE + j;
            float ga = 0.f, ua = 0.f;
#pragma unroll 8
            for (int k = 0; k < DM; ++k) { const float hv = hs[k]; ga += hv * pg_[(size_t)k * DE]; ua += hv * pu_[(size_t)k * DE]; }
            hes[half * 256 + j] = silu_f(ga) * ua;
        }
        __syncthreads();
        float y0 = 0.f, y1 = 0.f;
#pragma unroll
        for (int half = 0; half < 2; ++half) {
            const float* pd = wd + (size_t)ex[half] * DE * DM + tid; float a0 = 0.f, a1 = 0.f;
#pragma unroll 8
            for (int j = 0; j < DE; ++j) { const float hv = hes[half * 256 + j]; a0 += hv * pd[(size_t)j * DM]; a1 += hv * pd[(size_t)j * DM + 512]; }
            y0 += wx[half] * a0; y1 += wx[half] * a1;
        }
        float u0 = ALPHA * h0 + y0, u1 = ALPHA * h1 + y1;
        const float mean2 = block_sum(u0 + u1, red, tid) * (1.f / DM);
        u0 -= mean2; u1 -= mean2;
        const float var2 = block_sum(u0 * u0 + u1 * u1, red, tid) * (1.f / DM);
        const float rstd2 = rsqrtf(var2 + LN_EPS);
        float dscale = 1.f;
#ifdef DBG_ANY
        { const float* dw = (const float*)(A.W() + WS_CTL) + CW_DBG; dscale = 1.f + sqrtf(dw[0] / fmaxf(dw[1], 1e-30f)); }
#endif
        out[ro + tid] = (u0 * rstd2 * g2[tid] + b2[tid]) * dscale; out[ro + tid + 512] = (u1 * rstd2 * g2[tid + 512] + b2[tid + 512]) * dscale;
    }
}

struct MbPart { int own, t_lo, t_hi, slot; };
struct MbSplit { int own, slot0, nparts; };
constexpr int MB_NPARTS = 30, MB_NSLOTS = 24, MB_NSPLIT = 10;
__device__ const MbPart MB_PARTS[MB_NPARTS] = {{5, 0, 24, -1}, {11, 0, 24, 10}, {11, 24, 48, 11}, {10, 0, 22, 8}, {10, 22, 44, 9}, {15, 0, 22, 21}, {15, 22, 44, 22}, {4, 0, 20, -1}, {9, 0, 20, 6}, {9, 20, 40, 7}, {13, 0, 20, 15}, {13, 20, 40, 16}, {14, 0, 20, 18}, {14, 20, 40, 19}, {14, 40, 60, 20}, {15, 44, 64, 23}, {8, 0, 18, 4}, {8, 18, 36, 5}, {12, 0, 18, 12}, {12, 18, 36, 13}, {3, 0, 16, -1}, {7, 0, 16, 2}, {7, 16, 32, 3}, {12, 36, 52, 14}, {13, 40, 56, 17}, {6, 0, 14, 0}, {6, 14, 28, 1}, {2, 0, 12, -1}, {1, 0, 8, -1}, {0, 0, 4, -1}};
__device__ const MbSplit MB_SPLITS[MB_NSPLIT] = {{6, 0, 2}, {7, 2, 2}, {8, 4, 2}, {9, 6, 2}, {10, 8, 2}, {11, 10, 2}, {12, 12, 3}, {13, 15, 3}, {14, 18, 3}, {15, 21, 3}};
constexpr size_t WS_MBPO = WS_PJ;
constexpr size_t WS_MBLSE = WS_PJ + 24 * MiB;
constexpr int CW_MBQ = 96;
typedef mb::BlockRef<bf16, bf16> mbref_t;
DI mbref_t mb_ref(unsigned char* ws, int p, int xq) {
    const int bh = __builtin_amdgcn_readfirstlane(2 * xq + (p & 1)), k = __builtin_amdgcn_readfirstlane(p >> 1);
    const MbPart pt = MB_PARTS[k];
    const int own = __builtin_amdgcn_readfirstlane(pt.own), slot = __builtin_amdgcn_readfirstlane(pt.slot);
    const int b = bh >> 2, h = bh & 3; const size_t row0 = (size_t)b * SEQ;
    mbref_t r;
    r.Q = (const bf16*)(ws + WS_PJ + 4 * PJ_STRIDE) + (row0 + (size_t)own * 256) * 512 + h * 128;
    r.K = (const bf16*)(ws + WS_PJ + 5 * PJ_STRIDE) + row0 * 512 + h * 128;
    r.V = (const bf16*)(ws + WS_PJ + 6 * PJ_STRIDE) + row0 * 512 + h * 128;
    r.O = (bf16*)(ws + WS_Y) + (row0 + (size_t)own * 256) * 1024 + 512 + h * 128;
    r.KM = (const float*)(ws + WS_KMP) + (size_t)(bh * 64) * 128;
    r.P0 = own * 256; r.t_lo = __builtin_amdgcn_readfirstlane(pt.t_lo); r.t_hi = __builtin_amdgcn_readfirstlane(pt.t_hi);
    r.OP = slot >= 0 ? (bf16*)(ws + WS_MBPO) + (size_t)(bh * MB_NSLOTS + slot) * (256 * 128) : nullptr;
    r.LSE = slot >= 0 ? (float*)(ws + WS_MBLSE) + (size_t)(bh * MB_NSLOTS + slot) * 256 : nullptr;
    return r;
}
DI int mb_claim(unsigned char* ws, LAS unsigned* word, int tid, int xq) {
    if (tid == 0) *word = __hip_atomic_fetch_add((unsigned*)(ws + WS_CTL) + CW_MBQ + 64 * xq, 1u, __ATOMIC_RELAXED, __HIP_MEMORY_SCOPE_AGENT);
    __syncthreads();
    const int p = __builtin_amdgcn_readfirstlane((int)*word);
    __syncthreads();
    return p;
}
DI void p3_moba_queue(unsigned char* ws, char* lds, LAS unsigned* word, int tid, int xq) {
    constexpr int WBIG = 0x3fffffff, NP = MB_NPARTS * 2;
    int p = mb_claim(ws, word, tid, xq);
    if (p >= NP) return;
    mbref_t cur = mb_ref(ws, p, xq);
    mb::Seam<bf16> S;
    mb::causal_swa_prime<bf16, bf16>(cur, WBIG, lds, S);
#pragma unroll 1
    for (;;) {
        const int pn = mb_claim(ws, word, tid, xq);
        const bool more = pn < NP;
        const mbref_t nxt = more ? mb_ref(ws, pn, xq) : cur;
        mb::causal_swa_block<bf16, bf16>(cur, nxt, SEQ, WBIG, lds, S);
        if (!more) break;
        cur = nxt;
    }
}
DI mbref_t mb_ref_full(unsigned char* ws, int bh, int own_) {
    const int own = __builtin_amdgcn_readfirstlane(own_); const int b = bh >> 2, h = bh & 3; const size_t row0 = (size_t)b * SEQ;
    mbref_t r;
    r.Q = (const bf16*)(ws + WS_PJ + 4 * PJ_STRIDE) + (row0 + (size_t)own * 256) * 512 + h * 128;
    r.K = (const bf16*)(ws + WS_PJ + 5 * PJ_STRIDE) + row0 * 512 + h * 128;
    r.V = (const bf16*)(ws + WS_PJ + 6 * PJ_STRIDE) + row0 * 512 + h * 128;
    r.O = (bf16*)(ws + WS_Y) + (row0 + (size_t)own * 256) * 1024 + 512 + h * 128;
    r.KM = (const float*)(ws + WS_KMP) + (size_t)(bh * 64) * 128;
    r.P0 = own * 256; r.t_lo = 0; r.t_hi = 4 * (own + 1); r.OP = nullptr; r.LSE = nullptr;
    return r;
}
DI void p3_moba_static(unsigned char* ws, char* lds, int bh, int own0, int own1) {
    constexpr int WBIG = 0x3fffffff;
    const int n = own1 >= 0 ? 2 : 1;
    mbref_t cur = mb_ref_full(ws, bh, own0);
    mb::Seam<bf16> S;
    mb::causal_swa_prime<bf16, bf16>(cur, WBIG, lds, S);
#pragma unroll 1
    for (int i = 0; i < n; ++i) {
        const mbref_t nxt = (i + 1 < n) ? mb_ref_full(ws, bh, own1) : cur;
        mb::causal_swa_block<bf16, bf16>(cur, nxt, SEQ, WBIG, lds, S);
        cur = nxt;
    }
}
DI void p4_moba_merge(unsigned char* ws, int it, int tid) {
    const int rh = it & 1, bh = (it >> 1) & 15; const MbSplit sp = MB_SPLITS[it >> 5];
    const int np = __builtin_amdgcn_readfirstlane(sp.nparts);
    const int b = bh >> 2, h = bh & 3, row = rh * 128 + (tid >> 2), qc = tid & 3;
    const float* lse = (const float*)(ws + WS_MBLSE) + (size_t)(bh * MB_NSLOTS + sp.slot0) * 256 + row;
    const bf16* po = (const bf16*)(ws + WS_MBPO) + (size_t)(bh * MB_NSLOTS + sp.slot0) * (256 * 128) + row * 128 + qc * 32;
    float l[3]; v4u w[3][4];
#pragma unroll
    for (int q = 0; q < 3; ++q) {
        const int qq = q < np ? q : 0;
        l[q] = lse[qq * 256];
#pragma unroll
        for (int c8 = 0; c8 < 4; ++c8) w[q][c8] = *(const v4u*)(po + (size_t)qq * (256 * 128) + c8 * 8);
    }
    float mx = -3e38f;
#pragma unroll
    for (int q = 0; q < 3; ++q) { l[q] = q < np ? l[q] : -__builtin_inff(); mx = fmaxf(mx, l[q]); }
    float wsum = 0.f;
#pragma unroll
    for (int q = 0; q < 3; ++q) { l[q] = __builtin_amdgcn_exp2f(l[q] - mx); wsum += l[q]; }
    const float inv = 1.f / wsum;
    bf16* yp = (bf16*)(ws + WS_Y) + ((size_t)b * SEQ + (size_t)sp.own * 256 + row) * 1024 + 512 + h * 128 + qc * 32;
#pragma unroll
    for (int c8 = 0; c8 < 4; ++c8) {
        v4u o;
#pragma unroll
        for (int e = 0; e < 4; ++e) {
            const float a0 = l[0] * bflo(w[0][c8][e]) + l[1] * bflo(w[1][c8][e]) + l[2] * bflo(w[2][c8][e]);
            const float a1 = l[0] * bfhi(w[0][c8][e]) + l[1] * bfhi(w[1][c8][e]) + l[2] * bfhi(w[2][c8][e]);
            o[e] = pk2(a0 * inv, a1 * inv);
        }
        *(v4u*)(yp + c8 * 8) = o;
    }
}

DI void p6_ln_router(const Frame& F, const KA& A) {
    unsigned char* ws = A.W();
    const float* x = A.I(0); const float* g1 = A.I(7); const float* b1 = A.I(8);
    const float* rw1 = A.I(9); const float* rb1 = A.I(10); const float* rw2 = A.I(11); const float* rb2 = A.I(12);
    float* out = A.O(); bf16* HB = (bf16*)(ws + WS_HB); const bf16* MIXB = (const bf16*)(ws + WS_MIXB); (void)out; (void)MIXB;
    int* TOKE = (int*)(ws + WS_TOKE); int* TOKP = (int*)(ws + WS_TOKP); float* TOKW = (float*)(ws + WS_TOKW);
    unsigned* gcnt = (unsigned*)(ws + WS_CTL) + CW_CNT; int* LIST = (int*)(ws + WS_LIST);
    LAS float* rwl = (LAS float*)(F.lds + RING_OFF);
    LAS unsigned* lcnt = (LAS unsigned*)(F.lds + RING_OFF + 81920);
    for (int i = F.tid; i < 1024 * 20; i += NTHR) { const int k = i / 20, li = i % 20;
        rwl[i] = li < 4 ? rw1[k * 4 + li] : rw2[((size_t)((li - 4) >> 2) * DM + k) * 4 + ((li - 4) & 3)]; }
    if (F.tid < 32) lcnt[F.tid] = 0u;
    __syncthreads();
    const int gw = F.vcu * NWAVES + F.wave, NGW = F.G * NWAVES;
#ifdef LN1_FUSE
    for (int m = gw; m < M; m += NGW) {
        const size_t ro = (size_t)m * DM;
        f32x4 v[4];
        float lg[20];
#pragma unroll
        for (int q = 0; q < 20; ++q) lg[q] = 0.f;
#pragma unroll
        for (int j = 0; j < 4; ++j) {
            v[j] = *(const f32x4*)(out + ro + 256 * j + 4 * F.lane);
#pragma unroll
            for (int e = 0; e < 4; ++e) { const LAS float* wr_ = rwl + (256 * j + 4 * F.lane + e) * 20; const float hv = v[j][e];
#pragma unroll
                for (int q4 = 0; q4 < 5; ++q4) { const f32x4 w4 = *(const LAS f32x4*)(wr_ + 4 * q4);
                    lg[4 * q4] += hv * w4.x; lg[4 * q4 + 1] += hv * w4.y; lg[4 * q4 + 2] += hv * w4.z; lg[4 * q4 + 3] += hv * w4.w; } }
        }
#else
    for (int m = gw; m < M; m += NGW) {
        const size_t ro = (size_t)m * DM;
        f32x4 v[4]; float s = 0.f;
#pragma unroll
        for (int j = 0; j < 4; ++j) { const f32x4 xv = *(const f32x4*)(x + ro + 256 * j + 4 * F.lane); const uint2 mr = *(const uint2*)(MIXB + ro + 256 * j + 4 * F.lane);
            v[j].x = xv.x * ALPHA + bflo(mr.x); v[j].y = xv.y * ALPHA + bfhi(mr.x); v[j].z = xv.z * ALPHA + bflo(mr.y); v[j].w = xv.w * ALPHA + bfhi(mr.y); s += (v[j].x + v[j].y) + (v[j].z + v[j].w); }
        const float mean = wave_sum(s) * (1.f / DM); float s2 = 0.f;
#pragma unroll
        for (int j = 0; j < 4; ++j) { v[j] = v[j] - mean; s2 += (v[j].x * v[j].x + v[j].y * v[j].y) + (v[j].z * v[j].z + v[j].w * v[j].w); }
        const float rstd = rsqrtf(wave_sum(s2) * (1.f / DM) + LN_EPS);
        float lg[20];
#pragma unroll
        for (int q = 0; q < 20; ++q) lg[q] = 0.f;
#pragma unroll
        for (int j = 0; j < 4; ++j) {
            const f32x4 gv = *(const f32x4*)(g1 + 256 * j + 4 * F.lane), bv = *(const f32x4*)(b1 + 256 * j + 4 * F.lane);
            v[j] = v[j] * rstd * gv + bv;
            *(unsigned long long*)(HB + ro + 256 * j + 4 * F.lane) = (unsigned long long)pk2(v[j].x, v[j].y) | ((unsigned long long)pk2(v[j].z, v[j].w) << 32);
#pragma unroll
            for (int e = 0; e < 4; ++e) { const LAS float* wr_ = rwl + (256 * j + 4 * F.lane + e) * 20; const float hv = v[j][e];
#pragma unroll
                for (int q4 = 0; q4 < 5; ++q4) { const f32x4 w4 = *(const LAS f32x4*)(wr_ + 4 * q4);
                    lg[4 * q4] += hv * w4.x; lg[4 * q4 + 1] += hv * w4.y; lg[4 * q4 + 2] += hv * w4.z; lg[4 * q4 + 3] += hv * w4.w; } }
        }
#endif
#pragma unroll
        for (int q = 0; q < 20; ++q) lg[q] = wave_sum(lg[q]);
        float pgv[4]; float mx = -3e38f;
#pragma unroll
        for (int g = 0; g < 4; ++g) { pgv[g] = lg[g] + rb1[g]; mx = fmaxf(mx, pgv[g]); }
        float sum = 0.f;
#pragma unroll
        for (int g = 0; g < 4; ++g) { pgv[g] = __expf(pgv[g] - mx); sum += pgv[g]; }
        int gs = 0; float pbest = pgv[0];
#pragma unroll
        for (int g = 1; g < 4; ++g) if (pgv[g] > pbest) { pbest = pgv[g]; gs = g; }
        const float pg = pbest / sum;
        float pe[4]; mx = -3e38f;
#pragma unroll
        for (int e = 0; e < 4; ++e) { float l2 = 0.f;
#pragma unroll
            for (int g = 0; g < 4; ++g) l2 = (g == gs) ? lg[4 + g * 4 + e] + rb2[g * 4 + e] : l2;
            pe[e] = l2; mx = fmaxf(mx, l2); }
#pragma unroll
        for (int e = 0; e < 4; ++e) pe[e] = __expf(pe[e] - mx);
        int e0 = 0; float p0 = pe[0];
#pragma unroll
        for (int e = 1; e < 4; ++e) if (pe[e] > p0) { p0 = pe[e]; e0 = e; }
        int e1 = -1; float p1 = -1.f;
#pragma unroll
        for (int e = 0; e < 4; ++e) if (e != e0 && pe[e] > p1) { p1 = pe[e]; e1 = e; }
        const float den = p0 + p1; const int x0 = gs * 4 + e0, x1 = gs * 4 + e1;
        if (F.lane == 0) {
            const unsigned i0 = __hip_atomic_fetch_add(lcnt + x0, 1u, __ATOMIC_RELAXED, __HIP_MEMORY_SCOPE_WORKGROUP);
            const unsigned i1 = __hip_atomic_fetch_add(lcnt + x1, 1u, __ATOMIC_RELAXED, __HIP_MEMORY_SCOPE_WORKGROUP);
            TOKE[m] = x0 | (x1 << 8); TOKP[2 * m] = (int)i0; TOKP[2 * m + 1] = (int)i1; TOKW[2 * m] = pg * p0 / den; TOKW[2 * m + 1] = pg * p1 / den;
        }
    }
    __syncthreads();
    if (F.tid < 16) lcnt[16 + F.tid] = __hip_atomic_fetch_add(gcnt + F.tid, lcnt[F.tid], __ATOMIC_RELAXED, __HIP_MEMORY_SCOPE_AGENT);
    __syncthreads();
    for (int m = gw; m < M; m += NGW) {
        if (F.lane == 0) { const int ee = TOKE[m], e0 = ee & 255, e1 = ee >> 8; const int q0 = TOKP[2 * m] + (int)lcnt[16 + e0], q1 = TOKP[2 * m + 1] + (int)lcnt[16 + e1];
            TOKP[2 * m] = q0; TOKP[2 * m + 1] = q1; LIST[e0 * 16384 + q0] = m; LIST[e1 * 16384 + q1] = m; }
    }
}
DI void moe_tile_table(const Frame& F, unsigned char* ws, LAS int* tb) {
    if (F.tid == 0) { const unsigned* gcnt = (const unsigned*)(ws + WS_CTL) + CW_CNT; int acc = 0;
        for (int e = 0; e < 16; ++e) { tb[e] = acc; acc += (int)((__hip_atomic_load(gcnt + e, __ATOMIC_RELAXED, __HIP_MEMORY_SCOPE_AGENT) + 255u) >> 8); } tb[16] = acc; }
    __syncthreads();
}
DI void p7_permute(const Frame& F, const KA& A) {
    unsigned char* ws = A.W();
    LAS int* tb = (LAS int*)(F.lds + RING_OFF);
    moe_tile_table(F, ws, tb);
    const bf16* HB = (const bf16*)(ws + WS_HB); bf16* HS = (bf16*)(ws + WS_HS);
    const int* TOKE = (const int*)(ws + WS_TOKE); const int* TOKP = (const int*)(ws + WS_TOKP);
    const int gw = F.vcu * NWAVES + F.wave, NGW = F.G * NWAVES;
    for (int it = gw; it < 2 * M; it += NGW) {
        const int m = it >> 1, k = it & 1; const int ee = TOKE[m]; const int e = k ? (ee >> 8) : (ee & 255);
        const size_t row = (size_t)tb[e] * 256 + TOKP[it];
        const v4u a0 = *(const v4u*)(HB + (size_t)m * DM + 8 * F.lane), a1 = *(const v4u*)(HB + (size_t)m * DM + 512 + 8 * F.lane);
        pg8::st16_wt(HS + row * DM + 8 * F.lane, a0); pg8::st16_wt(HS + row * DM + 512 + 8 * F.lane, a1);
    }
}
DI void p10_combine(const Frame& F, const KA& A) {
    unsigned char* ws = A.W();
    LAS int* tb = (LAS int*)(F.lds + RING_OFF);
    moe_tile_table(F, ws, tb);
    const float* g2 = A.I(16); const float* b2 = A.I(17); float* out = A.O();
    const bf16* Y2 = (const bf16*)(ws + WS_Y2);
    const bf16* HBc = (const bf16*)(ws + WS_HB); (void)HBc;
    const int* TOKE = (const int*)(ws + WS_TOKE); const int* TOKP = (const int*)(ws + WS_TOKP); const float* TOKW = (const float*)(ws + WS_TOKW);
    const int gw = F.vcu * NWAVES + F.wave, NGW = F.G * NWAVES;
    for (int m0 = gw * 2; m0 < M; m0 += NGW * 2) {
        int ee[2], tp[2][2]; float tw[2][2];
#pragma unroll
        for (int t = 0; t < 2; ++t) { const int m = m0 + t; ee[t] = TOKE[m]; tp[t][0] = TOKP[2 * m]; tp[t][1] = TOKP[2 * m + 1]; tw[t][0] = TOKW[2 * m]; tw[t][1] = TOKW[2 * m + 1]; }
        uint2 hr[2][4], ya[2][4], yb[2][4];
#pragma unroll
        for (int t = 0; t < 2; ++t) {
            const size_t ro = (size_t)(m0 + t) * DM;
            const size_t r0 = (size_t)tb[ee[t] & 255] * 256 + tp[t][0], r1 = (size_t)tb[ee[t] >> 8] * 256 + tp[t][1];
#pragma unroll
            for (int j = 0; j < 4; ++j) { hr[t][j] = *(const uint2*)(HBc + ro + 256 * j + 4 * F.lane);
                ya[t][j] = *(const uint2*)(Y2 + r0 * DM + 256 * j + 4 * F.lane); yb[t][j] = *(const uint2*)(Y2 + r1 * DM + 256 * j + 4 * F.lane); }
        }
#pragma unroll
        for (int t = 0; t < 2; ++t) {
            const size_t ro = (size_t)(m0 + t) * DM; const float w0 = tw[t][0], w1 = tw[t][1];
            f32x4 v[4]; float s = 0.f;
#pragma unroll
            for (int j = 0; j < 4; ++j) {
                v[j].x = ALPHA * bflo(hr[t][j].x) + w0 * bflo(ya[t][j].x) + w1 * bflo(yb[t][j].x); v[j].y = ALPHA * bfhi(hr[t][j].x) + w0 * bfhi(ya[t][j].x) + w1 * bfhi(yb[t][j].x);
                v[j].z = ALPHA * bflo(hr[t][j].y) + w0 * bflo(ya[t][j].y) + w1 * bflo(yb[t][j].y); v[j].w = ALPHA * bfhi(hr[t][j].y) + w0 * bfhi(ya[t][j].y) + w1 * bfhi(yb[t][j].y);
                s += (v[j].x + v[j].y) + (v[j].z + v[j].w);
            }
            const float mean = wave_sum(s) * (1.f / DM); float s2 = 0.f;
#pragma unroll
            for (int j = 0; j < 4; ++j) { v[j] = v[j] - mean; s2 += (v[j].x * v[j].x + v[j].y * v[j].y) + (v[j].z * v[j].z + v[j].w * v[j].w); }
            const float rstd = rsqrtf(wave_sum(s2) * (1.f / DM) + LN_EPS);
#pragma unroll
            for (int j = 0; j < 4; ++j) { const f32x4 gv = *(const f32x4*)(g2 + 256 * j + 4 * F.lane), bv = *(const f32x4*)(b2 + 256 * j + 4 * F.lane);
                *(f32x4*)(out + ro + 256 * j + 4 * F.lane) = v[j] * rstd * gv + bv; }
        }
    }
}

#ifndef DUP_P0
#define DUP_P0 1
#endif
#ifndef DUP_P1
#define DUP_P1 1
#endif
#ifndef DUP_P2
#define DUP_P2 1
#endif
#ifndef DUP_P3
#define DUP_P3 1
#endif
#ifndef DUP_P5
#define DUP_P5 1
#endif
#ifndef DUP_P7
#define DUP_P7 1
#endif
#ifndef DUP_P8
#define DUP_P8 1
#endif
#ifndef DUP_P9
#define DUP_P9 1
#endif
#ifdef SKIP_N2B
#define n2b_dn_recurrent(...) ((void)0)
#endif
#ifdef SKIP_N3B
#define n3b_moba_naive(...) ((void)0)
#endif
#ifdef SKIP_N5
#define n5_token_tail(...) ((void)0)
#endif
#ifdef SKIP_P0
#define p0_prologue(...) ((void)0)
#endif
#ifdef SKIP_N2A
#define n2a_conv_norm(...) ((void)0)
#endif
#ifdef SKIP_N3A
#define n3a_rope(...) ((void)0)
#endif
#ifdef SKIP_N2C
#define n2c_dn_gate(...) ((void)0)
#endif
#if defined(DBG_MOBA) || defined(DBG_DN)
#define DBG_ANY 1
#endif
#ifdef MOE_NAIVE
constexpr int N_PHASES = 7;
#else
constexpr int N_PHASES = 11;
#endif
__global__ void __launch_bounds__(NTHR, 2) mk_fwd(Args args_unused) {
    (void)args_unused;
    extern __shared__ __attribute__((aligned(16))) unsigned char lds[];
    Frame F;
    F.lds = (LAS unsigned char*)lds;
    F.tid = threadIdx.x; F.lane = F.tid & 63; F.wave = __builtin_amdgcn_readfirstlane(F.tid >> 6);
    F.G = gridDim.x; { const int bx = blockIdx.x; F.vcu = (F.G % 8 == 0) ? (bx % 8) * (F.G / 8) + bx / 8 : bx; }
    unsigned char* ws = kargs().W();
    gu32* ctl = (gu32*)(ws + WS_CTL);
    volatile LAS unsigned* MISC = (volatile LAS unsigned*)(F.lds + MISC_OFF);
    for (int u = F.tid; u < (LDS_BYTES - LDSCTL_OFF) / 4; u += NTHR) ((LAS unsigned*)(F.lds + LDSCTL_OFF))[u] = 0u;
    __syncthreads();
    const int lo = kargs().lo(), hi = kargs().hi();
    const bool multi = (hi - lo) > 1;
    XcdBarrier bar; bar.bar = (unsigned*)(ctl + CW_BAR); bar.x = 0; bar.st = nullptr;
    if (multi) bar = xcd_barrier_post((unsigned*)(ctl + CW_BAR), MISC + 8);
#define IN(k) (lo <= (k) && (k) < hi)
#define REFRESH_F() do { int t_ = threadIdx.x; asm volatile("" : "+v"(t_)); F.tid = t_; F.lane = t_ & 63; F.wave = __builtin_amdgcn_readfirstlane(t_ >> 6); } while (0)
#define SEAM(k) do { if (IN(k) && IN((k) + 1)) xcd_barrier(bar); } while (0)

    if (IN(0)) { REFRESH_F(); for (int rep_ = 0; rep_ < DUP_P0; ++rep_) { const KA args = kargs(); p0_prologue(F, args); __syncthreads(); } SEAM(0); }
    if (IN(1)) { REFRESH_F(); for (int rep_ = 0; rep_ < DUP_P1; ++rep_) {
        pg8::Gemm g{(const bf16*)(ws + WS_XB), (const bf16*)(ws + WS_WIN), M, NPROJ, DM}; pg8::StaticOrder S; S.init(M, NPROJ, F.G, (int)blockIdx.x);
        pg8::EpiBf16<0> E{(bf16*)(ws + WS_PJ), 512, nullptr, 512, (size_t)(PJ_STRIDE / 2), 1.f};
        pg8::gemm_phase<pg8::EpiBf16<0>, pg8::StaticOrder, PG8_ALIGN, PG8_SP2>(F.lds + RING_OFF, g, S, E); }
        SEAM(1);
    }
    if (IN(2)) { REFRESH_F();
        const KA args = kargs();
#if defined(DN_NAIVE) || defined(DBG_DN)
        n2a_conv_norm(F, args);
#endif
#ifndef DN_NAIVE
        for (int rep_ = 0; rep_ < DUP_P2; ++rep_) for (int it = F.vcu; it < 1024; it += F.G)
            dn::chunk_local(F.lds, it, (const bf16*)(ws + WS_PJ), PJ_STRIDE / 2, (const float*)(ws + WS_GATES), args.I(2), args.I(3), args.I(4),
                            (unsigned char*)args.O(), ws + WS_UF, (float*)(ws + WS_GL));
#endif
        n3a_rope(F, args); SEAM(2); }
    if (IN(3)) { REFRESH_F();
        const KA args = kargs();
#ifdef DN_NAIVE
        float* ODN = args.O();
#else
        float* ODN = (float*)(ws + WS_PJ);
#endif
        {
            const int v = F.vcu;
            const int bh = __builtin_amdgcn_readfirstlane(v >> 4), r = __builtin_amdgcn_readfirstlane(v & 15);
            if (r == 15 && v < 256) {
#if defined(DN_NAIVE) || defined(DBG_DN)
                n2b_dn_recurrent(F, args, bh, ODN);
#endif
#ifndef DN_NAIVE
                dn::scan_bh(F.lds, bh, (const unsigned char*)args.O(), ws + WS_UF, (const float*)(ws + WS_GL), ws + WS_SF, ws + WS_VF);
#endif
            }
#ifdef MB_QUEUE
            p3_moba_queue(ws, (char*)lds, (LAS unsigned*)(F.lds + LDSCTL_OFF + 640), F.tid, __builtin_amdgcn_readfirstlane((v >> 5) & 7));
#else
            if (r != 15) p3_moba_static(ws, (char*)lds, bh, 15 - r, r == 14 ? 0 : -1);
#endif
        }
        SEAM(3);
    }
    if (IN(4)) { REFRESH_F(); const KA args = kargs();
#ifdef DN_NAIVE
        n2c_dn_gate(F, args, args.O(), (bf16*)(ws + WS_Y), 1024);
#else
        for (int it = F.vcu; it < 512; it += F.G)
            dn::chunk_out(F.lds, it, (const unsigned char*)args.O(), ws + WS_SF, ws + WS_VF, (const bf16*)(ws + WS_PJ + 3 * PJ_STRIDE), args.I(5), (bf16*)(ws + WS_Y));
#endif
#ifdef MB_QUEUE
        for (int it = F.vcu; it < MB_NSPLIT * 32; it += F.G) p4_moba_merge(ws, it, F.tid);
#endif
        SEAM(4); }
    if (IN(5)) { REFRESH_F();
        const KA args = kargs();
        pg8::Gemm g{(const bf16*)(ws + WS_Y), (const bf16*)(ws + WS_WOUT), M, DM, DM}; pg8::StaticOrder S; S.init(M, DM, F.G, (int)blockIdx.x);
#if defined(MOE_NAIVE)
        pg8::EpiF32 E{args.O(), DM};
        for (int rep_ = 0; rep_ < DUP_P5; ++rep_) pg8::gemm_phase<pg8::EpiF32, pg8::StaticOrder, PG8_ALIGN, PG8_SP2>(F.lds + RING_OFF, g, S, E);
#elif !defined(LN1_FUSE)
        pg8::EpiBf16<0> E{(bf16*)(ws + WS_MIXB), DM, nullptr, 0, 0, 1.f};
        pg8::gemm_phase<pg8::EpiBf16<0>, pg8::StaticOrder, PG8_ALIGN, PG8_SP2>(F.lds + RING_OFF, g, S, E);
#else
        if (F.G == 256) {
            pg8::PanelStats st{(unsigned*)(ws + WS_XBUF), (unsigned*)(ws + WS_CTL) + CW_SEAM, (unsigned*)(ws + WS_CTL), DM / 256, LN_EPS, 0x740u};
            pg8::EpiLn1 E{args.I(0), args.O(), (bf16*)(ws + WS_HB), args.I(7), args.I(8), ALPHA, st, 0u};
            pg8::gemm_phase<pg8::EpiLn1, pg8::StaticOrder, false, PG8_SP2>(F.lds + RING_OFF, g, S, E);
        }
#endif
        SEAM(5);
    }
#ifdef MOE_NAIVE
    if (IN(6)) { REFRESH_F(); const KA args = kargs(); n5_token_tail(F, args); }
#else
    if (IN(6)) { REFRESH_F(); const KA args = kargs(); p6_ln_router(F, args); SEAM(6); }
#ifdef MOE_PERMUTE
    if (IN(7)) { REFRESH_F(); for (int rep_ = 0; rep_ < DUP_P7; ++rep_) { const KA args = kargs(); p7_permute(F, args); __syncthreads(); } SEAM(7); }
#endif
    if (IN(8)) { REFRESH_F();
        LAS int* tb = (LAS int*)(F.lds + LDSCTL_OFF + 512); moe_tile_table(F, ws, tb);
#ifdef MOE_PERMUTE
        pg8::Gemm g{(const bf16*)(ws + WS_HS), (const bf16*)(ws + WS_WGU), 36864, 512, DM}; pg8::MoeOrder<false> S{(const LAS int*)tb, 2, F.G, (int)blockIdx.x, (size_t)512 * DM * 2, nullptr, nullptr};
#else
        pg8::Gemm g{(const bf16*)(ws + WS_HB), (const bf16*)(ws + WS_WGU), 36864, 512, DM}; pg8::MoeOrder<true> S{(const LAS int*)tb, 2, F.G, (int)blockIdx.x, (size_t)512 * DM * 2, (const int*)(ws + WS_LIST), (const unsigned*)(ws + WS_CTL) + CW_CNT};
#endif
        pg8::EpiSwiGLU E{(bf16*)(ws + WS_HE)};
        pg8::gemm_phase<pg8::EpiSwiGLU, decltype(S), PG8_ALIGN, PG8_SP2>(F.lds + RING_OFF, g, S, E);
        SEAM(8);
    }
    if (IN(9)) { REFRESH_F();
        LAS int* tb = (LAS int*)(F.lds + LDSCTL_OFF + 512); moe_tile_table(F, ws, tb);
        int kdim = DE; asm volatile("" : "+s"(kdim));
        pg8::Gemm g{(const bf16*)(ws + WS_HE), (const bf16*)(ws + WS_WD), 36864, DM, kdim}; pg8::MoeOrder<false> S{(const LAS int*)tb, 4, F.G, (int)blockIdx.x, (size_t)DM * DE * 2, nullptr, nullptr};
        pg8::EpiBf16<0> E{(bf16*)(ws + WS_Y2), DM, nullptr, 0, 0, 1.f};
        pg8::gemm_phase<pg8::EpiBf16<0>, pg8::MoeOrder<false>, PG8_ALIGN, PG8_SP2>(F.lds + RING_OFF, g, S, E);
        SEAM(9);
    }
    if (IN(10)) { REFRESH_F(); const KA args = kargs(); p10_combine(F, args); }
#endif
#undef IN
#undef SEAM
}

extern "C" void kernel_launch(void* const* d_in, const int* in_sizes, int n_in, void* d_out, int out_size, void* d_ws, size_t ws_size, hipStream_t stream) {
    static int grid = 0;
    if (grid == 0) {
        if (n_in != 18 || in_sizes[0] != M * DM || out_size != M * DM || ws_size < WS_END) { fprintf(stderr, "kernel_launch: unexpected shapes (n_in %d, in0 %d, out %d, ws %zu)\n", n_in, n_in > 0 ? in_sizes[0] : -1, out_size, ws_size); grid = -1; return; }
        int dev = 0, cus = 0;
        if (hipGetDevice(&dev) != hipSuccess || hipDeviceGetAttribute(&cus, hipDeviceAttributeMultiprocessorCount, dev) != hipSuccess) { grid = -1; return; }
        if (hipFuncSetAttribute((const void*)mk_fwd, hipFuncAttributeMaxDynamicSharedMemorySize, LDS_BYTES) != hipSuccess) { fprintf(stderr, "kernel_launch: hipFuncSetAttribute failed\n"); grid = -1; return; }
        int per_cu = 0;
        if (hipOccupancyMaxActiveBlocksPerMultiprocessor(&per_cu, (const void*)mk_fwd, NTHR, LDS_BYTES) != hipSuccess || per_cu < 1) fprintf(stderr, "kernel_launch: occupancy query says %d\n", per_cu);
        (void)hipGetLastError();
        grid = cus;
    }
    if (grid < 0) return;
    (void)hipMemsetAsync((char*)d_ws + WS_CTL, 0, CTL_ZERO_BYTES, stream);
    Args a{};
    for (int i = 0; i < 18; ++i) a.in_[i] = (const GAS float*)d_in[i];
    a.out_ = (GAS float*)d_out; a.ws_ = (GAS unsigned char*)d_ws;
#ifndef MK_PER_PHASE
    a.ph_lo = 0; a.ph_hi = N_PHASES;
    hipLaunchKernelGGL(mk_fwd, dim3(grid), dim3(NTHR), LDS_BYTES, stream, a);
#else
    for (int p = 0; p < N_PHASES; ++p) { a.ph_lo = p; a.ph_hi = p + 1; hipLaunchKernelGGL(mk_fwd, dim3(grid), dim3(NTHR), LDS_BYTES, stream, a); }
#endif
}
```

```cpp
#define MB_PIPE 1
#define MB_QUEUE 1
#define ROPE_EPI 1
#include <hip/hip_runtime.h>
#include <cstdio>
#include <cstdint>
#include <cstddef>
namespace pg8 {
#define PG8_LAS __attribute__((address_space(3)))
typedef unsigned short bf16_t;
typedef short bf16x8 __attribute__((ext_vector_type(8)));
typedef float f32x4 __attribute__((ext_vector_type(4)));
typedef unsigned u32x4 __attribute__((ext_vector_type(4)));
__device__ __forceinline__ void st16_wt(void* p, u32x4 v) {
#ifdef WT_STORES
    asm volatile("global_store_dwordx4 %0, %1, off sc1\n\ts_nop 1" :: "v"((__attribute__((address_space(1))) void*)p), "v"(v) : "memory");
#else
    *(u32x4*)p = v;
#endif
}
constexpr int BM = 256, BK = 64, HALF = 128, HTB = HALF * BK * 2  , STAGE_BYTES = 8 * HTB, NXCD = 8, WGM = 8;

__host__ __device__ __forceinline__ int lds_byte(int r, int c) { const int st = (r >> 4) * 2 + (c >> 5), rr = r & 15, cc = c & 31, ob = rr * 64 + cc * 2; return st * 1024 + (ob ^ (((ob >> 9) & 1) << 5)); }
__host__ __device__ __forceinline__ void stage_rc(int b, int& R, int& C) { const int st = b / 1024, sb = b % 1024, swz = sb ^ (((sb >> 9) & 1) << 5); R = (st >> 1) * 16 + swz / 64; C = (st & 1) * 32 + (swz % 64) / 2; }
__host__ __device__ __forceinline__ int perm32(int rho) { const int n = rho >> 4, i = rho & 15; return 8 * (i >> 2) + 4 * n + (i & 3); }

struct Unit { int pm, pn; };
struct Gemm { const bf16_t* A; const bf16_t* Bt; int M, N, K; };

struct StaticOrder {
    int nM, nN, nwg, G, c;
    __host__ __device__ void init(int M, int N, int G_, int c_) { nM = M / BM; nN = N / BM; nwg = nM * nN; G = G_; c = c_; }
    __host__ __device__ bool next(int i, Unit& u) const {
        const long L = (long)i * G + c; if (L >= nwg) return false;
        int wgid = (int)L; { const int q = nwg / NXCD, r = nwg % NXCD, xcd = wgid % NXCD, off = wgid / NXCD; wgid = (xcd < r ? xcd * (q + 1) : r * (q + 1) + (xcd - r) * q) + off; }
        const int nig = WGM * nN, gid = wgid / nig, fm = gid * WGM, gsz = (nM - fm) < WGM ? (nM - fm) : WGM;
        u.pm = fm + ((wgid % nig) % gsz); u.pn = (wgid % nig) / gsz; return true;
    }
    __device__ __forceinline__ void a_ready(const Unit&) const {}
    __device__ __forceinline__ void done(const Unit&) const {}
    __device__ __forceinline__ size_t bofs(const Unit&) const { return 0; }
    static constexpr bool GATHER = false;
    __device__ __forceinline__ int arow(const Unit&, int) const { return 0; }
};

__device__ __forceinline__ unsigned cvt_pk_bf16(float lo, float hi) { unsigned r; asm volatile("v_cvt_pk_bf16_f32 %0, %1, %2" : "=v"(r) : "v"(lo), "v"(hi)); return r; }
typedef float f32x2 __attribute__((ext_vector_type(2)));
__device__ __forceinline__ f32x2 gelu_pk(f32x2 v) {
    const f32x2 av = __builtin_elementwise_abs(v), d = av * 0.2316418882f + 1.0f;
    f32x2 t; t.x = __builtin_amdgcn_rcpf(d.x); t.y = __builtin_amdgcn_rcpf(d.y);
    f32x2 q = t * 0.5307027145f + (-0.7265760135f); q = q * t + 0.7107068705f; q = q * t + (-0.142248368f); q = q * t + 0.127414796f; q = q * t;
    const f32x2 s = (v * v) * (-0.72134752044f);
    f32x2 e; e.x = __builtin_amdgcn_exp2f(s.x); e.y = __builtin_amdgcn_exp2f(s.y);
    const f32x2 m = v * (q * e), r = v - m;
    f32x2 o; o.x = v.x < 0.f ? m.x : r.x; o.y = v.y < 0.f ? m.y : r.y; return o;
}

template <int ACT  > struct EpiBf16 {
    static constexpr bool PERM = true, AFTER_DRAIN = false; static_assert(ACT == 0 || ACT == 1, "EpiBf16: ACT is 0 (none) or 1 (gelu_pk)");
    bf16_t* O; int ldc; const float* bias; int split_cols; size_t split_stride; float scale0;
    __device__ __forceinline__ void operator()(const f32x4 (&acc)[2][2][4][2], const Unit& u, int wr, int wc, int fr, int fq) const {
        const int row0 = u.pm * BM + wr * 64 + fr; int colt = u.pn * BM; bf16_t* base = O;
        float sc = 1.f; if (split_cols) { const int t = colt / split_cols; base += (size_t)t * split_stride; colt -= t * split_cols; if (t == 0) sc = scale0; }
        const int col0 = colt + wc * 32 + 8 * fq, bcol0 = u.pn * BM + wc * 32 + 8 * fq;
        f32x4 bv[2][2];
#pragma unroll
        for (int bj = 0; bj < 2; ++bj)
#pragma unroll
            for (int n = 0; n < 2; ++n) bv[bj][n] = bias ? *(const f32x4*)(bias + bcol0 + bj * HALF + 4 * n) : (f32x4){0.f, 0.f, 0.f, 0.f};
#pragma unroll
        for (int ai = 0; ai < 2; ++ai)
#pragma unroll
            for (int m = 0; m < 4; ++m) { bf16_t* rowp = base + (size_t)(row0 + ai * HALF + m * 16) * ldc + col0;
#pragma unroll
                for (int bj = 0; bj < 2; ++bj) { f32x4 v0 = acc[ai][bj][m][0] + bv[bj][0], v1 = acc[ai][bj][m][1] + bv[bj][1];
                    if (ACT == 1) { f32x2 a = gelu_pk((f32x2){v0[0], v0[1]}), b = gelu_pk((f32x2){v0[2], v0[3]}), c = gelu_pk((f32x2){v1[0], v1[1]}), d = gelu_pk((f32x2){v1[2], v1[3]});
                        v0 = (f32x4){a.x, a.y, b.x, b.y}; v1 = (f32x4){c.x, c.y, d.x, d.y}; }
                    v0 = v0 * sc; v1 = v1 * sc; u32x4 w; w.x = cvt_pk_bf16(v0[0], v0[1]); w.y = cvt_pk_bf16(v0[2], v0[3]); w.z = cvt_pk_bf16(v1[0], v1[1]); w.w = cvt_pk_bf16(v1[2], v1[3]);
                    st16_wt(rowp + bj * HALF, w); } }
    }
};

struct PanelStats {
    unsigned* xbuf;
    unsigned* cnt;
    unsigned* tmo;
    int ntn; float eps;
    unsigned code;
    __device__ __forceinline__ bool run(const f32x4 (&v)[2][2][4][2], const Unit& u, int wr, int wc, int fr, int fq, PG8_LAS unsigned char* lds, int wid, int lane) const {
        typedef float f32x2v __attribute__((ext_vector_type(2)));
        PG8_LAS f32x2v* P = (PG8_LAS f32x2v*)lds;
        PG8_LAS f32x2v* S = (PG8_LAS f32x2v*)(lds + 8192);
        PG8_LAS unsigned* flag = (PG8_LAS unsigned*)(lds + 8192 + 2048);
#pragma unroll
        for (int ai = 0; ai < 2; ++ai)
#pragma unroll
            for (int m = 0; m < 4; ++m) {
                float s = 0.f;
#pragma unroll
                for (int bj = 0; bj < 2; ++bj)
#pragma unroll
                    for (int n = 0; n < 2; ++n) { const f32x4 x = v[ai][bj][m][n]; s += (x[0] + x[1]) + (x[2] + x[3]); }
                s += __shfl_xor(s, 16); s += __shfl_xor(s, 32);
                const float mw = s * (1.0f / 64.0f); float q = 0.f;
#pragma unroll
                for (int bj = 0; bj < 2; ++bj)
#pragma unroll
                    for (int n = 0; n < 2; ++n) { const f32x4 d = v[ai][bj][m][n] - mw; q += (d[0] * d[0] + d[1] * d[1]) + (d[2] * d[2] + d[3] * d[3]); }
                q += __shfl_xor(q, 16); q += __shfl_xor(q, 32);
                if (fq == 0) P[(ai * HALF + wr * 64 + m * 16 + fr) * 4 + wc] = (f32x2v){mw, q};
            }
        asm volatile("s_waitcnt lgkmcnt(0)" ::: "memory"); __builtin_amdgcn_s_barrier(); asm volatile("" ::: "memory");
#if defined(BROKEN_EXCHANGE_NO_WAIT)
#warning BROKEN CONTROL BUILD: the row-statistics exchange does not wait; results are wrong by design
        if (blockIdx.x >= 64) { const long long t0_ = clock64(); while (clock64() - t0_ < 60000) __builtin_amdgcn_s_sleep(8); }
#endif
        const int row = wid * 32 + (lane & 31);
        if (lane < 32) {
            const f32x2v a = P[row * 4 + 0], b = P[row * 4 + 1], c = P[row * 4 + 2], d = P[row * 4 + 3];
            const float mt = (a.x + b.x + c.x + d.x) * 0.25f;
            const float da = a.x - mt, db = b.x - mt, dc = c.x - mt, dd = d.x - mt;
            const float m2 = (a.y + b.y) + (c.y + d.y) + 64.0f * ((da * da + db * db) + (dc * dc + dd * dd));
            unsigned long long* slot = (unsigned long long*)xbuf + ((size_t)(u.pm * BM + row) * 4 + u.pn);
            __hip_atomic_store(slot, ((unsigned long long)__float_as_uint(m2) << 32) | __float_as_uint(mt), __ATOMIC_RELAXED, __HIP_MEMORY_SCOPE_AGENT);
        }
        asm volatile("s_waitcnt vmcnt(0)" ::: "memory");
        if (lane == 0) __hip_atomic_fetch_add(cnt + 64 * u.pm, 1u, __ATOMIC_RELAXED, __HIP_MEMORY_SCOPE_AGENT);
        if (wid == 0) {
            bool dead = false; const unsigned long long t0 = __builtin_amdgcn_s_memrealtime(); const unsigned want = 8u * (unsigned)ntn;
            for (;;) {
#if defined(BROKEN_EXCHANGE_NO_WAIT)
                break;
#endif
                if ((unsigned)__builtin_amdgcn_readfirstlane(__hip_atomic_load(cnt + 64 * u.pm, __ATOMIC_RELAXED, __HIP_MEMORY_SCOPE_AGENT)) >= want) break;
                if (__builtin_amdgcn_s_memrealtime() - t0 > 2000000ull) {
                    if (lane == 0) { unsigned expect = 0u; __hip_atomic_compare_exchange_strong(tmo + 1, &expect, code | (unsigned)(u.pm & 0xff), __ATOMIC_RELAXED, __ATOMIC_RELAXED, __HIP_MEMORY_SCOPE_AGENT);
                                     __hip_atomic_store(tmo, 1u, __ATOMIC_RELAXED, __HIP_MEMORY_SCOPE_AGENT); }
                    dead = true; break; }
                __builtin_amdgcn_s_sleep(2);
            }
            __builtin_amdgcn_fence(__ATOMIC_ACQUIRE, "agent");
            if (lane == 0) flag[0] = dead ? 1u : 0u;
        }
        asm volatile("s_waitcnt vmcnt(0) lgkmcnt(0)" ::: "memory"); __builtin_amdgcn_s_barrier(); asm volatile("" ::: "memory");
        const bool bad = flag[0] != 0u;
        if (lane < 32) {
            const unsigned long long* slot = (const unsigned long long*)xbuf + (size_t)(u.pm * BM + row) * 4; float mt[4], m2[4]; float ms = 0.f;
#pragma unroll
            for (int t = 0; t < 4; ++t) { if (t < ntn) { const unsigned long long w = __hip_atomic_load(slot + t, __ATOMIC_RELAXED, __HIP_MEMORY_SCOPE_AGENT); mt[t] = __uint_as_float((unsigned)w); m2[t] = __uint_as_float((unsigned)(w >> 32)); } else { mt[t] = 0.f; m2[t] = 0.f; } ms += mt[t]; }
            const float mean = ms / (float)ntn; float q = 0.f;
#pragma unroll
            for (int t = 0; t < 4; ++t) if (t < ntn) { const float dm = mt[t] - mean; q += m2[t] + 256.0f * dm * dm; }
            S[row] = (f32x2v){mean, 1.0f / sqrtf(q / (256.0f * (float)ntn) + eps)};
        }
        asm volatile("s_waitcnt lgkmcnt(0)" ::: "memory"); __builtin_amdgcn_s_barrier(); asm volatile("" ::: "memory");
        return bad;
    }
};
struct EpiLnRes {
    static constexpr bool PERM = false, AFTER_DRAIN = true;
    const float* base; float* out; int ldc; const float* bias; PanelStats st; unsigned poison;
    __device__ __forceinline__ void fused(f32x4 (&acc)[2][2][4][2], const Unit& u, int wr, int wc, int fr, int fq, PG8_LAS unsigned char* lds, int wid, int lane) const {
        typedef float f32x2v __attribute__((ext_vector_type(2)));
        const PG8_LAS f32x2v* S = (const PG8_LAS f32x2v*)(lds + 8192);
        const int col0 = u.pn * BM + wc * 32 + 4 * fq;
#pragma unroll
        for (int bj = 0; bj < 2; ++bj)
#pragma unroll
            for (int n = 0; n < 2; ++n) { const f32x4 bv = bias ? *(const f32x4*)(bias + col0 + bj * HALF + n * 16) : (f32x4){0.f, 0.f, 0.f, 0.f};
#pragma unroll
                for (int ai = 0; ai < 2; ++ai)
#pragma unroll
                    for (int m = 0; m < 4; ++m) acc[ai][bj][m][n] += bv; }
        f32x4 pre[4][2][2];
#pragma unroll
        for (int m = 0; m < 4; ++m) { const size_t off = (size_t)(u.pm * BM + wr * 64 + m * 16 + fr) * ldc + col0;
#pragma unroll
            for (int bj = 0; bj < 2; ++bj)
#pragma unroll
                for (int n = 0; n < 2; ++n) pre[m][bj][n] = *(const f32x4*)(base + off + bj * HALF + n * 16); }
        const bool bad = st.run(acc, u, wr, wc, fr, fq, lds, wid, lane) || poison != 0u;
        const float qnan = __builtin_nanf("");
#pragma unroll
        for (int ai = 0; ai < 2; ++ai)
#pragma unroll
            for (int m = 0; m < 4; ++m) { const int r = ai * HALF + wr * 64 + m * 16 + fr; const f32x2v sr = S[r]; const size_t off = (size_t)(u.pm * BM + r) * ldc + col0;
#pragma unroll
                for (int bj = 0; bj < 2; ++bj)
#pragma unroll
                    for (int n = 0; n < 2; ++n) { const f32x4 bs = ai == 0 ? pre[m][bj][n] : *(const f32x4*)(base + off + bj * HALF + n * 16); f32x4 o = bs + (acc[ai][bj][m][n] - sr.x) * sr.y;
                        if (bad) o = (f32x4){qnan, qnan, qnan, qnan}; *(f32x4*)(out + off + bj * HALF + n * 16) = o; }
                if (m & 1) asm volatile("" ::: "memory"); }
    }
};
struct EpiLnResLn {
    static constexpr bool PERM = false, AFTER_DRAIN = true;
    const float* base; float* out; bf16_t* xn; int ldc; const float* bias; PanelStats st1, st2; unsigned poison;
    __device__ __forceinline__ void fused(f32x4 (&acc)[2][2][4][2], const Unit& u, int wr, int wc, int fr, int fq, PG8_LAS unsigned char* lds, int wid, int lane) const {
        typedef float f32x2v __attribute__((ext_vector_type(2))); typedef unsigned u32x2v __attribute__((ext_vector_type(2)));
        const PG8_LAS f32x2v* S = (const PG8_LAS f32x2v*)(lds + 8192);
        const int col0 = u.pn * BM + wc * 32 + 4 * fq;
#pragma unroll
        for (int bj = 0; bj < 2; ++bj)
#pragma unroll
            for (int n = 0; n < 2; ++n) { const f32x4 bv = bias ? *(const f32x4*)(bias + col0 + bj * HALF + n * 16) : (f32x4){0.f, 0.f, 0.f, 0.f};
#pragma unroll
                for (int ai = 0; ai < 2; ++ai)
#pragma unroll
                    for (int m = 0; m < 4; ++m) acc[ai][bj][m][n] += bv; }
        bool bad = st1.run(acc, u, wr, wc, fr, fq, lds, wid, lane) || poison != 0u;
        const float qnan = __builtin_nanf("");
#pragma unroll
        for (int ai = 0; ai < 2; ++ai)
#pragma unroll
            for (int m = 0; m < 4; ++m) { const int r = ai * HALF + wr * 64 + m * 16 + fr; const f32x2v sr = S[r]; const size_t off = (size_t)(u.pm * BM + r) * ldc + col0;
#pragma unroll
                for (int bj = 0; bj < 2; ++bj)
#pragma unroll
                    for (int n = 0; n < 2; ++n) { const f32x4 bs = *(const f32x4*)(base + off + bj * HALF + n * 16); acc[ai][bj][m][n] = bs + (acc[ai][bj][m][n] - sr.x) * sr.y; }
                asm volatile("" : "+v"(acc[ai][0][m][0]), "+v"(acc[ai][0][m][1]), "+v"(acc[ai][1][m][0]), "+v"(acc[ai][1][m][1]));
                if (m & 1) asm volatile("" ::: "memory"); }
        const bool bad1 = bad;
        bad = st2.run(acc, u, wr, wc, fr, fq, lds, wid, lane) || bad;
#pragma unroll
        for (int ai = 0; ai < 2; ++ai)
#pragma unroll
            for (int m = 0; m < 4; ++m) { const int r = ai * HALF + wr * 64 + m * 16 + fr; const f32x2v sr = S[r]; const size_t off = (size_t)(u.pm * BM + r) * ldc + col0;
#pragma unroll
                for (int bj = 0; bj < 2; ++bj)
#pragma unroll
                    for (int n = 0; n < 2; ++n) { const f32x4 x1 = acc[ai][bj][m][n]; *(f32x4*)(out + off + bj * HALF + n * 16) = bad1 ? (f32x4){qnan, qnan, qnan, qnan} : x1;
                        const f32x4 o = (x1 - sr.x) * sr.y; u32x2v w; w.x = cvt_pk_bf16(o[0], o[1]); w.y = cvt_pk_bf16(o[2], o[3]);
                        if (bad) { w.x = 0x7fc07fc0u; w.y = 0x7fc07fc0u; } *(u32x2v*)(xn + off + bj * HALF + n * 16) = w; }
                asm volatile("" ::: "memory"); }
    }
};

template <class Epi, class Sched, bool ALIGN_EPI = false, bool SP2 = false>
__device__ __forceinline__ void gemm_phase(PG8_LAS unsigned char* lds, const Gemm g, const Sched& S, const Epi& E) {
    const int tid = threadIdx.x, wid = __builtin_amdgcn_readfirstlane(tid >> 6), lane = tid & 63, wr = wid >> 2, wc = wid & 3, fr = lane & 15, fq = lane >> 4;
    const int K = g.K, nt = K / BK;
    unsigned voffA[2], voffB[2];
    unsigned cvo[2][2], nvo[2][2];
    int RA[2], CA[2];
#pragma unroll
    for (int i = 0; i < 2; ++i) { int R, C; stage_rc(tid * 16 + i * 8192, R, C); const int Rb = Epi::PERM ? ((R & ~31) + perm32(R & 31)) : R;
        voffA[i] = (unsigned)(R * K + C) * 2u; voffB[i] = (unsigned)(Rb * K + C) * 2u; RA[i] = R; CA[i] = C; }
    const size_t kstep = (size_t)(BK * 2);
    const size_t hstep = (size_t)HALF * K * 2;
    const size_t tstep = 2 * hstep;
    constexpr bool GATHER = Sched::GATHER;
    const size_t hstepA = GATHER ? 0 : hstep, tstepA = GATHER ? 0 : tstep;
#define PG8_VOA(h, nx) (GATHER ? ((nx) ? nvo[h] : cvo[h]) : voffA)
#define PG8_GOFFS(dst, u) do { _Pragma("unroll") for (int h_ = 0; h_ < 2; ++h_) _Pragma("unroll") for (int i_ = 0; i_ < 2; ++i_) dst[h_][i_] = (unsigned)((size_t)S.arow(u, h_ * HALF + RA[i_]) * K + CA[i_]) * 2u; } while (0)
    const unsigned ldsw = (unsigned)wid * 1024u;
    const int aoff = lds_byte(wr * 64 + fr, fq * 8), boff = lds_byte(wc * 32 + fr, fq * 8);
#define PG8_SA(b, h) (((b) * 2 + (h)) * HTB)
#define PG8_SB(b, h) ((4 + (b) * 2 + (h)) * HTB)
#define PG8_STAGE(bufoff, gbase, voff) do { _Pragma("unroll") for (int _i = 0; _i < 2; ++_i) \
        __builtin_amdgcn_global_load_lds((const unsigned*)((const char*)(gbase) + (voff)[_i]), (PG8_LAS unsigned*)(lds + (bufoff) + ldsw + _i * 8192), 16, 0, 0); } while (0)
#define PG8_LDA(dst, b, h) do { _Pragma("unroll") for (int m = 0; m < 4; ++m) _Pragma("unroll") for (int k = 0; k < 2; ++k) dst[m][k] = *(const PG8_LAS bf16x8*)(lds + PG8_SA(b, h) + aoff + m * 2048 + k * 1024); } while (0)
#define PG8_LDB(dst, b, h) do { _Pragma("unroll") for (int n = 0; n < 2; ++n) _Pragma("unroll") for (int k = 0; k < 2; ++k) dst[n][k] = *(const PG8_LAS bf16x8*)(lds + PG8_SB(b, h) + boff + n * 2048 + k * 1024); } while (0)
#define PG8_MMA(ai, bj, At, Bt) do { __builtin_amdgcn_s_setprio(1); _Pragma("unroll") for (int m = 0; m < 4; ++m) _Pragma("unroll") for (int n = 0; n < 2; ++n) _Pragma("unroll") for (int k = 0; k < 2; ++k) \
        acc[ai][bj][m][n] = __builtin_amdgcn_mfma_f32_16x16x32_bf16(Bt[n][k], At[m][k], acc[ai][bj][m][n], 0, 0, 0); __builtin_amdgcn_s_setprio(0); } while (0)
#define PG8_WAIT_V(n) asm volatile("s_waitcnt vmcnt(" #n ")" ::: "memory")
#define PG8_WAIT_L(n) asm volatile("s_waitcnt lgkmcnt(" #n ")" ::: "memory")
#define PG8_BAR __builtin_amdgcn_s_barrier()
#define PG8_SCHED __builtin_amdgcn_sched_barrier(0)
    Unit cur, nxt; int ui = 0;
    if (!S.next(0, cur)) return;
    f32x4 acc[2][2][4][2];
#pragma unroll
    for (int a = 0; a < 2; ++a)
#pragma unroll
        for (int b = 0; b < 2; ++b)
#pragma unroll
            for (int m = 0; m < 4; ++m)
#pragma unroll
                for (int n = 0; n < 2; ++n) acc[a][b][m][n] = (f32x4){0.f, 0.f, 0.f, 0.f};
    bf16x8 At[4][2], B0[2][2], B1[2][2];
    const char* cA = (const char*)g.A + (size_t)cur.pm * tstepA; const char* cB = (const char*)g.Bt + S.bofs(cur) + (size_t)cur.pn * tstep;
    if constexpr (GATHER) { PG8_GOFFS(cvo, cur); Unit u1_; if (S.next(1, u1_)) PG8_GOFFS(nvo, u1_); else { _Pragma("unroll") for (int h_ = 0; h_ < 2; ++h_) _Pragma("unroll") for (int i_ = 0; i_ < 2; ++i_) nvo[h_][i_] = cvo[h_][i_]; } }
    S.a_ready(cur);
    if constexpr (SP2) {
        PG8_STAGE(PG8_SB(0, 0), cB, voffB); PG8_STAGE(PG8_SB(0, 1), cB + hstep, voffB); PG8_STAGE(PG8_SA(0, 0), cA, PG8_VOA(0, false)); PG8_STAGE(PG8_SA(0, 1), cA + hstepA, PG8_VOA(1, false));
        if (wr == 1) PG8_BAR;
        PG8_WAIT_V(2); PG8_BAR;
        PG8_STAGE(PG8_SB(1, 0), cB + kstep, voffB); PG8_STAGE(PG8_SA(1, 0), cA + kstep, PG8_VOA(0, false)); PG8_STAGE(PG8_SB(1, 1), cB + hstep + kstep, voffB);
        PG8_WAIT_V(6); PG8_BAR;
    } else {
        PG8_STAGE(PG8_SB(0, 0), cB, voffB); PG8_STAGE(PG8_SA(0, 0), cA, PG8_VOA(0, false)); PG8_STAGE(PG8_SB(0, 1), cB + hstep, voffB); PG8_STAGE(PG8_SA(0, 1), cA + hstepA, PG8_VOA(1, false));
        if (wr == 1) PG8_BAR;
        PG8_WAIT_V(4); PG8_BAR;
        PG8_STAGE(PG8_SB(1, 0), cB + kstep, voffB); PG8_STAGE(PG8_SA(1, 0), cA + kstep, PG8_VOA(0, false)); PG8_STAGE(PG8_SB(1, 1), cB + hstep + kstep, voffB);
        PG8_WAIT_V(6); PG8_BAR;
    }
    for (;;) {
        const bool has_next = S.next(ui + 1, nxt);
        const char* nA = has_next ? (const char*)g.A + (size_t)nxt.pm * tstepA : cA;
        if constexpr (GATHER) { if (ui > 0) { if (has_next) PG8_GOFFS(nvo, nxt); else { _Pragma("unroll") for (int h_ = 0; h_ < 2; ++h_) _Pragma("unroll") for (int i_ = 0; i_ < 2; ++i_) nvo[h_][i_] = cvo[h_][i_]; } } } const char* nB = has_next ? (const char*)g.Bt + S.bofs(nxt) + (size_t)nxt.pn * tstep : cB;
        for (int t = 0; t < nt; t += 2) {
            const bool last = (t == nt - 2);
            const char* a1 = cA + (size_t)(t + 1) * kstep;
            const char* a2 = last ? nA : cA + (size_t)(t + 2) * kstep; const char* b2 = last ? nB : cB + (size_t)(t + 2) * kstep;
            const char* a3 = a2 + kstep; const char* b3 = b2 + kstep;
            if (last && has_next) S.a_ready(nxt);
            if constexpr (SP2) {
            PG8_LDB(B0, 0, 0); PG8_LDB(B1, 0, 1); PG8_SCHED; PG8_LDA(At, 0, 0); PG8_STAGE(PG8_SA(1, 1), a1 + hstepA, PG8_VOA(1, false));
            PG8_WAIT_V(8); PG8_WAIT_L(0); PG8_BAR; PG8_MMA(0, 0, At, B0); PG8_MMA(0, 1, At, B1); PG8_BAR; PG8_SCHED;
            PG8_LDA(At, 0, 1); PG8_STAGE(PG8_SB(0, 0), b2, voffB); PG8_STAGE(PG8_SB(0, 1), b2 + hstep, voffB); PG8_STAGE(PG8_SA(0, 0), a2, PG8_VOA(0, last));
            PG8_WAIT_V(8); PG8_WAIT_L(0); PG8_BAR; PG8_MMA(1, 0, At, B0); PG8_MMA(1, 1, At, B1); PG8_BAR; PG8_SCHED;
            PG8_LDB(B0, 1, 0); PG8_LDB(B1, 1, 1); PG8_SCHED; PG8_LDA(At, 1, 0); PG8_STAGE(PG8_SA(0, 1), a2 + hstepA, PG8_VOA(1, last));
            PG8_WAIT_V(8); PG8_WAIT_L(0); PG8_BAR; PG8_MMA(0, 0, At, B0); PG8_MMA(0, 1, At, B1); PG8_BAR; PG8_SCHED;
            PG8_LDA(At, 1, 1); PG8_STAGE(PG8_SB(1, 0), b3, voffB); PG8_STAGE(PG8_SB(1, 1), b3 + hstep, voffB); PG8_STAGE(PG8_SA(1, 0), a3, PG8_VOA(0, last));
            PG8_WAIT_V(8); PG8_WAIT_L(0); PG8_BAR; PG8_MMA(1, 0, At, B0); PG8_MMA(1, 1, At, B1); PG8_BAR; PG8_SCHED;
            } else {
            PG8_LDB(B0, 0, 0); PG8_SCHED; PG8_LDA(At, 0, 0); PG8_STAGE(PG8_SA(1, 1), a1 + hstepA, PG8_VOA(1, false));
            PG8_WAIT_L(8); PG8_BAR; PG8_WAIT_L(0); PG8_MMA(0, 0, At, B0); PG8_BAR; PG8_SCHED;
            PG8_LDB(B1, 0, 1); PG8_STAGE(PG8_SB(0, 0), b2, voffB);
            PG8_BAR; PG8_WAIT_L(0); PG8_MMA(0, 1, At, B1); PG8_BAR;
            PG8_LDA(At, 0, 1); PG8_STAGE(PG8_SA(0, 0), a2, PG8_VOA(0, last));
            PG8_BAR; PG8_WAIT_L(0); PG8_MMA(1, 0, At, B0); PG8_BAR; PG8_SCHED;
            PG8_STAGE(PG8_SB(0, 1), b2 + hstep, voffB);
            PG8_WAIT_V(6); PG8_BAR; PG8_MMA(1, 1, At, B1); PG8_BAR;
            PG8_LDB(B0, 1, 0); PG8_SCHED; PG8_LDA(At, 1, 0); PG8_STAGE(PG8_SA(0, 1), a2 + hstepA, PG8_VOA(1, last));
            PG8_WAIT_L(8); PG8_BAR; PG8_WAIT_L(0); PG8_MMA(0, 0, At, B0); PG8_BAR; PG8_SCHED;
            PG8_LDB(B1, 1, 1); PG8_STAGE(PG8_SB(1, 0), b3, voffB);
            PG8_BAR; PG8_WAIT_L(0); PG8_MMA(0, 1, At, B1); PG8_BAR;
            PG8_LDA(At, 1, 1); PG8_STAGE(PG8_SA(1, 0), a3, PG8_VOA(0, last));
            PG8_BAR; PG8_WAIT_L(0); PG8_MMA(1, 0, At, B0); PG8_BAR; PG8_SCHED;
            PG8_STAGE(PG8_SB(1, 1), b3 + hstep, voffB);
            PG8_WAIT_V(6); PG8_BAR; PG8_MMA(1, 1, At, B1); PG8_BAR;
            }
        }
        if constexpr (ALIGN_EPI) { if (wr == 0) PG8_BAR; }
        if constexpr (!Epi::AFTER_DRAIN) { E(acc, cur, wr, wc, fr, fq); S.done(cur); }
        if (!has_next) break;
#pragma unroll
        for (int a = 0; a < 2; ++a)
#pragma unroll
            for (int b = 0; b < 2; ++b)
#pragma unroll
                for (int m = 0; m < 4; ++m)
#pragma unroll
                    for (int n = 0; n < 2; ++n) acc[a][b][m][n] = (f32x4){0.f, 0.f, 0.f, 0.f};
        cur = nxt; cA = nA; cB = nB; ++ui;
        if constexpr (GATHER) { _Pragma("unroll") for (int h_ = 0; h_ < 2; ++h_) _Pragma("unroll") for (int i_ = 0; i_ < 2; ++i_) cvo[h_][i_] = nvo[h_][i_]; }
        if constexpr (ALIGN_EPI) { if (wr == 1) PG8_BAR; }
    }
    PG8_WAIT_V(0);
    if constexpr (!ALIGN_EPI) { if (wr == 0) PG8_BAR; }
    PG8_BAR;
    if constexpr (Epi::AFTER_DRAIN) { E.fused(acc, cur, wr, wc, fr, fq, lds, wid, lane); S.done(cur); }
#undef PG8_SA
#undef PG8_VOA
#undef PG8_GOFFS
#undef PG8_SB
#undef PG8_STAGE
#undef PG8_LDA
#undef PG8_LDB
#undef PG8_MMA
#undef PG8_WAIT_V
#undef PG8_WAIT_L
#undef PG8_BAR
#undef PG8_SCHED
}
}

#ifndef PG8_SP2
#define PG8_SP2 true
#endif
#ifndef PG8_ALIGN
#define PG8_ALIGN true
#endif
namespace pg8 {
struct EpiF32 {
    static constexpr bool PERM = false, AFTER_DRAIN = false;
    float* O; int ldc;
    __device__ __forceinline__ void operator()(const f32x4 (&acc)[2][2][4][2], const Unit& u, int wr, int wc, int fr, int fq) const {
        const int row0 = u.pm * BM + wr * 64 + fr, col0 = u.pn * BM + wc * 32 + 4 * fq;
#pragma unroll
        for (int ai = 0; ai < 2; ++ai)
#pragma unroll
            for (int m = 0; m < 4; ++m) { float* rowp = O + (size_t)(row0 + ai * HALF + m * 16) * ldc + col0;
#pragma unroll
                for (int bj = 0; bj < 2; ++bj)
#pragma unroll
                    for (int n = 0; n < 2; ++n) *(f32x4*)(rowp + bj * HALF + n * 16) = acc[ai][bj][m][n]; }
    }
};
template <bool GATHER_> struct MoeOrder {
    const PG8_LAS int* tb; int ncol, G, c; size_t estride; const int* list; const unsigned* cnt;
    static constexpr bool GATHER = GATHER_;
    __device__ __forceinline__ int arow(const Unit& u, int r) const { int e = 0;
#pragma unroll
        for (int k = 1; k < 16; ++k) e += (u.pm >= tb[k]) ? 1 : 0;
        const int pos = (u.pm - tb[e]) * 256 + r; return pos < (int)cnt[e] ? list[e * 16384 + pos] : 0; }
    __device__ __forceinline__ bool next(int i, Unit& u) const { const int L = i * G + c, t = L / ncol; if (t >= __builtin_amdgcn_readfirstlane(tb[16])) return false; u.pm = t; u.pn = L - t * ncol; return true; }
    __device__ __forceinline__ void a_ready(const Unit&) const {}
    __device__ __forceinline__ void done(const Unit&) const {}
    __device__ __forceinline__ size_t bofs(const Unit& u) const { int e = 0;
#pragma unroll
        for (int k = 1; k < 16; ++k) e += (u.pm >= tb[k]) ? 1 : 0;
        return (size_t)__builtin_amdgcn_readfirstlane(e) * estride; }
};
struct EpiSwiGLU {
    static constexpr bool PERM = true, AFTER_DRAIN = false;
    bf16_t* O;
    __device__ __forceinline__ void operator()(const f32x4 (&acc)[2][2][4][2], const Unit& u, int wr, int wc, int fr, int fq) const {
        const int row0 = u.pm * BM + wr * 64 + fr, col0 = u.pn * 128 + wc * 32 + 8 * fq;
#pragma unroll
        for (int ai = 0; ai < 2; ++ai)
#pragma unroll
            for (int m = 0; m < 4; ++m) { bf16_t* rowp = O + (size_t)(row0 + ai * HALF + m * 16) * 256 + col0;
                f32x4 v[2];
#pragma unroll
                for (int n = 0; n < 2; ++n)
#pragma unroll
                    for (int e = 0; e < 4; ++e) { const float gt = acc[ai][0][m][n][e]; v[n][e] = gt / (1.f + __expf(-gt)) * acc[ai][1][m][n][e]; }
                u32x4 w; w.x = cvt_pk_bf16(v[0][0], v[0][1]); w.y = cvt_pk_bf16(v[0][2], v[0][3]); w.z = cvt_pk_bf16(v[1][0], v[1][1]); w.w = cvt_pk_bf16(v[1][2], v[1][3]);
                st16_wt(rowp, w); }
    }
};
struct EpiLn1 {
    static constexpr bool PERM = false, AFTER_DRAIN = true;
    const float* x; float* hout; bf16_t* hb; const float* gam; const float* bet; float alpha; PanelStats st; unsigned poison;
    __device__ __forceinline__ void fused(f32x4 (&acc)[2][2][4][2], const Unit& u, int wr, int wc, int fr, int fq, PG8_LAS unsigned char* lds, int wid, int lane) const {
        typedef float f32x2v __attribute__((ext_vector_type(2))); typedef unsigned u32x2v __attribute__((ext_vector_type(2)));
        const PG8_LAS f32x2v* S = (const PG8_LAS f32x2v*)(lds + 8192);
        const int col0 = u.pn * BM + wc * 32 + 4 * fq, ldc = 1024;
#pragma unroll
        for (int ai = 0; ai < 2; ++ai)
#pragma unroll
            for (int m = 0; m < 4; ++m) { const size_t off = (size_t)(u.pm * BM + ai * HALF + wr * 64 + m * 16 + fr) * ldc + col0;
#pragma unroll
                for (int bj = 0; bj < 2; ++bj)
#pragma unroll
                    for (int n = 0; n < 2; ++n) { const f32x4 xv = *(const f32x4*)(x + off + bj * HALF + n * 16); acc[ai][bj][m][n] = xv * alpha + acc[ai][bj][m][n]; }
                asm volatile("" : "+v"(acc[ai][0][m][0]), "+v"(acc[ai][0][m][1]), "+v"(acc[ai][1][m][0]), "+v"(acc[ai][1][m][1]));
                if (m & 1) asm volatile("" ::: "memory"); }
        const bool bad = st.run(acc, u, wr, wc, fr, fq, lds, wid, lane) || poison != 0u;
        const float qnan = __builtin_nanf("");
        f32x4 gv[2][2], bv[2][2];
#pragma unroll
        for (int bj = 0; bj < 2; ++bj)
#pragma unroll
            for (int n = 0; n < 2; ++n) { gv[bj][n] = *(const f32x4*)(gam + col0 + bj * HALF + n * 16); bv[bj][n] = *(const f32x4*)(bet + col0 + bj * HALF + n * 16); }
#pragma unroll
        for (int ai = 0; ai < 2; ++ai)
#pragma unroll
            for (int m = 0; m < 4; ++m) { const int r = ai * HALF + wr * 64 + m * 16 + fr; const f32x2v sr = S[r]; const size_t off = (size_t)(u.pm * BM + r) * ldc + col0;
#pragma unroll
                for (int bj = 0; bj < 2; ++bj)
#pragma unroll
                    for (int n = 0; n < 2; ++n) { f32x4 o = (acc[ai][bj][m][n] - sr.x) * sr.y * gv[bj][n] + bv[bj][n];
                        if (bad) o = (f32x4){qnan, qnan, qnan, qnan};
                        *(f32x4*)(hout + off + bj * HALF + n * 16) = o;
                        u32x2v w; w.x = cvt_pk_bf16(o[0], o[1]); w.y = cvt_pk_bf16(o[2], o[3]); *(u32x2v*)(hb + off + bj * HALF + n * 16) = w; }
                asm volatile("" ::: "memory"); }
    }
};
struct EpiProj {
    static constexpr bool PERM = true, AFTER_DRAIN = false;
    bf16_t* PJ; size_t slot_stride; const float* rope; float* KM; PG8_LAS float* xch;
    __device__ __forceinline__ void operator()(const f32x4 (&acc)[2][2][4][2], const Unit& u, int wr, int wc, int fr, int fq) const {
        const int slot = u.pn >> 1, row0 = u.pm * BM + wr * 64 + fr;
        bf16_t* base = PJ + (size_t)slot * slot_stride;
        if (slot != 4 && slot != 5) {
            const int col0 = (u.pn & 1) * BM + wc * 32 + 8 * fq;
#pragma unroll
            for (int ai = 0; ai < 2; ++ai)
#pragma unroll
                for (int m = 0; m < 4; ++m) { bf16_t* rowp = base + (size_t)(row0 + ai * HALF + m * 16) * 512 + col0;
#pragma unroll
                    for (int bj = 0; bj < 2; ++bj) { const f32x4 v0 = acc[ai][bj][m][0], v1 = acc[ai][bj][m][1];
                        u32x4 w; w.x = cvt_pk_bf16(v0[0], v0[1]); w.y = cvt_pk_bf16(v0[2], v0[3]); w.z = cvt_pk_bf16(v1[0], v1[1]); w.w = cvt_pk_bf16(v1[2], v1[3]);
                        *(u32x4*)(rowp + bj * HALF) = w; } }
            return;
        }
        const int head = (u.pn & 1) * 2 + (wc >> 1), d0 = 32 * (wc & 1) + 8 * fq;
        float cs1[8], cs2[8];
#pragma unroll
        for (int k = 0; k < 8; ++k) { cs1[k] = 0.f; cs2[k] = 0.f; }
#pragma unroll
        for (int ai = 0; ai < 2; ++ai)
#pragma unroll
            for (int m = 0; m < 4; ++m) {
                const int row = row0 + ai * HALF + m * 16, pos = row & 4095;
                const float* rp = rope + ((size_t)pos * 64 + d0) * 2;
                const f32x4 c0 = *(const f32x4*)rp, c1 = *(const f32x4*)(rp + 4), c2 = *(const f32x4*)(rp + 8), c3 = *(const f32x4*)(rp + 12);
                const float cs[8] = {c0[0], c0[2], c1[0], c1[2], c2[0], c2[2], c3[0], c3[2]}, sn[8] = {c0[1], c0[3], c1[1], c1[3], c2[1], c2[3], c3[1], c3[3]};
                float r1[8], r2[8];
#pragma unroll
                for (int k = 0; k < 8; ++k) { const float t1 = acc[ai][0][m][k >> 2][k & 3], t2 = acc[ai][1][m][k >> 2][k & 3];
                    r1[k] = t1 * cs[k] - t2 * sn[k]; r2[k] = t2 * cs[k] + t1 * sn[k]; }
                if (slot == 5) {
#pragma unroll
                    for (int k = 0; k < 8; ++k) { cs1[k] += r1[k]; cs2[k] += r2[k]; }
                    asm volatile("" : "+v"(cs1[0]), "+v"(cs1[1]), "+v"(cs1[2]), "+v"(cs1[3]), "+v"(cs1[4]), "+v"(cs1[5]), "+v"(cs1[6]), "+v"(cs1[7]));
                    asm volatile("" : "+v"(cs2[0]), "+v"(cs2[1]), "+v"(cs2[2]), "+v"(cs2[3]), "+v"(cs2[4]), "+v"(cs2[5]), "+v"(cs2[6]), "+v"(cs2[7]));
                }
                bf16_t* rowp = base + (size_t)row * 512 + head * 128 + d0;
                u32x4 w1, w2;
                w1.x = cvt_pk_bf16(r1[0], r1[1]); w1.y = cvt_pk_bf16(r1[2], r1[3]); w1.z = cvt_pk_bf16(r1[4], r1[5]); w1.w = cvt_pk_bf16(r1[6], r1[7]);
                w2.x = cvt_pk_bf16(r2[0], r2[1]); w2.y = cvt_pk_bf16(r2[2], r2[3]); w2.z = cvt_pk_bf16(r2[4], r2[5]); w2.w = cvt_pk_bf16(r2[6], r2[7]);
                *(u32x4*)rowp = w1; *(u32x4*)(rowp + 64) = w2;
                asm volatile("" ::: "memory");
            }
        if (slot == 5) {
#pragma unroll
            for (int k = 0; k < 8; ++k) {
#pragma unroll
                for (int o = 1; o < 16; o <<= 1) { cs1[k] += __shfl_xor(cs1[k], o); cs2[k] += __shfl_xor(cs2[k], o); } }
            PG8_LAS float* x = xch + (wc * 4 + fq) * 16;
            if (wr == 1 && fr == 0) {
#pragma unroll
                for (int k = 0; k < 8; ++k) { x[k] = cs1[k]; x[8 + k] = cs2[k]; } }
            asm volatile("s_waitcnt lgkmcnt(0)" ::: "memory"); __builtin_amdgcn_s_barrier(); asm volatile("" ::: "memory");
            if (wr == 0 && fr == 0) {
                const int b = (u.pm * BM) >> 12, j = ((u.pm * BM) & 4095) >> 8;
                float* kp = KM + ((size_t)((b * 4 + head) * 16 + j)) * 128 + d0;
#pragma unroll
                for (int k = 0; k < 8; ++k) { kp[k] = cs1[k] + x[k]; kp[64 + k] = cs2[k] + x[8 + k]; }
            }
        }
    }
};
}
#define GAS __attribute__((address_space(1)))
#define LAS __attribute__((address_space(3)))
typedef unsigned short bf16;
typedef unsigned v4u __attribute__((ext_vector_type(4)));
typedef float f32x4 __attribute__((ext_vector_type(4)));
typedef short bf16x8 __attribute__((ext_vector_type(8)));
typedef GAS unsigned gu32;
typedef GAS unsigned long long gu64;
#define RLX_AGENT __ATOMIC_RELAXED, __HIP_MEMORY_SCOPE_AGENT
#define LDS_WAIT() asm volatile("s_waitcnt lgkmcnt(0)" ::: "memory")
#define VM_WAIT() asm volatile("s_waitcnt vmcnt(0)" ::: "memory")
__device__ __forceinline__ unsigned long long rt() { return __builtin_amdgcn_s_memrealtime(); }
__device__ __forceinline__ unsigned f2bf(float f) { unsigned u = __builtin_bit_cast(unsigned, f); return (u + 0x7fffu + ((u >> 16) & 1u)) >> 16; }
__device__ __forceinline__ unsigned pk2(float lo, float hi) { return f2bf(lo) | (f2bf(hi) << 16); }

#define XB_TMO      128
#define XB_XCNT(j)  (256  + 64 * (j))
#define XB_XSUB(j)  (1280 + 64 * (j))
#define XB_XGEN(j)  (2304 + 64 * (j))
#define XB_TOP      3328
#define XB_TOPGEN   3392
#define XCD_BAR_WORDS 3456
#define XB_SPIN_CAP (1u << 18)

__device__ __forceinline__ unsigned xb_ld(unsigned* p)              { return __hip_atomic_load(p, __ATOMIC_RELAXED, __HIP_MEMORY_SCOPE_AGENT); }
__device__ __forceinline__ unsigned xb_add(unsigned* p, unsigned v) { return __hip_atomic_fetch_add(p, v, __ATOMIC_RELAXED, __HIP_MEMORY_SCOPE_AGENT); }
__device__ __forceinline__ unsigned xb_xcc_id() { return (unsigned)__builtin_amdgcn_s_getreg((3 << 11) | 20) & 0xFu; }
#define XB_SPIN(cond, bar) do { unsigned _sp = 0; while (cond) { __builtin_amdgcn_s_sleep(1); \
    if ((++_sp & 255u) == 0u) { if (xb_ld(&(bar)[XB_TMO])) break; if (_sp > XB_SPIN_CAP) { atomicAdd(&(bar)[XB_TMO], 1u); break; } } } } while (0)

struct XcdBarrier {
    unsigned* bar; unsigned x;
    volatile LAS unsigned* st;
};

__device__ __forceinline__ XcdBarrier xcd_barrier_post(unsigned* bar, volatile LAS unsigned* st) {
    XcdBarrier b; b.bar = bar; b.x = xb_xcc_id(); b.st = st;
    if (threadIdx.x == 0) (void)xb_add(&bar[XB_XCNT(b.x)], 1u);
    return b;
}
__device__ __forceinline__ void xcd_barrier_complete(unsigned* bar, unsigned x, unsigned& nloc, unsigned& nx) {
    const unsigned G = gridDim.x * gridDim.y * gridDim.z;
    unsigned sum, cnt, mine, sp = 0u;
    for (;;) {
        sum = 0u; cnt = 0u; mine = 0u;
#pragma unroll
        for (unsigned j = 0; j < 16; ++j) { const unsigned c = xb_ld(&bar[XB_XCNT(j)]); sum += c; cnt += (c > 0u) ? 1u : 0u; mine = (j == x) ? c : mine; }
        if (sum == G) break;
        __builtin_amdgcn_s_sleep(1);
        if ((++sp & 255u) == 0u) { if (xb_ld(&bar[XB_TMO])) break; if (sp > XB_SPIN_CAP) { atomicAdd(&bar[XB_TMO], 1u); break; } }
    }
    nloc = mine > 0u ? mine : 1u; nx = cnt > 0u ? cnt : 1u;
}

__device__ __forceinline__ void xcd_barrier(const XcdBarrier& b) {
    asm volatile("s_waitcnt vmcnt(0)" ::: "memory");
    __syncthreads();
    if (threadIdx.x == 0) {
        unsigned* bar = b.bar;
        __builtin_amdgcn_s_waitcnt(0);
        unsigned nloc = b.st[0], nx = b.st[1];
        if (nloc == 0u) { xcd_barrier_complete(bar, b.x, nloc, nx); b.st[0] = nloc; b.st[1] = nx; }
        const unsigned old = xb_add(&bar[XB_XSUB(b.x)], 1u);
        const unsigned gen = old / nloc;
        if (old + 1u == (gen + 1u) * nloc) {
            __builtin_amdgcn_fence(__ATOMIC_RELEASE, "agent");
            asm volatile("s_waitcnt vmcnt(0)" ::: "memory");
            const unsigned og = xb_add(&bar[XB_TOP], 1u);
            const unsigned tg = og / nx;
            if (og + 1u == (tg + 1u) * nx) xb_add(&bar[XB_TOPGEN], 1u);
            else XB_SPIN(xb_ld(&bar[XB_TOPGEN]) == tg, bar);
            __builtin_amdgcn_fence(__ATOMIC_ACQUIRE, "agent");
            xb_add(&bar[XB_XGEN(b.x)], 1u);
            asm volatile("s_waitcnt vmcnt(0)" ::: "memory");
        } else {
            XB_SPIN(xb_ld(&bar[XB_XGEN(b.x)]) == gen, bar);
            __builtin_amdgcn_fence(__ATOMIC_ACQUIRE, "agent");
            asm volatile("s_waitcnt vmcnt(0)" ::: "memory");
        }
    }
    __syncthreads();
}
namespace mb {
constexpr int D = 128, PITCH = 512, OPITCH = 1024;
constexpr float THR = 8.f;
constexpr bool WSKIP = false;
constexpr int KM_OFF = 69632;
constexpr float SCALE = 0.08838834764831845f;
constexpr int NW = 8, QBLK = 32, KVBLK = 64, QB = NW * QBLK;
constexpr int SHM_V = KVBLK * D * 2, SHM_K = KVBLK * D * 2;
constexpr int LDS_BYTES = 2 * SHM_V + 2 * SHM_K + NW * 64 * 4;

typedef short bf16x8 __attribute__((ext_vector_type(8)));
typedef short s16x4 __attribute__((ext_vector_type(4)));
typedef float f32x16 __attribute__((ext_vector_type(16)));
typedef float f32x4 __attribute__((ext_vector_type(4)));
typedef unsigned u32x4 __attribute__((ext_vector_type(4)));
template <class A, class Bt> struct same_t { static constexpr bool v = false; };
template <class A> struct same_t<A, A> { static constexpr bool v = true; };

typedef const GAS char* gcptr;
__device__ __forceinline__ gcptr uni(const void* p) {
    const unsigned long long u = (unsigned long long)p;
    const unsigned lo = __builtin_amdgcn_readfirstlane((unsigned)u), hi = __builtin_amdgcn_readfirstlane((unsigned)(u >> 32));
    return (gcptr)(((unsigned long long)hi << 32) | lo);
}
#define KSWZ(row, colB) ((row) * 256 + ((colB) ^ (((row) & 7) << 4)))
#define SBAR() __builtin_amdgcn_sched_barrier(0)
__device__ __forceinline__ int v_st(int k, int c) { const int kk = (k & ~0xC) | ((k & 4) << 1) | ((k & 8) >> 1); return ((kk >> 3) * 4 + (c >> 5)) * 512 + ((kk & 7) * 32 + (c & 31)) * 2; }
__device__ __forceinline__ int v_rd_base(int lane) { return ((lane & 3) << 3) | (((lane >> 2) & 3) << 6) | (((lane >> 4) & 1) << 5) | (((lane >> 5) & 1) << 8); }
constexpr int v_rd_off(int d0, int ks, int half) { return d0 * 512 + ks * 4096 + half * 2048; }
__device__ __forceinline__ int crow(int r, int hi) { return (r & 3) + 8 * (r >> 2) + 4 * hi; }
__device__ __forceinline__ unsigned cvtpk(float lo, float hi) {
    unsigned r; asm volatile("v_cvt_pk_bf16_f32 %0, %1, %2" : "=v"(r) : "v"(lo), "v"(hi)); return r;
}
__device__ __forceinline__ bf16x8 pack8(f32x4 a, f32x4 b) {
    u32x4 w = {cvtpk(a[0], a[1]), cvtpk(a[2], a[3]), cvtpk(b[0], b[1]), cvtpk(b[2], b[3])};
    return *reinterpret_cast<bf16x8*>(&w);
}
template <class T> __device__ __forceinline__ bf16x8 load8(const T* p) {
    if constexpr (same_t<T, float>::v) { return pack8(*(const f32x4*)p, *(const f32x4*)(p + 4)); }
    else { return *reinterpret_cast<const bf16x8*>(p); }
}
__device__ __forceinline__ void mask_tile(f32x16& p0, f32x16& p1, int dq, unsigned W) {
    const float NEG = -__builtin_inff();
#pragma unroll
    for (int r = 0; r < 16; ++r) {
        const int c = (r & 3) + 8 * (r >> 2);
        if ((unsigned)(dq - c) >= W) p0[r] = NEG;
        if ((unsigned)(dq - c - 32) >= W) p1[r] = NEG;
    }
}
__device__ __forceinline__ void partialSM(f32x16& p0, f32x16& p1, float& m_reg, float& mn, float& alpha) {
    float pmax = p0[0]; for (int r = 1; r < 16; ++r) pmax = fmaxf(pmax, p0[r]); for (int r = 0; r < 16; ++r) pmax = fmaxf(pmax, p1[r]);
    { auto rr = __builtin_amdgcn_permlane32_swap(__float_as_uint(pmax), __float_as_uint(pmax), false, false);
      pmax = fmaxf(__uint_as_float(rr[0]), __uint_as_float(rr[1])); }
    constexpr float C2 = 1.4426950408889634f * SCALE;
    if (__builtin_expect(__all((pmax - m_reg) * SCALE <= THR), 1)) { mn = m_reg; alpha = 1.f; }
    else { mn = fmaxf(m_reg, pmax); alpha = __builtin_amdgcn_exp2f((m_reg - mn) * C2); m_reg = mn; }
    const float mnL = -mn * C2;
    for (int r = 0; r < 16; ++r) p0[r] = fmaf(p0[r], C2, mnL); for (int r = 0; r < 16; ++r) p1[r] = fmaf(p1[r], C2, mnL);
    for (int r = 0; r < 16; ++r) p0[r] = __builtin_amdgcn_exp2f(p0[r]);
}
__device__ __forceinline__ void finishSM(f32x16& p0, f32x16& p1, float alpha, float& l_reg, bf16x8& pa0, bf16x8& pa1, bf16x8& pa2, bf16x8& pa3) {
    for (int r = 0; r < 16; ++r) p1[r] = __builtin_amdgcn_exp2f(p1[r]);
    float ps = 0; for (int r = 0; r < 16; ++r) ps += p0[r]; for (int r = 0; r < 16; ++r) ps += p1[r];
    { auto rr = __builtin_amdgcn_permlane32_swap(__float_as_uint(ps), __float_as_uint(ps), false, false);
      ps = __uint_as_float(rr[0]) + __uint_as_float(rr[1]); }
    l_reg = l_reg * alpha + ps;
#define PK4(P, B_, OUT) do { unsigned a0 = cvtpk(P[B_+0], P[B_+1]), a1 = cvtpk(P[B_+2], P[B_+3]);                          \
        unsigned b0 = cvtpk(P[B_+4], P[B_+5]), b1 = cvtpk(P[B_+6], P[B_+7]);                                             \
        auto r0 = __builtin_amdgcn_permlane32_swap(a0, b0, false, false); auto r1 = __builtin_amdgcn_permlane32_swap(a1, b1, false, false); \
        u32x4 w = {r0[0], r1[0], r0[1], r1[1]}; OUT = *reinterpret_cast<bf16x8*>(&w); } while (0)
    PK4(p0, 0, pa0); PK4(p0, 8, pa1); PK4(p1, 0, pa2); PK4(p1, 8, pa3);
#undef PK4
}
template <int KB, bool SK>
__device__ __forceinline__ void qkt(f32x16& p0, f32x16& p1, const char* K_lds, int r32, int hi, const bf16x8* qr, bool act) {
    if (SK && !act) { const float NEG = -__builtin_inff();
#pragma unroll
        for (int r = 0; r < 16; ++r) { p0[r] = NEG; p1[r] = NEG; } return; }
    p0 = f32x16{}; p1 = f32x16{};
    const char* kb[4];
#pragma unroll
    for (int dd = 0; dd < 4; ++dd) kb[dd] = K_lds + KB * SHM_K + KSWZ(r32, (dd * 16 + hi * 8) * 2);
#pragma unroll
    for (int d0 = 0; d0 < 8; ++d0) { const char* a = kb[d0 & 3] + (d0 >> 2) * 128;
        bf16x8 b0 = *reinterpret_cast<const bf16x8*>(a);
        bf16x8 b1 = *reinterpret_cast<const bf16x8*>(a + 32 * 256);
        p0 = __builtin_amdgcn_mfma_f32_32x32x16_bf16(b0, qr[d0], p0, 0, 0, 0);
        p1 = __builtin_amdgcn_mfma_f32_32x32x16_bf16(b1, qr[d0], p1, 0, 0, 0); }
}
template <int VB, bool SK>
__device__ __forceinline__ void pv_tile(f32x16* o, int vb0, bf16x8 pa0, bf16x8 pa1, bf16x8 pa2, bf16x8 pa3, bool act) {
    if (SK && !act) return;
#define TRRD(dst, off) asm volatile("ds_read_b64_tr_b16 %0, %1 offset:%2" : "=&v"(dst) : "v"(vb0), "i"(off) : "memory")
#define PV_D0(d0) do { s16x4 l0, l1, l2, l3, h0, h1, h2, h3; constexpr int b_ = VB * SHM_V + v_rd_off(d0, 0, 0);     \
        TRRD(l0, b_); TRRD(h0, b_ + 2048); TRRD(l1, b_ + 4096); TRRD(h1, b_ + 6144); TRRD(l2, b_ + 8192); TRRD(h2, b_ + 10240); TRRD(l3, b_ + 12288); TRRD(h3, b_ + 14336); \
        asm volatile("s_waitcnt lgkmcnt(0)" ::: "memory"); SBAR();                 \
        o[d0] = __builtin_amdgcn_mfma_f32_32x32x16_bf16(pa0, (bf16x8){l0[0], l0[1], l0[2], l0[3], h0[0], h0[1], h0[2], h0[3]}, o[d0], 0, 0, 0);   \
        o[d0] = __builtin_amdgcn_mfma_f32_32x32x16_bf16(pa1, (bf16x8){l1[0], l1[1], l1[2], l1[3], h1[0], h1[1], h1[2], h1[3]}, o[d0], 0, 0, 0);   \
        o[d0] = __builtin_amdgcn_mfma_f32_32x32x16_bf16(pa2, (bf16x8){l2[0], l2[1], l2[2], l2[3], h2[0], h2[1], h2[2], h2[3]}, o[d0], 0, 0, 0);   \
        o[d0] = __builtin_amdgcn_mfma_f32_32x32x16_bf16(pa3, (bf16x8){l3[0], l3[1], l3[2], l3[3], h3[0], h3[1], h3[2], h3[3]}, o[d0], 0, 0, 0); } while (0)
    PV_D0(0); PV_D0(1); PV_D0(2); PV_D0(3);
#undef PV_D0
#undef TRRD
}

template <class TIn, class TOut> struct BlockRef { const TIn* Q; const TIn* K; const TIn* V; TOut* O; const float* KM; int P0; int t_lo, t_hi; TOut* OP; float* LSE; };
template <class TIn> struct Seam {
    bf16x8 qr[8];
    bf16x8 st_v0, st_v1, st_k0, st_k1; f32x4 sf0, sf1, sf2, sf3;
    f32x4 tq[16];
};
__device__ __forceinline__ int swa_jlo(int P0, int W) { const int lowk = P0 - W + 1; return lowk > 0 ? lowk / KVBLK : 0; }
#define ROW(p, k0, rr) ((p) + (size_t)((k0) + (rr)) * PITCH + sc)
#define VMW() asm volatile("s_waitcnt vmcnt(0)" ::: "memory")
#define VMWN(n) asm volatile("s_waitcnt vmcnt(%0)" :: "i"(n) : "memory")
#define LD16U(base, boff) (*(const GAS bf16x8*)(uni((const char*)(base) + (size_t)(boff)) + voff))
#define SLOAD_H(Kp, Vp, k0) do { S.st_v0 = LD16U(Vp, (size_t)(k0) * (PITCH * 2)); S.st_v1 = LD16U(Vp, (size_t)((k0) + 32) * (PITCH * 2));              \
                         S.st_k0 = LD16U(Kp, (size_t)(k0) * (PITCH * 2)); S.st_k1 = LD16U(Kp, (size_t)((k0) + 32) * (PITCH * 2)); } while (0)
#define SWRITE_HK(bf) do { *(bf16x8*)(K_lds + (bf) * SHM_K + kws) = S.st_k0; *(bf16x8*)(K_lds + (bf) * SHM_K + kws + 32 * 256) = S.st_k1; } while (0)
#define SWRITE_HV(bf) do { *(bf16x8*)(V_lds + (bf) * SHM_V + vst0) = S.st_v0; *(bf16x8*)(V_lds + (bf) * SHM_V + vst1) = S.st_v1; } while (0)
#define SWRITE_H(bf) do { SWRITE_HV(bf); SWRITE_HK(bf); } while (0)
#define SLOAD_F(p, k0) do { S.sf0 = *(const f32x4*)ROW(p, k0, sr); S.sf1 = *(const f32x4*)(ROW(p, k0, sr) + 4);                \
                            S.sf2 = *(const f32x4*)ROW(p, k0, 32 + sr); S.sf3 = *(const f32x4*)(ROW(p, k0, 32 + sr) + 4); } while (0)
#define SWRITE_KF(bf) do { *(bf16x8*)(K_lds + (bf) * SHM_K + kws) = pack8(S.sf0, S.sf1); *(bf16x8*)(K_lds + (bf) * SHM_K + kws + 32 * 256) = pack8(S.sf2, S.sf3); } while (0)
#define SWRITE_VF(bf) do { *(bf16x8*)(V_lds + (bf) * SHM_V + vst0) = pack8(S.sf0, S.sf1); *(bf16x8*)(V_lds + (bf) * SHM_V + vst1) = pack8(S.sf2, S.sf3); } while (0)
template <class TIn, class TOut>
__device__ __forceinline__ void causal_swa_prime(const BlockRef<TIn, TOut>& cur, int W, char* lds, Seam<TIn>& S) {
    constexpr bool F32 = same_t<TIn, float>::v;
    int tid = threadIdx.x; asm volatile("" : "+v"(tid));
    const int wid = __builtin_amdgcn_readfirstlane(tid >> 6), lane = tid & 63, r32 = lane & 31, hi = lane >> 5;
    const int sr = tid >> 4, sc = (tid & 15) * 8, kws = KSWZ(sr, sc * 2); char* K_lds = lds + 2 * SHM_V;
    const unsigned voff = (unsigned)(sr * PITCH + sc) * 2u, qoff = (unsigned)((wid * QBLK + r32) * PITCH + hi * 8) * 2u;
    const int kb0 = cur.t_lo * KVBLK;
    for (int d0 = 0; d0 < 8; ++d0) S.qr[d0] = *(const GAS bf16x8*)(uni((const char*)cur.Q + d0 * 32) + qoff);
    if constexpr (F32) { SLOAD_F((const float*)cur.K, kb0); VMW(); SWRITE_KF(0); SBAR(); SLOAD_F((const float*)cur.V, kb0); }
    else { SLOAD_H(cur.K, cur.V, kb0); VMW(); SWRITE_HK(0); }
    __syncthreads();
}
template <class TIn, class TOut>
__device__ __forceinline__ void causal_swa_block(const BlockRef<TIn, TOut>& cur, const BlockRef<TIn, TOut>& nxt, int skv, int W, char* lds, Seam<TIn>& S) {
    constexpr bool F32 = same_t<TIn, float>::v;
    int tid = threadIdx.x; asm volatile("" : "+v"(tid));
    const int wid = __builtin_amdgcn_readfirstlane(tid >> 6), lane = tid & 63, r32 = lane & 31, hi = lane >> 5;
    const int j_lo = cur.t_lo, j_hi = cur.t_hi;
    const int NT = j_hi - j_lo;
    const int kbn = nxt.t_lo * KVBLK;
    const int qlo = cur.P0 + wid * QBLK, qm = qlo + r32 - 4 * hi;
    char* V_lds = lds; char* K_lds = lds + 2 * SHM_V;
    float* ws = (float*)(lds + 2 * SHM_V + 2 * SHM_K) + wid * 64; float* li_l = ws, * al_l = ws + 32;
    float m_reg = -1e30f, l_reg = 0; f32x16 o[4] = {};
    const int sr = tid >> 4, sc = (tid & 15) * 8, vst0 = v_st(sr, sc), vst1 = v_st(32 + sr, sc), kws = KSWZ(sr, sc * 2);
    const unsigned voff = (unsigned)(sr * PITCH + sc) * 2u, qoff = (unsigned)((wid * QBLK + r32) * PITCH + hi * 8) * 2u;
    const int vb0 = (int)(uintptr_t)V_lds + v_rd_base(lane);
    const TIn* Kh = cur.K; const TIn* Vh = cur.V;
    const int own = cur.P0 / QB, own4 = cur.P0 / KVBLK;
    unsigned sel = 0u;
    {
        float* km = (float*)(lds + KM_OFF);
#ifdef ROPE_EPI
        for (int i = tid; i < 16 * 128; i += 64 * NW) km[i] = *(const GAS float*)(uni(cur.KM) + (unsigned)(i * 4));
#else
        for (int i = tid; i < 16 * 128; i += 64 * NW) { const GAS float* p = (const GAS float*)(uni(cur.KM) + (unsigned)(((i >> 7) * 512 + (i & 127)) * 4)); km[i] = (p[0] + p[128]) + (p[256] + p[384]); }
#endif
        __syncthreads();
        float best[3] = {-3e38f, -3e38f, -3e38f}; int bidx[3] = {0, 0, 0};
#pragma unroll 1
        for (int j = 0; j < own; ++j) {
            float a = 0.f;
#pragma unroll
            for (int d0 = 0; d0 < 8; ++d0) {
                const f32x4 k0 = *(const f32x4*)(km + j * 128 + d0 * 16 + hi * 8), k1 = *(const f32x4*)(km + j * 128 + d0 * 16 + hi * 8 + 4);
                const u32x4 qw = *reinterpret_cast<const u32x4*>(&S.qr[d0]);
                a += __uint_as_float(qw[0] << 16) * k0[0] + __uint_as_float(qw[0] & 0xffff0000u) * k0[1] + __uint_as_float(qw[1] << 16) * k0[2] + __uint_as_float(qw[1] & 0xffff0000u) * k0[3]
                   + __uint_as_float(qw[2] << 16) * k1[0] + __uint_as_float(qw[2] & 0xffff0000u) * k1[1] + __uint_as_float(qw[3] << 16) * k1[2] + __uint_as_float(qw[3] & 0xffff0000u) * k1[3];
            }
            a += __shfl_xor(a, 32);
            if (a > best[0]) { best[2] = best[1]; bidx[2] = bidx[1]; best[1] = best[0]; bidx[1] = bidx[0]; best[0] = a; bidx[0] = j; }
            else if (a > best[1]) { best[2] = best[1]; bidx[2] = bidx[1]; best[1] = a; bidx[1] = j; }
            else if (a > best[2]) { best[2] = a; bidx[2] = j; }
        }
#pragma unroll
        for (int r = 0; r < 3; ++r) if (best[r] > -1e37f) sel |= 1u << bidx[r];
    }
#define RESC(a) do { if (__any((a) < 1.f)) { if (hi == 0) al_l[r32] = (a); asm volatile("s_waitcnt lgkmcnt(0)" ::: "memory");              \
                     for (int d_ = 0; d_ < 4; ++d_) for (int r = 0; r < 16; ++r) o[d_][r] *= al_l[crow(r, hi)]; } } while (0)
#define KBASE(t) ((j_lo + (t)) * KVBLK)
#define ACT(t) (KBASE(t) <= qlo + QBLK - 1 && KBASE(t) + KVBLK - 1 >= qlo - W + 1)
#define MASKT(P0_, P1_, t) do { const int kb_ = KBASE(t), gt_ = j_lo + (t); if (gt_ >= own4) { if (kb_ + KVBLK - 1 > qlo) mask_tile(P0_, P1_, qm - kb_, 0x3fffffffu); } else if (!((sel >> (gt_ >> 2)) & 1u)) { const float NEG_ = -__builtin_inff(); _Pragma("unroll") for (int r_ = 0; r_ < 16; ++r_) { P0_[r_] = NEG_; P1_[r_] = NEG_; } } } while (0)
    constexpr int NQL = F32 ? 16 : 8;
    constexpr bool SK = WSKIP && !F32;
#define SEAM_K0() do { VMWN(NQL); if constexpr (F32) { SWRITE_KF(0); SBAR(); SLOAD_F((const float*)nxt.V, kbn); } else { SWRITE_HK(0); } SBAR(); } while (0)
    f32x16 pA0, pA1, pB0, pB1; float mnA, mnB, alA, alB; bf16x8 pa0, pa1, pa2, pa3;
    if constexpr (F32) { VMW(); SWRITE_VF(0); SBAR(); } else { SWRITE_HV(0); SBAR(); }
    if (NT > 1) { if constexpr (F32) SLOAD_F((const float*)Kh, KBASE(1)); else SLOAD_H(Kh, Vh, KBASE(1)); }
    SBAR(); qkt<0, SK>(pA0, pA1, K_lds, r32, hi, S.qr, ACT(0));
    if constexpr (F32) { if (NT > 1) { VMW(); SWRITE_KF(1); SBAR(); SLOAD_F((const float*)Vh, KBASE(1)); } }
    MASKT(pA0, pA1, 0); partialSM(pA0, pA1, m_reg, mnA, alA);
    if (NT > 1) { VMW(); if constexpr (F32) { SWRITE_VF(1); SBAR(); if (NT > 2) SLOAD_F((const float*)Kh, KBASE(2)); } else SWRITE_H(1); }
    __syncthreads();
#define HALF_STEP(PX0, PX1, mnX, alX, PY0, PY1, alY, t, KB, VB, SB) do {                                                      \
        SBAR(); qkt<KB, SK>(PX0, PX1, K_lds, r32, hi, S.qr, ACT(t));                                             \
        finishSM(PY0, PY1, alY, l_reg, pa0, pa1, pa2, pa3); SBAR();                                                           \
        if ((t) + 1 < NT) { if constexpr (F32) { VMW(); SWRITE_KF(SB); SBAR(); SLOAD_F((const float*)Vh, KBASE((t) + 1)); }  \
                            else { SLOAD_H(Kh, Vh, KBASE((t) + 1)); } SBAR(); }                                               \
        pv_tile<VB, SK>(o, vb0, pa0, pa1, pa2, pa3, ACT((t) - 1)); MASKT(PX0, PX1, (t)); partialSM(PX0, PX1, m_reg, mnX, alX);                                        \
        __syncthreads();                                                                                                      \
        if ((t) + 1 < NT) { VMW(); if constexpr (F32) { SWRITE_VF(SB); SBAR(); if ((t) + 2 < NT) SLOAD_F((const float*)Kh, KBASE((t) + 2)); } \
                            else { SWRITE_H(SB); } }                                                                          \
        RESC(alX); __syncthreads(); } while (0)
    for (int t = 1; t + 1 < NT; t += 2) {
        HALF_STEP(pB0, pB1, mnB, alB, pA0, pA1, alA, t, 1, 0, 0);
        HALF_STEP(pA0, pA1, mnA, alA, pB0, pB1, alB, t + 1, 0, 1, 1);
    }
    const bool even = (NT & 1) == 0;
    if (even) { SBAR(); qkt<1, SK>(pB0, pB1, K_lds, r32, hi, S.qr, ACT(NT - 1)); SBAR(); }
#define QROW(e) (nxt.Q + (size_t)(wid * QBLK + r32) * PITCH + ((e) >> 1) * 16 + hi * 8 + ((e) & 1) * 4)
    if constexpr (F32) { SLOAD_F((const float*)nxt.K, kbn); SBAR();
#pragma unroll
        for (int e = 0; e < 8; ++e) S.tq[e] = *(const f32x4*)QROW(e); }
    else { SLOAD_H(nxt.K, nxt.V, kbn); SBAR();
#pragma unroll
        for (int d0 = 0; d0 < 8; ++d0) S.qr[d0] = *(const GAS bf16x8*)(uni((const char*)nxt.Q + d0 * 32) + qoff); }
    SBAR();
    finishSM(pA0, pA1, alA, l_reg, pa0, pa1, pa2, pa3); SBAR();
    if constexpr (F32) {
#pragma unroll
        for (int e = 8; e < 16; ++e) S.tq[e] = *(const f32x4*)QROW(e); SBAR(); }
#undef QROW
    pv_tile<0, SK>(o, vb0, pa0, pa1, pa2, pa3, ACT(even ? NT - 2 : NT - 1));
    if (even) { MASKT(pB0, pB1, NT - 1); partialSM(pB0, pB1, m_reg, mnB, alB); __syncthreads(); RESC(alB);
        finishSM(pB0, pB1, alB, l_reg, pa0, pa1, pa2, pa3); SBAR(); pv_tile<1, SK>(o, vb0, pa0, pa1, pa2, pa3, ACT(NT - 1)); }
    SBAR(); SEAM_K0();
    if (hi == 0) li_l[r32] = l_reg; asm volatile("s_waitcnt lgkmcnt(0)" ::: "memory");
    float rli[16];
#pragma unroll
    for (int r = 0; r < 16; ++r) { const float li_ = li_l[crow(r, hi)]; rli[r] = li_ > 0.f ? __builtin_amdgcn_rcpf(li_) : 0.f; }
    if (cur.OP) {
        if (hi == 0) cur.LSE[wid * QBLK + r32] = l_reg > 0.f ? m_reg * (1.4426950408889634f * SCALE) + __builtin_amdgcn_logf(l_reg) : -__builtin_inff();
        GAS char* Ow = (GAS char*)uni(cur.OP + (size_t)(wid * QBLK) * 128);
        unsigned obase = (unsigned)((4 * hi * 128 + r32) * 2); asm volatile("" : "+v"(obase));
#pragma unroll
        for (int r = 0; r < 16; ++r) {
#pragma unroll
            for (int d0 = 0; d0 < 4; ++d0) { const float v = o[d0][r] * rli[r];
                const float vn = __shfl_xor(v, 1);
                if ((r32 & 1) == 0) *(GAS unsigned*)(Ow + (obase + (unsigned)((((r & 3) + 8 * (r >> 2)) * 128 + d0 * 32) * 2))) = cvtpk(v, vn); } }
    } else {
        GAS char* Ow = (GAS char*)uni(cur.O + (size_t)(wid * QBLK) * OPITCH);
        unsigned obase = (unsigned)((4 * hi * OPITCH + r32) * 2); asm volatile("" : "+v"(obase));
#pragma unroll
        for (int r = 0; r < 16; ++r) {
#pragma unroll
            for (int d0 = 0; d0 < 4; ++d0) { const float v = o[d0][r] * rli[r];
                const float vn = __shfl_xor(v, 1);
                if ((r32 & 1) == 0) *(GAS unsigned*)(Ow + (obase + (unsigned)((((r & 3) + 8 * (r >> 2)) * OPITCH + d0 * 32) * 2))) = cvtpk(v, vn); } }
    }
    if constexpr (F32) {
#pragma unroll
        for (int d0 = 0; d0 < 8; ++d0) S.qr[d0] = pack8(S.tq[2 * d0], S.tq[2 * d0 + 1]); }
    __syncthreads();
#undef RESC
#undef KBASE
#undef ACT
#undef MASKT
#undef SEAM_K0
#undef HALF_STEP
}
#undef ROW
#undef VMW
#undef VMWN
#undef SLOAD_H
#undef LD16U
#undef SWRITE_HK
#undef SWRITE_HV
#undef SWRITE_H
#undef SLOAD_F
#undef SWRITE_KF
#undef SWRITE_VF
}
namespace dn {
typedef short bf16x8 __attribute__((ext_vector_type(8)));
typedef float f32x16 __attribute__((ext_vector_type(16)));
typedef float f32x4 __attribute__((ext_vector_type(4)));
typedef unsigned u32x4 __attribute__((ext_vector_type(4)));
typedef unsigned u32x2 __attribute__((ext_vector_type(2)));
#define DNI __device__ __forceinline__
#define DN_MFMA(a, b, c) __builtin_amdgcn_mfma_f32_32x32x16_bf16((a), (b), (c), 0, 0, 0)
constexpr int LQ = 136, LT = 72;
constexpr int BLOB_FRAGS = 56, BLOB_BYTES = BLOB_FRAGS * 1024, UF_BYTES = 16384;
constexpr int L_QS = 0, L_KS = 17408, L_KST = 34816, L_VST = 53248, L_AF = 71680, L_ABF = 89088, L_TRM = 98304, L_TW = 107520, L_TU = 116736,
              L_T00T = 125952, L_GATE = 128512, L_CONVW = 129536, L_END = 135680;
DNI int crow(int i, int h) { return (i & 3) + 8 * (i >> 2) + 4 * h; }
DNI unsigned cvtpk2(float lo, float hi) {
    typedef float f2_t __attribute__((ext_vector_type(2))); typedef __bf16 b2_t __attribute__((ext_vector_type(2)));
    f2_t v = {lo, hi}; b2_t b = __builtin_convertvector(v, b2_t); return __builtin_bit_cast(unsigned, b);
}
template <int SS> DNI bf16x8 pack_acc(const f32x16& x) {
    u32x4 p = {cvtpk2(x[8 * SS], x[8 * SS + 1]), cvtpk2(x[8 * SS + 2], x[8 * SS + 3]), cvtpk2(x[8 * SS + 4], x[8 * SS + 5]), cvtpk2(x[8 * SS + 6], x[8 * SS + 7])};
    return __builtin_bit_cast(bf16x8, p);
}
DNI bf16x8 lds16(const LAS unsigned char* p) { return *(const LAS bf16x8*)p; }
DNI bf16x8 lds_perm8(const LAS unsigned char* rowp, int colbase, int h) {
    const u32x2 a = *(const LAS u32x2*)(rowp + (colbase + 4 * h) * 2), b = *(const LAS u32x2*)(rowp + (colbase + 8 + 4 * h) * 2);
    u32x4 p = {a.x, a.y, b.x, b.y}; return __builtin_bit_cast(bf16x8, p);
}
DNI float bflo_(unsigned w) { return __uint_as_float(w << 16); }
DNI float bfhi_(unsigned w) { return __uint_as_float(w & 0xffff0000u); }

struct RawQKV { u32x4 w[3][4][2]; };
DNI void chunk_load(RawQKV& R, int item, const bf16* PJ, size_t pj_stride) {
    const int tid = threadIdx.x, row = tid >> 3, c0 = (tid & 7) * 16;
    const int n = item & 63, hd = (item >> 6) & 3, b = item >> 8, t = n * 64 + row;
    const size_t row0 = (size_t)b * 4096 + (size_t)n * 64;
#pragma unroll
    for (int X = 0; X < 3; ++X)
#pragma unroll
        for (int j = 0; j < 4; ++j) {
            if (t - 3 + j >= 0) { const bf16* src = PJ + (size_t)X * pj_stride + (row0 + row - 3 + j) * 512 + hd * 128 + c0; R.w[X][j][0] = *(const u32x4*)src; R.w[X][j][1] = *(const u32x4*)(src + 8); }
            else { R.w[X][j][0] = u32x4{}; R.w[X][j][1] = u32x4{}; }
        }
}
DNI void chunk_local(LAS unsigned char* lds, int item, RawQKV& RAW, int next_item, const bf16* PJ, size_t pj_stride, const float* GATES, const float* conv_w, const float* a_log, const float* dt_bias,
                     unsigned char* BLOB, unsigned char* UF, float* GL) {
    int tid = threadIdx.x; asm volatile("" : "+v"(tid));
    const int wid = __builtin_amdgcn_readfirstlane(tid >> 6), lane = tid & 63, r = lane & 31, h2 = lane >> 5;
    const int n = item & 63, hd = (item >> 6) & 3, b = item >> 8;
    const size_t row0 = (size_t)b * 4096 + (size_t)n * 64;
    LAS float* gate = (LAS float*)(lds + L_GATE);
    LAS float* convw = (LAS float*)(lds + L_CONVW);
    unsigned char* blob = BLOB + (size_t)item * BLOB_BYTES;
    for (int i = tid; i < 4 * 384; i += 512) { const int j = i / 384, c = i % 384; convw[i] = conv_w[j * 1536 + (c >> 7) * 512 + hd * 128 + (c & 127)]; }
    if (wid == 0) {
        const size_t m = row0 + lane;
        const float braw = GATES[m * 8 + hd], araw = GATES[m * 8 + 4 + hd];
        const float beta = 1.f / (1.f + __expf(-braw));
        const float sp = fmaxf(araw + dt_bias[hd], 0.f) + log1pf(__expf(-fabsf(araw + dt_bias[hd])));
        float g = -__expf(a_log[hd]) * sp;
#pragma unroll
        for (int d = 1; d < 64; d <<= 1) { const float t = __shfl_up(g, d); if (lane >= d) g += t; }
        const float glast = __shfl(g, 63);
        gate[lane] = beta; gate[64 + lane] = g; gate[128 + lane] = __expf(g); gate[192 + lane] = __expf(glast - g);
        if (lane == 63) GL[item] = __expf(glast);
    }
    __syncthreads();
    {
        const int row = tid >> 3, seg = tid & 7, c0 = seg * 16;
        float val[3][16];
#pragma unroll
        for (int X = 0; X < 3; ++X) {
#pragma unroll
            for (int e = 0; e < 16; ++e) val[X][e] = 0.f;
#pragma unroll
            for (int j = 0; j < 4; ++j) {
                {
                    const u32x4 w0 = RAW.w[X][j][0], w1 = RAW.w[X][j][1];
                    const LAS float* cw = convw + j * 384 + X * 128 + c0;
#pragma unroll
                    for (int e = 0; e < 4; ++e) { val[X][2 * e] += cw[2 * e] * bflo_(w0[e]); val[X][2 * e + 1] += cw[2 * e + 1] * bfhi_(w0[e]);
                                                  val[X][8 + 2 * e] += cw[8 + 2 * e] * bflo_(w1[e]); val[X][8 + 2 * e + 1] += cw[8 + 2 * e + 1] * bfhi_(w1[e]); }
                }
            }
#pragma unroll
            for (int e = 0; e < 16; ++e) val[X][e] = val[X][e] / (1.f + __expf(-val[X][e]));
        }
        float sq = 0.f, sk = 0.f;
#pragma unroll
        for (int e = 0; e < 16; ++e) { sq += val[0][e] * val[0][e]; sk += val[1][e] * val[1][e]; }
        sq += __shfl_xor(sq, 1); sq += __shfl_xor(sq, 2); sq += __shfl_xor(sq, 4);
        sk += __shfl_xor(sk, 1); sk += __shfl_xor(sk, 2); sk += __shfl_xor(sk, 4);
        const float rq = rsqrtf(sq + 1e-6f) * 0.08838834764831845f, rk = rsqrtf(sk + 1e-6f);
        u32x4 qa, qb, ka, kb;
#pragma unroll
        for (int e = 0; e < 4; ++e) { qa[e] = cvtpk2(val[0][2 * e] * rq, val[0][2 * e + 1] * rq); qb[e] = cvtpk2(val[0][8 + 2 * e] * rq, val[0][8 + 2 * e + 1] * rq);
                                      ka[e] = cvtpk2(val[1][2 * e] * rk, val[1][2 * e + 1] * rk); kb[e] = cvtpk2(val[1][8 + 2 * e] * rk, val[1][8 + 2 * e + 1] * rk); }
        *(LAS u32x4*)(lds + L_QS + (row * LQ + c0) * 2) = qa; *(LAS u32x4*)(lds + L_QS + (row * LQ + c0 + 8) * 2) = qb;
        *(LAS u32x4*)(lds + L_KS + (row * LQ + c0) * 2) = ka; *(LAS u32x4*)(lds + L_KS + (row * LQ + c0 + 8) * 2) = kb;
#pragma unroll
        for (int e = 0; e < 16; ++e) {
            const unsigned kw = (e < 8) ? ka[e >> 1] : kb[(e - 8) >> 1];
            *(LAS unsigned short*)(lds + L_KST + ((c0 + e) * LT + row) * 2) = (unsigned short)((e & 1) ? (kw >> 16) : (kw & 0xffffu));
            *(LAS unsigned short*)(lds + L_VST + ((c0 + e) * LT + row) * 2) = (unsigned short)(cvtpk2(val[2][e], 0.f) & 0xffffu);
        }
    }
    if (next_item >= 0) chunk_load(RAW, next_item, PJ, pj_stride);
    __syncthreads();
    {
        const int p = wid >> 2, ri = (wid >> 1) & 1, ci = wid & 1;
        const LAS unsigned char* Ap = lds + L_KS + ((32 * ri + r) * LQ + 8 * h2) * 2;
        const LAS unsigned char* Bp = lds + (p == 0 ? L_KS : L_QS) + ((32 * ci + r) * LQ + 8 * h2) * 2;
        f32x16 acc = {};
        const bool live = (p == 0) ? (ri >= ci) : (ri <= ci);
        if (live) {
#pragma unroll
            for (int ks = 0; ks < 8; ++ks) acc = DN_MFMA(lds16(Ap + ks * 32), lds16(Bp + ks * 32), acc);
        }
        const int colg = 32 * ci + r;
        const float gcol = gate[64 + colg];
        if (p == 0) {
#pragma unroll
            for (int i = 0; i < 16; ++i) {
                const int c = 32 * ri + crow(i, h2);
                const float a = (c > colg) ? gate[c] * acc[i] * __expf(gate[64 + c] - gcol) : 0.f;
                *(LAS float*)(lds + L_AF + (c * 68 + colg) * 4) = a;
                *(LAS unsigned short*)(lds + L_ABF + (c * LT + colg) * 2) = (unsigned short)(cvtpk2(a, 0.f) & 0xffffu);
            }
        } else {
            f32x16 x;
#pragma unroll
            for (int i = 0; i < 16; ++i) { const int s = 32 * ri + crow(i, h2); x[i] = (colg >= s) ? acc[i] * __expf(gcol - gate[64 + s]) : 0.f; }
            *(u32x4*)(blob + (32 + ci * 4 + 2 * ri + 0) * 1024 + lane * 16) = __builtin_bit_cast(u32x4, pack_acc<0>(x));
            *(u32x4*)(blob + (32 + ci * 4 + 2 * ri + 1) * 1024 + lane * 16) = __builtin_bit_cast(u32x4, pack_acc<1>(x));
        }
    }
    __syncthreads();
    if (wid == 0) {
        const int blk = h2, j = r, jg = 32 * blk + j;
        float x[32];
#pragma unroll
        for (int c = 0; c < 32; ++c) {
            float a0 = (c == j) ? 1.f : 0.f, a1 = 0.f, a2 = 0.f, a3 = 0.f;
            const LAS float* arow = (const LAS float*)(lds + L_AF) + (32 * blk + c) * 68 + 32 * blk;
#pragma unroll
            for (int s = 0; s < c; ++s) { const float t_ = arow[s] * x[s]; if ((s & 3) == 0) a0 -= t_; else if ((s & 3) == 1) a1 -= t_; else if ((s & 3) == 2) a2 -= t_; else a3 -= t_; }
            x[c] = (a0 + a1) + (a2 + a3);
        }
        const float sw = gate[jg] * gate[128 + jg], su = gate[jg];
#pragma unroll
        for (int c = 0; c < 32; ++c) {
            const int off = ((32 * blk + c) * LT + jg) * 2;
            *(LAS unsigned short*)(lds + L_TRM + off) = (unsigned short)(cvtpk2(x[c], 0.f) & 0xffffu);
            *(LAS unsigned short*)(lds + L_TW + off) = (unsigned short)(cvtpk2(x[c] * sw, 0.f) & 0xffffu);
            *(LAS unsigned short*)(lds + L_TU + off) = (unsigned short)(cvtpk2(x[c] * su, 0.f) & 0xffffu);
        }
        if (blk == 0) {
#pragma unroll
            for (int c4 = 0; c4 < 4; ++c4) { u32x4 w = {cvtpk2(x[8 * c4], x[8 * c4 + 1]), cvtpk2(x[8 * c4 + 2], x[8 * c4 + 3]), cvtpk2(x[8 * c4 + 4], x[8 * c4 + 5]), cvtpk2(x[8 * c4 + 6], x[8 * c4 + 7])};
                *(LAS u32x4*)(lds + L_T00T + (j * 40 + 8 * c4) * 2) = w; }
        }
        asm volatile("s_waitcnt lgkmcnt(0)" ::: "memory");
        f32x16 m1 = {};
#pragma unroll
        for (int ks = 0; ks < 2; ++ks) m1 = DN_MFMA(lds16(lds + L_ABF + ((32 + r) * LT + 16 * ks + 8 * h2) * 2), lds16(lds + L_T00T + (r * 40 + 16 * ks + 8 * h2) * 2), m1);
        f32x16 t10 = {};
        t10 = DN_MFMA(lds_perm8(lds + L_TRM + ((32 + r) * LT) * 2, 32 + 0, h2), pack_acc<0>(m1), t10);
        t10 = DN_MFMA(lds_perm8(lds + L_TRM + ((32 + r) * LT) * 2, 32 + 16, h2), pack_acc<1>(m1), t10);
        const float sw0 = gate[r] * gate[128 + r], su0 = gate[r];
#pragma unroll
        for (int i = 0; i < 16; ++i) {
            const int off = ((32 + crow(i, h2)) * LT + r) * 2; const float tv = -t10[i];
            *(LAS unsigned short*)(lds + L_TW + off) = (unsigned short)(cvtpk2(tv * sw0, 0.f) & 0xffffu);
            *(LAS unsigned short*)(lds + L_TU + off) = (unsigned short)(cvtpk2(tv * su0, 0.f) & 0xffffu);
        }
    } else {
        for (int f = wid - 1; f < 32; f += 7) {
            bf16x8 v; float sc[8];
            if (f < 16) {
                const int mt = f >> 3, s = f & 7, row = 32 * mt + r;
                v = lds_perm8(lds + L_QS + (row * LQ) * 2, 32 * (s >> 1) + 16 * (s & 1), h2);
                const float e = gate[128 + row];
#pragma unroll
                for (int jj = 0; jj < 8; ++jj) sc[jj] = e;
            } else {
                const int kt = (f - 16) >> 2, s2 = (f - 16) & 3, row = 32 * kt + r, cb = 32 * (s2 >> 1) + 16 * (s2 & 1);
                v = lds_perm8(lds + L_KST + (row * LT) * 2, cb, h2);
#pragma unroll
                for (int jj = 0; jj < 8; ++jj) sc[jj] = gate[192 + cb + 8 * (jj >> 2) + 4 * h2 + (jj & 3)];
            }
            const u32x4 w = __builtin_bit_cast(u32x4, v);
            u32x4 o;
#pragma unroll
            for (int e = 0; e < 4; ++e) o[e] = cvtpk2(bflo_(w[e]) * sc[2 * e], bfhi_(w[e]) * sc[2 * e + 1]);
            *(u32x4*)(blob + (f < 16 ? 16 + f : 40 + (f - 16)) * 1024 + lane * 16) = o;
        }
    }
    __syncthreads();
    {
        const int kt = wid >> 1, mt = wid & 1;
        f32x16 wt = {}, ut = {};
        const int nks = mt == 0 ? 2 : 4;
        for (int ks = 0; ks < nks; ++ks) {
            wt = DN_MFMA(lds16(lds + L_KST + ((32 * kt + r) * LT + 16 * ks + 8 * h2) * 2), lds16(lds + L_TW + ((32 * mt + r) * LT + 16 * ks + 8 * h2) * 2), wt);
            ut = DN_MFMA(lds16(lds + L_TU + ((32 * mt + r) * LT + 16 * ks + 8 * h2) * 2), lds16(lds + L_VST + ((32 * kt + r) * LT + 16 * ks + 8 * h2) * 2), ut);
        }
#pragma unroll
        for (int i = 0; i < 16; ++i) wt[i] = -wt[i];
        *(u32x4*)(blob + (mt * 8 + 2 * kt + 0) * 1024 + lane * 16) = __builtin_bit_cast(u32x4, pack_acc<0>(wt));
        *(u32x4*)(blob + (mt * 8 + 2 * kt + 1) * 1024 + lane * 16) = __builtin_bit_cast(u32x4, pack_acc<1>(wt));
        unsigned char* uf = UF + (size_t)item * UF_BYTES + ((kt * 2 + mt) * 64 + lane) * 32;
        *(u32x4*)uf = __builtin_bit_cast(u32x4, pack_acc<0>(ut)); *(u32x4*)(uf + 16) = __builtin_bit_cast(u32x4, pack_acc<1>(ut));
    }
    __syncthreads();
}

constexpr int S_SLOT = 32768, S_END = 4 * S_SLOT;
DNI void glds16(const void* gsrc, LAS unsigned char* dst) { __builtin_amdgcn_global_load_lds((const GAS unsigned*)gsrc, (LAS unsigned*)dst, 16, 0, 0); }
DNI void scan_bh(LAS unsigned char* lds, int bh, const unsigned char* BLOB, const unsigned char* UF, const float* GL, unsigned char* SF, unsigned char* VF) {
    int tid = threadIdx.x; asm volatile("" : "+v"(tid));
    const int wid = __builtin_amdgcn_readfirstlane(tid >> 6), lane = tid & 63;
    const unsigned char* blob0 = BLOB + (size_t)bh * 64 * BLOB_BYTES;
    unsigned lane16 = (unsigned)lane * 16u; asm volatile("" : "+v"(lane16));
#define DN_B() do { __builtin_amdgcn_s_barrier(); asm volatile("" ::: "memory"); } while (0)
    if (wid >= 4) {
        const int lw = wid - 4;
#define DN_ISSUE(c) do { const unsigned char* bc_ = blob0 + (size_t)(c) * BLOB_BYTES + lw * 1024; LAS unsigned char* sl_ = lds + ((c) & 3) * S_SLOT + lw * 1024; _Pragma("unroll") for (int i_ = 0; i_ < 4; ++i_) { \
        glds16(bc_ + i_ * 4096 + lane16, sl_ + i_ * 4096); glds16(bc_ + 40960 + i_ * 4096 + lane16, sl_ + 16384 + i_ * 4096); } } while (0)
        DN_ISSUE(0); DN_ISSUE(1); DN_ISSUE(2);
        asm volatile("s_waitcnt vmcnt(16)" ::: "memory"); DN_B();
#pragma unroll 1
        for (int c = 0; c < 64; ++c) {
            if (c + 3 < 64) { DN_ISSUE(c + 3); asm volatile("s_waitcnt vmcnt(16)" ::: "memory"); }
            else if (c + 2 < 64) asm volatile("s_waitcnt vmcnt(8)" ::: "memory");
            else asm volatile("s_waitcnt vmcnt(0)" ::: "memory");
            DN_B();
        }
#undef DN_ISSUE
    } else {
        const float glv = GL[bh * 64 + lane];
        const unsigned char* uf0 = UF + (size_t)bh * 64 * UF_BYTES + (wid * 128 + lane) * 32;
        unsigned char* sf0 = SF + ((size_t)(bh * 64) * 4 + wid) * 8192 + lane * 16;
        unsigned char* vf0 = VF + ((size_t)(bh * 64) * 4 + wid) * 4096 + lane * 16;
        f32x16 S0 = {}, S1 = {}, S2 = {}, S3 = {};
        u32x4 ua[4], ub[4];
#define DN_ULOAD(U, c) do { const unsigned char* u_ = uf0 + (size_t)(c) * UF_BYTES; U[0] = *(const u32x4*)u_; U[1] = *(const u32x4*)(u_ + 16); U[2] = *(const u32x4*)(u_ + 2048); U[3] = *(const u32x4*)(u_ + 2048 + 16); } while (0)
        DN_ULOAD(ua, 0); DN_ULOAD(ub, 1);
        DN_B();
#define RD4(X, f0, f1, f2, f3) do { asm volatile("ds_read_b128 %0, %4 offset:%5\n\tds_read_b128 %1, %4 offset:%6\n\tds_read_b128 %2, %4 offset:%7\n\tds_read_b128 %3, %4 offset:%8" \
        : "=&v"(X##0), "=&v"(X##1), "=&v"(X##2), "=&v"(X##3) : "v"(fba), "i"((f0) * 1024), "i"((f1) * 1024), "i"((f2) * 1024), "i"((f3) * 1024)); __builtin_amdgcn_sched_barrier(0); } while (0)
#define PIN2(a, b) asm volatile("" : "+v"(a), "+v"(b))
#define PIN4(a, b, c, d) asm volatile("" : "+v"(a), "+v"(b), "+v"(c), "+v"(d))
#define LWAIT() do { asm volatile("s_waitcnt lgkmcnt(0)" ::: "memory"); __builtin_amdgcn_sched_barrier(0); } while (0)
#define DN_STEP(U, c) do { \
            const unsigned fba = (unsigned)(uintptr_t)(lds + ((c) & 3) * S_SLOT) + lane16; \
            const float gl = __builtin_bit_cast(float, __builtin_amdgcn_readlane(__builtin_bit_cast(int, glv), (c))); \
            f32x16 v0, v1; \
            _Pragma("unroll") for (int i = 0; i < 8; ++i) { v0[2 * i] = bflo_(U[i >> 2][i & 3]); v0[2 * i + 1] = bfhi_(U[i >> 2][i & 3]); v1[2 * i] = bflo_(U[2 + (i >> 2)][i & 3]); v1[2 * i + 1] = bfhi_(U[2 + (i >> 2)][i & 3]); } \
            PIN2(v0, v1); \
            if ((c) + 2 < 64) DN_ULOAD(U, (c) + 2); \
            asm volatile("s_waitcnt lgkmcnt(0)" ::: "memory"); \
            unsigned char* sfc = sf0 + (size_t)(c) * 32768; unsigned char* vfc = vf0 + (size_t)(c) * 16384; \
            bf16x8 A0, A1, A2, A3, B0, B1, B2, B3; \
            RD4(A, 0, 8, 1, 9); LWAIT(); \
              \
            { const bf16x8 s0_ = pack_acc<0>(S0), s1_ = pack_acc<1>(S0); *(u32x4*)(sfc) = __builtin_bit_cast(u32x4, s0_); *(u32x4*)(sfc + 1024) = __builtin_bit_cast(u32x4, s1_); RD4(B, 2, 10, 3, 11); \
              v0 = DN_MFMA(A0, s0_, v0); v1 = DN_MFMA(A1, s0_, v1); v0 = DN_MFMA(A2, s1_, v0); v1 = DN_MFMA(A3, s1_, v1); PIN2(v0, v1); LWAIT(); } \
            { const bf16x8 s0_ = pack_acc<0>(S1), s1_ = pack_acc<1>(S1); *(u32x4*)(sfc + 2048) = __builtin_bit_cast(u32x4, s0_); *(u32x4*)(sfc + 3072) = __builtin_bit_cast(u32x4, s1_); RD4(A, 4, 12, 5, 13); \
              v0 = DN_MFMA(B0, s0_, v0); v1 = DN_MFMA(B1, s0_, v1); v0 = DN_MFMA(B2, s1_, v0); v1 = DN_MFMA(B3, s1_, v1); PIN2(v0, v1); LWAIT(); } \
            { const bf16x8 s0_ = pack_acc<0>(S2), s1_ = pack_acc<1>(S2); *(u32x4*)(sfc + 4096) = __builtin_bit_cast(u32x4, s0_); *(u32x4*)(sfc + 5120) = __builtin_bit_cast(u32x4, s1_); RD4(B, 6, 14, 7, 15); \
              v0 = DN_MFMA(A0, s0_, v0); v1 = DN_MFMA(A1, s0_, v1); v0 = DN_MFMA(A2, s1_, v0); v1 = DN_MFMA(A3, s1_, v1); PIN2(v0, v1); LWAIT(); } \
            { const bf16x8 s0_ = pack_acc<0>(S3), s1_ = pack_acc<1>(S3); *(u32x4*)(sfc + 6144) = __builtin_bit_cast(u32x4, s0_); *(u32x4*)(sfc + 7168) = __builtin_bit_cast(u32x4, s1_); RD4(A, 16, 20, 24, 28); \
              v0 = DN_MFMA(B0, s0_, v0); v1 = DN_MFMA(B1, s0_, v1); v0 = DN_MFMA(B2, s1_, v0); v1 = DN_MFMA(B3, s1_, v1); PIN2(v0, v1); LWAIT(); } \
            const bf16x8 vf0_ = pack_acc<0>(v0), vf1_ = pack_acc<1>(v0), vf2_ = pack_acc<0>(v1), vf3_ = pack_acc<1>(v1); \
            *(u32x4*)(vfc) = __builtin_bit_cast(u32x4, vf0_); *(u32x4*)(vfc + 1024) = __builtin_bit_cast(u32x4, vf1_); *(u32x4*)(vfc + 2048) = __builtin_bit_cast(u32x4, vf2_); *(u32x4*)(vfc + 3072) = __builtin_bit_cast(u32x4, vf3_); \
            _Pragma("unroll") for (int i = 0; i < 16; ++i) { S0[i] *= gl; S1[i] *= gl; S2[i] *= gl; S3[i] *= gl; } \
              \
            RD4(B, 17, 21, 25, 29); \
            S0 = DN_MFMA(A0, vf0_, S0); S1 = DN_MFMA(A1, vf0_, S1); S2 = DN_MFMA(A2, vf0_, S2); S3 = DN_MFMA(A3, vf0_, S3); PIN4(S0, S1, S2, S3); LWAIT(); \
            RD4(A, 18, 22, 26, 30); \
            S0 = DN_MFMA(B0, vf1_, S0); S1 = DN_MFMA(B1, vf1_, S1); S2 = DN_MFMA(B2, vf1_, S2); S3 = DN_MFMA(B3, vf1_, S3); PIN4(S0, S1, S2, S3); LWAIT(); \
            RD4(B, 19, 23, 27, 31); \
            S0 = DN_MFMA(A0, vf2_, S0); S1 = DN_MFMA(A1, vf2_, S1); S2 = DN_MFMA(A2, vf2_, S2); S3 = DN_MFMA(A3, vf2_, S3); PIN4(S0, S1, S2, S3); LWAIT(); \
            S0 = DN_MFMA(B0, vf3_, S0); S1 = DN_MFMA(B1, vf3_, S1); S2 = DN_MFMA(B2, vf3_, S2); S3 = DN_MFMA(B3, vf3_, S3); PIN4(S0, S1, S2, S3); \
            __builtin_amdgcn_sched_barrier(0); \
            DN_B(); } while (0)
#pragma unroll 1
        for (int c = 0; c < 64; c += 2) { DN_STEP(ua, c); DN_STEP(ub, c + 1); }
#undef DN_STEP
#undef RD4
#undef PIN2
#undef PIN4
#undef LWAIT
#undef DN_ULOAD
    }
    __syncthreads();
#undef DN_B
}

constexpr int O_OT = 0, O_NW = 2 * 64 * LQ * 2, O_END = O_NW + 512;
DNI void chunk_out(LAS unsigned char* lds, int item, const unsigned char* BLOB, const unsigned char* SF, const unsigned char* VF, const bf16* DNZ, const float* norm_w, bf16* Y) {
    int tid = threadIdx.x; asm volatile("" : "+v"(tid));
    const int wid = __builtin_amdgcn_readfirstlane(tid >> 6), lane = tid & 63, r = lane & 31, h2 = lane >> 5, half = wid >> 2, w = wid & 3;
    const int ck = 2 * item + half;
    const int n = ck & 63, hd = (ck >> 6) & 3, b = ck >> 8;
    if (tid < 128) ((LAS float*)(lds + O_NW))[tid] = norm_w[tid];
    const unsigned char* blob = BLOB + (size_t)ck * BLOB_BYTES + lane * 16;
    const unsigned char* sfp = SF + ((size_t)ck * 4 + w) * 8192 + lane * 16;
    const unsigned char* vfp = VF + ((size_t)ck * 4 + w) * 4096 + lane * 16;
    f32x16 o0 = {}, o1 = {};
#define GF(f) (*(const bf16x8*)(blob + (f) * 1024))
    {
        bf16x8 sf[8], vf[4], qa[8], qb[8];
#pragma unroll
        for (int s = 0; s < 8; ++s) { sf[s] = *(const bf16x8*)(sfp + s * 1024); qa[s] = GF(16 + s); }
#pragma unroll
        for (int s = 0; s < 8; ++s) qb[s] = GF(24 + s);
#pragma unroll
        for (int s2 = 0; s2 < 4; ++s2) vf[s2] = *(const bf16x8*)(vfp + s2 * 1024);
#pragma unroll
        for (int s = 0; s < 8; ++s) o0 = DN_MFMA(qa[s], sf[s], o0);
#pragma unroll
        for (int s2 = 0; s2 < 4; ++s2) { qa[s2] = GF(32 + s2); qa[4 + s2] = GF(36 + s2); }
#pragma unroll
        for (int s = 0; s < 8; ++s) o1 = DN_MFMA(qb[s], sf[s], o1);
#pragma unroll
        for (int s2 = 0; s2 < 4; ++s2) { o0 = DN_MFMA(qa[s2], vf[s2], o0); o1 = DN_MFMA(qa[4 + s2], vf[s2], o1); }
    }
#undef GF
    {
        LAS unsigned char* obp = lds + O_OT + half * (64 * LQ * 2) + ((4 * h2) * LQ + 32 * w + r) * 2;
#pragma unroll
        for (int i = 0; i < 16; ++i) {
            *(LAS unsigned short*)(obp + ((i & 3) + 8 * (i >> 2)) * (LQ * 2)) = (unsigned short)(cvtpk2(o0[i], 0.f) & 0xffffu);
            *(LAS unsigned short*)(obp + (32 + (i & 3) + 8 * (i >> 2)) * (LQ * 2)) = (unsigned short)(cvtpk2(o1[i], 0.f) & 0xffffu);
        }
    }
    __syncthreads();
    {
        const int t4 = tid & 255, pos = t4 >> 2, seg = t4 & 3;
        const LAS unsigned char* op = lds + O_OT + half * (64 * LQ * 2) + (pos * LQ + seg * 32) * 2;
        u32x4 wv[4];
#pragma unroll
        for (int q = 0; q < 4; ++q) wv[q] = *(const LAS u32x4*)(op + q * 16);
        float ss = 0.f;
#pragma unroll
        for (int q = 0; q < 4; ++q)
#pragma unroll
            for (int e = 0; e < 4; ++e) { const float a = bflo_(wv[q][e]), c = bfhi_(wv[q][e]); ss += a * a + c * c; }
        ss += __shfl_xor(ss, 1); ss += __shfl_xor(ss, 2);
        const float rs = rsqrtf(ss * (1.f / 128.f) + 1e-6f);
        const size_t m = (size_t)b * 4096 + (size_t)n * 64 + pos;
        const bf16* zp = DNZ + m * 512 + hd * 128 + seg * 32; bf16* yp = Y + m * 1024 + hd * 128 + seg * 32; const LAS float* nw = (const LAS float*)(lds + O_NW) + seg * 32;
#pragma unroll
        for (int q = 0; q < 4; ++q) {
            const u32x4 z = *(const u32x4*)(zp + q * 8); u32x4 o;
#pragma unroll
            for (int e = 0; e < 4; ++e) {
                const float z0 = bflo_(z[e]), z1 = bfhi_(z[e]);
                o[e] = cvtpk2(bflo_(wv[q][e]) * rs * nw[q * 8 + 2 * e] * (z0 / (1.f + __expf(-z0))), bfhi_(wv[q][e]) * rs * nw[q * 8 + 2 * e + 1] * (z1 / (1.f + __expf(-z1))));
            }
            *(u32x4*)(yp + q * 8) = o;
        }
    }
    __syncthreads();
}
#undef DN_MFMA
#undef DNI
}
constexpr int NWAVES = 8, NTHR = NWAVES * 64;
constexpr int BATCH = 4, SEQ = 4096, DM = 1024, M = BATCH * SEQ;
constexpr int HD = 128, NH = 4, DDN = 512, DMB = 512, NPROJ = 3584, DINP = 3592;
constexpr int MBLK = 256, NBLK = SEQ / MBLK;
constexpr int NE = 16, DE = 256;
constexpr float LN_EPS = 1e-5f, RMS_EPS = 1e-6f, ALPHA = 1.189207115002721f, QSCALE = 0.08838834764831845f;

constexpr size_t MiB = 1u << 20;
constexpr size_t WS_CTL = 0, CTL_ZERO_BYTES = 1 * MiB;
constexpr size_t WS_WIN = 2 * MiB;
constexpr size_t WS_WOUT = 10 * MiB;
constexpr size_t WS_WGU = 12 * MiB;
constexpr size_t WS_WD = 28 * MiB;
constexpr size_t WS_ROPE = 36 * MiB;
constexpr size_t WS_KMP = 38 * MiB;
constexpr size_t WS_GATES = 39 * MiB;
constexpr size_t WS_BETA = WS_GATES + 512 * 1024;
constexpr size_t WS_GLOG = WS_BETA + 256 * 1024;
constexpr size_t WS_XB = 48 * MiB;
constexpr size_t WS_DNQN = 48 * MiB, WS_DNKN = 64 * MiB;
constexpr size_t WS_PJ = 80 * MiB;
constexpr size_t PJ_STRIDE = 16 * MiB;
constexpr size_t WS_Y = 192 * MiB;
constexpr size_t WS_DNVN = 224 * MiB;
constexpr size_t WS_GL = 40 * MiB;
constexpr size_t WS_SF = 48 * MiB;
constexpr size_t WS_VF = 224 * MiB;
constexpr size_t WS_UF = 240 * MiB;
constexpr size_t WS_TOKE = 41 * MiB;
constexpr size_t WS_TOKP = WS_TOKE + 256 * 1024;
constexpr size_t WS_TOKW = WS_TOKP + 256 * 1024;
constexpr size_t WS_HB = 48 * MiB;
constexpr size_t WS_HS = 80 * MiB;
constexpr size_t WS_HE = 152 * MiB;
constexpr size_t WS_Y2 = 170 * MiB;
constexpr size_t WS_MIXB = 224 * MiB;
constexpr size_t WS_END = 256 * MiB;
constexpr int CW_CNT = 64;
constexpr int CW_SEAM = 16384;
constexpr size_t WS_LIST = 43 * MiB;
constexpr size_t WS_XBUF = 42 * MiB;
constexpr int CW_BAR = 4096;

constexpr int RING_OFF = 0, RING_BYTES = 139264;
constexpr int LDSCTL_OFF = RING_BYTES, MISC_OFF = LDSCTL_OFF + 320;
constexpr int LDS_BYTES = 147456;

#define DI __device__ __forceinline__
DI float bf2f(unsigned short v) { return __uint_as_float((unsigned)v << 16); }
DI float bflo(unsigned w) { return __uint_as_float(w << 16); }
DI float bfhi(unsigned w) { return __uint_as_float(w & 0xffff0000u); }
DI float wave_sum(float v) {
#pragma unroll
    for (int o = 1; o < 64; o <<= 1) v += __shfl_xor(v, o);
    return v;
}
DI float wave_max(float v) {
#pragma unroll
    for (int o = 1; o < 64; o <<= 1) v = fmaxf(v, __shfl_xor(v, o));
    return v;
}
DI float silu_f(float v) { return v / (1.f + __expf(-v)); }
DI float softplus_f(float v) { return fmaxf(v, 0.f) + log1pf(__expf(-fabsf(v))); }

struct Args {
    const GAS float* in_[18]; GAS float* out_; GAS unsigned char* ws_; int ph_lo, ph_hi;
    DI const float* I(int k) const { return (const float*)in_[k]; }
    DI float* O() const { return (float*)out_; }
    DI unsigned char* W() const { return (unsigned char*)ws_; }
};
#define CAS __attribute__((address_space(4)))
struct KA {
    const CAS unsigned char* p;
    DI const float* I(int k) const { return (const float*)(*(const GAS float* const CAS*)(p + 8 * k)); }
    DI float* O() const { return (float*)(*(GAS float* const CAS*)(p + 144)); }
    DI unsigned char* W() const { return (unsigned char*)(*(GAS unsigned char* const CAS*)(p + 152)); }
    DI int lo() const { return *(const CAS int*)(p + 160); }
    DI int hi() const { return *(const CAS int*)(p + 164); }
};
static_assert(offsetof(Args, out_) == 144 && offsetof(Args, ws_) == 152 && offsetof(Args, ph_lo) == 160 && offsetof(Args, ph_hi) == 164, "Args layout");
DI KA kargs() { KA a; a.p = (const CAS unsigned char*)__builtin_amdgcn_kernarg_segment_ptr(); asm volatile("" : "+s"(a.p)); return a; }
struct Frame {
    LAS unsigned char* lds;
    int tid, lane, wave, vcu, G;
};

DI void p0_transpose_item(const float* W, int ldw, int src_col0, int K, bf16* WT, int dst_row0, LAS float* scr, int kb, int nb, int lane) {
    const int k0 = 64 * kb, n0 = 32 * nb;
#pragma unroll 8
    for (int i = 0; i < 32; ++i) { const int kk = 2 * i + (lane >> 5); scr[kk * 33 + (lane & 31)] = W[(size_t)(k0 + kk) * ldw + src_col0 + n0 + (lane & 31)]; }
    LDS_WAIT(); asm volatile("" ::: "memory");
    const int c = lane & 7;
#pragma unroll
    for (int j = 0; j < 4; ++j) { const int n = (lane >> 3) + 8 * j; const LAS float* s = scr + (8 * c) * 33 + n;
        v4u o; o.x = pk2(s[0 * 33], s[1 * 33]); o.y = pk2(s[2 * 33], s[3 * 33]); o.z = pk2(s[4 * 33], s[5 * 33]); o.w = pk2(s[6 * 33], s[7 * 33]);
        pg8::st16_wt(WT + (size_t)(dst_row0 + n0 + n) * K + k0 + 8 * c, o); }
    LDS_WAIT(); asm volatile("" ::: "memory");
}

DI void p0_prologue(const Frame& F, const KA& A) {
    unsigned char* ws = A.W();
    const float* x = A.I(0); const float* w_in = A.I(1); const float* w_out = A.I(6);
    const int gw = F.vcu * NWAVES + F.wave, NGW = F.G * NWAVES;
    {
        LAS float* wgl = (LAS float*)(F.lds + RING_OFF);
        for (int i = F.tid; i < 1024 * 8; i += NTHR) wgl[i] = w_in[(size_t)(i >> 3) * DINP + 2048 + (i & 7)];
        __syncthreads();
        bf16* XB = (bf16*)(ws + WS_XB); float* GATES = (float*)(ws + WS_GATES);
        for (int m0 = gw * 2; m0 < M; m0 += NGW * 2) {
            f32x4 v[2][4];
#pragma unroll
            for (int rr = 0; rr < 2; ++rr) { const GAS f32x4* xr = (const GAS f32x4*)(x + (size_t)(m0 + rr) * DM) + F.lane;
#pragma unroll
                for (int j = 0; j < 4; ++j) v[rr][j] = xr[64 * j]; }
#pragma unroll
            for (int rr = 0; rr < 2; ++rr) {
                const int m = m0 + rr;
                GAS unsigned long long* o8 = (GAS unsigned long long*)(XB + (size_t)m * DM) + F.lane;
                float g[8];
#pragma unroll
                for (int q = 0; q < 8; ++q) g[q] = 0.f;
#pragma unroll
                for (int j = 0; j < 4; ++j) {
                    o8[64 * j] = (unsigned long long)pk2(v[rr][j].x, v[rr][j].y) | ((unsigned long long)pk2(v[rr][j].z, v[rr][j].w) << 32);
#pragma unroll
                    for (int e = 0; e < 4; ++e) { const int k = 256 * j + 4 * F.lane + e; const float xv = v[rr][j][e];
                        const f32x4 w0 = *(const LAS f32x4*)(wgl + k * 8), w1 = *(const LAS f32x4*)(wgl + k * 8 + 4);
                        g[0] += xv * w0.x; g[1] += xv * w0.y; g[2] += xv * w0.z; g[3] += xv * w0.w;
                        g[4] += xv * w1.x; g[5] += xv * w1.y; g[6] += xv * w1.z; g[7] += xv * w1.w; }
                }
#pragma unroll
                for (int q = 0; q < 8; ++q) g[q] = wave_sum(g[q]);
                if (F.lane == 0) {
#pragma unroll
                    for (int q = 0; q < 8; ++q) GATES[(size_t)m * 8 + q] = g[q];
                }
            }
        }
        __syncthreads();
    }
    {
        LAS float* scr = (LAS float*)(F.lds + RING_OFF + F.wave * 16384);
        bf16* WIN = (bf16*)(ws + WS_WIN); bf16* WOUT = (bf16*)(ws + WS_WOUT);
        constexpr int I_A = 16 * 64, I_B = 16 * 48, I_O = 16 * 32, I_GU = NE * 4 * 64, I_D = NE * 128;
        const float* wgate = A.I(13); const float* wup = A.I(14); const float* wdn = A.I(15);
        bf16* WGU = (bf16*)(ws + WS_WGU); bf16* WD = (bf16*)(ws + WS_WD);
        for (int it = gw; it < I_A + I_B + I_O + I_GU + I_D; it += NGW) {
            int r = it;
            if (r < I_A) { p0_transpose_item(w_in, DINP, 0, DM, WIN, 0, scr, r / 64, r % 64, F.lane); continue; } r -= I_A;
            if (r < I_B) { const int kb = r / 48, nb = r % 48; int dst = 2048 + 32 * nb;
#ifdef ROPE_EPI
                if (nb < 32) { const int sl = nb >> 4, cis = 32 * (nb & 15), head = cis >> 7, dblk = (cis & 127) >> 5;
                    dst = 2048 + sl * 512 + (head >> 1) * 256 + (dblk < 2 ? (head & 1) * 64 + 32 * dblk : 128 + (head & 1) * 64 + 32 * (dblk - 2)); }
#endif
                p0_transpose_item(w_in, DINP, 2056 + 32 * nb, DM, WIN, dst, scr, kb, 0, F.lane); continue; } r -= I_B;
            if (r < I_O) { p0_transpose_item(w_out, DM, 0, DM, WOUT, 0, scr, r / 32, r % 32, F.lane); continue; } r -= I_O;
            if (r < I_GU) {
                const int e = r >> 8, q = (r >> 6) & 3, pn = q >> 1, up = q & 1, kb = (r >> 2) & 15, nb = r & 3;
                p0_transpose_item((up ? wup : wgate) + (size_t)e * DM * DE, DE, pn * 128, DM, WGU, e * 512 + pn * 256 + up * 128, scr, kb, nb, F.lane); continue; } r -= I_GU;
            { const int e = r >> 7, kb = (r >> 5) & 3, nb = r & 31;
              p0_transpose_item(wdn + (size_t)e * DE * DM, DM, 0, DE, WD + (size_t)e * DM * DE, 0, scr, kb, nb, F.lane); }
        }
    }
    {
        float2* ROPE = (float2*)(ws + WS_ROPE);
        for (int i = (F.vcu * NTHR + F.tid); i < SEQ * 64; i += F.G * NTHR) {
            const int pos = i >> 6, j = i & 63;
            const float inv = exp2f(-(float)j * (13.287712379549449f / 64.f));
            const float ang = (float)pos * inv;
            double rev = (double)ang * 0.15915494309189535; rev -= __builtin_rint(rev);
            const float rr = (float)rev;
            ROPE[i] = make_float2(__builtin_amdgcn_cosf(rr), __builtin_amdgcn_sinf(rr));
        }
    }
}

DI void n2a_conv_norm(const Frame& F, const KA& A) {
    unsigned char* ws = A.W();
    const float* conv_w = A.I(2); const float* a_log = A.I(3); const float* dt_bias = A.I(4);
    const bf16* PJ = (const bf16*)(ws + WS_PJ);
    bf16* OUTX[3] = {(bf16*)(ws + WS_DNQN), (bf16*)(ws + WS_DNKN), (bf16*)(ws + WS_DNVN)};
    const float* GATES = (const float*)(ws + WS_GATES); float* BETA = (float*)(ws + WS_BETA); float* GLOG = (float*)(ws + WS_GLOG);
    const int gw = F.vcu * NWAVES + F.wave, NGW = F.G * NWAVES;
    for (int it = gw; it < M * NH; it += NGW) {
        const int m = it >> 2, h = it & 3, t = m & (SEQ - 1), c = 2 * F.lane;
        float val[3][2];
#pragma unroll
        for (int X = 0; X < 3; ++X) {
            float a0 = 0.f, a1 = 0.f;
#pragma unroll
            for (int j = 0; j < 4; ++j) {
                const int tt = t - 3 + j;
                if (tt >= 0) {
                    const unsigned raw = *(const unsigned*)(PJ + X * (PJ_STRIDE / 2) + (size_t)(m - 3 + j) * 512 + h * 128 + c);
                    const float w0 = conv_w[j * 1536 + X * 512 + h * 128 + c], w1 = conv_w[j * 1536 + X * 512 + h * 128 + c + 1];
                    a0 += w0 * bflo(raw); a1 += w1 * bfhi(raw);
                }
            }
            val[X][0] = silu_f(a0); val[X][1] = silu_f(a1);
        }
        const float sq = wave_sum(val[0][0] * val[0][0] + val[0][1] * val[0][1]);
        const float sk = wave_sum(val[1][0] * val[1][0] + val[1][1] * val[1][1]);
        const float rq = rsqrtf(sq + 1e-6f) * QSCALE, rk = rsqrtf(sk + 1e-6f);
        val[0][0] *= rq; val[0][1] *= rq; val[1][0] *= rk; val[1][1] *= rk;
#pragma unroll
        for (int X = 0; X < 3; ++X) *(unsigned*)(OUTX[X] + (size_t)m * 512 + h * 128 + c) = pk2(val[X][0], val[X][1]);
        if (F.lane == 0) {
            const float bb = GATES[(size_t)m * 8 + h], aa = GATES[(size_t)m * 8 + 4 + h];
            BETA[(size_t)m * 4 + h] = 1.f / (1.f + __expf(-bb));
            GLOG[(size_t)m * 4 + h] = -__expf(a_log[h]) * softplus_f(aa + dt_bias[h]);
        }
    }
}

DI void rope8(bf16* p, const float2* rp, float* s1, float* s2) {
    const v4u lo = *(const v4u*)p, hi = *(const v4u*)(p + 64);
    const f32x4 c0 = *(const f32x4*)rp, c1 = *(const f32x4*)(rp + 2), c2 = *(const f32x4*)(rp + 4), c3 = *(const f32x4*)(rp + 6);
    const float cs[8] = {c0.x, c0.z, c1.x, c1.z, c2.x, c2.z, c3.x, c3.z}, sn[8] = {c0.y, c0.w, c1.y, c1.w, c2.y, c2.w, c3.y, c3.w};
    float r1[8], r2[8];
#pragma unroll
    for (int e = 0; e < 4; ++e) {
        const float a0 = bflo(lo[e]), a1 = bfhi(lo[e]), b0 = bflo(hi[e]), b1 = bfhi(hi[e]);
        r1[2 * e] = a0 * cs[2 * e] - b0 * sn[2 * e]; r2[2 * e] = b0 * cs[2 * e] + a0 * sn[2 * e];
        r1[2 * e + 1] = a1 * cs[2 * e + 1] - b1 * sn[2 * e + 1]; r2[2 * e + 1] = b1 * cs[2 * e + 1] + a1 * sn[2 * e + 1];
    }
    v4u o1, o2;
#pragma unroll
    for (int e = 0; e < 4; ++e) { o1[e] = pk2(r1[2 * e], r1[2 * e + 1]); o2[e] = pk2(r2[2 * e], r2[2 * e + 1]); }
    *(v4u*)p = o1; *(v4u*)(p + 64) = o2;
    if (s1) {
#pragma unroll
        for (int e = 0; e < 8; ++e) { s1[e] += r1[e]; s2[e] += r2[e]; }
    }
}
DI void n3a_rope(const Frame& F, const KA& A) {
    unsigned char* ws = A.W();
    bf16* MBQ = (bf16*)(ws + WS_PJ + 4 * PJ_STRIDE); bf16* MBK = (bf16*)(ws + WS_PJ + 5 * PJ_STRIDE);
    const float2* ROPE = (const float2*)(ws + WS_ROPE); float* KMP = (float*)(ws + WS_KMP);
    const int gw = F.vcu * NWAVES + F.wave, NGW = F.G * NWAVES, rr = F.lane >> 3, dseg = F.lane & 7;
    for (int it = gw; it < 1024; it += NGW) {
        const int qtr = it & 3, j = (it >> 2) & 15, h = (it >> 6) & 3, b = it >> 8;
        float s1[8], s2[8];
#pragma unroll
        for (int e = 0; e < 8; ++e) { s1[e] = 0.f; s2[e] = 0.f; }
#pragma unroll 2
        for (int r8 = 0; r8 < 8; ++r8) {
            const int pos = j * 256 + qtr * 64 + r8 * 8 + rr; const size_t m = (size_t)b * SEQ + pos;
            rope8(MBK + m * 512 + h * 128 + dseg * 8, ROPE + pos * 64 + dseg * 8, s1, s2);
        }
#pragma unroll
        for (int e = 0; e < 8; ++e) { s1[e] += __shfl_xor(s1[e], 8); s1[e] += __shfl_xor(s1[e], 16); s1[e] += __shfl_xor(s1[e], 32);
                                      s2[e] += __shfl_xor(s2[e], 8); s2[e] += __shfl_xor(s2[e], 16); s2[e] += __shfl_xor(s2[e], 32); }
        if (rr == 0) {
#pragma unroll
            for (int e = 0; e < 8; ++e) { KMP[(size_t)it * 128 + dseg * 8 + e] = s1[e]; KMP[(size_t)it * 128 + 64 + dseg * 8 + e] = s2[e]; }
        }
    }
    for (int it = gw; it < (M / 8) * NH; it += NGW) {
        const int m8 = it >> 2, h = it & 3; const size_t m = (size_t)m8 * 8 + rr; const int pos = (int)(m & (SEQ - 1));
        rope8(MBQ + m * 512 + h * 128 + dseg * 8, ROPE + pos * 64 + dseg * 8, nullptr, nullptr);
    }
}

DI void n2b_dn_recurrent(const Frame& F, const KA& A, int item, float* ODN) {
    unsigned char* ws = A.W();
    const bf16* QN = (const bf16*)(ws + WS_DNQN); const bf16* KN = (const bf16*)(ws + WS_DNKN); const bf16* VN = (const bf16*)(ws + WS_DNVN);
    const float* BETA = (const float*)(ws + WS_BETA); const float* GLOG = (const float*)(ws + WS_GLOG);
    const int b = item >> 2, h = item & 3;
    LAS float* qs = (LAS float*)(F.lds + RING_OFF);
    LAS float* ks = qs + 16 * 128; LAS float* vs = ks + 16 * 128; LAS float* bs = vs + 16 * 128; LAS float* as = bs + 16;
    float S[128];
#pragma unroll
    for (int k = 0; k < 128; ++k) S[k] = 0.f;
    for (int t0 = 0; t0 < SEQ; t0 += 16) {
        __syncthreads();
        for (int idx = F.tid; idx < 16 * 384; idx += NTHR) {
            const int r = idx / 384, c = idx % 384, X = c >> 7, cc = c & 127; const size_t m = (size_t)b * SEQ + t0 + r;
            const bf16* src = X == 0 ? QN : (X == 1 ? KN : VN);
            (X == 0 ? qs : (X == 1 ? ks : vs))[r * 128 + cc] = bf2f(src[m * 512 + h * 128 + cc]);
        }
        if (F.tid < 16) { const size_t m = (size_t)b * SEQ + t0 + F.tid; bs[F.tid] = BETA[m * 4 + h]; as[F.tid] = __expf(GLOG[m * 4 + h]); }
        __syncthreads();
        if (F.tid < 128) {
#pragma unroll 1
            for (int r = 0; r < 16; ++r) {
                const LAS float* kr = ks + r * 128; const LAS float* qr = qs + r * 128;
                float kS = 0.f;
#pragma unroll
                for (int kb = 0; kb < 128; kb += 16) {
#pragma unroll
                    for (int k = 0; k < 16; ++k) kS += kr[kb + k] * S[kb + k];
                    asm volatile("" ::: "memory");
                }
                const float al = as[r], be = bs[r];
                const float vn = be * (vs[r * 128 + F.tid] - al * kS);
                float o = 0.f;
#pragma unroll
                for (int kb = 0; kb < 128; kb += 16) {
#pragma unroll
                    for (int k = 0; k < 16; ++k) { S[kb + k] = al * S[kb + k] + kr[kb + k] * vn; o += qr[kb + k] * S[kb + k]; }
                    asm volatile("" ::: "memory");
                }
                ODN[((size_t)b * SEQ + t0 + r) * 512 + h * 128 + F.tid] = o;
            }
        }
    }
}

DI void n3b_moba_naive(const Frame& F, const KA& A, int w0, int nw, bf16* Yo, int ypitch, int ycol0) {
    unsigned char* ws = A.W();
    const bf16* MBQ = (const bf16*)(ws + WS_PJ + 4 * PJ_STRIDE); const bf16* MBK = (const bf16*)(ws + WS_PJ + 5 * PJ_STRIDE); const bf16* MBV = (const bf16*)(ws + WS_PJ + 6 * PJ_STRIDE);
    const float* KMP = (const float*)(ws + WS_KMP);
    LAS float* qs = (LAS float*)(F.lds + RING_OFF + 32768) + F.wave * 128;
    const int lane = F.lane;
    for (int it = w0; it < M * NH; it += nw) {
        const int m = it >> 2, h = it & 3, b = m >> 12, t = m & (SEQ - 1), own = t >> 8;
        { const unsigned raw = *(const unsigned*)(MBQ + (size_t)m * 512 + h * 128 + 2 * lane); qs[2 * lane] = bflo(raw) * QSCALE; qs[2 * lane + 1] = bfhi(raw) * QSCALE; }
        asm volatile("s_waitcnt lgkmcnt(0)" ::: "memory");
        float gate = -3e38f;
        if (lane < own) {
            const float* kp = KMP + (size_t)(((b * 4 + h) * 16 + lane) * 4) * 128; float acc = 0.f;
            for (int dd = 0; dd < 128; ++dd) acc += qs[dd] * ((kp[dd] + kp[128 + dd]) + (kp[256 + dd] + kp[384 + dd]));
            gate = acc * (1.f / 256.f);
        }
        int blist[4] = {-1, -1, -1, own};
#pragma unroll
        for (int r = 0; r < 3; ++r) {
            const float mx = wave_max(gate);
            if (mx > -1e37f) {
                const unsigned long long bal = __ballot(gate == mx); const int idx = __builtin_ctzll(bal);
                blist[r] = idx; if (lane == idx) gate = -3e38f;
            }
        }
        float sc[4][4]; float mloc = -3e38f;
#pragma unroll
        for (int s = 0; s < 4; ++s) {
            const int jb = blist[s];
#pragma unroll
            for (int i = 0; i < 4; ++i) {
                float v = -3e38f;
                if (jb >= 0) {
                    const int key = jb * 256 + i * 64 + lane;
                    if (s < 3 || key <= t) {
                        const bf16* kp = MBK + ((size_t)b * SEQ + key) * 512 + h * 128; float acc = 0.f;
#pragma unroll 4
                        for (int c8 = 0; c8 < 16; ++c8) { const v4u w = *(const v4u*)(kp + c8 * 8); const LAS float* q8 = qs + c8 * 8;
                            acc += q8[0] * bflo(w.x) + q8[1] * bfhi(w.x) + q8[2] * bflo(w.y) + q8[3] * bfhi(w.y) + q8[4] * bflo(w.z) + q8[5] * bfhi(w.z) + q8[6] * bflo(w.w) + q8[7] * bfhi(w.w); }
                        v = acc;
                    }
                }
                sc[s][i] = v; mloc = fmaxf(mloc, v);
            }
        }
        const float mx = wave_max(mloc); float lsum = 0.f;
#pragma unroll
        for (int s = 0; s < 4; ++s)
#pragma unroll
            for (int i = 0; i < 4; ++i) { const float p = sc[s][i] > -1e37f ? __expf(sc[s][i] - mx) : 0.f; sc[s][i] = p; lsum += p; }
        const float l = wave_sum(lsum);
        float o0 = 0.f, o1 = 0.f;
#pragma unroll
        for (int s = 0; s < 4; ++s) {
            const int jb = blist[s];
            if (jb >= 0) {
#pragma unroll
                for (int i = 0; i < 4; ++i) {
                    const bf16* vp = MBV + ((size_t)b * SEQ + jb * 256 + i * 64) * 512 + h * 128 + 2 * lane;
                    for (int src = 0; src < 64; ++src) {
                        const float pv = __shfl(sc[s][i], src);
                        if (pv != 0.f) { const unsigned raw = *(const unsigned*)(vp + (size_t)src * 512); o0 += pv * bflo(raw); o1 += pv * bfhi(raw); }
                    }
                }
            }
        }
        const float il = 1.f / l;
        *(unsigned*)(Yo + (size_t)m * ypitch + ycol0 + h * 128 + 2 * lane) = pk2(o0 * il, o1 * il);
        asm volatile("s_waitcnt lgkmcnt(0)" ::: "memory");
    }
}

DI void n2c_dn_gate(const Frame& F, const KA& A, const float* ODN, bf16* Yo, int ypitch) {
    unsigned char* ws = A.W();
    const float* norm_w = A.I(5); const bf16* DNZ = (const bf16*)(ws + WS_PJ + 3 * PJ_STRIDE);
    const int gw = F.vcu * NWAVES + F.wave, NGW = F.G * NWAVES, c = 2 * F.lane;
    for (int it = gw; it < M * NH; it += NGW) {
        const int m = it >> 2, h = it & 3;
        const float2 o = *(const float2*)(ODN + (size_t)m * 512 + h * 128 + c);
        const float ss = wave_sum(o.x * o.x + o.y * o.y) * (1.f / 128.f);
        const float rs = rsqrtf(ss + RMS_EPS);
        const unsigned zr = *(const unsigned*)(DNZ + (size_t)m * 512 + h * 128 + c);
        *(unsigned*)(Yo + (size_t)m * ypitch + h * 128 + c) = pk2(o.x * rs * norm_w[c] * silu_f(bflo(zr)), o.y * rs * norm_w[c + 1] * silu_f(bfhi(zr)));
    }
}

constexpr int CW_DBG = 16;
DI void dbg_compare(const Frame& F, unsigned char* ws, const bf16* T, int tp, int tc0, const bf16* R, int rp, int rc0) {
    float sd = 0.f, sr = 0.f;
    for (int i = F.vcu * NTHR + F.tid; i < M * 256; i += F.G * NTHR) {
        const int m = i >> 8, c = (i & 255) * 2;
        const unsigned a = *(const unsigned*)(T + (size_t)m * tp + tc0 + c), b = *(const unsigned*)(R + (size_t)m * rp + rc0 + c);
        const float d0 = bflo(a) - bflo(b), d1 = bfhi(a) - bfhi(b); sd += d0 * d0 + d1 * d1; sr += bflo(b) * bflo(b) + bfhi(b) * bfhi(b);
    }
    sd = wave_sum(sd); sr = wave_sum(sr);
    if (F.lane == 0) { atomicAdd((float*)(ws + WS_CTL) + CW_DBG, sd); atomicAdd((float*)(ws + WS_CTL) + CW_DBG + 1, sr); }
}
DI float block_sum(float v, LAS float* red, int tid) {
    v = wave_sum(v);
    __syncthreads();
    if ((tid & 63) == 0) red[tid >> 6] = v;
    __syncthreads();
    float s = 0.f;
#pragma unroll
    for (int w = 0; w < NWAVES; ++w) s += red[w];
    return s;
}

DI void n5_token_tail(const Frame& F, const KA& A) {
    const float* x = A.I(0); const float* g1 = A.I(7); const float* b1 = A.I(8);
    const float* rw1 = A.I(9); const float* rb1 = A.I(10); const float* rw2 = A.I(11); const float* rb2 = A.I(12);
    const float* wg = A.I(13); const float* wu = A.I(14); const float* wd = A.I(15); const float* g2 = A.I(16); const float* b2 = A.I(17);
    float* out = A.O();
    LAS float* hs = (LAS float*)(F.lds + RING_OFF);
    LAS float* hes = hs + 1024;
    LAS float* lg = hes + 512;
    LAS float* red = lg + 32;
    LAS float* rt_ = red + 8;
    const int tid = F.tid;
    for (int m = blockIdx.x; m < M; m += F.G) {
        __syncthreads();
        const size_t ro = (size_t)m * DM;
        float v0 = ALPHA * x[ro + tid] + out[ro + tid], v1 = ALPHA * x[ro + tid + 512] + out[ro + tid + 512];
        const float mean = block_sum(v0 + v1, red, tid) * (1.f / DM);
        v0 -= mean; v1 -= mean;
        const float var = block_sum(v0 * v0 + v1 * v1, red, tid) * (1.f / DM);
        const float rstd = rsqrtf(var + LN_EPS);
        const float h0 = v0 * rstd * g1[tid] + b1[tid], h1 = v1 * rstd * g1[tid + 512] + b1[tid + 512];
        hs[tid] = h0; hs[tid + 512] = h1;
        __syncthreads();
        for (int li = F.wave; li < 20; li += NWAVES) {
            float acc = 0.f;
            for (int k = F.lane; k < DM; k += 64) {
                const float wv = li < 4 ? rw1[k * 4 + li] : rw2[((size_t)((li - 4) >> 2) * DM + k) * 4 + ((li - 4) & 3)];
                acc += hs[k] * wv;
            }
            acc = wave_sum(acc);
            if (F.lane == 0) lg[li] = acc;
        }
        __syncthreads();
        if (tid == 0) {
            float pgv[4]; float mx = -3e38f;
            for (int g = 0; g < 4; ++g) { pgv[g] = lg[g] + rb1[g]; mx = fmaxf(mx, pgv[g]); }
            float sum = 0.f; for (int g = 0; g < 4; ++g) { pgv[g] = __expf(pgv[g] - mx); sum += pgv[g]; }
            int gs = 0; for (int g = 1; g < 4; ++g) if (pgv[g] > pgv[gs]) gs = g;
            const float pg = pgv[gs] / sum;
            float pe[4]; mx = -3e38f;
            for (int e = 0; e < 4; ++e) { pe[e] = lg[4 + gs * 4 + e] + rb2[gs * 4 + e]; mx = fmaxf(mx, pe[e]); }
            sum = 0.f; for (int e = 0; e < 4; ++e) { pe[e] = __expf(pe[e] - mx); sum += pe[e]; }
            int e0 = 0; for (int e = 1; e < 4; ++e) if (pe[e] > pe[e0]) e0 = e;
            int e1 = (e0 == 0) ? 1 : 0; for (int e = 0; e < 4; ++e) if (e != e0 && pe[e] > pe[e1]) e1 = e;
            const float den = pe[e0] + pe[e1];
            rt_[0] = __int_as_float(gs * 4 + e0); rt_[1] = __int_as_float(gs * 4 + e1); rt_[2] = pg * pe[e0] / den; rt_[3] = pg * pe[e1] / den;
        }
        __syncthreads();
        const int ex[2] = {__float_as_int(rt_[0]), __float_as_int(rt_[1])}; const float wx[2] = {rt_[2], rt_[3]};
        {
            const int half = tid >> 8, j = tid & 255, e = ex[half];
            const float* pg_ = wg + (size_t)e * DM * DE + j; const float* pu_ = wu + (size_t)e * DM * DE + j;
            float ga = 0.f, ua = 0.f;
#pragma unroll 8
            for (int k = 0; k < DM; ++k) { const float hv = hs[k]; ga += hv * pg_[(size_t)k * DE]; ua += hv * pu_[(size_t)k * DE]; }
            hes[half * 256 + j] = silu_f(ga) * ua;
        }
        __syncthreads();
        float y0 = 0.f, y1 = 0.f;
#pragma unroll
        for (int half = 0; half < 2; ++half) {
            const float* pd = wd + (size_t)ex[half] * DE * DM + tid; float a0 = 0.f, a1 = 0.f;
#pragma unroll 8
            for (int j = 0; j < DE; ++j) { const float hv = hes[half * 256 + j]; a0 += hv * pd[(size_t)j * DM]; a1 += hv * pd[(size_t)j * DM + 512]; }
            y0 += wx[half] * a0; y1 += wx[half] * a1;
        }
        float u0 = ALPHA * h0 + y0, u1 = ALPHA * h1 + y1;
        const float mean2 = block_sum(u0 + u1, red, tid) * (1.f / DM);
        u0 -= mean2; u1 -= mean2;
        const float var2 = block_sum(u0 * u0 + u1 * u1, red, tid) * (1.f / DM);
        const float rstd2 = rsqrtf(var2 + LN_EPS);
        float dscale = 1.f;
#ifdef DBG_ANY
        { const float* dw = (const float*)(A.W() + WS_CTL) + CW_DBG; dscale = 1.f + sqrtf(dw[0] / fmaxf(dw[1], 1e-30f)); }
#endif
        out[ro + tid] = (u0 * rstd2 * g2[tid] + b2[tid]) * dscale; out[ro + tid + 512] = (u1 * rstd2 * g2[tid + 512] + b2[tid + 512]) * dscale;
    }
}

struct MbPart { int own, t_lo, t_hi, slot; };
struct MbSplit { int own, slot0, nparts; };
constexpr int MB_NPARTS = 30, MB_NSLOTS = 24, MB_NSPLIT = 10;
__device__ const MbPart MB_PARTS[MB_NPARTS] = {{5, 0, 24, -1}, {11, 0, 24, 10}, {11, 24, 48, 11}, {10, 0, 22, 8}, {10, 22, 44, 9}, {15, 0, 22, 21}, {15, 22, 44, 22}, {4, 0, 20, -1}, {9, 0, 20, 6}, {9, 20, 40, 7}, {13, 0, 20, 15}, {13, 20, 40, 16}, {14, 0, 20, 18}, {14, 20, 40, 19}, {14, 40, 60, 20}, {15, 44, 64, 23}, {8, 0, 18, 4}, {8, 18, 36, 5}, {12, 0, 18, 12}, {12, 18, 36, 13}, {3, 0, 16, -1}, {7, 0, 16, 2}, {7, 16, 32, 3}, {12, 36, 52, 14}, {13, 40, 56, 17}, {6, 0, 14, 0}, {6, 14, 28, 1}, {2, 0, 12, -1}, {1, 0, 8, -1}, {0, 0, 4, -1}};
__device__ const MbSplit MB_SPLITS[MB_NSPLIT] = {{6, 0, 2}, {7, 2, 2}, {8, 4, 2}, {9, 6, 2}, {10, 8, 2}, {11, 10, 2}, {12, 12, 3}, {13, 15, 3}, {14, 18, 3}, {15, 21, 3}};
constexpr size_t WS_MBPO = WS_PJ;
constexpr size_t WS_MBLSE = WS_PJ + 24 * MiB;
constexpr int CW_MBQ = 96;
typedef mb::BlockRef<bf16, bf16> mbref_t;
DI mbref_t mb_ref(unsigned char* ws, int p, int xq) {
    const int bh = __builtin_amdgcn_readfirstlane(2 * xq + (p & 1)), k = __builtin_amdgcn_readfirstlane(p >> 1);
    const MbPart pt = MB_PARTS[k];
    const int own = __builtin_amdgcn_readfirstlane(pt.own), slot = __builtin_amdgcn_readfirstlane(pt.slot);
    const int b = bh >> 2, h = bh & 3; const size_t row0 = (size_t)b * SEQ;
    mbref_t r;
    r.Q = (const bf16*)(ws + WS_PJ + 4 * PJ_STRIDE) + (row0 + (size_t)own * 256) * 512 + h * 128;
    r.K = (const bf16*)(ws + WS_PJ + 5 * PJ_STRIDE) + row0 * 512 + h * 128;
    r.V = (const bf16*)(ws + WS_PJ + 6 * PJ_STRIDE) + row0 * 512 + h * 128;
    r.O = (bf16*)(ws + WS_Y) + (row0 + (size_t)own * 256) * 1024 + 512 + h * 128;
#ifdef ROPE_EPI
    r.KM = (const float*)(ws + WS_KMP) + (size_t)(bh * 16) * 128;
#else
    r.KM = (const float*)(ws + WS_KMP) + (size_t)(bh * 64) * 128;
#endif
    r.P0 = own * 256; r.t_lo = __builtin_amdgcn_readfirstlane(pt.t_lo); r.t_hi = __builtin_amdgcn_readfirstlane(pt.t_hi);
    r.OP = slot >= 0 ? (bf16*)(ws + WS_MBPO) + (size_t)(bh * MB_NSLOTS + slot) * (256 * 128) : nullptr;
    r.LSE = slot >= 0 ? (float*)(ws + WS_MBLSE) + (size_t)(bh * MB_NSLOTS + slot) * 256 : nullptr;
    return r;
}
DI int mb_claim(unsigned char* ws, LAS unsigned* word, int tid, int xq) {
    if (tid == 0) *word = __hip_atomic_fetch_add((unsigned*)(ws + WS_CTL) + CW_MBQ + 64 * xq, 1u, __ATOMIC_RELAXED, __HIP_MEMORY_SCOPE_AGENT);
    __syncthreads();
    const int p = __builtin_amdgcn_readfirstlane((int)*word);
    __syncthreads();
    return p;
}
DI void p3_moba_queue(unsigned char* ws, char* lds, LAS unsigned* word, int tid, int xq) {
    constexpr int WBIG = 0x3fffffff, NP = MB_NPARTS * 2;
    int p = mb_claim(ws, word, tid, xq);
    if (p >= NP) return;
    mbref_t cur = mb_ref(ws, p, xq);
    mb::Seam<bf16> S;
    mb::causal_swa_prime<bf16, bf16>(cur, WBIG, lds, S);
#pragma unroll 1
    for (;;) {
        const int pn = mb_claim(ws, word, tid, xq);
        const bool more = pn < NP;
        const mbref_t nxt = more ? mb_ref(ws, pn, xq) : cur;
        mb::causal_swa_block<bf16, bf16>(cur, nxt, SEQ, WBIG, lds, S);
        if (!more) break;
        cur = nxt;
    }
}
DI mbref_t mb_ref_full(unsigned char* ws, int bh, int own_) {
    const int own = __builtin_amdgcn_readfirstlane(own_); const int b = bh >> 2, h = bh & 3; const size_t row0 = (size_t)b * SEQ;
    mbref_t r;
    r.Q = (const bf16*)(ws + WS_PJ + 4 * PJ_STRIDE) + (row0 + (size_t)own * 256) * 512 + h * 128;
    r.K = (const bf16*)(ws + WS_PJ + 5 * PJ_STRIDE) + row0 * 512 + h * 128;
    r.V = (const bf16*)(ws + WS_PJ + 6 * PJ_STRIDE) + row0 * 512 + h * 128;
    r.O = (bf16*)(ws + WS_Y) + (row0 + (size_t)own * 256) * 1024 + 512 + h * 128;
#ifdef ROPE_EPI
    r.KM = (const float*)(ws + WS_KMP) + (size_t)(bh * 16) * 128;
#else
    r.KM = (const float*)(ws + WS_KMP) + (size_t)(bh * 64) * 128;
#endif
    r.P0 = own * 256; r.t_lo = 0; r.t_hi = 4 * (own + 1); r.OP = nullptr; r.LSE = nullptr;
    return r;
}
DI void p3_moba_static(unsigned char* ws, char* lds, int bh, int own0, int own1) {
    constexpr int WBIG = 0x3fffffff;
    const int n = own1 >= 0 ? 2 : 1;
    mbref_t cur = mb_ref_full(ws, bh, own0);
    mb::Seam<bf16> S;
    mb::causal_swa_prime<bf16, bf16>(cur, WBIG, lds, S);
#pragma unroll 1
    for (int i = 0; i < n; ++i) {
        const mbref_t nxt = (i + 1 < n) ? mb_ref_full(ws, bh, own1) : cur;
        mb::causal_swa_block<bf16, bf16>(cur, nxt, SEQ, WBIG, lds, S);
        cur = nxt;
    }
}
DI void p4_moba_merge(unsigned char* ws, int it, int tid) {
    const int rh = it & 1, bh = (it >> 1) & 15; const MbSplit sp = MB_SPLITS[it >> 5];
    const int np = __builtin_amdgcn_readfirstlane(sp.nparts);
    const int b = bh >> 2, h = bh & 3, row = rh * 128 + (tid >> 2), qc = tid & 3;
    const float* lse = (const float*)(ws + WS_MBLSE) + (size_t)(bh * MB_NSLOTS + sp.slot0) * 256 + row;
    const bf16* po = (const bf16*)(ws + WS_MBPO) + (size_t)(bh * MB_NSLOTS + sp.slot0) * (256 * 128) + row * 128 + qc * 32;
    float l[3]; v4u w[3][4];
#pragma unroll
    for (int q = 0; q < 3; ++q) {
        const int qq = q < np ? q : 0;
        l[q] = lse[qq * 256];
#pragma unroll
        for (int c8 = 0; c8 < 4; ++c8) w[q][c8] = *(const v4u*)(po + (size_t)qq * (256 * 128) + c8 * 8);
    }
    float mx = -3e38f;
#pragma unroll
    for (int q = 0; q < 3; ++q) { l[q] = q < np ? l[q] : -__builtin_inff(); mx = fmaxf(mx, l[q]); }
    float wsum = 0.f;
#pragma unroll
    for (int q = 0; q < 3; ++q) { l[q] = __builtin_amdgcn_exp2f(l[q] - mx); wsum += l[q]; }
    const float inv = 1.f / wsum;
    bf16* yp = (bf16*)(ws + WS_Y) + ((size_t)b * SEQ + (size_t)sp.own * 256 + row) * 1024 + 512 + h * 128 + qc * 32;
#pragma unroll
    for (int c8 = 0; c8 < 4; ++c8) {
        v4u o;
#pragma unroll
        for (int e = 0; e < 4; ++e) {
            const float a0 = l[0] * bflo(w[0][c8][e]) + l[1] * bflo(w[1][c8][e]) + l[2] * bflo(w[2][c8][e]);
            const float a1 = l[0] * bfhi(w[0][c8][e]) + l[1] * bfhi(w[1][c8][e]) + l[2] * bfhi(w[2][c8][e]);
            o[e] = pk2(a0 * inv, a1 * inv);
        }
        *(v4u*)(yp + c8 * 8) = o;
    }
}

DI void p6_ln_router(const Frame& F, const KA& A) {
    unsigned char* ws = A.W();
    const float* x = A.I(0); const float* g1 = A.I(7); const float* b1 = A.I(8);
    const float* rw1 = A.I(9); const float* rb1 = A.I(10); const float* rw2 = A.I(11); const float* rb2 = A.I(12);
    float* out = A.O(); bf16* HB = (bf16*)(ws + WS_HB); const bf16* MIXB = (const bf16*)(ws + WS_MIXB); (void)out; (void)MIXB;
    int* TOKE = (int*)(ws + WS_TOKE); int* TOKP = (int*)(ws + WS_TOKP); float* TOKW = (float*)(ws + WS_TOKW);
    unsigned* gcnt = (unsigned*)(ws + WS_CTL) + CW_CNT; int* LIST = (int*)(ws + WS_LIST);
    LAS float* rwl = (LAS float*)(F.lds + RING_OFF);
    LAS unsigned* lcnt = (LAS unsigned*)(F.lds + RING_OFF + 81920);
    for (int i = F.tid; i < 1024 * 20; i += NTHR) { const int k = i / 20, li = i % 20;
        rwl[i] = li < 4 ? rw1[k * 4 + li] : rw2[((size_t)((li - 4) >> 2) * DM + k) * 4 + ((li - 4) & 3)]; }
    if (F.tid < 32) lcnt[F.tid] = 0u;
    __syncthreads();
    const int gw = F.vcu * NWAVES + F.wave, NGW = F.G * NWAVES;
#ifdef LN1_FUSE
    for (int m = gw; m < M; m += NGW) {
        const size_t ro = (size_t)m * DM;
        f32x4 v[4];
        float lg[20];
#pragma unroll
        for (int q = 0; q < 20; ++q) lg[q] = 0.f;
#pragma unroll
        for (int j = 0; j < 4; ++j) {
            v[j] = *(const f32x4*)(out + ro + 256 * j + 4 * F.lane);
#pragma unroll
            for (int e = 0; e < 4; ++e) { const LAS float* wr_ = rwl + (256 * j + 4 * F.lane + e) * 20; const float hv = v[j][e];
#pragma unroll
                for (int q4 = 0; q4 < 5; ++q4) { const f32x4 w4 = *(const LAS f32x4*)(wr_ + 4 * q4);
                    lg[4 * q4] += hv * w4.x; lg[4 * q4 + 1] += hv * w4.y; lg[4 * q4 + 2] += hv * w4.z; lg[4 * q4 + 3] += hv * w4.w; } }
        }
#else
    for (int m = gw; m < M; m += NGW) {
        const size_t ro = (size_t)m * DM;
        f32x4 v[4]; float s = 0.f;
#pragma unroll
        for (int j = 0; j < 4; ++j) { const f32x4 xv = *(const f32x4*)(x + ro + 256 * j + 4 * F.lane); const uint2 mr = *(const uint2*)(MIXB + ro + 256 * j + 4 * F.lane);
            v[j].x = xv.x * ALPHA + bflo(mr.x); v[j].y = xv.y * ALPHA + bfhi(mr.x); v[j].z = xv.z * ALPHA + bflo(mr.y); v[j].w = xv.w * ALPHA + bfhi(mr.y); s += (v[j].x + v[j].y) + (v[j].z + v[j].w); }
        const float mean = wave_sum(s) * (1.f / DM); float s2 = 0.f;
#pragma unroll
        for (int j = 0; j < 4; ++j) { v[j] = v[j] - mean; s2 += (v[j].x * v[j].x + v[j].y * v[j].y) + (v[j].z * v[j].z + v[j].w * v[j].w); }
        const float rstd = rsqrtf(wave_sum(s2) * (1.f / DM) + LN_EPS);
        float lg[20];
#pragma unroll
        for (int q = 0; q < 20; ++q) lg[q] = 0.f;
#pragma unroll
        for (int j = 0; j < 4; ++j) {
            const f32x4 gv = *(const f32x4*)(g1 + 256 * j + 4 * F.lane), bv = *(const f32x4*)(b1 + 256 * j + 4 * F.lane);
            v[j] = v[j] * rstd * gv + bv;
            *(unsigned long long*)(HB + ro + 256 * j + 4 * F.lane) = (unsigned long long)pk2(v[j].x, v[j].y) | ((unsigned long long)pk2(v[j].z, v[j].w) << 32);
#pragma unroll
            for (int e = 0; e < 4; ++e) { const LAS float* wr_ = rwl + (256 * j + 4 * F.lane + e) * 20; const float hv = v[j][e];
#pragma unroll
                for (int q4 = 0; q4 < 5; ++q4) { const f32x4 w4 = *(const LAS f32x4*)(wr_ + 4 * q4);
                    lg[4 * q4] += hv * w4.x; lg[4 * q4 + 1] += hv * w4.y; lg[4 * q4 + 2] += hv * w4.z; lg[4 * q4 + 3] += hv * w4.w; } }
        }
#endif
#pragma unroll
        for (int q = 0; q < 20; ++q) lg[q] = wave_sum(lg[q]);
        float pgv[4]; float mx = -3e38f;
#pragma unroll
        for (int g = 0; g < 4; ++g) { pgv[g] = lg[g] + rb1[g]; mx = fmaxf(mx, pgv[g]); }
        float sum = 0.f;
#pragma unroll
        for (int g = 0; g < 4; ++g) { pgv[g] = __expf(pgv[g] - mx); sum += pgv[g]; }
        int gs = 0; float pbest = pgv[0];
#pragma unroll
        for (int g = 1; g < 4; ++g) if (pgv[g] > pbest) { pbest = pgv[g]; gs = g; }
        const float pg = pbest / sum;
        float pe[4]; mx = -3e38f;
#pragma unroll
        for (int e = 0; e < 4; ++e) { float l2 = 0.f;
#pragma unroll
            for (int g = 0; g < 4; ++g) l2 = (g == gs) ? lg[4 + g * 4 + e] + rb2[g * 4 + e] : l2;
            pe[e] = l2; mx = fmaxf(mx, l2); }
#pragma unroll
        for (int e = 0; e < 4; ++e) pe[e] = __expf(pe[e] - mx);
        int e0 = 0; float p0 = pe[0];
#pragma unroll
        for (int e = 1; e < 4; ++e) if (pe[e] > p0) { p0 = pe[e]; e0 = e; }
        int e1 = -1; float p1 = -1.f;
#pragma unroll
        for (int e = 0; e < 4; ++e) if (e != e0 && pe[e] > p1) { p1 = pe[e]; e1 = e; }
        const float den = p0 + p1; const int x0 = gs * 4 + e0, x1 = gs * 4 + e1;
        if (F.lane == 0) {
            const unsigned i0 = __hip_atomic_fetch_add(lcnt + x0, 1u, __ATOMIC_RELAXED, __HIP_MEMORY_SCOPE_WORKGROUP);
            const unsigned i1 = __hip_atomic_fetch_add(lcnt + x1, 1u, __ATOMIC_RELAXED, __HIP_MEMORY_SCOPE_WORKGROUP);
            TOKE[m] = x0 | (x1 << 8); TOKP[2 * m] = (int)i0; TOKP[2 * m + 1] = (int)i1; TOKW[2 * m] = pg * p0 / den; TOKW[2 * m + 1] = pg * p1 / den;
        }
    }
    __syncthreads();
    if (F.tid < 16) lcnt[16 + F.tid] = __hip_atomic_fetch_add(gcnt + F.tid, lcnt[F.tid], __ATOMIC_RELAXED, __HIP_MEMORY_SCOPE_AGENT);
    __syncthreads();
    for (int m = gw; m < M; m += NGW) {
        if (F.lane == 0) { const int ee = TOKE[m], e0 = ee & 255, e1 = ee >> 8; const int q0 = TOKP[2 * m] + (int)lcnt[16 + e0], q1 = TOKP[2 * m + 1] + (int)lcnt[16 + e1];
            TOKP[2 * m] = q0; TOKP[2 * m + 1] = q1; LIST[e0 * 16384 + q0] = m; LIST[e1 * 16384 + q1] = m; }
    }
}
DI void moe_tile_table(const Frame& F, unsigned char* ws, LAS int* tb) {
    if (F.tid == 0) { const unsigned* gcnt = (const unsigned*)(ws + WS_CTL) + CW_CNT; int acc = 0;
        for (int e = 0; e < 16; ++e) { tb[e] = acc; acc += (int)((__hip_atomic_load(gcnt + e, __ATOMIC_RELAXED, __HIP_MEMORY_SCOPE_AGENT) + 255u) >> 8); } tb[16] = acc; }
    __syncthreads();
}
DI void p7_permute(const Frame& F, const KA& A) {
    unsigned char* ws = A.W();
    LAS int* tb = (LAS int*)(F.lds + RING_OFF);
    moe_tile_table(F, ws, tb);
    const bf16* HB = (const bf16*)(ws + WS_HB); bf16* HS = (bf16*)(ws + WS_HS);
    const int* TOKE = (const int*)(ws + WS_TOKE); const int* TOKP = (const int*)(ws + WS_TOKP);
    const int gw = F.vcu * NWAVES + F.wave, NGW = F.G * NWAVES;
    for (int it = gw; it < 2 * M; it += NGW) {
        const int m = it >> 1, k = it & 1; const int ee = TOKE[m]; const int e = k ? (ee >> 8) : (ee & 255);
        const size_t row = (size_t)tb[e] * 256 + TOKP[it];
        const v4u a0 = *(const v4u*)(HB + (size_t)m * DM + 8 * F.lane), a1 = *(const v4u*)(HB + (size_t)m * DM + 512 + 8 * F.lane);
        pg8::st16_wt(HS + row * DM + 8 * F.lane, a0); pg8::st16_wt(HS + row * DM + 512 + 8 * F.lane, a1);
    }
}
DI void p10_combine(const Frame& F, const KA& A) {
    unsigned char* ws = A.W();
    LAS int* tb = (LAS int*)(F.lds + RING_OFF);
    moe_tile_table(F, ws, tb);
    const float* g2 = A.I(16); const float* b2 = A.I(17); float* out = A.O();
    const bf16* Y2 = (const bf16*)(ws + WS_Y2);
    const bf16* HBc = (const bf16*)(ws + WS_HB); (void)HBc;
    const int* TOKE = (const int*)(ws + WS_TOKE); const int* TOKP = (const int*)(ws + WS_TOKP); const float* TOKW = (const float*)(ws + WS_TOKW);
    const int gw = F.vcu * NWAVES + F.wave, NGW = F.G * NWAVES;
    for (int m0 = gw * 2; m0 < M; m0 += NGW * 2) {
        int ee[2], tp[2][2]; float tw[2][2];
#pragma unroll
        for (int t = 0; t < 2; ++t) { const int m = m0 + t; ee[t] = TOKE[m]; tp[t][0] = TOKP[2 * m]; tp[t][1] = TOKP[2 * m + 1]; tw[t][0] = TOKW[2 * m]; tw[t][1] = TOKW[2 * m + 1]; }
        uint2 hr[2][4], ya[2][4], yb[2][4];
#pragma unroll
        for (int t = 0; t < 2; ++t) {
            const size_t ro = (size_t)(m0 + t) * DM;
            const size_t r0 = (size_t)tb[ee[t] & 255] * 256 + tp[t][0], r1 = (size_t)tb[ee[t] >> 8] * 256 + tp[t][1];
#pragma unroll
            for (int j = 0; j < 4; ++j) { hr[t][j] = *(const uint2*)(HBc + ro + 256 * j + 4 * F.lane);
                ya[t][j] = *(const uint2*)(Y2 + r0 * DM + 256 * j + 4 * F.lane); yb[t][j] = *(const uint2*)(Y2 + r1 * DM + 256 * j + 4 * F.lane); }
        }
#pragma unroll
        for (int t = 0; t < 2; ++t) {
            const size_t ro = (size_t)(m0 + t) * DM; const float w0 = tw[t][0], w1 = tw[t][1];
            f32x4 v[4]; float s = 0.f;
#pragma unroll
            for (int j = 0; j < 4; ++j) {
                v[j].x = ALPHA * bflo(hr[t][j].x) + w0 * bflo(ya[t][j].x) + w1 * bflo(yb[t][j].x); v[j].y = ALPHA * bfhi(hr[t][j].x) + w0 * bfhi(ya[t][j].x) + w1 * bfhi(yb[t][j].x);
                v[j].z = ALPHA * bflo(hr[t][j].y) + w0 * bflo(ya[t][j].y) + w1 * bflo(yb[t][j].y); v[j].w = ALPHA * bfhi(hr[t][j].y) + w0 * bfhi(ya[t][j].y) + w1 * bfhi(yb[t][j].y);
                s += (v[j].x + v[j].y) + (v[j].z + v[j].w);
            }
            const float mean = wave_sum(s) * (1.f / DM); float s2 = 0.f;
#pragma unroll
            for (int j = 0; j < 4; ++j) { v[j] = v[j] - mean; s2 += (v[j].x * v[j].x + v[j].y * v[j].y) + (v[j].z * v[j].z + v[j].w * v[j].w); }
            const float rstd = rsqrtf(wave_sum(s2) * (1.f / DM) + LN_EPS);
#pragma unroll
            for (int j = 0; j < 4; ++j) { const f32x4 gv = *(const f32x4*)(g2 + 256 * j + 4 * F.lane), bv = *(const f32x4*)(b2 + 256 * j + 4 * F.lane);
                *(f32x4*)(out + ro + 256 * j + 4 * F.lane) = v[j] * rstd * gv + bv; }
        }
    }
}

#ifndef DUP_P0
#define DUP_P0 1
#endif
#ifndef DUP_P1
#define DUP_P1 1
#endif
#ifndef DUP_P2
#define DUP_P2 1
#endif
#ifndef DUP_P3
#define DUP_P3 1
#endif
#ifndef DUP_P5
#define DUP_P5 1
#endif
#ifndef DUP_P7
#define DUP_P7 1
#endif
#ifndef DUP_P8
#define DUP_P8 1
#endif
#ifndef DUP_P9
#define DUP_P9 1
#endif
#ifdef SKIP_N2B
#define n2b_dn_recurrent(...) ((void)0)
#endif
#ifdef SKIP_N3B
#define n3b_moba_naive(...) ((void)0)
#endif
#ifdef SKIP_N5
#define n5_token_tail(...) ((void)0)
#endif
#ifdef SKIP_P0
#define p0_prologue(...) ((void)0)
#endif
#ifdef SKIP_N2A
#define n2a_conv_norm(...) ((void)0)
#endif
#ifdef SKIP_N3A
#define n3a_rope(...) ((void)0)
#endif
#ifdef SKIP_N2C
#define n2c_dn_gate(...) ((void)0)
#endif
#if defined(DBG_MOBA) || defined(DBG_DN)
#define DBG_ANY 1
#endif
#ifdef MOE_NAIVE
constexpr int N_PHASES = 7;
#else
constexpr int N_PHASES = 11;
#endif
__global__ void __launch_bounds__(NTHR, 2) mk_fwd(Args args_unused) {
    (void)args_unused;
    extern __shared__ __attribute__((aligned(16))) unsigned char lds[];
    Frame F;
    F.lds = (LAS unsigned char*)lds;
    F.tid = threadIdx.x; F.lane = F.tid & 63; F.wave = __builtin_amdgcn_readfirstlane(F.tid >> 6);
    F.G = gridDim.x; { const int bx = blockIdx.x; F.vcu = (F.G % 8 == 0) ? (bx % 8) * (F.G / 8) + bx / 8 : bx; }
    unsigned char* ws = kargs().W();
    gu32* ctl = (gu32*)(ws + WS_CTL);
    volatile LAS unsigned* MISC = (volatile LAS unsigned*)(F.lds + MISC_OFF);
    for (int u = F.tid; u < (LDS_BYTES - LDSCTL_OFF) / 4; u += NTHR) ((LAS unsigned*)(F.lds + LDSCTL_OFF))[u] = 0u;
    __syncthreads();
    const int lo = kargs().lo(), hi = kargs().hi();
    const bool multi = (hi - lo) > 1;
    XcdBarrier bar; bar.bar = (unsigned*)(ctl + CW_BAR); bar.x = 0; bar.st = nullptr;
    if (multi) bar = xcd_barrier_post((unsigned*)(ctl + CW_BAR), MISC + 8);
#define IN(k) (lo <= (k) && (k) < hi)
#define REFRESH_F() do { int t_ = threadIdx.x; asm volatile("" : "+v"(t_)); F.tid = t_; F.lane = t_ & 63; F.wave = __builtin_amdgcn_readfirstlane(t_ >> 6); } while (0)
#define SEAM(k) do { if (IN(k) && IN((k) + 1)) xcd_barrier(bar); } while (0)

    if (IN(0)) { REFRESH_F(); for (int rep_ = 0; rep_ < DUP_P0; ++rep_) { const KA args = kargs(); p0_prologue(F, args); __syncthreads(); } SEAM(0); }
    if (IN(1)) { REFRESH_F(); for (int rep_ = 0; rep_ < DUP_P1; ++rep_) {
        pg8::Gemm g{(const bf16*)(ws + WS_XB), (const bf16*)(ws + WS_WIN), M, NPROJ, DM}; pg8::StaticOrder S; S.init(M, NPROJ, F.G, (int)blockIdx.x);
#ifdef ROPE_EPI
        pg8::EpiProj E{(bf16*)(ws + WS_PJ), (size_t)(PJ_STRIDE / 2), (const float*)(ws + WS_ROPE), (float*)(ws + WS_KMP), (LAS float*)(F.lds + 131072)};
        pg8::gemm_phase<pg8::EpiProj, pg8::StaticOrder, true, PG8_SP2>(F.lds + RING_OFF, g, S, E); }
#else
        pg8::EpiBf16<0> E{(bf16*)(ws + WS_PJ), 512, nullptr, 512, (size_t)(PJ_STRIDE / 2), 1.f};
        pg8::gemm_phase<pg8::EpiBf16<0>, pg8::StaticOrder, PG8_ALIGN, PG8_SP2>(F.lds + RING_OFF, g, S, E); }
#endif
        SEAM(1);
    }
    if (IN(2)) { REFRESH_F();
        const KA args = kargs();
#if defined(DN_NAIVE) || defined(DBG_DN)
        n2a_conv_norm(F, args);
#endif
#ifndef DN_NAIVE
        {
            dn::RawQKV raw;
            int it = F.vcu;
            if (it < 1024) dn::chunk_load(raw, it, (const bf16*)(ws + WS_PJ), PJ_STRIDE / 2);
#pragma unroll 1
            for (; it < 1024; it += F.G)
                dn::chunk_local(F.lds, it, raw, it + F.G < 1024 ? it + F.G : -1, (const bf16*)(ws + WS_PJ), PJ_STRIDE / 2, (const float*)(ws + WS_GATES), args.I(2), args.I(3), args.I(4),
                                (unsigned char*)args.O(), ws + WS_UF, (float*)(ws + WS_GL));
        }
#endif
#ifndef ROPE_EPI
        n3a_rope(F, args);
#endif
        SEAM(2); }
    if (IN(3)) { REFRESH_F();
        const KA args = kargs();
#ifdef DN_NAIVE
        float* ODN = args.O();
#else
        float* ODN = (float*)(ws + WS_PJ);
#endif
        {
            const int v = F.vcu;
            const int bh = __builtin_amdgcn_readfirstlane(v >> 4), r = __builtin_amdgcn_readfirstlane(v & 15);
            if (r == 15 && v < 256) {
#if defined(DN_NAIVE) || defined(DBG_DN)
                n2b_dn_recurrent(F, args, bh, ODN);
#endif
#ifndef DN_NAIVE
                dn::scan_bh(F.lds, bh, (const unsigned char*)args.O(), ws + WS_UF, (const float*)(ws + WS_GL), ws + WS_SF, ws + WS_VF);
#endif
            }
#ifdef MB_QUEUE
            p3_moba_queue(ws, (char*)lds, (LAS unsigned*)(F.lds + LDSCTL_OFF + 640), F.tid, __builtin_amdgcn_readfirstlane((v >> 5) & 7));
#else
            if (r != 15) p3_moba_static(ws, (char*)lds, bh, 15 - r, r == 14 ? 0 : -1);
#endif
        }
        SEAM(3);
    }
    if (IN(4)) { REFRESH_F(); const KA args = kargs();
#ifdef DN_NAIVE
        n2c_dn_gate(F, args, args.O(), (bf16*)(ws + WS_Y), 1024);
#else
        for (int it = F.vcu; it < 512; it += F.G)
            dn::chunk_out(F.lds, it, (const unsigned char*)args.O(), ws + WS_SF, ws + WS_VF, (const bf16*)(ws + WS_PJ + 3 * PJ_STRIDE), args.I(5), (bf16*)(ws + WS_Y));
#endif
#ifdef MB_QUEUE
        for (int it = F.vcu; it < MB_NSPLIT * 32; it += F.G) p4_moba_merge(ws, it, F.tid);
#endif
        SEAM(4); }
    if (IN(5)) { REFRESH_F();
        const KA args = kargs();
        pg8::Gemm g{(const bf16*)(ws + WS_Y), (const bf16*)(ws + WS_WOUT), M, DM, DM}; pg8::StaticOrder S; S.init(M, DM, F.G, (int)blockIdx.x);
#if defined(MOE_NAIVE)
        pg8::EpiF32 E{args.O(), DM};
        for (int rep_ = 0; rep_ < DUP_P5; ++rep_) pg8::gemm_phase<pg8::EpiF32, pg8::StaticOrder, PG8_ALIGN, PG8_SP2>(F.lds + RING_OFF, g, S, E);
#elif !defined(LN1_FUSE)
        pg8::EpiBf16<0> E{(bf16*)(ws + WS_MIXB), DM, nullptr, 0, 0, 1.f};
        pg8::gemm_phase<pg8::EpiBf16<0>, pg8::StaticOrder, PG8_ALIGN, PG8_SP2>(F.lds + RING_OFF, g, S, E);
#else
        if (F.G == 256) {
            pg8::PanelStats st{(unsigned*)(ws + WS_XBUF), (unsigned*)(ws + WS_CTL) + CW_SEAM, (unsigned*)(ws + WS_CTL), DM / 256, LN_EPS, 0x740u};
            pg8::EpiLn1 E{args.I(0), args.O(), (bf16*)(ws + WS_HB), args.I(7), args.I(8), ALPHA, st, 0u};
            pg8::gemm_phase<pg8::EpiLn1, pg8::StaticOrder, false, PG8_SP2>(F.lds + RING_OFF, g, S, E);
        }
#endif
        SEAM(5);
    }
#ifdef MOE_NAIVE
    if (IN(6)) { REFRESH_F(); const KA args = kargs(); n5_token_tail(F, args); }
#else
    if (IN(6)) { REFRESH_F(); const KA args = kargs(); p6_ln_router(F, args); SEAM(6); }
#ifdef MOE_PERMUTE
    if (IN(7)) { REFRESH_F(); for (int rep_ = 0; rep_ < DUP_P7; ++rep_) { const KA args = kargs(); p7_permute(F, args); __syncthreads(); } SEAM(7); }
#endif
    if (IN(8)) { REFRESH_F();
        LAS int* tb = (LAS int*)(F.lds + LDSCTL_OFF + 512); moe_tile_table(F, ws, tb);
#ifdef MOE_PERMUTE
        pg8::Gemm g{(const bf16*)(ws + WS_HS), (const bf16*)(ws + WS_WGU), 36864, 512, DM}; pg8::MoeOrder<false> S{(const LAS int*)tb, 2, F.G, (int)blockIdx.x, (size_t)512 * DM * 2, nullptr, nullptr};
#else
        pg8::Gemm g{(const bf16*)(ws + WS_HB), (const bf16*)(ws + WS_WGU), 36864, 512, DM}; pg8::MoeOrder<true> S{(const LAS int*)tb, 2, F.G, (int)blockIdx.x, (size_t)512 * DM * 2, (const int*)(ws + WS_LIST), (const unsigned*)(ws + WS_CTL) + CW_CNT};
#endif
        pg8::EpiSwiGLU E{(bf16*)(ws + WS_HE)};
        pg8::gemm_phase<pg8::EpiSwiGLU, decltype(S), PG8_ALIGN, PG8_SP2>(F.lds + RING_OFF, g, S, E);
        SEAM(8);
    }
    if (IN(9)) { REFRESH_F();
        LAS int* tb = (LAS int*)(F.lds + LDSCTL_OFF + 512); moe_tile_table(F, ws, tb);
        int kdim = DE; asm volatile("" : "+s"(kdim));
        pg8::Gemm g{(const bf16*)(ws + WS_HE), (const bf16*)(ws + WS_WD), 36864, DM, kdim}; pg8::MoeOrder<false> S{(const LAS int*)tb, 4, F.G, (int)blockIdx.x, (size_t)DM * DE * 2, nullptr, nullptr};
        pg8::EpiBf16<0> E{(bf16*)(ws + WS_Y2), DM, nullptr, 0, 0, 1.f};
        pg8::gemm_phase<pg8::EpiBf16<0>, pg8::MoeOrder<false>, PG8_ALIGN, PG8_SP2>(F.lds + RING_OFF, g, S, E);
        SEAM(9);
    }
    if (IN(10)) { REFRESH_F(); const KA args = kargs(); p10_combine(F, args); }
#endif
#undef IN
#undef SEAM
}

extern "C" void kernel_launch(void* const* d_in, const int* in_sizes, int n_in, void* d_out, int out_size, void* d_ws, size_t ws_size, hipStream_t stream) {
    static int grid = 0;
    if (grid == 0) {
        if (n_in != 18 || in_sizes[0] != M * DM || out_size != M * DM || ws_size < WS_END) { fprintf(stderr, "kernel_launch: unexpected shapes (n_in %d, in0 %d, out %d, ws %zu)\n", n_in, n_in > 0 ? in_sizes[0] : -1, out_size, ws_size); grid = -1; return; }
        int dev = 0, cus = 0;
        if (hipGetDevice(&dev) != hipSuccess || hipDeviceGetAttribute(&cus, hipDeviceAttributeMultiprocessorCount, dev) != hipSuccess) { grid = -1; return; }
        if (hipFuncSetAttribute((const void*)mk_fwd, hipFuncAttributeMaxDynamicSharedMemorySize, LDS_BYTES) != hipSuccess) { fprintf(stderr, "kernel_launch: hipFuncSetAttribute failed\n"); grid = -1; return; }
        int per_cu = 0;
        if (hipOccupancyMaxActiveBlocksPerMultiprocessor(&per_cu, (const void*)mk_fwd, NTHR, LDS_BYTES) != hipSuccess || per_cu < 1) fprintf(stderr, "kernel_launch: occupancy query says %d\n", per_cu);
        (void)hipGetLastError();
        grid = cus;
    }
    if (grid < 0) return;
    (void)hipMemsetAsync((char*)d_ws + WS_CTL, 0, CTL_ZERO_BYTES, stream);
    Args a{};
    for (int i = 0; i < 18; ++i) a.in_[i] = (const GAS float*)d_in[i];
    a.out_ = (GAS float*)d_out; a.ws_ = (GAS unsigned char*)d_ws;
#ifndef MK_PER_PHASE
    a.ph_lo = 0; a.ph_hi = N_PHASES;
    hipLaunchKernelGGL(mk_fwd, dim3(grid), dim3(NTHR), LDS_BYTES, stream, a);
#else
    for (int p = 0; p < N_PHASES; ++p) { a.ph_lo = p; a.ph_hi = p + 1; hipLaunchKernelGGL(mk_fwd, dim3(grid), dim3(NTHR), LDS_BYTES, stream, a); }
#endif
}
```

```cpp
#define MB_PIPE 1
#define MB_QUEUE 1
#define ROPE_EPI 1
#include <hip/hip_runtime.h>
#include <cstdio>
#include <cstdint>
#include <cstddef>
namespace pg8 {
#define PG8_LAS __attribute__((address_space(3)))
typedef unsigned short bf16_t;
typedef short bf16x8 __attribute__((ext_vector_type(8)));
typedef float f32x4 __attribute__((ext_vector_type(4)));
typedef unsigned u32x4 __attribute__((ext_vector_type(4)));
__device__ __forceinline__ void st16_wt(void* p, u32x4 v) {
#ifdef WT_STORES
    asm volatile("global_store_dwordx4 %0, %1, off sc1\n\ts_nop 1" :: "v"((__attribute__((address_space(1))) void*)p), "v"(v) : "memory");
#else
    *(u32x4*)p = v;
#endif
}
constexpr int BM = 256, BK = 64, HALF = 128, HTB = HALF * BK * 2  , STAGE_BYTES = 8 * HTB, NXCD = 8, WGM = 8;

__host__ __device__ __forceinline__ int lds_byte(int r, int c) { const int st = (r >> 4) * 2 + (c >> 5), rr = r & 15, cc = c & 31, ob = rr * 64 + cc * 2; return st * 1024 + (ob ^ (((ob >> 9) & 1) << 5)); }
__host__ __device__ __forceinline__ void stage_rc(int b, int& R, int& C) { const int st = b / 1024, sb = b % 1024, swz = sb ^ (((sb >> 9) & 1) << 5); R = (st >> 1) * 16 + swz / 64; C = (st & 1) * 32 + (swz % 64) / 2; }
__host__ __device__ __forceinline__ int perm32(int rho) { const int n = rho >> 4, i = rho & 15; return 8 * (i >> 2) + 4 * n + (i & 3); }

struct Unit { int pm, pn; };
struct Gemm { const bf16_t* A; const bf16_t* Bt; int M, N, K; };

struct StaticOrder {
    int nM, nN, nwg, G, c;
    __host__ __device__ void init(int M, int N, int G_, int c_) { nM = M / BM; nN = N / BM; nwg = nM * nN; G = G_; c = c_; }
    __host__ __device__ bool next(int i, Unit& u) const {
        const long L = (long)i * G + c; if (L >= nwg) return false;
        int wgid = (int)L; { const int q = nwg / NXCD, r = nwg % NXCD, xcd = wgid % NXCD, off = wgid / NXCD; wgid = (xcd < r ? xcd * (q + 1) : r * (q + 1) + (xcd - r) * q) + off; }
        const int nig = WGM * nN, gid = wgid / nig, fm = gid * WGM, gsz = (nM - fm) < WGM ? (nM - fm) : WGM;
        u.pm = fm + ((wgid % nig) % gsz); u.pn = (wgid % nig) / gsz; return true;
    }
    __device__ __forceinline__ void a_ready(const Unit&) const {}
    __device__ __forceinline__ void done(const Unit&) const {}
    __device__ __forceinline__ size_t bofs(const Unit&) const { return 0; }
    static constexpr bool GATHER = false;
    __device__ __forceinline__ int arow(const Unit&, int) const { return 0; }
};

__device__ __forceinline__ unsigned cvt_pk_bf16(float lo, float hi) { unsigned r; asm volatile("v_cvt_pk_bf16_f32 %0, %1, %2" : "=v"(r) : "v"(lo), "v"(hi)); return r; }
typedef float f32x2 __attribute__((ext_vector_type(2)));
__device__ __forceinline__ f32x2 gelu_pk(f32x2 v) {
    const f32x2 av = __builtin_elementwise_abs(v), d = av * 0.2316418882f + 1.0f;
    f32x2 t; t.x = __builtin_amdgcn_rcpf(d.x); t.y = __builtin_amdgcn_rcpf(d.y);
    f32x2 q = t * 0.5307027145f + (-0.7265760135f); q = q * t + 0.7107068705f; q = q * t + (-0.142248368f); q = q * t + 0.127414796f; q = q * t;
    const f32x2 s = (v * v) * (-0.72134752044f);
    f32x2 e; e.x = __builtin_amdgcn_exp2f(s.x); e.y = __builtin_amdgcn_exp2f(s.y);
    const f32x2 m = v * (q * e), r = v - m;
    f32x2 o; o.x = v.x < 0.f ? m.x : r.x; o.y = v.y < 0.f ? m.y : r.y; return o;
}

template <int ACT  > struct EpiBf16 {
    static constexpr bool PERM = true, AFTER_DRAIN = false; static_assert(ACT == 0 || ACT == 1, "EpiBf16: ACT is 0 (none) or 1 (gelu_pk)");
    bf16_t* O; int ldc; const float* bias; int split_cols; size_t split_stride; float scale0;
    __device__ __forceinline__ void operator()(const f32x4 (&acc)[2][2][4][2], const Unit& u, int wr, int wc, int fr, int fq) const {
        const int row0 = u.pm * BM + wr * 64 + fr; int colt = u.pn * BM; bf16_t* base = O;
        float sc = 1.f; if (split_cols) { const int t = colt / split_cols; base += (size_t)t * split_stride; colt -= t * split_cols; if (t == 0) sc = scale0; }
        const int col0 = colt + wc * 32 + 8 * fq, bcol0 = u.pn * BM + wc * 32 + 8 * fq;
        f32x4 bv[2][2];
#pragma unroll
        for (int bj = 0; bj < 2; ++bj)
#pragma unroll
            for (int n = 0; n < 2; ++n) bv[bj][n] = bias ? *(const f32x4*)(bias + bcol0 + bj * HALF + 4 * n) : (f32x4){0.f, 0.f, 0.f, 0.f};
#pragma unroll
        for (int ai = 0; ai < 2; ++ai)
#pragma unroll
            for (int m = 0; m < 4; ++m) { bf16_t* rowp = base + (size_t)(row0 + ai * HALF + m * 16) * ldc + col0;
#pragma unroll
                for (int bj = 0; bj < 2; ++bj) { f32x4 v0 = acc[ai][bj][m][0] + bv[bj][0], v1 = acc[ai][bj][m][1] + bv[bj][1];
                    if (ACT == 1) { f32x2 a = gelu_pk((f32x2){v0[0], v0[1]}), b = gelu_pk((f32x2){v0[2], v0[3]}), c = gelu_pk((f32x2){v1[0], v1[1]}), d = gelu_pk((f32x2){v1[2], v1[3]});
                        v0 = (f32x4){a.x, a.y, b.x, b.y}; v1 = (f32x4){c.x, c.y, d.x, d.y}; }
                    v0 = v0 * sc; v1 = v1 * sc; u32x4 w; w.x = cvt_pk_bf16(v0[0], v0[1]); w.y = cvt_pk_bf16(v0[2], v0[3]); w.z = cvt_pk_bf16(v1[0], v1[1]); w.w = cvt_pk_bf16(v1[2], v1[3]);
                    st16_wt(rowp + bj * HALF, w); } }
    }
};

struct PanelStats {
    unsigned* xbuf;
    unsigned* cnt;
    unsigned* tmo;
    int ntn; float eps;
    unsigned code;
    __device__ __forceinline__ bool run(const f32x4 (&v)[2][2][4][2], const Unit& u, int wr, int wc, int fr, int fq, PG8_LAS unsigned char* lds, int wid, int lane) const {
        typedef float f32x2v __attribute__((ext_vector_type(2)));
        PG8_LAS f32x2v* P = (PG8_LAS f32x2v*)lds;
        PG8_LAS f32x2v* S = (PG8_LAS f32x2v*)(lds + 8192);
        PG8_LAS unsigned* flag = (PG8_LAS unsigned*)(lds + 8192 + 2048);
#pragma unroll
        for (int ai = 0; ai < 2; ++ai)
#pragma unroll
            for (int m = 0; m < 4; ++m) {
                float s = 0.f;
#pragma unroll
                for (int bj = 0; bj < 2; ++bj)
#pragma unroll
                    for (int n = 0; n < 2; ++n) { const f32x4 x = v[ai][bj][m][n]; s += (x[0] + x[1]) + (x[2] + x[3]); }
                s += __shfl_xor(s, 16); s += __shfl_xor(s, 32);
                const float mw = s * (1.0f / 64.0f); float q = 0.f;
#pragma unroll
                for (int bj = 0; bj < 2; ++bj)
#pragma unroll
                    for (int n = 0; n < 2; ++n) { const f32x4 d = v[ai][bj][m][n] - mw; q += (d[0] * d[0] + d[1] * d[1]) + (d[2] * d[2] + d[3] * d[3]); }
                q += __shfl_xor(q, 16); q += __shfl_xor(q, 32);
                if (fq == 0) P[(ai * HALF + wr * 64 + m * 16 + fr) * 4 + wc] = (f32x2v){mw, q};
            }
        asm volatile("s_waitcnt lgkmcnt(0)" ::: "memory"); __builtin_amdgcn_s_barrier(); asm volatile("" ::: "memory");
#if defined(BROKEN_EXCHANGE_NO_WAIT)
#warning BROKEN CONTROL BUILD: the row-statistics exchange does not wait; results are wrong by design
        if (blockIdx.x >= 64) { const long long t0_ = clock64(); while (clock64() - t0_ < 60000) __builtin_amdgcn_s_sleep(8); }
#endif
        const int row = wid * 32 + (lane & 31);
        if (lane < 32) {
            const f32x2v a = P[row * 4 + 0], b = P[row * 4 + 1], c = P[row * 4 + 2], d = P[row * 4 + 3];
            const float mt = (a.x + b.x + c.x + d.x) * 0.25f;
            const float da = a.x - mt, db = b.x - mt, dc = c.x - mt, dd = d.x - mt;
            const float m2 = (a.y + b.y) + (c.y + d.y) + 64.0f * ((da * da + db * db) + (dc * dc + dd * dd));
            unsigned long long* slot = (unsigned long long*)xbuf + ((size_t)(u.pm * BM + row) * 4 + u.pn);
            __hip_atomic_store(slot, ((unsigned long long)__float_as_uint(m2) << 32) | __float_as_uint(mt), __ATOMIC_RELAXED, __HIP_MEMORY_SCOPE_AGENT);
        }
        asm volatile("s_waitcnt vmcnt(0)" ::: "memory");
        if (lane == 0) __hip_atomic_fetch_add(cnt + 64 * u.pm, 1u, __ATOMIC_RELAXED, __HIP_MEMORY_SCOPE_AGENT);
        if (wid == 0) {
            bool dead = false; const unsigned long long t0 = __builtin_amdgcn_s_memrealtime(); const unsigned want = 8u * (unsigned)ntn;
            for (;;) {
#if defined(BROKEN_EXCHANGE_NO_WAIT)
                break;
#endif
                if ((unsigned)__builtin_amdgcn_readfirstlane(__hip_atomic_load(cnt + 64 * u.pm, __ATOMIC_RELAXED, __HIP_MEMORY_SCOPE_AGENT)) >= want) break;
                if (__builtin_amdgcn_s_memrealtime() - t0 > 2000000ull) {
                    if (lane == 0) { unsigned expect = 0u; __hip_atomic_compare_exchange_strong(tmo + 1, &expect, code | (unsigned)(u.pm & 0xff), __ATOMIC_RELAXED, __ATOMIC_RELAXED, __HIP_MEMORY_SCOPE_AGENT);
                                     __hip_atomic_store(tmo, 1u, __ATOMIC_RELAXED, __HIP_MEMORY_SCOPE_AGENT); }
                    dead = true; break; }
                __builtin_amdgcn_s_sleep(2);
            }
            __builtin_amdgcn_fence(__ATOMIC_ACQUIRE, "agent");
            if (lane == 0) flag[0] = dead ? 1u : 0u;
        }
        asm volatile("s_waitcnt vmcnt(0) lgkmcnt(0)" ::: "memory"); __builtin_amdgcn_s_barrier(); asm volatile("" ::: "memory");
        const bool bad = flag[0] != 0u;
        if (lane < 32) {
            const unsigned long long* slot = (const unsigned long long*)xbuf + (size_t)(u.pm * BM + row) * 4; float mt[4], m2[4]; float ms = 0.f;
#pragma unroll
            for (int t = 0; t < 4; ++t) { if (t < ntn) { const unsigned long long w = __hip_atomic_load(slot + t, __ATOMIC_RELAXED, __HIP_MEMORY_SCOPE_AGENT); mt[t] = __uint_as_float((unsigned)w); m2[t] = __uint_as_float((unsigned)(w >> 32)); } else { mt[t] = 0.f; m2[t] = 0.f; } ms += mt[t]; }
            const float mean = ms / (float)ntn; float q = 0.f;
#pragma unroll
            for (int t = 0; t < 4; ++t) if (t < ntn) { const float dm = mt[t] - mean; q += m2[t] + 256.0f * dm * dm; }
            S[row] = (f32x2v){mean, 1.0f / sqrtf(q / (256.0f * (float)ntn) + eps)};
        }
        asm volatile("s_waitcnt lgkmcnt(0)" ::: "memory"); __builtin_amdgcn_s_barrier(); asm volatile("" ::: "memory");
        return bad;
    }
};
struct EpiLnRes {
    static constexpr bool PERM = false, AFTER_DRAIN = true;
    const float* base; float* out; int ldc; const float* bias; PanelStats st; unsigned poison;
    __device__ __forceinline__ void fused(f32x4 (&acc)[2][2][4][2], const Unit& u, int wr, int wc, int fr, int fq, PG8_LAS unsigned char* lds, int wid, int lane) const {
        typedef float f32x2v __attribute__((ext_vector_type(2)));
        const PG8_LAS f32x2v* S = (const PG8_LAS f32x2v*)(lds + 8192);
        const int col0 = u.pn * BM + wc * 32 + 4 * fq;
#pragma unroll
        for (int bj = 0; bj < 2; ++bj)
#pragma unroll
            for (int n = 0; n < 2; ++n) { const f32x4 bv = bias ? *(const f32x4*)(bias + col0 + bj * HALF + n * 16) : (f32x4){0.f, 0.f, 0.f, 0.f};
#pragma unroll
                for (int ai = 0; ai < 2; ++ai)
#pragma unroll
                    for (int m = 0; m < 4; ++m) acc[ai][bj][m][n] += bv; }
        f32x4 pre[4][2][2];
#pragma unroll
        for (int m = 0; m < 4; ++m) { const size_t off = (size_t)(u.pm * BM + wr * 64 + m * 16 + fr) * ldc + col0;
#pragma unroll
            for (int bj = 0; bj < 2; ++bj)
#pragma unroll
                for (int n = 0; n < 2; ++n) pre[m][bj][n] = *(const f32x4*)(base + off + bj * HALF + n * 16); }
        const bool bad = st.run(acc, u, wr, wc, fr, fq, lds, wid, lane) || poison != 0u;
        const float qnan = __builtin_nanf("");
#pragma unroll
        for (int ai = 0; ai < 2; ++ai)
#pragma unroll
            for (int m = 0; m < 4; ++m) { const int r = ai * HALF + wr * 64 + m * 16 + fr; const f32x2v sr = S[r]; const size_t off = (size_t)(u.pm * BM + r) * ldc + col0;
#pragma unroll
                for (int bj = 0; bj < 2; ++bj)
#pragma unroll
                    for (int n = 0; n < 2; ++n) { const f32x4 bs = ai == 0 ? pre[m][bj][n] : *(const f32x4*)(base + off + bj * HALF + n * 16); f32x4 o = bs + (acc[ai][bj][m][n] - sr.x) * sr.y;
                        if (bad) o = (f32x4){qnan, qnan, qnan, qnan}; *(f32x4*)(out + off + bj * HALF + n * 16) = o; }
                if (m & 1) asm volatile("" ::: "memory"); }
    }
};
struct EpiLnResLn {
    static constexpr bool PERM = false, AFTER_DRAIN = true;
    const float* base; float* out; bf16_t* xn; int ldc; const float* bias; PanelStats st1, st2; unsigned poison;
    __device__ __forceinline__ void fused(f32x4 (&acc)[2][2][4][2], const Unit& u, int wr, int wc, int fr, int fq, PG8_LAS unsigned char* lds, int wid, int lane) const {
        typedef float f32x2v __attribute__((ext_vector_type(2))); typedef unsigned u32x2v __attribute__((ext_vector_type(2)));
        const PG8_LAS f32x2v* S = (const PG8_LAS f32x2v*)(lds + 8192);
        const int col0 = u.pn * BM + wc * 32 + 4 * fq;
#pragma unroll
        for (int bj = 0; bj < 2; ++bj)
#pragma unroll
            for (int n = 0; n < 2; ++n) { const f32x4 bv = bias ? *(const f32x4*)(bias + col0 + bj * HALF + n * 16) : (f32x4){0.f, 0.f, 0.f, 0.f};
#pragma unroll
                for (int ai = 0; ai < 2; ++ai)
#pragma unroll
                    for (int m = 0; m < 4; ++m) acc[ai][bj][m][n] += bv; }
        bool bad = st1.run(acc, u, wr, wc, fr, fq, lds, wid, lane) || poison != 0u;
        const float qnan = __builtin_nanf("");
#pragma unroll
        for (int ai = 0; ai < 2; ++ai)
#pragma unroll
            for (int m = 0; m < 4; ++m) { const int r = ai * HALF + wr * 64 + m * 16 + fr; const f32x2v sr = S[r]; const size_t off = (size_t)(u.pm * BM + r) * ldc + col0;
#pragma unroll
                for (int bj = 0; bj < 2; ++bj)
#pragma unroll
                    for (int n = 0; n < 2; ++n) { const f32x4 bs = *(const f32x4*)(base + off + bj * HALF + n * 16); acc[ai][bj][m][n] = bs + (acc[ai][bj][m][n] - sr.x) * sr.y; }
                asm volatile("" : "+v"(acc[ai][0][m][0]), "+v"(acc[ai][0][m][1]), "+v"(acc[ai][1][m][0]), "+v"(acc[ai][1][m][1]));
                if (m & 1) asm volatile("" ::: "memory"); }
        const bool bad1 = bad;
        bad = st2.run(acc, u, wr, wc, fr, fq, lds, wid, lane) || bad;
#pragma unroll
        for (int ai = 0; ai < 2; ++ai)
#pragma unroll
            for (int m = 0; m < 4; ++m) { const int r = ai * HALF + wr * 64 + m * 16 + fr; const f32x2v sr = S[r]; const size_t off = (size_t)(u.pm * BM + r) * ldc + col0;
#pragma unroll
                for (int bj = 0; bj < 2; ++bj)
#pragma unroll
                    for (int n = 0; n < 2; ++n) { const f32x4 x1 = acc[ai][bj][m][n]; *(f32x4*)(out + off + bj * HALF + n * 16) = bad1 ? (f32x4){qnan, qnan, qnan, qnan} : x1;
                        const f32x4 o = (x1 - sr.x) * sr.y; u32x2v w; w.x = cvt_pk_bf16(o[0], o[1]); w.y = cvt_pk_bf16(o[2], o[3]);
                        if (bad) { w.x = 0x7fc07fc0u; w.y = 0x7fc07fc0u; } *(u32x2v*)(xn + off + bj * HALF + n * 16) = w; }
                asm volatile("" ::: "memory"); }
    }
};

template <class Epi, class Sched, bool ALIGN_EPI = false, bool SP2 = false>
__device__ __forceinline__ void gemm_phase(PG8_LAS unsigned char* lds, const Gemm g, const Sched& S, const Epi& E) {
    const int tid = threadIdx.x, wid = __builtin_amdgcn_readfirstlane(tid >> 6), lane = tid & 63, wr = wid >> 2, wc = wid & 3, fr = lane & 15, fq = lane >> 4;
    const int K = g.K, nt = K / BK;
    unsigned voffA[2], voffB[2];
    unsigned cvo[2][2], nvo[2][2];
    int RA[2], CA[2];
#pragma unroll
    for (int i = 0; i < 2; ++i) { int R, C; stage_rc(tid * 16 + i * 8192, R, C); const int Rb = Epi::PERM ? ((R & ~31) + perm32(R & 31)) : R;
        voffA[i] = (unsigned)(R * K + C) * 2u; voffB[i] = (unsigned)(Rb * K + C) * 2u; RA[i] = R; CA[i] = C; }
    const size_t kstep = (size_t)(BK * 2);
    const size_t hstep = (size_t)HALF * K * 2;
    const size_t tstep = 2 * hstep;
    constexpr bool GATHER = Sched::GATHER;
    const size_t hstepA = GATHER ? 0 : hstep, tstepA = GATHER ? 0 : tstep;
#define PG8_VOA(h, nx) (GATHER ? ((nx) ? nvo[h] : cvo[h]) : voffA)
#define PG8_GOFFS(dst, u) do { _Pragma("unroll") for (int h_ = 0; h_ < 2; ++h_) _Pragma("unroll") for (int i_ = 0; i_ < 2; ++i_) dst[h_][i_] = (unsigned)((size_t)S.arow(u, h_ * HALF + RA[i_]) * K + CA[i_]) * 2u; } while (0)
    const unsigned ldsw = (unsigned)wid * 1024u;
    const int aoff = lds_byte(wr * 64 + fr, fq * 8), boff = lds_byte(wc * 32 + fr, fq * 8);
#define PG8_SA(b, h) (((b) * 2 + (h)) * HTB)
#define PG8_SB(b, h) ((4 + (b) * 2 + (h)) * HTB)
#define PG8_STAGE(bufoff, gbase, voff) do { _Pragma("unroll") for (int _i = 0; _i < 2; ++_i) \
        __builtin_amdgcn_global_load_lds((const unsigned*)((const char*)(gbase) + (voff)[_i]), (PG8_LAS unsigned*)(lds + (bufoff) + ldsw + _i * 8192), 16, 0, 0); } while (0)
#define PG8_LDA(dst, b, h) do { _Pragma("unroll") for (int m = 0; m < 4; ++m) _Pragma("unroll") for (int k = 0; k < 2; ++k) dst[m][k] = *(const PG8_LAS bf16x8*)(lds + PG8_SA(b, h) + aoff + m * 2048 + k * 1024); } while (0)
#define PG8_LDB(dst, b, h) do { _Pragma("unroll") for (int n = 0; n < 2; ++n) _Pragma("unroll") for (int k = 0; k < 2; ++k) dst[n][k] = *(const PG8_LAS bf16x8*)(lds + PG8_SB(b, h) + boff + n * 2048 + k * 1024); } while (0)
#define PG8_MMA(ai, bj, At, Bt) do { __builtin_amdgcn_s_setprio(1); _Pragma("unroll") for (int m = 0; m < 4; ++m) _Pragma("unroll") for (int n = 0; n < 2; ++n) _Pragma("unroll") for (int k = 0; k < 2; ++k) \
        acc[ai][bj][m][n] = __builtin_amdgcn_mfma_f32_16x16x32_bf16(Bt[n][k], At[m][k], acc[ai][bj][m][n], 0, 0, 0); __builtin_amdgcn_s_setprio(0); } while (0)
#define PG8_WAIT_V(n) asm volatile("s_waitcnt vmcnt(" #n ")" ::: "memory")
#define PG8_WAIT_L(n) asm volatile("s_waitcnt lgkmcnt(" #n ")" ::: "memory")
#define PG8_BAR __builtin_amdgcn_s_barrier()
#define PG8_SCHED __builtin_amdgcn_sched_barrier(0)
    Unit cur, nxt; int ui = 0;
    if (!S.next(0, cur)) return;
    f32x4 acc[2][2][4][2];
#pragma unroll
    for (int a = 0; a < 2; ++a)
#pragma unroll
        for (int b = 0; b < 2; ++b)
#pragma unroll
            for (int m = 0; m < 4; ++m)
#pragma unroll
                for (int n = 0; n < 2; ++n) acc[a][b][m][n] = (f32x4){0.f, 0.f, 0.f, 0.f};
    bf16x8 At[4][2], B0[2][2], B1[2][2];
    const char* cA = (const char*)g.A + (size_t)cur.pm * tstepA; const char* cB = (const char*)g.Bt + S.bofs(cur) + (size_t)cur.pn * tstep;
    if constexpr (GATHER) { PG8_GOFFS(cvo, cur); Unit u1_; if (S.next(1, u1_)) PG8_GOFFS(nvo, u1_); else { _Pragma("unroll") for (int h_ = 0; h_ < 2; ++h_) _Pragma("unroll") for (int i_ = 0; i_ < 2; ++i_) nvo[h_][i_] = cvo[h_][i_]; } }
    S.a_ready(cur);
    if constexpr (SP2) {
        PG8_STAGE(PG8_SB(0, 0), cB, voffB); PG8_STAGE(PG8_SB(0, 1), cB + hstep, voffB); PG8_STAGE(PG8_SA(0, 0), cA, PG8_VOA(0, false)); PG8_STAGE(PG8_SA(0, 1), cA + hstepA, PG8_VOA(1, false));
        if (wr == 1) PG8_BAR;
        PG8_WAIT_V(2); PG8_BAR;
        PG8_STAGE(PG8_SB(1, 0), cB + kstep, voffB); PG8_STAGE(PG8_SA(1, 0), cA + kstep, PG8_VOA(0, false)); PG8_STAGE(PG8_SB(1, 1), cB + hstep + kstep, voffB);
        PG8_WAIT_V(6); PG8_BAR;
    } else {
        PG8_STAGE(PG8_SB(0, 0), cB, voffB); PG8_STAGE(PG8_SA(0, 0), cA, PG8_VOA(0, false)); PG8_STAGE(PG8_SB(0, 1), cB + hstep, voffB); PG8_STAGE(PG8_SA(0, 1), cA + hstepA, PG8_VOA(1, false));
        if (wr == 1) PG8_BAR;
        PG8_WAIT_V(4); PG8_BAR;
        PG8_STAGE(PG8_SB(1, 0), cB + kstep, voffB); PG8_STAGE(PG8_SA(1, 0), cA + kstep, PG8_VOA(0, false)); PG8_STAGE(PG8_SB(1, 1), cB + hstep + kstep, voffB);
        PG8_WAIT_V(6); PG8_BAR;
    }
    for (;;) {
        const bool has_next = S.next(ui + 1, nxt);
        const char* nA = has_next ? (const char*)g.A + (size_t)nxt.pm * tstepA : cA;
        if constexpr (GATHER) { if (ui > 0) { if (has_next) PG8_GOFFS(nvo, nxt); else { _Pragma("unroll") for (int h_ = 0; h_ < 2; ++h_) _Pragma("unroll") for (int i_ = 0; i_ < 2; ++i_) nvo[h_][i_] = cvo[h_][i_]; } } } const char* nB = has_next ? (const char*)g.Bt + S.bofs(nxt) + (size_t)nxt.pn * tstep : cB;
        for (int t = 0; t < nt; t += 2) {
            const bool last = (t == nt - 2);
            const char* a1 = cA + (size_t)(t + 1) * kstep;
            const char* a2 = last ? nA : cA + (size_t)(t + 2) * kstep; const char* b2 = last ? nB : cB + (size_t)(t + 2) * kstep;
            const char* a3 = a2 + kstep; const char* b3 = b2 + kstep;
            if (last && has_next) S.a_ready(nxt);
            if constexpr (SP2) {
            PG8_LDB(B0, 0, 0); PG8_LDB(B1, 0, 1); PG8_SCHED; PG8_LDA(At, 0, 0); PG8_STAGE(PG8_SA(1, 1), a1 + hstepA, PG8_VOA(1, false));
            PG8_WAIT_V(8); PG8_WAIT_L(0); PG8_BAR; PG8_MMA(0, 0, At, B0); PG8_MMA(0, 1, At, B1); PG8_BAR; PG8_SCHED;
            PG8_LDA(At, 0, 1); PG8_STAGE(PG8_SB(0, 0), b2, voffB); PG8_STAGE(PG8_SB(0, 1), b2 + hstep, voffB); PG8_STAGE(PG8_SA(0, 0), a2, PG8_VOA(0, last));
            PG8_WAIT_V(8); PG8_WAIT_L(0); PG8_BAR; PG8_MMA(1, 0, At, B0); PG8_MMA(1, 1, At, B1); PG8_BAR; PG8_SCHED;
            PG8_LDB(B0, 1, 0); PG8_LDB(B1, 1, 1); PG8_SCHED; PG8_LDA(At, 1, 0); PG8_STAGE(PG8_SA(0, 1), a2 + hstepA, PG8_VOA(1, last));
            PG8_WAIT_V(8); PG8_WAIT_L(0); PG8_BAR; PG8_MMA(0, 0, At, B0); PG8_MMA(0, 1, At, B1); PG8_BAR; PG8_SCHED;
            PG8_LDA(At, 1, 1); PG8_STAGE(PG8_SB(1, 0), b3, voffB); PG8_STAGE(PG8_SB(1, 1), b3 + hstep, voffB); PG8_STAGE(PG8_SA(1, 0), a3, PG8_VOA(0, last));
            PG8_WAIT_V(8); PG8_WAIT_L(0); PG8_BAR; PG8_MMA(1, 0, At, B0); PG8_MMA(1, 1, At, B1); PG8_BAR; PG8_SCHED;
            } else {
            PG8_LDB(B0, 0, 0); PG8_SCHED; PG8_LDA(At, 0, 0); PG8_STAGE(PG8_SA(1, 1), a1 + hstepA, PG8_VOA(1, false));
            PG8_WAIT_L(8); PG8_BAR; PG8_WAIT_L(0); PG8_MMA(0, 0, At, B0); PG8_BAR; PG8_SCHED;
            PG8_LDB(B1, 0, 1); PG8_STAGE(PG8_SB(0, 0), b2, voffB);
            PG8_BAR; PG8_WAIT_L(0); PG8_MMA(0, 1, At, B1); PG8_BAR;
            PG8_LDA(At, 0, 1); PG8_STAGE(PG8_SA(0, 0), a2, PG8_VOA(0, last));
            PG8_BAR; PG8_WAIT_L(0); PG8_MMA(1, 0, At, B0); PG8_BAR; PG8_SCHED;
            PG8_STAGE(PG8_SB(0, 1), b2 + hstep, voffB);
            PG8_WAIT_V(6); PG8_BAR; PG8_MMA(1, 1, At, B1); PG8_BAR;
            PG8_LDB(B0, 1, 0); PG8_SCHED; PG8_LDA(At, 1, 0); PG8_STAGE(PG8_SA(0, 1), a2 + hstepA, PG8_VOA(1, last));
            PG8_WAIT_L(8); PG8_BAR; PG8_WAIT_L(0); PG8_MMA(0, 0, At, B0); PG8_BAR; PG8_SCHED;
            PG8_LDB(B1, 1, 1); PG8_STAGE(PG8_SB(1, 0), b3, voffB);
            PG8_BAR; PG8_WAIT_L(0); PG8_MMA(0, 1, At, B1); PG8_BAR;
            PG8_LDA(At, 1, 1); PG8_STAGE(PG8_SA(1, 0), a3, PG8_VOA(0, last));
            PG8_BAR; PG8_WAIT_L(0); PG8_MMA(1, 0, At, B0); PG8_BAR; PG8_SCHED;
            PG8_STAGE(PG8_SB(1, 1), b3 + hstep, voffB);
            PG8_WAIT_V(6); PG8_BAR; PG8_MMA(1, 1, At, B1); PG8_BAR;
            }
        }
        if constexpr (ALIGN_EPI) { if (wr == 0) PG8_BAR; }
        if constexpr (!Epi::AFTER_DRAIN) { E(acc, cur, wr, wc, fr, fq); S.done(cur); }
        if (!has_next) break;
#pragma unroll
        for (int a = 0; a < 2; ++a)
#pragma unroll
            for (int b = 0; b < 2; ++b)
#pragma unroll
                for (int m = 0; m < 4; ++m)
#pragma unroll
                    for (int n = 0; n < 2; ++n) acc[a][b][m][n] = (f32x4){0.f, 0.f, 0.f, 0.f};
        cur = nxt; cA = nA; cB = nB; ++ui;
        if constexpr (GATHER) { _Pragma("unroll") for (int h_ = 0; h_ < 2; ++h_) _Pragma("unroll") for (int i_ = 0; i_ < 2; ++i_) cvo[h_][i_] = nvo[h_][i_]; }
        if constexpr (ALIGN_EPI) { if (wr == 1) PG8_BAR; }
    }
    PG8_WAIT_V(0);
    if constexpr (!ALIGN_EPI) { if (wr == 0) PG8_BAR; }
    PG8_BAR;
    if constexpr (Epi::AFTER_DRAIN) { E.fused(acc, cur, wr, wc, fr, fq, lds, wid, lane); S.done(cur); }
#undef PG8_SA
#undef PG8_VOA
#undef PG8_GOFFS
#undef PG8_SB
#undef PG8_STAGE
#undef PG8_LDA
#undef PG8_LDB
#undef PG8_MMA
#undef PG8_WAIT_V
#undef PG8_WAIT_L
#undef PG8_BAR
#undef PG8_SCHED
}
}

#ifndef PG8_SP2
#define PG8_SP2 true
#endif
#ifndef PG8_ALIGN
#define PG8_ALIGN true
#endif
namespace pg8 {
struct EpiF32 {
    static constexpr bool PERM = false, AFTER_DRAIN = false;
    float* O; int ldc;
    __device__ __forceinline__ void operator()(const f32x4 (&acc)[2][2][4][2], const Unit& u, int wr, int wc, int fr, int fq) const {
        const int row0 = u.pm * BM + wr * 64 + fr, col0 = u.pn * BM + wc * 32 + 4 * fq;
#pragma unroll
        for (int ai = 0; ai < 2; ++ai)
#pragma unroll
            for (int m = 0; m < 4; ++m) { float* rowp = O + (size_t)(row0 + ai * HALF + m * 16) * ldc + col0;
#pragma unroll
                for (int bj = 0; bj < 2; ++bj)
#pragma unroll
                    for (int n = 0; n < 2; ++n) *(f32x4*)(rowp + bj * HALF + n * 16) = acc[ai][bj][m][n]; }
    }
};
template <bool GATHER_> struct MoeOrder {
    const PG8_LAS int* tb; int ncol, G, c; size_t estride; const int* list; const unsigned* cnt;
    static constexpr bool GATHER = GATHER_;
    __device__ __forceinline__ int arow(const Unit& u, int r) const { int e = 0;
#pragma unroll
        for (int k = 1; k < 16; ++k) e += (u.pm >= tb[k]) ? 1 : 0;
        const int pos = (u.pm - tb[e]) * 256 + r; return pos < (int)cnt[e] ? list[e * 16384 + pos] : 0; }
    __device__ __forceinline__ bool next(int i, Unit& u) const { const int L = i * G + c, t = L / ncol; if (t >= __builtin_amdgcn_readfirstlane(tb[17])) return false; u.pm = __builtin_amdgcn_readfirstlane(tb[18 + t]); u.pn = L - t * ncol; return true; }
    __device__ __forceinline__ void a_ready(const Unit&) const {}
    __device__ __forceinline__ void done(const Unit&) const {}
    __device__ __forceinline__ size_t bofs(const Unit& u) const { int e = 0;
#pragma unroll
        for (int k = 1; k < 16; ++k) e += (u.pm >= tb[k]) ? 1 : 0;
        return (size_t)__builtin_amdgcn_readfirstlane(e) * estride; }
};
struct EpiSwiGLU {
    static constexpr bool PERM = true, AFTER_DRAIN = false;
    bf16_t* O;
    __device__ __forceinline__ void operator()(const f32x4 (&acc)[2][2][4][2], const Unit& u, int wr, int wc, int fr, int fq) const {
        const int row0 = u.pm * BM + wr * 64 + fr, col0 = u.pn * 128 + wc * 32 + 8 * fq;
#pragma unroll
        for (int ai = 0; ai < 2; ++ai)
#pragma unroll
            for (int m = 0; m < 4; ++m) { bf16_t* rowp = O + (size_t)(row0 + ai * HALF + m * 16) * 256 + col0;
                f32x4 v[2];
#pragma unroll
                for (int n = 0; n < 2; ++n)
#pragma unroll
                    for (int e = 0; e < 4; ++e) { const float gt = acc[ai][0][m][n][e]; v[n][e] = gt / (1.f + __expf(-gt)) * acc[ai][1][m][n][e]; }
                u32x4 w; w.x = cvt_pk_bf16(v[0][0], v[0][1]); w.y = cvt_pk_bf16(v[0][2], v[0][3]); w.z = cvt_pk_bf16(v[1][0], v[1][1]); w.w = cvt_pk_bf16(v[1][2], v[1][3]);
                st16_wt(rowp, w); }
    }
};
struct EpiLn1 {
    static constexpr bool PERM = false, AFTER_DRAIN = true;
    const float* x; float* hout; bf16_t* hb; const float* gam; const float* bet; float alpha; PanelStats st; unsigned poison;
    __device__ __forceinline__ void fused(f32x4 (&acc)[2][2][4][2], const Unit& u, int wr, int wc, int fr, int fq, PG8_LAS unsigned char* lds, int wid, int lane) const {
        typedef float f32x2v __attribute__((ext_vector_type(2))); typedef unsigned u32x2v __attribute__((ext_vector_type(2)));
        const PG8_LAS f32x2v* S = (const PG8_LAS f32x2v*)(lds + 8192);
        const int col0 = u.pn * BM + wc * 32 + 4 * fq, ldc = 1024;
#pragma unroll
        for (int ai = 0; ai < 2; ++ai)
#pragma unroll
            for (int m = 0; m < 4; ++m) { const size_t off = (size_t)(u.pm * BM + ai * HALF + wr * 64 + m * 16 + fr) * ldc + col0;
#pragma unroll
                for (int bj = 0; bj < 2; ++bj)
#pragma unroll
                    for (int n = 0; n < 2; ++n) { const f32x4 xv = *(const f32x4*)(x + off + bj * HALF + n * 16); acc[ai][bj][m][n] = xv * alpha + acc[ai][bj][m][n]; }
                asm volatile("" : "+v"(acc[ai][0][m][0]), "+v"(acc[ai][0][m][1]), "+v"(acc[ai][1][m][0]), "+v"(acc[ai][1][m][1]));
                if (m & 1) asm volatile("" ::: "memory"); }
        const bool bad = st.run(acc, u, wr, wc, fr, fq, lds, wid, lane) || poison != 0u;
        const float qnan = __builtin_nanf("");
        f32x4 gv[2][2], bv[2][2];
#pragma unroll
        for (int bj = 0; bj < 2; ++bj)
#pragma unroll
            for (int n = 0; n < 2; ++n) { gv[bj][n] = *(const f32x4*)(gam + col0 + bj * HALF + n * 16); bv[bj][n] = *(const f32x4*)(bet + col0 + bj * HALF + n * 16); }
#pragma unroll
        for (int ai = 0; ai < 2; ++ai)
#pragma unroll
            for (int m = 0; m < 4; ++m) { const int r = ai * HALF + wr * 64 + m * 16 + fr; const f32x2v sr = S[r]; const size_t off = (size_t)(u.pm * BM + r) * ldc + col0;
#pragma unroll
                for (int bj = 0; bj < 2; ++bj)
#pragma unroll
                    for (int n = 0; n < 2; ++n) { f32x4 o = (acc[ai][bj][m][n] - sr.x) * sr.y * gv[bj][n] + bv[bj][n];
                        if (bad) o = (f32x4){qnan, qnan, qnan, qnan};
                        *(f32x4*)(hout + off + bj * HALF + n * 16) = o;
                        u32x2v w; w.x = cvt_pk_bf16(o[0], o[1]); w.y = cvt_pk_bf16(o[2], o[3]); *(u32x2v*)(hb + off + bj * HALF + n * 16) = w; }
                asm volatile("" ::: "memory"); }
    }
};
struct EpiProj {
    static constexpr bool PERM = true, AFTER_DRAIN = false;
    bf16_t* PJ; size_t slot_stride; const float* rope; float* KM; PG8_LAS float* xch;
    __device__ __forceinline__ void operator()(const f32x4 (&acc)[2][2][4][2], const Unit& u, int wr, int wc, int fr, int fq) const {
        const int slot = u.pn >> 1, row0 = u.pm * BM + wr * 64 + fr;
        bf16_t* base = PJ + (size_t)slot * slot_stride;
        if (slot != 4 && slot != 5) {
            const int col0 = (u.pn & 1) * BM + wc * 32 + 8 * fq;
#pragma unroll
            for (int ai = 0; ai < 2; ++ai)
#pragma unroll
                for (int m = 0; m < 4; ++m) { bf16_t* rowp = base + (size_t)(row0 + ai * HALF + m * 16) * 512 + col0;
#pragma unroll
                    for (int bj = 0; bj < 2; ++bj) { const f32x4 v0 = acc[ai][bj][m][0], v1 = acc[ai][bj][m][1];
                        u32x4 w; w.x = cvt_pk_bf16(v0[0], v0[1]); w.y = cvt_pk_bf16(v0[2], v0[3]); w.z = cvt_pk_bf16(v1[0], v1[1]); w.w = cvt_pk_bf16(v1[2], v1[3]);
                        *(u32x4*)(rowp + bj * HALF) = w; } }
            return;
        }
        const int head = (u.pn & 1) * 2 + (wc >> 1), d0 = 32 * (wc & 1) + 8 * fq;
        float cs1[8], cs2[8];
#pragma unroll
        for (int k = 0; k < 8; ++k) { cs1[k] = 0.f; cs2[k] = 0.f; }
#pragma unroll
        for (int ai = 0; ai < 2; ++ai)
#pragma unroll
            for (int m = 0; m < 4; ++m) {
                const int row = row0 + ai * HALF + m * 16, pos = row & 4095;
                const float* rp = rope + ((size_t)pos * 64 + d0) * 2;
                const f32x4 c0 = *(const f32x4*)rp, c1 = *(const f32x4*)(rp + 4), c2 = *(const f32x4*)(rp + 8), c3 = *(const f32x4*)(rp + 12);
                const float cs[8] = {c0[0], c0[2], c1[0], c1[2], c2[0], c2[2], c3[0], c3[2]}, sn[8] = {c0[1], c0[3], c1[1], c1[3], c2[1], c2[3], c3[1], c3[3]};
                float r1[8], r2[8];
#pragma unroll
                for (int k = 0; k < 8; ++k) { const float t1 = acc[ai][0][m][k >> 2][k & 3], t2 = acc[ai][1][m][k >> 2][k & 3];
                    r1[k] = t1 * cs[k] - t2 * sn[k]; r2[k] = t2 * cs[k] + t1 * sn[k]; }
                if (slot == 5) {
#pragma unroll
                    for (int k = 0; k < 8; ++k) { cs1[k] += r1[k]; cs2[k] += r2[k]; }
                    asm volatile("" : "+v"(cs1[0]), "+v"(cs1[1]), "+v"(cs1[2]), "+v"(cs1[3]), "+v"(cs1[4]), "+v"(cs1[5]), "+v"(cs1[6]), "+v"(cs1[7]));
                    asm volatile("" : "+v"(cs2[0]), "+v"(cs2[1]), "+v"(cs2[2]), "+v"(cs2[3]), "+v"(cs2[4]), "+v"(cs2[5]), "+v"(cs2[6]), "+v"(cs2[7]));
                }
                bf16_t* rowp = base + (size_t)row * 512 + head * 128 + d0;
                u32x4 w1, w2;
                w1.x = cvt_pk_bf16(r1[0], r1[1]); w1.y = cvt_pk_bf16(r1[2], r1[3]); w1.z = cvt_pk_bf16(r1[4], r1[5]); w1.w = cvt_pk_bf16(r1[6], r1[7]);
                w2.x = cvt_pk_bf16(r2[0], r2[1]); w2.y = cvt_pk_bf16(r2[2], r2[3]); w2.z = cvt_pk_bf16(r2[4], r2[5]); w2.w = cvt_pk_bf16(r2[6], r2[7]);
                *(u32x4*)rowp = w1; *(u32x4*)(rowp + 64) = w2;
                asm volatile("" ::: "memory");
            }
        if (slot == 5) {
#pragma unroll
            for (int k = 0; k < 8; ++k) {
#pragma unroll
                for (int o = 1; o < 16; o <<= 1) { cs1[k] += __shfl_xor(cs1[k], o); cs2[k] += __shfl_xor(cs2[k], o); } }
            PG8_LAS float* x = xch + (wc * 4 + fq) * 16;
            if (wr == 1 && fr == 0) {
#pragma unroll
                for (int k = 0; k < 8; ++k) { x[k] = cs1[k]; x[8 + k] = cs2[k]; } }
            asm volatile("s_waitcnt lgkmcnt(0)" ::: "memory"); __builtin_amdgcn_s_barrier(); asm volatile("" ::: "memory");
            if (wr == 0 && fr == 0) {
                const int b = (u.pm * BM) >> 12, j = ((u.pm * BM) & 4095) >> 8;
                float* kp = KM + ((size_t)((b * 4 + head) * 16 + j)) * 128 + d0;
#pragma unroll
                for (int k = 0; k < 8; ++k) { kp[k] = cs1[k] + x[k]; kp[64 + k] = cs2[k] + x[8 + k]; }
            }
        }
    }
};
}
#define GAS __attribute__((address_space(1)))
#define LAS __attribute__((address_space(3)))
typedef unsigned short bf16;
typedef unsigned v4u __attribute__((ext_vector_type(4)));
typedef float f32x4 __attribute__((ext_vector_type(4)));
typedef short bf16x8 __attribute__((ext_vector_type(8)));
typedef GAS unsigned gu32;
typedef GAS unsigned long long gu64;
#define RLX_AGENT __ATOMIC_RELAXED, __HIP_MEMORY_SCOPE_AGENT
#define LDS_WAIT() asm volatile("s_waitcnt lgkmcnt(0)" ::: "memory")
#define VM_WAIT() asm volatile("s_waitcnt vmcnt(0)" ::: "memory")
__device__ __forceinline__ unsigned long long rt() { return __builtin_amdgcn_s_memrealtime(); }
__device__ __forceinline__ unsigned f2bf(float f) { unsigned u = __builtin_bit_cast(unsigned, f); return (u + 0x7fffu + ((u >> 16) & 1u)) >> 16; }
__device__ __forceinline__ unsigned pk2(float lo, float hi) { return f2bf(lo) | (f2bf(hi) << 16); }

#define XB_TMO      128
#define XB_XCNT(j)  (256  + 64 * (j))
#define XB_XSUB(j)  (1280 + 64 * (j))
#define XB_XGEN(j)  (2304 + 64 * (j))
#define XB_TOP      3328
#define XB_TOPGEN   3392
#define XCD_BAR_WORDS 3456
#define XB_SPIN_CAP (1u << 18)

__device__ __forceinline__ unsigned xb_ld(unsigned* p)              { return __hip_atomic_load(p, __ATOMIC_RELAXED, __HIP_MEMORY_SCOPE_AGENT); }
__device__ __forceinline__ unsigned xb_add(unsigned* p, unsigned v) { return __hip_atomic_fetch_add(p, v, __ATOMIC_RELAXED, __HIP_MEMORY_SCOPE_AGENT); }
__device__ __forceinline__ unsigned xb_xcc_id() { return (unsigned)__builtin_amdgcn_s_getreg((3 << 11) | 20) & 0xFu; }
#define XB_SPIN(cond, bar) do { unsigned _sp = 0; while (cond) { __builtin_amdgcn_s_sleep(1); \
    if ((++_sp & 255u) == 0u) { if (xb_ld(&(bar)[XB_TMO])) break; if (_sp > XB_SPIN_CAP) { atomicAdd(&(bar)[XB_TMO], 1u); break; } } } } while (0)

struct XcdBarrier {
    unsigned* bar; unsigned x;
    volatile LAS unsigned* st;
};

__device__ __forceinline__ XcdBarrier xcd_barrier_post(unsigned* bar, volatile LAS unsigned* st) {
    XcdBarrier b; b.bar = bar; b.x = xb_xcc_id(); b.st = st;
    if (threadIdx.x == 0) (void)xb_add(&bar[XB_XCNT(b.x)], 1u);
    return b;
}
__device__ __forceinline__ void xcd_barrier_complete(unsigned* bar, unsigned x, unsigned& nloc, unsigned& nx) {
    const unsigned G = gridDim.x * gridDim.y * gridDim.z;
    unsigned sum, cnt, mine, sp = 0u;
    for (;;) {
        sum = 0u; cnt = 0u; mine = 0u;
#pragma unroll
        for (unsigned j = 0; j < 16; ++j) { const unsigned c = xb_ld(&bar[XB_XCNT(j)]); sum += c; cnt += (c > 0u) ? 1u : 0u; mine = (j == x) ? c : mine; }
        if (sum == G) break;
        __builtin_amdgcn_s_sleep(1);
        if ((++sp & 255u) == 0u) { if (xb_ld(&bar[XB_TMO])) break; if (sp > XB_SPIN_CAP) { atomicAdd(&bar[XB_TMO], 1u); break; } }
    }
    nloc = mine > 0u ? mine : 1u; nx = cnt > 0u ? cnt : 1u;
}

__device__ __forceinline__ void xcd_barrier(const XcdBarrier& b) {
    asm volatile("s_waitcnt vmcnt(0)" ::: "memory");
    __syncthreads();
    if (threadIdx.x == 0) {
        unsigned* bar = b.bar;
        __builtin_amdgcn_s_waitcnt(0);
        unsigned nloc = b.st[0], nx = b.st[1];
        if (nloc == 0u) { xcd_barrier_complete(bar, b.x, nloc, nx); b.st[0] = nloc; b.st[1] = nx; }
        const unsigned old = xb_add(&bar[XB_XSUB(b.x)], 1u);
        const unsigned gen = old / nloc;
        if (old + 1u == (gen + 1u) * nloc) {
            __builtin_amdgcn_fence(__ATOMIC_RELEASE, "agent");
            asm volatile("s_waitcnt vmcnt(0)" ::: "memory");
            const unsigned og = xb_add(&bar[XB_TOP], 1u);
            const unsigned tg = og / nx;
            if (og + 1u == (tg + 1u) * nx) xb_add(&bar[XB_TOPGEN], 1u);
            else XB_SPIN(xb_ld(&bar[XB_TOPGEN]) == tg, bar);
            __builtin_amdgcn_fence(__ATOMIC_ACQUIRE, "agent");
            xb_add(&bar[XB_XGEN(b.x)], 1u);
            asm volatile("s_waitcnt vmcnt(0)" ::: "memory");
        } else {
            XB_SPIN(xb_ld(&bar[XB_XGEN(b.x)]) == gen, bar);
            __builtin_amdgcn_fence(__ATOMIC_ACQUIRE, "agent");
            asm volatile("s_waitcnt vmcnt(0)" ::: "memory");
        }
    }
    __syncthreads();
}
namespace mb {
constexpr int D = 128, PITCH = 512, OPITCH = 1024;
constexpr float THR = 8.f;
constexpr bool WSKIP = false;
constexpr int KM_OFF = 69632;
constexpr float SCALE = 0.08838834764831845f;
constexpr int NW = 8, QBLK = 32, KVBLK = 64, QB = NW * QBLK;
constexpr int SHM_V = KVBLK * D * 2, SHM_K = KVBLK * D * 2;
constexpr int LDS_BYTES = 2 * SHM_V + 2 * SHM_K + NW * 64 * 4;

typedef short bf16x8 __attribute__((ext_vector_type(8)));
typedef short s16x4 __attribute__((ext_vector_type(4)));
typedef float f32x16 __attribute__((ext_vector_type(16)));
typedef float f32x4 __attribute__((ext_vector_type(4)));
typedef unsigned u32x4 __attribute__((ext_vector_type(4)));
template <class A, class Bt> struct same_t { static constexpr bool v = false; };
template <class A> struct same_t<A, A> { static constexpr bool v = true; };

typedef const GAS char* gcptr;
__device__ __forceinline__ gcptr uni(const void* p) {
    const unsigned long long u = (unsigned long long)p;
    const unsigned lo = __builtin_amdgcn_readfirstlane((unsigned)u), hi = __builtin_amdgcn_readfirstlane((unsigned)(u >> 32));
    return (gcptr)(((unsigned long long)hi << 32) | lo);
}
#define KSWZ(row, colB) ((row) * 256 + ((colB) ^ (((row) & 7) << 4)))
#define SBAR() __builtin_amdgcn_sched_barrier(0)
__device__ __forceinline__ int v_st(int k, int c) { const int kk = (k & ~0xC) | ((k & 4) << 1) | ((k & 8) >> 1); return ((kk >> 3) * 4 + (c >> 5)) * 512 + ((kk & 7) * 32 + (c & 31)) * 2; }
__device__ __forceinline__ int v_rd_base(int lane) { return ((lane & 3) << 3) | (((lane >> 2) & 3) << 6) | (((lane >> 4) & 1) << 5) | (((lane >> 5) & 1) << 8); }
constexpr int v_rd_off(int d0, int ks, int half) { return d0 * 512 + ks * 4096 + half * 2048; }
__device__ __forceinline__ int crow(int r, int hi) { return (r & 3) + 8 * (r >> 2) + 4 * hi; }
__device__ __forceinline__ unsigned cvtpk(float lo, float hi) {
    unsigned r; asm volatile("v_cvt_pk_bf16_f32 %0, %1, %2" : "=v"(r) : "v"(lo), "v"(hi)); return r;
}
__device__ __forceinline__ bf16x8 pack8(f32x4 a, f32x4 b) {
    u32x4 w = {cvtpk(a[0], a[1]), cvtpk(a[2], a[3]), cvtpk(b[0], b[1]), cvtpk(b[2], b[3])};
    return *reinterpret_cast<bf16x8*>(&w);
}
template <class T> __device__ __forceinline__ bf16x8 load8(const T* p) {
    if constexpr (same_t<T, float>::v) { return pack8(*(const f32x4*)p, *(const f32x4*)(p + 4)); }
    else { return *reinterpret_cast<const bf16x8*>(p); }
}
__device__ __forceinline__ void mask_tile(f32x16& p0, f32x16& p1, int dq, unsigned W) {
    const float NEG = -__builtin_inff();
#pragma unroll
    for (int r = 0; r < 16; ++r) {
        const int c = (r & 3) + 8 * (r >> 2);
        if ((unsigned)(dq - c) >= W) p0[r] = NEG;
        if ((unsigned)(dq - c - 32) >= W) p1[r] = NEG;
    }
}
__device__ __forceinline__ void partialSM(f32x16& p0, f32x16& p1, float& m_reg, float& mn, float& alpha) {
    float pmax = p0[0]; for (int r = 1; r < 16; ++r) pmax = fmaxf(pmax, p0[r]); for (int r = 0; r < 16; ++r) pmax = fmaxf(pmax, p1[r]);
    { auto rr = __builtin_amdgcn_permlane32_swap(__float_as_uint(pmax), __float_as_uint(pmax), false, false);
      pmax = fmaxf(__uint_as_float(rr[0]), __uint_as_float(rr[1])); }
    constexpr float C2 = 1.4426950408889634f * SCALE;
    if (__builtin_expect(__all((pmax - m_reg) * SCALE <= THR), 1)) { mn = m_reg; alpha = 1.f; }
    else { mn = fmaxf(m_reg, pmax); alpha = __builtin_amdgcn_exp2f((m_reg - mn) * C2); m_reg = mn; }
    const float mnL = -mn * C2;
    for (int r = 0; r < 16; ++r) p0[r] = fmaf(p0[r], C2, mnL); for (int r = 0; r < 16; ++r) p1[r] = fmaf(p1[r], C2, mnL);
    for (int r = 0; r < 16; ++r) p0[r] = __builtin_amdgcn_exp2f(p0[r]);
}
__device__ __forceinline__ void finishSM(f32x16& p0, f32x16& p1, float alpha, float& l_reg, bf16x8& pa0, bf16x8& pa1, bf16x8& pa2, bf16x8& pa3) {
    for (int r = 0; r < 16; ++r) p1[r] = __builtin_amdgcn_exp2f(p1[r]);
    float ps = 0; for (int r = 0; r < 16; ++r) ps += p0[r]; for (int r = 0; r < 16; ++r) ps += p1[r];
    { auto rr = __builtin_amdgcn_permlane32_swap(__float_as_uint(ps), __float_as_uint(ps), false, false);
      ps = __uint_as_float(rr[0]) + __uint_as_float(rr[1]); }
    l_reg = l_reg * alpha + ps;
#define PK4(P, B_, OUT) do { unsigned a0 = cvtpk(P[B_+0], P[B_+1]), a1 = cvtpk(P[B_+2], P[B_+3]);                          \
        unsigned b0 = cvtpk(P[B_+4], P[B_+5]), b1 = cvtpk(P[B_+6], P[B_+7]);                                             \
        auto r0 = __builtin_amdgcn_permlane32_swap(a0, b0, false, false); auto r1 = __builtin_amdgcn_permlane32_swap(a1, b1, false, false); \
        u32x4 w = {r0[0], r1[0], r0[1], r1[1]}; OUT = *reinterpret_cast<bf16x8*>(&w); } while (0)
    PK4(p0, 0, pa0); PK4(p0, 8, pa1); PK4(p1, 0, pa2); PK4(p1, 8, pa3);
#undef PK4
}
template <int KB, bool SK>
__device__ __forceinline__ void qkt(f32x16& p0, f32x16& p1, const char* K_lds, int r32, int hi, const bf16x8* qr, bool act) {
    if (SK && !act) { const float NEG = -__builtin_inff();
#pragma unroll
        for (int r = 0; r < 16; ++r) { p0[r] = NEG; p1[r] = NEG; } return; }
    p0 = f32x16{}; p1 = f32x16{};
    const char* kb[4];
#pragma unroll
    for (int dd = 0; dd < 4; ++dd) kb[dd] = K_lds + KB * SHM_K + KSWZ(r32, (dd * 16 + hi * 8) * 2);
#pragma unroll
    for (int d0 = 0; d0 < 8; ++d0) { const char* a = kb[d0 & 3] + (d0 >> 2) * 128;
        bf16x8 b0 = *reinterpret_cast<const bf16x8*>(a);
        bf16x8 b1 = *reinterpret_cast<const bf16x8*>(a + 32 * 256);
        p0 = __builtin_amdgcn_mfma_f32_32x32x16_bf16(b0, qr[d0], p0, 0, 0, 0);
        p1 = __builtin_amdgcn_mfma_f32_32x32x16_bf16(b1, qr[d0], p1, 0, 0, 0); }
}
template <int VB, bool SK>
__device__ __forceinline__ void pv_tile(f32x16* o, int vb0, bf16x8 pa0, bf16x8 pa1, bf16x8 pa2, bf16x8 pa3, bool act) {
    if (SK && !act) return;
#define TRRD(dst, off) asm volatile("ds_read_b64_tr_b16 %0, %1 offset:%2" : "=&v"(dst) : "v"(vb0), "i"(off) : "memory")
#define PV_D0(d0) do { s16x4 l0, l1, l2, l3, h0, h1, h2, h3; constexpr int b_ = VB * SHM_V + v_rd_off(d0, 0, 0);     \
        TRRD(l0, b_); TRRD(h0, b_ + 2048); TRRD(l1, b_ + 4096); TRRD(h1, b_ + 6144); TRRD(l2, b_ + 8192); TRRD(h2, b_ + 10240); TRRD(l3, b_ + 12288); TRRD(h3, b_ + 14336); \
        asm volatile("s_waitcnt lgkmcnt(0)" ::: "memory"); SBAR();                 \
        o[d0] = __builtin_amdgcn_mfma_f32_32x32x16_bf16(pa0, (bf16x8){l0[0], l0[1], l0[2], l0[3], h0[0], h0[1], h0[2], h0[3]}, o[d0], 0, 0, 0);   \
        o[d0] = __builtin_amdgcn_mfma_f32_32x32x16_bf16(pa1, (bf16x8){l1[0], l1[1], l1[2], l1[3], h1[0], h1[1], h1[2], h1[3]}, o[d0], 0, 0, 0);   \
        o[d0] = __builtin_amdgcn_mfma_f32_32x32x16_bf16(pa2, (bf16x8){l2[0], l2[1], l2[2], l2[3], h2[0], h2[1], h2[2], h2[3]}, o[d0], 0, 0, 0);   \
        o[d0] = __builtin_amdgcn_mfma_f32_32x32x16_bf16(pa3, (bf16x8){l3[0], l3[1], l3[2], l3[3], h3[0], h3[1], h3[2], h3[3]}, o[d0], 0, 0, 0); } while (0)
    PV_D0(0); PV_D0(1); PV_D0(2); PV_D0(3);
#undef PV_D0
#undef TRRD
}

template <class TIn, class TOut> struct BlockRef { const TIn* Q; const TIn* K; const TIn* V; TOut* O; const float* KM; int P0; int t_lo, t_hi; TOut* OP; float* LSE; };
template <class TIn> struct Seam {
    bf16x8 qr[8];
    bf16x8 st_v0, st_v1, st_k0, st_k1; f32x4 sf0, sf1, sf2, sf3;
    f32x4 tq[16];
};
__device__ __forceinline__ int swa_jlo(int P0, int W) { const int lowk = P0 - W + 1; return lowk > 0 ? lowk / KVBLK : 0; }
#define ROW(p, k0, rr) ((p) + (size_t)((k0) + (rr)) * PITCH + sc)
#define VMW() asm volatile("s_waitcnt vmcnt(0)" ::: "memory")
#define VMWN(n) asm volatile("s_waitcnt vmcnt(%0)" :: "i"(n) : "memory")
#define LD16U(base, boff) (*(const GAS bf16x8*)(uni((const char*)(base) + (size_t)(boff)) + voff))
#define SLOAD_H(Kp, Vp, k0) do { S.st_v0 = LD16U(Vp, (size_t)(k0) * (PITCH * 2)); S.st_v1 = LD16U(Vp, (size_t)((k0) + 32) * (PITCH * 2));              \
                         S.st_k0 = LD16U(Kp, (size_t)(k0) * (PITCH * 2)); S.st_k1 = LD16U(Kp, (size_t)((k0) + 32) * (PITCH * 2)); } while (0)
#define SWRITE_HK(bf) do { *(bf16x8*)(K_lds + (bf) * SHM_K + kws) = S.st_k0; *(bf16x8*)(K_lds + (bf) * SHM_K + kws + 32 * 256) = S.st_k1; } while (0)
#define SWRITE_HV(bf) do { *(bf16x8*)(V_lds + (bf) * SHM_V + vst0) = S.st_v0; *(bf16x8*)(V_lds + (bf) * SHM_V + vst1) = S.st_v1; } while (0)
#define SWRITE_H(bf) do { SWRITE_HV(bf); SWRITE_HK(bf); } while (0)
#define SLOAD_F(p, k0) do { S.sf0 = *(const f32x4*)ROW(p, k0, sr); S.sf1 = *(const f32x4*)(ROW(p, k0, sr) + 4);                \
                            S.sf2 = *(const f32x4*)ROW(p, k0, 32 + sr); S.sf3 = *(const f32x4*)(ROW(p, k0, 32 + sr) + 4); } while (0)
#define SWRITE_KF(bf) do { *(bf16x8*)(K_lds + (bf) * SHM_K + kws) = pack8(S.sf0, S.sf1); *(bf16x8*)(K_lds + (bf) * SHM_K + kws + 32 * 256) = pack8(S.sf2, S.sf3); } while (0)
#define SWRITE_VF(bf) do { *(bf16x8*)(V_lds + (bf) * SHM_V + vst0) = pack8(S.sf0, S.sf1); *(bf16x8*)(V_lds + (bf) * SHM_V + vst1) = pack8(S.sf2, S.sf3); } while (0)
template <class TIn, class TOut>
__device__ __forceinline__ void causal_swa_prime(const BlockRef<TIn, TOut>& cur, int W, char* lds, Seam<TIn>& S) {
    constexpr bool F32 = same_t<TIn, float>::v;
    int tid = threadIdx.x; asm volatile("" : "+v"(tid));
    const int wid = __builtin_amdgcn_readfirstlane(tid >> 6), lane = tid & 63, r32 = lane & 31, hi = lane >> 5;
    const int sr = tid >> 4, sc = (tid & 15) * 8, kws = KSWZ(sr, sc * 2); char* K_lds = lds + 2 * SHM_V;
    const unsigned voff = (unsigned)(sr * PITCH + sc) * 2u, qoff = (unsigned)((wid * QBLK + r32) * PITCH + hi * 8) * 2u;
    const int kb0 = cur.t_lo * KVBLK;
    for (int d0 = 0; d0 < 8; ++d0) S.qr[d0] = *(const GAS bf16x8*)(uni((const char*)cur.Q + d0 * 32) + qoff);
    if constexpr (F32) { SLOAD_F((const float*)cur.K, kb0); VMW(); SWRITE_KF(0); SBAR(); SLOAD_F((const float*)cur.V, kb0); }
    else { SLOAD_H(cur.K, cur.V, kb0); VMW(); SWRITE_HK(0); }
    __syncthreads();
}
template <class TIn, class TOut>
__device__ __forceinline__ void causal_swa_block(const BlockRef<TIn, TOut>& cur, const BlockRef<TIn, TOut>& nxt, int skv, int W, char* lds, Seam<TIn>& S) {
    constexpr bool F32 = same_t<TIn, float>::v;
    int tid = threadIdx.x; asm volatile("" : "+v"(tid));
    const int wid = __builtin_amdgcn_readfirstlane(tid >> 6), lane = tid & 63, r32 = lane & 31, hi = lane >> 5;
    const int j_lo = cur.t_lo, j_hi = cur.t_hi;
    const int NT = j_hi - j_lo;
    const int kbn = nxt.t_lo * KVBLK;
    const int qlo = cur.P0 + wid * QBLK, qm = qlo + r32 - 4 * hi;
    char* V_lds = lds; char* K_lds = lds + 2 * SHM_V;
    float* ws = (float*)(lds + 2 * SHM_V + 2 * SHM_K) + wid * 64; float* li_l = ws, * al_l = ws + 32;
    float m_reg = -1e30f, l_reg = 0; f32x16 o[4] = {};
    const int sr = tid >> 4, sc = (tid & 15) * 8, vst0 = v_st(sr, sc), vst1 = v_st(32 + sr, sc), kws = KSWZ(sr, sc * 2);
    const unsigned voff = (unsigned)(sr * PITCH + sc) * 2u, qoff = (unsigned)((wid * QBLK + r32) * PITCH + hi * 8) * 2u;
    const int vb0 = (int)(uintptr_t)V_lds + v_rd_base(lane);
    const TIn* Kh = cur.K; const TIn* Vh = cur.V;
    const int own = cur.P0 / QB, own4 = cur.P0 / KVBLK;
    unsigned sel = 0u;
    {
        float* km = (float*)(lds + KM_OFF);
#ifdef ROPE_EPI
        for (int i = tid; i < 16 * 128; i += 64 * NW) km[i] = *(const GAS float*)(uni(cur.KM) + (unsigned)(i * 4));
#else
        for (int i = tid; i < 16 * 128; i += 64 * NW) { const GAS float* p = (const GAS float*)(uni(cur.KM) + (unsigned)(((i >> 7) * 512 + (i & 127)) * 4)); km[i] = (p[0] + p[128]) + (p[256] + p[384]); }
#endif
        __syncthreads();
        float best[3] = {-3e38f, -3e38f, -3e38f}; int bidx[3] = {0, 0, 0};
#pragma unroll 1
        for (int j = 0; j < own; ++j) {
            float a = 0.f;
#pragma unroll
            for (int d0 = 0; d0 < 8; ++d0) {
                const f32x4 k0 = *(const f32x4*)(km + j * 128 + d0 * 16 + hi * 8), k1 = *(const f32x4*)(km + j * 128 + d0 * 16 + hi * 8 + 4);
                const u32x4 qw = *reinterpret_cast<const u32x4*>(&S.qr[d0]);
                a += __uint_as_float(qw[0] << 16) * k0[0] + __uint_as_float(qw[0] & 0xffff0000u) * k0[1] + __uint_as_float(qw[1] << 16) * k0[2] + __uint_as_float(qw[1] & 0xffff0000u) * k0[3]
                   + __uint_as_float(qw[2] << 16) * k1[0] + __uint_as_float(qw[2] & 0xffff0000u) * k1[1] + __uint_as_float(qw[3] << 16) * k1[2] + __uint_as_float(qw[3] & 0xffff0000u) * k1[3];
            }
            a += __shfl_xor(a, 32);
            if (a > best[0]) { best[2] = best[1]; bidx[2] = bidx[1]; best[1] = best[0]; bidx[1] = bidx[0]; best[0] = a; bidx[0] = j; }
            else if (a > best[1]) { best[2] = best[1]; bidx[2] = bidx[1]; best[1] = a; bidx[1] = j; }
            else if (a > best[2]) { best[2] = a; bidx[2] = j; }
        }
#pragma unroll
        for (int r = 0; r < 3; ++r) if (best[r] > -1e37f) sel |= 1u << bidx[r];
    }
#define RESC(a) do { if (__any((a) < 1.f)) { if (hi == 0) al_l[r32] = (a); asm volatile("s_waitcnt lgkmcnt(0)" ::: "memory");              \
                     for (int d_ = 0; d_ < 4; ++d_) for (int r = 0; r < 16; ++r) o[d_][r] *= al_l[crow(r, hi)]; } } while (0)
#define KBASE(t) ((j_lo + (t)) * KVBLK)
#define ACT(t) (KBASE(t) <= qlo + QBLK - 1 && KBASE(t) + KVBLK - 1 >= qlo - W + 1)
#define MASKT(P0_, P1_, t) do { const int kb_ = KBASE(t), gt_ = j_lo + (t); if (gt_ >= own4) { if (kb_ + KVBLK - 1 > qlo) mask_tile(P0_, P1_, qm - kb_, 0x3fffffffu); } else if (!((sel >> (gt_ >> 2)) & 1u)) { const float NEG_ = -__builtin_inff(); _Pragma("unroll") for (int r_ = 0; r_ < 16; ++r_) { P0_[r_] = NEG_; P1_[r_] = NEG_; } } } while (0)
    constexpr int NQL = F32 ? 16 : 8;
    constexpr bool SK = WSKIP && !F32;
#define SEAM_K0() do { VMWN(NQL); if constexpr (F32) { SWRITE_KF(0); SBAR(); SLOAD_F((const float*)nxt.V, kbn); } else { SWRITE_HK(0); } SBAR(); } while (0)
    f32x16 pA0, pA1, pB0, pB1; float mnA, mnB, alA, alB; bf16x8 pa0, pa1, pa2, pa3;
    if constexpr (F32) { VMW(); SWRITE_VF(0); SBAR(); } else { SWRITE_HV(0); SBAR(); }
    if (NT > 1) { if constexpr (F32) SLOAD_F((const float*)Kh, KBASE(1)); else SLOAD_H(Kh, Vh, KBASE(1)); }
    SBAR(); qkt<0, SK>(pA0, pA1, K_lds, r32, hi, S.qr, ACT(0));
    if constexpr (F32) { if (NT > 1) { VMW(); SWRITE_KF(1); SBAR(); SLOAD_F((const float*)Vh, KBASE(1)); } }
    MASKT(pA0, pA1, 0); partialSM(pA0, pA1, m_reg, mnA, alA);
    if (NT > 1) { VMW(); if constexpr (F32) { SWRITE_VF(1); SBAR(); if (NT > 2) SLOAD_F((const float*)Kh, KBASE(2)); } else SWRITE_H(1); }
    __syncthreads();
#define HALF_STEP(PX0, PX1, mnX, alX, PY0, PY1, alY, t, KB, VB, SB) do {                                                      \
        SBAR(); qkt<KB, SK>(PX0, PX1, K_lds, r32, hi, S.qr, ACT(t));                                             \
        finishSM(PY0, PY1, alY, l_reg, pa0, pa1, pa2, pa3); SBAR();                                                           \
        if ((t) + 1 < NT) { if constexpr (F32) { VMW(); SWRITE_KF(SB); SBAR(); SLOAD_F((const float*)Vh, KBASE((t) + 1)); }  \
                            else { SLOAD_H(Kh, Vh, KBASE((t) + 1)); } SBAR(); }                                               \
        pv_tile<VB, SK>(o, vb0, pa0, pa1, pa2, pa3, ACT((t) - 1)); MASKT(PX0, PX1, (t)); partialSM(PX0, PX1, m_reg, mnX, alX);                                        \
        __syncthreads();                                                                                                      \
        if ((t) + 1 < NT) { VMW(); if constexpr (F32) { SWRITE_VF(SB); SBAR(); if ((t) + 2 < NT) SLOAD_F((const float*)Kh, KBASE((t) + 2)); } \
                            else { SWRITE_H(SB); } }                                                                          \
        RESC(alX); __syncthreads(); } while (0)
    for (int t = 1; t + 1 < NT; t += 2) {
        HALF_STEP(pB0, pB1, mnB, alB, pA0, pA1, alA, t, 1, 0, 0);
        HALF_STEP(pA0, pA1, mnA, alA, pB0, pB1, alB, t + 1, 0, 1, 1);
    }
    const bool even = (NT & 1) == 0;
    if (even) { SBAR(); qkt<1, SK>(pB0, pB1, K_lds, r32, hi, S.qr, ACT(NT - 1)); SBAR(); }
#define QROW(e) (nxt.Q + (size_t)(wid * QBLK + r32) * PITCH + ((e) >> 1) * 16 + hi * 8 + ((e) & 1) * 4)
    if constexpr (F32) { SLOAD_F((const float*)nxt.K, kbn); SBAR();
#pragma unroll
        for (int e = 0; e < 8; ++e) S.tq[e] = *(const f32x4*)QROW(e); }
    else { SLOAD_H(nxt.K, nxt.V, kbn); SBAR();
#pragma unroll
        for (int d0 = 0; d0 < 8; ++d0) S.qr[d0] = *(const GAS bf16x8*)(uni((const char*)nxt.Q + d0 * 32) + qoff); }
    SBAR();
    finishSM(pA0, pA1, alA, l_reg, pa0, pa1, pa2, pa3); SBAR();
    if constexpr (F32) {
#pragma unroll
        for (int e = 8; e < 16; ++e) S.tq[e] = *(const f32x4*)QROW(e); SBAR(); }
#undef QROW
    pv_tile<0, SK>(o, vb0, pa0, pa1, pa2, pa3, ACT(even ? NT - 2 : NT - 1));
    if (even) { MASKT(pB0, pB1, NT - 1); partialSM(pB0, pB1, m_reg, mnB, alB); __syncthreads(); RESC(alB);
        finishSM(pB0, pB1, alB, l_reg, pa0, pa1, pa2, pa3); SBAR(); pv_tile<1, SK>(o, vb0, pa0, pa1, pa2, pa3, ACT(NT - 1)); }
    SBAR(); SEAM_K0();
    if (hi == 0) li_l[r32] = l_reg; asm volatile("s_waitcnt lgkmcnt(0)" ::: "memory");
    float rli[16];
#pragma unroll
    for (int r = 0; r < 16; ++r) { const float li_ = li_l[crow(r, hi)]; rli[r] = li_ > 0.f ? __builtin_amdgcn_rcpf(li_) : 0.f; }
    if (cur.OP) {
        if (hi == 0) cur.LSE[wid * QBLK + r32] = l_reg > 0.f ? m_reg * (1.4426950408889634f * SCALE) + __builtin_amdgcn_logf(l_reg) : -__builtin_inff();
        GAS char* Ow = (GAS char*)uni(cur.OP + (size_t)(wid * QBLK) * 128);
        unsigned obase = (unsigned)((4 * hi * 128 + r32) * 2); asm volatile("" : "+v"(obase));
#pragma unroll
        for (int r = 0; r < 16; ++r) {
#pragma unroll
            for (int d0 = 0; d0 < 4; ++d0) { const float v = o[d0][r] * rli[r];
                const float vn = __shfl_xor(v, 1);
                if ((r32 & 1) == 0) *(GAS unsigned*)(Ow + (obase + (unsigned)((((r & 3) + 8 * (r >> 2)) * 128 + d0 * 32) * 2))) = cvtpk(v, vn); } }
    } else {
        GAS char* Ow = (GAS char*)uni(cur.O + (size_t)(wid * QBLK) * OPITCH);
        unsigned obase = (unsigned)((4 * hi * OPITCH + r32) * 2); asm volatile("" : "+v"(obase));
#pragma unroll
        for (int r = 0; r < 16; ++r) {
#pragma unroll
            for (int d0 = 0; d0 < 4; ++d0) { const float v = o[d0][r] * rli[r];
                const float vn = __shfl_xor(v, 1);
                if ((r32 & 1) == 0) *(GAS unsigned*)(Ow + (obase + (unsigned)((((r & 3) + 8 * (r >> 2)) * OPITCH + d0 * 32) * 2))) = cvtpk(v, vn); } }
    }
    if constexpr (F32) {
#pragma unroll
        for (int d0 = 0; d0 < 8; ++d0) S.qr[d0] = pack8(S.tq[2 * d0], S.tq[2 * d0 + 1]); }
    __syncthreads();
#undef RESC
#undef KBASE
#undef ACT
#undef MASKT
#undef SEAM_K0
#undef HALF_STEP
}
#undef ROW
#undef VMW
#undef VMWN
#undef SLOAD_H
#undef LD16U
#undef SWRITE_HK
#undef SWRITE_HV
#undef SWRITE_H
#undef SLOAD_F
#undef SWRITE_KF
#undef SWRITE_VF
}
namespace dn {
typedef short bf16x8 __attribute__((ext_vector_type(8)));
typedef float f32x16 __attribute__((ext_vector_type(16)));
typedef float f32x4 __attribute__((ext_vector_type(4)));
typedef unsigned u32x4 __attribute__((ext_vector_type(4)));
typedef unsigned u32x2 __attribute__((ext_vector_type(2)));
#define DNI __device__ __forceinline__
#define DN_MFMA(a, b, c) __builtin_amdgcn_mfma_f32_32x32x16_bf16((a), (b), (c), 0, 0, 0)
constexpr int LQ = 136, LT = 72;
constexpr int BLOB_FRAGS = 56, BLOB_BYTES = BLOB_FRAGS * 1024, UF_BYTES = 16384;
constexpr int L_QS = 0, L_KS = 17408, L_KST = 34816, L_VST = 53248, L_AF = 71680, L_ABF = 89088, L_TRM = 98304, L_TW = 107520, L_TU = 116736,
              L_T00T = 125952, L_GATE = 128512, L_CONVW = 129536, L_END = 135680;
DNI int crow(int i, int h) { return (i & 3) + 8 * (i >> 2) + 4 * h; }
DNI unsigned cvtpk2(float lo, float hi) {
    typedef float f2_t __attribute__((ext_vector_type(2))); typedef __bf16 b2_t __attribute__((ext_vector_type(2)));
    f2_t v = {lo, hi}; b2_t b = __builtin_convertvector(v, b2_t); return __builtin_bit_cast(unsigned, b);
}
template <int SS> DNI bf16x8 pack_acc(const f32x16& x) {
    u32x4 p = {cvtpk2(x[8 * SS], x[8 * SS + 1]), cvtpk2(x[8 * SS + 2], x[8 * SS + 3]), cvtpk2(x[8 * SS + 4], x[8 * SS + 5]), cvtpk2(x[8 * SS + 6], x[8 * SS + 7])};
    return __builtin_bit_cast(bf16x8, p);
}
DNI bf16x8 lds16(const LAS unsigned char* p) { return *(const LAS bf16x8*)p; }
DNI bf16x8 lds_perm8(const LAS unsigned char* rowp, int colbase, int h) {
    const u32x2 a = *(const LAS u32x2*)(rowp + (colbase + 4 * h) * 2), b = *(const LAS u32x2*)(rowp + (colbase + 8 + 4 * h) * 2);
    u32x4 p = {a.x, a.y, b.x, b.y}; return __builtin_bit_cast(bf16x8, p);
}
DNI float bflo_(unsigned w) { return __uint_as_float(w << 16); }
DNI float bfhi_(unsigned w) { return __uint_as_float(w & 0xffff0000u); }

struct RawQKV { u32x4 w[3][4][2]; };
DNI void chunk_load(RawQKV& R, int item, const bf16* PJ, size_t pj_stride) {
    const int tid = threadIdx.x, row = tid >> 3, c0 = (tid & 7) * 16;
    const int n = item & 63, hd = (item >> 6) & 3, b = item >> 8, t = n * 64 + row;
    const size_t row0 = (size_t)b * 4096 + (size_t)n * 64;
#pragma unroll
    for (int X = 0; X < 3; ++X)
#pragma unroll
        for (int j = 0; j < 4; ++j) {
            if (t - 3 + j >= 0) { const bf16* src = PJ + (size_t)X * pj_stride + (row0 + row - 3 + j) * 512 + hd * 128 + c0; R.w[X][j][0] = *(const u32x4*)src; R.w[X][j][1] = *(const u32x4*)(src + 8); }
            else { R.w[X][j][0] = u32x4{}; R.w[X][j][1] = u32x4{}; }
        }
}
DNI void chunk_local(LAS unsigned char* lds, int item, RawQKV& RAW, int next_item, const bf16* PJ, size_t pj_stride, const float* GATES, const float* conv_w, const float* a_log, const float* dt_bias,
                     unsigned char* BLOB, unsigned char* UF, float* GL) {
    int tid = threadIdx.x; asm volatile("" : "+v"(tid));
    const int wid = __builtin_amdgcn_readfirstlane(tid >> 6), lane = tid & 63, r = lane & 31, h2 = lane >> 5;
    const int n = item & 63, hd = (item >> 6) & 3, b = item >> 8;
    const size_t row0 = (size_t)b * 4096 + (size_t)n * 64;
    LAS float* gate = (LAS float*)(lds + L_GATE);
    LAS float* convw = (LAS float*)(lds + L_CONVW);
    unsigned char* blob = BLOB + (size_t)item * BLOB_BYTES;
    for (int i = tid; i < 4 * 384; i += 512) { const int j = i / 384, c = i % 384; convw[i] = conv_w[j * 1536 + (c >> 7) * 512 + hd * 128 + (c & 127)]; }
    if (wid == 0) {
        const size_t m = row0 + lane;
        const float braw = GATES[m * 8 + hd], araw = GATES[m * 8 + 4 + hd];
        const float beta = 1.f / (1.f + __expf(-braw));
        const float sp = fmaxf(araw + dt_bias[hd], 0.f) + log1pf(__expf(-fabsf(araw + dt_bias[hd])));
        float g = -__expf(a_log[hd]) * sp;
#pragma unroll
        for (int d = 1; d < 64; d <<= 1) { const float t = __shfl_up(g, d); if (lane >= d) g += t; }
        const float glast = __shfl(g, 63);
        gate[lane] = beta; gate[64 + lane] = g; gate[128 + lane] = __expf(g); gate[192 + lane] = __expf(glast - g);
        if (lane == 63) GL[item] = __expf(glast);
    }
    __syncthreads();
    {
        const int row = tid >> 3, seg = tid & 7, c0 = seg * 16;
        float val[3][16];
#pragma unroll
        for (int X = 0; X < 3; ++X) {
#pragma unroll
            for (int e = 0; e < 16; ++e) val[X][e] = 0.f;
#pragma unroll
            for (int j = 0; j < 4; ++j) {
                {
                    const u32x4 w0 = RAW.w[X][j][0], w1 = RAW.w[X][j][1];
                    const LAS float* cw = convw + j * 384 + X * 128 + c0;
#pragma unroll
                    for (int e = 0; e < 4; ++e) { val[X][2 * e] += cw[2 * e] * bflo_(w0[e]); val[X][2 * e + 1] += cw[2 * e + 1] * bfhi_(w0[e]);
                                                  val[X][8 + 2 * e] += cw[8 + 2 * e] * bflo_(w1[e]); val[X][8 + 2 * e + 1] += cw[8 + 2 * e + 1] * bfhi_(w1[e]); }
                }
            }
#pragma unroll
            for (int e = 0; e < 16; ++e) val[X][e] = val[X][e] / (1.f + __expf(-val[X][e]));
        }
        float sq = 0.f, sk = 0.f;
#pragma unroll
        for (int e = 0; e < 16; ++e) { sq += val[0][e] * val[0][e]; sk += val[1][e] * val[1][e]; }
        sq += __shfl_xor(sq, 1); sq += __shfl_xor(sq, 2); sq += __shfl_xor(sq, 4);
        sk += __shfl_xor(sk, 1); sk += __shfl_xor(sk, 2); sk += __shfl_xor(sk, 4);
        const float rq = rsqrtf(sq + 1e-6f) * 0.08838834764831845f, rk = rsqrtf(sk + 1e-6f);
        u32x4 qa, qb, ka, kb;
#pragma unroll
        for (int e = 0; e < 4; ++e) { qa[e] = cvtpk2(val[0][2 * e] * rq, val[0][2 * e + 1] * rq); qb[e] = cvtpk2(val[0][8 + 2 * e] * rq, val[0][8 + 2 * e + 1] * rq);
                                      ka[e] = cvtpk2(val[1][2 * e] * rk, val[1][2 * e + 1] * rk); kb[e] = cvtpk2(val[1][8 + 2 * e] * rk, val[1][8 + 2 * e + 1] * rk); }
        *(LAS u32x4*)(lds + L_QS + (row * LQ + c0) * 2) = qa; *(LAS u32x4*)(lds + L_QS + (row * LQ + c0 + 8) * 2) = qb;
        *(LAS u32x4*)(lds + L_KS + (row * LQ + c0) * 2) = ka; *(LAS u32x4*)(lds + L_KS + (row * LQ + c0 + 8) * 2) = kb;
#pragma unroll
        for (int e = 0; e < 16; ++e) {
            const unsigned kw = (e < 8) ? ka[e >> 1] : kb[(e - 8) >> 1];
            *(LAS unsigned short*)(lds + L_KST + ((c0 + e) * LT + row) * 2) = (unsigned short)((e & 1) ? (kw >> 16) : (kw & 0xffffu));
            *(LAS unsigned short*)(lds + L_VST + ((c0 + e) * LT + row) * 2) = (unsigned short)(cvtpk2(val[2][e], 0.f) & 0xffffu);
        }
    }
    if (next_item >= 0) chunk_load(RAW, next_item, PJ, pj_stride);
    __syncthreads();
    {
        const int p = wid >> 2, ri = (wid >> 1) & 1, ci = wid & 1;
        const LAS unsigned char* Ap = lds + L_KS + ((32 * ri + r) * LQ + 8 * h2) * 2;
        const LAS unsigned char* Bp = lds + (p == 0 ? L_KS : L_QS) + ((32 * ci + r) * LQ + 8 * h2) * 2;
        f32x16 acc = {};
        const bool live = (p == 0) ? (ri >= ci) : (ri <= ci);
        if (live) {
#pragma unroll
            for (int ks = 0; ks < 8; ++ks) acc = DN_MFMA(lds16(Ap + ks * 32), lds16(Bp + ks * 32), acc);
        }
        const int colg = 32 * ci + r;
        const float gcol = gate[64 + colg];
        if (p == 0) {
#pragma unroll
            for (int i = 0; i < 16; ++i) {
                const int c = 32 * ri + crow(i, h2);
                const float a = (c > colg) ? gate[c] * acc[i] * __expf(gate[64 + c] - gcol) : 0.f;
                *(LAS float*)(lds + L_AF + (c * 68 + colg) * 4) = a;
                *(LAS unsigned short*)(lds + L_ABF + (c * LT + colg) * 2) = (unsigned short)(cvtpk2(a, 0.f) & 0xffffu);
            }
        } else {
            f32x16 x;
#pragma unroll
            for (int i = 0; i < 16; ++i) { const int s = 32 * ri + crow(i, h2); x[i] = (colg >= s) ? acc[i] * __expf(gcol - gate[64 + s]) : 0.f; }
            *(u32x4*)(blob + (32 + ci * 4 + 2 * ri + 0) * 1024 + lane * 16) = __builtin_bit_cast(u32x4, pack_acc<0>(x));
            *(u32x4*)(blob + (32 + ci * 4 + 2 * ri + 1) * 1024 + lane * 16) = __builtin_bit_cast(u32x4, pack_acc<1>(x));
        }
    }
    __syncthreads();
    if (wid == 0) {
        const int blk = h2, j = r, jg = 32 * blk + j;
        float x[32];
#pragma unroll
        for (int c = 0; c < 32; ++c) {
            float a0 = (c == j) ? 1.f : 0.f, a1 = 0.f, a2 = 0.f, a3 = 0.f;
            const LAS float* arow = (const LAS float*)(lds + L_AF) + (32 * blk + c) * 68 + 32 * blk;
#pragma unroll
            for (int s = 0; s < c; ++s) { const float t_ = arow[s] * x[s]; if ((s & 3) == 0) a0 -= t_; else if ((s & 3) == 1) a1 -= t_; else if ((s & 3) == 2) a2 -= t_; else a3 -= t_; }
            x[c] = (a0 + a1) + (a2 + a3);
        }
        const float sw = gate[jg] * gate[128 + jg], su = gate[jg];
#pragma unroll
        for (int c = 0; c < 32; ++c) {
            const int off = ((32 * blk + c) * LT + jg) * 2;
            *(LAS unsigned short*)(lds + L_TRM + off) = (unsigned short)(cvtpk2(x[c], 0.f) & 0xffffu);
            *(LAS unsigned short*)(lds + L_TW + off) = (unsigned short)(cvtpk2(x[c] * sw, 0.f) & 0xffffu);
            *(LAS unsigned short*)(lds + L_TU + off) = (unsigned short)(cvtpk2(x[c] * su, 0.f) & 0xffffu);
        }
        if (blk == 0) {
#pragma unroll
            for (int c4 = 0; c4 < 4; ++c4) { u32x4 w = {cvtpk2(x[8 * c4], x[8 * c4 + 1]), cvtpk2(x[8 * c4 + 2], x[8 * c4 + 3]), cvtpk2(x[8 * c4 + 4], x[8 * c4 + 5]), cvtpk2(x[8 * c4 + 6], x[8 * c4 + 7])};
                *(LAS u32x4*)(lds + L_T00T + (j * 40 + 8 * c4) * 2) = w; }
        }
        asm volatile("s_waitcnt lgkmcnt(0)" ::: "memory");
        f32x16 m1 = {};
#pragma unroll
        for (int ks = 0; ks < 2; ++ks) m1 = DN_MFMA(lds16(lds + L_ABF + ((32 + r) * LT + 16 * ks + 8 * h2) * 2), lds16(lds + L_T00T + (r * 40 + 16 * ks + 8 * h2) * 2), m1);
        f32x16 t10 = {};
        t10 = DN_MFMA(lds_perm8(lds + L_TRM + ((32 + r) * LT) * 2, 32 + 0, h2), pack_acc<0>(m1), t10);
        t10 = DN_MFMA(lds_perm8(lds + L_TRM + ((32 + r) * LT) * 2, 32 + 16, h2), pack_acc<1>(m1), t10);
        const float sw0 = gate[r] * gate[128 + r], su0 = gate[r];
#pragma unroll
        for (int i = 0; i < 16; ++i) {
            const int off = ((32 + crow(i, h2)) * LT + r) * 2; const float tv = -t10[i];
            *(LAS unsigned short*)(lds + L_TW + off) = (unsigned short)(cvtpk2(tv * sw0, 0.f) & 0xffffu);
            *(LAS unsigned short*)(lds + L_TU + off) = (unsigned short)(cvtpk2(tv * su0, 0.f) & 0xffffu);
        }
    } else {
        for (int f = wid - 1; f < 32; f += 7) {
            bf16x8 v; float sc[8];
            if (f < 16) {
                const int mt = f >> 3, s = f & 7, row = 32 * mt + r;
                v = lds_perm8(lds + L_QS + (row * LQ) * 2, 32 * (s >> 1) + 16 * (s & 1), h2);
                const float e = gate[128 + row];
#pragma unroll
                for (int jj = 0; jj < 8; ++jj) sc[jj] = e;
            } else {
                const int kt = (f - 16) >> 2, s2 = (f - 16) & 3, row = 32 * kt + r, cb = 32 * (s2 >> 1) + 16 * (s2 & 1);
                v = lds_perm8(lds + L_KST + (row * LT) * 2, cb, h2);
#pragma unroll
                for (int jj = 0; jj < 8; ++jj) sc[jj] = gate[192 + cb + 8 * (jj >> 2) + 4 * h2 + (jj & 3)];
            }
            const u32x4 w = __builtin_bit_cast(u32x4, v);
            u32x4 o;
#pragma unroll
            for (int e = 0; e < 4; ++e) o[e] = cvtpk2(bflo_(w[e]) * sc[2 * e], bfhi_(w[e]) * sc[2 * e + 1]);
            *(u32x4*)(blob + (f < 16 ? 16 + f : 40 + (f - 16)) * 1024 + lane * 16) = o;
        }
    }
    __syncthreads();
    {
        const int kt = wid >> 1, mt = wid & 1;
        f32x16 wt = {}, ut = {};
        const int nks = mt == 0 ? 2 : 4;
        for (int ks = 0; ks < nks; ++ks) {
            wt = DN_MFMA(lds16(lds + L_KST + ((32 * kt + r) * LT + 16 * ks + 8 * h2) * 2), lds16(lds + L_TW + ((32 * mt + r) * LT + 16 * ks + 8 * h2) * 2), wt);
            ut = DN_MFMA(lds16(lds + L_TU + ((32 * mt + r) * LT + 16 * ks + 8 * h2) * 2), lds16(lds + L_VST + ((32 * kt + r) * LT + 16 * ks + 8 * h2) * 2), ut);
        }
#pragma unroll
        for (int i = 0; i < 16; ++i) wt[i] = -wt[i];
        *(u32x4*)(blob + (mt * 8 + 2 * kt + 0) * 1024 + lane * 16) = __builtin_bit_cast(u32x4, pack_acc<0>(wt));
        *(u32x4*)(blob + (mt * 8 + 2 * kt + 1) * 1024 + lane * 16) = __builtin_bit_cast(u32x4, pack_acc<1>(wt));
        unsigned char* uf = UF + (size_t)item * UF_BYTES + ((kt * 2 + mt) * 64 + lane) * 32;
        *(u32x4*)uf = __builtin_bit_cast(u32x4, pack_acc<0>(ut)); *(u32x4*)(uf + 16) = __builtin_bit_cast(u32x4, pack_acc<1>(ut));
    }
    __syncthreads();
}

constexpr int S_SLOT = 32768, S_END = 4 * S_SLOT;
DNI void glds16(const void* gsrc, LAS unsigned char* dst) { __builtin_amdgcn_global_load_lds((const GAS unsigned*)gsrc, (LAS unsigned*)dst, 16, 0, 0); }
DNI void scan_bh(LAS unsigned char* lds, int bh, const unsigned char* BLOB, const unsigned char* UF, const float* GL, unsigned char* SF, unsigned char* VF) {
    int tid = threadIdx.x; asm volatile("" : "+v"(tid));
    const int wid = __builtin_amdgcn_readfirstlane(tid >> 6), lane = tid & 63;
    const unsigned char* blob0 = BLOB + (size_t)bh * 64 * BLOB_BYTES;
    unsigned lane16 = (unsigned)lane * 16u; asm volatile("" : "+v"(lane16));
#define DN_B() do { __builtin_amdgcn_s_barrier(); asm volatile("" ::: "memory"); } while (0)
    if (wid >= 4) {
        const int lw = wid - 4;
#define DN_ISSUE(c) do { const unsigned char* bc_ = blob0 + (size_t)(c) * BLOB_BYTES + lw * 1024; LAS unsigned char* sl_ = lds + ((c) & 3) * S_SLOT + lw * 1024; _Pragma("unroll") for (int i_ = 0; i_ < 4; ++i_) { \
        glds16(bc_ + i_ * 4096 + lane16, sl_ + i_ * 4096); glds16(bc_ + 40960 + i_ * 4096 + lane16, sl_ + 16384 + i_ * 4096); } } while (0)
        DN_ISSUE(0); DN_ISSUE(1); DN_ISSUE(2);
        asm volatile("s_waitcnt vmcnt(16)" ::: "memory"); DN_B();
#pragma unroll 1
        for (int c = 0; c < 64; ++c) {
            if (c + 3 < 64) { DN_ISSUE(c + 3); asm volatile("s_waitcnt vmcnt(16)" ::: "memory"); }
            else if (c + 2 < 64) asm volatile("s_waitcnt vmcnt(8)" ::: "memory");
            else asm volatile("s_waitcnt vmcnt(0)" ::: "memory");
            DN_B();
        }
#undef DN_ISSUE
    } else {
        const float glv = GL[bh * 64 + lane];
        const unsigned char* uf0 = UF + (size_t)bh * 64 * UF_BYTES + (wid * 128 + lane) * 32;
        unsigned char* sf0 = SF + ((size_t)(bh * 64) * 4 + wid) * 8192 + lane * 16;
        unsigned char* vf0 = VF + ((size_t)(bh * 64) * 4 + wid) * 4096 + lane * 16;
        f32x16 S0 = {}, S1 = {}, S2 = {}, S3 = {};
        u32x4 ua[4], ub[4];
#define DN_ULOAD(U, c) do { const unsigned char* u_ = uf0 + (size_t)(c) * UF_BYTES; U[0] = *(const u32x4*)u_; U[1] = *(const u32x4*)(u_ + 16); U[2] = *(const u32x4*)(u_ + 2048); U[3] = *(const u32x4*)(u_ + 2048 + 16); } while (0)
        DN_ULOAD(ua, 0); DN_ULOAD(ub, 1);
        DN_B();
#define RD4(X, f0, f1, f2, f3) do { asm volatile("ds_read_b128 %0, %4 offset:%5\n\tds_read_b128 %1, %4 offset:%6\n\tds_read_b128 %2, %4 offset:%7\n\tds_read_b128 %3, %4 offset:%8" \
        : "=&v"(X##0), "=&v"(X##1), "=&v"(X##2), "=&v"(X##3) : "v"(fba), "i"((f0) * 1024), "i"((f1) * 1024), "i"((f2) * 1024), "i"((f3) * 1024)); __builtin_amdgcn_sched_barrier(0); } while (0)
#define PIN2(a, b) asm volatile("" : "+v"(a), "+v"(b))
#define PIN4(a, b, c, d) asm volatile("" : "+v"(a), "+v"(b), "+v"(c), "+v"(d))
#define LWAIT() do { asm volatile("s_waitcnt lgkmcnt(0)" ::: "memory"); __builtin_amdgcn_sched_barrier(0); } while (0)
#define DN_STEP(U, c) do { \
            const unsigned fba = (unsigned)(uintptr_t)(lds + ((c) & 3) * S_SLOT) + lane16; \
            const float gl = __builtin_bit_cast(float, __builtin_amdgcn_readlane(__builtin_bit_cast(int, glv), (c))); \
            f32x16 v0, v1; \
            _Pragma("unroll") for (int i = 0; i < 8; ++i) { v0[2 * i] = bflo_(U[i >> 2][i & 3]); v0[2 * i + 1] = bfhi_(U[i >> 2][i & 3]); v1[2 * i] = bflo_(U[2 + (i >> 2)][i & 3]); v1[2 * i + 1] = bfhi_(U[2 + (i >> 2)][i & 3]); } \
            PIN2(v0, v1); \
            if ((c) + 2 < 64) DN_ULOAD(U, (c) + 2); \
            asm volatile("s_waitcnt lgkmcnt(0)" ::: "memory"); \
            unsigned char* sfc = sf0 + (size_t)(c) * 32768; unsigned char* vfc = vf0 + (size_t)(c) * 16384; \
            bf16x8 A0, A1, A2, A3, B0, B1, B2, B3; \
            RD4(A, 0, 8, 1, 9); LWAIT(); \
              \
            { const bf16x8 s0_ = pack_acc<0>(S0), s1_ = pack_acc<1>(S0); *(u32x4*)(sfc) = __builtin_bit_cast(u32x4, s0_); *(u32x4*)(sfc + 1024) = __builtin_bit_cast(u32x4, s1_); RD4(B, 2, 10, 3, 11); \
              v0 = DN_MFMA(A0, s0_, v0); v1 = DN_MFMA(A1, s0_, v1); v0 = DN_MFMA(A2, s1_, v0); v1 = DN_MFMA(A3, s1_, v1); PIN2(v0, v1); LWAIT(); } \
            { const bf16x8 s0_ = pack_acc<0>(S1), s1_ = pack_acc<1>(S1); *(u32x4*)(sfc + 2048) = __builtin_bit_cast(u32x4, s0_); *(u32x4*)(sfc + 3072) = __builtin_bit_cast(u32x4, s1_); RD4(A, 4, 12, 5, 13); \
              v0 = DN_MFMA(B0, s0_, v0); v1 = DN_MFMA(B1, s0_, v1); v0 = DN_MFMA(B2, s1_, v0); v1 = DN_MFMA(B3, s1_, v1); PIN2(v0, v1); LWAIT(); } \
            { const bf16x8 s0_ = pack_acc<0>(S2), s1_ = pack_acc<1>(S2); *(u32x4*)(sfc + 4096) = __builtin_bit_cast(u32x4, s0_); *(u32x4*)(sfc + 5120) = __builtin_bit_cast(u32x4, s1_); RD4(B, 6, 14, 7, 15); \
              v0 = DN_MFMA(A0, s0_, v0); v1 = DN_MFMA(A1, s0_, v1); v0 = DN_MFMA(A2, s1_, v0); v1 = DN_MFMA(A3, s1_, v1); PIN2(v0, v1); LWAIT(); } \
            { const bf16x8 s0_ = pack_acc<0>(S3), s1_ = pack_acc<1>(S3); *(u32x4*)(sfc + 6144) = __builtin_bit_cast(u32x4, s0_); *(u32x4*)(sfc + 7168) = __builtin_bit_cast(u32x4, s1_); RD4(A, 16, 20, 24, 28); \
              v0 = DN_MFMA(B0, s0_, v0); v1 = DN_MFMA(B1, s0_, v1); v0 = DN_MFMA(B2, s1_, v0); v1 = DN_MFMA(B3, s1_, v1); PIN2(v0, v1); LWAIT(); } \
            const bf16x8 vf0_ = pack_acc<0>(v0), vf1_ = pack_acc<1>(v0), vf2_ = pack_acc<0>(v1), vf3_ = pack_acc<1>(v1); \
            *(u32x4*)(vfc) = __builtin_bit_cast(u32x4, vf0_); *(u32x4*)(vfc + 1024) = __builtin_bit_cast(u32x4, vf1_); *(u32x4*)(vfc + 2048) = __builtin_bit_cast(u32x4, vf2_); *(u32x4*)(vfc + 3072) = __builtin_bit_cast(u32x4, vf3_); \
            _Pragma("unroll") for (int i = 0; i < 16; ++i) { S0[i] *= gl; S1[i] *= gl; S2[i] *= gl; S3[i] *= gl; } \
              \
            RD4(B, 17, 21, 25, 29); \
            S0 = DN_MFMA(A0, vf0_, S0); S1 = DN_MFMA(A1, vf0_, S1); S2 = DN_MFMA(A2, vf0_, S2); S3 = DN_MFMA(A3, vf0_, S3); PIN4(S0, S1, S2, S3); LWAIT(); \
            RD4(A, 18, 22, 26, 30); \
            S0 = DN_MFMA(B0, vf1_, S0); S1 = DN_MFMA(B1, vf1_, S1); S2 = DN_MFMA(B2, vf1_, S2); S3 = DN_MFMA(B3, vf1_, S3); PIN4(S0, S1, S2, S3); LWAIT(); \
            RD4(B, 19, 23, 27, 31); \
            S0 = DN_MFMA(A0, vf2_, S0); S1 = DN_MFMA(A1, vf2_, S1); S2 = DN_MFMA(A2, vf2_, S2); S3 = DN_MFMA(A3, vf2_, S3); PIN4(S0, S1, S2, S3); LWAIT(); \
            S0 = DN_MFMA(B0, vf3_, S0); S1 = DN_MFMA(B1, vf3_, S1); S2 = DN_MFMA(B2, vf3_, S2); S3 = DN_MFMA(B3, vf3_, S3); PIN4(S0, S1, S2, S3); \
            __builtin_amdgcn_sched_barrier(0); \
            DN_B(); } while (0)
#pragma unroll 1
        for (int c = 0; c < 64; c += 2) { DN_STEP(ua, c); DN_STEP(ub, c + 1); }
#undef DN_STEP
#undef RD4
#undef PIN2
#undef PIN4
#undef LWAIT
#undef DN_ULOAD
    }
    __syncthreads();
#undef DN_B
}

constexpr int O_OT = 0, O_NW = 2 * 64 * LQ * 2, O_END = O_NW + 512;
DNI void chunk_out(LAS unsigned char* lds, int item, const unsigned char* BLOB, const unsigned char* SF, const unsigned char* VF, const bf16* DNZ, const float* norm_w, bf16* Y) {
    int tid = threadIdx.x; asm volatile("" : "+v"(tid));
    const int wid = __builtin_amdgcn_readfirstlane(tid >> 6), lane = tid & 63, r = lane & 31, h2 = lane >> 5, half = wid >> 2, w = wid & 3;
    const int ck = 2 * item + half;
    const int n = ck & 63, hd = (ck >> 6) & 3, b = ck >> 8;
    if (tid < 128) ((LAS float*)(lds + O_NW))[tid] = norm_w[tid];
    const unsigned char* blob = BLOB + (size_t)ck * BLOB_BYTES + lane * 16;
    const unsigned char* sfp = SF + ((size_t)ck * 4 + w) * 8192 + lane * 16;
    const unsigned char* vfp = VF + ((size_t)ck * 4 + w) * 4096 + lane * 16;
    f32x16 o0 = {}, o1 = {};
#define GF(f) (*(const bf16x8*)(blob + (f) * 1024))
    {
        bf16x8 sf[8], vf[4], qa[8], qb[8];
#pragma unroll
        for (int s = 0; s < 8; ++s) { sf[s] = *(const bf16x8*)(sfp + s * 1024); qa[s] = GF(16 + s); }
#pragma unroll
        for (int s = 0; s < 8; ++s) qb[s] = GF(24 + s);
#pragma unroll
        for (int s2 = 0; s2 < 4; ++s2) vf[s2] = *(const bf16x8*)(vfp + s2 * 1024);
#pragma unroll
        for (int s = 0; s < 8; ++s) o0 = DN_MFMA(qa[s], sf[s], o0);
#pragma unroll
        for (int s2 = 0; s2 < 4; ++s2) { qa[s2] = GF(32 + s2); qa[4 + s2] = GF(36 + s2); }
#pragma unroll
        for (int s = 0; s < 8; ++s) o1 = DN_MFMA(qb[s], sf[s], o1);
#pragma unroll
        for (int s2 = 0; s2 < 4; ++s2) { o0 = DN_MFMA(qa[s2], vf[s2], o0); o1 = DN_MFMA(qa[4 + s2], vf[s2], o1); }
    }
#undef GF
    {
        LAS unsigned char* obp = lds + O_OT + half * (64 * LQ * 2) + ((4 * h2) * LQ + 32 * w + r) * 2;
#pragma unroll
        for (int i = 0; i < 16; ++i) {
            *(LAS unsigned short*)(obp + ((i & 3) + 8 * (i >> 2)) * (LQ * 2)) = (unsigned short)(cvtpk2(o0[i], 0.f) & 0xffffu);
            *(LAS unsigned short*)(obp + (32 + (i & 3) + 8 * (i >> 2)) * (LQ * 2)) = (unsigned short)(cvtpk2(o1[i], 0.f) & 0xffffu);
        }
    }
    __syncthreads();
    {
        const int t4 = tid & 255, pos = t4 >> 2, seg = t4 & 3;
        const LAS unsigned char* op = lds + O_OT + half * (64 * LQ * 2) + (pos * LQ + seg * 32) * 2;
        u32x4 wv[4];
#pragma unroll
        for (int q = 0; q < 4; ++q) wv[q] = *(const LAS u32x4*)(op + q * 16);
        float ss = 0.f;
#pragma unroll
        for (int q = 0; q < 4; ++q)
#pragma unroll
            for (int e = 0; e < 4; ++e) { const float a = bflo_(wv[q][e]), c = bfhi_(wv[q][e]); ss += a * a + c * c; }
        ss += __shfl_xor(ss, 1); ss += __shfl_xor(ss, 2);
        const float rs = rsqrtf(ss * (1.f / 128.f) + 1e-6f);
        const size_t m = (size_t)b * 4096 + (size_t)n * 64 + pos;
        const bf16* zp = DNZ + m * 512 + hd * 128 + seg * 32; bf16* yp = Y + m * 1024 + hd * 128 + seg * 32; const LAS float* nw = (const LAS float*)(lds + O_NW) + seg * 32;
#pragma unroll
        for (int q = 0; q < 4; ++q) {
            const u32x4 z = *(const u32x4*)(zp + q * 8); u32x4 o;
#pragma unroll
            for (int e = 0; e < 4; ++e) {
                const float z0 = bflo_(z[e]), z1 = bfhi_(z[e]);
                o[e] = cvtpk2(bflo_(wv[q][e]) * rs * nw[q * 8 + 2 * e] * (z0 / (1.f + __expf(-z0))), bfhi_(wv[q][e]) * rs * nw[q * 8 + 2 * e + 1] * (z1 / (1.f + __expf(-z1))));
            }
            *(u32x4*)(yp + q * 8) = o;
        }
    }
    __syncthreads();
}
#undef DN_MFMA
#undef DNI
}
constexpr int NWAVES = 8, NTHR = NWAVES * 64;
constexpr int BATCH = 4, SEQ = 4096, DM = 1024, M = BATCH * SEQ;
constexpr int HD = 128, NH = 4, DDN = 512, DMB = 512, NPROJ = 3584, DINP = 3592;
constexpr int MBLK = 256, NBLK = SEQ / MBLK;
constexpr int NE = 16, DE = 256;
constexpr float LN_EPS = 1e-5f, RMS_EPS = 1e-6f, ALPHA = 1.189207115002721f, QSCALE = 0.08838834764831845f;

constexpr size_t MiB = 1u << 20;
constexpr size_t WS_CTL = 0, CTL_ZERO_BYTES = 1 * MiB;
constexpr size_t WS_WIN = 2 * MiB;
constexpr size_t WS_WOUT = 10 * MiB;
constexpr size_t WS_WGU = 12 * MiB;
constexpr size_t WS_WD = 28 * MiB;
constexpr size_t WS_ROPE = 36 * MiB;
constexpr size_t WS_KMP = 38 * MiB;
constexpr size_t WS_GATES = 39 * MiB;
constexpr size_t WS_BETA = WS_GATES + 512 * 1024;
constexpr size_t WS_GLOG = WS_BETA + 256 * 1024;
constexpr size_t WS_XB = 48 * MiB;
constexpr size_t WS_DNQN = 48 * MiB, WS_DNKN = 64 * MiB;
constexpr size_t WS_PJ = 80 * MiB;
constexpr size_t PJ_STRIDE = 16 * MiB;
constexpr size_t WS_Y = 192 * MiB;
constexpr size_t WS_DNVN = 224 * MiB;
constexpr size_t WS_GL = 40 * MiB;
constexpr size_t WS_SF = 48 * MiB;
constexpr size_t WS_VF = 224 * MiB;
constexpr size_t WS_UF = 240 * MiB;
constexpr size_t WS_TOKE = 41 * MiB;
constexpr size_t WS_TOKP = WS_TOKE + 256 * 1024;
constexpr size_t WS_TOKW = WS_TOKP + 256 * 1024;
constexpr size_t WS_HB = 48 * MiB;
constexpr size_t WS_HS = 80 * MiB;
constexpr size_t WS_HE = 152 * MiB;
constexpr size_t WS_Y2 = 170 * MiB;
constexpr size_t WS_MIXB = 224 * MiB;
constexpr size_t WS_END = 256 * MiB;
constexpr int CW_CNT = 64;
constexpr int CW_SEAM = 16384;
constexpr size_t WS_LIST = 43 * MiB;
constexpr size_t WS_XBUF = 42 * MiB;
constexpr int CW_BAR = 4096;

constexpr int RING_OFF = 0, RING_BYTES = 139264;
constexpr int LDSCTL_OFF = RING_BYTES, MISC_OFF = LDSCTL_OFF + 320;
constexpr int LDS_BYTES = 147456;

#define DI __device__ __forceinline__
DI float bf2f(unsigned short v) { return __uint_as_float((unsigned)v << 16); }
DI float bflo(unsigned w) { return __uint_as_float(w << 16); }
DI float bfhi(unsigned w) { return __uint_as_float(w & 0xffff0000u); }
DI float wave_sum(float v) {
#pragma unroll
    for (int o = 1; o < 64; o <<= 1) v += __shfl_xor(v, o);
    return v;
}
DI float wave_max(float v) {
#pragma unroll
    for (int o = 1; o < 64; o <<= 1) v = fmaxf(v, __shfl_xor(v, o));
    return v;
}
DI float silu_f(float v) { return v / (1.f + __expf(-v)); }
DI float softplus_f(float v) { return fmaxf(v, 0.f) + log1pf(__expf(-fabsf(v))); }

struct Args {
    const GAS float* in_[18]; GAS float* out_; GAS unsigned char* ws_; int ph_lo, ph_hi;
    DI const float* I(int k) const { return (const float*)in_[k]; }
    DI float* O() const { return (float*)out_; }
    DI unsigned char* W() const { return (unsigned char*)ws_; }
};
#define CAS __attribute__((address_space(4)))
struct KA {
    const CAS unsigned char* p;
    DI const float* I(int k) const { return (const float*)(*(const GAS float* const CAS*)(p + 8 * k)); }
    DI float* O() const { return (float*)(*(GAS float* const CAS*)(p + 144)); }
    DI unsigned char* W() const { return (unsigned char*)(*(GAS unsigned char* const CAS*)(p + 152)); }
    DI int lo() const { return *(const CAS int*)(p + 160); }
    DI int hi() const { return *(const CAS int*)(p + 164); }
};
static_assert(offsetof(Args, out_) == 144 && offsetof(Args, ws_) == 152 && offsetof(Args, ph_lo) == 160 && offsetof(Args, ph_hi) == 164, "Args layout");
DI KA kargs() { KA a; a.p = (const CAS unsigned char*)__builtin_amdgcn_kernarg_segment_ptr(); asm volatile("" : "+s"(a.p)); return a; }
struct Frame {
    LAS unsigned char* lds;
    int tid, lane, wave, vcu, G;
};

struct TItem { const float* src; int ldw; bf16* dst; int K; };
DI void t_load(const TItem& t, f32x4 (&v)[8], int lane) {
    const float* p = t.src + (size_t)(lane >> 3) * t.ldw + 4 * (lane & 7);
#pragma unroll
    for (int i = 0; i < 8; ++i) v[i] = *(const f32x4*)(p + (size_t)(8 * i) * t.ldw);
}
DI void t_store(const TItem& t, const f32x4 (&v)[8], LAS float* scr, int lane) {
    { LAS float* q = scr + (lane >> 3) * 33 + 4 * (lane & 7);
#pragma unroll
      for (int i = 0; i < 8; ++i) { q[i * 264] = v[i].x; q[i * 264 + 1] = v[i].y; q[i * 264 + 2] = v[i].z; q[i * 264 + 3] = v[i].w; } }
    LDS_WAIT(); asm volatile("" ::: "memory");
    const int c = lane & 7;
#pragma unroll
    for (int j = 0; j < 4; ++j) { const int n = (lane >> 3) + 8 * j; const LAS float* s = scr + (8 * c) * 33 + n;
        v4u o; o.x = pk2(s[0 * 33], s[1 * 33]); o.y = pk2(s[2 * 33], s[3 * 33]); o.z = pk2(s[4 * 33], s[5 * 33]); o.w = pk2(s[6 * 33], s[7 * 33]);
        *(GAS v4u*)(t.dst + (size_t)n * t.K + 8 * c) = o; }
    LDS_WAIT(); asm volatile("" ::: "memory");
}

DI void p0_prologue(const Frame& F, const KA& A) {
    unsigned char* ws = A.W();
    const float* x = A.I(0); const float* w_in = A.I(1); const float* w_out = A.I(6);
    const int gw = F.vcu * NWAVES + F.wave, NGW = F.G * NWAVES;
#ifndef DUP_P0A
#define DUP_P0A 1
#endif
#ifndef DUP_P0B
#define DUP_P0B 1
#endif
    for (int ra_ = 0; ra_ < DUP_P0A; ++ra_) {
        LAS float* wgl = (LAS float*)(F.lds + RING_OFF);
        for (int i = F.tid; i < 1024 * 8; i += NTHR) { const int k = i >> 3, q = i & 7;
            wgl[(q >> 2) * 4096 + ((((k >> 8) * 4 + (k & 3)) * 64 + ((k & 255) >> 2)) << 2) + (q & 3)] = w_in[(size_t)k * DINP + 2048 + q]; }
        __syncthreads();
        bf16* XB = (bf16*)(ws + WS_XB); float* GATES = (float*)(ws + WS_GATES);
        for (int m0 = gw * 4; m0 < M; m0 += NGW * 4) {
            f32x4 v[4][4];
#pragma unroll
            for (int rr = 0; rr < 4; ++rr) { const GAS f32x4* xr = (const GAS f32x4*)(x + (size_t)(m0 + rr) * DM) + F.lane;
#pragma unroll
                for (int j = 0; j < 4; ++j) v[rr][j] = xr[64 * j]; }
            float g[4][8];
#pragma unroll
            for (int rr = 0; rr < 4; ++rr) {
#pragma unroll
                for (int q = 0; q < 8; ++q) g[rr][q] = 0.f; }
#pragma unroll
            for (int j = 0; j < 4; ++j) {
#pragma unroll
                for (int rr = 0; rr < 4; ++rr) { GAS unsigned long long* o8 = (GAS unsigned long long*)(XB + (size_t)(m0 + rr) * DM) + F.lane;
                    o8[64 * j] = (unsigned long long)pk2(v[rr][j].x, v[rr][j].y) | ((unsigned long long)pk2(v[rr][j].z, v[rr][j].w) << 32); }
#pragma unroll
                for (int e = 0; e < 4; ++e) {
                    const f32x4 w0 = *(const LAS f32x4*)(wgl + (((j * 4 + e) * 64 + F.lane) << 2)), w1 = *(const LAS f32x4*)(wgl + 4096 + (((j * 4 + e) * 64 + F.lane) << 2));
#pragma unroll
                    for (int rr = 0; rr < 4; ++rr) { const float xv = v[rr][j][e];
                        g[rr][0] += xv * w0.x; g[rr][1] += xv * w0.y; g[rr][2] += xv * w0.z; g[rr][3] += xv * w0.w;
                        g[rr][4] += xv * w1.x; g[rr][5] += xv * w1.y; g[rr][6] += xv * w1.z; g[rr][7] += xv * w1.w; }
                }
            }
#pragma unroll
            for (int rr = 0; rr < 4; ++rr) {
#pragma unroll
                for (int q = 0; q < 8; ++q) g[rr][q] = wave_sum(g[rr][q]);
                if (F.lane == 0) {
#pragma unroll
                    for (int q = 0; q < 8; ++q) GATES[(size_t)(m0 + rr) * 8 + q] = g[rr][q];
                }
            }
        }
        __syncthreads();
    }
    for (int rb_ = 0; rb_ < DUP_P0B; ++rb_) {
        LAS float* scr = (LAS float*)(F.lds + RING_OFF + F.wave * 16384);
        bf16* WIN = (bf16*)(ws + WS_WIN); bf16* WOUT = (bf16*)(ws + WS_WOUT);
        constexpr int I_A = 16 * 64, I_B = 16 * 48, I_O = 16 * 32, I_GU = NE * 4 * 64, I_D = NE * 128, I_ALL = I_A + I_B + I_O + I_GU + I_D;
        const float* wgate = A.I(13); const float* wup = A.I(14); const float* wdn = A.I(15);
        bf16* WGU = (bf16*)(ws + WS_WGU); bf16* WD = (bf16*)(ws + WS_WD);
        auto item = [&](int r) -> TItem {
            TItem t;
            if (r < I_A) { const int kb = r / 64, nb = r % 64; t.src = w_in + (size_t)(64 * kb) * DINP + 32 * nb; t.ldw = DINP; t.dst = WIN + (size_t)(32 * nb) * DM + 64 * kb; t.K = DM; return t; } r -= I_A;
            if (r < I_B) { const int kb = r / 48, nb = r % 48; int dst = 2048 + 32 * nb;
#ifdef ROPE_EPI
                if (nb < 32) { const int sl = nb >> 4, cis = 32 * (nb & 15), head = cis >> 7, dblk = (cis & 127) >> 5;
                    dst = 2048 + sl * 512 + (head >> 1) * 256 + (dblk < 2 ? (head & 1) * 64 + 32 * dblk : 128 + (head & 1) * 64 + 32 * (dblk - 2)); }
#endif
                t.src = w_in + (size_t)(64 * kb) * DINP + 2056 + 32 * nb; t.ldw = DINP; t.dst = WIN + (size_t)dst * DM + 64 * kb; t.K = DM; return t; } r -= I_B;
            if (r < I_O) { const int kb = r / 32, nb = r % 32; t.src = w_out + (size_t)(64 * kb) * DM + 32 * nb; t.ldw = DM; t.dst = WOUT + (size_t)(32 * nb) * DM + 64 * kb; t.K = DM; return t; } r -= I_O;
            if (r < I_GU) {
                const int e = r >> 8, q = (r >> 6) & 3, pn = q >> 1, up = q & 1, kb = (r >> 2) & 15, nb = r & 3;
                t.src = (up ? wup : wgate) + (size_t)e * DM * DE + (size_t)(64 * kb) * DE + pn * 128 + 32 * nb; t.ldw = DE;
                t.dst = WGU + (size_t)(e * 512 + pn * 256 + up * 128 + 32 * nb) * DM + 64 * kb; t.K = DM; return t; } r -= I_GU;
            { const int e = r >> 7, kb = (r >> 5) & 3, nb = r & 31;
              t.src = wdn + (size_t)e * DE * DM + (size_t)(64 * kb) * DM + 32 * nb; t.ldw = DM; t.dst = WD + (size_t)e * DM * DE + (size_t)(32 * nb) * DE + 64 * kb; t.K = DE; return t; }
        };
        f32x4 va[8], vb[8];
        int it = gw;
        if (it < I_ALL) { const TItem t0 = item(it); t_load(t0, va, F.lane); }
#pragma unroll 1
        for (; it < I_ALL; it += 2 * NGW) {
            const bool hb = it + NGW < I_ALL;
            if (hb) { const TItem t1 = item(it + NGW); t_load(t1, vb, F.lane); }
            { const TItem t0 = item(it); t_store(t0, va, scr, F.lane); }
            if (!hb) break;
            if (it + 2 * NGW < I_ALL) { const TItem t2 = item(it + 2 * NGW); t_load(t2, va, F.lane); }
            { const TItem t1 = item(it + NGW); t_store(t1, vb, scr, F.lane); }
        }
    }
    {
        float2* ROPE = (float2*)(ws + WS_ROPE);
        for (int i = (F.vcu * NTHR + F.tid); i < SEQ * 64; i += F.G * NTHR) {
            const int pos = i >> 6, j = i & 63;
            const float inv = exp2f(-(float)j * (13.287712379549449f / 64.f));
            const float ang = (float)pos * inv;
            double rev = (double)ang * 0.15915494309189535; rev -= __builtin_rint(rev);
            const float rr = (float)rev;
            ROPE[i] = make_float2(__builtin_amdgcn_cosf(rr), __builtin_amdgcn_sinf(rr));
        }
    }
}

DI void n2a_conv_norm(const Frame& F, const KA& A) {
    unsigned char* ws = A.W();
    const float* conv_w = A.I(2); const float* a_log = A.I(3); const float* dt_bias = A.I(4);
    const bf16* PJ = (const bf16*)(ws + WS_PJ);
    bf16* OUTX[3] = {(bf16*)(ws + WS_DNQN), (bf16*)(ws + WS_DNKN), (bf16*)(ws + WS_DNVN)};
    const float* GATES = (const float*)(ws + WS_GATES); float* BETA = (float*)(ws + WS_BETA); float* GLOG = (float*)(ws + WS_GLOG);
    const int gw = F.vcu * NWAVES + F.wave, NGW = F.G * NWAVES;
    for (int it = gw; it < M * NH; it += NGW) {
        const int m = it >> 2, h = it & 3, t = m & (SEQ - 1), c = 2 * F.lane;
        float val[3][2];
#pragma unroll
        for (int X = 0; X < 3; ++X) {
            float a0 = 0.f, a1 = 0.f;
#pragma unroll
            for (int j = 0; j < 4; ++j) {
                const int tt = t - 3 + j;
                if (tt >= 0) {
                    const unsigned raw = *(const unsigned*)(PJ + X * (PJ_STRIDE / 2) + (size_t)(m - 3 + j) * 512 + h * 128 + c);
                    const float w0 = conv_w[j * 1536 + X * 512 + h * 128 + c], w1 = conv_w[j * 1536 + X * 512 + h * 128 + c + 1];
                    a0 += w0 * bflo(raw); a1 += w1 * bfhi(raw);
                }
            }
            val[X][0] = silu_f(a0); val[X][1] = silu_f(a1);
        }
        const float sq = wave_sum(val[0][0] * val[0][0] + val[0][1] * val[0][1]);
        const float sk = wave_sum(val[1][0] * val[1][0] + val[1][1] * val[1][1]);
        const float rq = rsqrtf(sq + 1e-6f) * QSCALE, rk = rsqrtf(sk + 1e-6f);
        val[0][0] *= rq; val[0][1] *= rq; val[1][0] *= rk; val[1][1] *= rk;
#pragma unroll
        for (int X = 0; X < 3; ++X) *(unsigned*)(OUTX[X] + (size_t)m * 512 + h * 128 + c) = pk2(val[X][0], val[X][1]);
        if (F.lane == 0) {
            const float bb = GATES[(size_t)m * 8 + h], aa = GATES[(size_t)m * 8 + 4 + h];
            BETA[(size_t)m * 4 + h] = 1.f / (1.f + __expf(-bb));
            GLOG[(size_t)m * 4 + h] = -__expf(a_log[h]) * softplus_f(aa + dt_bias[h]);
        }
    }
}

DI void rope8(bf16* p, const float2* rp, float* s1, float* s2) {
    const v4u lo = *(const v4u*)p, hi = *(const v4u*)(p + 64);
    const f32x4 c0 = *(const f32x4*)rp, c1 = *(const f32x4*)(rp + 2), c2 = *(const f32x4*)(rp + 4), c3 = *(const f32x4*)(rp + 6);
    const float cs[8] = {c0.x, c0.z, c1.x, c1.z, c2.x, c2.z, c3.x, c3.z}, sn[8] = {c0.y, c0.w, c1.y, c1.w, c2.y, c2.w, c3.y, c3.w};
    float r1[8], r2[8];
#pragma unroll
    for (int e = 0; e < 4; ++e) {
        const float a0 = bflo(lo[e]), a1 = bfhi(lo[e]), b0 = bflo(hi[e]), b1 = bfhi(hi[e]);
        r1[2 * e] = a0 * cs[2 * e] - b0 * sn[2 * e]; r2[2 * e] = b0 * cs[2 * e] + a0 * sn[2 * e];
        r1[2 * e + 1] = a1 * cs[2 * e + 1] - b1 * sn[2 * e + 1]; r2[2 * e + 1] = b1 * cs[2 * e + 1] + a1 * sn[2 * e + 1];
    }
    v4u o1, o2;
#pragma unroll
    for (int e = 0; e < 4; ++e) { o1[e] = pk2(r1[2 * e], r1[2 * e + 1]); o2[e] = pk2(r2[2 * e], r2[2 * e + 1]); }
    *(v4u*)p = o1; *(v4u*)(p + 64) = o2;
    if (s1) {
#pragma unroll
        for (int e = 0; e < 8; ++e) { s1[e] += r1[e]; s2[e] += r2[e]; }
    }
}
DI void n3a_rope(const Frame& F, const KA& A) {
    unsigned char* ws = A.W();
    bf16* MBQ = (bf16*)(ws + WS_PJ + 4 * PJ_STRIDE); bf16* MBK = (bf16*)(ws + WS_PJ + 5 * PJ_STRIDE);
    const float2* ROPE = (const float2*)(ws + WS_ROPE); float* KMP = (float*)(ws + WS_KMP);
    const int gw = F.vcu * NWAVES + F.wave, NGW = F.G * NWAVES, rr = F.lane >> 3, dseg = F.lane & 7;
    for (int it = gw; it < 1024; it += NGW) {
        const int qtr = it & 3, j = (it >> 2) & 15, h = (it >> 6) & 3, b = it >> 8;
        float s1[8], s2[8];
#pragma unroll
        for (int e = 0; e < 8; ++e) { s1[e] = 0.f; s2[e] = 0.f; }
#pragma unroll 2
        for (int r8 = 0; r8 < 8; ++r8) {
            const int pos = j * 256 + qtr * 64 + r8 * 8 + rr; const size_t m = (size_t)b * SEQ + pos;
            rope8(MBK + m * 512 + h * 128 + dseg * 8, ROPE + pos * 64 + dseg * 8, s1, s2);
        }
#pragma unroll
        for (int e = 0; e < 8; ++e) { s1[e] += __shfl_xor(s1[e], 8); s1[e] += __shfl_xor(s1[e], 16); s1[e] += __shfl_xor(s1[e], 32);
                                      s2[e] += __shfl_xor(s2[e], 8); s2[e] += __shfl_xor(s2[e], 16); s2[e] += __shfl_xor(s2[e], 32); }
        if (rr == 0) {
#pragma unroll
            for (int e = 0; e < 8; ++e) { KMP[(size_t)it * 128 + dseg * 8 + e] = s1[e]; KMP[(size_t)it * 128 + 64 + dseg * 8 + e] = s2[e]; }
        }
    }
    for (int it = gw; it < (M / 8) * NH; it += NGW) {
        const int m8 = it >> 2, h = it & 3; const size_t m = (size_t)m8 * 8 + rr; const int pos = (int)(m & (SEQ - 1));
        rope8(MBQ + m * 512 + h * 128 + dseg * 8, ROPE + pos * 64 + dseg * 8, nullptr, nullptr);
    }
}

DI void n2b_dn_recurrent(const Frame& F, const KA& A, int item, float* ODN) {
    unsigned char* ws = A.W();
    const bf16* QN = (const bf16*)(ws + WS_DNQN); const bf16* KN = (const bf16*)(ws + WS_DNKN); const bf16* VN = (const bf16*)(ws + WS_DNVN);
    const float* BETA = (const float*)(ws + WS_BETA); const float* GLOG = (const float*)(ws + WS_GLOG);
    const int b = item >> 2, h = item & 3;
    LAS float* qs = (LAS float*)(F.lds + RING_OFF);
    LAS float* ks = qs + 16 * 128; LAS float* vs = ks + 16 * 128; LAS float* bs = vs + 16 * 128; LAS float* as = bs + 16;
    float S[128];
#pragma unroll
    for (int k = 0; k < 128; ++k) S[k] = 0.f;
    for (int t0 = 0; t0 < SEQ; t0 += 16) {
        __syncthreads();
        for (int idx = F.tid; idx < 16 * 384; idx += NTHR) {
            const int r = idx / 384, c = idx % 384, X = c >> 7, cc = c & 127; const size_t m = (size_t)b * SEQ + t0 + r;
            const bf16* src = X == 0 ? QN : (X == 1 ? KN : VN);
            (X == 0 ? qs : (X == 1 ? ks : vs))[r * 128 + cc] = bf2f(src[m * 512 + h * 128 + cc]);
        }
        if (F.tid < 16) { const size_t m = (size_t)b * SEQ + t0 + F.tid; bs[F.tid] = BETA[m * 4 + h]; as[F.tid] = __expf(GLOG[m * 4 + h]); }
        __syncthreads();
        if (F.tid < 128) {
#pragma unroll 1
            for (int r = 0; r < 16; ++r) {
                const LAS float* kr = ks + r * 128; const LAS float* qr = qs + r * 128;
                float kS = 0.f;
#pragma unroll
                for (int kb = 0; kb < 128; kb += 16) {
#pragma unroll
                    for (int k = 0; k < 16; ++k) kS += kr[kb + k] * S[kb + k];
                    asm volatile("" ::: "memory");
                }
                const float al = as[r], be = bs[r];
                const float vn = be * (vs[r * 128 + F.tid] - al * kS);
                float o = 0.f;
#pragma unroll
                for (int kb = 0; kb < 128; kb += 16) {
#pragma unroll
                    for (int k = 0; k < 16; ++k) { S[kb + k] = al * S[kb + k] + kr[kb + k] * vn; o += qr[kb + k] * S[kb + k]; }
                    asm volatile("" ::: "memory");
                }
                ODN[((size_t)b * SEQ + t0 + r) * 512 + h * 128 + F.tid] = o;
            }
        }
    }
}

DI void n3b_moba_naive(const Frame& F, const KA& A, int w0, int nw, bf16* Yo, int ypitch, int ycol0) {
    unsigned char* ws = A.W();
    const bf16* MBQ = (const bf16*)(ws + WS_PJ + 4 * PJ_STRIDE); const bf16* MBK = (const bf16*)(ws + WS_PJ + 5 * PJ_STRIDE); const bf16* MBV = (const bf16*)(ws + WS_PJ + 6 * PJ_STRIDE);
    const float* KMP = (const float*)(ws + WS_KMP);
    LAS float* qs = (LAS float*)(F.lds + RING_OFF + 32768) + F.wave * 128;
    const int lane = F.lane;
    for (int it = w0; it < M * NH; it += nw) {
        const int m = it >> 2, h = it & 3, b = m >> 12, t = m & (SEQ - 1), own = t >> 8;
        { const unsigned raw = *(const unsigned*)(MBQ + (size_t)m * 512 + h * 128 + 2 * lane); qs[2 * lane] = bflo(raw) * QSCALE; qs[2 * lane + 1] = bfhi(raw) * QSCALE; }
        asm volatile("s_waitcnt lgkmcnt(0)" ::: "memory");
        float gate = -3e38f;
        if (lane < own) {
            const float* kp = KMP + (size_t)(((b * 4 + h) * 16 + lane) * 4) * 128; float acc = 0.f;
            for (int dd = 0; dd < 128; ++dd) acc += qs[dd] * ((kp[dd] + kp[128 + dd]) + (kp[256 + dd] + kp[384 + dd]));
            gate = acc * (1.f / 256.f);
        }
        int blist[4] = {-1, -1, -1, own};
#pragma unroll
        for (int r = 0; r < 3; ++r) {
            const float mx = wave_max(gate);
            if (mx > -1e37f) {
                const unsigned long long bal = __ballot(gate == mx); const int idx = __builtin_ctzll(bal);
                blist[r] = idx; if (lane == idx) gate = -3e38f;
            }
        }
        float sc[4][4]; float mloc = -3e38f;
#pragma unroll
        for (int s = 0; s < 4; ++s) {
            const int jb = blist[s];
#pragma unroll
            for (int i = 0; i < 4; ++i) {
                float v = -3e38f;
                if (jb >= 0) {
                    const int key = jb * 256 + i * 64 + lane;
                    if (s < 3 || key <= t) {
                        const bf16* kp = MBK + ((size_t)b * SEQ + key) * 512 + h * 128; float acc = 0.f;
#pragma unroll 4
                        for (int c8 = 0; c8 < 16; ++c8) { const v4u w = *(const v4u*)(kp + c8 * 8); const LAS float* q8 = qs + c8 * 8;
                            acc += q8[0] * bflo(w.x) + q8[1] * bfhi(w.x) + q8[2] * bflo(w.y) + q8[3] * bfhi(w.y) + q8[4] * bflo(w.z) + q8[5] * bfhi(w.z) + q8[6] * bflo(w.w) + q8[7] * bfhi(w.w); }
                        v = acc;
                    }
                }
                sc[s][i] = v; mloc = fmaxf(mloc, v);
            }
        }
        const float mx = wave_max(mloc); float lsum = 0.f;
#pragma unroll
        for (int s = 0; s < 4; ++s)
#pragma unroll
            for (int i = 0; i < 4; ++i) { const float p = sc[s][i] > -1e37f ? __expf(sc[s][i] - mx) : 0.f; sc[s][i] = p; lsum += p; }
        const float l = wave_sum(lsum);
        float o0 = 0.f, o1 = 0.f;
#pragma unroll
        for (int s = 0; s < 4; ++s) {
            const int jb = blist[s];
            if (jb >= 0) {
#pragma unroll
                for (int i = 0; i < 4; ++i) {
                    const bf16* vp = MBV + ((size_t)b * SEQ + jb * 256 + i * 64) * 512 + h * 128 + 2 * lane;
                    for (int src = 0; src < 64; ++src) {
                        const float pv = __shfl(sc[s][i], src);
                        if (pv != 0.f) { const unsigned raw = *(const unsigned*)(vp + (size_t)src * 512); o0 += pv * bflo(raw); o1 += pv * bfhi(raw); }
                    }
                }
            }
        }
        const float il = 1.f / l;
        *(unsigned*)(Yo + (size_t)m * ypitch + ycol0 + h * 128 + 2 * lane) = pk2(o0 * il, o1 * il);
        asm volatile("s_waitcnt lgkmcnt(0)" ::: "memory");
    }
}

DI void n2c_dn_gate(const Frame& F, const KA& A, const float* ODN, bf16* Yo, int ypitch) {
    unsigned char* ws = A.W();
    const float* norm_w = A.I(5); const bf16* DNZ = (const bf16*)(ws + WS_PJ + 3 * PJ_STRIDE);
    const int gw = F.vcu * NWAVES + F.wave, NGW = F.G * NWAVES, c = 2 * F.lane;
    for (int it = gw; it < M * NH; it += NGW) {
        const int m = it >> 2, h = it & 3;
        const float2 o = *(const float2*)(ODN + (size_t)m * 512 + h * 128 + c);
        const float ss = wave_sum(o.x * o.x + o.y * o.y) * (1.f / 128.f);
        const float rs = rsqrtf(ss + RMS_EPS);
        const unsigned zr = *(const unsigned*)(DNZ + (size_t)m * 512 + h * 128 + c);
        *(unsigned*)(Yo + (size_t)m * ypitch + h * 128 + c) = pk2(o.x * rs * norm_w[c] * silu_f(bflo(zr)), o.y * rs * norm_w[c + 1] * silu_f(bfhi(zr)));
    }
}

constexpr int CW_DBG = 16;
DI void dbg_compare(const Frame& F, unsigned char* ws, const bf16* T, int tp, int tc0, const bf16* R, int rp, int rc0) {
    float sd = 0.f, sr = 0.f;
    for (int i = F.vcu * NTHR + F.tid; i < M * 256; i += F.G * NTHR) {
        const int m = i >> 8, c = (i & 255) * 2;
        const unsigned a = *(const unsigned*)(T + (size_t)m * tp + tc0 + c), b = *(const unsigned*)(R + (size_t)m * rp + rc0 + c);
        const float d0 = bflo(a) - bflo(b), d1 = bfhi(a) - bfhi(b); sd += d0 * d0 + d1 * d1; sr += bflo(b) * bflo(b) + bfhi(b) * bfhi(b);
    }
    sd = wave_sum(sd); sr = wave_sum(sr);
    if (F.lane == 0) { atomicAdd((float*)(ws + WS_CTL) + CW_DBG, sd); atomicAdd((float*)(ws + WS_CTL) + CW_DBG + 1, sr); }
}
DI float block_sum(float v, LAS float* red, int tid) {
    v = wave_sum(v);
    __syncthreads();
    if ((tid & 63) == 0) red[tid >> 6] = v;
    __syncthreads();
    float s = 0.f;
#pragma unroll
    for (int w = 0; w < NWAVES; ++w) s += red[w];
    return s;
}

DI void n5_token_tail(const Frame& F, const KA& A) {
    const float* x = A.I(0); const float* g1 = A.I(7); const float* b1 = A.I(8);
    const float* rw1 = A.I(9); const float* rb1 = A.I(10); const float* rw2 = A.I(11); const float* rb2 = A.I(12);
    const float* wg = A.I(13); const float* wu = A.I(14); const float* wd = A.I(15); const float* g2 = A.I(16); const float* b2 = A.I(17);
    float* out = A.O();
    LAS float* hs = (LAS float*)(F.lds + RING_OFF);
    LAS float* hes = hs + 1024;
    LAS float* lg = hes + 512;
    LAS float* red = lg + 32;
    LAS float* rt_ = red + 8;
    const int tid = F.tid;
    for (int m = blockIdx.x; m < M; m += F.G) {
        __syncthreads();
        const size_t ro = (size_t)m * DM;
        float v0 = ALPHA * x[ro + tid] + out[ro + tid], v1 = ALPHA * x[ro + tid + 512] + out[ro + tid + 512];
        const float mean = block_sum(v0 + v1, red, tid) * (1.f / DM);
        v0 -= mean; v1 -= mean;
        const float var = block_sum(v0 * v0 + v1 * v1, red, tid) * (1.f / DM);
        const float rstd = rsqrtf(var + LN_EPS);
        const float h0 = v0 * rstd * g1[tid] + b1[tid], h1 = v1 * rstd * g1[tid + 512] + b1[tid + 512];
        hs[tid] = h0; hs[tid + 512] = h1;
        __syncthreads();
        for (int li = F.wave; li < 20; li += NWAVES) {
            float acc = 0.f;
            for (int k = F.lane; k < DM; k += 64) {
                const float wv = li < 4 ? rw1[k * 4 + li] : rw2[((size_t)((li - 4) >> 2) * DM + k) * 4 + ((li - 4) & 3)];
                acc += hs[k] * wv;
            }
            acc = wave_sum(acc);
            if (F.lane == 0) lg[li] = acc;
        }
        __syncthreads();
        if (tid == 0) {
            float pgv[4]; float mx = -3e38f;
            for (int g = 0; g < 4; ++g) { pgv[g] = lg[g] + rb1[g]; mx = fmaxf(mx, pgv[g]); }
            float sum = 0.f; for (int g = 0; g < 4; ++g) { pgv[g] = __expf(pgv[g] - mx); sum += pgv[g]; }
            int gs = 0; for (int g = 1; g < 4; ++g) if (pgv[g] > pgv[gs]) gs = g;
            const float pg = pgv[gs] / sum;
            float pe[4]; mx = -3e38f;
            for (int e = 0; e < 4; ++e) { pe[e] = lg[4 + gs * 4 + e] + rb2[gs * 4 + e]; mx = fmaxf(mx, pe[e]); }
            sum = 0.f; for (int e = 0; e < 4; ++e) { pe[e] = __expf(pe[e] - mx); sum += pe[e]; }
            int e0 = 0; for (int e = 1; e < 4; ++e) if (pe[e] > pe[e0]) e0 = e;
            int e1 = (e0 == 0) ? 1 : 0; for (int e = 0; e < 4; ++e) if (e != e0 && pe[e] > pe[e1]) e1 = e;
            const float den = pe[e0] + pe[e1];
            rt_[0] = __int_as_float(gs * 4 + e0); rt_[1] = __int_as_float(gs * 4 + e1); rt_[2] = pg * pe[e0] / den; rt_[3] = pg * pe[e1] / den;
        }
        __syncthreads();
        const int ex[2] = {__float_as_int(rt_[0]), __float_as_int(rt_[1])}; const float wx[2] = {rt_[2], rt_[3]};
        {
            const int half = tid >> 8, j = tid & 255, e = ex[half];
            const float* pg_ = wg + (size_t)e * DM * DE + j; const float* pu_ = wu + (size_t)e * DM * DE + j;
            float ga = 0.f, ua = 0.f;
#pragma unroll 8
            for (int k = 0; k < DM; ++k) { const float hv = hs[k]; ga += hv * pg_[(size_t)k * DE]; ua += hv * pu_[(size_t)k * DE]; }
            hes[half * 256 + j] = silu_f(ga) * ua;
        }
        __syncthreads();
        float y0 = 0.f, y1 = 0.f;
#pragma unroll
        for (int half = 0; half < 2; ++half) {
            const float* pd = wd + (size_t)ex[half] * DE * DM + tid; float a0 = 0.f, a1 = 0.f;
#pragma unroll 8
            for (int j = 0; j < DE; ++j) { const float hv = hes[half * 256 + j]; a0 += hv * pd[(size_t)j * DM]; a1 += hv * pd[(size_t)j * DM + 512]; }
            y0 += wx[half] * a0; y1 += wx[half] * a1;
        }
        float u0 = ALPHA * h0 + y0, u1 = ALPHA * h1 + y1;
        const float mean2 = block_sum(u0 + u1, red, tid) * (1.f / DM);
        u0 -= mean2; u1 -= mean2;
        const float var2 = block_sum(u0 * u0 + u1 * u1, red, tid) * (1.f / DM);
        const float rstd2 = rsqrtf(var2 + LN_EPS);
        float dscale = 1.f;
#ifdef DBG_ANY
        { const float* dw = (const float*)(A.W() + WS_CTL) + CW_DBG; dscale = 1.f + sqrtf(dw[0] / fmaxf(dw[1], 1e-30f)); }
#endif
        out[ro + tid] = (u0 * rstd2 * g2[tid] + b2[tid]) * dscale; out[ro + tid + 512] = (u1 * rstd2 * g2[tid + 512] + b2[tid + 512]) * dscale;
    }
}

struct MbPart { int own, t_lo, t_hi, slot; };
struct MbSplit { int own, slot0, nparts; };
constexpr int MB_NPARTS = 30, MB_NSLOTS = 24, MB_NSPLIT = 10;
__device__ const MbPart MB_PARTS[MB_NPARTS] = {{5, 0, 24, -1}, {11, 0, 24, 10}, {11, 24, 48, 11}, {10, 0, 22, 8}, {10, 22, 44, 9}, {15, 0, 22, 21}, {15, 22, 44, 22}, {4, 0, 20, -1}, {9, 0, 20, 6}, {9, 20, 40, 7}, {13, 0, 20, 15}, {13, 20, 40, 16}, {14, 0, 20, 18}, {14, 20, 40, 19}, {14, 40, 60, 20}, {15, 44, 64, 23}, {8, 0, 18, 4}, {8, 18, 36, 5}, {12, 0, 18, 12}, {12, 18, 36, 13}, {3, 0, 16, -1}, {7, 0, 16, 2}, {7, 16, 32, 3}, {12, 36, 52, 14}, {13, 40, 56, 17}, {6, 0, 14, 0}, {6, 14, 28, 1}, {2, 0, 12, -1}, {1, 0, 8, -1}, {0, 0, 4, -1}};
__device__ const MbSplit MB_SPLITS[MB_NSPLIT] = {{6, 0, 2}, {7, 2, 2}, {8, 4, 2}, {9, 6, 2}, {10, 8, 2}, {11, 10, 2}, {12, 12, 3}, {13, 15, 3}, {14, 18, 3}, {15, 21, 3}};
constexpr size_t WS_MBPO = WS_PJ;
constexpr size_t WS_MBLSE = WS_PJ + 24 * MiB;
constexpr int CW_MBQ = 96;
typedef mb::BlockRef<bf16, bf16> mbref_t;
DI mbref_t mb_ref(unsigned char* ws, int p, int xq) {
    const int bh = __builtin_amdgcn_readfirstlane(2 * xq + (p & 1)), k = __builtin_amdgcn_readfirstlane(p >> 1);
    const MbPart pt = MB_PARTS[k];
    const int own = __builtin_amdgcn_readfirstlane(pt.own), slot = __builtin_amdgcn_readfirstlane(pt.slot);
    const int b = bh >> 2, h = bh & 3; const size_t row0 = (size_t)b * SEQ;
    mbref_t r;
    r.Q = (const bf16*)(ws + WS_PJ + 4 * PJ_STRIDE) + (row0 + (size_t)own * 256) * 512 + h * 128;
    r.K = (const bf16*)(ws + WS_PJ + 5 * PJ_STRIDE) + row0 * 512 + h * 128;
    r.V = (const bf16*)(ws + WS_PJ + 6 * PJ_STRIDE) + row0 * 512 + h * 128;
    r.O = (bf16*)(ws + WS_Y) + (row0 + (size_t)own * 256) * 1024 + 512 + h * 128;
#ifdef ROPE_EPI
    r.KM = (const float*)(ws + WS_KMP) + (size_t)(bh * 16) * 128;
#else
    r.KM = (const float*)(ws + WS_KMP) + (size_t)(bh * 64) * 128;
#endif
    r.P0 = own * 256; r.t_lo = __builtin_amdgcn_readfirstlane(pt.t_lo); r.t_hi = __builtin_amdgcn_readfirstlane(pt.t_hi);
    r.OP = slot >= 0 ? (bf16*)(ws + WS_MBPO) + (size_t)(bh * MB_NSLOTS + slot) * (256 * 128) : nullptr;
    r.LSE = slot >= 0 ? (float*)(ws + WS_MBLSE) + (size_t)(bh * MB_NSLOTS + slot) * 256 : nullptr;
    return r;
}
DI int mb_claim(unsigned char* ws, LAS unsigned* word, int tid, int xq) {
    if (tid == 0) *word = __hip_atomic_fetch_add((unsigned*)(ws + WS_CTL) + CW_MBQ + 64 * xq, 1u, __ATOMIC_RELAXED, __HIP_MEMORY_SCOPE_AGENT);
    __syncthreads();
    const int p = __builtin_amdgcn_readfirstlane((int)*word);
    __syncthreads();
    return p;
}
DI void p3_moba_queue(unsigned char* ws, char* lds, LAS unsigned* word, int tid, int xq) {
    constexpr int WBIG = 0x3fffffff, NP = MB_NPARTS * 2;
    int p = mb_claim(ws, word, tid, xq);
    if (p >= NP) return;
    mbref_t cur = mb_ref(ws, p, xq);
    mb::Seam<bf16> S;
    mb::causal_swa_prime<bf16, bf16>(cur, WBIG, lds, S);
#pragma unroll 1
    for (;;) {
        const int pn = mb_claim(ws, word, tid, xq);
        const bool more = pn < NP;
        const mbref_t nxt = more ? mb_ref(ws, pn, xq) : cur;
        mb::causal_swa_block<bf16, bf16>(cur, nxt, SEQ, WBIG, lds, S);
        if (!more) break;
        cur = nxt;
    }
}
DI mbref_t mb_ref_full(unsigned char* ws, int bh, int own_) {
    const int own = __builtin_amdgcn_readfirstlane(own_); const int b = bh >> 2, h = bh & 3; const size_t row0 = (size_t)b * SEQ;
    mbref_t r;
    r.Q = (const bf16*)(ws + WS_PJ + 4 * PJ_STRIDE) + (row0 + (size_t)own * 256) * 512 + h * 128;
    r.K = (const bf16*)(ws + WS_PJ + 5 * PJ_STRIDE) + row0 * 512 + h * 128;
    r.V = (const bf16*)(ws + WS_PJ + 6 * PJ_STRIDE) + row0 * 512 + h * 128;
    r.O = (bf16*)(ws + WS_Y) + (row0 + (size_t)own * 256) * 1024 + 512 + h * 128;
#ifdef ROPE_EPI
    r.KM = (const float*)(ws + WS_KMP) + (size_t)(bh * 16) * 128;
#else
    r.KM = (const float*)(ws + WS_KMP) + (size_t)(bh * 64) * 128;
#endif
    r.P0 = own * 256; r.t_lo = 0; r.t_hi = 4 * (own + 1); r.OP = nullptr; r.LSE = nullptr;
    return r;
}
DI void p3_moba_static(unsigned char* ws, char* lds, int bh, int own0, int own1) {
    constexpr int WBIG = 0x3fffffff;
    const int n = own1 >= 0 ? 2 : 1;
    mbref_t cur = mb_ref_full(ws, bh, own0);
    mb::Seam<bf16> S;
    mb::causal_swa_prime<bf16, bf16>(cur, WBIG, lds, S);
#pragma unroll 1
    for (int i = 0; i < n; ++i) {
        const mbref_t nxt = (i + 1 < n) ? mb_ref_full(ws, bh, own1) : cur;
        mb::causal_swa_block<bf16, bf16>(cur, nxt, SEQ, WBIG, lds, S);
        cur = nxt;
    }
}
DI void p4_moba_merge(unsigned char* ws, int it, int tid) {
    const int rh = it & 1, bh = (it >> 1) & 15; const MbSplit sp = MB_SPLITS[it >> 5];
    const int np = __builtin_amdgcn_readfirstlane(sp.nparts);
    const int b = bh >> 2, h = bh & 3, row = rh * 128 + (tid >> 2), qc = tid & 3;
    const float* lse = (const float*)(ws + WS_MBLSE) + (size_t)(bh * MB_NSLOTS + sp.slot0) * 256 + row;
    const bf16* po = (const bf16*)(ws + WS_MBPO) + (size_t)(bh * MB_NSLOTS + sp.slot0) * (256 * 128) + row * 128 + qc * 32;
    float l[3]; v4u w[3][4];
#pragma unroll
    for (int q = 0; q < 3; ++q) {
        const int qq = q < np ? q : 0;
        l[q] = lse[qq * 256];
#pragma unroll
        for (int c8 = 0; c8 < 4; ++c8) w[q][c8] = *(const v4u*)(po + (size_t)qq * (256 * 128) + c8 * 8);
    }
    float mx = -3e38f;
#pragma unroll
    for (int q = 0; q < 3; ++q) { l[q] = q < np ? l[q] : -__builtin_inff(); mx = fmaxf(mx, l[q]); }
    float wsum = 0.f;
#pragma unroll
    for (int q = 0; q < 3; ++q) { l[q] = __builtin_amdgcn_exp2f(l[q] - mx); wsum += l[q]; }
    const float inv = 1.f / wsum;
    bf16* yp = (bf16*)(ws + WS_Y) + ((size_t)b * SEQ + (size_t)sp.own * 256 + row) * 1024 + 512 + h * 128 + qc * 32;
#pragma unroll
    for (int c8 = 0; c8 < 4; ++c8) {
        v4u o;
#pragma unroll
        for (int e = 0; e < 4; ++e) {
            const float a0 = l[0] * bflo(w[0][c8][e]) + l[1] * bflo(w[1][c8][e]) + l[2] * bflo(w[2][c8][e]);
            const float a1 = l[0] * bfhi(w[0][c8][e]) + l[1] * bfhi(w[1][c8][e]) + l[2] * bfhi(w[2][c8][e]);
            o[e] = pk2(a0 * inv, a1 * inv);
        }
        *(v4u*)(yp + c8 * 8) = o;
    }
}

DI void p6_ln_router(const Frame& F, const KA& A) {
    unsigned char* ws = A.W();
    const float* x = A.I(0); const float* g1 = A.I(7); const float* b1 = A.I(8);
    const float* rw1 = A.I(9); const float* rb1 = A.I(10); const float* rw2 = A.I(11); const float* rb2 = A.I(12);
    float* out = A.O(); bf16* HB = (bf16*)(ws + WS_HB); const bf16* MIXB = (const bf16*)(ws + WS_MIXB); (void)out; (void)MIXB;
    int* TOKE = (int*)(ws + WS_TOKE); int* TOKP = (int*)(ws + WS_TOKP); float* TOKW = (float*)(ws + WS_TOKW);
    unsigned* gcnt = (unsigned*)(ws + WS_CTL) + CW_CNT; int* LIST = (int*)(ws + WS_LIST);
    LAS float* rwl = (LAS float*)(F.lds + RING_OFF);
    LAS unsigned* lcnt = (LAS unsigned*)(F.lds + RING_OFF + 81920);
    for (int i = F.tid; i < 1024 * 20; i += NTHR) { const int k = i / 20, li = i % 20;
        rwl[i] = li < 4 ? rw1[k * 4 + li] : rw2[((size_t)((li - 4) >> 2) * DM + k) * 4 + ((li - 4) & 3)]; }
    if (F.tid < 32) lcnt[F.tid] = 0u;
    __syncthreads();
    const int gw = F.vcu * NWAVES + F.wave, NGW = F.G * NWAVES;
#ifdef LN1_FUSE
    for (int m = gw; m < M; m += NGW) {
        const size_t ro = (size_t)m * DM;
        f32x4 v[4];
        float lg[20];
#pragma unroll
        for (int q = 0; q < 20; ++q) lg[q] = 0.f;
#pragma unroll
        for (int j = 0; j < 4; ++j) {
            v[j] = *(const f32x4*)(out + ro + 256 * j + 4 * F.lane);
#pragma unroll
            for (int e = 0; e < 4; ++e) { const LAS float* wr_ = rwl + (256 * j + 4 * F.lane + e) * 20; const float hv = v[j][e];
#pragma unroll
                for (int q4 = 0; q4 < 5; ++q4) { const f32x4 w4 = *(const LAS f32x4*)(wr_ + 4 * q4);
                    lg[4 * q4] += hv * w4.x; lg[4 * q4 + 1] += hv * w4.y; lg[4 * q4 + 2] += hv * w4.z; lg[4 * q4 + 3] += hv * w4.w; } }
        }
#else
    for (int m = gw; m < M; m += NGW) {
        const size_t ro = (size_t)m * DM;
        f32x4 v[4]; float s = 0.f;
#pragma unroll
        for (int j = 0; j < 4; ++j) { const f32x4 xv = *(const f32x4*)(x + ro + 256 * j + 4 * F.lane); const uint2 mr = *(const uint2*)(MIXB + ro + 256 * j + 4 * F.lane);
            v[j].x = xv.x * ALPHA + bflo(mr.x); v[j].y = xv.y * ALPHA + bfhi(mr.x); v[j].z = xv.z * ALPHA + bflo(mr.y); v[j].w = xv.w * ALPHA + bfhi(mr.y); s += (v[j].x + v[j].y) + (v[j].z + v[j].w); }
        const float mean = wave_sum(s) * (1.f / DM); float s2 = 0.f;
#pragma unroll
        for (int j = 0; j < 4; ++j) { v[j] = v[j] - mean; s2 += (v[j].x * v[j].x + v[j].y * v[j].y) + (v[j].z * v[j].z + v[j].w * v[j].w); }
        const float rstd = rsqrtf(wave_sum(s2) * (1.f / DM) + LN_EPS);
        float lg[20];
#pragma unroll
        for (int q = 0; q < 20; ++q) lg[q] = 0.f;
#pragma unroll
        for (int j = 0; j < 4; ++j) {
            const f32x4 gv = *(const f32x4*)(g1 + 256 * j + 4 * F.lane), bv = *(const f32x4*)(b1 + 256 * j + 4 * F.lane);
            v[j] = v[j] * rstd * gv + bv;
            *(unsigned long long*)(HB + ro + 256 * j + 4 * F.lane) = (unsigned long long)pk2(v[j].x, v[j].y) | ((unsigned long long)pk2(v[j].z, v[j].w) << 32);
#pragma unroll
            for (int e = 0; e < 4; ++e) { const LAS float* wr_ = rwl + (256 * j + 4 * F.lane + e) * 20; const float hv = v[j][e];
#pragma unroll
                for (int q4 = 0; q4 < 5; ++q4) { const f32x4 w4 = *(const LAS f32x4*)(wr_ + 4 * q4);
                    lg[4 * q4] += hv * w4.x; lg[4 * q4 + 1] += hv * w4.y; lg[4 * q4 + 2] += hv * w4.z; lg[4 * q4 + 3] += hv * w4.w; } }
        }
#endif
#pragma unroll
        for (int q = 0; q < 20; ++q) lg[q] = wave_sum(lg[q]);
        float pgv[4]; float mx = -3e38f;
#pragma unroll
        for (int g = 0; g < 4; ++g) { pgv[g] = lg[g] + rb1[g]; mx = fmaxf(mx, pgv[g]); }
        float sum = 0.f;
#pragma unroll
        for (int g = 0; g < 4; ++g) { pgv[g] = __expf(pgv[g] - mx); sum += pgv[g]; }
        int gs = 0; float pbest = pgv[0];
#pragma unroll
        for (int g = 1; g < 4; ++g) if (pgv[g] > pbest) { pbest = pgv[g]; gs = g; }
        const float pg = pbest / sum;
        float pe[4]; mx = -3e38f;
#pragma unroll
        for (int e = 0; e < 4; ++e) { float l2 = 0.f;
#pragma unroll
            for (int g = 0; g < 4; ++g) l2 = (g == gs) ? lg[4 + g * 4 + e] + rb2[g * 4 + e] : l2;
            pe[e] = l2; mx = fmaxf(mx, l2); }
#pragma unroll
        for (int e = 0; e < 4; ++e) pe[e] = __expf(pe[e] - mx);
        int e0 = 0; float p0 = pe[0];
#pragma unroll
        for (int e = 1; e < 4; ++e) if (pe[e] > p0) { p0 = pe[e]; e0 = e; }
        int e1 = -1; float p1 = -1.f;
#pragma unroll
        for (int e = 0; e < 4; ++e) if (e != e0 && pe[e] > p1) { p1 = pe[e]; e1 = e; }
        const float den = p0 + p1; const int x0 = gs * 4 + e0, x1 = gs * 4 + e1;
        if (F.lane == 0) {
            const unsigned i0 = __hip_atomic_fetch_add(lcnt + x0, 1u, __ATOMIC_RELAXED, __HIP_MEMORY_SCOPE_WORKGROUP);
            const unsigned i1 = __hip_atomic_fetch_add(lcnt + x1, 1u, __ATOMIC_RELAXED, __HIP_MEMORY_SCOPE_WORKGROUP);
            TOKE[m] = x0 | (x1 << 8); TOKP[2 * m] = (int)i0; TOKP[2 * m + 1] = (int)i1; TOKW[2 * m] = pg * p0 / den; TOKW[2 * m + 1] = pg * p1 / den;
        }
    }
    __syncthreads();
    if (F.tid < 16) lcnt[16 + F.tid] = __hip_atomic_fetch_add(gcnt + F.tid, lcnt[F.tid], __ATOMIC_RELAXED, __HIP_MEMORY_SCOPE_AGENT);
    __syncthreads();
    for (int m = gw; m < M; m += NGW) {
        if (F.lane == 0) { const int ee = TOKE[m], e0 = ee & 255, e1 = ee >> 8; const int q0 = TOKP[2 * m] + (int)lcnt[16 + e0], q1 = TOKP[2 * m + 1] + (int)lcnt[16 + e1];
            TOKP[2 * m] = q0; TOKP[2 * m + 1] = q1; LIST[e0 * 16384 + q0] = m; LIST[e1 * 16384 + q1] = m; }
    }
}
DI void moe_tile_table(const Frame& F, unsigned char* ws, LAS int* tb) {
    if (F.wave == 0) {
        const unsigned* gcnt = (const unsigned*)(ws + WS_CTL) + CW_CNT; const int e = F.lane & 15;
        const int c = (int)__hip_atomic_load(gcnt + e, __ATOMIC_RELAXED, __HIP_MEMORY_SCOPE_AGENT);
        const int ct = (c + 255) >> 8, fl = c >> 8; int pc = ct, pf = fl;
#pragma unroll
        for (int d = 1; d < 16; d <<= 1) { const int a = __shfl_up(pc, d), b = __shfl_up(pf, d); if (e >= d) { pc += a; pf += b; } }
        if (F.lane < 16) { tb[e] = pc - ct; for (int k = 0; k < fl; ++k) tb[18 + pf - fl + k] = pc - ct + k; if (e == 15) { tb[16] = pc; tb[17] = pf; } }
    }
    __syncthreads();
}
typedef float f32x16m __attribute__((ext_vector_type(16)));
constexpr int TG_STAGE = 320 * 128;
template <int WR, int NCH, class WRowF, class TRowF>
DI void tail_gemm(const Frame& F, int r, WRowF wrow, TRowF trow, f32x16m (&acc)[WR / 32]) {
    const int TRp = (r + 31) & ~31, NQ = __builtin_amdgcn_readfirstlane((WR + TRp + 63) >> 6);
    const int l = F.lane, n = l & 31, kh = l >> 5;
    const char* gp[5];
#pragma unroll
    for (int q = 0; q < 5; ++q) { const int R = 8 * (F.wave + 8 * q) + (l >> 3);
        const char* base = R < WR ? wrow(R) : (R - WR < TRp ? trow(R - WR) : wrow(0));
        gp[q] = base + 16 * ((l & 7) ^ ((R >> 1) & 7)); }
#pragma unroll
    for (int wb = 0; wb < WR / 32; ++wb)
#pragma unroll
        for (int q = 0; q < 16; ++q) acc[wb][q] = 0.f;
    LAS unsigned char* ring = F.lds + RING_OFF;
#define TG_ISSUE(c, st) do { _Pragma("unroll") for (int q_ = 0; q_ < 5; ++q_) if (q_ < NQ) \
        __builtin_amdgcn_global_load_lds((const unsigned*)(gp[q_] + 128 * (c)), (LAS unsigned*)(ring + (st) * TG_STAGE + 1024 * (F.wave + 8 * q_)), 16, 0, 0); } while (0)
    TG_ISSUE(0, 0);
    if (NCH > 1) TG_ISSUE(1, 1);
    const bool active = 32 * F.wave < r;
    const int pofs = ((n >> 1) & 7);
    int st = 0;
#pragma unroll 1
    for (int c = 0; c < NCH; ++c) {
        if (c + 1 < NCH) { switch (NQ) { case 1: asm volatile("s_waitcnt vmcnt(1)" ::: "memory"); break; case 2: asm volatile("s_waitcnt vmcnt(2)" ::: "memory"); break; case 3: asm volatile("s_waitcnt vmcnt(3)" ::: "memory"); break;
                                         case 4: asm volatile("s_waitcnt vmcnt(4)" ::: "memory"); break; default: asm volatile("s_waitcnt vmcnt(5)" ::: "memory"); break; } }
        else asm volatile("s_waitcnt vmcnt(0)" ::: "memory");
        __builtin_amdgcn_s_barrier(); asm volatile("" ::: "memory");
        if (c + 2 < NCH) { const int s2 = st >= 1 ? st - 1 : 2; TG_ISSUE(c + 2, s2); }
        if (active) {
            const LAS unsigned char* sb = ring + st * TG_STAGE;
            bf16x8 b[4], a[WR / 32][4];
#pragma unroll
            for (int ks = 0; ks < 4; ++ks) { const int p = 16 * ((2 * ks + kh) ^ pofs);
                b[ks] = *(const LAS bf16x8*)(sb + (WR + 32 * F.wave + n) * 128 + p);
#pragma unroll
                for (int wb = 0; wb < WR / 32; ++wb) a[wb][ks] = *(const LAS bf16x8*)(sb + (32 * wb + n) * 128 + p); }
#pragma unroll
            for (int ks = 0; ks < 4; ++ks)
#pragma unroll
                for (int wb = 0; wb < WR / 32; ++wb) acc[wb] = __builtin_amdgcn_mfma_f32_32x32x16_bf16(a[wb][ks], b[ks], acc[wb], 0, 0, 0);
        }
        st = st == 2 ? 0 : st + 1;
    }
#undef TG_ISSUE
    asm volatile("" ::: "memory"); __builtin_amdgcn_s_barrier(); asm volatile("" ::: "memory");
}
DI void p8_tail(const Frame& F, unsigned char* ws, const LAS int* tb) {
    const bf16* HB = (const bf16*)(ws + WS_HB); const bf16* WGU = (const bf16*)(ws + WS_WGU); bf16* HE = (bf16*)(ws + WS_HE);
    const int* LIST = (const int*)(ws + WS_LIST); const unsigned* gcnt = (const unsigned*)(ws + WS_CTL) + CW_CNT;
    const int n = F.lane & 31, kh = F.lane >> 5;
    for (int u = F.vcu; u < 256; u += F.G) {
        const int e = u >> 4, s = u & 15;
        const int ce = __builtin_amdgcn_readfirstlane((int)__hip_atomic_load(gcnt + e, __ATOMIC_RELAXED, __HIP_MEMORY_SCOPE_AGENT)), full = ce >> 8, r = ce & 255;
        if (r == 0) continue;
        f32x16m acc[1];
        tail_gemm<32, 16>(F, r,
            [&](int R) -> const char* { return (const char*)(WGU + (size_t)(e * 512 + (s >> 3) * 256 + (R >= 16 ? 128 : 0) + (s & 7) * 16 + (R & 15)) * DM); },
            [&](int R) -> const char* { const int pos = full * 256 + R; const int tok = pos < ce ? LIST[e * 16384 + pos] : 0; return (const char*)(HB + (size_t)tok * DM); }, acc);
        const int pos = full * 256 + 32 * F.wave + n;
        if (pos < ce && 32 * F.wave < r) {
            bf16* orow = HE + ((size_t)tb[e] * 256 + pos) * DE + 16 * s + 4 * kh;
#pragma unroll
            for (int q = 0; q < 2; ++q) {
                float h[4];
#pragma unroll
                for (int t = 0; t < 4; ++t) { const float gt = acc[0][4 * q + t]; h[t] = gt / (1.f + __expf(-gt)) * acc[0][4 * (q + 2) + t]; }
                *(GAS unsigned long long*)(orow + 8 * q) = (unsigned long long)pk2(h[0], h[1]) | ((unsigned long long)pk2(h[2], h[3]) << 32);
            }
        }
    }
}
DI void p9_tail(const Frame& F, unsigned char* ws, const LAS int* tb) {
    const bf16* HE = (const bf16*)(ws + WS_HE); const bf16* WD = (const bf16*)(ws + WS_WD); bf16* Y2 = (bf16*)(ws + WS_Y2);
    const unsigned* gcnt = (const unsigned*)(ws + WS_CTL) + CW_CNT;
    const int n = F.lane & 31, kh = F.lane >> 5;
    for (int u = F.vcu; u < 256; u += F.G) {
        const int e = u >> 4, s = u & 15;
        const int ce = __builtin_amdgcn_readfirstlane((int)__hip_atomic_load(gcnt + e, __ATOMIC_RELAXED, __HIP_MEMORY_SCOPE_AGENT)), full = ce >> 8, r = ce & 255;
        if (r == 0) continue;
        const size_t row0 = (size_t)tb[e] * 256 + full * 256;
        f32x16m acc[2];
        tail_gemm<64, 4>(F, r,
            [&](int R) -> const char* { return (const char*)(WD + ((size_t)e * DM + 64 * s + R) * DE); },
            [&](int R) -> const char* { return (const char*)(HE + (row0 + R) * DE); }, acc);
        const int pos = full * 256 + 32 * F.wave + n;
        if (pos < ce && 32 * F.wave < r) {
#pragma unroll
            for (int c2 = 0; c2 < 2; ++c2) {
                bf16* orow = Y2 + (row0 + 32 * F.wave + n) * DM + 64 * s + 32 * c2 + 4 * kh;
#pragma unroll
                for (int q = 0; q < 4; ++q) *(GAS unsigned long long*)(orow + 8 * q) = (unsigned long long)pk2(acc[c2][4 * q], acc[c2][4 * q + 1]) | ((unsigned long long)pk2(acc[c2][4 * q + 2], acc[c2][4 * q + 3]) << 32);
            }
        }
    }
}
DI void p7_permute(const Frame& F, const KA& A) {
    unsigned char* ws = A.W();
    LAS int* tb = (LAS int*)(F.lds + RING_OFF);
    moe_tile_table(F, ws, tb);
    const bf16* HB = (const bf16*)(ws + WS_HB); bf16* HS = (bf16*)(ws + WS_HS);
    const int* TOKE = (const int*)(ws + WS_TOKE); const int* TOKP = (const int*)(ws + WS_TOKP);
    const int gw = F.vcu * NWAVES + F.wave, NGW = F.G * NWAVES;
    for (int it = gw; it < 2 * M; it += NGW) {
        const int m = it >> 1, k = it & 1; const int ee = TOKE[m]; const int e = k ? (ee >> 8) : (ee & 255);
        const size_t row = (size_t)tb[e] * 256 + TOKP[it];
        const v4u a0 = *(const v4u*)(HB + (size_t)m * DM + 8 * F.lane), a1 = *(const v4u*)(HB + (size_t)m * DM + 512 + 8 * F.lane);
        pg8::st16_wt(HS + row * DM + 8 * F.lane, a0); pg8::st16_wt(HS + row * DM + 512 + 8 * F.lane, a1);
    }
}
DI void p10_combine(const Frame& F, const KA& A) {
    unsigned char* ws = A.W();
    LAS int* tb = (LAS int*)(F.lds + RING_OFF);
    moe_tile_table(F, ws, tb);
    const float* g2 = A.I(16); const float* b2 = A.I(17); float* out = A.O();
    const bf16* Y2 = (const bf16*)(ws + WS_Y2);
    const bf16* HBc = (const bf16*)(ws + WS_HB); (void)HBc;
    const int* TOKE = (const int*)(ws + WS_TOKE); const int* TOKP = (const int*)(ws + WS_TOKP); const float* TOKW = (const float*)(ws + WS_TOKW);
    const int gw = F.vcu * NWAVES + F.wave, NGW = F.G * NWAVES;
    for (int m0 = gw * 2; m0 < M; m0 += NGW * 2) {
        int ee[2], tp[2][2]; float tw[2][2];
#pragma unroll
        for (int t = 0; t < 2; ++t) { const int m = m0 + t; ee[t] = TOKE[m]; tp[t][0] = TOKP[2 * m]; tp[t][1] = TOKP[2 * m + 1]; tw[t][0] = TOKW[2 * m]; tw[t][1] = TOKW[2 * m + 1]; }
        uint2 hr[2][4], ya[2][4], yb[2][4];
#pragma unroll
        for (int t = 0; t < 2; ++t) {
            const size_t ro = (size_t)(m0 + t) * DM;
            const size_t r0 = (size_t)tb[ee[t] & 255] * 256 + tp[t][0], r1 = (size_t)tb[ee[t] >> 8] * 256 + tp[t][1];
#pragma unroll
            for (int j = 0; j < 4; ++j) { hr[t][j] = *(const uint2*)(HBc + ro + 256 * j + 4 * F.lane);
                ya[t][j] = *(const uint2*)(Y2 + r0 * DM + 256 * j + 4 * F.lane); yb[t][j] = *(const uint2*)(Y2 + r1 * DM + 256 * j + 4 * F.lane); }
        }
#pragma unroll
        for (int t = 0; t < 2; ++t) {
            const size_t ro = (size_t)(m0 + t) * DM; const float w0 = tw[t][0], w1 = tw[t][1];
            f32x4 v[4]; float s = 0.f;
#pragma unroll
            for (int j = 0; j < 4; ++j) {
                v[j].x = ALPHA * bflo(hr[t][j].x) + w0 * bflo(ya[t][j].x) + w1 * bflo(yb[t][j].x); v[j].y = ALPHA * bfhi(hr[t][j].x) + w0 * bfhi(ya[t][j].x) + w1 * bfhi(yb[t][j].x);
                v[j].z = ALPHA * bflo(hr[t][j].y) + w0 * bflo(ya[t][j].y) + w1 * bflo(yb[t][j].y); v[j].w = ALPHA * bfhi(hr[t][j].y) + w0 * bfhi(ya[t][j].y) + w1 * bfhi(yb[t][j].y);
                s += (v[j].x + v[j].y) + (v[j].z + v[j].w);
            }
            const float mean = wave_sum(s) * (1.f / DM); float s2 = 0.f;
#pragma unroll
            for (int j = 0; j < 4; ++j) { v[j] = v[j] - mean; s2 += (v[j].x * v[j].x + v[j].y * v[j].y) + (v[j].z * v[j].z + v[j].w * v[j].w); }
            const float rstd = rsqrtf(wave_sum(s2) * (1.f / DM) + LN_EPS);
#pragma unroll
            for (int j = 0; j < 4; ++j) { const f32x4 gv = *(const f32x4*)(g2 + 256 * j + 4 * F.lane), bv = *(const f32x4*)(b2 + 256 * j + 4 * F.lane);
                *(f32x4*)(out + ro + 256 * j + 4 * F.lane) = v[j] * rstd * gv + bv; }
        }
    }
}

#ifndef DUP_P0
#define DUP_P0 1
#endif
#ifndef DUP_P1
#define DUP_P1 1
#endif
#ifndef DUP_P2
#define DUP_P2 1
#endif
#ifndef DUP_P3
#define DUP_P3 1
#endif
#ifndef DUP_P5
#define DUP_P5 1
#endif
#ifndef DUP_P7
#define DUP_P7 1
#endif
#ifndef DUP_P8
#define DUP_P8 1
#endif
#ifndef DUP_P9
#define DUP_P9 1
#endif
#ifdef SKIP_N2B
#define n2b_dn_recurrent(...) ((void)0)
#endif
#ifdef SKIP_N3B
#define n3b_moba_naive(...) ((void)0)
#endif
#ifdef SKIP_N5
#define n5_token_tail(...) ((void)0)
#endif
#ifdef SKIP_P0
#define p0_prologue(...) ((void)0)
#endif
#ifdef SKIP_N2A
#define n2a_conv_norm(...) ((void)0)
#endif
#ifdef SKIP_N3A
#define n3a_rope(...) ((void)0)
#endif
#ifdef SKIP_N2C
#define n2c_dn_gate(...) ((void)0)
#endif
#if defined(DBG_MOBA) || defined(DBG_DN)
#define DBG_ANY 1
#endif
#ifdef MOE_NAIVE
constexpr int N_PHASES = 7;
#else
constexpr int N_PHASES = 11;
#endif
__global__ void __launch_bounds__(NTHR, 2) mk_fwd(Args args_unused) {
    (void)args_unused;
    extern __shared__ __attribute__((aligned(16))) unsigned char lds[];
    Frame F;
    F.lds = (LAS unsigned char*)lds;
    F.tid = threadIdx.x; F.lane = F.tid & 63; F.wave = __builtin_amdgcn_readfirstlane(F.tid >> 6);
    F.G = gridDim.x; { const int bx = blockIdx.x; F.vcu = (F.G % 8 == 0) ? (bx % 8) * (F.G / 8) + bx / 8 : bx; }
    unsigned char* ws = kargs().W();
    gu32* ctl = (gu32*)(ws + WS_CTL);
    volatile LAS unsigned* MISC = (volatile LAS unsigned*)(F.lds + MISC_OFF);
    for (int u = F.tid; u < (LDS_BYTES - LDSCTL_OFF) / 4; u += NTHR) ((LAS unsigned*)(F.lds + LDSCTL_OFF))[u] = 0u;
    __syncthreads();
    const int lo = kargs().lo(), hi = kargs().hi();
    const bool multi = (hi - lo) > 1;
    XcdBarrier bar; bar.bar = (unsigned*)(ctl + CW_BAR); bar.x = 0; bar.st = nullptr;
    if (multi) bar = xcd_barrier_post((unsigned*)(ctl + CW_BAR), MISC + 8);
#define IN(k) (lo <= (k) && (k) < hi)
#define REFRESH_F() do { int t_ = threadIdx.x; asm volatile("" : "+v"(t_)); F.tid = t_; F.lane = t_ & 63; F.wave = __builtin_amdgcn_readfirstlane(t_ >> 6); } while (0)
#define SEAM(k) do { if (IN(k) && IN((k) + 1)) xcd_barrier(bar); } while (0)

    if (IN(0)) { REFRESH_F(); for (int rep_ = 0; rep_ < DUP_P0; ++rep_) { const KA args = kargs(); p0_prologue(F, args); __syncthreads(); } SEAM(0); }
    if (IN(1)) { REFRESH_F(); for (int rep_ = 0; rep_ < DUP_P1; ++rep_) {
        pg8::Gemm g{(const bf16*)(ws + WS_XB), (const bf16*)(ws + WS_WIN), M, NPROJ, DM}; pg8::StaticOrder S; S.init(M, NPROJ, F.G, (int)blockIdx.x);
#ifdef ROPE_EPI
        pg8::EpiProj E{(bf16*)(ws + WS_PJ), (size_t)(PJ_STRIDE / 2), (const float*)(ws + WS_ROPE), (float*)(ws + WS_KMP), (LAS float*)(F.lds + 131072)};
        pg8::gemm_phase<pg8::EpiProj, pg8::StaticOrder, true, PG8_SP2>(F.lds + RING_OFF, g, S, E); }
#else
        pg8::EpiBf16<0> E{(bf16*)(ws + WS_PJ), 512, nullptr, 512, (size_t)(PJ_STRIDE / 2), 1.f};
        pg8::gemm_phase<pg8::EpiBf16<0>, pg8::StaticOrder, PG8_ALIGN, PG8_SP2>(F.lds + RING_OFF, g, S, E); }
#endif
        SEAM(1);
    }
    if (IN(2)) { REFRESH_F();
        const KA args = kargs();
#if defined(DN_NAIVE) || defined(DBG_DN)
        n2a_conv_norm(F, args);
#endif
#ifndef DN_NAIVE
        {
            dn::RawQKV raw;
            int it = F.vcu;
            if (it < 1024) dn::chunk_load(raw, it, (const bf16*)(ws + WS_PJ), PJ_STRIDE / 2);
#pragma unroll 1
            for (; it < 1024; it += F.G)
                dn::chunk_local(F.lds, it, raw, it + F.G < 1024 ? it + F.G : -1, (const bf16*)(ws + WS_PJ), PJ_STRIDE / 2, (const float*)(ws + WS_GATES), args.I(2), args.I(3), args.I(4),
                                (unsigned char*)args.O(), ws + WS_UF, (float*)(ws + WS_GL));
        }
#endif
#ifndef ROPE_EPI
        n3a_rope(F, args);
#endif
        SEAM(2); }
    if (IN(3)) { REFRESH_F();
        const KA args = kargs();
#ifdef DN_NAIVE
        float* ODN = args.O();
#else
        float* ODN = (float*)(ws + WS_PJ);
#endif
        {
            const int v = F.vcu;
            const int bh = __builtin_amdgcn_readfirstlane(v >> 4), r = __builtin_amdgcn_readfirstlane(v & 15);
            if (r == 15 && v < 256) {
#if defined(DN_NAIVE) || defined(DBG_DN)
                n2b_dn_recurrent(F, args, bh, ODN);
#endif
#ifndef DN_NAIVE
                dn::scan_bh(F.lds, bh, (const unsigned char*)args.O(), ws + WS_UF, (const float*)(ws + WS_GL), ws + WS_SF, ws + WS_VF);
#endif
            }
#ifdef MB_QUEUE
            p3_moba_queue(ws, (char*)lds, (LAS unsigned*)(F.lds + LDSCTL_OFF + 640), F.tid, __builtin_amdgcn_readfirstlane((v >> 5) & 7));
#else
            if (r != 15) p3_moba_static(ws, (char*)lds, bh, 15 - r, r == 14 ? 0 : -1);
#endif
        }
        SEAM(3);
    }
    if (IN(4)) { REFRESH_F(); const KA args = kargs();
#ifdef DN_NAIVE
        n2c_dn_gate(F, args, args.O(), (bf16*)(ws + WS_Y), 1024);
#else
        for (int it = F.vcu; it < 512; it += F.G)
            dn::chunk_out(F.lds, it, (const unsigned char*)args.O(), ws + WS_SF, ws + WS_VF, (const bf16*)(ws + WS_PJ + 3 * PJ_STRIDE), args.I(5), (bf16*)(ws + WS_Y));
#endif
#ifdef MB_QUEUE
        for (int it = F.vcu; it < MB_NSPLIT * 32; it += F.G) p4_moba_merge(ws, it, F.tid);
#endif
        SEAM(4); }
    if (IN(5)) { REFRESH_F();
        const KA args = kargs();
        pg8::Gemm g{(const bf16*)(ws + WS_Y), (const bf16*)(ws + WS_WOUT), M, DM, DM}; pg8::StaticOrder S; S.init(M, DM, F.G, (int)blockIdx.x);
#if defined(MOE_NAIVE)
        pg8::EpiF32 E{args.O(), DM};
        for (int rep_ = 0; rep_ < DUP_P5; ++rep_) pg8::gemm_phase<pg8::EpiF32, pg8::StaticOrder, PG8_ALIGN, PG8_SP2>(F.lds + RING_OFF, g, S, E);
#elif !defined(LN1_FUSE)
        pg8::EpiBf16<0> E{(bf16*)(ws + WS_MIXB), DM, nullptr, 0, 0, 1.f};
        pg8::gemm_phase<pg8::EpiBf16<0>, pg8::StaticOrder, PG8_ALIGN, PG8_SP2>(F.lds + RING_OFF, g, S, E);
#else
        if (F.G == 256) {
            pg8::PanelStats st{(unsigned*)(ws + WS_XBUF), (unsigned*)(ws + WS_CTL) + CW_SEAM, (unsigned*)(ws + WS_CTL), DM / 256, LN_EPS, 0x740u};
            pg8::EpiLn1 E{args.I(0), args.O(), (bf16*)(ws + WS_HB), args.I(7), args.I(8), ALPHA, st, 0u};
            pg8::gemm_phase<pg8::EpiLn1, pg8::StaticOrder, false, PG8_SP2>(F.lds + RING_OFF, g, S, E);
        }
#endif
        SEAM(5);
    }
#ifdef MOE_NAIVE
    if (IN(6)) { REFRESH_F(); const KA args = kargs(); n5_token_tail(F, args); }
#else
    if (IN(6)) { REFRESH_F(); const KA args = kargs(); p6_ln_router(F, args); SEAM(6); }
#ifdef MOE_PERMUTE
    if (IN(7)) { REFRESH_F(); for (int rep_ = 0; rep_ < DUP_P7; ++rep_) { const KA args = kargs(); p7_permute(F, args); __syncthreads(); } SEAM(7); }
#endif
    if (IN(8)) { REFRESH_F();
        LAS int* tb = (LAS int*)(F.lds + LDSCTL_OFF + 1024); moe_tile_table(F, ws, tb);
#ifdef MOE_PERMUTE
        pg8::Gemm g{(const bf16*)(ws + WS_HS), (const bf16*)(ws + WS_WGU), 36864, 512, DM}; pg8::MoeOrder<false> S{(const LAS int*)tb, 2, F.G, (int)blockIdx.x, (size_t)512 * DM * 2, nullptr, nullptr};
#else
        pg8::Gemm g{(const bf16*)(ws + WS_HB), (const bf16*)(ws + WS_WGU), 36864, 512, DM}; pg8::MoeOrder<true> S{(const LAS int*)tb, 2, F.G, (int)blockIdx.x, (size_t)512 * DM * 2, (const int*)(ws + WS_LIST), (const unsigned*)(ws + WS_CTL) + CW_CNT};
#endif
        pg8::EpiSwiGLU E{(bf16*)(ws + WS_HE)};
        for (int rep_ = 0; rep_ < DUP_P8; ++rep_) pg8::gemm_phase<pg8::EpiSwiGLU, decltype(S), PG8_ALIGN, PG8_SP2>(F.lds + RING_OFF, g, S, E);
        REFRESH_F(); p8_tail(F, ws, tb);
        SEAM(8);
    }
    if (IN(9)) { REFRESH_F();
        LAS int* tb = (LAS int*)(F.lds + LDSCTL_OFF + 1024); moe_tile_table(F, ws, tb);
        int kdim = DE; asm volatile("" : "+s"(kdim));
        pg8::Gemm g{(const bf16*)(ws + WS_HE), (const bf16*)(ws + WS_WD), 36864, DM, kdim}; pg8::MoeOrder<false> S{(const LAS int*)tb, 4, F.G, (int)blockIdx.x, (size_t)DM * DE * 2, nullptr, nullptr};
        pg8::EpiBf16<0> E{(bf16*)(ws + WS_Y2), DM, nullptr, 0, 0, 1.f};
        for (int rep_ = 0; rep_ < DUP_P9; ++rep_) pg8::gemm_phase<pg8::EpiBf16<0>, pg8::MoeOrder<false>, PG8_ALIGN, PG8_SP2>(F.lds + RING_OFF, g, S, E);
        REFRESH_F(); p9_tail(F, ws, tb);
        SEAM(9);
    }
    if (IN(10)) { REFRESH_F(); const KA args = kargs(); p10_combine(F, args); }
#endif
#undef IN
#undef SEAM
}

extern "C" void kernel_launch(void* const* d_in, const int* in_sizes, int n_in, void* d_out, int out_size, void* d_ws, size_t ws_size, hipStream_t stream) {
    static int grid = 0;
    if (grid == 0) {
        if (n_in != 18 || in_sizes[0] != M * DM || out_size != M * DM || ws_size < WS_END) { fprintf(stderr, "kernel_launch: unexpected shapes (n_in %d, in0 %d, out %d, ws %zu)\n", n_in, n_in > 0 ? in_sizes[0] : -1, out_size, ws_size); grid = -1; return; }
        int dev = 0, cus = 0;
        if (hipGetDevice(&dev) != hipSuccess || hipDeviceGetAttribute(&cus, hipDeviceAttributeMultiprocessorCount, dev) != hipSuccess) { grid = -1; return; }
        if (hipFuncSetAttribute((const void*)mk_fwd, hipFuncAttributeMaxDynamicSharedMemorySize, LDS_BYTES) != hipSuccess) { fprintf(stderr, "kernel_launch: hipFuncSetAttribute failed\n"); grid = -1; return; }
        int per_cu = 0;
        if (hipOccupancyMaxActiveBlocksPerMultiprocessor(&per_cu, (const void*)mk_fwd, NTHR, LDS_BYTES) != hipSuccess || per_cu < 1) fprintf(stderr, "kernel_launch: occupancy query says %d\n", per_cu);
        (void)hipGetLastError();
        grid = cus;
    }
    if (grid < 0) return;
    (void)hipMemsetAsync((char*)d_ws + WS_CTL, 0, CTL_ZERO_BYTES, stream);
    Args a{};
    for (int i = 0; i < 18; ++i) a.in_[i] = (const GAS float*)d_in[i];
    a.out_ = (GAS float*)d_out; a.ws_ = (GAS unsigned char*)d_ws;
#ifndef MK_PER_PHASE
    a.ph_lo = 0; a.ph_hi = N_PHASES;
    hipLaunchKernelGGL(mk_fwd, dim3(grid), dim3(NTHR), LDS_BYTES, stream, a);
#else
    for (int p = 0; p < N_PHASES; ++p) { a.ph_lo = p; a.ph_hi = p + 1; hipLaunchKernelGGL(mk_fwd, dim3(grid), dim3(NTHR), LDS_BYTES, stream, a); }
#endif
}
```

```cpp
#define MB_PIPE 1
#define MB_QUEUE 1
#define ROPE_EPI 1
#include <hip/hip_runtime.h>
#include <cstdio>
#include <cstdint>
#include <cstddef>
namespace pg8 {
#define PG8_LAS __attribute__((address_space(3)))
typedef unsigned short bf16_t;
typedef short bf16x8 __attribute__((ext_vector_type(8)));
typedef float f32x4 __attribute__((ext_vector_type(4)));
typedef unsigned u32x4 __attribute__((ext_vector_type(4)));
__device__ __forceinline__ void st16_wt(void* p, u32x4 v) {
#ifdef WT_STORES
    asm volatile("global_store_dwordx4 %0, %1, off sc1\n\ts_nop 1" :: "v"((__attribute__((address_space(1))) void*)p), "v"(v) : "memory");
#else
    *(u32x4*)p = v;
#endif
}
constexpr int BM = 256, BK = 64, HALF = 128, HTB = HALF * BK * 2  , STAGE_BYTES = 8 * HTB, NXCD = 8, WGM = 8;

__host__ __device__ __forceinline__ int lds_byte(int r, int c) { const int st = (r >> 4) * 2 + (c >> 5), rr = r & 15, cc = c & 31, ob = rr * 64 + cc * 2; return st * 1024 + (ob ^ (((ob >> 9) & 1) << 5)); }
__host__ __device__ __forceinline__ void stage_rc(int b, int& R, int& C) { const int st = b / 1024, sb = b % 1024, swz = sb ^ (((sb >> 9) & 1) << 5); R = (st >> 1) * 16 + swz / 64; C = (st & 1) * 32 + (swz % 64) / 2; }
__host__ __device__ __forceinline__ int perm32(int rho) { const int n = rho >> 4, i = rho & 15; return 8 * (i >> 2) + 4 * n + (i & 3); }

struct Unit { int pm, pn; };
struct Gemm { const bf16_t* A; const bf16_t* Bt; int M, N, K; };

struct StaticOrder {
    int nM, nN, nwg, G, c;
    __host__ __device__ void init(int M, int N, int G_, int c_) { nM = M / BM; nN = N / BM; nwg = nM * nN; G = G_; c = c_; }
    __host__ __device__ bool next(int i, Unit& u) const {
        const long L = (long)i * G + c; if (L >= nwg) return false;
        int wgid = (int)L; { const int q = nwg / NXCD, r = nwg % NXCD, xcd = wgid % NXCD, off = wgid / NXCD; wgid = (xcd < r ? xcd * (q + 1) : r * (q + 1) + (xcd - r) * q) + off; }
        const int nig = WGM * nN, gid = wgid / nig, fm = gid * WGM, gsz = (nM - fm) < WGM ? (nM - fm) : WGM;
        u.pm = fm + ((wgid % nig) % gsz); u.pn = (wgid % nig) / gsz; return true;
    }
    __device__ __forceinline__ void a_ready(const Unit&) const {}
    __device__ __forceinline__ void done(const Unit&) const {}
    __device__ __forceinline__ size_t bofs(const Unit&) const { return 0; }
    static constexpr bool GATHER = false;
    __device__ __forceinline__ int arow(const Unit&, int) const { return 0; }
};

__device__ __forceinline__ unsigned cvt_pk_bf16(float lo, float hi) { unsigned r; asm volatile("v_cvt_pk_bf16_f32 %0, %1, %2" : "=v"(r) : "v"(lo), "v"(hi)); return r; }
typedef float f32x2 __attribute__((ext_vector_type(2)));
__device__ __forceinline__ f32x2 gelu_pk(f32x2 v) {
    const f32x2 av = __builtin_elementwise_abs(v), d = av * 0.2316418882f + 1.0f;
    f32x2 t; t.x = __builtin_amdgcn_rcpf(d.x); t.y = __builtin_amdgcn_rcpf(d.y);
    f32x2 q = t * 0.5307027145f + (-0.7265760135f); q = q * t + 0.7107068705f; q = q * t + (-0.142248368f); q = q * t + 0.127414796f; q = q * t;
    const f32x2 s = (v * v) * (-0.72134752044f);
    f32x2 e; e.x = __builtin_amdgcn_exp2f(s.x); e.y = __builtin_amdgcn_exp2f(s.y);
    const f32x2 m = v * (q * e), r = v - m;
    f32x2 o; o.x = v.x < 0.f ? m.x : r.x; o.y = v.y < 0.f ? m.y : r.y; return o;
}

template <int ACT  > struct EpiBf16 {
    static constexpr bool PERM = true, AFTER_DRAIN = false; static_assert(ACT == 0 || ACT == 1, "EpiBf16: ACT is 0 (none) or 1 (gelu_pk)");
    bf16_t* O; int ldc; const float* bias; int split_cols; size_t split_stride; float scale0;
    __device__ __forceinline__ void operator()(const f32x4 (&acc)[2][2][4][2], const Unit& u, int wr, int wc, int fr, int fq) const {
        const int row0 = u.pm * BM + wr * 64 + fr; int colt = u.pn * BM; bf16_t* base = O;
        float sc = 1.f; if (split_cols) { const int t = colt / split_cols; base += (size_t)t * split_stride; colt -= t * split_cols; if (t == 0) sc = scale0; }
        const int col0 = colt + wc * 32 + 8 * fq, bcol0 = u.pn * BM + wc * 32 + 8 * fq;
        f32x4 bv[2][2];
#pragma unroll
        for (int bj = 0; bj < 2; ++bj)
#pragma unroll
            for (int n = 0; n < 2; ++n) bv[bj][n] = bias ? *(const f32x4*)(bias + bcol0 + bj * HALF + 4 * n) : (f32x4){0.f, 0.f, 0.f, 0.f};
#pragma unroll
        for (int ai = 0; ai < 2; ++ai)
#pragma unroll
            for (int m = 0; m < 4; ++m) { bf16_t* rowp = base + (size_t)(row0 + ai * HALF + m * 16) * ldc + col0;
#pragma unroll
                for (int bj = 0; bj < 2; ++bj) { f32x4 v0 = acc[ai][bj][m][0] + bv[bj][0], v1 = acc[ai][bj][m][1] + bv[bj][1];
                    if (ACT == 1) { f32x2 a = gelu_pk((f32x2){v0[0], v0[1]}), b = gelu_pk((f32x2){v0[2], v0[3]}), c = gelu_pk((f32x2){v1[0], v1[1]}), d = gelu_pk((f32x2){v1[2], v1[3]});
                        v0 = (f32x4){a.x, a.y, b.x, b.y}; v1 = (f32x4){c.x, c.y, d.x, d.y}; }
                    v0 = v0 * sc; v1 = v1 * sc; u32x4 w; w.x = cvt_pk_bf16(v0[0], v0[1]); w.y = cvt_pk_bf16(v0[2], v0[3]); w.z = cvt_pk_bf16(v1[0], v1[1]); w.w = cvt_pk_bf16(v1[2], v1[3]);
                    st16_wt(rowp + bj * HALF, w); } }
    }
};

struct PanelStats {
    unsigned* xbuf;
    unsigned* cnt;
    unsigned* tmo;
    int ntn; float eps;
    unsigned code;
    __device__ __forceinline__ bool run(const f32x4 (&v)[2][2][4][2], const Unit& u, int wr, int wc, int fr, int fq, PG8_LAS unsigned char* lds, int wid, int lane) const {
        typedef float f32x2v __attribute__((ext_vector_type(2)));
        PG8_LAS f32x2v* P = (PG8_LAS f32x2v*)lds;
        PG8_LAS f32x2v* S = (PG8_LAS f32x2v*)(lds + 8192);
        PG8_LAS unsigned* flag = (PG8_LAS unsigned*)(lds + 8192 + 2048);
#pragma unroll
        for (int ai = 0; ai < 2; ++ai)
#pragma unroll
            for (int m = 0; m < 4; ++m) {
                float s = 0.f;
#pragma unroll
                for (int bj = 0; bj < 2; ++bj)
#pragma unroll
                    for (int n = 0; n < 2; ++n) { const f32x4 x = v[ai][bj][m][n]; s += (x[0] + x[1]) + (x[2] + x[3]); }
                s += __shfl_xor(s, 16); s += __shfl_xor(s, 32);
                const float mw = s * (1.0f / 64.0f); float q = 0.f;
#pragma unroll
                for (int bj = 0; bj < 2; ++bj)
#pragma unroll
                    for (int n = 0; n < 2; ++n) { const f32x4 d = v[ai][bj][m][n] - mw; q += (d[0] * d[0] + d[1] * d[1]) + (d[2] * d[2] + d[3] * d[3]); }
                q += __shfl_xor(q, 16); q += __shfl_xor(q, 32);
                if (fq == 0) P[(ai * HALF + wr * 64 + m * 16 + fr) * 4 + wc] = (f32x2v){mw, q};
            }
        asm volatile("s_waitcnt lgkmcnt(0)" ::: "memory"); __builtin_amdgcn_s_barrier(); asm volatile("" ::: "memory");
#if defined(BROKEN_EXCHANGE_NO_WAIT)
#warning BROKEN CONTROL BUILD: the row-statistics exchange does not wait; results are wrong by design
        if (blockIdx.x >= 64) { const long long t0_ = clock64(); while (clock64() - t0_ < 60000) __builtin_amdgcn_s_sleep(8); }
#endif
        const int row = wid * 32 + (lane & 31);
        if (lane < 32) {
            const f32x2v a = P[row * 4 + 0], b = P[row * 4 + 1], c = P[row * 4 + 2], d = P[row * 4 + 3];
            const float mt = (a.x + b.x + c.x + d.x) * 0.25f;
            const float da = a.x - mt, db = b.x - mt, dc = c.x - mt, dd = d.x - mt;
            const float m2 = (a.y + b.y) + (c.y + d.y) + 64.0f * ((da * da + db * db) + (dc * dc + dd * dd));
            unsigned long long* slot = (unsigned long long*)xbuf + ((size_t)(u.pm * BM + row) * 4 + u.pn);
            __hip_atomic_store(slot, ((unsigned long long)__float_as_uint(m2) << 32) | __float_as_uint(mt), __ATOMIC_RELAXED, __HIP_MEMORY_SCOPE_AGENT);
        }
        asm volatile("s_waitcnt vmcnt(0)" ::: "memory");
        if (lane == 0) __hip_atomic_fetch_add(cnt + 64 * u.pm, 1u, __ATOMIC_RELAXED, __HIP_MEMORY_SCOPE_AGENT);
        if (wid == 0) {
            bool dead = false; const unsigned long long t0 = __builtin_amdgcn_s_memrealtime(); const unsigned want = 8u * (unsigned)ntn;
            for (;;) {
#if defined(BROKEN_EXCHANGE_NO_WAIT)
                break;
#endif
                if ((unsigned)__builtin_amdgcn_readfirstlane(__hip_atomic_load(cnt + 64 * u.pm, __ATOMIC_RELAXED, __HIP_MEMORY_SCOPE_AGENT)) >= want) break;
                if (__builtin_amdgcn_s_memrealtime() - t0 > 2000000ull) {
                    if (lane == 0) { unsigned expect = 0u; __hip_atomic_compare_exchange_strong(tmo + 1, &expect, code | (unsigned)(u.pm & 0xff), __ATOMIC_RELAXED, __ATOMIC_RELAXED, __HIP_MEMORY_SCOPE_AGENT);
                                     __hip_atomic_store(tmo, 1u, __ATOMIC_RELAXED, __HIP_MEMORY_SCOPE_AGENT); }
                    dead = true; break; }
                __builtin_amdgcn_s_sleep(2);
            }
            __builtin_amdgcn_fence(__ATOMIC_ACQUIRE, "agent");
            if (lane == 0) flag[0] = dead ? 1u : 0u;
        }
        asm volatile("s_waitcnt vmcnt(0) lgkmcnt(0)" ::: "memory"); __builtin_amdgcn_s_barrier(); asm volatile("" ::: "memory");
        const bool bad = flag[0] != 0u;
        if (lane < 32) {
            const unsigned long long* slot = (const unsigned long long*)xbuf + (size_t)(u.pm * BM + row) * 4; float mt[4], m2[4]; float ms = 0.f;
#pragma unroll
            for (int t = 0; t < 4; ++t) { if (t < ntn) { const unsigned long long w = __hip_atomic_load(slot + t, __ATOMIC_RELAXED, __HIP_MEMORY_SCOPE_AGENT); mt[t] = __uint_as_float((unsigned)w); m2[t] = __uint_as_float((unsigned)(w >> 32)); } else { mt[t] = 0.f; m2[t] = 0.f; } ms += mt[t]; }
            const float mean = ms / (float)ntn; float q = 0.f;
#pragma unroll
            for (int t = 0; t < 4; ++t) if (t < ntn) { const float dm = mt[t] - mean; q += m2[t] + 256.0f * dm * dm; }
            S[row] = (f32x2v){mean, 1.0f / sqrtf(q / (256.0f * (float)ntn) + eps)};
        }
        asm volatile("s_waitcnt lgkmcnt(0)" ::: "memory"); __builtin_amdgcn_s_barrier(); asm volatile("" ::: "memory");
        return bad;
    }
};
struct EpiLnRes {
    static constexpr bool PERM = false, AFTER_DRAIN = true;
    const float* base; float* out; int ldc; const float* bias; PanelStats st; unsigned poison;
    __device__ __forceinline__ void fused(f32x4 (&acc)[2][2][4][2], const Unit& u, int wr, int wc, int fr, int fq, PG8_LAS unsigned char* lds, int wid, int lane) const {
        typedef float f32x2v __attribute__((ext_vector_type(2)));
        const PG8_LAS f32x2v* S = (const PG8_LAS f32x2v*)(lds + 8192);
        const int col0 = u.pn * BM + wc * 32 + 4 * fq;
#pragma unroll
        for (int bj = 0; bj < 2; ++bj)
#pragma unroll
            for (int n = 0; n < 2; ++n) { const f32x4 bv = bias ? *(const f32x4*)(bias + col0 + bj * HALF + n * 16) : (f32x4){0.f, 0.f, 0.f, 0.f};
#pragma unroll
                for (int ai = 0; ai < 2; ++ai)
#pragma unroll
                    for (int m = 0; m < 4; ++m) acc[ai][bj][m][n] += bv; }
        f32x4 pre[4][2][2];
#pragma unroll
        for (int m = 0; m < 4; ++m) { const size_t off = (size_t)(u.pm * BM + wr * 64 + m * 16 + fr) * ldc + col0;
#pragma unroll
            for (int bj = 0; bj < 2; ++bj)
#pragma unroll
                for (int n = 0; n < 2; ++n) pre[m][bj][n] = *(const f32x4*)(base + off + bj * HALF + n * 16); }
        const bool bad = st.run(acc, u, wr, wc, fr, fq, lds, wid, lane) || poison != 0u;
        const float qnan = __builtin_nanf("");
#pragma unroll
        for (int ai = 0; ai < 2; ++ai)
#pragma unroll
            for (int m = 0; m < 4; ++m) { const int r = ai * HALF + wr * 64 + m * 16 + fr; const f32x2v sr = S[r]; const size_t off = (size_t)(u.pm * BM + r) * ldc + col0;
#pragma unroll
                for (int bj = 0; bj < 2; ++bj)
#pragma unroll
                    for (int n = 0; n < 2; ++n) { const f32x4 bs = ai == 0 ? pre[m][bj][n] : *(const f32x4*)(base + off + bj * HALF + n * 16); f32x4 o = bs + (acc[ai][bj][m][n] - sr.x) * sr.y;
                        if (bad) o = (f32x4){qnan, qnan, qnan, qnan}; *(f32x4*)(out + off + bj * HALF + n * 16) = o; }
                if (m & 1) asm volatile("" ::: "memory"); }
    }
};
struct EpiLnResLn {
    static constexpr bool PERM = false, AFTER_DRAIN = true;
    const float* base; float* out; bf16_t* xn; int ldc; const float* bias; PanelStats st1, st2; unsigned poison;
    __device__ __forceinline__ void fused(f32x4 (&acc)[2][2][4][2], const Unit& u, int wr, int wc, int fr, int fq, PG8_LAS unsigned char* lds, int wid, int lane) const {
        typedef float f32x2v __attribute__((ext_vector_type(2))); typedef unsigned u32x2v __attribute__((ext_vector_type(2)));
        const PG8_LAS f32x2v* S = (const PG8_LAS f32x2v*)(lds + 8192);
        const int col0 = u.pn * BM + wc * 32 + 4 * fq;
#pragma unroll
        for (int bj = 0; bj < 2; ++bj)
#pragma unroll
            for (int n = 0; n < 2; ++n) { const f32x4 bv = bias ? *(const f32x4*)(bias + col0 + bj * HALF + n * 16) : (f32x4){0.f, 0.f, 0.f, 0.f};
#pragma unroll
                for (int ai = 0; ai < 2; ++ai)
#pragma unroll
                    for (int m = 0; m < 4; ++m) acc[ai][bj][m][n] += bv; }
        bool bad = st1.run(acc, u, wr, wc, fr, fq, lds, wid, lane) || poison != 0u;
        const float qnan = __builtin_nanf("");
#pragma unroll
        for (int ai = 0; ai < 2; ++ai)
#pragma unroll
            for (int m = 0; m < 4; ++m) { const int r = ai * HALF + wr * 64 + m * 16 + fr; const f32x2v sr = S[r]; const size_t off = (size_t)(u.pm * BM + r) * ldc + col0;
#pragma unroll
                for (int bj = 0; bj < 2; ++bj)
#pragma unroll
                    for (int n = 0; n < 2; ++n) { const f32x4 bs = *(const f32x4*)(base + off + bj * HALF + n * 16); acc[ai][bj][m][n] = bs + (acc[ai][bj][m][n] - sr.x) * sr.y; }
                asm volatile("" : "+v"(acc[ai][0][m][0]), "+v"(acc[ai][0][m][1]), "+v"(acc[ai][1][m][0]), "+v"(acc[ai][1][m][1]));
                if (m & 1) asm volatile("" ::: "memory"); }
        const bool bad1 = bad;
        bad = st2.run(acc, u, wr, wc, fr, fq, lds, wid, lane) || bad;
#pragma unroll
        for (int ai = 0; ai < 2; ++ai)
#pragma unroll
            for (int m = 0; m < 4; ++m) { const int r = ai * HALF + wr * 64 + m * 16 + fr; const f32x2v sr = S[r]; const size_t off = (size_t)(u.pm * BM + r) * ldc + col0;
#pragma unroll
                for (int bj = 0; bj < 2; ++bj)
#pragma unroll
                    for (int n = 0; n < 2; ++n) { const f32x4 x1 = acc[ai][bj][m][n]; *(f32x4*)(out + off + bj * HALF + n * 16) = bad1 ? (f32x4){qnan, qnan, qnan, qnan} : x1;
                        const f32x4 o = (x1 - sr.x) * sr.y; u32x2v w; w.x = cvt_pk_bf16(o[0], o[1]); w.y = cvt_pk_bf16(o[2], o[3]);
                        if (bad) { w.x = 0x7fc07fc0u; w.y = 0x7fc07fc0u; } *(u32x2v*)(xn + off + bj * HALF + n * 16) = w; }
                asm volatile("" ::: "memory"); }
    }
};

template <class Epi, class Sched, bool ALIGN_EPI = false, bool SP2 = false>
__device__ __forceinline__ void gemm_phase(PG8_LAS unsigned char* lds, const Gemm g, const Sched& S, const Epi& E) {
    const int tid = threadIdx.x, wid = __builtin_amdgcn_readfirstlane(tid >> 6), lane = tid & 63, wr = wid >> 2, wc = wid & 3, fr = lane & 15, fq = lane >> 4;
    const int K = g.K, nt = K / BK;
    unsigned voffA[2], voffB[2];
    unsigned cvo[2][2], nvo[2][2];
    int RA[2], CA[2];
#pragma unroll
    for (int i = 0; i < 2; ++i) { int R, C; stage_rc(tid * 16 + i * 8192, R, C); const int Rb = Epi::PERM ? ((R & ~31) + perm32(R & 31)) : R;
        voffA[i] = (unsigned)(R * K + C) * 2u; voffB[i] = (unsigned)(Rb * K + C) * 2u; RA[i] = R; CA[i] = C; }
    const size_t kstep = (size_t)(BK * 2);
    const size_t hstep = (size_t)HALF * K * 2;
    const size_t tstep = 2 * hstep;
    constexpr bool GATHER = Sched::GATHER;
    const size_t hstepA = GATHER ? 0 : hstep, tstepA = GATHER ? 0 : tstep;
#define PG8_VOA(h, nx) (GATHER ? ((nx) ? nvo[h] : cvo[h]) : voffA)
#define PG8_GOFFS(dst, u) do { _Pragma("unroll") for (int h_ = 0; h_ < 2; ++h_) _Pragma("unroll") for (int i_ = 0; i_ < 2; ++i_) dst[h_][i_] = (unsigned)((size_t)S.arow(u, h_ * HALF + RA[i_]) * K + CA[i_]) * 2u; } while (0)
    const unsigned ldsw = (unsigned)wid * 1024u;
    const int aoff = lds_byte(wr * 64 + fr, fq * 8), boff = lds_byte(wc * 32 + fr, fq * 8);
#define PG8_SA(b, h) (((b) * 2 + (h)) * HTB)
#define PG8_SB(b, h) ((4 + (b) * 2 + (h)) * HTB)
#define PG8_STAGE(bufoff, gbase, voff) do { _Pragma("unroll") for (int _i = 0; _i < 2; ++_i) \
        __builtin_amdgcn_global_load_lds((const unsigned*)((const char*)(gbase) + (voff)[_i]), (PG8_LAS unsigned*)(lds + (bufoff) + ldsw + _i * 8192), 16, 0, 0); } while (0)
#define PG8_LDA(dst, b, h) do { _Pragma("unroll") for (int m = 0; m < 4; ++m) _Pragma("unroll") for (int k = 0; k < 2; ++k) dst[m][k] = *(const PG8_LAS bf16x8*)(lds + PG8_SA(b, h) + aoff + m * 2048 + k * 1024); } while (0)
#define PG8_LDB(dst, b, h) do { _Pragma("unroll") for (int n = 0; n < 2; ++n) _Pragma("unroll") for (int k = 0; k < 2; ++k) dst[n][k] = *(const PG8_LAS bf16x8*)(lds + PG8_SB(b, h) + boff + n * 2048 + k * 1024); } while (0)
#define PG8_MMA(ai, bj, At, Bt) do { __builtin_amdgcn_s_setprio(1); _Pragma("unroll") for (int m = 0; m < 4; ++m) _Pragma("unroll") for (int n = 0; n < 2; ++n) _Pragma("unroll") for (int k = 0; k < 2; ++k) \
        acc[ai][bj][m][n] = __builtin_amdgcn_mfma_f32_16x16x32_bf16(Bt[n][k], At[m][k], acc[ai][bj][m][n], 0, 0, 0); __builtin_amdgcn_s_setprio(0); } while (0)
#define PG8_WAIT_V(n) asm volatile("s_waitcnt vmcnt(" #n ")" ::: "memory")
#define PG8_WAIT_L(n) asm volatile("s_waitcnt lgkmcnt(" #n ")" ::: "memory")
#define PG8_BAR __builtin_amdgcn_s_barrier()
#define PG8_SCHED __builtin_amdgcn_sched_barrier(0)
    Unit cur, nxt; int ui = 0;
    if (!S.next(0, cur)) return;
    f32x4 acc[2][2][4][2];
#pragma unroll
    for (int a = 0; a < 2; ++a)
#pragma unroll
        for (int b = 0; b < 2; ++b)
#pragma unroll
            for (int m = 0; m < 4; ++m)
#pragma unroll
                for (int n = 0; n < 2; ++n) acc[a][b][m][n] = (f32x4){0.f, 0.f, 0.f, 0.f};
    bf16x8 At[4][2], B0[2][2], B1[2][2];
    const char* cA = (const char*)g.A + (size_t)cur.pm * tstepA; const char* cB = (const char*)g.Bt + S.bofs(cur) + (size_t)cur.pn * tstep;
    if constexpr (GATHER) { PG8_GOFFS(cvo, cur); Unit u1_; if (S.next(1, u1_)) PG8_GOFFS(nvo, u1_); else { _Pragma("unroll") for (int h_ = 0; h_ < 2; ++h_) _Pragma("unroll") for (int i_ = 0; i_ < 2; ++i_) nvo[h_][i_] = cvo[h_][i_]; } }
    S.a_ready(cur);
    if constexpr (SP2) {
        PG8_STAGE(PG8_SB(0, 0), cB, voffB); PG8_STAGE(PG8_SB(0, 1), cB + hstep, voffB); PG8_STAGE(PG8_SA(0, 0), cA, PG8_VOA(0, false)); PG8_STAGE(PG8_SA(0, 1), cA + hstepA, PG8_VOA(1, false));
        if (wr == 1) PG8_BAR;
        PG8_WAIT_V(2); PG8_BAR;
        PG8_STAGE(PG8_SB(1, 0), cB + kstep, voffB); PG8_STAGE(PG8_SA(1, 0), cA + kstep, PG8_VOA(0, false)); PG8_STAGE(PG8_SB(1, 1), cB + hstep + kstep, voffB);
        PG8_WAIT_V(6); PG8_BAR;
    } else {
        PG8_STAGE(PG8_SB(0, 0), cB, voffB); PG8_STAGE(PG8_SA(0, 0), cA, PG8_VOA(0, false)); PG8_STAGE(PG8_SB(0, 1), cB + hstep, voffB); PG8_STAGE(PG8_SA(0, 1), cA + hstepA, PG8_VOA(1, false));
        if (wr == 1) PG8_BAR;
        PG8_WAIT_V(4); PG8_BAR;
        PG8_STAGE(PG8_SB(1, 0), cB + kstep, voffB); PG8_STAGE(PG8_SA(1, 0), cA + kstep, PG8_VOA(0, false)); PG8_STAGE(PG8_SB(1, 1), cB + hstep + kstep, voffB);
        PG8_WAIT_V(6); PG8_BAR;
    }
    for (;;) {
        const bool has_next = S.next(ui + 1, nxt);
        const char* nA = has_next ? (const char*)g.A + (size_t)nxt.pm * tstepA : cA;
        if constexpr (GATHER) { if (ui > 0) { if (has_next) PG8_GOFFS(nvo, nxt); else { _Pragma("unroll") for (int h_ = 0; h_ < 2; ++h_) _Pragma("unroll") for (int i_ = 0; i_ < 2; ++i_) nvo[h_][i_] = cvo[h_][i_]; } } } const char* nB = has_next ? (const char*)g.Bt + S.bofs(nxt) + (size_t)nxt.pn * tstep : cB;
        for (int t = 0; t < nt; t += 2) {
            const bool last = (t == nt - 2);
            const char* a1 = cA + (size_t)(t + 1) * kstep;
            const char* a2 = last ? nA : cA + (size_t)(t + 2) * kstep; const char* b2 = last ? nB : cB + (size_t)(t + 2) * kstep;
            const char* a3 = a2 + kstep; const char* b3 = b2 + kstep;
            if (last && has_next) S.a_ready(nxt);
            if constexpr (SP2) {
            PG8_LDB(B0, 0, 0); PG8_LDB(B1, 0, 1); PG8_SCHED; PG8_LDA(At, 0, 0); PG8_STAGE(PG8_SA(1, 1), a1 + hstepA, PG8_VOA(1, false));
            PG8_WAIT_V(8); PG8_WAIT_L(0); PG8_BAR; PG8_MMA(0, 0, At, B0); PG8_MMA(0, 1, At, B1); PG8_BAR; PG8_SCHED;
            PG8_LDA(At, 0, 1); PG8_STAGE(PG8_SB(0, 0), b2, voffB); PG8_STAGE(PG8_SB(0, 1), b2 + hstep, voffB); PG8_STAGE(PG8_SA(0, 0), a2, PG8_VOA(0, last));
            PG8_WAIT_V(8); PG8_WAIT_L(0); PG8_BAR; PG8_MMA(1, 0, At, B0); PG8_MMA(1, 1, At, B1); PG8_BAR; PG8_SCHED;
            PG8_LDB(B0, 1, 0); PG8_LDB(B1, 1, 1); PG8_SCHED; PG8_LDA(At, 1, 0); PG8_STAGE(PG8_SA(0, 1), a2 + hstepA, PG8_VOA(1, last));
            PG8_WAIT_V(8); PG8_WAIT_L(0); PG8_BAR; PG8_MMA(0, 0, At, B0); PG8_MMA(0, 1, At, B1); PG8_BAR; PG8_SCHED;
            PG8_LDA(At, 1, 1); PG8_STAGE(PG8_SB(1, 0), b3, voffB); PG8_STAGE(PG8_SB(1, 1), b3 + hstep, voffB); PG8_STAGE(PG8_SA(1, 0), a3, PG8_VOA(0, last));
            PG8_WAIT_V(8); PG8_WAIT_L(0); PG8_BAR; PG8_MMA(1, 0, At, B0); PG8_MMA(1, 1, At, B1); PG8_BAR; PG8_SCHED;
            } else {
            PG8_LDB(B0, 0, 0); PG8_SCHED; PG8_LDA(At, 0, 0); PG8_STAGE(PG8_SA(1, 1), a1 + hstepA, PG8_VOA(1, false));
            PG8_WAIT_L(8); PG8_BAR; PG8_WAIT_L(0); PG8_MMA(0, 0, At, B0); PG8_BAR; PG8_SCHED;
            PG8_LDB(B1, 0, 1); PG8_STAGE(PG8_SB(0, 0), b2, voffB);
            PG8_BAR; PG8_WAIT_L(0); PG8_MMA(0, 1, At, B1); PG8_BAR;
            PG8_LDA(At, 0, 1); PG8_STAGE(PG8_SA(0, 0), a2, PG8_VOA(0, last));
            PG8_BAR; PG8_WAIT_L(0); PG8_MMA(1, 0, At, B0); PG8_BAR; PG8_SCHED;
            PG8_STAGE(PG8_SB(0, 1), b2 + hstep, voffB);
            PG8_WAIT_V(6); PG8_BAR; PG8_MMA(1, 1, At, B1); PG8_BAR;
            PG8_LDB(B0, 1, 0); PG8_SCHED; PG8_LDA(At, 1, 0); PG8_STAGE(PG8_SA(0, 1), a2 + hstepA, PG8_VOA(1, last));
            PG8_WAIT_L(8); PG8_BAR; PG8_WAIT_L(0); PG8_MMA(0, 0, At, B0); PG8_BAR; PG8_SCHED;
            PG8_LDB(B1, 1, 1); PG8_STAGE(PG8_SB(1, 0), b3, voffB);
            PG8_BAR; PG8_WAIT_L(0); PG8_MMA(0, 1, At, B1); PG8_BAR;
            PG8_LDA(At, 1, 1); PG8_STAGE(PG8_SA(1, 0), a3, PG8_VOA(0, last));
            PG8_BAR; PG8_WAIT_L(0); PG8_MMA(1, 0, At, B0); PG8_BAR; PG8_SCHED;
            PG8_STAGE(PG8_SB(1, 1), b3 + hstep, voffB);
            PG8_WAIT_V(6); PG8_BAR; PG8_MMA(1, 1, At, B1); PG8_BAR;
            }
        }
        if constexpr (ALIGN_EPI) { if (wr == 0) PG8_BAR; }
        if constexpr (!Epi::AFTER_DRAIN) { E(acc, cur, wr, wc, fr, fq); S.done(cur); }
        if (!has_next) break;
#pragma unroll
        for (int a = 0; a < 2; ++a)
#pragma unroll
            for (int b = 0; b < 2; ++b)
#pragma unroll
                for (int m = 0; m < 4; ++m)
#pragma unroll
                    for (int n = 0; n < 2; ++n) acc[a][b][m][n] = (f32x4){0.f, 0.f, 0.f, 0.f};
        cur = nxt; cA = nA; cB = nB; ++ui;
        if constexpr (GATHER) { _Pragma("unroll") for (int h_ = 0; h_ < 2; ++h_) _Pragma("unroll") for (int i_ = 0; i_ < 2; ++i_) cvo[h_][i_] = nvo[h_][i_]; }
        if constexpr (ALIGN_EPI) { if (wr == 1) PG8_BAR; }
    }
    PG8_WAIT_V(0);
    if constexpr (!ALIGN_EPI) { if (wr == 0) PG8_BAR; }
    PG8_BAR;
    if constexpr (Epi::AFTER_DRAIN) { E.fused(acc, cur, wr, wc, fr, fq, lds, wid, lane); S.done(cur); }
#undef PG8_SA
#undef PG8_VOA
#undef PG8_GOFFS
#undef PG8_SB
#undef PG8_STAGE
#undef PG8_LDA
#undef PG8_LDB
#undef PG8_MMA
#undef PG8_WAIT_V
#undef PG8_WAIT_L
#undef PG8_BAR
#undef PG8_SCHED
}
}

#ifndef PG8_SP2
#define PG8_SP2 true
#endif
#ifndef PG8_ALIGN
#define PG8_ALIGN true
#endif
namespace pg8 {
struct EpiF32 {
    static constexpr bool PERM = false, AFTER_DRAIN = false;
    float* O; int ldc;
    __device__ __forceinline__ void operator()(const f32x4 (&acc)[2][2][4][2], const Unit& u, int wr, int wc, int fr, int fq) const {
        const int row0 = u.pm * BM + wr * 64 + fr, col0 = u.pn * BM + wc * 32 + 4 * fq;
#pragma unroll
        for (int ai = 0; ai < 2; ++ai)
#pragma unroll
            for (int m = 0; m < 4; ++m) { float* rowp = O + (size_t)(row0 + ai * HALF + m * 16) * ldc + col0;
#pragma unroll
                for (int bj = 0; bj < 2; ++bj)
#pragma unroll
                    for (int n = 0; n < 2; ++n) *(f32x4*)(rowp + bj * HALF + n * 16) = acc[ai][bj][m][n]; }
    }
};
template <bool GATHER_> struct MoeOrder {
    const PG8_LAS int* tb; int ncol, G, c; size_t estride; const int* list; const unsigned* cnt;
    static constexpr bool GATHER = GATHER_;
    __device__ __forceinline__ int arow(const Unit& u, int r) const { int e = 0;
#pragma unroll
        for (int k = 1; k < 16; ++k) e += (u.pm >= tb[k]) ? 1 : 0;
        const int pos = (u.pm - tb[e]) * 256 + r; return pos < (int)cnt[e] ? list[e * 16384 + pos] : 0; }
    __device__ __forceinline__ bool next(int i, Unit& u) const { const int L = i * G + c, t = L / ncol; if (t >= __builtin_amdgcn_readfirstlane(tb[17])) return false; u.pm = __builtin_amdgcn_readfirstlane(tb[18 + t]); u.pn = L - t * ncol; return true; }
    __device__ __forceinline__ void a_ready(const Unit&) const {}
    __device__ __forceinline__ void done(const Unit&) const {}
    __device__ __forceinline__ size_t bofs(const Unit& u) const { int e = 0;
#pragma unroll
        for (int k = 1; k < 16; ++k) e += (u.pm >= tb[k]) ? 1 : 0;
        return (size_t)__builtin_amdgcn_readfirstlane(e) * estride; }
};
struct EpiSwiGLU {
    static constexpr bool PERM = true, AFTER_DRAIN = false;
    bf16_t* O;
    __device__ __forceinline__ void operator()(const f32x4 (&acc)[2][2][4][2], const Unit& u, int wr, int wc, int fr, int fq) const {
        const int row0 = u.pm * BM + wr * 64 + fr, col0 = u.pn * 128 + wc * 32 + 8 * fq;
#pragma unroll
        for (int ai = 0; ai < 2; ++ai)
#pragma unroll
            for (int m = 0; m < 4; ++m) { bf16_t* rowp = O + (size_t)(row0 + ai * HALF + m * 16) * 256 + col0;
                f32x4 v[2];
#pragma unroll
                for (int n = 0; n < 2; ++n)
#pragma unroll
                    for (int e = 0; e < 4; ++e) { const float gt = acc[ai][0][m][n][e]; v[n][e] = gt / (1.f + __expf(-gt)) * acc[ai][1][m][n][e]; }
                u32x4 w; w.x = cvt_pk_bf16(v[0][0], v[0][1]); w.y = cvt_pk_bf16(v[0][2], v[0][3]); w.z = cvt_pk_bf16(v[1][0], v[1][1]); w.w = cvt_pk_bf16(v[1][2], v[1][3]);
                st16_wt(rowp, w); }
    }
};
struct EpiLn1 {
    static constexpr bool PERM = false, AFTER_DRAIN = true;
    const float* x; float* hout; bf16_t* hb; const float* gam; const float* bet; float alpha; PanelStats st; unsigned poison;
    __device__ __forceinline__ void fused(f32x4 (&acc)[2][2][4][2], const Unit& u, int wr, int wc, int fr, int fq, PG8_LAS unsigned char* lds, int wid, int lane) const {
        typedef float f32x2v __attribute__((ext_vector_type(2))); typedef unsigned u32x2v __attribute__((ext_vector_type(2)));
        const PG8_LAS f32x2v* S = (const PG8_LAS f32x2v*)(lds + 8192);
        const int col0 = u.pn * BM + wc * 32 + 4 * fq, ldc = 1024;
#pragma unroll
        for (int ai = 0; ai < 2; ++ai)
#pragma unroll
            for (int m = 0; m < 4; ++m) { const size_t off = (size_t)(u.pm * BM + ai * HALF + wr * 64 + m * 16 + fr) * ldc + col0;
#pragma unroll
                for (int bj = 0; bj < 2; ++bj)
#pragma unroll
                    for (int n = 0; n < 2; ++n) { const f32x4 xv = *(const f32x4*)(x + off + bj * HALF + n * 16); acc[ai][bj][m][n] = xv * alpha + acc[ai][bj][m][n]; }
                asm volatile("" : "+v"(acc[ai][0][m][0]), "+v"(acc[ai][0][m][1]), "+v"(acc[ai][1][m][0]), "+v"(acc[ai][1][m][1]));
                if (m & 1) asm volatile("" ::: "memory"); }
        const bool bad = st.run(acc, u, wr, wc, fr, fq, lds, wid, lane) || poison != 0u;
        const float qnan = __builtin_nanf("");
        f32x4 gv[2][2], bv[2][2];
#pragma unroll
        for (int bj = 0; bj < 2; ++bj)
#pragma unroll
            for (int n = 0; n < 2; ++n) { gv[bj][n] = *(const f32x4*)(gam + col0 + bj * HALF + n * 16); bv[bj][n] = *(const f32x4*)(bet + col0 + bj * HALF + n * 16); }
#pragma unroll
        for (int ai = 0; ai < 2; ++ai)
#pragma unroll
            for (int m = 0; m < 4; ++m) { const int r = ai * HALF + wr * 64 + m * 16 + fr; const f32x2v sr = S[r]; const size_t off = (size_t)(u.pm * BM + r) * ldc + col0;
#pragma unroll
                for (int bj = 0; bj < 2; ++bj)
#pragma unroll
                    for (int n = 0; n < 2; ++n) { f32x4 o = (acc[ai][bj][m][n] - sr.x) * sr.y * gv[bj][n] + bv[bj][n];
                        if (bad) o = (f32x4){qnan, qnan, qnan, qnan};
                        *(f32x4*)(hout + off + bj * HALF + n * 16) = o;
                        u32x2v w; w.x = cvt_pk_bf16(o[0], o[1]); w.y = cvt_pk_bf16(o[2], o[3]); *(u32x2v*)(hb + off + bj * HALF + n * 16) = w; }
                asm volatile("" ::: "memory"); }
    }
};
struct EpiProj {
    static constexpr bool PERM = true, AFTER_DRAIN = false;
    bf16_t* PJ; size_t slot_stride; const float* rope; float* KM; PG8_LAS float* xch;
    __device__ __forceinline__ void operator()(const f32x4 (&acc)[2][2][4][2], const Unit& u, int wr, int wc, int fr, int fq) const {
        const int slot = u.pn >> 1, row0 = u.pm * BM + wr * 64 + fr;
        bf16_t* base = PJ + (size_t)slot * slot_stride;
        if (slot != 4 && slot != 5) {
            const int col0 = (u.pn & 1) * BM + wc * 32 + 8 * fq;
#pragma unroll
            for (int ai = 0; ai < 2; ++ai)
#pragma unroll
                for (int m = 0; m < 4; ++m) { bf16_t* rowp = base + (size_t)(row0 + ai * HALF + m * 16) * 512 + col0;
#pragma unroll
                    for (int bj = 0; bj < 2; ++bj) { const f32x4 v0 = acc[ai][bj][m][0], v1 = acc[ai][bj][m][1];
                        u32x4 w; w.x = cvt_pk_bf16(v0[0], v0[1]); w.y = cvt_pk_bf16(v0[2], v0[3]); w.z = cvt_pk_bf16(v1[0], v1[1]); w.w = cvt_pk_bf16(v1[2], v1[3]);
                        *(u32x4*)(rowp + bj * HALF) = w; } }
            return;
        }
        const int head = (u.pn & 1) * 2 + (wc >> 1), d0 = 32 * (wc & 1) + 8 * fq;
        float cs1[8], cs2[8];
#pragma unroll
        for (int k = 0; k < 8; ++k) { cs1[k] = 0.f; cs2[k] = 0.f; }
#pragma unroll
        for (int ai = 0; ai < 2; ++ai)
#pragma unroll
            for (int m = 0; m < 4; ++m) {
                const int row = row0 + ai * HALF + m * 16, pos = row & 4095;
                const float* rp = rope + ((size_t)pos * 64 + d0) * 2;
                const f32x4 c0 = *(const f32x4*)rp, c1 = *(const f32x4*)(rp + 4), c2 = *(const f32x4*)(rp + 8), c3 = *(const f32x4*)(rp + 12);
                const float cs[8] = {c0[0], c0[2], c1[0], c1[2], c2[0], c2[2], c3[0], c3[2]}, sn[8] = {c0[1], c0[3], c1[1], c1[3], c2[1], c2[3], c3[1], c3[3]};
                float r1[8], r2[8];
#pragma unroll
                for (int k = 0; k < 8; ++k) { const float t1 = acc[ai][0][m][k >> 2][k & 3], t2 = acc[ai][1][m][k >> 2][k & 3];
                    r1[k] = t1 * cs[k] - t2 * sn[k]; r2[k] = t2 * cs[k] + t1 * sn[k]; }
                if (slot == 5) {
#pragma unroll
                    for (int k = 0; k < 8; ++k) { cs1[k] += r1[k]; cs2[k] += r2[k]; }
                    asm volatile("" : "+v"(cs1[0]), "+v"(cs1[1]), "+v"(cs1[2]), "+v"(cs1[3]), "+v"(cs1[4]), "+v"(cs1[5]), "+v"(cs1[6]), "+v"(cs1[7]));
                    asm volatile("" : "+v"(cs2[0]), "+v"(cs2[1]), "+v"(cs2[2]), "+v"(cs2[3]), "+v"(cs2[4]), "+v"(cs2[5]), "+v"(cs2[6]), "+v"(cs2[7]));
                }
                bf16_t* rowp = base + (size_t)row * 512 + head * 128 + d0;
                u32x4 w1, w2;
                w1.x = cvt_pk_bf16(r1[0], r1[1]); w1.y = cvt_pk_bf16(r1[2], r1[3]); w1.z = cvt_pk_bf16(r1[4], r1[5]); w1.w = cvt_pk_bf16(r1[6], r1[7]);
                w2.x = cvt_pk_bf16(r2[0], r2[1]); w2.y = cvt_pk_bf16(r2[2], r2[3]); w2.z = cvt_pk_bf16(r2[4], r2[5]); w2.w = cvt_pk_bf16(r2[6], r2[7]);
                *(u32x4*)rowp = w1; *(u32x4*)(rowp + 64) = w2;
                asm volatile("" ::: "memory");
            }
        if (slot == 5) {
#pragma unroll
            for (int k = 0; k < 8; ++k) {
#pragma unroll
                for (int o = 1; o < 16; o <<= 1) { cs1[k] += __shfl_xor(cs1[k], o); cs2[k] += __shfl_xor(cs2[k], o); } }
            PG8_LAS float* x = xch + (wc * 4 + fq) * 16;
            if (wr == 1 && fr == 0) {
#pragma unroll
                for (int k = 0; k < 8; ++k) { x[k] = cs1[k]; x[8 + k] = cs2[k]; } }
            asm volatile("s_waitcnt lgkmcnt(0)" ::: "memory"); __builtin_amdgcn_s_barrier(); asm volatile("" ::: "memory");
            if (wr == 0 && fr == 0) {
                const int b = (u.pm * BM) >> 12, j = ((u.pm * BM) & 4095) >> 8;
                float* kp = KM + ((size_t)((b * 4 + head) * 16 + j)) * 128 + d0;
#pragma unroll
                for (int k = 0; k < 8; ++k) { kp[k] = cs1[k] + x[k]; kp[64 + k] = cs2[k] + x[8 + k]; }
            }
        }
    }
};
}
#define GAS __attribute__((address_space(1)))
#define LAS __attribute__((address_space(3)))
typedef unsigned short bf16;
typedef unsigned v4u __attribute__((ext_vector_type(4)));
typedef float f32x4 __attribute__((ext_vector_type(4)));
typedef short bf16x8 __attribute__((ext_vector_type(8)));
typedef GAS unsigned gu32;
typedef GAS unsigned long long gu64;
#define RLX_AGENT __ATOMIC_RELAXED, __HIP_MEMORY_SCOPE_AGENT
#define LDS_WAIT() asm volatile("s_waitcnt lgkmcnt(0)" ::: "memory")
#define VM_WAIT() asm volatile("s_waitcnt vmcnt(0)" ::: "memory")
__device__ __forceinline__ unsigned long long rt() { return __builtin_amdgcn_s_memrealtime(); }
__device__ __forceinline__ unsigned f2bf(float f) { unsigned u = __builtin_bit_cast(unsigned, f); return (u + 0x7fffu + ((u >> 16) & 1u)) >> 16; }
__device__ __forceinline__ unsigned pk2(float lo, float hi) { return f2bf(lo) | (f2bf(hi) << 16); }

#define XB_TMO      128
#define XB_XCNT(j)  (256  + 64 * (j))
#define XB_XSUB(j)  (1280 + 64 * (j))
#define XB_XGEN(j)  (2304 + 64 * (j))
#define XB_TOP      3328
#define XB_TOPGEN   3392
#define XCD_BAR_WORDS 3456
#define XB_SPIN_CAP (1u << 18)

__device__ __forceinline__ unsigned xb_ld(unsigned* p)              { return __hip_atomic_load(p, __ATOMIC_RELAXED, __HIP_MEMORY_SCOPE_AGENT); }
__device__ __forceinline__ unsigned xb_add(unsigned* p, unsigned v) { return __hip_atomic_fetch_add(p, v, __ATOMIC_RELAXED, __HIP_MEMORY_SCOPE_AGENT); }
__device__ __forceinline__ unsigned xb_xcc_id() { return (unsigned)__builtin_amdgcn_s_getreg((3 << 11) | 20) & 0xFu; }
#define XB_SPIN(cond, bar) do { unsigned _sp = 0; while (cond) { __builtin_amdgcn_s_sleep(1); \
    if ((++_sp & 255u) == 0u) { if (xb_ld(&(bar)[XB_TMO])) break; if (_sp > XB_SPIN_CAP) { atomicAdd(&(bar)[XB_TMO], 1u); break; } } } } while (0)

struct XcdBarrier {
    unsigned* bar; unsigned x;
    volatile LAS unsigned* st;
};

__device__ __forceinline__ XcdBarrier xcd_barrier_post(unsigned* bar, volatile LAS unsigned* st) {
    XcdBarrier b; b.bar = bar; b.x = xb_xcc_id(); b.st = st;
    if (threadIdx.x == 0) (void)xb_add(&bar[XB_XCNT(b.x)], 1u);
    return b;
}
__device__ __forceinline__ void xcd_barrier_complete(unsigned* bar, unsigned x, unsigned& nloc, unsigned& nx) {
    const unsigned G = gridDim.x * gridDim.y * gridDim.z;
    unsigned sum, cnt, mine, sp = 0u;
    for (;;) {
        sum = 0u; cnt = 0u; mine = 0u;
#pragma unroll
        for (unsigned j = 0; j < 16; ++j) { const unsigned c = xb_ld(&bar[XB_XCNT(j)]); sum += c; cnt += (c > 0u) ? 1u : 0u; mine = (j == x) ? c : mine; }
        if (sum == G) break;
        __builtin_amdgcn_s_sleep(1);
        if ((++sp & 255u) == 0u) { if (xb_ld(&bar[XB_TMO])) break; if (sp > XB_SPIN_CAP) { atomicAdd(&bar[XB_TMO], 1u); break; } }
    }
    nloc = mine > 0u ? mine : 1u; nx = cnt > 0u ? cnt : 1u;
}

__device__ __forceinline__ void xcd_barrier(const XcdBarrier& b) {
    asm volatile("s_waitcnt vmcnt(0)" ::: "memory");
    __syncthreads();
    if (threadIdx.x == 0) {
        unsigned* bar = b.bar;
        __builtin_amdgcn_s_waitcnt(0);
        unsigned nloc = b.st[0], nx = b.st[1];
        if (nloc == 0u) { xcd_barrier_complete(bar, b.x, nloc, nx); b.st[0] = nloc; b.st[1] = nx; }
        const unsigned old = xb_add(&bar[XB_XSUB(b.x)], 1u);
        const unsigned gen = old / nloc;
        if (old + 1u == (gen + 1u) * nloc) {
            __builtin_amdgcn_fence(__ATOMIC_RELEASE, "agent");
            asm volatile("s_waitcnt vmcnt(0)" ::: "memory");
            const unsigned og = xb_add(&bar[XB_TOP], 1u);
            const unsigned tg = og / nx;
            if (og + 1u == (tg + 1u) * nx) xb_add(&bar[XB_TOPGEN], 1u);
            else XB_SPIN(xb_ld(&bar[XB_TOPGEN]) == tg, bar);
            __builtin_amdgcn_fence(__ATOMIC_ACQUIRE, "agent");
            xb_add(&bar[XB_XGEN(b.x)], 1u);
            asm volatile("s_waitcnt vmcnt(0)" ::: "memory");
        } else {
            XB_SPIN(xb_ld(&bar[XB_XGEN(b.x)]) == gen, bar);
            __builtin_amdgcn_fence(__ATOMIC_ACQUIRE, "agent");
            asm volatile("s_waitcnt vmcnt(0)" ::: "memory");
        }
    }
    __syncthreads();
}
namespace mb {
constexpr int D = 128, PITCH = 512, OPITCH = 1024;
constexpr float THR = 8.f;
constexpr bool WSKIP = false;
constexpr int KM_OFF = 69632;
constexpr float SCALE = 0.08838834764831845f;
constexpr int NW = 8, QBLK = 32, KVBLK = 64, QB = NW * QBLK;
constexpr int SHM_V = KVBLK * D * 2, SHM_K = KVBLK * D * 2;
constexpr int LDS_BYTES = 2 * SHM_V + 2 * SHM_K + NW * 64 * 4;

typedef short bf16x8 __attribute__((ext_vector_type(8)));
typedef short s16x4 __attribute__((ext_vector_type(4)));
typedef float f32x16 __attribute__((ext_vector_type(16)));
typedef float f32x4 __attribute__((ext_vector_type(4)));
typedef unsigned u32x4 __attribute__((ext_vector_type(4)));
template <class A, class Bt> struct same_t { static constexpr bool v = false; };
template <class A> struct same_t<A, A> { static constexpr bool v = true; };

typedef const GAS char* gcptr;
__device__ __forceinline__ gcptr uni(const void* p) {
    const unsigned long long u = (unsigned long long)p;
    const unsigned lo = __builtin_amdgcn_readfirstlane((unsigned)u), hi = __builtin_amdgcn_readfirstlane((unsigned)(u >> 32));
    return (gcptr)(((unsigned long long)hi << 32) | lo);
}
#define KSWZ(row, colB) ((row) * 256 + ((colB) ^ (((row) & 7) << 4)))
#define SBAR() __builtin_amdgcn_sched_barrier(0)
__device__ __forceinline__ int v_st(int k, int c) { const int kk = (k & ~0xC) | ((k & 4) << 1) | ((k & 8) >> 1); return ((kk >> 3) * 4 + (c >> 5)) * 512 + ((kk & 7) * 32 + (c & 31)) * 2; }
__device__ __forceinline__ int v_rd_base(int lane) { return ((lane & 3) << 3) | (((lane >> 2) & 3) << 6) | (((lane >> 4) & 1) << 5) | (((lane >> 5) & 1) << 8); }
constexpr int v_rd_off(int d0, int ks, int half) { return d0 * 512 + ks * 4096 + half * 2048; }
__device__ __forceinline__ int crow(int r, int hi) { return (r & 3) + 8 * (r >> 2) + 4 * hi; }
__device__ __forceinline__ unsigned cvtpk(float lo, float hi) {
    unsigned r; asm volatile("v_cvt_pk_bf16_f32 %0, %1, %2" : "=v"(r) : "v"(lo), "v"(hi)); return r;
}
__device__ __forceinline__ bf16x8 pack8(f32x4 a, f32x4 b) {
    u32x4 w = {cvtpk(a[0], a[1]), cvtpk(a[2], a[3]), cvtpk(b[0], b[1]), cvtpk(b[2], b[3])};
    return *reinterpret_cast<bf16x8*>(&w);
}
template <class T> __device__ __forceinline__ bf16x8 load8(const T* p) {
    if constexpr (same_t<T, float>::v) { return pack8(*(const f32x4*)p, *(const f32x4*)(p + 4)); }
    else { return *reinterpret_cast<const bf16x8*>(p); }
}
__device__ __forceinline__ void mask_tile(f32x16& p0, f32x16& p1, int dq, unsigned W) {
    const float NEG = -__builtin_inff();
#pragma unroll
    for (int r = 0; r < 16; ++r) {
        const int c = (r & 3) + 8 * (r >> 2);
        if ((unsigned)(dq - c) >= W) p0[r] = NEG;
        if ((unsigned)(dq - c - 32) >= W) p1[r] = NEG;
    }
}
__device__ __forceinline__ void partialSM(f32x16& p0, f32x16& p1, float& m_reg, float& mn, float& alpha) {
    float pmax = p0[0]; for (int r = 1; r < 16; ++r) pmax = fmaxf(pmax, p0[r]); for (int r = 0; r < 16; ++r) pmax = fmaxf(pmax, p1[r]);
    { auto rr = __builtin_amdgcn_permlane32_swap(__float_as_uint(pmax), __float_as_uint(pmax), false, false);
      pmax = fmaxf(__uint_as_float(rr[0]), __uint_as_float(rr[1])); }
    constexpr float C2 = 1.4426950408889634f * SCALE;
    if (__builtin_expect(__all((pmax - m_reg) * SCALE <= THR), 1)) { mn = m_reg; alpha = 1.f; }
    else { mn = fmaxf(m_reg, pmax); alpha = __builtin_amdgcn_exp2f((m_reg - mn) * C2); m_reg = mn; }
    const float mnL = -mn * C2;
    for (int r = 0; r < 16; ++r) p0[r] = fmaf(p0[r], C2, mnL); for (int r = 0; r < 16; ++r) p1[r] = fmaf(p1[r], C2, mnL);
    for (int r = 0; r < 16; ++r) p0[r] = __builtin_amdgcn_exp2f(p0[r]);
}
__device__ __forceinline__ void finishSM(f32x16& p0, f32x16& p1, float alpha, float& l_reg, bf16x8& pa0, bf16x8& pa1, bf16x8& pa2, bf16x8& pa3) {
    for (int r = 0; r < 16; ++r) p1[r] = __builtin_amdgcn_exp2f(p1[r]);
    float ps = 0; for (int r = 0; r < 16; ++r) ps += p0[r]; for (int r = 0; r < 16; ++r) ps += p1[r];
    { auto rr = __builtin_amdgcn_permlane32_swap(__float_as_uint(ps), __float_as_uint(ps), false, false);
      ps = __uint_as_float(rr[0]) + __uint_as_float(rr[1]); }
    l_reg = l_reg * alpha + ps;
#define PK4(P, B_, OUT) do { unsigned a0 = cvtpk(P[B_+0], P[B_+1]), a1 = cvtpk(P[B_+2], P[B_+3]);                          \
        unsigned b0 = cvtpk(P[B_+4], P[B_+5]), b1 = cvtpk(P[B_+6], P[B_+7]);                                             \
        auto r0 = __builtin_amdgcn_permlane32_swap(a0, b0, false, false); auto r1 = __builtin_amdgcn_permlane32_swap(a1, b1, false, false); \
        u32x4 w = {r0[0], r1[0], r0[1], r1[1]}; OUT = *reinterpret_cast<bf16x8*>(&w); } while (0)
    PK4(p0, 0, pa0); PK4(p0, 8, pa1); PK4(p1, 0, pa2); PK4(p1, 8, pa3);
#undef PK4
}
template <int KB, bool SK>
__device__ __forceinline__ void qkt(f32x16& p0, f32x16& p1, const char* K_lds, int r32, int hi, const bf16x8* qr, bool act) {
    if (SK && !act) { const float NEG = -__builtin_inff();
#pragma unroll
        for (int r = 0; r < 16; ++r) { p0[r] = NEG; p1[r] = NEG; } return; }
    p0 = f32x16{}; p1 = f32x16{};
    const char* kb[4];
#pragma unroll
    for (int dd = 0; dd < 4; ++dd) kb[dd] = K_lds + KB * SHM_K + KSWZ(r32, (dd * 16 + hi * 8) * 2);
#pragma unroll
    for (int d0 = 0; d0 < 8; ++d0) { const char* a = kb[d0 & 3] + (d0 >> 2) * 128;
        bf16x8 b0 = *reinterpret_cast<const bf16x8*>(a);
        bf16x8 b1 = *reinterpret_cast<const bf16x8*>(a + 32 * 256);
        p0 = __builtin_amdgcn_mfma_f32_32x32x16_bf16(b0, qr[d0], p0, 0, 0, 0);
        p1 = __builtin_amdgcn_mfma_f32_32x32x16_bf16(b1, qr[d0], p1, 0, 0, 0); }
}
template <int VB, bool SK>
__device__ __forceinline__ void pv_tile(f32x16* o, int vb0, bf16x8 pa0, bf16x8 pa1, bf16x8 pa2, bf16x8 pa3, bool act) {
    if (SK && !act) return;
#define TRRD(dst, off) asm volatile("ds_read_b64_tr_b16 %0, %1 offset:%2" : "=&v"(dst) : "v"(vb0), "i"(off) : "memory")
#define PV_D0(d0) do { s16x4 l0, l1, l2, l3, h0, h1, h2, h3; constexpr int b_ = VB * SHM_V + v_rd_off(d0, 0, 0);     \
        TRRD(l0, b_); TRRD(h0, b_ + 2048); TRRD(l1, b_ + 4096); TRRD(h1, b_ + 6144); TRRD(l2, b_ + 8192); TRRD(h2, b_ + 10240); TRRD(l3, b_ + 12288); TRRD(h3, b_ + 14336); \
        asm volatile("s_waitcnt lgkmcnt(0)" ::: "memory"); SBAR();                 \
        o[d0] = __builtin_amdgcn_mfma_f32_32x32x16_bf16(pa0, (bf16x8){l0[0], l0[1], l0[2], l0[3], h0[0], h0[1], h0[2], h0[3]}, o[d0], 0, 0, 0);   \
        o[d0] = __builtin_amdgcn_mfma_f32_32x32x16_bf16(pa1, (bf16x8){l1[0], l1[1], l1[2], l1[3], h1[0], h1[1], h1[2], h1[3]}, o[d0], 0, 0, 0);   \
        o[d0] = __builtin_amdgcn_mfma_f32_32x32x16_bf16(pa2, (bf16x8){l2[0], l2[1], l2[2], l2[3], h2[0], h2[1], h2[2], h2[3]}, o[d0], 0, 0, 0);   \
        o[d0] = __builtin_amdgcn_mfma_f32_32x32x16_bf16(pa3, (bf16x8){l3[0], l3[1], l3[2], l3[3], h3[0], h3[1], h3[2], h3[3]}, o[d0], 0, 0, 0); } while (0)
    PV_D0(0); PV_D0(1); PV_D0(2); PV_D0(3);
#undef PV_D0
#undef TRRD
}

template <class TIn, class TOut> struct BlockRef { const TIn* Q; const TIn* K; const TIn* V; TOut* O; const float* KM; int P0; int t_lo, t_hi; TOut* OP; float* LSE; };
template <class TIn> struct Seam {
    bf16x8 qr[8];
    bf16x8 st_v0, st_v1, st_k0, st_k1; f32x4 sf0, sf1, sf2, sf3;
    f32x4 tq[16];
};
__device__ __forceinline__ int swa_jlo(int P0, int W) { const int lowk = P0 - W + 1; return lowk > 0 ? lowk / KVBLK : 0; }
#define ROW(p, k0, rr) ((p) + (size_t)((k0) + (rr)) * PITCH + sc)
#define VMW() asm volatile("s_waitcnt vmcnt(0)" ::: "memory")
#define VMWN(n) asm volatile("s_waitcnt vmcnt(%0)" :: "i"(n) : "memory")
#define LD16U(base, boff) (*(const GAS bf16x8*)(uni((const char*)(base) + (size_t)(boff)) + voff))
#define SLOAD_H(Kp, Vp, k0) do { S.st_v0 = LD16U(Vp, (size_t)(k0) * (PITCH * 2)); S.st_v1 = LD16U(Vp, (size_t)((k0) + 32) * (PITCH * 2));              \
                         S.st_k0 = LD16U(Kp, (size_t)(k0) * (PITCH * 2)); S.st_k1 = LD16U(Kp, (size_t)((k0) + 32) * (PITCH * 2)); } while (0)
#define SWRITE_HK(bf) do { *(bf16x8*)(K_lds + (bf) * SHM_K + kws) = S.st_k0; *(bf16x8*)(K_lds + (bf) * SHM_K + kws + 32 * 256) = S.st_k1; } while (0)
#define SWRITE_HV(bf) do { *(bf16x8*)(V_lds + (bf) * SHM_V + vst0) = S.st_v0; *(bf16x8*)(V_lds + (bf) * SHM_V + vst1) = S.st_v1; } while (0)
#define SWRITE_H(bf) do { SWRITE_HV(bf); SWRITE_HK(bf); } while (0)
#define SLOAD_F(p, k0) do { S.sf0 = *(const f32x4*)ROW(p, k0, sr); S.sf1 = *(const f32x4*)(ROW(p, k0, sr) + 4);                \
                            S.sf2 = *(const f32x4*)ROW(p, k0, 32 + sr); S.sf3 = *(const f32x4*)(ROW(p, k0, 32 + sr) + 4); } while (0)
#define SWRITE_KF(bf) do { *(bf16x8*)(K_lds + (bf) * SHM_K + kws) = pack8(S.sf0, S.sf1); *(bf16x8*)(K_lds + (bf) * SHM_K + kws + 32 * 256) = pack8(S.sf2, S.sf3); } while (0)
#define SWRITE_VF(bf) do { *(bf16x8*)(V_lds + (bf) * SHM_V + vst0) = pack8(S.sf0, S.sf1); *(bf16x8*)(V_lds + (bf) * SHM_V + vst1) = pack8(S.sf2, S.sf3); } while (0)
template <class TIn, class TOut>
__device__ __forceinline__ void causal_swa_prime(const BlockRef<TIn, TOut>& cur, int W, char* lds, Seam<TIn>& S) {
    constexpr bool F32 = same_t<TIn, float>::v;
    int tid = threadIdx.x; asm volatile("" : "+v"(tid));
    const int wid = __builtin_amdgcn_readfirstlane(tid >> 6), lane = tid & 63, r32 = lane & 31, hi = lane >> 5;
    const int sr = tid >> 4, sc = (tid & 15) * 8, kws = KSWZ(sr, sc * 2); char* K_lds = lds + 2 * SHM_V;
    const unsigned voff = (unsigned)(sr * PITCH + sc) * 2u, qoff = (unsigned)((wid * QBLK + r32) * PITCH + hi * 8) * 2u;
    const int kb0 = cur.t_lo * KVBLK;
    for (int d0 = 0; d0 < 8; ++d0) S.qr[d0] = *(const GAS bf16x8*)(uni((const char*)cur.Q + d0 * 32) + qoff);
    if constexpr (F32) { SLOAD_F((const float*)cur.K, kb0); VMW(); SWRITE_KF(0); SBAR(); SLOAD_F((const float*)cur.V, kb0); }
    else { SLOAD_H(cur.K, cur.V, kb0); VMW(); SWRITE_HK(0); }
    __syncthreads();
}
template <class TIn, class TOut>
__device__ __forceinline__ void causal_swa_block(const BlockRef<TIn, TOut>& cur, const BlockRef<TIn, TOut>& nxt, int skv, int W, char* lds, Seam<TIn>& S) {
    constexpr bool F32 = same_t<TIn, float>::v;
    int tid = threadIdx.x; asm volatile("" : "+v"(tid));
    const int wid = __builtin_amdgcn_readfirstlane(tid >> 6), lane = tid & 63, r32 = lane & 31, hi = lane >> 5;
    const int j_lo = cur.t_lo, j_hi = cur.t_hi;
    const int NT = j_hi - j_lo;
    const int kbn = nxt.t_lo * KVBLK;
    const int qlo = cur.P0 + wid * QBLK, qm = qlo + r32 - 4 * hi;
    char* V_lds = lds; char* K_lds = lds + 2 * SHM_V;
    float* ws = (float*)(lds + 2 * SHM_V + 2 * SHM_K) + wid * 64; float* li_l = ws, * al_l = ws + 32;
    float m_reg = -1e30f, l_reg = 0; f32x16 o[4] = {};
    const int sr = tid >> 4, sc = (tid & 15) * 8, vst0 = v_st(sr, sc), vst1 = v_st(32 + sr, sc), kws = KSWZ(sr, sc * 2);
    const unsigned voff = (unsigned)(sr * PITCH + sc) * 2u, qoff = (unsigned)((wid * QBLK + r32) * PITCH + hi * 8) * 2u;
    const int vb0 = (int)(uintptr_t)V_lds + v_rd_base(lane);
    const TIn* Kh = cur.K; const TIn* Vh = cur.V;
    const int own = cur.P0 / QB, own4 = cur.P0 / KVBLK;
    unsigned sel = 0u;
    {
        float* km = (float*)(lds + KM_OFF);
#ifdef ROPE_EPI
        for (int i = tid; i < 16 * 128; i += 64 * NW) km[i] = *(const GAS float*)(uni(cur.KM) + (unsigned)(i * 4));
#else
        for (int i = tid; i < 16 * 128; i += 64 * NW) { const GAS float* p = (const GAS float*)(uni(cur.KM) + (unsigned)(((i >> 7) * 512 + (i & 127)) * 4)); km[i] = (p[0] + p[128]) + (p[256] + p[384]); }
#endif
        __syncthreads();
        float best[3] = {-3e38f, -3e38f, -3e38f}; int bidx[3] = {0, 0, 0};
#pragma unroll 1
        for (int j = 0; j < own; ++j) {
            float a = 0.f;
#pragma unroll
            for (int d0 = 0; d0 < 8; ++d0) {
                const f32x4 k0 = *(const f32x4*)(km + j * 128 + d0 * 16 + hi * 8), k1 = *(const f32x4*)(km + j * 128 + d0 * 16 + hi * 8 + 4);
                const u32x4 qw = *reinterpret_cast<const u32x4*>(&S.qr[d0]);
                a += __uint_as_float(qw[0] << 16) * k0[0] + __uint_as_float(qw[0] & 0xffff0000u) * k0[1] + __uint_as_float(qw[1] << 16) * k0[2] + __uint_as_float(qw[1] & 0xffff0000u) * k0[3]
                   + __uint_as_float(qw[2] << 16) * k1[0] + __uint_as_float(qw[2] & 0xffff0000u) * k1[1] + __uint_as_float(qw[3] << 16) * k1[2] + __uint_as_float(qw[3] & 0xffff0000u) * k1[3];
            }
            a += __shfl_xor(a, 32);
            if (a > best[0]) { best[2] = best[1]; bidx[2] = bidx[1]; best[1] = best[0]; bidx[1] = bidx[0]; best[0] = a; bidx[0] = j; }
            else if (a > best[1]) { best[2] = best[1]; bidx[2] = bidx[1]; best[1] = a; bidx[1] = j; }
            else if (a > best[2]) { best[2] = a; bidx[2] = j; }
        }
#pragma unroll
        for (int r = 0; r < 3; ++r) if (best[r] > -1e37f) sel |= 1u << bidx[r];
    }
#define RESC(a) do { if (__any((a) < 1.f)) { if (hi == 0) al_l[r32] = (a); asm volatile("s_waitcnt lgkmcnt(0)" ::: "memory");              \
                     for (int d_ = 0; d_ < 4; ++d_) for (int r = 0; r < 16; ++r) o[d_][r] *= al_l[crow(r, hi)]; } } while (0)
#define KBASE(t) ((j_lo + (t)) * KVBLK)
#define ACT(t) (KBASE(t) <= qlo + QBLK - 1 && KBASE(t) + KVBLK - 1 >= qlo - W + 1)
#define MASKT(P0_, P1_, t) do { const int kb_ = KBASE(t), gt_ = j_lo + (t); if (gt_ >= own4) { if (kb_ + KVBLK - 1 > qlo) mask_tile(P0_, P1_, qm - kb_, 0x3fffffffu); } else if (!((sel >> (gt_ >> 2)) & 1u)) { const float NEG_ = -__builtin_inff(); _Pragma("unroll") for (int r_ = 0; r_ < 16; ++r_) { P0_[r_] = NEG_; P1_[r_] = NEG_; } } } while (0)
    constexpr int NQL = F32 ? 16 : 8;
    constexpr bool SK = WSKIP && !F32;
#define SEAM_K0() do { VMWN(NQL); if constexpr (F32) { SWRITE_KF(0); SBAR(); SLOAD_F((const float*)nxt.V, kbn); } else { SWRITE_HK(0); } SBAR(); } while (0)
    f32x16 pA0, pA1, pB0, pB1; float mnA, mnB, alA, alB; bf16x8 pa0, pa1, pa2, pa3;
    if constexpr (F32) { VMW(); SWRITE_VF(0); SBAR(); } else { SWRITE_HV(0); SBAR(); }
    if (NT > 1) { if constexpr (F32) SLOAD_F((const float*)Kh, KBASE(1)); else SLOAD_H(Kh, Vh, KBASE(1)); }
    SBAR(); qkt<0, SK>(pA0, pA1, K_lds, r32, hi, S.qr, ACT(0));
    if constexpr (F32) { if (NT > 1) { VMW(); SWRITE_KF(1); SBAR(); SLOAD_F((const float*)Vh, KBASE(1)); } }
    MASKT(pA0, pA1, 0); partialSM(pA0, pA1, m_reg, mnA, alA);
    if (NT > 1) { VMW(); if constexpr (F32) { SWRITE_VF(1); SBAR(); if (NT > 2) SLOAD_F((const float*)Kh, KBASE(2)); } else SWRITE_H(1); }
    __syncthreads();
#define HALF_STEP(PX0, PX1, mnX, alX, PY0, PY1, alY, t, KB, VB, SB) do {                                                      \
        SBAR(); qkt<KB, SK>(PX0, PX1, K_lds, r32, hi, S.qr, ACT(t));                                             \
        finishSM(PY0, PY1, alY, l_reg, pa0, pa1, pa2, pa3); SBAR();                                                           \
        if ((t) + 1 < NT) { if constexpr (F32) { VMW(); SWRITE_KF(SB); SBAR(); SLOAD_F((const float*)Vh, KBASE((t) + 1)); }  \
                            else { SLOAD_H(Kh, Vh, KBASE((t) + 1)); } SBAR(); }                                               \
        pv_tile<VB, SK>(o, vb0, pa0, pa1, pa2, pa3, ACT((t) - 1)); MASKT(PX0, PX1, (t)); partialSM(PX0, PX1, m_reg, mnX, alX);                                        \
        __syncthreads();                                                                                                      \
        if ((t) + 1 < NT) { VMW(); if constexpr (F32) { SWRITE_VF(SB); SBAR(); if ((t) + 2 < NT) SLOAD_F((const float*)Kh, KBASE((t) + 2)); } \
                            else { SWRITE_H(SB); } }                                                                          \
        RESC(alX); __syncthreads(); } while (0)
    for (int t = 1; t + 1 < NT; t += 2) {
        HALF_STEP(pB0, pB1, mnB, alB, pA0, pA1, alA, t, 1, 0, 0);
        HALF_STEP(pA0, pA1, mnA, alA, pB0, pB1, alB, t + 1, 0, 1, 1);
    }
    const bool even = (NT & 1) == 0;
    if (even) { SBAR(); qkt<1, SK>(pB0, pB1, K_lds, r32, hi, S.qr, ACT(NT - 1)); SBAR(); }
#define QROW(e) (nxt.Q + (size_t)(wid * QBLK + r32) * PITCH + ((e) >> 1) * 16 + hi * 8 + ((e) & 1) * 4)
    if constexpr (F32) { SLOAD_F((const float*)nxt.K, kbn); SBAR();
#pragma unroll
        for (int e = 0; e < 8; ++e) S.tq[e] = *(const f32x4*)QROW(e); }
    else { SLOAD_H(nxt.K, nxt.V, kbn); SBAR();
#pragma unroll
        for (int d0 = 0; d0 < 8; ++d0) S.qr[d0] = *(const GAS bf16x8*)(uni((const char*)nxt.Q + d0 * 32) + qoff); }
    SBAR();
    finishSM(pA0, pA1, alA, l_reg, pa0, pa1, pa2, pa3); SBAR();
    if constexpr (F32) {
#pragma unroll
        for (int e = 8; e < 16; ++e) S.tq[e] = *(const f32x4*)QROW(e); SBAR(); }
#undef QROW
    pv_tile<0, SK>(o, vb0, pa0, pa1, pa2, pa3, ACT(even ? NT - 2 : NT - 1));
    if (even) { MASKT(pB0, pB1, NT - 1); partialSM(pB0, pB1, m_reg, mnB, alB); __syncthreads(); RESC(alB);
        finishSM(pB0, pB1, alB, l_reg, pa0, pa1, pa2, pa3); SBAR(); pv_tile<1, SK>(o, vb0, pa0, pa1, pa2, pa3, ACT(NT - 1)); }
    SBAR(); SEAM_K0();
    if (hi == 0) li_l[r32] = l_reg; asm volatile("s_waitcnt lgkmcnt(0)" ::: "memory");
    float rli[16];
#pragma unroll
    for (int r = 0; r < 16; ++r) { const float li_ = li_l[crow(r, hi)]; rli[r] = li_ > 0.f ? __builtin_amdgcn_rcpf(li_) : 0.f; }
    if (cur.OP) {
        if (hi == 0) cur.LSE[wid * QBLK + r32] = l_reg > 0.f ? m_reg * (1.4426950408889634f * SCALE) + __builtin_amdgcn_logf(l_reg) : -__builtin_inff();
        GAS char* Ow = (GAS char*)uni(cur.OP + (size_t)(wid * QBLK) * 128);
        unsigned obase = (unsigned)((4 * hi * 128 + r32) * 2); asm volatile("" : "+v"(obase));
#pragma unroll
        for (int r = 0; r < 16; ++r) {
#pragma unroll
            for (int d0 = 0; d0 < 4; ++d0) { const float v = o[d0][r] * rli[r];
                const float vn = __shfl_xor(v, 1);
                if ((r32 & 1) == 0) *(GAS unsigned*)(Ow + (obase + (unsigned)((((r & 3) + 8 * (r >> 2)) * 128 + d0 * 32) * 2))) = cvtpk(v, vn); } }
    } else {
        GAS char* Ow = (GAS char*)uni(cur.O + (size_t)(wid * QBLK) * OPITCH);
        unsigned obase = (unsigned)((4 * hi * OPITCH + r32) * 2); asm volatile("" : "+v"(obase));
#pragma unroll
        for (int r = 0; r < 16; ++r) {
#pragma unroll
            for (int d0 = 0; d0 < 4; ++d0) { const float v = o[d0][r] * rli[r];
                const float vn = __shfl_xor(v, 1);
                if ((r32 & 1) == 0) *(GAS unsigned*)(Ow + (obase + (unsigned)((((r & 3) + 8 * (r >> 2)) * OPITCH + d0 * 32) * 2))) = cvtpk(v, vn); } }
    }
    if constexpr (F32) {
#pragma unroll
        for (int d0 = 0; d0 < 8; ++d0) S.qr[d0] = pack8(S.tq[2 * d0], S.tq[2 * d0 + 1]); }
    __syncthreads();
#undef RESC
#undef KBASE
#undef ACT
#undef MASKT
#undef SEAM_K0
#undef HALF_STEP
}
#undef ROW
#undef VMW
#undef VMWN
#undef SLOAD_H
#undef LD16U
#undef SWRITE_HK
#undef SWRITE_HV
#undef SWRITE_H
#undef SLOAD_F
#undef SWRITE_KF
#undef SWRITE_VF
}
namespace dn {
typedef short bf16x8 __attribute__((ext_vector_type(8)));
typedef float f32x16 __attribute__((ext_vector_type(16)));
typedef float f32x4 __attribute__((ext_vector_type(4)));
typedef unsigned u32x4 __attribute__((ext_vector_type(4)));
typedef unsigned u32x2 __attribute__((ext_vector_type(2)));
#define DNI __device__ __forceinline__
#define DN_MFMA(a, b, c) __builtin_amdgcn_mfma_f32_32x32x16_bf16((a), (b), (c), 0, 0, 0)
constexpr int LQ = 136, LT = 72;
constexpr int BLOB_FRAGS = 56, BLOB_BYTES = BLOB_FRAGS * 1024, UF_BYTES = 16384;
constexpr int L_QS = 0, L_KS = 17408, L_KST = 34816, L_VST = 53248, L_AF = 71680, L_ABF = 89088, L_TRM = 98304, L_TW = 107520, L_TU = 116736,
              L_T00T = 125952, L_GATE = 128512, L_CONVW = 129536, L_END = 135680;
DNI int crow(int i, int h) { return (i & 3) + 8 * (i >> 2) + 4 * h; }
DNI unsigned cvtpk2(float lo, float hi) {
    typedef float f2_t __attribute__((ext_vector_type(2))); typedef __bf16 b2_t __attribute__((ext_vector_type(2)));
    f2_t v = {lo, hi}; b2_t b = __builtin_convertvector(v, b2_t); return __builtin_bit_cast(unsigned, b);
}
template <int SS> DNI bf16x8 pack_acc(const f32x16& x) {
    u32x4 p = {cvtpk2(x[8 * SS], x[8 * SS + 1]), cvtpk2(x[8 * SS + 2], x[8 * SS + 3]), cvtpk2(x[8 * SS + 4], x[8 * SS + 5]), cvtpk2(x[8 * SS + 6], x[8 * SS + 7])};
    return __builtin_bit_cast(bf16x8, p);
}
DNI bf16x8 lds16(const LAS unsigned char* p) { return *(const LAS bf16x8*)p; }
DNI bf16x8 lds_perm8(const LAS unsigned char* rowp, int colbase, int h) {
    const u32x2 a = *(const LAS u32x2*)(rowp + (colbase + 4 * h) * 2), b = *(const LAS u32x2*)(rowp + (colbase + 8 + 4 * h) * 2);
    u32x4 p = {a.x, a.y, b.x, b.y}; return __builtin_bit_cast(bf16x8, p);
}
DNI float bflo_(unsigned w) { return __uint_as_float(w << 16); }
DNI float bfhi_(unsigned w) { return __uint_as_float(w & 0xffff0000u); }

struct RawQKV { u32x4 w[3][4][2]; };
DNI void chunk_load(RawQKV& R, int item, const bf16* PJ, size_t pj_stride) {
    const int tid = threadIdx.x, row = tid >> 3, c0 = (tid & 7) * 16;
    const int n = item & 63, hd = (item >> 6) & 3, b = item >> 8, t = n * 64 + row;
    const size_t row0 = (size_t)b * 4096 + (size_t)n * 64;
#pragma unroll
    for (int X = 0; X < 3; ++X)
#pragma unroll
        for (int j = 0; j < 4; ++j) {
            if (t - 3 + j >= 0) { const bf16* src = PJ + (size_t)X * pj_stride + (row0 + row - 3 + j) * 512 + hd * 128 + c0; R.w[X][j][0] = *(const u32x4*)src; R.w[X][j][1] = *(const u32x4*)(src + 8); }
            else { R.w[X][j][0] = u32x4{}; R.w[X][j][1] = u32x4{}; }
        }
}
DNI void chunk_local(LAS unsigned char* lds, int item, RawQKV& RAW, int next_item, const bf16* PJ, size_t pj_stride, const float* GATES, const float* conv_w, const float* a_log, const float* dt_bias,
                     unsigned char* BLOB, unsigned char* UF, float* GL) {
    int tid = threadIdx.x; asm volatile("" : "+v"(tid));
    const int wid = __builtin_amdgcn_readfirstlane(tid >> 6), lane = tid & 63, r = lane & 31, h2 = lane >> 5;
    const int n = item & 63, hd = (item >> 6) & 3, b = item >> 8;
    const size_t row0 = (size_t)b * 4096 + (size_t)n * 64;
    LAS float* gate = (LAS float*)(lds + L_GATE);
    LAS float* convw = (LAS float*)(lds + L_CONVW);
    unsigned char* blob = BLOB + (size_t)item * BLOB_BYTES;
    for (int i = tid; i < 4 * 384; i += 512) { const int j = i / 384, c = i % 384; convw[i] = conv_w[j * 1536 + (c >> 7) * 512 + hd * 128 + (c & 127)]; }
    if (wid == 0) {
        const size_t m = row0 + lane;
        const float braw = GATES[m * 8 + hd], araw = GATES[m * 8 + 4 + hd];
        const float beta = 1.f / (1.f + __expf(-braw));
        const float sp = fmaxf(araw + dt_bias[hd], 0.f) + log1pf(__expf(-fabsf(araw + dt_bias[hd])));
        float g = -__expf(a_log[hd]) * sp;
#pragma unroll
        for (int d = 1; d < 64; d <<= 1) { const float t = __shfl_up(g, d); if (lane >= d) g += t; }
        const float glast = __shfl(g, 63);
        gate[lane] = beta; gate[64 + lane] = g; gate[128 + lane] = __expf(g); gate[192 + lane] = __expf(glast - g);
        if (lane == 63) GL[item] = __expf(glast);
    }
    __syncthreads();
    {
        const int row = tid >> 3, seg = tid & 7, c0 = seg * 16;
        float val[3][16];
#pragma unroll
        for (int X = 0; X < 3; ++X) {
#pragma unroll
            for (int e = 0; e < 16; ++e) val[X][e] = 0.f;
#pragma unroll
            for (int j = 0; j < 4; ++j) {
                {
                    const u32x4 w0 = RAW.w[X][j][0], w1 = RAW.w[X][j][1];
                    const LAS float* cw = convw + j * 384 + X * 128 + c0;
#pragma unroll
                    for (int e = 0; e < 4; ++e) { val[X][2 * e] += cw[2 * e] * bflo_(w0[e]); val[X][2 * e + 1] += cw[2 * e + 1] * bfhi_(w0[e]);
                                                  val[X][8 + 2 * e] += cw[8 + 2 * e] * bflo_(w1[e]); val[X][8 + 2 * e + 1] += cw[8 + 2 * e + 1] * bfhi_(w1[e]); }
                }
            }
#pragma unroll
            for (int e = 0; e < 16; ++e) val[X][e] = val[X][e] / (1.f + __expf(-val[X][e]));
        }
        float sq = 0.f, sk = 0.f;
#pragma unroll
        for (int e = 0; e < 16; ++e) { sq += val[0][e] * val[0][e]; sk += val[1][e] * val[1][e]; }
        sq += __shfl_xor(sq, 1); sq += __shfl_xor(sq, 2); sq += __shfl_xor(sq, 4);
        sk += __shfl_xor(sk, 1); sk += __shfl_xor(sk, 2); sk += __shfl_xor(sk, 4);
        const float rq = rsqrtf(sq + 1e-6f) * 0.08838834764831845f, rk = rsqrtf(sk + 1e-6f);
        u32x4 qa, qb, ka, kb;
#pragma unroll
        for (int e = 0; e < 4; ++e) { qa[e] = cvtpk2(val[0][2 * e] * rq, val[0][2 * e + 1] * rq); qb[e] = cvtpk2(val[0][8 + 2 * e] * rq, val[0][8 + 2 * e + 1] * rq);
                                      ka[e] = cvtpk2(val[1][2 * e] * rk, val[1][2 * e + 1] * rk); kb[e] = cvtpk2(val[1][8 + 2 * e] * rk, val[1][8 + 2 * e + 1] * rk); }
        *(LAS u32x4*)(lds + L_QS + (row * LQ + c0) * 2) = qa; *(LAS u32x4*)(lds + L_QS + (row * LQ + c0 + 8) * 2) = qb;
        *(LAS u32x4*)(lds + L_KS + (row * LQ + c0) * 2) = ka; *(LAS u32x4*)(lds + L_KS + (row * LQ + c0 + 8) * 2) = kb;
#pragma unroll
        for (int e = 0; e < 16; ++e) {
            const unsigned kw = (e < 8) ? ka[e >> 1] : kb[(e - 8) >> 1];
            *(LAS unsigned short*)(lds + L_KST + ((c0 + e) * LT + row) * 2) = (unsigned short)((e & 1) ? (kw >> 16) : (kw & 0xffffu));
            *(LAS unsigned short*)(lds + L_VST + ((c0 + e) * LT + row) * 2) = (unsigned short)(cvtpk2(val[2][e], 0.f) & 0xffffu);
        }
    }
    if (next_item >= 0) chunk_load(RAW, next_item, PJ, pj_stride);
    __syncthreads();
    {
        const int p = wid >> 2, ri = (wid >> 1) & 1, ci = wid & 1;
        const LAS unsigned char* Ap = lds + L_KS + ((32 * ri + r) * LQ + 8 * h2) * 2;
        const LAS unsigned char* Bp = lds + (p == 0 ? L_KS : L_QS) + ((32 * ci + r) * LQ + 8 * h2) * 2;
        f32x16 acc = {};
        const bool live = (p == 0) ? (ri >= ci) : (ri <= ci);
        if (live) {
#pragma unroll
            for (int ks = 0; ks < 8; ++ks) acc = DN_MFMA(lds16(Ap + ks * 32), lds16(Bp + ks * 32), acc);
        }
        const int colg = 32 * ci + r;
        const float gcol = gate[64 + colg];
        if (p == 0) {
#pragma unroll
            for (int i = 0; i < 16; ++i) {
                const int c = 32 * ri + crow(i, h2);
                const float a = (c > colg) ? gate[c] * acc[i] * __expf(gate[64 + c] - gcol) : 0.f;
                *(LAS float*)(lds + L_AF + (c * 68 + colg) * 4) = a;
                *(LAS unsigned short*)(lds + L_ABF + (c * LT + colg) * 2) = (unsigned short)(cvtpk2(a, 0.f) & 0xffffu);
            }
        } else {
            f32x16 x;
#pragma unroll
            for (int i = 0; i < 16; ++i) { const int s = 32 * ri + crow(i, h2); x[i] = (colg >= s) ? acc[i] * __expf(gcol - gate[64 + s]) : 0.f; }
            *(u32x4*)(blob + (32 + ci * 4 + 2 * ri + 0) * 1024 + lane * 16) = __builtin_bit_cast(u32x4, pack_acc<0>(x));
            *(u32x4*)(blob + (32 + ci * 4 + 2 * ri + 1) * 1024 + lane * 16) = __builtin_bit_cast(u32x4, pack_acc<1>(x));
        }
    }
    __syncthreads();
    if (wid == 0) {
        const int blk = h2, j = r, jg = 32 * blk + j;
        float x[32];
#pragma unroll
        for (int c = 0; c < 32; ++c) {
            float a0 = (c == j) ? 1.f : 0.f, a1 = 0.f, a2 = 0.f, a3 = 0.f;
            const LAS float* arow = (const LAS float*)(lds + L_AF) + (32 * blk + c) * 68 + 32 * blk;
#pragma unroll
            for (int s = 0; s < c; ++s) { const float t_ = arow[s] * x[s]; if ((s & 3) == 0) a0 -= t_; else if ((s & 3) == 1) a1 -= t_; else if ((s & 3) == 2) a2 -= t_; else a3 -= t_; }
            x[c] = (a0 + a1) + (a2 + a3);
        }
        const float sw = gate[jg] * gate[128 + jg], su = gate[jg];
#pragma unroll
        for (int c = 0; c < 32; ++c) {
            const int off = ((32 * blk + c) * LT + jg) * 2;
            *(LAS unsigned short*)(lds + L_TRM + off) = (unsigned short)(cvtpk2(x[c], 0.f) & 0xffffu);
            *(LAS unsigned short*)(lds + L_TW + off) = (unsigned short)(cvtpk2(x[c] * sw, 0.f) & 0xffffu);
            *(LAS unsigned short*)(lds + L_TU + off) = (unsigned short)(cvtpk2(x[c] * su, 0.f) & 0xffffu);
        }
        if (blk == 0) {
#pragma unroll
            for (int c4 = 0; c4 < 4; ++c4) { u32x4 w = {cvtpk2(x[8 * c4], x[8 * c4 + 1]), cvtpk2(x[8 * c4 + 2], x[8 * c4 + 3]), cvtpk2(x[8 * c4 + 4], x[8 * c4 + 5]), cvtpk2(x[8 * c4 + 6], x[8 * c4 + 7])};
                *(LAS u32x4*)(lds + L_T00T + (j * 40 + 8 * c4) * 2) = w; }
        }
        asm volatile("s_waitcnt lgkmcnt(0)" ::: "memory");
        f32x16 m1 = {};
#pragma unroll
        for (int ks = 0; ks < 2; ++ks) m1 = DN_MFMA(lds16(lds + L_ABF + ((32 + r) * LT + 16 * ks + 8 * h2) * 2), lds16(lds + L_T00T + (r * 40 + 16 * ks + 8 * h2) * 2), m1);
        f32x16 t10 = {};
        t10 = DN_MFMA(lds_perm8(lds + L_TRM + ((32 + r) * LT) * 2, 32 + 0, h2), pack_acc<0>(m1), t10);
        t10 = DN_MFMA(lds_perm8(lds + L_TRM + ((32 + r) * LT) * 2, 32 + 16, h2), pack_acc<1>(m1), t10);
        const float sw0 = gate[r] * gate[128 + r], su0 = gate[r];
#pragma unroll
        for (int i = 0; i < 16; ++i) {
            const int off = ((32 + crow(i, h2)) * LT + r) * 2; const float tv = -t10[i];
            *(LAS unsigned short*)(lds + L_TW + off) = (unsigned short)(cvtpk2(tv * sw0, 0.f) & 0xffffu);
            *(LAS unsigned short*)(lds + L_TU + off) = (unsigned short)(cvtpk2(tv * su0, 0.f) & 0xffffu);
        }
    } else {
        for (int f = wid - 1; f < 32; f += 7) {
            bf16x8 v; float sc[8];
            if (f < 16) {
                const int mt = f >> 3, s = f & 7, row = 32 * mt + r;
                v = lds_perm8(lds + L_QS + (row * LQ) * 2, 32 * (s >> 1) + 16 * (s & 1), h2);
                const float e = gate[128 + row];
#pragma unroll
                for (int jj = 0; jj < 8; ++jj) sc[jj] = e;
            } else {
                const int kt = (f - 16) >> 2, s2 = (f - 16) & 3, row = 32 * kt + r, cb = 32 * (s2 >> 1) + 16 * (s2 & 1);
                v = lds_perm8(lds + L_KST + (row * LT) * 2, cb, h2);
#pragma unroll
                for (int jj = 0; jj < 8; ++jj) sc[jj] = gate[192 + cb + 8 * (jj >> 2) + 4 * h2 + (jj & 3)];
            }
            const u32x4 w = __builtin_bit_cast(u32x4, v);
            u32x4 o;
#pragma unroll
            for (int e = 0; e < 4; ++e) o[e] = cvtpk2(bflo_(w[e]) * sc[2 * e], bfhi_(w[e]) * sc[2 * e + 1]);
            *(u32x4*)(blob + (f < 16 ? 16 + f : 40 + (f - 16)) * 1024 + lane * 16) = o;
        }
    }
    __syncthreads();
    {
        const int kt = wid >> 1, mt = wid & 1;
        f32x16 wt = {}, ut = {};
        const int nks = mt == 0 ? 2 : 4;
        for (int ks = 0; ks < nks; ++ks) {
            wt = DN_MFMA(lds16(lds + L_KST + ((32 * kt + r) * LT + 16 * ks + 8 * h2) * 2), lds16(lds + L_TW + ((32 * mt + r) * LT + 16 * ks + 8 * h2) * 2), wt);
            ut = DN_MFMA(lds16(lds + L_TU + ((32 * mt + r) * LT + 16 * ks + 8 * h2) * 2), lds16(lds + L_VST + ((32 * kt + r) * LT + 16 * ks + 8 * h2) * 2), ut);
        }
#pragma unroll
        for (int i = 0; i < 16; ++i) wt[i] = -wt[i];
        *(u32x4*)(blob + (mt * 8 + 2 * kt + 0) * 1024 + lane * 16) = __builtin_bit_cast(u32x4, pack_acc<0>(wt));
        *(u32x4*)(blob + (mt * 8 + 2 * kt + 1) * 1024 + lane * 16) = __builtin_bit_cast(u32x4, pack_acc<1>(wt));
        unsigned char* uf = UF + (size_t)item * UF_BYTES + ((kt * 2 + mt) * 64 + lane) * 32;
        *(u32x4*)uf = __builtin_bit_cast(u32x4, pack_acc<0>(ut)); *(u32x4*)(uf + 16) = __builtin_bit_cast(u32x4, pack_acc<1>(ut));
    }
    __syncthreads();
}

constexpr int S_SLOT = 32768, S_END = 4 * S_SLOT;
DNI void glds16(const void* gsrc, LAS unsigned char* dst) { __builtin_amdgcn_global_load_lds((const GAS unsigned*)gsrc, (LAS unsigned*)dst, 16, 0, 0); }
DNI void scan_bh(LAS unsigned char* lds, int bh, const unsigned char* BLOB, const unsigned char* UF, const float* GL, unsigned char* SF, unsigned char* VF) {
    int tid = threadIdx.x; asm volatile("" : "+v"(tid));
    const int wid = __builtin_amdgcn_readfirstlane(tid >> 6), lane = tid & 63;
    const unsigned char* blob0 = BLOB + (size_t)bh * 64 * BLOB_BYTES;
    unsigned lane16 = (unsigned)lane * 16u; asm volatile("" : "+v"(lane16));
#define DN_B() do { __builtin_amdgcn_s_barrier(); asm volatile("" ::: "memory"); } while (0)
    if (wid >= 4) {
        const int lw = wid - 4;
#define DN_ISSUE(c) do { const unsigned char* bc_ = blob0 + (size_t)(c) * BLOB_BYTES + lw * 1024; LAS unsigned char* sl_ = lds + ((c) & 3) * S_SLOT + lw * 1024; _Pragma("unroll") for (int i_ = 0; i_ < 4; ++i_) { \
        glds16(bc_ + i_ * 4096 + lane16, sl_ + i_ * 4096); glds16(bc_ + 40960 + i_ * 4096 + lane16, sl_ + 16384 + i_ * 4096); } } while (0)
        DN_ISSUE(0); DN_ISSUE(1); DN_ISSUE(2);
        asm volatile("s_waitcnt vmcnt(16)" ::: "memory"); DN_B();
#pragma unroll 1
        for (int c = 0; c < 64; ++c) {
            if (c + 3 < 64) { DN_ISSUE(c + 3); asm volatile("s_waitcnt vmcnt(16)" ::: "memory"); }
            else if (c + 2 < 64) asm volatile("s_waitcnt vmcnt(8)" ::: "memory");
            else asm volatile("s_waitcnt vmcnt(0)" ::: "memory");
            DN_B();
        }
#undef DN_ISSUE
    } else {
        const float glv = GL[bh * 64 + lane];
        const unsigned char* uf0 = UF + (size_t)bh * 64 * UF_BYTES + (wid * 128 + lane) * 32;
        unsigned char* sf0 = SF + ((size_t)(bh * 64) * 4 + wid) * 8192 + lane * 16;
        unsigned char* vf0 = VF + ((size_t)(bh * 64) * 4 + wid) * 4096 + lane * 16;
        f32x16 S0 = {}, S1 = {}, S2 = {}, S3 = {};
        u32x4 ua[4], ub[4];
#define DN_ULOAD(U, c) do { const unsigned char* u_ = uf0 + (size_t)(c) * UF_BYTES; U[0] = *(const u32x4*)u_; U[1] = *(const u32x4*)(u_ + 16); U[2] = *(const u32x4*)(u_ + 2048); U[3] = *(const u32x4*)(u_ + 2048 + 16); } while (0)
        DN_ULOAD(ua, 0); DN_ULOAD(ub, 1);
        DN_B();
#define RD4(X, f0, f1, f2, f3) do { asm volatile("ds_read_b128 %0, %4 offset:%5\n\tds_read_b128 %1, %4 offset:%6\n\tds_read_b128 %2, %4 offset:%7\n\tds_read_b128 %3, %4 offset:%8" \
        : "=&v"(X##0), "=&v"(X##1), "=&v"(X##2), "=&v"(X##3) : "v"(fba), "i"((f0) * 1024), "i"((f1) * 1024), "i"((f2) * 1024), "i"((f3) * 1024)); __builtin_amdgcn_sched_barrier(0); } while (0)
#define PIN2(a, b) asm volatile("" : "+v"(a), "+v"(b))
#define PIN4(a, b, c, d) asm volatile("" : "+v"(a), "+v"(b), "+v"(c), "+v"(d))
#define LWAIT() do { asm volatile("s_waitcnt lgkmcnt(0)" ::: "memory"); __builtin_amdgcn_sched_barrier(0); } while (0)
#define DN_STEP(U, c) do { \
            const unsigned fba = (unsigned)(uintptr_t)(lds + ((c) & 3) * S_SLOT) + lane16; \
            const float gl = __builtin_bit_cast(float, __builtin_amdgcn_readlane(__builtin_bit_cast(int, glv), (c))); \
            f32x16 v0, v1; \
            _Pragma("unroll") for (int i = 0; i < 8; ++i) { v0[2 * i] = bflo_(U[i >> 2][i & 3]); v0[2 * i + 1] = bfhi_(U[i >> 2][i & 3]); v1[2 * i] = bflo_(U[2 + (i >> 2)][i & 3]); v1[2 * i + 1] = bfhi_(U[2 + (i >> 2)][i & 3]); } \
            PIN2(v0, v1); \
            if ((c) + 2 < 64) DN_ULOAD(U, (c) + 2); \
            asm volatile("s_waitcnt lgkmcnt(0)" ::: "memory"); \
            unsigned char* sfc = sf0 + (size_t)(c) * 32768; unsigned char* vfc = vf0 + (size_t)(c) * 16384; \
            bf16x8 A0, A1, A2, A3, B0, B1, B2, B3; \
            RD4(A, 0, 8, 1, 9); LWAIT(); \
              \
            { const bf16x8 s0_ = pack_acc<0>(S0), s1_ = pack_acc<1>(S0); *(u32x4*)(sfc) = __builtin_bit_cast(u32x4, s0_); *(u32x4*)(sfc + 1024) = __builtin_bit_cast(u32x4, s1_); RD4(B, 2, 10, 3, 11); \
              v0 = DN_MFMA(A0, s0_, v0); v1 = DN_MFMA(A1, s0_, v1); v0 = DN_MFMA(A2, s1_, v0); v1 = DN_MFMA(A3, s1_, v1); PIN2(v0, v1); LWAIT(); } \
            { const bf16x8 s0_ = pack_acc<0>(S1), s1_ = pack_acc<1>(S1); *(u32x4*)(sfc + 2048) = __builtin_bit_cast(u32x4, s0_); *(u32x4*)(sfc + 3072) = __builtin_bit_cast(u32x4, s1_); RD4(A, 4, 12, 5, 13); \
              v0 = DN_MFMA(B0, s0_, v0); v1 = DN_MFMA(B1, s0_, v1); v0 = DN_MFMA(B2, s1_, v0); v1 = DN_MFMA(B3, s1_, v1); PIN2(v0, v1); LWAIT(); } \
            { const bf16x8 s0_ = pack_acc<0>(S2), s1_ = pack_acc<1>(S2); *(u32x4*)(sfc + 4096) = __builtin_bit_cast(u32x4, s0_); *(u32x4*)(sfc + 5120) = __builtin_bit_cast(u32x4, s1_); RD4(B, 6, 14, 7, 15); \
              v0 = DN_MFMA(A0, s0_, v0); v1 = DN_MFMA(A1, s0_, v1); v0 = DN_MFMA(A2, s1_, v0); v1 = DN_MFMA(A3, s1_, v1); PIN2(v0, v1); LWAIT(); } \
            { const bf16x8 s0_ = pack_acc<0>(S3), s1_ = pack_acc<1>(S3); *(u32x4*)(sfc + 6144) = __builtin_bit_cast(u32x4, s0_); *(u32x4*)(sfc + 7168) = __builtin_bit_cast(u32x4, s1_); RD4(A, 16, 20, 24, 28); \
              v0 = DN_MFMA(B0, s0_, v0); v1 = DN_MFMA(B1, s0_, v1); v0 = DN_MFMA(B2, s1_, v0); v1 = DN_MFMA(B3, s1_, v1); PIN2(v0, v1); LWAIT(); } \
            const bf16x8 vf0_ = pack_acc<0>(v0), vf1_ = pack_acc<1>(v0), vf2_ = pack_acc<0>(v1), vf3_ = pack_acc<1>(v1); \
            *(u32x4*)(vfc) = __builtin_bit_cast(u32x4, vf0_); *(u32x4*)(vfc + 1024) = __builtin_bit_cast(u32x4, vf1_); *(u32x4*)(vfc + 2048) = __builtin_bit_cast(u32x4, vf2_); *(u32x4*)(vfc + 3072) = __builtin_bit_cast(u32x4, vf3_); \
            _Pragma("unroll") for (int i = 0; i < 16; ++i) { S0[i] *= gl; S1[i] *= gl; S2[i] *= gl; S3[i] *= gl; } \
              \
            RD4(B, 17, 21, 25, 29); \
            S0 = DN_MFMA(A0, vf0_, S0); S1 = DN_MFMA(A1, vf0_, S1); S2 = DN_MFMA(A2, vf0_, S2); S3 = DN_MFMA(A3, vf0_, S3); PIN4(S0, S1, S2, S3); LWAIT(); \
            RD4(A, 18, 22, 26, 30); \
            S0 = DN_MFMA(B0, vf1_, S0); S1 = DN_MFMA(B1, vf1_, S1); S2 = DN_MFMA(B2, vf1_, S2); S3 = DN_MFMA(B3, vf1_, S3); PIN4(S0, S1, S2, S3); LWAIT(); \
            RD4(B, 19, 23, 27, 31); \
            S0 = DN_MFMA(A0, vf2_, S0); S1 = DN_MFMA(A1, vf2_, S1); S2 = DN_MFMA(A2, vf2_, S2); S3 = DN_MFMA(A3, vf2_, S3); PIN4(S0, S1, S2, S3); LWAIT(); \
            S0 = DN_MFMA(B0, vf3_, S0); S1 = DN_MFMA(B1, vf3_, S1); S2 = DN_MFMA(B2, vf3_, S2); S3 = DN_MFMA(B3, vf3_, S3); PIN4(S0, S1, S2, S3); \
            __builtin_amdgcn_sched_barrier(0); \
            DN_B(); } while (0)
#pragma unroll 1
        for (int c = 0; c < 64; c += 2) { DN_STEP(ua, c); DN_STEP(ub, c + 1); }
#undef DN_STEP
#undef RD4
#undef PIN2
#undef PIN4
#undef LWAIT
#undef DN_ULOAD
    }
    __syncthreads();
#undef DN_B
}

constexpr int O_OT = 0, O_NW = 2 * 64 * LQ * 2, O_END = O_NW + 512;
DNI void chunk_out(LAS unsigned char* lds, int item, const unsigned char* BLOB, const unsigned char* SF, const unsigned char* VF, const bf16* DNZ, const float* norm_w, bf16* Y) {
    int tid = threadIdx.x; asm volatile("" : "+v"(tid));
    const int wid = __builtin_amdgcn_readfirstlane(tid >> 6), lane = tid & 63, r = lane & 31, h2 = lane >> 5, half = wid >> 2, w = wid & 3;
    const int ck = 2 * item + half;
    const int n = ck & 63, hd = (ck >> 6) & 3, b = ck >> 8;
    if (tid < 128) ((LAS float*)(lds + O_NW))[tid] = norm_w[tid];
    const unsigned char* blob = BLOB + (size_t)ck * BLOB_BYTES + lane * 16;
    const unsigned char* sfp = SF + ((size_t)ck * 4 + w) * 8192 + lane * 16;
    const unsigned char* vfp = VF + ((size_t)ck * 4 + w) * 4096 + lane * 16;
    f32x16 o0 = {}, o1 = {};
#define GF(f) (*(const bf16x8*)(blob + (f) * 1024))
    {
        bf16x8 sf[8], vf[4], qa[8], qb[8];
#pragma unroll
        for (int s = 0; s < 8; ++s) { sf[s] = *(const bf16x8*)(sfp + s * 1024); qa[s] = GF(16 + s); }
#pragma unroll
        for (int s = 0; s < 8; ++s) qb[s] = GF(24 + s);
#pragma unroll
        for (int s2 = 0; s2 < 4; ++s2) vf[s2] = *(const bf16x8*)(vfp + s2 * 1024);
#pragma unroll
        for (int s = 0; s < 8; ++s) o0 = DN_MFMA(qa[s], sf[s], o0);
#pragma unroll
        for (int s2 = 0; s2 < 4; ++s2) { qa[s2] = GF(32 + s2); qa[4 + s2] = GF(36 + s2); }
#pragma unroll
        for (int s = 0; s < 8; ++s) o1 = DN_MFMA(qb[s], sf[s], o1);
#pragma unroll
        for (int s2 = 0; s2 < 4; ++s2) { o0 = DN_MFMA(qa[s2], vf[s2], o0); o1 = DN_MFMA(qa[4 + s2], vf[s2], o1); }
    }
#undef GF
    {
        LAS unsigned char* obp = lds + O_OT + half * (64 * LQ * 2) + ((4 * h2) * LQ + 32 * w + r) * 2;
#pragma unroll
        for (int i = 0; i < 16; ++i) {
            *(LAS unsigned short*)(obp + ((i & 3) + 8 * (i >> 2)) * (LQ * 2)) = (unsigned short)(cvtpk2(o0[i], 0.f) & 0xffffu);
            *(LAS unsigned short*)(obp + (32 + (i & 3) + 8 * (i >> 2)) * (LQ * 2)) = (unsigned short)(cvtpk2(o1[i], 0.f) & 0xffffu);
        }
    }
    __syncthreads();
    {
        const int t4 = tid & 255, pos = t4 >> 2, seg = t4 & 3;
        const LAS unsigned char* op = lds + O_OT + half * (64 * LQ * 2) + (pos * LQ + seg * 32) * 2;
        u32x4 wv[4];
#pragma unroll
        for (int q = 0; q < 4; ++q) wv[q] = *(const LAS u32x4*)(op + q * 16);
        float ss = 0.f;
#pragma unroll
        for (int q = 0; q < 4; ++q)
#pragma unroll
            for (int e = 0; e < 4; ++e) { const float a = bflo_(wv[q][e]), c = bfhi_(wv[q][e]); ss += a * a + c * c; }
        ss += __shfl_xor(ss, 1); ss += __shfl_xor(ss, 2);
        const float rs = rsqrtf(ss * (1.f / 128.f) + 1e-6f);
        const size_t m = (size_t)b * 4096 + (size_t)n * 64 + pos;
        const bf16* zp = DNZ + m * 512 + hd * 128 + seg * 32; bf16* yp = Y + m * 1024 + hd * 128 + seg * 32; const LAS float* nw = (const LAS float*)(lds + O_NW) + seg * 32;
#pragma unroll
        for (int q = 0; q < 4; ++q) {
            const u32x4 z = *(const u32x4*)(zp + q * 8); u32x4 o;
#pragma unroll
            for (int e = 0; e < 4; ++e) {
                const float z0 = bflo_(z[e]), z1 = bfhi_(z[e]);
                o[e] = cvtpk2(bflo_(wv[q][e]) * rs * nw[q * 8 + 2 * e] * (z0 / (1.f + __expf(-z0))), bfhi_(wv[q][e]) * rs * nw[q * 8 + 2 * e + 1] * (z1 / (1.f + __expf(-z1))));
            }
            *(u32x4*)(yp + q * 8) = o;
        }
    }
    __syncthreads();
}
#undef DN_MFMA
#undef DNI
}
constexpr int NWAVES = 8, NTHR = NWAVES * 64;
constexpr int BATCH = 4, SEQ = 4096, DM = 1024, M = BATCH * SEQ;
constexpr int HD = 128, NH = 4, DDN = 512, DMB = 512, NPROJ = 3584, DINP = 3592;
constexpr int MBLK = 256, NBLK = SEQ / MBLK;
constexpr int NE = 16, DE = 256;
constexpr float LN_EPS = 1e-5f, RMS_EPS = 1e-6f, ALPHA = 1.189207115002721f, QSCALE = 0.08838834764831845f;

constexpr size_t MiB = 1u << 20;
constexpr size_t WS_CTL = 0, CTL_ZERO_BYTES = 1 * MiB;
constexpr size_t WS_WIN = 2 * MiB;
constexpr size_t WS_WOUT = 10 * MiB;
constexpr size_t WS_WGU = 12 * MiB;
constexpr size_t WS_WD = 28 * MiB;
constexpr size_t WS_ROPE = 36 * MiB;
constexpr size_t WS_KMP = 38 * MiB;
constexpr size_t WS_GATES = 39 * MiB;
constexpr size_t WS_BETA = WS_GATES + 512 * 1024;
constexpr size_t WS_GLOG = WS_BETA + 256 * 1024;
constexpr size_t WS_XB = 48 * MiB;
constexpr size_t WS_DNQN = 48 * MiB, WS_DNKN = 64 * MiB;
constexpr size_t WS_PJ = 80 * MiB;
constexpr size_t PJ_STRIDE = 16 * MiB;
constexpr size_t WS_Y = 192 * MiB;
constexpr size_t WS_DNVN = 224 * MiB;
constexpr size_t WS_GL = 40 * MiB;
constexpr size_t WS_SF = 48 * MiB;
constexpr size_t WS_VF = 224 * MiB;
constexpr size_t WS_UF = 240 * MiB;
constexpr size_t WS_TOKE = 41 * MiB;
constexpr size_t WS_TOKP = WS_TOKE + 256 * 1024;
constexpr size_t WS_TOKW = WS_TOKP + 256 * 1024;
constexpr size_t WS_HB = 48 * MiB;
constexpr size_t WS_HS = 80 * MiB;
constexpr size_t WS_HE = 152 * MiB;
constexpr size_t WS_Y2 = 170 * MiB;
constexpr size_t WS_MIXB = 224 * MiB;
constexpr size_t WS_END = 256 * MiB;
constexpr int CW_CNT = 64;
constexpr int CW_SEAM = 16384;
constexpr size_t WS_LIST = 43 * MiB;
constexpr size_t WS_XBUF = 42 * MiB;
constexpr int CW_BAR = 4096;

constexpr int RING_OFF = 0, RING_BYTES = 139264;
constexpr int LDSCTL_OFF = RING_BYTES, MISC_OFF = LDSCTL_OFF + 320;
constexpr int LDS_BYTES = 147456;

#define DI __device__ __forceinline__
DI float bf2f(unsigned short v) { return __uint_as_float((unsigned)v << 16); }
DI float bflo(unsigned w) { return __uint_as_float(w << 16); }
DI float bfhi(unsigned w) { return __uint_as_float(w & 0xffff0000u); }
DI float wave_sum(float v) {
#pragma unroll
    for (int o = 1; o < 64; o <<= 1) v += __shfl_xor(v, o);
    return v;
}
DI float wave_max(float v) {
#pragma unroll
    for (int o = 1; o < 64; o <<= 1) v = fmaxf(v, __shfl_xor(v, o));
    return v;
}
DI float silu_f(float v) { return v / (1.f + __expf(-v)); }
DI float softplus_f(float v) { return fmaxf(v, 0.f) + log1pf(__expf(-fabsf(v))); }

struct Args {
    const GAS float* in_[18]; GAS float* out_; GAS unsigned char* ws_; int ph_lo, ph_hi;
    DI const float* I(int k) const { return (const float*)in_[k]; }
    DI float* O() const { return (float*)out_; }
    DI unsigned char* W() const { return (unsigned char*)ws_; }
};
#define CAS __attribute__((address_space(4)))
struct KA {
    const CAS unsigned char* p;
    DI const float* I(int k) const { return (const float*)(*(const GAS float* const CAS*)(p + 8 * k)); }
    DI float* O() const { return (float*)(*(GAS float* const CAS*)(p + 144)); }
    DI unsigned char* W() const { return (unsigned char*)(*(GAS unsigned char* const CAS*)(p + 152)); }
    DI int lo() const { return *(const CAS int*)(p + 160); }
    DI int hi() const { return *(const CAS int*)(p + 164); }
};
static_assert(offsetof(Args, out_) == 144 && offsetof(Args, ws_) == 152 && offsetof(Args, ph_lo) == 160 && offsetof(Args, ph_hi) == 164, "Args layout");
DI KA kargs() { KA a; a.p = (const CAS unsigned char*)__builtin_amdgcn_kernarg_segment_ptr(); asm volatile("" : "+s"(a.p)); return a; }
struct Frame {
    LAS unsigned char* lds;
    int tid, lane, wave, vcu, G;
};

struct TItem { const float* src; int ldw; bf16* dst; int K; };
DI void t_load(const TItem& t, f32x4 (&v)[8], int lane) {
    const float* p = t.src + (size_t)(lane >> 3) * t.ldw + 4 * (lane & 7);
#pragma unroll
    for (int i = 0; i < 8; ++i) v[i] = *(const f32x4*)(p + (size_t)(8 * i) * t.ldw);
}
DI void t_store(const TItem& t, const f32x4 (&v)[8], LAS float* scr, int lane) {
    { LAS float* q = scr + (lane >> 3) * 33 + 4 * (lane & 7);
#pragma unroll
      for (int i = 0; i < 8; ++i) { q[i * 264] = v[i].x; q[i * 264 + 1] = v[i].y; q[i * 264 + 2] = v[i].z; q[i * 264 + 3] = v[i].w; } }
    LDS_WAIT(); asm volatile("" ::: "memory");
    const int c = lane & 7;
#pragma unroll
    for (int j = 0; j < 4; ++j) { const int n = (lane >> 3) + 8 * j; const LAS float* s = scr + (8 * c) * 33 + n;
        v4u o; o.x = pk2(s[0 * 33], s[1 * 33]); o.y = pk2(s[2 * 33], s[3 * 33]); o.z = pk2(s[4 * 33], s[5 * 33]); o.w = pk2(s[6 * 33], s[7 * 33]);
        *(GAS v4u*)(t.dst + (size_t)n * t.K + 8 * c) = o; }
    LDS_WAIT(); asm volatile("" ::: "memory");
}

constexpr int TR_I_A = 16 * 64, TR_I_B = 16 * 48, TR_I_O = 16 * 32, TR_I_GU = NE * 4 * 64, TR_I_D = NE * 128, TR_I_ALL = TR_I_A + TR_I_B + TR_I_O + TR_I_GU + TR_I_D;
DI void weight_transposes(const Frame& F, const KA& A, int first, int last, int worker, int nworkers) {
    unsigned char* ws = A.W();
    const float* w_in = A.I(1); const float* w_out = A.I(6);
    {
        LAS float* scr = (LAS float*)(F.lds + RING_OFF + F.wave * 16384);
        bf16* WIN = (bf16*)(ws + WS_WIN); bf16* WOUT = (bf16*)(ws + WS_WOUT);
        constexpr int I_A = TR_I_A, I_B = TR_I_B, I_O = TR_I_O, I_GU = TR_I_GU;
        const float* wgate = A.I(13); const float* wup = A.I(14); const float* wdn = A.I(15);
        bf16* WGU = (bf16*)(ws + WS_WGU); bf16* WD = (bf16*)(ws + WS_WD);
        auto item = [&](int r) -> TItem {
            TItem t;
            if (r < I_A) { const int kb = r / 64, nb = r % 64; t.src = w_in + (size_t)(64 * kb) * DINP + 32 * nb; t.ldw = DINP; t.dst = WIN + (size_t)(32 * nb) * DM + 64 * kb; t.K = DM; return t; } r -= I_A;
            if (r < I_B) { const int kb = r / 48, nb = r % 48; int dst = 2048 + 32 * nb;
#ifdef ROPE_EPI
                if (nb < 32) { const int sl = nb >> 4, cis = 32 * (nb & 15), head = cis >> 7, dblk = (cis & 127) >> 5;
                    dst = 2048 + sl * 512 + (head >> 1) * 256 + (dblk < 2 ? (head & 1) * 64 + 32 * dblk : 128 + (head & 1) * 64 + 32 * (dblk - 2)); }
#endif
                t.src = w_in + (size_t)(64 * kb) * DINP + 2056 + 32 * nb; t.ldw = DINP; t.dst = WIN + (size_t)dst * DM + 64 * kb; t.K = DM; return t; } r -= I_B;
            if (r < I_O) { const int kb = r / 32, nb = r % 32; t.src = w_out + (size_t)(64 * kb) * DM + 32 * nb; t.ldw = DM; t.dst = WOUT + (size_t)(32 * nb) * DM + 64 * kb; t.K = DM; return t; } r -= I_O;
            if (r < I_GU) {
                const int e = r >> 8, q = (r >> 6) & 3, pn = q >> 1, up = q & 1, kb = (r >> 2) & 15, nb = r & 3;
                t.src = (up ? wup : wgate) + (size_t)e * DM * DE + (size_t)(64 * kb) * DE + pn * 128 + 32 * nb; t.ldw = DE;
                t.dst = WGU + (size_t)(e * 512 + pn * 256 + up * 128 + 32 * nb) * DM + 64 * kb; t.K = DM; return t; } r -= I_GU;
            { const int e = r >> 7, kb = (r >> 5) & 3, nb = r & 31;
              t.src = wdn + (size_t)e * DE * DM + (size_t)(64 * kb) * DM + 32 * nb; t.ldw = DM; t.dst = WD + (size_t)e * DM * DE + (size_t)(32 * nb) * DE + 64 * kb; t.K = DE; return t; }
        };
        f32x4 va[8], vb[8];
        int it = first + worker;
        if (it < last) { const TItem t0 = item(it); t_load(t0, va, F.lane); }
#pragma unroll 1
        for (; it < last; it += 2 * nworkers) {
            const bool hb = it + nworkers < last;
            if (hb) { const TItem t1 = item(it + nworkers); t_load(t1, vb, F.lane); }
            { const TItem t0 = item(it); t_store(t0, va, scr, F.lane); }
            if (!hb) break;
            if (it + 2 * nworkers < last) { const TItem t2 = item(it + 2 * nworkers); t_load(t2, va, F.lane); }
            { const TItem t1 = item(it + nworkers); t_store(t1, vb, scr, F.lane); }
        }
    }
}

DI void p0_prologue(const Frame& F, const KA& A) {
    unsigned char* ws = A.W();
    const float* x = A.I(0); const float* w_in = A.I(1); const float* w_out = A.I(6);
    const int gw = F.vcu * NWAVES + F.wave, NGW = F.G * NWAVES;
#ifndef DUP_P0A
#define DUP_P0A 1
#endif
#ifndef DUP_P0B
#define DUP_P0B 1
#endif
    for (int ra_ = 0; ra_ < DUP_P0A; ++ra_) {
        LAS float* wgl = (LAS float*)(F.lds + RING_OFF);
        for (int i = F.tid; i < 1024 * 8; i += NTHR) { const int k = i >> 3, q = i & 7;
            wgl[(q >> 2) * 4096 + ((((k >> 8) * 4 + (k & 3)) * 64 + ((k & 255) >> 2)) << 2) + (q & 3)] = w_in[(size_t)k * DINP + 2048 + q]; }
        __syncthreads();
        bf16* XB = (bf16*)(ws + WS_XB); float* GATES = (float*)(ws + WS_GATES);
        for (int m0 = gw * 4; m0 < M; m0 += NGW * 4) {
            f32x4 v[4][4];
#pragma unroll
            for (int rr = 0; rr < 4; ++rr) { const GAS f32x4* xr = (const GAS f32x4*)(x + (size_t)(m0 + rr) * DM) + F.lane;
#pragma unroll
                for (int j = 0; j < 4; ++j) v[rr][j] = xr[64 * j]; }
            float g[4][8];
#pragma unroll
            for (int rr = 0; rr < 4; ++rr) {
#pragma unroll
                for (int q = 0; q < 8; ++q) g[rr][q] = 0.f; }
#pragma unroll
            for (int j = 0; j < 4; ++j) {
#pragma unroll
                for (int rr = 0; rr < 4; ++rr) { GAS unsigned long long* o8 = (GAS unsigned long long*)(XB + (size_t)(m0 + rr) * DM) + F.lane;
                    o8[64 * j] = (unsigned long long)pk2(v[rr][j].x, v[rr][j].y) | ((unsigned long long)pk2(v[rr][j].z, v[rr][j].w) << 32); }
#pragma unroll
                for (int e = 0; e < 4; ++e) {
                    const f32x4 w0 = *(const LAS f32x4*)(wgl + (((j * 4 + e) * 64 + F.lane) << 2)), w1 = *(const LAS f32x4*)(wgl + 4096 + (((j * 4 + e) * 64 + F.lane) << 2));
#pragma unroll
                    for (int rr = 0; rr < 4; ++rr) { const float xv = v[rr][j][e];
                        g[rr][0] += xv * w0.x; g[rr][1] += xv * w0.y; g[rr][2] += xv * w0.z; g[rr][3] += xv * w0.w;
                        g[rr][4] += xv * w1.x; g[rr][5] += xv * w1.y; g[rr][6] += xv * w1.z; g[rr][7] += xv * w1.w; }
                }
            }
#pragma unroll
            for (int rr = 0; rr < 4; ++rr) {
#pragma unroll
                for (int q = 0; q < 8; ++q) g[rr][q] = wave_sum(g[rr][q]);
                if (F.lane == 0) {
#pragma unroll
                    for (int q = 0; q < 8; ++q) GATES[(size_t)(m0 + rr) * 8 + q] = g[rr][q];
                }
            }
        }
        __syncthreads();
    }
    for (int rb_ = 0; rb_ < DUP_P0B; ++rb_) weight_transposes(F, A, 0, TR_I_A + TR_I_B, gw, NGW);
    {
        float2* ROPE = (float2*)(ws + WS_ROPE);
        for (int i = (F.vcu * NTHR + F.tid); i < SEQ * 64; i += F.G * NTHR) {
            const int pos = i >> 6, j = i & 63;
            const float inv = exp2f(-(float)j * (13.287712379549449f / 64.f));
            const float ang = (float)pos * inv;
            double rev = (double)ang * 0.15915494309189535; rev -= __builtin_rint(rev);
            const float rr = (float)rev;
            ROPE[i] = make_float2(__builtin_amdgcn_cosf(rr), __builtin_amdgcn_sinf(rr));
        }
    }
}

DI void n2a_conv_norm(const Frame& F, const KA& A) {
    unsigned char* ws = A.W();
    const float* conv_w = A.I(2); const float* a_log = A.I(3); const float* dt_bias = A.I(4);
    const bf16* PJ = (const bf16*)(ws + WS_PJ);
    bf16* OUTX[3] = {(bf16*)(ws + WS_DNQN), (bf16*)(ws + WS_DNKN), (bf16*)(ws + WS_DNVN)};
    const float* GATES = (const float*)(ws + WS_GATES); float* BETA = (float*)(ws + WS_BETA); float* GLOG = (float*)(ws + WS_GLOG);
    const int gw = F.vcu * NWAVES + F.wave, NGW = F.G * NWAVES;
    for (int it = gw; it < M * NH; it += NGW) {
        const int m = it >> 2, h = it & 3, t = m & (SEQ - 1), c = 2 * F.lane;
        float val[3][2];
#pragma unroll
        for (int X = 0; X < 3; ++X) {
            float a0 = 0.f, a1 = 0.f;
#pragma unroll
            for (int j = 0; j < 4; ++j) {
                const int tt = t - 3 + j;
                if (tt >= 0) {
                    const unsigned raw = *(const unsigned*)(PJ + X * (PJ_STRIDE / 2) + (size_t)(m - 3 + j) * 512 + h * 128 + c);
                    const float w0 = conv_w[j * 1536 + X * 512 + h * 128 + c], w1 = conv_w[j * 1536 + X * 512 + h * 128 + c + 1];
                    a0 += w0 * bflo(raw); a1 += w1 * bfhi(raw);
                }
            }
            val[X][0] = silu_f(a0); val[X][1] = silu_f(a1);
        }
        const float sq = wave_sum(val[0][0] * val[0][0] + val[0][1] * val[0][1]);
        const float sk = wave_sum(val[1][0] * val[1][0] + val[1][1] * val[1][1]);
        const float rq = rsqrtf(sq + 1e-6f) * QSCALE, rk = rsqrtf(sk + 1e-6f);
        val[0][0] *= rq; val[0][1] *= rq; val[1][0] *= rk; val[1][1] *= rk;
#pragma unroll
        for (int X = 0; X < 3; ++X) *(unsigned*)(OUTX[X] + (size_t)m * 512 + h * 128 + c) = pk2(val[X][0], val[X][1]);
        if (F.lane == 0) {
            const float bb = GATES[(size_t)m * 8 + h], aa = GATES[(size_t)m * 8 + 4 + h];
            BETA[(size_t)m * 4 + h] = 1.f / (1.f + __expf(-bb));
            GLOG[(size_t)m * 4 + h] = -__expf(a_log[h]) * softplus_f(aa + dt_bias[h]);
        }
    }
}

DI void rope8(bf16* p, const float2* rp, float* s1, float* s2) {
    const v4u lo = *(const v4u*)p, hi = *(const v4u*)(p + 64);
    const f32x4 c0 = *(const f32x4*)rp, c1 = *(const f32x4*)(rp + 2), c2 = *(const f32x4*)(rp + 4), c3 = *(const f32x4*)(rp + 6);
    const float cs[8] = {c0.x, c0.z, c1.x, c1.z, c2.x, c2.z, c3.x, c3.z}, sn[8] = {c0.y, c0.w, c1.y, c1.w, c2.y, c2.w, c3.y, c3.w};
    float r1[8], r2[8];
#pragma unroll
    for (int e = 0; e < 4; ++e) {
        const float a0 = bflo(lo[e]), a1 = bfhi(lo[e]), b0 = bflo(hi[e]), b1 = bfhi(hi[e]);
        r1[2 * e] = a0 * cs[2 * e] - b0 * sn[2 * e]; r2[2 * e] = b0 * cs[2 * e] + a0 * sn[2 * e];
        r1[2 * e + 1] = a1 * cs[2 * e + 1] - b1 * sn[2 * e + 1]; r2[2 * e + 1] = b1 * cs[2 * e + 1] + a1 * sn[2 * e + 1];
    }
    v4u o1, o2;
#pragma unroll
    for (int e = 0; e < 4; ++e) { o1[e] = pk2(r1[2 * e], r1[2 * e + 1]); o2[e] = pk2(r2[2 * e], r2[2 * e + 1]); }
    *(v4u*)p = o1; *(v4u*)(p + 64) = o2;
    if (s1) {
#pragma unroll
        for (int e = 0; e < 8; ++e) { s1[e] += r1[e]; s2[e] += r2[e]; }
    }
}
DI void n3a_rope(const Frame& F, const KA& A) {
    unsigned char* ws = A.W();
    bf16* MBQ = (bf16*)(ws + WS_PJ + 4 * PJ_STRIDE); bf16* MBK = (bf16*)(ws + WS_PJ + 5 * PJ_STRIDE);
    const float2* ROPE = (const float2*)(ws + WS_ROPE); float* KMP = (float*)(ws + WS_KMP);
    const int gw = F.vcu * NWAVES + F.wave, NGW = F.G * NWAVES, rr = F.lane >> 3, dseg = F.lane & 7;
    for (int it = gw; it < 1024; it += NGW) {
        const int qtr = it & 3, j = (it >> 2) & 15, h = (it >> 6) & 3, b = it >> 8;
        float s1[8], s2[8];
#pragma unroll
        for (int e = 0; e < 8; ++e) { s1[e] = 0.f; s2[e] = 0.f; }
#pragma unroll 2
        for (int r8 = 0; r8 < 8; ++r8) {
            const int pos = j * 256 + qtr * 64 + r8 * 8 + rr; const size_t m = (size_t)b * SEQ + pos;
            rope8(MBK + m * 512 + h * 128 + dseg * 8, ROPE + pos * 64 + dseg * 8, s1, s2);
        }
#pragma unroll
        for (int e = 0; e < 8; ++e) { s1[e] += __shfl_xor(s1[e], 8); s1[e] += __shfl_xor(s1[e], 16); s1[e] += __shfl_xor(s1[e], 32);
                                      s2[e] += __shfl_xor(s2[e], 8); s2[e] += __shfl_xor(s2[e], 16); s2[e] += __shfl_xor(s2[e], 32); }
        if (rr == 0) {
#pragma unroll
            for (int e = 0; e < 8; ++e) { KMP[(size_t)it * 128 + dseg * 8 + e] = s1[e]; KMP[(size_t)it * 128 + 64 + dseg * 8 + e] = s2[e]; }
        }
    }
    for (int it = gw; it < (M / 8) * NH; it += NGW) {
        const int m8 = it >> 2, h = it & 3; const size_t m = (size_t)m8 * 8 + rr; const int pos = (int)(m & (SEQ - 1));
        rope8(MBQ + m * 512 + h * 128 + dseg * 8, ROPE + pos * 64 + dseg * 8, nullptr, nullptr);
    }
}

DI void n2b_dn_recurrent(const Frame& F, const KA& A, int item, float* ODN) {
    unsigned char* ws = A.W();
    const bf16* QN = (const bf16*)(ws + WS_DNQN); const bf16* KN = (const bf16*)(ws + WS_DNKN); const bf16* VN = (const bf16*)(ws + WS_DNVN);
    const float* BETA = (const float*)(ws + WS_BETA); const float* GLOG = (const float*)(ws + WS_GLOG);
    const int b = item >> 2, h = item & 3;
    LAS float* qs = (LAS float*)(F.lds + RING_OFF);
    LAS float* ks = qs + 16 * 128; LAS float* vs = ks + 16 * 128; LAS float* bs = vs + 16 * 128; LAS float* as = bs + 16;
    float S[128];
#pragma unroll
    for (int k = 0; k < 128; ++k) S[k] = 0.f;
    for (int t0 = 0; t0 < SEQ; t0 += 16) {
        __syncthreads();
        for (int idx = F.tid; idx < 16 * 384; idx += NTHR) {
            const int r = idx / 384, c = idx % 384, X = c >> 7, cc = c & 127; const size_t m = (size_t)b * SEQ + t0 + r;
            const bf16* src = X == 0 ? QN : (X == 1 ? KN : VN);
            (X == 0 ? qs : (X == 1 ? ks : vs))[r * 128 + cc] = bf2f(src[m * 512 + h * 128 + cc]);
        }
        if (F.tid < 16) { const size_t m = (size_t)b * SEQ + t0 + F.tid; bs[F.tid] = BETA[m * 4 + h]; as[F.tid] = __expf(GLOG[m * 4 + h]); }
        __syncthreads();
        if (F.tid < 128) {
#pragma unroll 1
            for (int r = 0; r < 16; ++r) {
                const LAS float* kr = ks + r * 128; const LAS float* qr = qs + r * 128;
                float kS = 0.f;
#pragma unroll
                for (int kb = 0; kb < 128; kb += 16) {
#pragma unroll
                    for (int k = 0; k < 16; ++k) kS += kr[kb + k] * S[kb + k];
                    asm volatile("" ::: "memory");
                }
                const float al = as[r], be = bs[r];
                const float vn = be * (vs[r * 128 + F.tid] - al * kS);
                float o = 0.f;
#pragma unroll
                for (int kb = 0; kb < 128; kb += 16) {
#pragma unroll
                    for (int k = 0; k < 16; ++k) { S[kb + k] = al * S[kb + k] + kr[kb + k] * vn; o += qr[kb + k] * S[kb + k]; }
                    asm volatile("" ::: "memory");
                }
                ODN[((size_t)b * SEQ + t0 + r) * 512 + h * 128 + F.tid] = o;
            }
        }
    }
}

DI void n3b_moba_naive(const Frame& F, const KA& A, int w0, int nw, bf16* Yo, int ypitch, int ycol0) {
    unsigned char* ws = A.W();
    const bf16* MBQ = (const bf16*)(ws + WS_PJ + 4 * PJ_STRIDE); const bf16* MBK = (const bf16*)(ws + WS_PJ + 5 * PJ_STRIDE); const bf16* MBV = (const bf16*)(ws + WS_PJ + 6 * PJ_STRIDE);
    const float* KMP = (const float*)(ws + WS_KMP);
    LAS float* qs = (LAS float*)(F.lds + RING_OFF + 32768) + F.wave * 128;
    const int lane = F.lane;
    for (int it = w0; it < M * NH; it += nw) {
        const int m = it >> 2, h = it & 3, b = m >> 12, t = m & (SEQ - 1), own = t >> 8;
        { const unsigned raw = *(const unsigned*)(MBQ + (size_t)m * 512 + h * 128 + 2 * lane); qs[2 * lane] = bflo(raw) * QSCALE; qs[2 * lane + 1] = bfhi(raw) * QSCALE; }
        asm volatile("s_waitcnt lgkmcnt(0)" ::: "memory");
        float gate = -3e38f;
        if (lane < own) {
            const float* kp = KMP + (size_t)(((b * 4 + h) * 16 + lane) * 4) * 128; float acc = 0.f;
            for (int dd = 0; dd < 128; ++dd) acc += qs[dd] * ((kp[dd] + kp[128 + dd]) + (kp[256 + dd] + kp[384 + dd]));
            gate = acc * (1.f / 256.f);
        }
        int blist[4] = {-1, -1, -1, own};
#pragma unroll
        for (int r = 0; r < 3; ++r) {
            const float mx = wave_max(gate);
            if (mx > -1e37f) {
                const unsigned long long bal = __ballot(gate == mx); const int idx = __builtin_ctzll(bal);
                blist[r] = idx; if (lane == idx) gate = -3e38f;
            }
        }
        float sc[4][4]; float mloc = -3e38f;
#pragma unroll
        for (int s = 0; s < 4; ++s) {
            const int jb = blist[s];
#pragma unroll
            for (int i = 0; i < 4; ++i) {
                float v = -3e38f;
                if (jb >= 0) {
                    const int key = jb * 256 + i * 64 + lane;
                    if (s < 3 || key <= t) {
                        const bf16* kp = MBK + ((size_t)b * SEQ + key) * 512 + h * 128; float acc = 0.f;
#pragma unroll 4
                        for (int c8 = 0; c8 < 16; ++c8) { const v4u w = *(const v4u*)(kp + c8 * 8); const LAS float* q8 = qs + c8 * 8;
                            acc += q8[0] * bflo(w.x) + q8[1] * bfhi(w.x) + q8[2] * bflo(w.y) + q8[3] * bfhi(w.y) + q8[4] * bflo(w.z) + q8[5] * bfhi(w.z) + q8[6] * bflo(w.w) + q8[7] * bfhi(w.w); }
                        v = acc;
                    }
                }
                sc[s][i] = v; mloc = fmaxf(mloc, v);
            }
        }
        const float mx = wave_max(mloc); float lsum = 0.f;
#pragma unroll
        for (int s = 0; s < 4; ++s)
#pragma unroll
            for (int i = 0; i < 4; ++i) { const float p = sc[s][i] > -1e37f ? __expf(sc[s][i] - mx) : 0.f; sc[s][i] = p; lsum += p; }
        const float l = wave_sum(lsum);
        float o0 = 0.f, o1 = 0.f;
#pragma unroll
        for (int s = 0; s < 4; ++s) {
            const int jb = blist[s];
            if (jb >= 0) {
#pragma unroll
                for (int i = 0; i < 4; ++i) {
                    const bf16* vp = MBV + ((size_t)b * SEQ + jb * 256 + i * 64) * 512 + h * 128 + 2 * lane;
                    for (int src = 0; src < 64; ++src) {
                        const float pv = __shfl(sc[s][i], src);
                        if (pv != 0.f) { const unsigned raw = *(const unsigned*)(vp + (size_t)src * 512); o0 += pv * bflo(raw); o1 += pv * bfhi(raw); }
                    }
                }
            }
        }
        const float il = 1.f / l;
        *(unsigned*)(Yo + (size_t)m * ypitch + ycol0 + h * 128 + 2 * lane) = pk2(o0 * il, o1 * il);
        asm volatile("s_waitcnt lgkmcnt(0)" ::: "memory");
    }
}

DI void n2c_dn_gate(const Frame& F, const KA& A, const float* ODN, bf16* Yo, int ypitch) {
    unsigned char* ws = A.W();
    const float* norm_w = A.I(5); const bf16* DNZ = (const bf16*)(ws + WS_PJ + 3 * PJ_STRIDE);
    const int gw = F.vcu * NWAVES + F.wave, NGW = F.G * NWAVES, c = 2 * F.lane;
    for (int it = gw; it < M * NH; it += NGW) {
        const int m = it >> 2, h = it & 3;
        const float2 o = *(const float2*)(ODN + (size_t)m * 512 + h * 128 + c);
        const float ss = wave_sum(o.x * o.x + o.y * o.y) * (1.f / 128.f);
        const float rs = rsqrtf(ss + RMS_EPS);
        const unsigned zr = *(const unsigned*)(DNZ + (size_t)m * 512 + h * 128 + c);
        *(unsigned*)(Yo + (size_t)m * ypitch + h * 128 + c) = pk2(o.x * rs * norm_w[c] * silu_f(bflo(zr)), o.y * rs * norm_w[c + 1] * silu_f(bfhi(zr)));
    }
}

constexpr int CW_DBG = 16;
DI void dbg_compare(const Frame& F, unsigned char* ws, const bf16* T, int tp, int tc0, const bf16* R, int rp, int rc0) {
    float sd = 0.f, sr = 0.f;
    for (int i = F.vcu * NTHR + F.tid; i < M * 256; i += F.G * NTHR) {
        const int m = i >> 8, c = (i & 255) * 2;
        const unsigned a = *(const unsigned*)(T + (size_t)m * tp + tc0 + c), b = *(const unsigned*)(R + (size_t)m * rp + rc0 + c);
        const float d0 = bflo(a) - bflo(b), d1 = bfhi(a) - bfhi(b); sd += d0 * d0 + d1 * d1; sr += bflo(b) * bflo(b) + bfhi(b) * bfhi(b);
    }
    sd = wave_sum(sd); sr = wave_sum(sr);
    if (F.lane == 0) { atomicAdd((float*)(ws + WS_CTL) + CW_DBG, sd); atomicAdd((float*)(ws + WS_CTL) + CW_DBG + 1, sr); }
}
DI float block_sum(float v, LAS float* red, int tid) {
    v = wave_sum(v);
    __syncthreads();
    if ((tid & 63) == 0) red[tid >> 6] = v;
    __syncthreads();
    float s = 0.f;
#pragma unroll
    for (int w = 0; w < NWAVES; ++w) s += red[w];
    return s;
}

DI void n5_token_tail(const Frame& F, const KA& A) {
    const float* x = A.I(0); const float* g1 = A.I(7); const float* b1 = A.I(8);
    const float* rw1 = A.I(9); const float* rb1 = A.I(10); const float* rw2 = A.I(11); const float* rb2 = A.I(12);
    const float* wg = A.I(13); const float* wu = A.I(14); const float* wd = A.I(15); const float* g2 = A.I(16); const float* b2 = A.I(17);
    float* out = A.O();
    LAS float* hs = (LAS float*)(F.lds + RING_OFF);
    LAS float* hes = hs + 1024;
    LAS float* lg = hes + 512;
    LAS float* red = lg + 32;
    LAS float* rt_ = red + 8;
    const int tid = F.tid;
    for (int m = blockIdx.x; m < M; m += F.G) {
        __syncthreads();
        const size_t ro = (size_t)m * DM;
        float v0 = ALPHA * x[ro + tid] + out[ro + tid], v1 = ALPHA * x[ro + tid + 512] + out[ro + tid + 512];
        const float mean = block_sum(v0 + v1, red, tid) * (1.f / DM);
        v0 -= mean; v1 -= mean;
        const float var = block_sum(v0 * v0 + v1 * v1, red, tid) * (1.f / DM);
        const float rstd = rsqrtf(var + LN_EPS);
        const float h0 = v0 * rstd * g1[tid] + b1[tid], h1 = v1 * rstd * g1[tid + 512] + b1[tid + 512];
        hs[tid] = h0; hs[tid + 512] = h1;
        __syncthreads();
        for (int li = F.wave; li < 20; li += NWAVES) {
            float acc = 0.f;
            for (int k = F.lane; k < DM; k += 64) {
                const float wv = li < 4 ? rw1[k * 4 + li] : rw2[((size_t)((li - 4) >> 2) * DM + k) * 4 + ((li - 4) & 3)];
                acc += hs[k] * wv;
            }
            acc = wave_sum(acc);
            if (F.lane == 0) lg[li] = acc;
        }
        __syncthreads();
        if (tid == 0) {
            float pgv[4]; float mx = -3e38f;
            for (int g = 0; g < 4; ++g) { pgv[g] = lg[g] + rb1[g]; mx = fmaxf(mx, pgv[g]); }
            float sum = 0.f; for (int g = 0; g < 4; ++g) { pgv[g] = __expf(pgv[g] - mx); sum += pgv[g]; }
            int gs = 0; for (int g = 1; g < 4; ++g) if (pgv[g] > pgv[gs]) gs = g;
            const float pg = pgv[gs] / sum;
            float pe[4]; mx = -3e38f;
            for (int e = 0; e < 4; ++e) { pe[e] = lg[4 + gs * 4 + e] + rb2[gs * 4 + e]; mx = fmaxf(mx, pe[e]); }
            sum = 0.f; for (int e = 0; e < 4; ++e) { pe[e] = __expf(pe[e] - mx); sum += pe[e]; }
            int e0 = 0; for (int e = 1; e < 4; ++e) if (pe[e] > pe[e0]) e0 = e;
            int e1 = (e0 == 0) ? 1 : 0; for (int e = 0; e < 4; ++e) if (e != e0 && pe[e] > pe[e1]) e1 = e;
            const float den = pe[e0] + pe[e1];
            rt_[0] = __int_as_float(gs * 4 + e0); rt_[1] = __int_as_float(gs * 4 + e1); rt_[2] = pg * pe[e0] / den; rt_[3] = pg * pe[e1] / den;
        }
        __syncthreads();
        const int ex[2] = {__float_as_int(rt_[0]), __float_as_int(rt_[1])}; const float wx[2] = {rt_[2], rt_[3]};
        {
            const int half = tid >> 8, j = tid & 255, e = ex[half];
            const float* pg_ = wg + (size_t)e * DM * DE + j; const float* pu_ = wu + (size_t)e * DM * DE + j;
            float ga = 0.f, ua = 0.f;
#pragma unroll 8
            for (int k = 0; k < DM; ++k) { const float hv = hs[k]; ga += hv * pg_[(size_t)k * DE]; ua += hv * pu_[(size_t)k * DE]; }
            hes[half * 256 + j] = silu_f(ga) * ua;
        }
        __syncthreads();
        float y0 = 0.f, y1 = 0.f;
#pragma unroll
        for (int half = 0; half < 2; ++half) {
            const float* pd = wd + (size_t)ex[half] * DE * DM + tid; float a0 = 0.f, a1 = 0.f;
#pragma unroll 8
            for (int j = 0; j < DE; ++j) { const float hv = hes[half * 256 + j]; a0 += hv * pd[(size_t)j * DM]; a1 += hv * pd[(size_t)j * DM + 512]; }
            y0 += wx[half] * a0; y1 += wx[half] * a1;
        }
        float u0 = ALPHA * h0 + y0, u1 = ALPHA * h1 + y1;
        const float mean2 = block_sum(u0 + u1, red, tid) * (1.f / DM);
        u0 -= mean2; u1 -= mean2;
        const float var2 = block_sum(u0 * u0 + u1 * u1, red, tid) * (1.f / DM);
        const float rstd2 = rsqrtf(var2 + LN_EPS);
        float dscale = 1.f;
#ifdef DBG_ANY
        { const float* dw = (const float*)(A.W() + WS_CTL) + CW_DBG; dscale = 1.f + sqrtf(dw[0] / fmaxf(dw[1], 1e-30f)); }
#endif
        out[ro + tid] = (u0 * rstd2 * g2[tid] + b2[tid]) * dscale; out[ro + tid + 512] = (u1 * rstd2 * g2[tid + 512] + b2[tid + 512]) * dscale;
    }
}

struct MbPart { int own, t_lo, t_hi, slot; };
struct MbSplit { int own, slot0, nparts; };
constexpr int MB_NPARTS = 30, MB_NSLOTS = 24, MB_NSPLIT = 10;
__device__ const MbPart MB_PARTS[MB_NPARTS] = {{5, 0, 24, -1}, {11, 0, 24, 10}, {11, 24, 48, 11}, {10, 0, 22, 8}, {10, 22, 44, 9}, {15, 0, 22, 21}, {15, 22, 44, 22}, {4, 0, 20, -1}, {9, 0, 20, 6}, {9, 20, 40, 7}, {13, 0, 20, 15}, {13, 20, 40, 16}, {14, 0, 20, 18}, {14, 20, 40, 19}, {14, 40, 60, 20}, {15, 44, 64, 23}, {8, 0, 18, 4}, {8, 18, 36, 5}, {12, 0, 18, 12}, {12, 18, 36, 13}, {3, 0, 16, -1}, {7, 0, 16, 2}, {7, 16, 32, 3}, {12, 36, 52, 14}, {13, 40, 56, 17}, {6, 0, 14, 0}, {6, 14, 28, 1}, {2, 0, 12, -1}, {1, 0, 8, -1}, {0, 0, 4, -1}};
__device__ const MbSplit MB_SPLITS[MB_NSPLIT] = {{6, 0, 2}, {7, 2, 2}, {8, 4, 2}, {9, 6, 2}, {10, 8, 2}, {11, 10, 2}, {12, 12, 3}, {13, 15, 3}, {14, 18, 3}, {15, 21, 3}};
constexpr size_t WS_MBPO = WS_PJ;
constexpr size_t WS_MBLSE = WS_PJ + 24 * MiB;
constexpr int CW_MBQ = 96;
typedef mb::BlockRef<bf16, bf16> mbref_t;
DI mbref_t mb_ref(unsigned char* ws, int p, int xq) {
    const int bh = __builtin_amdgcn_readfirstlane(2 * xq + (p & 1)), k = __builtin_amdgcn_readfirstlane(p >> 1);
    const MbPart pt = MB_PARTS[k];
    const int own = __builtin_amdgcn_readfirstlane(pt.own), slot = __builtin_amdgcn_readfirstlane(pt.slot);
    const int b = bh >> 2, h = bh & 3; const size_t row0 = (size_t)b * SEQ;
    mbref_t r;
    r.Q = (const bf16*)(ws + WS_PJ + 4 * PJ_STRIDE) + (row0 + (size_t)own * 256) * 512 + h * 128;
    r.K = (const bf16*)(ws + WS_PJ + 5 * PJ_STRIDE) + row0 * 512 + h * 128;
    r.V = (const bf16*)(ws + WS_PJ + 6 * PJ_STRIDE) + row0 * 512 + h * 128;
    r.O = (bf16*)(ws + WS_Y) + (row0 + (size_t)own * 256) * 1024 + 512 + h * 128;
#ifdef ROPE_EPI
    r.KM = (const float*)(ws + WS_KMP) + (size_t)(bh * 16) * 128;
#else
    r.KM = (const float*)(ws + WS_KMP) + (size_t)(bh * 64) * 128;
#endif
    r.P0 = own * 256; r.t_lo = __builtin_amdgcn_readfirstlane(pt.t_lo); r.t_hi = __builtin_amdgcn_readfirstlane(pt.t_hi);
    r.OP = slot >= 0 ? (bf16*)(ws + WS_MBPO) + (size_t)(bh * MB_NSLOTS + slot) * (256 * 128) : nullptr;
    r.LSE = slot >= 0 ? (float*)(ws + WS_MBLSE) + (size_t)(bh * MB_NSLOTS + slot) * 256 : nullptr;
    return r;
}
DI int mb_claim(unsigned char* ws, LAS unsigned* word, int tid, int xq) {
    if (tid == 0) *word = __hip_atomic_fetch_add((unsigned*)(ws + WS_CTL) + CW_MBQ + 64 * xq, 1u, __ATOMIC_RELAXED, __HIP_MEMORY_SCOPE_AGENT);
    __syncthreads();
    const int p = __builtin_amdgcn_readfirstlane((int)*word);
    __syncthreads();
    return p;
}
DI void p3_moba_queue(unsigned char* ws, char* lds, LAS unsigned* word, int tid, int xq) {
    constexpr int WBIG = 0x3fffffff, NP = MB_NPARTS * 2;
    int p = mb_claim(ws, word, tid, xq);
    if (p >= NP) return;
    mbref_t cur = mb_ref(ws, p, xq);
    mb::Seam<bf16> S;
    mb::causal_swa_prime<bf16, bf16>(cur, WBIG, lds, S);
#pragma unroll 1
    for (;;) {
        const int pn = mb_claim(ws, word, tid, xq);
        const bool more = pn < NP;
        const mbref_t nxt = more ? mb_ref(ws, pn, xq) : cur;
        mb::causal_swa_block<bf16, bf16>(cur, nxt, SEQ, WBIG, lds, S);
        if (!more) break;
        cur = nxt;
    }
}
DI mbref_t mb_ref_full(unsigned char* ws, int bh, int own_) {
    const int own = __builtin_amdgcn_readfirstlane(own_); const int b = bh >> 2, h = bh & 3; const size_t row0 = (size_t)b * SEQ;
    mbref_t r;
    r.Q = (const bf16*)(ws + WS_PJ + 4 * PJ_STRIDE) + (row0 + (size_t)own * 256) * 512 + h * 128;
    r.K = (const bf16*)(ws + WS_PJ + 5 * PJ_STRIDE) + row0 * 512 + h * 128;
    r.V = (const bf16*)(ws + WS_PJ + 6 * PJ_STRIDE) + row0 * 512 + h * 128;
    r.O = (bf16*)(ws + WS_Y) + (row0 + (size_t)own * 256) * 1024 + 512 + h * 128;
#ifdef ROPE_EPI
    r.KM = (const float*)(ws + WS_KMP) + (size_t)(bh * 16) * 128;
#else
    r.KM = (const float*)(ws + WS_KMP) + (size_t)(bh * 64) * 128;
#endif
    r.P0 = own * 256; r.t_lo = 0; r.t_hi = 4 * (own + 1); r.OP = nullptr; r.LSE = nullptr;
    return r;
}
DI void p3_moba_static(unsigned char* ws, char* lds, int bh, int own0, int own1) {
    constexpr int WBIG = 0x3fffffff;
    const int n = own1 >= 0 ? 2 : 1;
    mbref_t cur = mb_ref_full(ws, bh, own0);
    mb::Seam<bf16> S;
    mb::causal_swa_prime<bf16, bf16>(cur, WBIG, lds, S);
#pragma unroll 1
    for (int i = 0; i < n; ++i) {
        const mbref_t nxt = (i + 1 < n) ? mb_ref_full(ws, bh, own1) : cur;
        mb::causal_swa_block<bf16, bf16>(cur, nxt, SEQ, WBIG, lds, S);
        cur = nxt;
    }
}
DI void p4_moba_merge(unsigned char* ws, int it, int tid) {
    const int rh = it & 1, bh = (it >> 1) & 15; const MbSplit sp = MB_SPLITS[it >> 5];
    const int np = __builtin_amdgcn_readfirstlane(sp.nparts);
    const int b = bh >> 2, h = bh & 3, row = rh * 128 + (tid >> 2), qc = tid & 3;
    const float* lse = (const float*)(ws + WS_MBLSE) + (size_t)(bh * MB_NSLOTS + sp.slot0) * 256 + row;
    const bf16* po = (const bf16*)(ws + WS_MBPO) + (size_t)(bh * MB_NSLOTS + sp.slot0) * (256 * 128) + row * 128 + qc * 32;
    float l[3]; v4u w[3][4];
#pragma unroll
    for (int q = 0; q < 3; ++q) {
        const int qq = q < np ? q : 0;
        l[q] = lse[qq * 256];
#pragma unroll
        for (int c8 = 0; c8 < 4; ++c8) w[q][c8] = *(const v4u*)(po + (size_t)qq * (256 * 128) + c8 * 8);
    }
    float mx = -3e38f;
#pragma unroll
    for (int q = 0; q < 3; ++q) { l[q] = q < np ? l[q] : -__builtin_inff(); mx = fmaxf(mx, l[q]); }
    float wsum = 0.f;
#pragma unroll
    for (int q = 0; q < 3; ++q) { l[q] = __builtin_amdgcn_exp2f(l[q] - mx); wsum += l[q]; }
    const float inv = 1.f / wsum;
    bf16* yp = (bf16*)(ws + WS_Y) + ((size_t)b * SEQ + (size_t)sp.own * 256 + row) * 1024 + 512 + h * 128 + qc * 32;
#pragma unroll
    for (int c8 = 0; c8 < 4; ++c8) {
        v4u o;
#pragma unroll
        for (int e = 0; e < 4; ++e) {
            const float a0 = l[0] * bflo(w[0][c8][e]) + l[1] * bflo(w[1][c8][e]) + l[2] * bflo(w[2][c8][e]);
            const float a1 = l[0] * bfhi(w[0][c8][e]) + l[1] * bfhi(w[1][c8][e]) + l[2] * bfhi(w[2][c8][e]);
            o[e] = pk2(a0 * inv, a1 * inv);
        }
        *(v4u*)(yp + c8 * 8) = o;
    }
}

DI void p6_ln_router(const Frame& F, const KA& A) {
    unsigned char* ws = A.W();
    const float* x = A.I(0); const float* g1 = A.I(7); const float* b1 = A.I(8);
    const float* rw1 = A.I(9); const float* rb1 = A.I(10); const float* rw2 = A.I(11); const float* rb2 = A.I(12);
    float* out = A.O(); bf16* HB = (bf16*)(ws + WS_HB); const bf16* MIXB = (const bf16*)(ws + WS_MIXB); (void)out; (void)MIXB;
    int* TOKE = (int*)(ws + WS_TOKE); int* TOKP = (int*)(ws + WS_TOKP); float* TOKW = (float*)(ws + WS_TOKW);
    unsigned* gcnt = (unsigned*)(ws + WS_CTL) + CW_CNT; int* LIST = (int*)(ws + WS_LIST);
    LAS float* rwl = (LAS float*)(F.lds + RING_OFF);
    LAS unsigned* lcnt = (LAS unsigned*)(F.lds + RING_OFF + 81920);
    for (int i = F.tid; i < 1024 * 20; i += NTHR) { const int k = i / 20, li = i % 20;
        rwl[i] = li < 4 ? rw1[k * 4 + li] : rw2[((size_t)((li - 4) >> 2) * DM + k) * 4 + ((li - 4) & 3)]; }
    if (F.tid < 32) lcnt[F.tid] = 0u;
    __syncthreads();
    const int gw = F.vcu * NWAVES + F.wave, NGW = F.G * NWAVES;
#ifdef LN1_FUSE
    for (int m = gw; m < M; m += NGW) {
        const size_t ro = (size_t)m * DM;
        f32x4 v[4];
        float lg[20];
#pragma unroll
        for (int q = 0; q < 20; ++q) lg[q] = 0.f;
#pragma unroll
        for (int j = 0; j < 4; ++j) {
            v[j] = *(const f32x4*)(out + ro + 256 * j + 4 * F.lane);
#pragma unroll
            for (int e = 0; e < 4; ++e) { const LAS float* wr_ = rwl + (256 * j + 4 * F.lane + e) * 20; const float hv = v[j][e];
#pragma unroll
                for (int q4 = 0; q4 < 5; ++q4) { const f32x4 w4 = *(const LAS f32x4*)(wr_ + 4 * q4);
                    lg[4 * q4] += hv * w4.x; lg[4 * q4 + 1] += hv * w4.y; lg[4 * q4 + 2] += hv * w4.z; lg[4 * q4 + 3] += hv * w4.w; } }
        }
#else
    for (int m = gw; m < M; m += NGW) {
        const size_t ro = (size_t)m * DM;
        f32x4 v[4]; float s = 0.f;
#pragma unroll
        for (int j = 0; j < 4; ++j) { const f32x4 xv = *(const f32x4*)(x + ro + 256 * j + 4 * F.lane); const uint2 mr = *(const uint2*)(MIXB + ro + 256 * j + 4 * F.lane);
            v[j].x = xv.x * ALPHA + bflo(mr.x); v[j].y = xv.y * ALPHA + bfhi(mr.x); v[j].z = xv.z * ALPHA + bflo(mr.y); v[j].w = xv.w * ALPHA + bfhi(mr.y); s += (v[j].x + v[j].y) + (v[j].z + v[j].w); }
        const float mean = wave_sum(s) * (1.f / DM); float s2 = 0.f;
#pragma unroll
        for (int j = 0; j < 4; ++j) { v[j] = v[j] - mean; s2 += (v[j].x * v[j].x + v[j].y * v[j].y) + (v[j].z * v[j].z + v[j].w * v[j].w); }
        const float rstd = rsqrtf(wave_sum(s2) * (1.f / DM) + LN_EPS);
        float lg[20];
#pragma unroll
        for (int q = 0; q < 20; ++q) lg[q] = 0.f;
#pragma unroll
        for (int j = 0; j < 4; ++j) {
            const f32x4 gv = *(const f32x4*)(g1 + 256 * j + 4 * F.lane), bv = *(const f32x4*)(b1 + 256 * j + 4 * F.lane);
            v[j] = v[j] * rstd * gv + bv;
            *(unsigned long long*)(HB + ro + 256 * j + 4 * F.lane) = (unsigned long long)pk2(v[j].x, v[j].y) | ((unsigned long long)pk2(v[j].z, v[j].w) << 32);
#pragma unroll
            for (int e = 0; e < 4; ++e) { const LAS float* wr_ = rwl + (256 * j + 4 * F.lane + e) * 20; const float hv = v[j][e];
#pragma unroll
                for (int q4 = 0; q4 < 5; ++q4) { const f32x4 w4 = *(const LAS f32x4*)(wr_ + 4 * q4);
                    lg[4 * q4] += hv * w4.x; lg[4 * q4 + 1] += hv * w4.y; lg[4 * q4 + 2] += hv * w4.z; lg[4 * q4 + 3] += hv * w4.w; } }
        }
#endif
#pragma unroll
        for (int q = 0; q < 20; ++q) lg[q] = wave_sum(lg[q]);
        float pgv[4]; float mx = -3e38f;
#pragma unroll
        for (int g = 0; g < 4; ++g) { pgv[g] = lg[g] + rb1[g]; mx = fmaxf(mx, pgv[g]); }
        float sum = 0.f;
#pragma unroll
        for (int g = 0; g < 4; ++g) { pgv[g] = __expf(pgv[g] - mx); sum += pgv[g]; }
        int gs = 0; float pbest = pgv[0];
#pragma unroll
        for (int g = 1; g < 4; ++g) if (pgv[g] > pbest) { pbest = pgv[g]; gs = g; }
        const float pg = pbest / sum;
        float pe[4]; mx = -3e38f;
#pragma unroll
        for (int e = 0; e < 4; ++e) { float l2 = 0.f;
#pragma unroll
            for (int g = 0; g < 4; ++g) l2 = (g == gs) ? lg[4 + g * 4 + e] + rb2[g * 4 + e] : l2;
            pe[e] = l2; mx = fmaxf(mx, l2); }
#pragma unroll
        for (int e = 0; e < 4; ++e) pe[e] = __expf(pe[e] - mx);
        int e0 = 0; float p0 = pe[0];
#pragma unroll
        for (int e = 1; e < 4; ++e) if (pe[e] > p0) { p0 = pe[e]; e0 = e; }
        int e1 = -1; float p1 = -1.f;
#pragma unroll
        for (int e = 0; e < 4; ++e) if (e != e0 && pe[e] > p1) { p1 = pe[e]; e1 = e; }
        const float den = p0 + p1; const int x0 = gs * 4 + e0, x1 = gs * 4 + e1;
        if (F.lane == 0) {
            const unsigned i0 = __hip_atomic_fetch_add(lcnt + x0, 1u, __ATOMIC_RELAXED, __HIP_MEMORY_SCOPE_WORKGROUP);
            const unsigned i1 = __hip_atomic_fetch_add(lcnt + x1, 1u, __ATOMIC_RELAXED, __HIP_MEMORY_SCOPE_WORKGROUP);
            TOKE[m] = x0 | (x1 << 8); TOKP[2 * m] = (int)i0; TOKP[2 * m + 1] = (int)i1; TOKW[2 * m] = pg * p0 / den; TOKW[2 * m + 1] = pg * p1 / den;
        }
    }
    __syncthreads();
    if (F.tid < 16) lcnt[16 + F.tid] = __hip_atomic_fetch_add(gcnt + F.tid, lcnt[F.tid], __ATOMIC_RELAXED, __HIP_MEMORY_SCOPE_AGENT);
    __syncthreads();
    for (int m = gw; m < M; m += NGW) {
        if (F.lane == 0) { const int ee = TOKE[m], e0 = ee & 255, e1 = ee >> 8; const int q0 = TOKP[2 * m] + (int)lcnt[16 + e0], q1 = TOKP[2 * m + 1] + (int)lcnt[16 + e1];
            TOKP[2 * m] = q0; TOKP[2 * m + 1] = q1; LIST[e0 * 16384 + q0] = m; LIST[e1 * 16384 + q1] = m; }
    }
}
DI void moe_tile_table(const Frame& F, unsigned char* ws, LAS int* tb) {
    if (F.wave == 0) {
        const unsigned* gcnt = (const unsigned*)(ws + WS_CTL) + CW_CNT; const int e = F.lane & 15;
        const int c = (int)__hip_atomic_load(gcnt + e, __ATOMIC_RELAXED, __HIP_MEMORY_SCOPE_AGENT);
        const int ct = (c + 255) >> 8, fl = c >> 8; int pc = ct, pf = fl;
#pragma unroll
        for (int d = 1; d < 16; d <<= 1) { const int a = __shfl_up(pc, d), b = __shfl_up(pf, d); if (e >= d) { pc += a; pf += b; } }
        if (F.lane < 16) { tb[e] = pc - ct; for (int k = 0; k < fl; ++k) tb[18 + pf - fl + k] = pc - ct + k; if (e == 15) { tb[16] = pc; tb[17] = pf; } }
    }
    __syncthreads();
}
typedef float f32x16m __attribute__((ext_vector_type(16)));
template <int WR, int NCH, class WRowF, class TRowF>
DI void tail_gemm(const Frame& F, int r, WRowF wrow, TRowF trow, f32x16m (&acc)[WR / 32]) {
    const int TRp = (r + 31) & ~31, NQ = __builtin_amdgcn_readfirstlane((WR + TRp + 63) >> 6);
    int NS = RING_BYTES / (NQ * 8192); NS = NS > 8 ? 8 : NS; NS = NS > NCH ? NCH : NS; NS = __builtin_amdgcn_readfirstlane(NS);
    const int stage_b = NQ * 8192;
    const int l = F.lane, n = l & 31, kh = l >> 5;
    const char* gp[5];
#pragma unroll
    for (int q = 0; q < 5; ++q) { const int R = 8 * (F.wave + 8 * q) + (l >> 3);
        const char* base = R < WR ? wrow(R) : (R - WR < TRp ? trow(R - WR) : wrow(0));
        gp[q] = base + 16 * ((l & 7) ^ ((R >> 1) & 7)); }
#pragma unroll
    for (int wb = 0; wb < WR / 32; ++wb)
#pragma unroll
        for (int q = 0; q < 16; ++q) acc[wb][q] = 0.f;
    LAS unsigned char* ring = F.lds + RING_OFF;
#define TG_ISSUE(c, sofs) do { _Pragma("unroll") for (int q_ = 0; q_ < 5; ++q_) if (q_ < NQ) \
        __builtin_amdgcn_global_load_lds((const unsigned*)(gp[q_] + 128 * (c)), (LAS unsigned*)(ring + (sofs) + 1024 * (F.wave + 8 * q_)), 16, 0, 0); } while (0)
#pragma unroll 1
    for (int c = 0; c < NS - 1; ++c) TG_ISSUE(c, c * stage_b);
    const bool active = 32 * F.wave < r;
    const int pofs = ((n >> 1) & 7);
    int sofs = 0, iofs = (NS - 1) * stage_b;
#pragma unroll 1
    for (int c = 0; c < NCH; ++c) {
        { int ahead = NCH - 1 - c; ahead = ahead > NS - 2 ? NS - 2 : ahead;
          switch (ahead * NQ) {
            case 0: asm volatile("s_waitcnt vmcnt(0)" ::: "memory"); break; case 1: asm volatile("s_waitcnt vmcnt(1)" ::: "memory"); break; case 2: asm volatile("s_waitcnt vmcnt(2)" ::: "memory"); break;
            case 3: asm volatile("s_waitcnt vmcnt(3)" ::: "memory"); break; case 4: asm volatile("s_waitcnt vmcnt(4)" ::: "memory"); break; case 5: asm volatile("s_waitcnt vmcnt(5)" ::: "memory"); break;
            case 6: asm volatile("s_waitcnt vmcnt(6)" ::: "memory"); break; case 8: asm volatile("s_waitcnt vmcnt(8)" ::: "memory"); break; case 9: asm volatile("s_waitcnt vmcnt(9)" ::: "memory"); break;
            case 10: asm volatile("s_waitcnt vmcnt(10)" ::: "memory"); break; case 12: asm volatile("s_waitcnt vmcnt(12)" ::: "memory"); break;
            default: asm volatile("s_waitcnt vmcnt(0)" ::: "memory"); break; } }
        __builtin_amdgcn_s_barrier(); asm volatile("" ::: "memory");
        if (c + NS - 1 < NCH) TG_ISSUE(c + NS - 1, iofs);
        if (active) {
            const LAS unsigned char* sb = ring + sofs;
            bf16x8 b[4], a[WR / 32][4];
#pragma unroll
            for (int ks = 0; ks < 4; ++ks) { const int p = 16 * ((2 * ks + kh) ^ pofs);
                b[ks] = *(const LAS bf16x8*)(sb + (WR + 32 * F.wave + n) * 128 + p);
#pragma unroll
                for (int wb = 0; wb < WR / 32; ++wb) a[wb][ks] = *(const LAS bf16x8*)(sb + (32 * wb + n) * 128 + p); }
#pragma unroll
            for (int ks = 0; ks < 4; ++ks)
#pragma unroll
                for (int wb = 0; wb < WR / 32; ++wb) acc[wb] = __builtin_amdgcn_mfma_f32_32x32x16_bf16(a[wb][ks], b[ks], acc[wb], 0, 0, 0);
        }
        iofs = sofs; sofs += stage_b; if (sofs == NS * stage_b) sofs = 0;
    }
#undef TG_ISSUE
    asm volatile("" ::: "memory"); __builtin_amdgcn_s_barrier(); asm volatile("" ::: "memory");
}
DI void p8_tail(const Frame& F, unsigned char* ws, const LAS int* tb) {
    const bf16* HB = (const bf16*)(ws + WS_HB); const bf16* WGU = (const bf16*)(ws + WS_WGU); bf16* HE = (bf16*)(ws + WS_HE);
    const int* LIST = (const int*)(ws + WS_LIST); const unsigned* gcnt = (const unsigned*)(ws + WS_CTL) + CW_CNT;
    const int n = F.lane & 31, kh = F.lane >> 5;
    for (int u = F.vcu; u < 256; u += F.G) {
        const int e = u >> 4, s = u & 15;
        const int ce = __builtin_amdgcn_readfirstlane((int)__hip_atomic_load(gcnt + e, __ATOMIC_RELAXED, __HIP_MEMORY_SCOPE_AGENT)), full = ce >> 8, r = ce & 255;
        if (r == 0) continue;
        f32x16m acc[1];
        tail_gemm<32, 16>(F, r,
            [&](int R) -> const char* { return (const char*)(WGU + (size_t)(e * 512 + (s >> 3) * 256 + (R >= 16 ? 128 : 0) + (s & 7) * 16 + (R & 15)) * DM); },
            [&](int R) -> const char* { const int pos = full * 256 + R; const int tok = pos < ce ? LIST[e * 16384 + pos] : 0; return (const char*)(HB + (size_t)tok * DM); }, acc);
        const int pos = full * 256 + 32 * F.wave + n;
        if (pos < ce && 32 * F.wave < r) {
            bf16* orow = HE + ((size_t)tb[e] * 256 + pos) * DE + 16 * s + 4 * kh;
#pragma unroll
            for (int q = 0; q < 2; ++q) {
                float h[4];
#pragma unroll
                for (int t = 0; t < 4; ++t) { const float gt = acc[0][4 * q + t]; h[t] = gt / (1.f + __expf(-gt)) * acc[0][4 * (q + 2) + t]; }
                *(GAS unsigned long long*)(orow + 8 * q) = (unsigned long long)pk2(h[0], h[1]) | ((unsigned long long)pk2(h[2], h[3]) << 32);
            }
        }
    }
}
DI void p9_tail(const Frame& F, unsigned char* ws, const LAS int* tb) {
    const bf16* HE = (const bf16*)(ws + WS_HE); const bf16* WD = (const bf16*)(ws + WS_WD); bf16* Y2 = (bf16*)(ws + WS_Y2);
    const unsigned* gcnt = (const unsigned*)(ws + WS_CTL) + CW_CNT;
    const int n = F.lane & 31, kh = F.lane >> 5;
    for (int u = F.vcu; u < 256; u += F.G) {
        const int e = u >> 4, s = u & 15;
        const int ce = __builtin_amdgcn_readfirstlane((int)__hip_atomic_load(gcnt + e, __ATOMIC_RELAXED, __HIP_MEMORY_SCOPE_AGENT)), full = ce >> 8, r = ce & 255;
        if (r == 0) continue;
        const size_t row0 = (size_t)tb[e] * 256 + full * 256;
        f32x16m acc[2];
        tail_gemm<64, 4>(F, r,
            [&](int R) -> const char* { return (const char*)(WD + ((size_t)e * DM + 64 * s + R) * DE); },
            [&](int R) -> const char* { return (const char*)(HE + (row0 + R) * DE); }, acc);
        const int pos = full * 256 + 32 * F.wave + n;
        if (pos < ce && 32 * F.wave < r) {
#pragma unroll
            for (int c2 = 0; c2 < 2; ++c2) {
                bf16* orow = Y2 + (row0 + 32 * F.wave + n) * DM + 64 * s + 32 * c2 + 4 * kh;
#pragma unroll
                for (int q = 0; q < 4; ++q) *(GAS unsigned long long*)(orow + 8 * q) = (unsigned long long)pk2(acc[c2][4 * q], acc[c2][4 * q + 1]) | ((unsigned long long)pk2(acc[c2][4 * q + 2], acc[c2][4 * q + 3]) << 32);
            }
        }
    }
}
DI void p7_permute(const Frame& F, const KA& A) {
    unsigned char* ws = A.W();
    LAS int* tb = (LAS int*)(F.lds + RING_OFF);
    moe_tile_table(F, ws, tb);
    const bf16* HB = (const bf16*)(ws + WS_HB); bf16* HS = (bf16*)(ws + WS_HS);
    const int* TOKE = (const int*)(ws + WS_TOKE); const int* TOKP = (const int*)(ws + WS_TOKP);
    const int gw = F.vcu * NWAVES + F.wave, NGW = F.G * NWAVES;
    for (int it = gw; it < 2 * M; it += NGW) {
        const int m = it >> 1, k = it & 1; const int ee = TOKE[m]; const int e = k ? (ee >> 8) : (ee & 255);
        const size_t row = (size_t)tb[e] * 256 + TOKP[it];
        const v4u a0 = *(const v4u*)(HB + (size_t)m * DM + 8 * F.lane), a1 = *(const v4u*)(HB + (size_t)m * DM + 512 + 8 * F.lane);
        pg8::st16_wt(HS + row * DM + 8 * F.lane, a0); pg8::st16_wt(HS + row * DM + 512 + 8 * F.lane, a1);
    }
}
DI void p10_combine(const Frame& F, const KA& A) {
    unsigned char* ws = A.W();
    LAS int* tb = (LAS int*)(F.lds + RING_OFF);
    moe_tile_table(F, ws, tb);
    const float* g2 = A.I(16); const float* b2 = A.I(17); float* out = A.O();
    const bf16* Y2 = (const bf16*)(ws + WS_Y2);
    const bf16* HBc = (const bf16*)(ws + WS_HB); (void)HBc;
    const int* TOKE = (const int*)(ws + WS_TOKE); const int* TOKP = (const int*)(ws + WS_TOKP); const float* TOKW = (const float*)(ws + WS_TOKW);
    const int gw = F.vcu * NWAVES + F.wave, NGW = F.G * NWAVES;
    for (int m0 = gw * 2; m0 < M; m0 += NGW * 2) {
        int ee[2], tp[2][2]; float tw[2][2];
#pragma unroll
        for (int t = 0; t < 2; ++t) { const int m = m0 + t; ee[t] = TOKE[m]; tp[t][0] = TOKP[2 * m]; tp[t][1] = TOKP[2 * m + 1]; tw[t][0] = TOKW[2 * m]; tw[t][1] = TOKW[2 * m + 1]; }
        uint2 hr[2][4], ya[2][4], yb[2][4];
#pragma unroll
        for (int t = 0; t < 2; ++t) {
            const size_t ro = (size_t)(m0 + t) * DM;
            const size_t r0 = (size_t)tb[ee[t] & 255] * 256 + tp[t][0], r1 = (size_t)tb[ee[t] >> 8] * 256 + tp[t][1];
#pragma unroll
            for (int j = 0; j < 4; ++j) { hr[t][j] = *(const uint2*)(HBc + ro + 256 * j + 4 * F.lane);
                ya[t][j] = *(const uint2*)(Y2 + r0 * DM + 256 * j + 4 * F.lane); yb[t][j] = *(const uint2*)(Y2 + r1 * DM + 256 * j + 4 * F.lane); }
        }
#pragma unroll
        for (int t = 0; t < 2; ++t) {
            const size_t ro = (size_t)(m0 + t) * DM; const float w0 = tw[t][0], w1 = tw[t][1];
            f32x4 v[4]; float s = 0.f;
#pragma unroll
            for (int j = 0; j < 4; ++j) {
                v[j].x = ALPHA * bflo(hr[t][j].x) + w0 * bflo(ya[t][j].x) + w1 * bflo(yb[t][j].x); v[j].y = ALPHA * bfhi(hr[t][j].x) + w0 * bfhi(ya[t][j].x) + w1 * bfhi(yb[t][j].x);
                v[j].z = ALPHA * bflo(hr[t][j].y) + w0 * bflo(ya[t][j].y) + w1 * bflo(yb[t][j].y); v[j].w = ALPHA * bfhi(hr[t][j].y) + w0 * bfhi(ya[t][j].y) + w1 * bfhi(yb[t][j].y);
                s += (v[j].x + v[j].y) + (v[j].z + v[j].w);
            }
            const float mean = wave_sum(s) * (1.f / DM); float s2 = 0.f;
#pragma unroll
            for (int j = 0; j < 4; ++j) { v[j] = v[j] - mean; s2 += (v[j].x * v[j].x + v[j].y * v[j].y) + (v[j].z * v[j].z + v[j].w * v[j].w); }
            const float rstd = rsqrtf(wave_sum(s2) * (1.f / DM) + LN_EPS);
#pragma unroll
            for (int j = 0; j < 4; ++j) { const f32x4 gv = *(const f32x4*)(g2 + 256 * j + 4 * F.lane), bv = *(const f32x4*)(b2 + 256 * j + 4 * F.lane);
                *(f32x4*)(out + ro + 256 * j + 4 * F.lane) = v[j] * rstd * gv + bv; }
        }
    }
}

#ifndef DUP_P0
#define DUP_P0 1
#endif
#ifndef DUP_P1
#define DUP_P1 1
#endif
#ifndef DUP_P2
#define DUP_P2 1
#endif
#ifndef DUP_P3
#define DUP_P3 1
#endif
#ifndef DUP_P5
#define DUP_P5 1
#endif
#ifndef DUP_P7
#define DUP_P7 1
#endif
#ifndef DUP_P8
#define DUP_P8 1
#endif
#ifndef DUP_P9
#define DUP_P9 1
#endif
#ifdef SKIP_N2B
#define n2b_dn_recurrent(...) ((void)0)
#endif
#ifdef SKIP_N3B
#define n3b_moba_naive(...) ((void)0)
#endif
#ifdef SKIP_N5
#define n5_token_tail(...) ((void)0)
#endif
#ifdef SKIP_P0
#define p0_prologue(...) ((void)0)
#endif
#ifdef SKIP_N2A
#define n2a_conv_norm(...) ((void)0)
#endif
#ifdef SKIP_N3A
#define n3a_rope(...) ((void)0)
#endif
#ifdef SKIP_N2C
#define n2c_dn_gate(...) ((void)0)
#endif
#if defined(DBG_MOBA) || defined(DBG_DN)
#define DBG_ANY 1
#endif
#ifdef MOE_NAIVE
constexpr int N_PHASES = 7;
#else
constexpr int N_PHASES = 11;
#endif
__global__ void __launch_bounds__(NTHR, 2) mk_fwd(Args args_unused) {
    (void)args_unused;
    extern __shared__ __attribute__((aligned(16))) unsigned char lds[];
    Frame F;
    F.lds = (LAS unsigned char*)lds;
    F.tid = threadIdx.x; F.lane = F.tid & 63; F.wave = __builtin_amdgcn_readfirstlane(F.tid >> 6);
    F.G = gridDim.x; { const int bx = blockIdx.x; F.vcu = (F.G % 8 == 0) ? (bx % 8) * (F.G / 8) + bx / 8 : bx; }
    unsigned char* ws = kargs().W();
    gu32* ctl = (gu32*)(ws + WS_CTL);
    volatile LAS unsigned* MISC = (volatile LAS unsigned*)(F.lds + MISC_OFF);
    for (int u = F.tid; u < (LDS_BYTES - LDSCTL_OFF) / 4; u += NTHR) ((LAS unsigned*)(F.lds + LDSCTL_OFF))[u] = 0u;
    __syncthreads();
    const int lo = kargs().lo(), hi = kargs().hi();
    const bool multi = (hi - lo) > 1;
    XcdBarrier bar; bar.bar = (unsigned*)(ctl + CW_BAR); bar.x = 0; bar.st = nullptr;
    if (multi) bar = xcd_barrier_post((unsigned*)(ctl + CW_BAR), MISC + 8);
#define IN(k) (lo <= (k) && (k) < hi)
#define REFRESH_F() do { int t_ = threadIdx.x; asm volatile("" : "+v"(t_)); F.tid = t_; F.lane = t_ & 63; F.wave = __builtin_amdgcn_readfirstlane(t_ >> 6); } while (0)
#define SEAM(k) do { if (IN(k) && IN((k) + 1)) xcd_barrier(bar); } while (0)

    if (IN(0)) { REFRESH_F(); for (int rep_ = 0; rep_ < DUP_P0; ++rep_) { const KA args = kargs(); p0_prologue(F, args); __syncthreads(); } SEAM(0); }
    if (IN(1)) { REFRESH_F(); for (int rep_ = 0; rep_ < DUP_P1; ++rep_) {
        pg8::Gemm g{(const bf16*)(ws + WS_XB), (const bf16*)(ws + WS_WIN), M, NPROJ, DM}; pg8::StaticOrder S; S.init(M, NPROJ, F.G, (int)blockIdx.x);
#ifdef ROPE_EPI
        pg8::EpiProj E{(bf16*)(ws + WS_PJ), (size_t)(PJ_STRIDE / 2), (const float*)(ws + WS_ROPE), (float*)(ws + WS_KMP), (LAS float*)(F.lds + 131072)};
        pg8::gemm_phase<pg8::EpiProj, pg8::StaticOrder, true, PG8_SP2>(F.lds + RING_OFF, g, S, E); }
        {
          REFRESH_F(); const KA args = kargs();
          const int ntile = (M / 256) * (NPROJ / 256), nlate = ntile % F.G, c = (int)blockIdx.x;
          const int nhelp = nlate ? F.G - nlate : F.G, hi = nlate ? c - nlate : c;
          if (hi >= 0) weight_transposes(F, args, TR_I_A + TR_I_B, TR_I_ALL, hi * NWAVES + F.wave, nhelp * NWAVES);
        }
#else
        pg8::EpiBf16<0> E{(bf16*)(ws + WS_PJ), 512, nullptr, 512, (size_t)(PJ_STRIDE / 2), 1.f};
        pg8::gemm_phase<pg8::EpiBf16<0>, pg8::StaticOrder, PG8_ALIGN, PG8_SP2>(F.lds + RING_OFF, g, S, E); }
#endif
        SEAM(1);
    }
    if (IN(2)) { REFRESH_F();
        const KA args = kargs();
#if defined(DN_NAIVE) || defined(DBG_DN)
        n2a_conv_norm(F, args);
#endif
#ifndef DN_NAIVE
        {
            dn::RawQKV raw;
            int it = F.vcu;
            if (it < 1024) dn::chunk_load(raw, it, (const bf16*)(ws + WS_PJ), PJ_STRIDE / 2);
#pragma unroll 1
            for (; it < 1024; it += F.G)
                dn::chunk_local(F.lds, it, raw, it + F.G < 1024 ? it + F.G : -1, (const bf16*)(ws + WS_PJ), PJ_STRIDE / 2, (const float*)(ws + WS_GATES), args.I(2), args.I(3), args.I(4),
                                (unsigned char*)args.O(), ws + WS_UF, (float*)(ws + WS_GL));
        }
#endif
#ifndef ROPE_EPI
        n3a_rope(F, args);
#endif
        SEAM(2); }
    if (IN(3)) { REFRESH_F();
        const KA args = kargs();
#ifdef DN_NAIVE
        float* ODN = args.O();
#else
        float* ODN = (float*)(ws + WS_PJ);
#endif
        {
            const int v = F.vcu;
            const int bh = __builtin_amdgcn_readfirstlane(v >> 4), r = __builtin_amdgcn_readfirstlane(v & 15);
            if (r == 15 && v < 256) {
#if defined(DN_NAIVE) || defined(DBG_DN)
                n2b_dn_recurrent(F, args, bh, ODN);
#endif
#ifndef DN_NAIVE
                dn::scan_bh(F.lds, bh, (const unsigned char*)args.O(), ws + WS_UF, (const float*)(ws + WS_GL), ws + WS_SF, ws + WS_VF);
#endif
            }
#ifdef MB_QUEUE
            p3_moba_queue(ws, (char*)lds, (LAS unsigned*)(F.lds + LDSCTL_OFF + 640), F.tid, __builtin_amdgcn_readfirstlane((v >> 5) & 7));
#else
            if (r != 15) p3_moba_static(ws, (char*)lds, bh, 15 - r, r == 14 ? 0 : -1);
#endif
        }
        SEAM(3);
    }
    if (IN(4)) { REFRESH_F(); const KA args = kargs();
#ifdef DN_NAIVE
        n2c_dn_gate(F, args, args.O(), (bf16*)(ws + WS_Y), 1024);
#else
        for (int it = F.vcu; it < 512; it += F.G)
            dn::chunk_out(F.lds, it, (const unsigned char*)args.O(), ws + WS_SF, ws + WS_VF, (const bf16*)(ws + WS_PJ + 3 * PJ_STRIDE), args.I(5), (bf16*)(ws + WS_Y));
#endif
#ifdef MB_QUEUE
        for (int it = F.vcu; it < MB_NSPLIT * 32; it += F.G) p4_moba_merge(ws, it, F.tid);
#endif
        SEAM(4); }
    if (IN(5)) { REFRESH_F();
        const KA args = kargs();
        pg8::Gemm g{(const bf16*)(ws + WS_Y), (const bf16*)(ws + WS_WOUT), M, DM, DM}; pg8::StaticOrder S; S.init(M, DM, F.G, (int)blockIdx.x);
#if defined(MOE_NAIVE)
        pg8::EpiF32 E{args.O(), DM};
        for (int rep_ = 0; rep_ < DUP_P5; ++rep_) pg8::gemm_phase<pg8::EpiF32, pg8::StaticOrder, PG8_ALIGN, PG8_SP2>(F.lds + RING_OFF, g, S, E);
#elif !defined(LN1_FUSE)
        pg8::EpiBf16<0> E{(bf16*)(ws + WS_MIXB), DM, nullptr, 0, 0, 1.f};
        pg8::gemm_phase<pg8::EpiBf16<0>, pg8::StaticOrder, PG8_ALIGN, PG8_SP2>(F.lds + RING_OFF, g, S, E);
#else
        if (F.G == 256) {
            pg8::PanelStats st{(unsigned*)(ws + WS_XBUF), (unsigned*)(ws + WS_CTL) + CW_SEAM, (unsigned*)(ws + WS_CTL), DM / 256, LN_EPS, 0x740u};
            pg8::EpiLn1 E{args.I(0), args.O(), (bf16*)(ws + WS_HB), args.I(7), args.I(8), ALPHA, st, 0u};
            pg8::gemm_phase<pg8::EpiLn1, pg8::StaticOrder, false, PG8_SP2>(F.lds + RING_OFF, g, S, E);
        }
#endif
        SEAM(5);
    }
#ifdef MOE_NAIVE
    if (IN(6)) { REFRESH_F(); const KA args = kargs(); n5_token_tail(F, args); }
#else
    if (IN(6)) { REFRESH_F(); const KA args = kargs(); p6_ln_router(F, args); SEAM(6); }
#ifdef MOE_PERMUTE
    if (IN(7)) { REFRESH_F(); for (int rep_ = 0; rep_ < DUP_P7; ++rep_) { const KA args = kargs(); p7_permute(F, args); __syncthreads(); } SEAM(7); }
#endif
    if (IN(8)) { REFRESH_F();
        LAS int* tb = (LAS int*)(F.lds + LDSCTL_OFF + 1024); moe_tile_table(F, ws, tb);
#ifdef MOE_PERMUTE
        pg8::Gemm g{(const bf16*)(ws + WS_HS), (const bf16*)(ws + WS_WGU), 36864, 512, DM}; pg8::MoeOrder<false> S{(const LAS int*)tb, 2, F.G, (int)blockIdx.x, (size_t)512 * DM * 2, nullptr, nullptr};
#else
        pg8::Gemm g{(const bf16*)(ws + WS_HB), (const bf16*)(ws + WS_WGU), 36864, 512, DM}; pg8::MoeOrder<true> S{(const LAS int*)tb, 2, F.G, (int)blockIdx.x, (size_t)512 * DM * 2, (const int*)(ws + WS_LIST), (const unsigned*)(ws + WS_CTL) + CW_CNT};
#endif
        pg8::EpiSwiGLU E{(bf16*)(ws + WS_HE)};
        for (int rep_ = 0; rep_ < DUP_P8; ++rep_) pg8::gemm_phase<pg8::EpiSwiGLU, decltype(S), PG8_ALIGN, PG8_SP2>(F.lds + RING_OFF, g, S, E);
#ifndef DUP_T8
#define DUP_T8 1
#endif
        for (int rep_ = 0; rep_ < DUP_T8; ++rep_) { REFRESH_F(); p8_tail(F, ws, tb); }
        SEAM(8);
    }
    if (IN(9)) { REFRESH_F();
        LAS int* tb = (LAS int*)(F.lds + LDSCTL_OFF + 1024); moe_tile_table(F, ws, tb);
        int kdim = DE; asm volatile("" : "+s"(kdim));
        pg8::Gemm g{(const bf16*)(ws + WS_HE), (const bf16*)(ws + WS_WD), 36864, DM, kdim}; pg8::MoeOrder<false> S{(const LAS int*)tb, 4, F.G, (int)blockIdx.x, (size_t)DM * DE * 2, nullptr, nullptr};
        pg8::EpiBf16<0> E{(bf16*)(ws + WS_Y2), DM, nullptr, 0, 0, 1.f};
        for (int rep_ = 0; rep_ < DUP_P9; ++rep_) pg8::gemm_phase<pg8::EpiBf16<0>, pg8::MoeOrder<false>, PG8_ALIGN, PG8_SP2>(F.lds + RING_OFF, g, S, E);
#ifndef DUP_T9
#define DUP_T9 1
#endif
        for (int rep_ = 0; rep_ < DUP_T9; ++rep_) { REFRESH_F(); p9_tail(F, ws, tb); }
        SEAM(9);
    }
    if (IN(10)) { REFRESH_F(); const KA args = kargs(); p10_combine(F, args); }
#endif
#undef IN
#undef SEAM
}

extern "C" void kernel_launch(void* const* d_in, const int* in_sizes, int n_in, void* d_out, int out_size, void* d_ws, size_t ws_size, hipStream_t stream) {
    static int grid = 0;
    if (grid == 0) {
        if (n_in != 18 || in_sizes[0] != M * DM || out_size != M * DM || ws_size < WS_END) { fprintf(stderr, "kernel_launch: unexpected shapes (n_in %d, in0 %d, out %d, ws %zu)\n", n_in, n_in > 0 ? in_sizes[0] : -1, out_size, ws_size); grid = -1; return; }
        int dev = 0, cus = 0;
        if (hipGetDevice(&dev) != hipSuccess || hipDeviceGetAttribute(&cus, hipDeviceAttributeMultiprocessorCount, dev) != hipSuccess) { grid = -1; return; }
        if (hipFuncSetAttribute((const void*)mk_fwd, hipFuncAttributeMaxDynamicSharedMemorySize, LDS_BYTES) != hipSuccess) { fprintf(stderr, "kernel_launch: hipFuncSetAttribute failed\n"); grid = -1; return; }
        int per_cu = 0;
        if (hipOccupancyMaxActiveBlocksPerMultiprocessor(&per_cu, (const void*)mk_fwd, NTHR, LDS_BYTES) != hipSuccess || per_cu < 1) fprintf(stderr, "kernel_launch: occupancy query says %d\n", per_cu);
        (void)hipGetLastError();
        grid = cus;
    }
    if (grid < 0) return;
    (void)hipMemsetAsync((char*)d_ws + WS_CTL, 0, CTL_ZERO_BYTES, stream);
    Args a{};
    for (int i = 0; i < 18; ++i) a.in_[i] = (const GAS float*)d_in[i];
    a.out_ = (GAS float*)d_out; a.ws_ = (GAS unsigned char*)d_ws;
#ifndef MK_PER_PHASE
    a.ph_lo = 0; a.ph_hi = N_PHASES;
    hipLaunchKernelGGL(mk_fwd, dim3(grid), dim3(NTHR), LDS_BYTES, stream, a);
#else
    for (int p = 0; p < N_PHASES; ++p) { a.ph_lo = p; a.ph_hi = p + 1; hipLaunchKernelGGL(mk_fwd, dim3(grid), dim3(NTHR), LDS_BYTES, stream, a); }
#endif
}
```
